# Optimizing an MI355X kernel written in HIP

```python
import jax, jax.numpy as jnp
from jax import lax
import numpy as np

D_MODEL = 1024
BATCH = 16
SEQ = 2048
DEPTH = 2

GRID_W = 64
CTX_LEN = 256
MIX_WIDTH = D_MODEL
RET_WIDTH = MIX_WIDTH // 2
POOL_WIDTH = MIX_WIDTH - RET_WIDTH
RET_HEADS = 4
RET_HEAD_DIM = RET_WIDTH // RET_HEADS
RET_CHUNK = 128
POOL_WINDOWS = (2, 4, 8, 16)
POOL_GROUPS = len(POOL_WINDOWS)
POOL_GROUP_DIM = POOL_WIDTH // POOL_GROUPS
IN_PROJ_WIDTH = 4 * RET_WIDTH + POOL_WIDTH
IN_PROJ_SPLITS = (RET_WIDTH, 2 * RET_WIDTH, 3 * RET_WIDTH, 4 * RET_WIDTH)
N_GROUPS = 4
EXPERTS_PER_GROUP = 8
N_EXPERTS = N_GROUPS * EXPERTS_PER_GROUP
TOP_K = 2
EXPERT_FF = D_MODEL // 2
MOE_BLOCK = 128
ROPE_BASE = 10000.0
NORM_EPS = 1e-6

kernel_name = "hybrid_retention_pool_hmoe_dit"


def rms_norm(x, gain):
    xf = x.astype(jnp.float32)
    y = xf * lax.rsqrt(jnp.mean(xf * xf, axis=-1, keepdims=True) + NORM_EPS)
    return (y * gain.astype(jnp.float32)).astype(x.dtype)


def modulate(x, gain, shift, scale):
    return rms_norm(x, gain) * (1.0 + scale) + shift


def rope_1d(x, pos):
    m = x.shape[-1] // 2
    inv = ROPE_BASE ** (-jnp.arange(m, dtype=jnp.float32) / m)
    ang = pos.astype(jnp.float32)[:, None] * inv[None, :]
    cos, sin = jnp.cos(ang), jnp.sin(ang)
    x1, x2 = x[..., :m], x[..., m:]
    return jnp.concatenate([x1 * cos - x2 * sin, x1 * sin + x2 * cos], axis=-1)


def rope_2d(x, rows, cols):
    h = x.shape[-1] // 2
    return jnp.concatenate([rope_1d(x[..., :h], rows), rope_1d(x[..., h:], cols)], axis=-1)


def to_heads(a):
    B, T, _ = a.shape
    return a.astype(jnp.float32).reshape(B, T, RET_HEADS, RET_HEAD_DIM).transpose(0, 2, 1, 3)


def retention_chunkwise(q, k, v, log_gamma, s0):
    B, H, T, Dh = q.shape
    C = RET_CHUNK
    n_chunks = T // C
    pos = jnp.arange(C, dtype=jnp.float32)
    diff = pos[:, None] - pos[None, :]
    intra = jnp.where(diff >= 0.0, jnp.exp(log_gamma[:, None, None] * jnp.maximum(diff, 0.0)), 0.0)
    q_decay = jnp.exp(log_gamma[:, None] * (pos + 1.0))[None, :, :, None]
    k_decay = jnp.exp(log_gamma[:, None] * (C - 1.0 - pos))[None, :, :, None]
    chunk_decay = jnp.exp(log_gamma * C)[None, :, None, None]

    def chunks(a):
        return a.reshape(B, H, n_chunks, C, Dh).transpose(2, 0, 1, 3, 4)

    def step(state, qkv):
        qc, kc, vc = qkv
        scores = jnp.einsum('bhid,bhjd->bhij', qc, kc) * intra
        o = jnp.einsum('bhij,bhjd->bhid', scores, vc) + jnp.einsum('bhid,bhde->bhie', qc * q_decay, state)
        state = state * chunk_decay + jnp.einsum('bhjd,bhje->bhde', kc * k_decay, vc)
        return state, o

    s_final, o = lax.scan(step, s0, (chunks(q), chunks(k), chunks(v)))
    return o.transpose(1, 2, 0, 3, 4).reshape(B, H, T, Dh), s_final


def bidir_retention(q_c, k_c, v_c, q_l, k_l, v_l, lg_f, lg_b):
    B, H, _, Dh = q_c.shape
    flip = lambda a: jnp.flip(a, axis=2)
    zero = jnp.zeros((B, H, Dh, Dh), jnp.float32)
    o_cf, s_f = retention_chunkwise(q_c, k_c, v_c, lg_f, zero)
    o_cb, s_b = retention_chunkwise(flip(q_c), flip(k_c), flip(v_c), lg_b, zero)
    o_lf, _ = retention_chunkwise(q_l, k_l, v_l, lg_f, s_f)
    o_lb, _ = retention_chunkwise(flip(q_l), flip(k_l), flip(v_l), lg_b, s_b)
    return o_cf + flip(o_cb), o_lf + flip(o_lb)


def multiscale_pool(p, pool_w, pool_scale):
    B, T, _ = p.shape
    grp = p.astype(jnp.float32).reshape(B, T, POOL_GROUPS, POOL_GROUP_DIM)
    cs = jnp.concatenate([jnp.zeros((B, 1, POOL_GROUPS, POOL_GROUP_DIM), jnp.float32),
                          jnp.cumsum(grp, axis=1)], axis=1)
    win = jnp.array(POOL_WINDOWS, jnp.int32)
    t = jnp.arange(T, dtype=jnp.int32)[:, None]
    lo = jnp.clip(t - win // 2, 0, T)
    hi = jnp.clip(t + win // 2, 0, T)
    gidx = jnp.arange(POOL_GROUPS, dtype=jnp.int32)[None, :]
    wsum = cs[:, hi, gidx] - cs[:, lo, gidx]
    mean = wsum / (hi - lo).astype(jnp.float32)[None, :, :, None]
    out = jnp.einsum('btgc,gcd->btgd', mean - grp, pool_w.astype(jnp.float32))
    return out.reshape(B, T, POOL_WIDTH) * pool_scale.astype(jnp.float32)


def token_mixer(h_lat, h_ctx, w_in, decay_f, decay_b, pool_w, pool_scale, w_out, rows, cols, ctx_out):
    pl = h_lat @ w_in
    pc = h_ctx @ w_in
    ql, kl, vl, gl, xl = jnp.split(pl, IN_PROJ_SPLITS, axis=-1)
    qc, kc, vc, gc, xc = jnp.split(pc, IN_PROJ_SPLITS, axis=-1)
    k_scale = RET_HEAD_DIM ** -0.5
    ql = rope_2d(to_heads(ql), rows, cols)
    kl = rope_2d(to_heads(kl), rows, cols) * k_scale
    qc = to_heads(qc)
    kc = to_heads(kc) * k_scale
    lg_f = jax.nn.log_sigmoid(decay_f.astype(jnp.float32))
    lg_b = jax.nn.log_sigmoid(decay_b.astype(jnp.float32))
    o_c, o_l = bidir_retention(qc, kc, to_heads(vc), ql, kl, to_heads(vl), lg_f, lg_b)

    def merge(o, g, xp):
        B, H, T, Dh = o.shape
        o = o * lax.rsqrt(jnp.mean(o * o, axis=-1, keepdims=True) + NORM_EPS)
        o = o.transpose(0, 2, 1, 3).reshape(B, T, RET_WIDTH)
        ret = jax.nn.silu(g.astype(jnp.float32)) * o
        pool = multiscale_pool(xp, pool_w, pool_scale)
        return jnp.concatenate([ret, pool], axis=-1).astype(h_lat.dtype) @ w_out

    y_lat = merge(o_l, gl, xl)
    y_ctx = merge(o_c, gc, xc) if ctx_out else None
    return y_lat, y_ctx


def hier_moe(h, rg_w, rg_b, re_w, re_b, w_gate, w_up, w_down):
    T, D = h.shape
    hf = h.astype(jnp.float32)
    g_logits = hf @ rg_w.astype(jnp.float32) + rg_b.astype(jnp.float32)
    g_top = jnp.argmax(g_logits, axis=-1)
    g_w = jnp.take_along_axis(jax.nn.softmax(g_logits, axis=-1), g_top[:, None], axis=-1)
    e_logits = (hf @ re_w.astype(jnp.float32) + re_b.astype(jnp.float32)).reshape(T, N_GROUPS, EXPERTS_PER_GROUP)
    e_in = jnp.take_along_axis(e_logits, g_top[:, None, None], axis=1)[:, 0]
    top_vals, top_idx = lax.top_k(e_in, TOP_K)
    top_w = jax.nn.softmax(top_vals, axis=-1) * g_w
    expert_idx = g_top[:, None].astype(jnp.int32) * EXPERTS_PER_GROUP + top_idx.astype(jnp.int32)

    A = T * TOP_K
    e_flat = expert_idx.reshape(A)
    w_flat = top_w.reshape(A)
    tok_flat = jnp.repeat(jnp.arange(T, dtype=jnp.int32), TOP_K)
    order = jnp.argsort(e_flat)
    e_sorted = e_flat[order]
    counts = jnp.bincount(e_flat, length=N_EXPERTS)
    starts = jnp.cumsum(counts) - counts
    padded = (counts + MOE_BLOCK - 1) // MOE_BLOCK * MOE_BLOCK
    pends = jnp.cumsum(padded)
    pstarts = pends - padded
    dest = pstarts[e_sorted] + (jnp.arange(A, dtype=jnp.int32) - starts[e_sorted])
    n_blocks = -(-A // MOE_BLOCK) + N_EXPERTS
    n_rows = n_blocks * MOE_BLOCK
    buf_tok = jnp.full((n_rows,), T, jnp.int32).at[dest].set(tok_flat[order])
    buf_w = jnp.zeros((n_rows,), jnp.float32).at[dest].set(w_flat[order])
    block_start = jnp.arange(n_blocks, dtype=jnp.int32) * MOE_BLOCK
    block_expert = jnp.minimum(jnp.searchsorted(pends, block_start, side='right'), N_EXPERTS - 1)
    h_pad = jnp.concatenate([h, jnp.zeros((1, D), h.dtype)], axis=0)

    def run_block(args):
        tok, e = args
        xb = h_pad[tok]
        return (jax.nn.silu(xb @ w_gate[e]) * (xb @ w_up[e])) @ w_down[e]

    y_buf = lax.map(run_block, (buf_tok.reshape(n_blocks, MOE_BLOCK), block_expert))
    y_buf = y_buf.reshape(n_rows, D).astype(jnp.float32) * buf_w[:, None]
    return jax.ops.segment_sum(y_buf, buf_tok, num_segments=T + 1)[:T].astype(h.dtype)


def setup_inputs(seed: int = 0) -> dict:
    key = jax.random.key(seed)
    ks = jax.random.split(key, 24)
    f32 = jnp.float32

    def nrm(k, shape, scale):
        return jax.random.normal(k, shape, f32) * scale

    gamma0 = 1.0 - 2.0 ** (-5.0 - np.arange(RET_HEADS, dtype=np.float32))
    logit0 = jnp.asarray(np.log(gamma0 / (1.0 - gamma0)), f32)
    return {
        "x": nrm(ks[0], (BATCH, SEQ, D_MODEL), 1.0),
        "c": nrm(ks[1], (BATCH, D_MODEL), 1.0),
        "ctx": nrm(ks[2], (BATCH, CTX_LEN, D_MODEL), 1.0),
        "c_ctx": nrm(ks[3], (D_MODEL,), 1.0),
        "ada_w": nrm(ks[4], (DEPTH, D_MODEL, 6 * D_MODEL), 0.5 * D_MODEL ** -0.5),
        "ada_b": nrm(ks[5], (DEPTH, 6 * D_MODEL), 0.02),
        "norm1_g": 1.0 + nrm(ks[6], (DEPTH, D_MODEL), 0.1),
        "w_in": nrm(ks[7], (DEPTH, D_MODEL, IN_PROJ_WIDTH), D_MODEL ** -0.5),
        "decay_fwd": logit0[None, :] + nrm(ks[8], (DEPTH, RET_HEADS), 0.05),
        "decay_bwd": logit0[None, :] + nrm(ks[9], (DEPTH, RET_HEADS), 0.05),
        "pool_w": nrm(ks[10], (DEPTH, POOL_GROUPS, POOL_GROUP_DIM, POOL_GROUP_DIM), POOL_GROUP_DIM ** -0.5),
        "pool_scale": 1.0 + nrm(ks[11], (DEPTH, POOL_WIDTH), 0.1),
        "w_out": nrm(ks[12], (DEPTH, MIX_WIDTH, D_MODEL), MIX_WIDTH ** -0.5),
        "norm2_g": 1.0 + nrm(ks[13], (DEPTH, D_MODEL), 0.1),
        "router_g_w": nrm(ks[14], (DEPTH, D_MODEL, N_GROUPS), D_MODEL ** -0.5),
        "router_g_b": nrm(ks[15], (DEPTH, N_GROUPS), 0.01),
        "router_e_w": nrm(ks[16], (DEPTH, D_MODEL, N_EXPERTS), D_MODEL ** -0.5),
        "router_e_b": nrm(ks[17], (DEPTH, N_EXPERTS), 0.01),
        "exp_w_gate": nrm(ks[18], (DEPTH, N_EXPERTS, D_MODEL, EXPERT_FF), D_MODEL ** -0.5),
        "exp_w_up": nrm(ks[19], (DEPTH, N_EXPERTS, D_MODEL, EXPERT_FF), D_MODEL ** -0.5),
        "exp_w_down": nrm(ks[20], (DEPTH, N_EXPERTS, EXPERT_FF, D_MODEL), EXPERT_FF ** -0.5),
        "final_norm_g": 1.0 + nrm(ks[21], (D_MODEL,), 0.1),
    }


def reference(x, c, ctx, c_ctx, ada_w, ada_b, norm1_g, w_in, decay_fwd, decay_bwd, pool_w, pool_scale,
              w_out, norm2_g, router_g_w, router_g_b, router_e_w, router_e_b, exp_w_gate, exp_w_up,
              exp_w_down, final_norm_g):
    B, T, D = x.shape
    rows_n = T // GRID_W
    rows = jnp.repeat(jnp.arange(rows_n, dtype=jnp.int32), GRID_W)
    cols = jnp.tile(jnp.arange(GRID_W, dtype=jnp.int32), rows_n)
    ctx_h = ctx
    n_ctx = ctx.shape[1]
    for l in range(DEPTH):
        last = l == DEPTH - 1
        mod = jax.nn.silu(c) @ ada_w[l] + ada_b[l]
        mod_c = jax.nn.silu(c_ctx) @ ada_w[l] + ada_b[l]
        sh1, sc1, g1, sh2, sc2, g2 = jnp.split(mod[:, None, :], 6, axis=-1)
        csh1, csc1, cg1, csh2, csc2, cg2 = jnp.split(mod_c[None, None, :], 6, axis=-1)

        h_lat = modulate(x, norm1_g[l], sh1, sc1)
        h_ctx = modulate(ctx_h, norm1_g[l], csh1, csc1)
        y_lat, y_ctx = token_mixer(h_lat, h_ctx, w_in[l], decay_fwd[l], decay_bwd[l], pool_w[l], pool_scale[l],
                                   w_out[l], rows, cols, not last)
        x = x + g1 * y_lat
        moe_args = (router_g_w[l], router_g_b[l], router_e_w[l], router_e_b[l],
                    exp_w_gate[l], exp_w_up[l], exp_w_down[l])
        h_lat = modulate(x, norm2_g[l], sh2, sc2)
        if not last:
            ctx_h = ctx_h + cg1 * y_ctx
            h_ctx = modulate(ctx_h, norm2_g[l], csh2, csc2)
            tokens = jnp.concatenate([h_lat.reshape(B * T, D), h_ctx.reshape(B * n_ctx, D)], axis=0)
            y = hier_moe(tokens, *moe_args)
            x = x + g2 * y[:B * T].reshape(B, T, D)
            ctx_h = ctx_h + cg2 * y[B * T:].reshape(B, n_ctx, D)
        else:
            y = hier_moe(h_lat.reshape(B * T, D), *moe_args)
            x = x + g2 * y.reshape(B, T, D)
    return rms_norm(x, final_norm_g)
```

```cpp
#include <hip/hip_runtime.h>
#include <cstdio>
#include <cstdint>

#ifndef MK_N_LAUNCHES
#define MK_N_LAUNCHES 18
#endif

#define LAS __attribute__((address_space(3)))
#define GAS __attribute__((address_space(1)))
typedef unsigned short bf16_t;
typedef short bf16x8 __attribute__((ext_vector_type(8)));
typedef short s16x4 __attribute__((ext_vector_type(4)));
typedef float f32x4 __attribute__((ext_vector_type(4)));
typedef float f32x2 __attribute__((ext_vector_type(2)));
typedef unsigned u32x4 __attribute__((ext_vector_type(4)));
typedef unsigned u32x2 __attribute__((ext_vector_type(2)));

constexpr int Bn = 16, TL = 2048, CT = 256, D = 1024, DEPTH = 2;
constexpr int NLAT = Bn * TL, NCTX = Bn * CT, NTOK = NLAT + NCTX;
constexpr int NP = 2560;
constexpr int NE = 32, FF = 512, NH = 4, HD = 128;
constexpr int NCHUNK = 18;
constexpr float EPS = 1e-6f;
constexpr int MAXTILES = 320;
constexpr int N_PHASES = 18;

constexpr size_t MiB = 1u << 20;
constexpr size_t WS_CTL = 0, CTL_ZERO_BYTES = 1 * MiB;
constexpr size_t WS_MOD = 1 * MiB;
constexpr size_t WS_ROPE = 2 * MiB;
constexpr size_t WS_TOKINFO = 3 * MiB;
constexpr size_t WS_LIST = 5 * MiB;
constexpr size_t WS_WIN = 10 * MiB;
constexpr size_t WS_WOUT = 20 * MiB;
constexpr size_t WS_WGU = 24 * MiB;
constexpr size_t WS_WD = 152 * MiB;
constexpr size_t WS_XC = 216 * MiB;
constexpr size_t WS_H = 232 * MiB;
constexpr size_t WS_P = 304 * MiB;
constexpr size_t WS_ACT = 484 * MiB;
constexpr size_t WS_END = 564 * MiB;
constexpr int CW_TMO = 0;
constexpr int CW_CNT = 1024;
constexpr int CW_BAR = 4096;

constexpr int RING_BYTES = 131072;
constexpr int TOKT_OFF = RING_BYTES;
constexpr int MISC_OFF = 147456;
constexpr int LDS_BYTES = 163840;

__device__ __forceinline__ unsigned f2bf(float f) { unsigned u = __builtin_bit_cast(unsigned, f); return (u + 0x7fffu + ((u >> 16) & 1u)) >> 16; }
__device__ __forceinline__ unsigned pk2(float lo, float hi) { return f2bf(lo) | (f2bf(hi) << 16); }
__device__ __forceinline__ float bflo(unsigned w) { return __builtin_bit_cast(float, w << 16); }
__device__ __forceinline__ float bfhi(unsigned w) { return __builtin_bit_cast(float, w & 0xffff0000u); }
__device__ __forceinline__ float wave_sum(float v) {
#pragma unroll
    for (int o = 1; o < 64; o <<= 1) v += __shfl_xor(v, o);
    return v;
}
__device__ __forceinline__ float silu_f(float x) { return x / (1.0f + __expf(-x)); }

#define XB_TMO      128
#define XB_XCNT(j)  (256  + 64 * (j))
#define XB_XSUB(j)  (1280 + 64 * (j))
#define XB_XGEN(j)  (2304 + 64 * (j))
#define XB_TOP      3328
#define XB_TOPGEN   3392
#define XCD_BAR_WORDS 3456
#define XB_SPIN_CAP (1u << 18)
__device__ __forceinline__ unsigned xb_ld(unsigned* p)              { return __hip_atomic_load(p, __ATOMIC_RELAXED, __HIP_MEMORY_SCOPE_AGENT); }
__device__ __forceinline__ unsigned xb_add(unsigned* p, unsigned v) { return __hip_atomic_fetch_add(p, v, __ATOMIC_RELAXED, __HIP_MEMORY_SCOPE_AGENT); }
__device__ __forceinline__ unsigned xb_xcc_id() { return (unsigned)__builtin_amdgcn_s_getreg((3 << 11) | 20) & 0xFu; }
#define XB_SPIN(cond, bar) do { unsigned _sp = 0; while (cond) { __builtin_amdgcn_s_sleep(1); \
    if ((++_sp & 255u) == 0u) { if (xb_ld(&(bar)[XB_TMO])) break; if (_sp > XB_SPIN_CAP) { atomicAdd(&(bar)[XB_TMO], 1u); break; } } } } while (0)
struct XcdBarrier { unsigned* bar; unsigned x; volatile LAS unsigned* st; };
__device__ __forceinline__ XcdBarrier xcd_barrier_post(unsigned* bar, volatile LAS unsigned* st) {
    XcdBarrier b; b.bar = bar; b.x = xb_xcc_id(); b.st = st;
    if (threadIdx.x == 0) (void)xb_add(&bar[XB_XCNT(b.x)], 1u);
    return b;
}
__device__ __forceinline__ void xcd_barrier_complete(unsigned* bar, unsigned x, unsigned& nloc, unsigned& nx) {
    const unsigned G = gridDim.x * gridDim.y * gridDim.z;
    unsigned sum, cnt, mine, sp = 0u;
    for (;;) {
        sum = 0u; cnt = 0u; mine = 0u;
#pragma unroll
        for (unsigned j = 0; j < 16; ++j) { const unsigned c = xb_ld(&bar[XB_XCNT(j)]); sum += c; cnt += (c > 0u) ? 1u : 0u; mine = (j == x) ? c : mine; }
        if (sum == G) break;
        __builtin_amdgcn_s_sleep(1);
        if ((++sp & 255u) == 0u) { if (xb_ld(&bar[XB_TMO])) break; if (sp > XB_SPIN_CAP) { atomicAdd(&bar[XB_TMO], 1u); break; } }
    }
    nloc = mine > 0u ? mine : 1u; nx = cnt > 0u ? cnt : 1u;
}
__device__ __forceinline__ void xcd_barrier(const XcdBarrier& b) {
    asm volatile("s_waitcnt vmcnt(0)" ::: "memory");
    __syncthreads();
    if (threadIdx.x == 0) {
        unsigned* bar = b.bar;
        __builtin_amdgcn_s_waitcnt(0);
        unsigned nloc = b.st[0], nx = b.st[1];
        if (nloc == 0u) { xcd_barrier_complete(bar, b.x, nloc, nx); b.st[0] = nloc; b.st[1] = nx; }
        const unsigned old = xb_add(&bar[XB_XSUB(b.x)], 1u);
        const unsigned gen = old / nloc;
        if (old + 1u == (gen + 1u) * nloc) {
            __builtin_amdgcn_fence(__ATOMIC_RELEASE, "agent");
            asm volatile("s_waitcnt vmcnt(0)" ::: "memory");
            const unsigned og = xb_add(&bar[XB_TOP], 1u);
            const unsigned tg = og / nx;
            if (og + 1u == (tg + 1u) * nx) xb_add(&bar[XB_TOPGEN], 1u);
            else XB_SPIN(xb_ld(&bar[XB_TOPGEN]) == tg, bar);
            __builtin_amdgcn_fence(__ATOMIC_ACQUIRE, "agent");
            xb_add(&bar[XB_XGEN(b.x)], 1u);
            asm volatile("s_waitcnt vmcnt(0)" ::: "memory");
        } else {
            XB_SPIN(xb_ld(&bar[XB_XGEN(b.x)]) == gen, bar);
            __builtin_amdgcn_fence(__ATOMIC_ACQUIRE, "agent");
            asm volatile("s_waitcnt vmcnt(0)" ::: "memory");
        }
    }
    __syncthreads();
}

namespace pg8 {
constexpr int BM = 256, BK = 64, HALF = 128, HTB = HALF * BK * 2, STAGE_BYTES = 8 * HTB, NXCD = 8, WGM = 8;
__device__ __forceinline__ int lds_byte(int r, int c) { const int st = (r >> 4) * 2 + (c >> 5), rr = r & 15, cc = c & 31, ob = rr * 64 + cc * 2; return st * 1024 + (ob ^ (((ob >> 9) & 1) << 5)); }
__device__ __forceinline__ void stage_rc(int b, int& R, int& C) { const int st = b / 1024, sb = b % 1024, swz = sb ^ (((sb >> 9) & 1) << 5); R = (st >> 1) * 16 + swz / 64; C = (st & 1) * 32 + (swz % 64) / 2; }
__device__ __forceinline__ int perm32(int rho) { const int n = rho >> 4, i = rho & 15; return 8 * (i >> 2) + 4 * n + (i & 3); }

struct Unit { int pm, pn; unsigned bofs; int aux; };

struct SchedDense {
    int nM, nN, nwg, G, c, K;
    __device__ void init(int M, int N, int K_, int G_, int c_) { nM = M / BM; nN = N / BM; nwg = nM * nN; G = G_; c = c_; K = K_; }
    __device__ bool next(int i, Unit& u) const {
        const long L = (long)i * G + c; if (L >= nwg) return false;
        int wgid = (int)L; { const int q = nwg / NXCD, r = nwg % NXCD, xcd = wgid % NXCD, off = wgid / NXCD; wgid = (xcd < r ? xcd * (q + 1) : r * (q + 1) + (xcd - r) * q) + off; }
        const int nig = WGM * nN, gid = wgid / nig, fm = gid * WGM, gsz = (nM - fm) < WGM ? (nM - fm) : WGM;
        u.pm = fm + ((wgid % nig) % gsz); u.pn = (wgid % nig) / gsz; u.bofs = (unsigned)u.pn * (unsigned)(BM * K * 2); u.aux = 0; return true;
    }
    __device__ __forceinline__ unsigned a_row(const Unit& u, int r) const { return (unsigned)(u.pm * BM + r); }
};
struct SchedGroup {
    const LAS int* tb; const LAS int* tokt; int G, c, K, gather;
    __device__ bool next(int i, Unit& u) const {
        const int L = i * G + c, nt = tb[NE]; if (L >= nt * 4) return false;
        const int g = L >> 2; int e = 0; while (tb[e + 1] <= g) ++e;
        u.pm = g; u.pn = L & 3; u.bofs = (unsigned)(e * 1024 + u.pn * BM) * (unsigned)(K * 2); u.aux = i; return true;
    }
    __device__ __forceinline__ unsigned a_row(const Unit& u, int r) const { return gather ? (unsigned)tokt[u.aux * 256 + r] : (unsigned)(u.pm * BM + r); }
};

__device__ __forceinline__ unsigned cvt_pk_bf16(float lo, float hi) { unsigned r; asm volatile("v_cvt_pk_bf16_f32 %0, %1, %2" : "=v"(r) : "v"(lo), "v"(hi)); return r; }

template <class Epi, class Sched, bool ALIGN_EPI, bool SP2>
__device__ __forceinline__ void gemm_phase(LAS unsigned char* lds, const int tid, const char* Abase, const char* Bbase, const int K, const Sched& S, const Epi& E) {
    const int wid = __builtin_amdgcn_readfirstlane(tid >> 6), lane = tid & 63, wr = wid >> 2, wc = wid & 3, fr = lane & 15, fq = lane >> 4;
    const int nt = K / BK;
    int Rr[2], Cc[2]; unsigned voffB[2];
#pragma unroll
    for (int i = 0; i < 2; ++i) { int R, C; stage_rc(tid * 16 + i * 8192, R, C); const int Rb = Epi::PERM ? ((R & ~31) + perm32(R & 31)) : R;
        Rr[i] = R; Cc[i] = C; voffB[i] = (unsigned)(Rb * K + C) * 2u; }
    const size_t kstep = (size_t)(BK * 2);
    const size_t hstep = (size_t)HALF * K * 2;
    const unsigned ldsw = (unsigned)wid * 1024u;
    const int aoff = lds_byte(wr * 64 + fr, fq * 8), boff = lds_byte(wc * 32 + fr, fq * 8);
#define PG8_SA(b, h) (((b) * 2 + (h)) * HTB)
#define PG8_SB(b, h) ((4 + (b) * 2 + (h)) * HTB)
#define PG8_STAGE(bufoff, gbase, voff) do { _Pragma("unroll") for (int _i = 0; _i < 2; ++_i) \
        __builtin_amdgcn_global_load_lds((const unsigned*)((const char*)(gbase) + (voff)[_i]), (LAS unsigned*)(lds + (bufoff) + ldsw + _i * 8192), 16, 0, 0); } while (0)
#define PG8_LDA(dst, b, h) do { _Pragma("unroll") for (int m = 0; m < 4; ++m) _Pragma("unroll") for (int k = 0; k < 2; ++k) dst[m][k] = *(const LAS bf16x8*)(lds + PG8_SA(b, h) + aoff + m * 2048 + k * 1024); } while (0)
#define PG8_LDB(dst, b, h) do { _Pragma("unroll") for (int n = 0; n < 2; ++n) _Pragma("unroll") for (int k = 0; k < 2; ++k) dst[n][k] = *(const LAS bf16x8*)(lds + PG8_SB(b, h) + boff + n * 2048 + k * 1024); } while (0)
#define PG8_MMA(ai, bj, At, Bt) do { __builtin_amdgcn_s_setprio(1); _Pragma("unroll") for (int m = 0; m < 4; ++m) _Pragma("unroll") for (int n = 0; n < 2; ++n) _Pragma("unroll") for (int k = 0; k < 2; ++k) \
        acc[ai][bj][m][n] = __builtin_amdgcn_mfma_f32_16x16x32_bf16(Bt[n][k], At[m][k], acc[ai][bj][m][n], 0, 0, 0); __builtin_amdgcn_s_setprio(0); } while (0)
#define PG8_WAIT_V(n) asm volatile("s_waitcnt vmcnt(" #n ")" ::: "memory")
#define PG8_WAIT_L(n) asm volatile("s_waitcnt lgkmcnt(" #n ")" ::: "memory")
#define PG8_BAR __builtin_amdgcn_s_barrier()
#define PG8_SCHED __builtin_amdgcn_sched_barrier(0)
#define PG8_AOFF(dst, u) do { _Pragma("unroll") for (int _h = 0; _h < 2; ++_h) _Pragma("unroll") for (int _i = 0; _i < 2; ++_i) \
        dst[_h][_i] = (S.a_row(u, _h * HALF + Rr[_i]) * (unsigned)K + (unsigned)Cc[_i]) * 2u; } while (0)
    Unit cur, nxt; int ui = 0;
    if (!S.next(0, cur)) return;
    f32x4 acc[2][2][4][2];
#pragma unroll
    for (int a = 0; a < 2; ++a)
#pragma unroll
        for (int b = 0; b < 2; ++b)
#pragma unroll
            for (int m = 0; m < 4; ++m)
#pragma unroll
                for (int n = 0; n < 2; ++n) acc[a][b][m][n] = (f32x4){0.f, 0.f, 0.f, 0.f};
    bf16x8 At[4][2], B0[2][2], B1[2][2];
    unsigned co[2][2], no[2][2];
    PG8_AOFF(co, cur);
    const char* cB = Bbase + cur.bofs;
    if constexpr (SP2) {
        PG8_STAGE(PG8_SB(0, 0), cB, voffB); PG8_STAGE(PG8_SB(0, 1), cB + hstep, voffB); PG8_STAGE(PG8_SA(0, 0), Abase, co[0]); PG8_STAGE(PG8_SA(0, 1), Abase, co[1]);
        if (wr == 1) PG8_BAR;
        PG8_WAIT_V(2); PG8_BAR;
        PG8_STAGE(PG8_SB(1, 0), cB + kstep, voffB); PG8_STAGE(PG8_SA(1, 0), Abase + kstep, co[0]); PG8_STAGE(PG8_SB(1, 1), cB + hstep + kstep, voffB);
        PG8_WAIT_V(6); PG8_BAR;
    } else {
        PG8_STAGE(PG8_SB(0, 0), cB, voffB); PG8_STAGE(PG8_SA(0, 0), Abase, co[0]); PG8_STAGE(PG8_SB(0, 1), cB + hstep, voffB); PG8_STAGE(PG8_SA(0, 1), Abase, co[1]);
        if (wr == 1) PG8_BAR;
        PG8_WAIT_V(4); PG8_BAR;
        PG8_STAGE(PG8_SB(1, 0), cB + kstep, voffB); PG8_STAGE(PG8_SA(1, 0), Abase + kstep, co[0]); PG8_STAGE(PG8_SB(1, 1), cB + hstep + kstep, voffB);
        PG8_WAIT_V(6); PG8_BAR;
    }
    for (;;) {
        const bool has_next = S.next(ui + 1, nxt);
        const char* nB = has_next ? Bbase + nxt.bofs : cB;
        if (has_next) { PG8_AOFF(no, nxt); } else {
#pragma unroll
            for (int h = 0; h < 2; ++h)
#pragma unroll
                for (int i = 0; i < 2; ++i) no[h][i] = co[h][i]; }
        for (int t = 0; t < nt; t += 2) {
            const bool last = (t == nt - 2);
            const char* a1 = Abase + (size_t)(t + 1) * kstep;
            const char* a2 = last ? Abase : Abase + (size_t)(t + 2) * kstep; const char* b2 = last ? nB : cB + (size_t)(t + 2) * kstep;
            const char* a3 = a2 + kstep; const char* b3 = b2 + kstep;
            unsigned o2[2][2];
#pragma unroll
            for (int h = 0; h < 2; ++h)
#pragma unroll
                for (int i = 0; i < 2; ++i) o2[h][i] = last ? no[h][i] : co[h][i];
            if constexpr (SP2) {
            PG8_LDB(B0, 0, 0); PG8_LDB(B1, 0, 1); PG8_SCHED; PG8_LDA(At, 0, 0); PG8_STAGE(PG8_SA(1, 1), a1, co[1]);
            PG8_WAIT_V(8); PG8_WAIT_L(0); PG8_BAR; PG8_MMA(0, 0, At, B0); PG8_MMA(0, 1, At, B1); PG8_BAR; PG8_SCHED;
            PG8_LDA(At, 0, 1); PG8_STAGE(PG8_SB(0, 0), b2, voffB); PG8_STAGE(PG8_SB(0, 1), b2 + hstep, voffB); PG8_STAGE(PG8_SA(0, 0), a2, o2[0]);
            PG8_WAIT_V(8); PG8_WAIT_L(0); PG8_BAR; PG8_MMA(1, 0, At, B0); PG8_MMA(1, 1, At, B1); PG8_BAR; PG8_SCHED;
            PG8_LDB(B0, 1, 0); PG8_LDB(B1, 1, 1); PG8_SCHED; PG8_LDA(At, 1, 0); PG8_STAGE(PG8_SA(0, 1), a2, o2[1]);
            PG8_WAIT_V(8); PG8_WAIT_L(0); PG8_BAR; PG8_MMA(0, 0, At, B0); PG8_MMA(0, 1, At, B1); PG8_BAR; PG8_SCHED;
            PG8_LDA(At, 1, 1); PG8_STAGE(PG8_SB(1, 0), b3, voffB); PG8_STAGE(PG8_SB(1, 1), b3 + hstep, voffB); PG8_STAGE(PG8_SA(1, 0), a3, o2[0]);
            PG8_WAIT_V(8); PG8_WAIT_L(0); PG8_BAR; PG8_MMA(1, 0, At, B0); PG8_MMA(1, 1, At, B1); PG8_BAR; PG8_SCHED;
            } else {
            PG8_LDB(B0, 0, 0); PG8_SCHED; PG8_LDA(At, 0, 0); PG8_STAGE(PG8_SA(1, 1), a1, co[1]);
            PG8_WAIT_L(8); PG8_BAR; PG8_WAIT_L(0); PG8_MMA(0, 0, At, B0); PG8_BAR; PG8_SCHED;
            PG8_LDB(B1, 0, 1); PG8_STAGE(PG8_SB(0, 0), b2, voffB);
            PG8_BAR; PG8_WAIT_L(0); PG8_MMA(0, 1, At, B1); PG8_BAR;
            PG8_LDA(At, 0, 1); PG8_STAGE(PG8_SA(0, 0), a2, o2[0]);
            PG8_BAR; PG8_WAIT_L(0); PG8_MMA(1, 0, At, B0); PG8_BAR; PG8_SCHED;
            PG8_STAGE(PG8_SB(0, 1), b2 + hstep, voffB);
            PG8_WAIT_V(6); PG8_BAR; PG8_MMA(1, 1, At, B1); PG8_BAR;
            PG8_LDB(B0, 1, 0); PG8_SCHED; PG8_LDA(At, 1, 0); PG8_STAGE(PG8_SA(0, 1), a2, o2[1]);
            PG8_WAIT_L(8); PG8_BAR; PG8_WAIT_L(0); PG8_MMA(0, 0, At, B0); PG8_BAR; PG8_SCHED;
            PG8_LDB(B1, 1, 1); PG8_STAGE(PG8_SB(1, 0), b3, voffB);
            PG8_BAR; PG8_WAIT_L(0); PG8_MMA(0, 1, At, B1); PG8_BAR;
            PG8_LDA(At, 1, 1); PG8_STAGE(PG8_SA(1, 0), a3, o2[0]);
            PG8_BAR; PG8_WAIT_L(0); PG8_MMA(1, 0, At, B0); PG8_BAR; PG8_SCHED;
            PG8_STAGE(PG8_SB(1, 1), b3 + hstep, voffB);
            PG8_WAIT_V(6); PG8_BAR; PG8_MMA(1, 1, At, B1); PG8_BAR;
            }
        }
        if constexpr (ALIGN_EPI) { if (wr == 0) PG8_BAR; }
        E(acc, cur, wr, wc, fr, fq);
        if (!has_next) break;
#pragma unroll
        for (int a = 0; a < 2; ++a)
#pragma unroll
            for (int b = 0; b < 2; ++b)
#pragma unroll
                for (int m = 0; m < 4; ++m)
#pragma unroll
                    for (int n = 0; n < 2; ++n) acc[a][b][m][n] = (f32x4){0.f, 0.f, 0.f, 0.f};
        cur = nxt; cB = nB; ++ui;
#pragma unroll
        for (int h = 0; h < 2; ++h)
#pragma unroll
            for (int i = 0; i < 2; ++i) co[h][i] = no[h][i];
        if constexpr (ALIGN_EPI) { if (wr == 1) PG8_BAR; }
    }
    PG8_WAIT_V(0);
    if constexpr (!ALIGN_EPI) { if (wr == 0) PG8_BAR; }
    PG8_BAR;
#undef PG8_SA
#undef PG8_SB
#undef PG8_STAGE
#undef PG8_LDA
#undef PG8_LDB
#undef PG8_MMA
#undef PG8_WAIT_V
#undef PG8_WAIT_L
#undef PG8_BAR
#undef PG8_SCHED
#undef PG8_AOFF
}

struct EpiInProj {
    static constexpr bool PERM = true;
    bf16_t* P; const float* ropeC; const float* ropeS;
    __device__ __forceinline__ void operator()(const f32x4 (&acc)[2][2][4][2], const Unit& u, int wr, int wc, int fr, int fq) const {
        const int row0 = u.pm * BM + wr * 64 + fr, col0 = u.pn * BM + wc * 32 + 8 * fq;
        const bool qk = u.pn < 4, rope = qk && (u.pm < NLAT / BM);
        const float ks = (u.pn >= 2 && u.pn < 4) ? 0.08838834764831845f : 1.0f;
        const int sec = wc >> 1, i0 = (wc & 1) * 16 + 4 * fq;
#pragma unroll
        for (int ai = 0; ai < 2; ++ai)
#pragma unroll
            for (int m = 0; m < 4; ++m) {
                const int row = row0 + ai * HALF + m * 16;
                f32x4 c4 = (f32x4){1.f, 1.f, 1.f, 1.f}, s4 = (f32x4){0.f, 0.f, 0.f, 0.f};
                if (rope) { const int t = row & (TL - 1), pos = sec ? (t & 63) : (t >> 6); const int ti = (sec ? 1024 : 0) + pos * 32 + i0;
                    c4 = *(const f32x4*)(ropeC + ti); s4 = *(const f32x4*)(ropeS + ti); }
                bf16_t* rowp = P + (size_t)row * NP + col0;
#pragma unroll
                for (int bj = 0; bj < 2; ++bj) {
                    f32x4 v0 = acc[ai][bj][m][0], v1 = acc[ai][bj][m][1];
                    if (qk) {
                        const float a0 = v0[0] * c4[0] - v0[1] * s4[0], b0 = v0[0] * s4[0] + v0[1] * c4[0];
                        const float a1 = v0[2] * c4[1] - v0[3] * s4[1], b1 = v0[2] * s4[1] + v0[3] * c4[1];
                        const float a2 = v1[0] * c4[2] - v1[1] * s4[2], b2 = v1[0] * s4[2] + v1[1] * c4[2];
                        const float a3 = v1[2] * c4[3] - v1[3] * s4[3], b3 = v1[2] * s4[3] + v1[3] * c4[3];
                        v0 = (f32x4){a0 * ks, b0 * ks, a1 * ks, b1 * ks}; v1 = (f32x4){a2 * ks, b2 * ks, a3 * ks, b3 * ks};
                    }
                    u32x4 w; w.x = cvt_pk_bf16(v0[0], v0[1]); w.y = cvt_pk_bf16(v0[2], v0[3]); w.z = cvt_pk_bf16(v1[0], v1[1]); w.w = cvt_pk_bf16(v1[2], v1[3]);
                    *(u32x4*)(rowp + bj * HALF) = w;
                }
            }
    }
};
struct EpiResid {
    static constexpr bool PERM = false;
    const float* rl; const float* rc; float* ol; float* oc; const float* gmod;
    __device__ __forceinline__ void operator()(const f32x4 (&acc)[2][2][4][2], const Unit& u, int wr, int wc, int fr, int fq) const {
        const int row0 = u.pm * BM + wr * 64 + fr, col0 = u.pn * BM + wc * 32 + 4 * fq;
        const bool lat = u.pm < NLAT / BM; const int b = lat ? (u.pm >> 3) : 16;
        const float* rbase = lat ? rl : rc - (size_t)NLAT * D; float* obase = lat ? ol : oc - (size_t)NLAT * D;
        f32x4 gv[2][2];
#pragma unroll
        for (int bj = 0; bj < 2; ++bj)
#pragma unroll
            for (int n = 0; n < 2; ++n) gv[bj][n] = *(const f32x4*)(gmod + (size_t)b * 6 * D + col0 + bj * HALF + n * 16);
#pragma unroll
        for (int ai = 0; ai < 2; ++ai)
#pragma unroll
            for (int m = 0; m < 4; ++m) { const size_t off = (size_t)(row0 + ai * HALF + m * 16) * D + col0;
#pragma unroll
                for (int bj = 0; bj < 2; ++bj)
#pragma unroll
                    for (int n = 0; n < 2; ++n) { const f32x4 r = *(const f32x4*)(rbase + off + bj * HALF + n * 16);
                        *(f32x4*)(obase + off + bj * HALF + n * 16) = r + gv[bj][n] * acc[ai][bj][m][n]; } }
    }
};
struct EpiSwiGLU {
    static constexpr bool PERM = true;
    bf16_t* O;
    __device__ __forceinline__ void operator()(const f32x4 (&acc)[2][2][4][2], const Unit& u, int wr, int wc, int fr, int fq) const {
        const int row0 = u.pm * BM + wr * 64 + fr, col0 = u.pn * 128 + wc * 16 + 4 * fq;
#pragma unroll
        for (int ai = 0; ai < 2; ++ai)
#pragma unroll
            for (int m = 0; m < 4; ++m) { bf16_t* rowp = O + (size_t)(row0 + ai * HALF + m * 16) * FF + col0;
#pragma unroll
                for (int bj = 0; bj < 2; ++bj) { const f32x4 g = acc[ai][bj][m][0], up = acc[ai][bj][m][1];
                    u32x2 w; w.x = cvt_pk_bf16(silu_f(g[0]) * up[0], silu_f(g[1]) * up[1]); w.y = cvt_pk_bf16(silu_f(g[2]) * up[2], silu_f(g[3]) * up[3]);
                    *(u32x2*)(rowp + bj * 64) = w; } }
    }
};
struct EpiBf16 {
    static constexpr bool PERM = true;
    bf16_t* O; int ldc;
    __device__ __forceinline__ void operator()(const f32x4 (&acc)[2][2][4][2], const Unit& u, int wr, int wc, int fr, int fq) const {
        const int row0 = u.pm * BM + wr * 64 + fr, col0 = u.pn * BM + wc * 32 + 8 * fq;
#pragma unroll
        for (int ai = 0; ai < 2; ++ai)
#pragma unroll
            for (int m = 0; m < 4; ++m) { bf16_t* rowp = O + (size_t)(row0 + ai * HALF + m * 16) * ldc + col0;
#pragma unroll
                for (int bj = 0; bj < 2; ++bj) { const f32x4 v0 = acc[ai][bj][m][0], v1 = acc[ai][bj][m][1];
                    u32x4 w; w.x = cvt_pk_bf16(v0[0], v0[1]); w.y = cvt_pk_bf16(v0[2], v0[3]); w.z = cvt_pk_bf16(v1[0], v1[1]); w.w = cvt_pk_bf16(v1[2], v1[3]);
                    *(u32x4*)(rowp + bj * HALF) = w; } }
    }
};
}

struct Args { const float* in[22]; float* out; unsigned char* ws; int ph_lo, ph_hi; };
enum { I_X = 0, I_C, I_CTX, I_CCTX, I_ADAW, I_ADAB, I_N1G, I_WIN, I_DF, I_DB, I_POOLW, I_POOLS, I_WOUT, I_N2G, I_RGW, I_RGB, I_REW, I_REB, I_WG, I_WU, I_WDN, I_FNG };

struct Frame {
    LAS unsigned char* lds; int tid, lane, wave, G, bx, vcu;
    const float* const* in; float* out; unsigned char* ws;
};
__device__ __forceinline__ float* xa_row(const Frame& F, int row) { return row < NLAT ? F.out + (size_t)row * D : (float*)(F.ws + WS_XC) + (size_t)(row - NLAT) * D; }
__device__ __forceinline__ const float* mod_ptr(const Frame& F, int l, int b, int which) { return (const float*)(F.ws + WS_MOD) + ((size_t)(l * 17 + b) * 6 + which) * D; }

__device__ __forceinline__ void tr_item(const float* colp, size_t ldw, int k0, bf16_t* WT, int K, int n0, LAS float* scr, int lane) {
#pragma unroll 8
    for (int i = 0; i < 32; ++i) { const int kk = 2 * i + (lane >> 5); scr[kk * 33 + (lane & 31)] = colp[(size_t)(k0 + kk) * ldw]; }
    asm volatile("s_waitcnt lgkmcnt(0)" ::: "memory");
    const int c = lane & 7;
#pragma unroll
    for (int j = 0; j < 4; ++j) { const int n = (lane >> 3) + 8 * j; const LAS float* s = scr + (8 * c) * 33 + n;
        u32x4 o; o.x = pk2(s[0 * 33], s[1 * 33]); o.y = pk2(s[2 * 33], s[3 * 33]); o.z = pk2(s[4 * 33], s[5 * 33]); o.w = pk2(s[6 * 33], s[7 * 33]);
        *(u32x4*)(WT + (size_t)(n0 + n) * K + k0 + 8 * c) = o; }
    asm volatile("s_waitcnt lgkmcnt(0)" ::: "memory");
}
__device__ __forceinline__ void fold_item(const float* win, const float* pw, const float* ps, int k0, bf16_t* WT, int n0, LAS float* scr, int lane) {
    const int n = n0 + (lane & 31), g = n >> 7, nn = n & 127;
    const float* pwc = pw + (size_t)g * 128 * 128 + nn; const float sc = ps[n];
    for (int i = 0; i < 32; ++i) { const int kk = 2 * i + (lane >> 5); const float* wr = win + (size_t)(k0 + kk) * NP + 2048 + g * 128;
        float s = 0.f;
#pragma unroll 8
        for (int c = 0; c < 128; ++c) s += wr[c] * pwc[(size_t)c * 128];
        scr[kk * 33 + (lane & 31)] = s * sc; }
    asm volatile("s_waitcnt lgkmcnt(0)" ::: "memory");
    const int c = lane & 7;
#pragma unroll
    for (int j = 0; j < 4; ++j) { const int nl = (lane >> 3) + 8 * j; const LAS float* s = scr + (8 * c) * 33 + nl;
        u32x4 o; o.x = pk2(s[0 * 33], s[1 * 33]); o.y = pk2(s[2 * 33], s[3 * 33]); o.z = pk2(s[4 * 33], s[5 * 33]); o.w = pk2(s[6 * 33], s[7 * 33]);
        *(u32x4*)(WT + (size_t)(2048 + n0 + nl) * D + k0 + 8 * c) = o; }
    asm volatile("s_waitcnt lgkmcnt(0)" ::: "memory");
}
__device__ __forceinline__ void p0_prologue(const Frame& F) {
    for (int task = F.bx; task < 2 * 96; task += F.G) {
        const int l = task / 96, cg = task % 96;
        LAS float* sc = (LAS float*)F.lds;
        LAS float* part = (LAS float*)(F.lds + 17 * 1024 * 4);
        for (int i = F.tid; i < 17 * 1024; i += 512) { const int b = i >> 10, k = i & 1023; const float v = b < 16 ? F.in[I_C][b * D + k] : F.in[I_CCTX][k]; sc[i] = silu_f(v); }
        __syncthreads();
        float acc[17];
#pragma unroll
        for (int b = 0; b < 17; ++b) acc[b] = 0.f;
        const float* aw = F.in[I_ADAW] + (size_t)l * D * 6 * D + cg * 64 + F.lane;
        for (int k = F.wave * 128; k < F.wave * 128 + 128; ++k) { const float w = aw[(size_t)k * 6 * D];
#pragma unroll
            for (int b = 0; b < 17; ++b) acc[b] += sc[b * 1024 + k] * w; }
#pragma unroll
        for (int b = 0; b < 17; ++b) part[(F.wave * 17 + b) * 64 + F.lane] = acc[b];
        __syncthreads();
        for (int i = F.tid; i < 17 * 64; i += 512) { const int b = i >> 6, n = i & 63; float s = F.in[I_ADAB][l * 6 * D + cg * 64 + n];
#pragma unroll
            for (int w = 0; w < 8; ++w) s += part[(w * 17 + b) * 64 + n];
            const int col = cg * 64 + n; ((float*)(F.ws + WS_MOD))[((size_t)(l * 17 + b) * 6 + (col >> 10)) * D + (col & 1023)] = s; }
        __syncthreads();
    }
    if (F.bx == F.G - 1) {
        float* rc = (float*)(F.ws + WS_ROPE); float* rs = rc + 96 * 32;
        for (int i = F.tid; i < 96 * 32; i += 512) { const int p = i >> 5, f = i & 31; const int pos = p < 32 ? p : p - 32;
            const float inv = powf(10000.0f, -(float)f / 32.0f); const float ang = (float)pos * inv; rc[i] = cosf(ang); rs[i] = sinf(ang); }
    }
    LAS float* scr = (LAS float*)(F.lds + F.wave * 8448);
    const int gw = F.vcu * 8 + F.wave, NGW = F.G * 8;
    constexpr int IT_WIN = 16 * 80, IT_WOUT = 16 * 32, IT_GU = 16 * 32, IT_DN = 8 * 32;
    constexpr int N_WIN = DEPTH * IT_WIN, N_WOUT = DEPTH * IT_WOUT, N_GU = DEPTH * NE * IT_GU, N_DN = DEPTH * NE * IT_DN;
    for (int it = gw; it < N_WIN + N_WOUT + N_GU + N_DN; it += NGW) {
        int r = it;
        if (r < N_WIN) { const int l = r / IT_WIN; r %= IT_WIN; const int kb = r / 80, nb = r % 80, n0 = nb * 32;
            const float* win = F.in[I_WIN] + (size_t)l * D * NP; bf16_t* WT = (bf16_t*)(F.ws + WS_WIN) + (size_t)l * NP * D;
            if (n0 >= 2048) { fold_item(win, F.in[I_POOLW] + (size_t)l * 4 * 128 * 128, F.in[I_POOLS] + l * 512, kb * 64, WT, n0 - 2048, scr, F.lane); continue; }
            const int n = n0 + (F.lane & 31); int src = n;
            if (n < 1024) { const int hh = n >> 7, j = n & 127, sec = j >> 6, jj = j & 63; src = (n & 512) + (hh & 3) * 128 + sec * 64 + (jj & 1) * 32 + (jj >> 1); }
            tr_item(win + src, NP, kb * 64, WT, D, n0, scr, F.lane); continue; }
        r -= N_WIN;
        if (r < N_WOUT) { const int l = r / IT_WOUT; r %= IT_WOUT; const int kb = r / 32, nb = r % 32, n0 = nb * 32;
            tr_item(F.in[I_WOUT] + (size_t)l * D * D + n0 + (F.lane & 31), D, kb * 64, (bf16_t*)(F.ws + WS_WOUT) + (size_t)l * D * D, D, n0, scr, F.lane); continue; }
        r -= N_WOUT;
        if (r < N_GU) { const int le = r / IT_GU; r %= IT_GU; const int kb = r / 32, nb = r % 32, n0 = nb * 32;
            const int n = n0 + (F.lane & 31), col = (n >> 3) * 4 + (n & 3); const float* src = ((n & 4) ? F.in[I_WU] : F.in[I_WG]) + (size_t)le * D * FF + col;
            tr_item(src, FF, kb * 64, (bf16_t*)(F.ws + WS_WGU) + (size_t)le * 1024 * D, D, n0, scr, F.lane); continue; }
        r -= N_GU;
        { const int le = r / IT_DN; r %= IT_DN; const int kb = r / 32, nb = r % 32, n0 = nb * 32;
            tr_item(F.in[I_WDN] + (size_t)le * FF * D + n0 + (F.lane & 31), D, kb * 64, (bf16_t*)(F.ws + WS_WD) + (size_t)le * D * FF, FF, n0, scr, F.lane); }
    }
}

__device__ __forceinline__ LAS int* build_tb(const Frame& F, int l) {
    LAS int* tb = (LAS int*)(F.lds + MISC_OFF + 64);
    if (F.tid == 0) { const unsigned* cnt = (const unsigned*)(F.ws + WS_CTL) + CW_CNT + l * NE * 16; int s = 0;
        for (int e = 0; e < NE; ++e) { tb[e] = s; const int c = (int)__hip_atomic_load(cnt + e * 16, __ATOMIC_RELAXED, __HIP_MEMORY_SCOPE_AGENT); tb[64 + e] = c; s += (c + 255) >> 8; }
        tb[NE] = s; }
    __syncthreads();
    return tb;
}

__device__ __forceinline__ void row_op_a(const Frame& F, int mode) {
    const int gw = F.vcu * 8 + F.wave, NGW = F.G * 8;
    const int nrows = (mode == 2) ? NLAT : NTOK; const int l = (mode == 0) ? 0 : 1, lp = mode - 1;
    const LAS int* tb = nullptr; if (mode != 0) tb = build_tb(F, lp);
    const bf16_t* YB = (const bf16_t*)(F.ws + WS_P); bf16_t* H = (bf16_t*)(F.ws + WS_H);
    const float* gain = (mode == 2) ? F.in[I_FNG] : F.in[I_N1G] + l * D;
    for (int row = gw; row < nrows; row += NGW) {
        const int b = row < NLAT ? (row >> 11) : 16;
        f32x4 v[4];
        if (mode == 0) { const f32x4* src = (const f32x4*)(row < NLAT ? F.in[I_X] + (size_t)row * D : F.in[I_CTX] + (size_t)(row - NLAT) * D) + F.lane;
#pragma unroll
            for (int j = 0; j < 4; ++j) v[j] = src[64 * j];
        } else {
            const int4 ti = *(const int4*)(F.ws + WS_TOKINFO + (size_t)row * 32); const f32x2 tw = *(const f32x2*)(F.ws + WS_TOKINFO + (size_t)row * 32 + 16);
            const size_t s1 = (size_t)(tb[ti.x] * 256 + ti.y), s2 = (size_t)(tb[ti.z] * 256 + ti.w);
            float* xr = xa_row(F, row); const f32x4* g2 = (const f32x4*)mod_ptr(F, lp, b, 5) + F.lane;
            const u32x2* y1 = (const u32x2*)(YB + s1 * D) + F.lane; const u32x2* y2 = (const u32x2*)(YB + s2 * D) + F.lane;
#pragma unroll
            for (int j = 0; j < 4; ++j) { const f32x4 x = ((const f32x4*)xr)[F.lane + 64 * j]; const u32x2 a = y1[64 * j], c = y2[64 * j]; const f32x4 g = g2[64 * j];
                f32x4 y; y[0] = tw.x * bflo(a.x) + tw.y * bflo(c.x); y[1] = tw.x * bfhi(a.x) + tw.y * bfhi(c.x); y[2] = tw.x * bflo(a.y) + tw.y * bflo(c.y); y[3] = tw.x * bfhi(a.y) + tw.y * bfhi(c.y);
                v[j] = x + g * y; if (mode == 1) ((f32x4*)xr)[F.lane + 64 * j] = v[j]; }
        }
        float ss = 0.f;
#pragma unroll
        for (int j = 0; j < 4; ++j) ss += (v[j][0] * v[j][0] + v[j][1] * v[j][1]) + (v[j][2] * v[j][2] + v[j][3] * v[j][3]);
        const float rstd = 1.0f / sqrtf(wave_sum(ss) * (1.0f / D) + EPS);
        if (mode == 2) {
#pragma unroll
            for (int j = 0; j < 4; ++j) { const f32x4 g = ((const f32x4*)gain)[F.lane + 64 * j]; ((f32x4*)(F.out + (size_t)row * D))[F.lane + 64 * j] = v[j] * rstd * g; }
        } else {
            const f32x4* sh = (const f32x4*)mod_ptr(F, l, b, 0) + F.lane; const f32x4* sc = (const f32x4*)mod_ptr(F, l, b, 1) + F.lane;
            u32x2* o = (u32x2*)(H + (size_t)row * D) + F.lane;
#pragma unroll
            for (int j = 0; j < 4; ++j) { const f32x4 g = ((const f32x4*)gain)[F.lane + 64 * j]; const f32x4 h = v[j] * rstd * g * (sc[64 * j] + 1.0f) + sh[64 * j];
                u32x2 w; w.x = pk2(h[0], h[1]); w.y = pk2(h[2], h[3]); o[64 * j] = w; }
        }
    }
}

__device__ __forceinline__ void row_op_b(const Frame& F, int l) {
    const int gw = F.vcu * 8 + F.wave, NGW = F.G * 8;
    const int nrows = (l == 0) ? NTOK : NLAT;
    LAS float* wr = (LAS float*)F.lds;
    { const float* rg = F.in[I_RGW] + (size_t)l * D * 4; const float* re = F.in[I_REW] + (size_t)l * D * NE;
      for (int i = F.tid; i < 1024 * 36; i += 512) { const int k = i / 36, n = i % 36; const int ln = (k & 255) >> 2, j = k >> 8, c = k & 3;
          wr[(((j * 4 + c) * 64) + ln) * 36 + n] = n < 4 ? rg[k * 4 + n] : re[k * NE + (n - 4)]; } }
    __syncthreads();
    bf16_t* H = (bf16_t*)(F.ws + WS_H);
    const float* gain = F.in[I_N2G] + l * D;
    unsigned* cnt = (unsigned*)(F.ws + WS_CTL) + CW_CNT + l * NE * 16;
    int* list = (int*)(F.ws + WS_LIST);
    for (int row = gw; row < nrows; row += NGW) {
        const int b = row < NLAT ? (row >> 11) : 16;
        const float* xr = xa_row(F, row);
        f32x4 v[4]; float ss = 0.f;
#pragma unroll
        for (int j = 0; j < 4; ++j) { v[j] = ((const f32x4*)xr)[F.lane + 64 * j]; ss += (v[j][0] * v[j][0] + v[j][1] * v[j][1]) + (v[j][2] * v[j][2] + v[j][3] * v[j][3]); }
        const float rstd = 1.0f / sqrtf(wave_sum(ss) * (1.0f / D) + EPS);
        const f32x4* sh = (const f32x4*)mod_ptr(F, l, b, 3) + F.lane; const f32x4* sc = (const f32x4*)mod_ptr(F, l, b, 4) + F.lane;
        u32x2* o = (u32x2*)(H + (size_t)row * D) + F.lane;
        float s[36];
#pragma unroll
        for (int n = 0; n < 36; ++n) s[n] = 0.f;
#pragma unroll
        for (int j = 0; j < 4; ++j) { const f32x4 g = ((const f32x4*)gain)[F.lane + 64 * j]; const f32x4 h = v[j] * rstd * g * (sc[64 * j] + 1.0f) + sh[64 * j];
            u32x2 w; w.x = pk2(h[0], h[1]); w.y = pk2(h[2], h[3]); o[64 * j] = w;
#pragma unroll
            for (int c = 0; c < 4; ++c) { asm volatile("" ::: "memory"); const LAS f32x4* wp = (const LAS f32x4*)(wr + (((j * 4 + c) * 64) + F.lane) * 36);
#pragma unroll
                for (int q = 0; q < 9; ++q) { const f32x4 w4 = wp[q]; s[4 * q] += h[c] * w4[0]; s[4 * q + 1] += h[c] * w4[1]; s[4 * q + 2] += h[c] * w4[2]; s[4 * q + 3] += h[c] * w4[3]; } } }
#pragma unroll
        for (int n = 0; n < 36; ++n) s[n] = wave_sum(s[n]);
        const float* rgb = F.in[I_RGB] + l * 4; const float* reb = F.in[I_REB] + l * NE;
        float gl[4];
#pragma unroll
        for (int i = 0; i < 4; ++i) gl[i] = s[i] + rgb[i];
        int gt = 0; float gm = gl[0];
#pragma unroll
        for (int i = 1; i < 4; ++i) if (gl[i] > gm) { gm = gl[i]; gt = i; }
        float gs = 0.f;
#pragma unroll
        for (int i = 0; i < 4; ++i) gs += expf(gl[i] - gm);
        const float gwt = 1.0f / gs;
        float el[8];
#pragma unroll
        for (int j = 0; j < 8; ++j) { const float a = gt == 0 ? s[4 + j] : gt == 1 ? s[12 + j] : gt == 2 ? s[20 + j] : s[28 + j]; el[j] = a + reb[gt * 8 + j]; }
        int i1 = 0; float v1 = el[0];
#pragma unroll
        for (int j = 1; j < 8; ++j) if (el[j] > v1) { v1 = el[j]; i1 = j; }
        int i2 = -1; float v2 = -3.0e38f;
#pragma unroll
        for (int j = 0; j < 8; ++j) if (j != i1 && el[j] > v2) { v2 = el[j]; i2 = j; }
        const float e2 = expf(v2 - v1); const float w1 = gwt / (1.0f + e2), w2 = gwt * e2 / (1.0f + e2);
        if (F.lane == 0) {
            const int x1 = gt * 8 + i1, x2 = gt * 8 + i2;
            const int r1 = (int)__hip_atomic_fetch_add(cnt + x1 * 16, 1u, __ATOMIC_RELAXED, __HIP_MEMORY_SCOPE_AGENT);
            const int r2 = (int)__hip_atomic_fetch_add(cnt + x2 * 16, 1u, __ATOMIC_RELAXED, __HIP_MEMORY_SCOPE_AGENT);
            list[(size_t)x1 * NTOK + r1] = row; list[(size_t)x2 * NTOK + r2] = row;
            *(int4*)(F.ws + WS_TOKINFO + (size_t)row * 32) = make_int4(x1, r1, x2, r2); *(f32x2*)(F.ws + WS_TOKINFO + (size_t)row * 32 + 16) = (f32x2){w1, w2};
        }
    }
    __syncthreads();
}

__device__ __forceinline__ unsigned off_b(unsigned row, unsigned ch) { return 256u * row + 16u * (ch ^ (((row & 3) << 2) | ((row >> 2) & 3))); }
__device__ __forceinline__ unsigned tr_base(unsigned lane, unsigned t) { const unsigned g = lane >> 4, q = (lane & 15) >> 2, p = lane & 3; return off_b(8 * g + 4 * t + q, (p >> 1)) + 8 * (p & 1); }
template <int O0, int O1, int O2, int O3>
__device__ __forceinline__ void tr_frag4(bf16x8 (&f)[4], unsigned a00, unsigned a01, unsigned a10, unsigned a11, unsigned a20, unsigned a21, unsigned a30, unsigned a31) {
    s16x4 l0, h0, l1, h1, l2, h2, l3, h3;
    asm volatile("ds_read_b64_tr_b16 %0, %8 offset:%16\n\tds_read_b64_tr_b16 %1, %9 offset:%16\n\t"
                 "ds_read_b64_tr_b16 %2, %10 offset:%17\n\tds_read_b64_tr_b16 %3, %11 offset:%17\n\t"
                 "ds_read_b64_tr_b16 %4, %12 offset:%18\n\tds_read_b64_tr_b16 %5, %13 offset:%18\n\t"
                 "ds_read_b64_tr_b16 %6, %14 offset:%19\n\tds_read_b64_tr_b16 %7, %15 offset:%19\n\ts_waitcnt lgkmcnt(0)"
                 : "=&v"(l0), "=&v"(h0), "=&v"(l1), "=&v"(h1), "=&v"(l2), "=&v"(h2), "=&v"(l3), "=&v"(h3)
                 : "v"(a00), "v"(a01), "v"(a10), "v"(a11), "v"(a20), "v"(a21), "v"(a30), "v"(a31), "n"(O0), "n"(O1), "n"(O2), "n"(O3) : "memory");
    f[0] = __builtin_shufflevector(l0, h0, 0, 1, 2, 3, 4, 5, 6, 7); f[1] = __builtin_shufflevector(l1, h1, 0, 1, 2, 3, 4, 5, 6, 7);
    f[2] = __builtin_shufflevector(l2, h2, 0, 1, 2, 3, 4, 5, 6, 7); f[3] = __builtin_shufflevector(l3, h3, 0, 1, 2, 3, 4, 5, 6, 7);
}
__device__ __forceinline__ int chunk_row0(int b, int ci) { return ci < 2 ? NLAT + b * CT + ci * 128 : b * TL + (ci - 2) * 128; }
__device__ __forceinline__ float log2_gamma(float decay) { return -log1pf(expf(-decay)) * 1.4426950408889634f; }

__device__ __forceinline__ void p3a_states_pool(const Frame& F, int l) {
    const bf16_t* P = (const bf16_t*)(F.ws + WS_P);
    bf16_t* ST = (bf16_t*)(F.ws + WS_ACT);
    bf16_t* A2 = (bf16_t*)(F.ws + WS_H);
    const int nstate = (F.G > 128) ? 128 : F.G;
    if (F.bx < nstate) {
        for (int unit = F.bx; unit < 128; unit += nstate) {
            const int dir = unit & 1, bh = unit >> 1, b = bh >> 2, h = bh & 3;
            const float lg2 = log2_gamma((dir ? F.in[I_DB] : F.in[I_DF])[l * NH + h]);
            const float gC = exp2f(lg2 * 128.0f);
            f32x4 acc[8];
#pragma unroll
            for (int dt = 0; dt < 8; ++dt) acc[dt] = (f32x4){0.f, 0.f, 0.f, 0.f};
            const unsigned kimg = 0u, vimg = 32768u;
            for (int n = 0; n < NCHUNK; ++n) {
                const int ci = dir ? (n < 2 ? 1 - n : 19 - n) : n;
                { bf16_t* sp = ST + ((size_t)((bh * 2 + dir) * NCHUNK + ci) * 128 + (F.wave * 16 + (F.lane & 15))) * 128 + 4 * (F.lane >> 4);
#pragma unroll
                  for (int dt = 0; dt < 8; ++dt) { u32x2 w; w.x = pk2(acc[dt][0], acc[dt][1]); w.y = pk2(acc[dt][2], acc[dt][3]); *(u32x2*)(sp + dt * 16) = w; } }
                if (n == NCHUNK - 1) break;
                const int row0 = chunk_row0(b, ci);
#pragma unroll
                for (int q = 0; q < 4; ++q) { const int p = F.tid + 512 * q, j = p >> 4, ch = p & 15;
                    const float kd = exp2f(lg2 * (float)(dir ? j : 127 - j));
                    const u32x4 kk = *(const u32x4*)(P + (size_t)(row0 + j) * NP + 512 + h * 128 + ch * 8);
                    const u32x4 vv = *(const u32x4*)(P + (size_t)(row0 + j) * NP + 1024 + h * 128 + ch * 8);
                    u32x4 ks; ks.x = pk2(bflo(kk.x) * kd, bfhi(kk.x) * kd); ks.y = pk2(bflo(kk.y) * kd, bfhi(kk.y) * kd); ks.z = pk2(bflo(kk.z) * kd, bfhi(kk.z) * kd); ks.w = pk2(bflo(kk.w) * kd, bfhi(kk.w) * kd);
                    *(LAS u32x4*)(F.lds + kimg + off_b(j, ch)) = ks; *(LAS u32x4*)(F.lds + vimg + off_b(j, ch)) = vv; }
                __syncthreads();
#pragma unroll
                for (int dt = 0; dt < 8; ++dt) acc[dt] *= gC;
                { const unsigned lb = (unsigned)(size_t)F.lds, t0 = lb + tr_base(F.lane, 0), t1 = lb + tr_base(F.lane, 1);
                  const unsigned v0 = t0 ^ ((unsigned)F.wave << 5), v1 = t1 ^ ((unsigned)F.wave << 5);
                  bf16x8 vb[4]; tr_frag4<32768, 32768 + 8192, 32768 + 16384, 32768 + 24576>(vb, v0, v1, v0, v1, v0, v1, v0, v1);
#define P3A_KS(ks) do { bf16x8 ka[4]; \
                      tr_frag4<(ks) * 8192, (ks) * 8192, (ks) * 8192, (ks) * 8192>(ka, t0, t1, t0 ^ 32u, t1 ^ 32u, t0 ^ 64u, t1 ^ 64u, t0 ^ 96u, t1 ^ 96u); \
                      _Pragma("unroll") for (int d4 = 0; d4 < 4; ++d4) acc[d4] = __builtin_amdgcn_mfma_f32_16x16x32_bf16(ka[d4], vb[ks], acc[d4], 0, 0, 0); \
                      tr_frag4<(ks) * 8192, (ks) * 8192, (ks) * 8192, (ks) * 8192>(ka, t0 ^ 128u, t1 ^ 128u, t0 ^ 160u, t1 ^ 160u, t0 ^ 192u, t1 ^ 192u, t0 ^ 224u, t1 ^ 224u); \
                      _Pragma("unroll") for (int d4 = 0; d4 < 4; ++d4) acc[4 + d4] = __builtin_amdgcn_mfma_f32_16x16x32_bf16(ka[d4], vb[ks], acc[4 + d4], 0, 0, 0); } while (0)
                  P3A_KS(0); P3A_KS(1); P3A_KS(2); P3A_KS(3);
#undef P3A_KS
                }
                __syncthreads();
            }
        }
    } else {
        const int pb = F.bx - nstate, npb = F.G - nstate;
        for (long it = (long)pb * 512 + F.tid; it < (long)NTOK * 64; it += (long)npb * 512) {
            const int row = (int)(it >> 6), cg = (int)(it & 63), g = cg >> 4, half = 1 << g;
            int t, T, base; if (row < NLAT) { t = row & (TL - 1); T = TL; base = row - t; } else { t = (row - NLAT) & (CT - 1); T = CT; base = row - t; }
            const int lo = t - half < 0 ? 0 : t - half, hi = t + half > T ? T : t + half;
            float s[8];
#pragma unroll
            for (int i = 0; i < 8; ++i) s[i] = 0.f;
            for (int tt = lo; tt < hi; ++tt) { const u32x4 x = *(const u32x4*)(P + (size_t)(base + tt) * NP + 2048 + cg * 8);
                s[0] += bflo(x.x); s[1] += bfhi(x.x); s[2] += bflo(x.y); s[3] += bfhi(x.y); s[4] += bflo(x.z); s[5] += bfhi(x.z); s[6] += bflo(x.w); s[7] += bfhi(x.w); }
            const float inv = 1.0f / (float)(hi - lo);
            const u32x4 x = *(const u32x4*)(P + (size_t)row * NP + 2048 + cg * 8);
            u32x4 o; o.x = pk2(s[0] * inv - bflo(x.x), s[1] * inv - bfhi(x.x)); o.y = pk2(s[2] * inv - bflo(x.y), s[3] * inv - bfhi(x.y));
            o.z = pk2(s[4] * inv - bflo(x.z), s[5] * inv - bfhi(x.z)); o.w = pk2(s[6] * inv - bflo(x.w), s[7] * inv - bfhi(x.w));
            *(u32x4*)(A2 + (size_t)row * D + 512 + cg * 8) = o;
        }
    }
}

__device__ __forceinline__ void p3b_retention(const Frame& F, int l) {
    const bf16_t* P = (const bf16_t*)(F.ws + WS_P);
    const bf16_t* ST = (const bf16_t*)(F.ws + WS_ACT);
    bf16_t* A2 = (bf16_t*)(F.ws + WS_H);
    const int c_lo = (l == DEPTH - 1) ? 2 : 0, ncu = NCHUNK - c_lo, nunits = 64 * ncu;
    const unsigned kimg = 0u, pimg = 65536u + (unsigned)F.wave * 4096u;
    const int fr = F.lane & 15, fq = F.lane >> 4;
    for (int unit = F.vcu; unit < nunits; unit += F.G) {
        unsigned rr0 = off_b((unsigned)fr, (unsigned)fq), tq0 = (unsigned)(size_t)F.lds + tr_base(F.lane, 0), tq1 = (unsigned)(size_t)F.lds + tr_base(F.lane, 1);
        asm volatile("" : "+v"(rr0), "+v"(tq0), "+v"(tq1));
        const int bh = unit / ncu, ci = c_lo + unit % ncu, b = bh >> 2, h = bh & 3;
        const float lgf = log2_gamma(F.in[I_DF][l * NH + h]), lgb = log2_gamma(F.in[I_DB][l * NH + h]);
        const int row0 = chunk_row0(b, ci);
        __syncthreads();
#pragma unroll
        for (int q = 0; q < 4; ++q) { const int p = F.tid + 512 * q, j = p >> 4, ch = p & 15;
            const u32x4 kk = *(const u32x4*)(P + (size_t)(row0 + j) * NP + 512 + h * 128 + ch * 8);
            const u32x4 vv = *(const u32x4*)(P + (size_t)(row0 + j) * NP + 1024 + h * 128 + ch * 8);
            *(LAS u32x4*)(F.lds + kimg + off_b(j, ch)) = kk; *(LAS u32x4*)(F.lds + 32768u + off_b(j, ch)) = vv; }
        int il = F.wave * 16 + fr;
        asm volatile("" : "+v"(il));
        bf16x8 qf[4];
#pragma unroll
        for (int ks = 0; ks < 4; ++ks) qf[ks] = *(const bf16x8*)(P + (size_t)(row0 + il) * NP + h * 128 + ks * 32 + fq * 8);
        __syncthreads();
#pragma unroll
        for (int jt = 0; jt < 8; ++jt) {
            asm volatile("" ::: "memory");
            f32x4 sa = (f32x4){0.f, 0.f, 0.f, 0.f};
#pragma unroll
            for (int ks = 0; ks < 4; ++ks) { const bf16x8 ka = *(const LAS bf16x8*)(F.lds + kimg + ((rr0 ^ ((unsigned)ks << 6)) + 4096u * jt)); sa = __builtin_amdgcn_mfma_f32_16x16x32_bf16(ka, qf[ks], sa, 0, 0, 0); }
            float pv[4];
#pragma unroll
            for (int r = 0; r < 4; ++r) { const int j = 16 * jt + 4 * fq + r, df = il - j; const float w = df > 0 ? exp2f(lgf * (float)df) : (df < 0 ? exp2f(lgb * (float)(-df)) : 2.0f); pv[r] = sa[r] * w; }
            u32x2 w; w.x = pk2(pv[0], pv[1]); w.y = pk2(pv[2], pv[3]);
            *(LAS u32x2*)(F.lds + pimg + off_b(fr, 2 * jt + (fq >> 1)) + 8 * (fq & 1)) = w;
        }
        asm volatile("s_waitcnt lgkmcnt(0)" ::: "memory");
        bf16x8 pf[4];
#pragma unroll
        for (int ks = 0; ks < 4; ++ks) pf[ks] = *(const LAS bf16x8*)(F.lds + pimg + (rr0 ^ ((unsigned)ks << 6)));
        const bf16_t* sf = ST + ((size_t)((bh * 2 + 0) * NCHUNK + ci) * 128) * 128; const bf16_t* sb = ST + ((size_t)((bh * 2 + 1) * NCHUNK + ci) * 128) * 128;
        const float qdf = exp2f(lgf * (float)(il + 1)), qdb = exp2f(lgb * (float)(128 - il));
        float o[8][4]; float ss = 0.f;
#pragma unroll
        for (int et = 0; et < 8; ++et) {
            asm volatile("" ::: "memory");
            f32x4 ao = (f32x4){0.f, 0.f, 0.f, 0.f}, af = ao, ab = ao;
            bf16x8 va[4]; { const unsigned a0 = tq0 ^ ((unsigned)et << 5), a1 = tq1 ^ ((unsigned)et << 5);
                tr_frag4<32768, 32768 + 8192, 32768 + 16384, 32768 + 24576>(va, a0, a1, a0, a1, a0, a1, a0, a1); }
#pragma unroll
            for (int ks = 0; ks < 4; ++ks) {
                ao = __builtin_amdgcn_mfma_f32_16x16x32_bf16(va[ks], pf[ks], ao, 0, 0, 0);
                const bf16x8 fa = *(const bf16x8*)(sf + (size_t)(et * 16 + fr) * 128 + ks * 32 + fq * 8);
                af = __builtin_amdgcn_mfma_f32_16x16x32_bf16(fa, qf[ks], af, 0, 0, 0);
                const bf16x8 ba = *(const bf16x8*)(sb + (size_t)(et * 16 + fr) * 128 + ks * 32 + fq * 8);
                ab = __builtin_amdgcn_mfma_f32_16x16x32_bf16(ba, qf[ks], ab, 0, 0, 0);
            }
#pragma unroll
            for (int r = 0; r < 4; ++r) { o[et][r] = ao[r] + qdf * af[r] + qdb * ab[r]; ss += o[et][r] * o[et][r]; }
        }
        ss += __shfl_xor(ss, 16); ss += __shfl_xor(ss, 32);
        const float rstd = 1.0f / sqrtf(ss * (1.0f / 128.0f) + EPS);
        const bf16_t* gp = P + (size_t)(row0 + il) * NP + 1536 + h * 128 + 4 * fq; bf16_t* op = A2 + (size_t)(row0 + il) * D + h * 128 + 4 * fq;
#pragma unroll
        for (int et = 0; et < 8; ++et) { const u32x2 g = *(const u32x2*)(gp + et * 16);
            u32x2 w; w.x = pk2(silu_f(bflo(g.x)) * o[et][0] * rstd, silu_f(bfhi(g.x)) * o[et][1] * rstd); w.y = pk2(silu_f(bflo(g.y)) * o[et][2] * rstd, silu_f(bfhi(g.y)) * o[et][3] * rstd);
            *(u32x2*)(op + et * 16) = w; }
    }
    __syncthreads();
}

__global__ void __launch_bounds__(512, 2) fwd_kernel(Args args) {
    extern __shared__ __attribute__((aligned(16))) unsigned char lds_raw[];
    Frame F;
    F.lds = (LAS unsigned char*)lds_raw; F.tid = threadIdx.x; F.lane = F.tid & 63; F.wave = __builtin_amdgcn_readfirstlane(F.tid >> 6);
    F.G = gridDim.x; F.bx = blockIdx.x; F.vcu = (F.G % 8 == 0) ? (F.bx % 8) * (F.G / 8) + F.bx / 8 : F.bx;
    F.in = args.in; F.out = args.out; F.ws = args.ws;
    volatile LAS unsigned* MISC = (volatile LAS unsigned*)(F.lds + MISC_OFF);
    if (F.tid < 4) MISC[F.tid] = 0u;
    __syncthreads();
    unsigned* ctl = (unsigned*)(F.ws + WS_CTL);
    XcdBarrier bar; bar.bar = ctl + CW_BAR; bar.x = 0; bar.st = nullptr;
    const int lo = args.ph_lo, hi = args.ph_hi;
    const bool multi = (hi - lo) > 1;
    if (multi) bar = xcd_barrier_post(ctl + CW_BAR, MISC);
#ifndef TYPE_MASK
#define TYPE_MASK 0x3ff
#endif
#define PTYPE(k) ((k) == 0 ? 0 : ((k) == 17 ? 9 : 1 + (((k) - 1) & 7)))
#define ENTER() do { int _t = threadIdx.x; asm volatile("" : "+v"(_t)); F.tid = _t; F.lane = _t & 63; F.wave = __builtin_amdgcn_readfirstlane(_t >> 6); } while (0)
#define IN(k) (((TYPE_MASK >> PTYPE(k)) & 1) && lo <= (k) && (k) < hi)
#define SEAM(k) do { if (IN(k) && IN((k) + 1)) xcd_barrier(bar); } while (0)

    if (IN(0)) { ENTER(); p0_prologue(F); }
    SEAM(0);
    for (int l = 0; l < DEPTH; ++l) {
        const int pb = 1 + 8 * l;
        const bool last = (l == DEPTH - 1);
        const int Mrows = last ? NLAT : NTOK;
        if (IN(pb + 0)) { ENTER(); row_op_a(F, l == 0 ? 0 : 1); }
        SEAM(pb + 0);
        if (IN(pb + 1)) { ENTER();
            pg8::SchedDense S; S.init(NTOK, NP, D, F.G, F.bx);
            pg8::EpiInProj E{(bf16_t*)(F.ws + WS_P), (const float*)(F.ws + WS_ROPE), (const float*)(F.ws + WS_ROPE) + 96 * 32};
            pg8::gemm_phase<pg8::EpiInProj, pg8::SchedDense, true, true>(F.lds, F.tid, (const char*)(F.ws + WS_H), (const char*)(F.ws + WS_WIN) + (size_t)l * NP * D * 2, D, S, E);
        }
        SEAM(pb + 1);
        if (IN(pb + 2)) { ENTER(); p3a_states_pool(F, l); }
        SEAM(pb + 2);
        if (IN(pb + 3)) { ENTER(); p3b_retention(F, l); }
        SEAM(pb + 3);
        if (IN(pb + 4)) { ENTER();
            pg8::SchedDense S; S.init(Mrows, D, D, F.G, F.bx);
            pg8::EpiResid E;
            if (l == 0) { E.rl = F.in[I_X]; E.rc = F.in[I_CTX]; } else { E.rl = F.out; E.rc = (const float*)(F.ws + WS_XC); }
            E.ol = F.out; E.oc = (float*)(F.ws + WS_XC); E.gmod = mod_ptr(F, l, 0, 2);
            pg8::gemm_phase<pg8::EpiResid, pg8::SchedDense, true, true>(F.lds, F.tid, (const char*)(F.ws + WS_H), (const char*)(F.ws + WS_WOUT) + (size_t)l * D * D * 2, D, S, E);
        }
        SEAM(pb + 4);
        if (IN(pb + 5)) { ENTER(); row_op_b(F, l); }
        SEAM(pb + 5);
        if (IN(pb + 6)) { ENTER();
            LAS int* tb = build_tb(F, l);
            LAS int* tokt = (LAS int*)(F.lds + TOKT_OFF);
            const int* list = (const int*)(F.ws + WS_LIST);
            pg8::SchedGroup S; S.tb = tb; S.tokt = tokt; S.G = F.G; S.c = F.vcu; S.K = D; S.gather = 1;
            { pg8::Unit u; for (int i = 0; i < 8 && S.next(i, u); ++i) { const int g = u.pm; int e = 0; while (tb[e + 1] <= g) ++e; const int rt = g - tb[e], cnt = tb[64 + e];
                if (F.tid < 256) { int r = rt * 256 + F.tid; if (r >= cnt) r = cnt - 1; tokt[i * 256 + F.tid] = list[(size_t)e * NTOK + r]; } } }
            __syncthreads();
            pg8::EpiSwiGLU E{(bf16_t*)(F.ws + WS_ACT)};
            pg8::gemm_phase<pg8::EpiSwiGLU, pg8::SchedGroup, true, true>(F.lds, F.tid, (const char*)(F.ws + WS_H), (const char*)(F.ws + WS_WGU) + (size_t)l * NE * 1024 * D * 2, D, S, E);
        }
        SEAM(pb + 6);
        if (IN(pb + 7)) { ENTER();
            LAS int* tb = build_tb(F, l);
            pg8::SchedGroup S; S.tb = tb; S.tokt = nullptr; S.G = F.G; S.c = F.vcu; S.K = FF; S.gather = 0;
            pg8::EpiBf16 E{(bf16_t*)(F.ws + WS_P), D};
            pg8::gemm_phase<pg8::EpiBf16, pg8::SchedGroup, true, true>(F.lds, F.tid, (const char*)(F.ws + WS_ACT), (const char*)(F.ws + WS_WD) + (size_t)l * NE * D * FF * 2, FF, S, E);
        }
        SEAM(pb + 7);
    }
    if (IN(17)) { ENTER(); row_op_a(F, 2); }
#undef IN
#undef SEAM
}

extern "C" void kernel_launch(void* const* d_in, const int* in_sizes, int n_in, void* d_out, int out_size, void* d_ws, size_t ws_size, hipStream_t stream) {
    static int grid = 0;
    if (grid == 0) {
        if (n_in != 22 || out_size != NLAT * D || ws_size < WS_END) { fprintf(stderr, "kernel_launch: unexpected shapes (n_in %d, out %d, ws %zu)\n", n_in, out_size, ws_size); grid = -1; return; }
        int dev = 0, cus = 0, per_cu = 0;
        if (hipGetDevice(&dev) != hipSuccess || hipDeviceGetAttribute(&cus, hipDeviceAttributeMultiprocessorCount, dev) != hipSuccess) { grid = -1; return; }
        if (hipFuncSetAttribute((const void*)fwd_kernel, hipFuncAttributeMaxDynamicSharedMemorySize, LDS_BYTES) != hipSuccess) { fprintf(stderr, "kernel_launch: hipFuncSetAttribute failed\n"); grid = -1; return; }
        if (hipOccupancyMaxActiveBlocksPerMultiprocessor(&per_cu, (const void*)fwd_kernel, 512, LDS_BYTES) != hipSuccess || per_cu < 1) { fprintf(stderr, "kernel_launch: occupancy query says %d\n", per_cu); }
        (void)hipGetLastError();
        grid = cus;
    }
    if (grid < 0) return;
    (void)hipMemsetAsync((char*)d_ws + WS_CTL, 0, CTL_ZERO_BYTES, stream);
    Args a{};
    for (int i = 0; i < 22; ++i) a.in[i] = (const float*)d_in[i];
    a.out = (float*)d_out; a.ws = (unsigned char*)d_ws;
    if (MK_N_LAUNCHES == 1) { a.ph_lo = 0; a.ph_hi = N_PHASES; hipLaunchKernelGGL(fwd_kernel, dim3(grid), dim3(512), LDS_BYTES, stream, a); }
    else { for (int p = 0; p < N_PHASES; ++p) { a.ph_lo = p; a.ph_hi = p + 1; hipLaunchKernelGGL(fwd_kernel, dim3(grid), dim3(512), LDS_BYTES, stream, a); } }
}
```

```cpp
#include <hip/hip_runtime.h>
#include <cstdio>
#include <cstdint>

#ifndef MK_N_LAUNCHES
#define MK_N_LAUNCHES 1
#endif

#define LAS __attribute__((address_space(3)))
#define GAS __attribute__((address_space(1)))
typedef unsigned short bf16_t;
typedef short bf16x8 __attribute__((ext_vector_type(8)));
typedef short s16x4 __attribute__((ext_vector_type(4)));
typedef float f32x4 __attribute__((ext_vector_type(4)));
typedef float f32x2 __attribute__((ext_vector_type(2)));
typedef unsigned u32x4 __attribute__((ext_vector_type(4)));
typedef unsigned u32x2 __attribute__((ext_vector_type(2)));

constexpr int Bn = 16, TL = 2048, CT = 256, D = 1024, DEPTH = 2;
constexpr int NLAT = Bn * TL, NCTX = Bn * CT, NTOK = NLAT + NCTX;
constexpr int NP = 2560;
constexpr int NE = 32, FF = 512, NH = 4, HD = 128;
constexpr int NCHUNK = 18;
constexpr float EPS = 1e-6f;
constexpr int MAXTILES = 320;
constexpr int N_PHASES = 18;

constexpr size_t MiB = 1u << 20;
constexpr size_t WS_CTL = 0, CTL_ZERO_BYTES = 1 * MiB;
constexpr size_t WS_MOD = 1 * MiB;
constexpr size_t WS_ROPE = 2 * MiB;
constexpr size_t WS_TOKINFO = 3 * MiB;
constexpr size_t WS_LIST = 5 * MiB;
constexpr size_t WS_WIN = 10 * MiB;
constexpr size_t WS_WOUT = 20 * MiB;
constexpr size_t WS_WGU = 24 * MiB;
constexpr size_t WS_WD = 152 * MiB;
constexpr size_t WS_XC = 216 * MiB;
constexpr size_t WS_H = 232 * MiB;
constexpr size_t WS_P = 304 * MiB;
constexpr size_t WS_ACT = 484 * MiB;
constexpr size_t WS_END = 564 * MiB;
constexpr int CW_TMO = 0;
constexpr int CW_CNT = 1024;
constexpr int CW_BAR = 4096;

constexpr int RING_BYTES = 131072;
constexpr int TOKT_OFF = RING_BYTES;
constexpr int MISC_OFF = 147456;
constexpr int LDS_BYTES = 163840;

__device__ __forceinline__ unsigned f2bf(float f) { unsigned u = __builtin_bit_cast(unsigned, f); return (u + 0x7fffu + ((u >> 16) & 1u)) >> 16; }
__device__ __forceinline__ unsigned pk2(float lo, float hi) { return f2bf(lo) | (f2bf(hi) << 16); }
__device__ __forceinline__ float bflo(unsigned w) { return __builtin_bit_cast(float, w << 16); }
__device__ __forceinline__ float bfhi(unsigned w) { return __builtin_bit_cast(float, w & 0xffff0000u); }
__device__ __forceinline__ float wave_sum(float v) {
#pragma unroll
    for (int o = 1; o < 64; o <<= 1) v += __shfl_xor(v, o);
    return v;
}
__device__ __forceinline__ float silu_f(float x) { return x / (1.0f + __expf(-x)); }

#define XB_TMO      128
#define XB_XCNT(j)  (256  + 64 * (j))
#define XB_XSUB(j)  (1280 + 64 * (j))
#define XB_XGEN(j)  (2304 + 64 * (j))
#define XB_TOP      3328
#define XB_TOPGEN   3392
#define XCD_BAR_WORDS 3456
#define XB_SPIN_CAP (1u << 18)
__device__ __forceinline__ unsigned xb_ld(unsigned* p)              { return __hip_atomic_load(p, __ATOMIC_RELAXED, __HIP_MEMORY_SCOPE_AGENT); }
__device__ __forceinline__ unsigned xb_add(unsigned* p, unsigned v) { return __hip_atomic_fetch_add(p, v, __ATOMIC_RELAXED, __HIP_MEMORY_SCOPE_AGENT); }
__device__ __forceinline__ unsigned xb_xcc_id() { return (unsigned)__builtin_amdgcn_s_getreg((3 << 11) | 20) & 0xFu; }
#define XB_SPIN(cond, bar) do { unsigned _sp = 0; while (cond) { __builtin_amdgcn_s_sleep(1); \
    if ((++_sp & 255u) == 0u) { if (xb_ld(&(bar)[XB_TMO])) break; if (_sp > XB_SPIN_CAP) { atomicAdd(&(bar)[XB_TMO], 1u); break; } } } } while (0)
struct XcdBarrier { unsigned* bar; unsigned x; volatile LAS unsigned* st; };
__device__ __forceinline__ XcdBarrier xcd_barrier_post(unsigned* bar, volatile LAS unsigned* st) {
    XcdBarrier b; b.bar = bar; b.x = xb_xcc_id(); b.st = st;
    if (threadIdx.x == 0) (void)xb_add(&bar[XB_XCNT(b.x)], 1u);
    return b;
}
__device__ __forceinline__ void xcd_barrier_complete(unsigned* bar, unsigned x, unsigned& nloc, unsigned& nx) {
    const unsigned G = gridDim.x * gridDim.y * gridDim.z;
    unsigned sum, cnt, mine, sp = 0u;
    for (;;) {
        sum = 0u; cnt = 0u; mine = 0u;
#pragma unroll
        for (unsigned j = 0; j < 16; ++j) { const unsigned c = xb_ld(&bar[XB_XCNT(j)]); sum += c; cnt += (c > 0u) ? 1u : 0u; mine = (j == x) ? c : mine; }
        if (sum == G) break;
        __builtin_amdgcn_s_sleep(1);
        if ((++sp & 255u) == 0u) { if (xb_ld(&bar[XB_TMO])) break; if (sp > XB_SPIN_CAP) { atomicAdd(&bar[XB_TMO], 1u); break; } }
    }
    nloc = mine > 0u ? mine : 1u; nx = cnt > 0u ? cnt : 1u;
}
__device__ __forceinline__ void xcd_barrier(const XcdBarrier& b) {
    asm volatile("s_waitcnt vmcnt(0)" ::: "memory");
    __syncthreads();
    if (threadIdx.x == 0) {
        unsigned* bar = b.bar;
        __builtin_amdgcn_s_waitcnt(0);
        unsigned nloc = b.st[0], nx = b.st[1];
        if (nloc == 0u) { xcd_barrier_complete(bar, b.x, nloc, nx); b.st[0] = nloc; b.st[1] = nx; }
        const unsigned old = xb_add(&bar[XB_XSUB(b.x)], 1u);
        const unsigned gen = old / nloc;
        if (old + 1u == (gen + 1u) * nloc) {
            __builtin_amdgcn_fence(__ATOMIC_RELEASE, "agent");
            asm volatile("s_waitcnt vmcnt(0)" ::: "memory");
            const unsigned og = xb_add(&bar[XB_TOP], 1u);
            const unsigned tg = og / nx;
            if (og + 1u == (tg + 1u) * nx) xb_add(&bar[XB_TOPGEN], 1u);
            else XB_SPIN(xb_ld(&bar[XB_TOPGEN]) == tg, bar);
            __builtin_amdgcn_fence(__ATOMIC_ACQUIRE, "agent");
            xb_add(&bar[XB_XGEN(b.x)], 1u);
            asm volatile("s_waitcnt vmcnt(0)" ::: "memory");
        } else {
            XB_SPIN(xb_ld(&bar[XB_XGEN(b.x)]) == gen, bar);
            __builtin_amdgcn_fence(__ATOMIC_ACQUIRE, "agent");
            asm volatile("s_waitcnt vmcnt(0)" ::: "memory");
        }
    }
    __syncthreads();
}

namespace pg8 {
constexpr int BM = 256, BK = 64, HALF = 128, HTB = HALF * BK * 2, STAGE_BYTES = 8 * HTB, NXCD = 8, WGM = 8;
__device__ __forceinline__ int lds_byte(int r, int c) { const int st = (r >> 4) * 2 + (c >> 5), rr = r & 15, cc = c & 31, ob = rr * 64 + cc * 2; return st * 1024 + (ob ^ (((ob >> 9) & 1) << 5)); }
__device__ __forceinline__ void stage_rc(int b, int& R, int& C) { const int st = b / 1024, sb = b % 1024, swz = sb ^ (((sb >> 9) & 1) << 5); R = (st >> 1) * 16 + swz / 64; C = (st & 1) * 32 + (swz % 64) / 2; }
__device__ __forceinline__ int perm32(int rho) { const int n = rho >> 4, i = rho & 15; return 8 * (i >> 2) + 4 * n + (i & 3); }

struct Unit { int pm, pn; unsigned bofs; int aux; };

struct SchedDense {
    int nM, nN, nwg, G, c, K;
    __device__ void init(int M, int N, int K_, int G_, int c_) { nM = M / BM; nN = N / BM; nwg = nM * nN; G = G_; c = c_; K = K_; }
    __device__ bool next(int i, Unit& u) const {
        const long L = (long)i * G + c; if (L >= nwg) return false;
        int wgid = (int)L; { const int q = nwg / NXCD, r = nwg % NXCD, xcd = wgid % NXCD, off = wgid / NXCD; wgid = (xcd < r ? xcd * (q + 1) : r * (q + 1) + (xcd - r) * q) + off; }
        const int nig = WGM * nN, gid = wgid / nig, fm = gid * WGM, gsz = (nM - fm) < WGM ? (nM - fm) : WGM;
        u.pm = fm + ((wgid % nig) % gsz); u.pn = (wgid % nig) / gsz; u.bofs = (unsigned)u.pn * (unsigned)(BM * K * 2); u.aux = 0; return true;
    }
    __device__ __forceinline__ unsigned a_row(const Unit& u, int r) const { return (unsigned)(u.pm * BM + r); }
};
struct SchedGroup {
    const LAS int* tb; const LAS int* tokt; int G, c, K, gather;
    __device__ bool next(int i, Unit& u) const {
        const int L = i * G + c, nt = tb[NE]; if (L >= nt * 4) return false;
        const int g = L >> 2; int e = 0; while (tb[e + 1] <= g) ++e;
        u.pm = g; u.pn = L & 3; u.bofs = (unsigned)(e * 1024 + u.pn * BM) * (unsigned)(K * 2); u.aux = i; return true;
    }
    __device__ __forceinline__ unsigned a_row(const Unit& u, int r) const { return gather ? (unsigned)tokt[u.aux * 256 + r] : (unsigned)(u.pm * BM + r); }
};

__device__ __forceinline__ unsigned cvt_pk_bf16(float lo, float hi) { unsigned r; asm volatile("v_cvt_pk_bf16_f32 %0, %1, %2" : "=v"(r) : "v"(lo), "v"(hi)); return r; }

template <class Epi, class Sched, bool ALIGN_EPI, bool SP2>
__device__ __forceinline__ void gemm_phase(LAS unsigned char* lds, const int tid, const char* Abase, const char* Bbase, const int K, const Sched& S, const Epi& E) {
    const int wid = __builtin_amdgcn_readfirstlane(tid >> 6), lane = tid & 63, wr = wid >> 2, wc = wid & 3, fr = lane & 15, fq = lane >> 4;
    const int nt = K / BK;
    int Rr[2], Cc[2]; unsigned voffB[2];
#pragma unroll
    for (int i = 0; i < 2; ++i) { int R, C; stage_rc(tid * 16 + i * 8192, R, C); const int Rb = Epi::PERM ? ((R & ~31) + perm32(R & 31)) : R;
        Rr[i] = R; Cc[i] = C; voffB[i] = (unsigned)(Rb * K + C) * 2u; }
    const size_t kstep = (size_t)(BK * 2);
    const size_t hstep = (size_t)HALF * K * 2;
    const unsigned ldsw = (unsigned)wid * 1024u;
    const int aoff = lds_byte(wr * 64 + fr, fq * 8), boff = lds_byte(wc * 32 + fr, fq * 8);
#define PG8_SA(b, h) (((b) * 2 + (h)) * HTB)
#define PG8_SB(b, h) ((4 + (b) * 2 + (h)) * HTB)
#define PG8_STAGE(bufoff, gbase, voff) do { _Pragma("unroll") for (int _i = 0; _i < 2; ++_i) \
        __builtin_amdgcn_global_load_lds((const unsigned*)((const char*)(gbase) + (voff)[_i]), (LAS unsigned*)(lds + (bufoff) + ldsw + _i * 8192), 16, 0, 0); } while (0)
#define PG8_LDA(dst, b, h) do { _Pragma("unroll") for (int m = 0; m < 4; ++m) _Pragma("unroll") for (int k = 0; k < 2; ++k) dst[m][k] = *(const LAS bf16x8*)(lds + PG8_SA(b, h) + aoff + m * 2048 + k * 1024); } while (0)
#define PG8_LDB(dst, b, h) do { _Pragma("unroll") for (int n = 0; n < 2; ++n) _Pragma("unroll") for (int k = 0; k < 2; ++k) dst[n][k] = *(const LAS bf16x8*)(lds + PG8_SB(b, h) + boff + n * 2048 + k * 1024); } while (0)
#define PG8_MMA(ai, bj, At, Bt) do { __builtin_amdgcn_s_setprio(1); _Pragma("unroll") for (int m = 0; m < 4; ++m) _Pragma("unroll") for (int n = 0; n < 2; ++n) _Pragma("unroll") for (int k = 0; k < 2; ++k) \
        acc[ai][bj][m][n] = __builtin_amdgcn_mfma_f32_16x16x32_bf16(Bt[n][k], At[m][k], acc[ai][bj][m][n], 0, 0, 0); __builtin_amdgcn_s_setprio(0); } while (0)
#define PG8_WAIT_V(n) asm volatile("s_waitcnt vmcnt(" #n ")" ::: "memory")
#define PG8_WAIT_L(n) asm volatile("s_waitcnt lgkmcnt(" #n ")" ::: "memory")
#define PG8_BAR __builtin_amdgcn_s_barrier()
#define PG8_SCHED __builtin_amdgcn_sched_barrier(0)
#define PG8_AOFF(dst, u) do { _Pragma("unroll") for (int _h = 0; _h < 2; ++_h) _Pragma("unroll") for (int _i = 0; _i < 2; ++_i) \
        dst[_h][_i] = (S.a_row(u, _h * HALF + Rr[_i]) * (unsigned)K + (unsigned)Cc[_i]) * 2u; } while (0)
    Unit cur, nxt; int ui = 0;
    if (!S.next(0, cur)) return;
    f32x4 acc[2][2][4][2];
#pragma unroll
    for (int a = 0; a < 2; ++a)
#pragma unroll
        for (int b = 0; b < 2; ++b)
#pragma unroll
            for (int m = 0; m < 4; ++m)
#pragma unroll
                for (int n = 0; n < 2; ++n) acc[a][b][m][n] = (f32x4){0.f, 0.f, 0.f, 0.f};
    bf16x8 At[4][2], B0[2][2], B1[2][2];
    unsigned co[2][2], no[2][2];
    PG8_AOFF(co, cur);
    const char* cB = Bbase + cur.bofs;
    if constexpr (SP2) {
        PG8_STAGE(PG8_SB(0, 0), cB, voffB); PG8_STAGE(PG8_SB(0, 1), cB + hstep, voffB); PG8_STAGE(PG8_SA(0, 0), Abase, co[0]); PG8_STAGE(PG8_SA(0, 1), Abase, co[1]);
        if (wr == 1) PG8_BAR;
        PG8_WAIT_V(2); PG8_BAR;
        PG8_STAGE(PG8_SB(1, 0), cB + kstep, voffB); PG8_STAGE(PG8_SA(1, 0), Abase + kstep, co[0]); PG8_STAGE(PG8_SB(1, 1), cB + hstep + kstep, voffB);
        PG8_WAIT_V(6); PG8_BAR;
    } else {
        PG8_STAGE(PG8_SB(0, 0), cB, voffB); PG8_STAGE(PG8_SA(0, 0), Abase, co[0]); PG8_STAGE(PG8_SB(0, 1), cB + hstep, voffB); PG8_STAGE(PG8_SA(0, 1), Abase, co[1]);
        if (wr == 1) PG8_BAR;
        PG8_WAIT_V(4); PG8_BAR;
        PG8_STAGE(PG8_SB(1, 0), cB + kstep, voffB); PG8_STAGE(PG8_SA(1, 0), Abase + kstep, co[0]); PG8_STAGE(PG8_SB(1, 1), cB + hstep + kstep, voffB);
        PG8_WAIT_V(6); PG8_BAR;
    }
    for (;;) {
        const bool has_next = S.next(ui + 1, nxt);
        const char* nB = has_next ? Bbase + nxt.bofs : cB;
        if (has_next) { PG8_AOFF(no, nxt); } else {
#pragma unroll
            for (int h = 0; h < 2; ++h)
#pragma unroll
                for (int i = 0; i < 2; ++i) no[h][i] = co[h][i]; }
        for (int t = 0; t < nt; t += 2) {
            const bool last = (t == nt - 2);
            const char* a1 = Abase + (size_t)(t + 1) * kstep;
            const char* a2 = last ? Abase : Abase + (size_t)(t + 2) * kstep; const char* b2 = last ? nB : cB + (size_t)(t + 2) * kstep;
            const char* a3 = a2 + kstep; const char* b3 = b2 + kstep;
            unsigned o2[2][2];
#pragma unroll
            for (int h = 0; h < 2; ++h)
#pragma unroll
                for (int i = 0; i < 2; ++i) o2[h][i] = last ? no[h][i] : co[h][i];
            if constexpr (SP2) {
            PG8_LDB(B0, 0, 0); PG8_LDB(B1, 0, 1); PG8_SCHED; PG8_LDA(At, 0, 0); PG8_STAGE(PG8_SA(1, 1), a1, co[1]);
            PG8_WAIT_V(8); PG8_WAIT_L(0); PG8_BAR; PG8_MMA(0, 0, At, B0); PG8_MMA(0, 1, At, B1); PG8_BAR; PG8_SCHED;
            PG8_LDA(At, 0, 1); PG8_STAGE(PG8_SB(0, 0), b2, voffB); PG8_STAGE(PG8_SB(0, 1), b2 + hstep, voffB); PG8_STAGE(PG8_SA(0, 0), a2, o2[0]);
            PG8_WAIT_V(8); PG8_WAIT_L(0); PG8_BAR; PG8_MMA(1, 0, At, B0); PG8_MMA(1, 1, At, B1); PG8_BAR; PG8_SCHED;
            PG8_LDB(B0, 1, 0); PG8_LDB(B1, 1, 1); PG8_SCHED; PG8_LDA(At, 1, 0); PG8_STAGE(PG8_SA(0, 1), a2, o2[1]);
            PG8_WAIT_V(8); PG8_WAIT_L(0); PG8_BAR; PG8_MMA(0, 0, At, B0); PG8_MMA(0, 1, At, B1); PG8_BAR; PG8_SCHED;
            PG8_LDA(At, 1, 1); PG8_STAGE(PG8_SB(1, 0), b3, voffB); PG8_STAGE(PG8_SB(1, 1), b3 + hstep, voffB); PG8_STAGE(PG8_SA(1, 0), a3, o2[0]);
            PG8_WAIT_V(8); PG8_WAIT_L(0); PG8_BAR; PG8_MMA(1, 0, At, B0); PG8_MMA(1, 1, At, B1); PG8_BAR; PG8_SCHED;
            } else {
            PG8_LDB(B0, 0, 0); PG8_SCHED; PG8_LDA(At, 0, 0); PG8_STAGE(PG8_SA(1, 1), a1, co[1]);
            PG8_WAIT_L(8); PG8_BAR; PG8_WAIT_L(0); PG8_MMA(0, 0, At, B0); PG8_BAR; PG8_SCHED;
            PG8_LDB(B1, 0, 1); PG8_STAGE(PG8_SB(0, 0), b2, voffB);
            PG8_BAR; PG8_WAIT_L(0); PG8_MMA(0, 1, At, B1); PG8_BAR;
            PG8_LDA(At, 0, 1); PG8_STAGE(PG8_SA(0, 0), a2, o2[0]);
            PG8_BAR; PG8_WAIT_L(0); PG8_MMA(1, 0, At, B0); PG8_BAR; PG8_SCHED;
            PG8_STAGE(PG8_SB(0, 1), b2 + hstep, voffB);
            PG8_WAIT_V(6); PG8_BAR; PG8_MMA(1, 1, At, B1); PG8_BAR;
            PG8_LDB(B0, 1, 0); PG8_SCHED; PG8_LDA(At, 1, 0); PG8_STAGE(PG8_SA(0, 1), a2, o2[1]);
            PG8_WAIT_L(8); PG8_BAR; PG8_WAIT_L(0); PG8_MMA(0, 0, At, B0); PG8_BAR; PG8_SCHED;
            PG8_LDB(B1, 1, 1); PG8_STAGE(PG8_SB(1, 0), b3, voffB);
            PG8_BAR; PG8_WAIT_L(0); PG8_MMA(0, 1, At, B1); PG8_BAR;
            PG8_LDA(At, 1, 1); PG8_STAGE(PG8_SA(1, 0), a3, o2[0]);
            PG8_BAR; PG8_WAIT_L(0); PG8_MMA(1, 0, At, B0); PG8_BAR; PG8_SCHED;
            PG8_STAGE(PG8_SB(1, 1), b3 + hstep, voffB);
            PG8_WAIT_V(6); PG8_BAR; PG8_MMA(1, 1, At, B1); PG8_BAR;
            }
        }
        if constexpr (ALIGN_EPI) { if (wr == 0) PG8_BAR; }
        E(acc, cur, wr, wc, fr, fq);
        if (!has_next) break;
#pragma unroll
        for (int a = 0; a < 2; ++a)
#pragma unroll
            for (int b = 0; b < 2; ++b)
#pragma unroll
                for (int m = 0; m < 4; ++m)
#pragma unroll
                    for (int n = 0; n < 2; ++n) acc[a][b][m][n] = (f32x4){0.f, 0.f, 0.f, 0.f};
        cur = nxt; cB = nB; ++ui;
#pragma unroll
        for (int h = 0; h < 2; ++h)
#pragma unroll
            for (int i = 0; i < 2; ++i) co[h][i] = no[h][i];
        if constexpr (ALIGN_EPI) { if (wr == 1) PG8_BAR; }
    }
    PG8_WAIT_V(0);
    if constexpr (!ALIGN_EPI) { if (wr == 0) PG8_BAR; }
    PG8_BAR;
#undef PG8_SA
#undef PG8_SB
#undef PG8_STAGE
#undef PG8_LDA
#undef PG8_LDB
#undef PG8_MMA
#undef PG8_WAIT_V
#undef PG8_WAIT_L
#undef PG8_BAR
#undef PG8_SCHED
#undef PG8_AOFF
}

struct EpiInProj {
    static constexpr bool PERM = true;
    bf16_t* P; const float* ropeC; const float* ropeS;
    __device__ __forceinline__ void operator()(const f32x4 (&acc)[2][2][4][2], const Unit& u, int wr, int wc, int fr, int fq) const {
        const int row0 = u.pm * BM + wr * 64 + fr, col0 = u.pn * BM + wc * 32 + 8 * fq;
        const bool qk = u.pn < 4, rope = qk && (u.pm < NLAT / BM);
        const float ks = (u.pn >= 2 && u.pn < 4) ? 0.08838834764831845f : 1.0f;
        const int sec = wc >> 1, i0 = (wc & 1) * 16 + 4 * fq;
#pragma unroll
        for (int ai = 0; ai < 2; ++ai)
#pragma unroll
            for (int m = 0; m < 4; ++m) {
                const int row = row0 + ai * HALF + m * 16;
                f32x4 c4 = (f32x4){1.f, 1.f, 1.f, 1.f}, s4 = (f32x4){0.f, 0.f, 0.f, 0.f};
                if (rope) { const int t = row & (TL - 1), pos = sec ? (t & 63) : (t >> 6); const int ti = (sec ? 1024 : 0) + pos * 32 + i0;
                    c4 = *(const f32x4*)(ropeC + ti); s4 = *(const f32x4*)(ropeS + ti); }
                bf16_t* rowp = P + (size_t)row * NP + col0;
#pragma unroll
                for (int bj = 0; bj < 2; ++bj) {
                    f32x4 v0 = acc[ai][bj][m][0], v1 = acc[ai][bj][m][1];
                    if (qk) {
                        const float a0 = v0[0] * c4[0] - v0[1] * s4[0], b0 = v0[0] * s4[0] + v0[1] * c4[0];
                        const float a1 = v0[2] * c4[1] - v0[3] * s4[1], b1 = v0[2] * s4[1] + v0[3] * c4[1];
                        const float a2 = v1[0] * c4[2] - v1[1] * s4[2], b2 = v1[0] * s4[2] + v1[1] * c4[2];
                        const float a3 = v1[2] * c4[3] - v1[3] * s4[3], b3 = v1[2] * s4[3] + v1[3] * c4[3];
                        v0 = (f32x4){a0 * ks, b0 * ks, a1 * ks, b1 * ks}; v1 = (f32x4){a2 * ks, b2 * ks, a3 * ks, b3 * ks};
                    }
                    u32x4 w; w.x = cvt_pk_bf16(v0[0], v0[1]); w.y = cvt_pk_bf16(v0[2], v0[3]); w.z = cvt_pk_bf16(v1[0], v1[1]); w.w = cvt_pk_bf16(v1[2], v1[3]);
                    *(u32x4*)(rowp + bj * HALF) = w;
                }
            }
    }
};
struct EpiResid {
    static constexpr bool PERM = false;
    const float* rl; const float* rc; float* ol; float* oc; const float* gmod;
    __device__ __forceinline__ void operator()(const f32x4 (&acc)[2][2][4][2], const Unit& u, int wr, int wc, int fr, int fq) const {
        const int row0 = u.pm * BM + wr * 64 + fr, col0 = u.pn * BM + wc * 32 + 4 * fq;
        const bool lat = u.pm < NLAT / BM; const int b = lat ? (u.pm >> 3) : 16;
        const float* rbase = lat ? rl : rc - (size_t)NLAT * D; float* obase = lat ? ol : oc - (size_t)NLAT * D;
        f32x4 gv[2][2];
#pragma unroll
        for (int bj = 0; bj < 2; ++bj)
#pragma unroll
            for (int n = 0; n < 2; ++n) gv[bj][n] = *(const f32x4*)(gmod + (size_t)b * 6 * D + col0 + bj * HALF + n * 16);
#pragma unroll
        for (int ai = 0; ai < 2; ++ai)
#pragma unroll
            for (int m = 0; m < 4; ++m) { const size_t off = (size_t)(row0 + ai * HALF + m * 16) * D + col0;
#pragma unroll
                for (int bj = 0; bj < 2; ++bj)
#pragma unroll
                    for (int n = 0; n < 2; ++n) { const f32x4 r = *(const f32x4*)(rbase + off + bj * HALF + n * 16);
                        *(f32x4*)(obase + off + bj * HALF + n * 16) = r + gv[bj][n] * acc[ai][bj][m][n]; } }
    }
};
struct EpiSwiGLU {
    static constexpr bool PERM = true;
    bf16_t* O;
    __device__ __forceinline__ void operator()(const f32x4 (&acc)[2][2][4][2], const Unit& u, int wr, int wc, int fr, int fq) const {
        const int row0 = u.pm * BM + wr * 64 + fr, col0 = u.pn * 128 + wc * 16 + 4 * fq;
#pragma unroll
        for (int ai = 0; ai < 2; ++ai)
#pragma unroll
            for (int m = 0; m < 4; ++m) { bf16_t* rowp = O + (size_t)(row0 + ai * HALF + m * 16) * FF + col0;
#pragma unroll
                for (int bj = 0; bj < 2; ++bj) { const f32x4 g = acc[ai][bj][m][0], up = acc[ai][bj][m][1];
                    u32x2 w; w.x = cvt_pk_bf16(silu_f(g[0]) * up[0], silu_f(g[1]) * up[1]); w.y = cvt_pk_bf16(silu_f(g[2]) * up[2], silu_f(g[3]) * up[3]);
                    *(u32x2*)(rowp + bj * 64) = w; } }
    }
};
struct EpiBf16 {
    static constexpr bool PERM = true;
    bf16_t* O; int ldc;
    __device__ __forceinline__ void operator()(const f32x4 (&acc)[2][2][4][2], const Unit& u, int wr, int wc, int fr, int fq) const {
        const int row0 = u.pm * BM + wr * 64 + fr, col0 = u.pn * BM + wc * 32 + 8 * fq;
#pragma unroll
        for (int ai = 0; ai < 2; ++ai)
#pragma unroll
            for (int m = 0; m < 4; ++m) { bf16_t* rowp = O + (size_t)(row0 + ai * HALF + m * 16) * ldc + col0;
#pragma unroll
                for (int bj = 0; bj < 2; ++bj) { const f32x4 v0 = acc[ai][bj][m][0], v1 = acc[ai][bj][m][1];
                    u32x4 w; w.x = cvt_pk_bf16(v0[0], v0[1]); w.y = cvt_pk_bf16(v0[2], v0[3]); w.z = cvt_pk_bf16(v1[0], v1[1]); w.w = cvt_pk_bf16(v1[2], v1[3]);
                    *(u32x4*)(rowp + bj * HALF) = w; } }
    }
};
}

struct Args { const float* in[22]; float* out; unsigned char* ws; int ph_lo, ph_hi; };
enum { I_X = 0, I_C, I_CTX, I_CCTX, I_ADAW, I_ADAB, I_N1G, I_WIN, I_DF, I_DB, I_POOLW, I_POOLS, I_WOUT, I_N2G, I_RGW, I_RGB, I_REW, I_REB, I_WG, I_WU, I_WDN, I_FNG };

struct Frame {
    LAS unsigned char* lds; int tid, lane, wave, G, bx, vcu;
    const float* const* in; float* out; unsigned char* ws;
};
__device__ __forceinline__ float* xa_row(const Frame& F, int row) { return row < NLAT ? F.out + (size_t)row * D : (float*)(F.ws + WS_XC) + (size_t)(row - NLAT) * D; }
__device__ __forceinline__ const float* mod_ptr(const Frame& F, int l, int b, int which) { return (const float*)(F.ws + WS_MOD) + ((size_t)(l * 17 + b) * 6 + which) * D; }

__device__ __forceinline__ void tr_item(const float* colp, size_t ldw, int k0, bf16_t* WT, int K, int n0, LAS float* scr, int lane) {
#pragma unroll 8
    for (int i = 0; i < 32; ++i) { const int kk = 2 * i + (lane >> 5); scr[kk * 33 + (lane & 31)] = colp[(size_t)(k0 + kk) * ldw]; }
    asm volatile("s_waitcnt lgkmcnt(0)" ::: "memory");
    const int c = lane & 7;
#pragma unroll
    for (int j = 0; j < 4; ++j) { const int n = (lane >> 3) + 8 * j; const LAS float* s = scr + (8 * c) * 33 + n;
        u32x4 o; o.x = pk2(s[0 * 33], s[1 * 33]); o.y = pk2(s[2 * 33], s[3 * 33]); o.z = pk2(s[4 * 33], s[5 * 33]); o.w = pk2(s[6 * 33], s[7 * 33]);
        *(u32x4*)(WT + (size_t)(n0 + n) * K + k0 + 8 * c) = o; }
    asm volatile("s_waitcnt lgkmcnt(0)" ::: "memory");
}
__device__ __forceinline__ void fold_item(const float* win, const float* pw, const float* ps, int k0, bf16_t* WT, int n0, LAS float* scr, int lane) {
    const int n = n0 + (lane & 31), g = n >> 7, nn = n & 127;
    const float* pwc = pw + (size_t)g * 128 * 128 + nn; const float sc = ps[n];
    for (int i = 0; i < 32; ++i) { const int kk = 2 * i + (lane >> 5); const float* wr = win + (size_t)(k0 + kk) * NP + 2048 + g * 128;
        float s = 0.f;
#pragma unroll 8
        for (int c = 0; c < 128; ++c) s += wr[c] * pwc[(size_t)c * 128];
        scr[kk * 33 + (lane & 31)] = s * sc; }
    asm volatile("s_waitcnt lgkmcnt(0)" ::: "memory");
    const int c = lane & 7;
#pragma unroll
    for (int j = 0; j < 4; ++j) { const int nl = (lane >> 3) + 8 * j; const LAS float* s = scr + (8 * c) * 33 + nl;
        u32x4 o; o.x = pk2(s[0 * 33], s[1 * 33]); o.y = pk2(s[2 * 33], s[3 * 33]); o.z = pk2(s[4 * 33], s[5 * 33]); o.w = pk2(s[6 * 33], s[7 * 33]);
        *(u32x4*)(WT + (size_t)(2048 + n0 + nl) * D + k0 + 8 * c) = o; }
    asm volatile("s_waitcnt lgkmcnt(0)" ::: "memory");
}
__device__ __forceinline__ void p0_prologue(const Frame& F) {
    for (int task = F.bx; task < 2 * 96; task += F.G) {
        const int l = task / 96, cg = task % 96;
        LAS float* sc = (LAS float*)F.lds;
        LAS float* part = (LAS float*)(F.lds + 17 * 1024 * 4);
        for (int i = F.tid; i < 17 * 1024; i += 512) { const int b = i >> 10, k = i & 1023; const float v = b < 16 ? F.in[I_C][b * D + k] : F.in[I_CCTX][k]; sc[i] = silu_f(v); }
        __syncthreads();
        float acc[17];
#pragma unroll
        for (int b = 0; b < 17; ++b) acc[b] = 0.f;
        const float* aw = F.in[I_ADAW] + (size_t)l * D * 6 * D + cg * 64 + F.lane;
        for (int k = F.wave * 128; k < F.wave * 128 + 128; ++k) { const float w = aw[(size_t)k * 6 * D];
#pragma unroll
            for (int b = 0; b < 17; ++b) acc[b] += sc[b * 1024 + k] * w; }
#pragma unroll
        for (int b = 0; b < 17; ++b) part[(F.wave * 17 + b) * 64 + F.lane] = acc[b];
        __syncthreads();
        for (int i = F.tid; i < 17 * 64; i += 512) { const int b = i >> 6, n = i & 63; float s = F.in[I_ADAB][l * 6 * D + cg * 64 + n];
#pragma unroll
            for (int w = 0; w < 8; ++w) s += part[(w * 17 + b) * 64 + n];
            const int col = cg * 64 + n; ((float*)(F.ws + WS_MOD))[((size_t)(l * 17 + b) * 6 + (col >> 10)) * D + (col & 1023)] = s; }
        __syncthreads();
    }
    if (F.bx == F.G - 1) {
        float* rc = (float*)(F.ws + WS_ROPE); float* rs = rc + 96 * 32;
        for (int i = F.tid; i < 96 * 32; i += 512) { const int p = i >> 5, f = i & 31; const int pos = p < 32 ? p : p - 32;
            const float inv = powf(10000.0f, -(float)f / 32.0f); const float ang = (float)pos * inv; rc[i] = cosf(ang); rs[i] = sinf(ang); }
    }
    LAS float* scr = (LAS float*)(F.lds + F.wave * 8448);
    const int gw = F.vcu * 8 + F.wave, NGW = F.G * 8;
    constexpr int IT_WIN = 16 * 80, IT_WOUT = 16 * 32, IT_GU = 16 * 32, IT_DN = 8 * 32;
    constexpr int N_WIN = DEPTH * IT_WIN, N_WOUT = DEPTH * IT_WOUT, N_GU = DEPTH * NE * IT_GU, N_DN = DEPTH * NE * IT_DN;
    for (int it = gw; it < N_WIN + N_WOUT + N_GU + N_DN; it += NGW) {
        int r = it;
        if (r < N_WIN) { const int l = r / IT_WIN; r %= IT_WIN; const int kb = r / 80, nb = r % 80, n0 = nb * 32;
            const float* win = F.in[I_WIN] + (size_t)l * D * NP; bf16_t* WT = (bf16_t*)(F.ws + WS_WIN) + (size_t)l * NP * D;
            if (n0 >= 2048) { fold_item(win, F.in[I_POOLW] + (size_t)l * 4 * 128 * 128, F.in[I_POOLS] + l * 512, kb * 64, WT, n0 - 2048, scr, F.lane); continue; }
            const int n = n0 + (F.lane & 31); int src = n;
            if (n < 1024) { const int hh = n >> 7, j = n & 127, sec = j >> 6, jj = j & 63; src = (n & 512) + (hh & 3) * 128 + sec * 64 + (jj & 1) * 32 + (jj >> 1); }
            tr_item(win + src, NP, kb * 64, WT, D, n0, scr, F.lane); continue; }
        r -= N_WIN;
        if (r < N_WOUT) { const int l = r / IT_WOUT; r %= IT_WOUT; const int kb = r / 32, nb = r % 32, n0 = nb * 32;
            tr_item(F.in[I_WOUT] + (size_t)l * D * D + n0 + (F.lane & 31), D, kb * 64, (bf16_t*)(F.ws + WS_WOUT) + (size_t)l * D * D, D, n0, scr, F.lane); continue; }
        r -= N_WOUT;
        if (r < N_GU) { const int le = r / IT_GU; r %= IT_GU; const int kb = r / 32, nb = r % 32, n0 = nb * 32;
            const int n = n0 + (F.lane & 31), col = (n >> 3) * 4 + (n & 3); const float* src = ((n & 4) ? F.in[I_WU] : F.in[I_WG]) + (size_t)le * D * FF + col;
            tr_item(src, FF, kb * 64, (bf16_t*)(F.ws + WS_WGU) + (size_t)le * 1024 * D, D, n0, scr, F.lane); continue; }
        r -= N_GU;
        { const int le = r / IT_DN; r %= IT_DN; const int kb = r / 32, nb = r % 32, n0 = nb * 32;
            tr_item(F.in[I_WDN] + (size_t)le * FF * D + n0 + (F.lane & 31), D, kb * 64, (bf16_t*)(F.ws + WS_WD) + (size_t)le * D * FF, FF, n0, scr, F.lane); }
    }
}

__device__ __forceinline__ LAS int* build_tb(const Frame& F, int l) {
    LAS int* tb = (LAS int*)(F.lds + MISC_OFF + 64);
    if (F.tid == 0) { const unsigned* cnt = (const unsigned*)(F.ws + WS_CTL) + CW_CNT + l * NE * 16; int s = 0;
        for (int e = 0; e < NE; ++e) { tb[e] = s; const int c = (int)__hip_atomic_load(cnt + e * 16, __ATOMIC_RELAXED, __HIP_MEMORY_SCOPE_AGENT); tb[64 + e] = c; s += (c + 255) >> 8; }
        tb[NE] = s; }
    __syncthreads();
    return tb;
}

__device__ __forceinline__ void row_op_a(const Frame& F, int mode) {
    const int gw = F.vcu * 8 + F.wave, NGW = F.G * 8;
    const int nrows = (mode == 2) ? NLAT : NTOK; const int l = (mode == 0) ? 0 : 1, lp = mode - 1;
    const LAS int* tb = nullptr; if (mode != 0) tb = build_tb(F, lp);
    const bf16_t* YB = (const bf16_t*)(F.ws + WS_P); bf16_t* H = (bf16_t*)(F.ws + WS_H);
    const float* gain = (mode == 2) ? F.in[I_FNG] : F.in[I_N1G] + l * D;
    for (int row = gw; row < nrows; row += NGW) {
        const int b = row < NLAT ? (row >> 11) : 16;
        f32x4 v[4];
        if (mode == 0) { const f32x4* src = (const f32x4*)(row < NLAT ? F.in[I_X] + (size_t)row * D : F.in[I_CTX] + (size_t)(row - NLAT) * D) + F.lane;
#pragma unroll
            for (int j = 0; j < 4; ++j) v[j] = src[64 * j];
        } else {
            const int4 ti = *(const int4*)(F.ws + WS_TOKINFO + (size_t)row * 32); const f32x2 tw = *(const f32x2*)(F.ws + WS_TOKINFO + (size_t)row * 32 + 16);
            const size_t s1 = (size_t)(tb[ti.x] * 256 + ti.y), s2 = (size_t)(tb[ti.z] * 256 + ti.w);
            float* xr = xa_row(F, row); const f32x4* g2 = (const f32x4*)mod_ptr(F, lp, b, 5) + F.lane;
            const u32x2* y1 = (const u32x2*)(YB + s1 * D) + F.lane; const u32x2* y2 = (const u32x2*)(YB + s2 * D) + F.lane;
#pragma unroll
            for (int j = 0; j < 4; ++j) { const f32x4 x = ((const f32x4*)xr)[F.lane + 64 * j]; const u32x2 a = y1[64 * j], c = y2[64 * j]; const f32x4 g = g2[64 * j];
                f32x4 y; y[0] = tw.x * bflo(a.x) + tw.y * bflo(c.x); y[1] = tw.x * bfhi(a.x) + tw.y * bfhi(c.x); y[2] = tw.x * bflo(a.y) + tw.y * bflo(c.y); y[3] = tw.x * bfhi(a.y) + tw.y * bfhi(c.y);
                v[j] = x + g * y; if (mode == 1) ((f32x4*)xr)[F.lane + 64 * j] = v[j]; }
        }
        float ss = 0.f;
#pragma unroll
        for (int j = 0; j < 4; ++j) ss += (v[j][0] * v[j][0] + v[j][1] * v[j][1]) + (v[j][2] * v[j][2] + v[j][3] * v[j][3]);
        const float rstd = 1.0f / sqrtf(wave_sum(ss) * (1.0f / D) + EPS);
        if (mode == 2) {
#pragma unroll
            for (int j = 0; j < 4; ++j) { const f32x4 g = ((const f32x4*)gain)[F.lane + 64 * j]; ((f32x4*)(F.out + (size_t)row * D))[F.lane + 64 * j] = v[j] * rstd * g; }
        } else {
            const f32x4* sh = (const f32x4*)mod_ptr(F, l, b, 0) + F.lane; const f32x4* sc = (const f32x4*)mod_ptr(F, l, b, 1) + F.lane;
            u32x2* o = (u32x2*)(H + (size_t)row * D) + F.lane;
#pragma unroll
            for (int j = 0; j < 4; ++j) { const f32x4 g = ((const f32x4*)gain)[F.lane + 64 * j]; const f32x4 h = v[j] * rstd * g * (sc[64 * j] + 1.0f) + sh[64 * j];
                u32x2 w; w.x = pk2(h[0], h[1]); w.y = pk2(h[2], h[3]); o[64 * j] = w; }
        }
    }
}

__device__ __forceinline__ void row_op_b(const Frame& F, int l) {
    const int gw = F.vcu * 8 + F.wave, NGW = F.G * 8;
    const int nrows = (l == 0) ? NTOK : NLAT;
    LAS float* wr = (LAS float*)F.lds;
    { const float* rg = F.in[I_RGW] + (size_t)l * D * 4; const float* re = F.in[I_REW] + (size_t)l * D * NE;
      for (int i = F.tid; i < 1024 * 36; i += 512) { const int k = i / 36, n = i % 36; const int ln = (k & 255) >> 2, j = k >> 8, c = k & 3;
          wr[(((j * 4 + c) * 64) + ln) * 36 + n] = n < 4 ? rg[k * 4 + n] : re[k * NE + (n - 4)]; } }
    __syncthreads();
    bf16_t* H = (bf16_t*)(F.ws + WS_H);
    const float* gain = F.in[I_N2G] + l * D;
    unsigned* cnt = (unsigned*)(F.ws + WS_CTL) + CW_CNT + l * NE * 16;
    int* list = (int*)(F.ws + WS_LIST);
    for (int row = gw; row < nrows; row += NGW) {
        const int b = row < NLAT ? (row >> 11) : 16;
        const float* xr = xa_row(F, row);
        f32x4 v[4]; float ss = 0.f;
#pragma unroll
        for (int j = 0; j < 4; ++j) { v[j] = ((const f32x4*)xr)[F.lane + 64 * j]; ss += (v[j][0] * v[j][0] + v[j][1] * v[j][1]) + (v[j][2] * v[j][2] + v[j][3] * v[j][3]); }
        const float rstd = 1.0f / sqrtf(wave_sum(ss) * (1.0f / D) + EPS);
        const f32x4* sh = (const f32x4*)mod_ptr(F, l, b, 3) + F.lane; const f32x4* sc = (const f32x4*)mod_ptr(F, l, b, 4) + F.lane;
        u32x2* o = (u32x2*)(H + (size_t)row * D) + F.lane;
        float s[36];
#pragma unroll
        for (int n = 0; n < 36; ++n) s[n] = 0.f;
#pragma unroll
        for (int j = 0; j < 4; ++j) { const f32x4 g = ((const f32x4*)gain)[F.lane + 64 * j]; const f32x4 h = v[j] * rstd * g * (sc[64 * j] + 1.0f) + sh[64 * j];
            u32x2 w; w.x = pk2(h[0], h[1]); w.y = pk2(h[2], h[3]); o[64 * j] = w;
#pragma unroll
            for (int c = 0; c < 4; ++c) { asm volatile("" ::: "memory"); const LAS f32x4* wp = (const LAS f32x4*)(wr + (((j * 4 + c) * 64) + F.lane) * 36);
#pragma unroll
                for (int q = 0; q < 9; ++q) { const f32x4 w4 = wp[q]; s[4 * q] += h[c] * w4[0]; s[4 * q + 1] += h[c] * w4[1]; s[4 * q + 2] += h[c] * w4[2]; s[4 * q + 3] += h[c] * w4[3]; } } }
#pragma unroll
        for (int n = 0; n < 36; ++n) s[n] = wave_sum(s[n]);
        const float* rgb = F.in[I_RGB] + l * 4; const float* reb = F.in[I_REB] + l * NE;
        float gl[4];
#pragma unroll
        for (int i = 0; i < 4; ++i) gl[i] = s[i] + rgb[i];
        int gt = 0; float gm = gl[0];
#pragma unroll
        for (int i = 1; i < 4; ++i) if (gl[i] > gm) { gm = gl[i]; gt = i; }
        float gs = 0.f;
#pragma unroll
        for (int i = 0; i < 4; ++i) gs += expf(gl[i] - gm);
        const float gwt = 1.0f / gs;
        float el[8];
#pragma unroll
        for (int j = 0; j < 8; ++j) { const float a = gt == 0 ? s[4 + j] : gt == 1 ? s[12 + j] : gt == 2 ? s[20 + j] : s[28 + j]; el[j] = a + reb[gt * 8 + j]; }
        int i1 = 0; float v1 = el[0];
#pragma unroll
        for (int j = 1; j < 8; ++j) if (el[j] > v1) { v1 = el[j]; i1 = j; }
        int i2 = -1; float v2 = -3.0e38f;
#pragma unroll
        for (int j = 0; j < 8; ++j) if (j != i1 && el[j] > v2) { v2 = el[j]; i2 = j; }
        const float e2 = expf(v2 - v1); const float w1 = gwt / (1.0f + e2), w2 = gwt * e2 / (1.0f + e2);
        if (F.lane == 0) {
            const int x1 = gt * 8 + i1, x2 = gt * 8 + i2;
            const int r1 = (int)__hip_atomic_fetch_add(cnt + x1 * 16, 1u, __ATOMIC_RELAXED, __HIP_MEMORY_SCOPE_AGENT);
            const int r2 = (int)__hip_atomic_fetch_add(cnt + x2 * 16, 1u, __ATOMIC_RELAXED, __HIP_MEMORY_SCOPE_AGENT);
            list[(size_t)x1 * NTOK + r1] = row; list[(size_t)x2 * NTOK + r2] = row;
            *(int4*)(F.ws + WS_TOKINFO + (size_t)row * 32) = make_int4(x1, r1, x2, r2); *(f32x2*)(F.ws + WS_TOKINFO + (size_t)row * 32 + 16) = (f32x2){w1, w2};
        }
    }
    __syncthreads();
}

__device__ __forceinline__ unsigned off_b(unsigned row, unsigned ch) { return 256u * row + 16u * (ch ^ (((row & 3) << 2) | ((row >> 2) & 3))); }
__device__ __forceinline__ unsigned tr_base(unsigned lane, unsigned t) { const unsigned g = lane >> 4, q = (lane & 15) >> 2, p = lane & 3; return off_b(8 * g + 4 * t + q, (p >> 1)) + 8 * (p & 1); }
template <int O0, int O1, int O2, int O3>
__device__ __forceinline__ void tr_frag4(bf16x8 (&f)[4], unsigned a00, unsigned a01, unsigned a10, unsigned a11, unsigned a20, unsigned a21, unsigned a30, unsigned a31) {
    s16x4 l0, h0, l1, h1, l2, h2, l3, h3;
    asm volatile("ds_read_b64_tr_b16 %0, %8 offset:%16\n\tds_read_b64_tr_b16 %1, %9 offset:%16\n\t"
                 "ds_read_b64_tr_b16 %2, %10 offset:%17\n\tds_read_b64_tr_b16 %3, %11 offset:%17\n\t"
                 "ds_read_b64_tr_b16 %4, %12 offset:%18\n\tds_read_b64_tr_b16 %5, %13 offset:%18\n\t"
                 "ds_read_b64_tr_b16 %6, %14 offset:%19\n\tds_read_b64_tr_b16 %7, %15 offset:%19\n\ts_waitcnt lgkmcnt(0)"
                 : "=&v"(l0), "=&v"(h0), "=&v"(l1), "=&v"(h1), "=&v"(l2), "=&v"(h2), "=&v"(l3), "=&v"(h3)
                 : "v"(a00), "v"(a01), "v"(a10), "v"(a11), "v"(a20), "v"(a21), "v"(a30), "v"(a31), "n"(O0), "n"(O1), "n"(O2), "n"(O3) : "memory");
    f[0] = __builtin_shufflevector(l0, h0, 0, 1, 2, 3, 4, 5, 6, 7); f[1] = __builtin_shufflevector(l1, h1, 0, 1, 2, 3, 4, 5, 6, 7);
    f[2] = __builtin_shufflevector(l2, h2, 0, 1, 2, 3, 4, 5, 6, 7); f[3] = __builtin_shufflevector(l3, h3, 0, 1, 2, 3, 4, 5, 6, 7);
}
__device__ __forceinline__ int chunk_row0(int b, int ci) { return ci < 2 ? NLAT + b * CT + ci * 128 : b * TL + (ci - 2) * 128; }
__device__ __forceinline__ float log2_gamma(float decay) { return -log1pf(expf(-decay)) * 1.4426950408889634f; }

__device__ __forceinline__ void p3a_states_pool(const Frame& F, int l) {
    const bf16_t* P = (const bf16_t*)(F.ws + WS_P);
    bf16_t* ST = (bf16_t*)(F.ws + WS_ACT);
    bf16_t* A2 = (bf16_t*)(F.ws + WS_H);
    const int nstate = (F.G > 128) ? 128 : F.G;
    if (F.bx < nstate) {
        for (int unit = F.bx; unit < 128; unit += nstate) {
            const int dir = unit & 1, bh = unit >> 1, b = bh >> 2, h = bh & 3;
            const float lg2 = log2_gamma((dir ? F.in[I_DB] : F.in[I_DF])[l * NH + h]);
            const float gC = exp2f(lg2 * 128.0f);
            f32x4 acc[8];
#pragma unroll
            for (int dt = 0; dt < 8; ++dt) acc[dt] = (f32x4){0.f, 0.f, 0.f, 0.f};
            const unsigned kimg = 0u, vimg = 32768u;
            for (int n = 0; n < NCHUNK; ++n) {
                const int ci = dir ? (n < 2 ? 1 - n : 19 - n) : n;
                { bf16_t* sp = ST + ((size_t)((bh * 2 + dir) * NCHUNK + ci) * 128 + (F.wave * 16 + (F.lane & 15))) * 128 + 4 * (F.lane >> 4);
#pragma unroll
                  for (int dt = 0; dt < 8; ++dt) { u32x2 w; w.x = pk2(acc[dt][0], acc[dt][1]); w.y = pk2(acc[dt][2], acc[dt][3]); *(u32x2*)(sp + dt * 16) = w; } }
                if (n == NCHUNK - 1) break;
                const int row0 = chunk_row0(b, ci);
#pragma unroll
                for (int q = 0; q < 4; ++q) { const int p = F.tid + 512 * q, j = p >> 4, ch = p & 15;
                    const float kd = exp2f(lg2 * (float)(dir ? j : 127 - j));
                    const u32x4 kk = *(const u32x4*)(P + (size_t)(row0 + j) * NP + 512 + h * 128 + ch * 8);
                    const u32x4 vv = *(const u32x4*)(P + (size_t)(row0 + j) * NP + 1024 + h * 128 + ch * 8);
                    u32x4 ks; ks.x = pk2(bflo(kk.x) * kd, bfhi(kk.x) * kd); ks.y = pk2(bflo(kk.y) * kd, bfhi(kk.y) * kd); ks.z = pk2(bflo(kk.z) * kd, bfhi(kk.z) * kd); ks.w = pk2(bflo(kk.w) * kd, bfhi(kk.w) * kd);
                    *(LAS u32x4*)(F.lds + kimg + off_b(j, ch)) = ks; *(LAS u32x4*)(F.lds + vimg + off_b(j, ch)) = vv; }
                __syncthreads();
#pragma unroll
                for (int dt = 0; dt < 8; ++dt) acc[dt] *= gC;
                { const unsigned lb = (unsigned)(size_t)F.lds, t0 = lb + tr_base(F.lane, 0), t1 = lb + tr_base(F.lane, 1);
                  const unsigned v0 = t0 ^ ((unsigned)F.wave << 5), v1 = t1 ^ ((unsigned)F.wave << 5);
                  bf16x8 vb[4]; tr_frag4<32768, 32768 + 8192, 32768 + 16384, 32768 + 24576>(vb, v0, v1, v0, v1, v0, v1, v0, v1);
#define P3A_KS(ks) do { bf16x8 ka[4]; \
                      tr_frag4<(ks) * 8192, (ks) * 8192, (ks) * 8192, (ks) * 8192>(ka, t0, t1, t0 ^ 32u, t1 ^ 32u, t0 ^ 64u, t1 ^ 64u, t0 ^ 96u, t1 ^ 96u); \
                      _Pragma("unroll") for (int d4 = 0; d4 < 4; ++d4) acc[d4] = __builtin_amdgcn_mfma_f32_16x16x32_bf16(ka[d4], vb[ks], acc[d4], 0, 0, 0); \
                      tr_frag4<(ks) * 8192, (ks) * 8192, (ks) * 8192, (ks) * 8192>(ka, t0 ^ 128u, t1 ^ 128u, t0 ^ 160u, t1 ^ 160u, t0 ^ 192u, t1 ^ 192u, t0 ^ 224u, t1 ^ 224u); \
                      _Pragma("unroll") for (int d4 = 0; d4 < 4; ++d4) acc[4 + d4] = __builtin_amdgcn_mfma_f32_16x16x32_bf16(ka[d4], vb[ks], acc[4 + d4], 0, 0, 0); } while (0)
                  P3A_KS(0); P3A_KS(1); P3A_KS(2); P3A_KS(3);
#undef P3A_KS
                }
                __syncthreads();
            }
        }
    } else {
        const int pb = F.bx - nstate, npb = F.G - nstate;
        for (long it = (long)pb * 512 + F.tid; it < (long)NTOK * 64; it += (long)npb * 512) {
            const int row = (int)(it >> 6), cg = (int)(it & 63), g = cg >> 4, half = 1 << g;
            int t, T, base; if (row < NLAT) { t = row & (TL - 1); T = TL; base = row - t; } else { t = (row - NLAT) & (CT - 1); T = CT; base = row - t; }
            const int lo = t - half < 0 ? 0 : t - half, hi = t + half > T ? T : t + half;
            float s[8];
#pragma unroll
            for (int i = 0; i < 8; ++i) s[i] = 0.f;
            for (int tt = lo; tt < hi; ++tt) { const u32x4 x = *(const u32x4*)(P + (size_t)(base + tt) * NP + 2048 + cg * 8);
                s[0] += bflo(x.x); s[1] += bfhi(x.x); s[2] += bflo(x.y); s[3] += bfhi(x.y); s[4] += bflo(x.z); s[5] += bfhi(x.z); s[6] += bflo(x.w); s[7] += bfhi(x.w); }
            const float inv = 1.0f / (float)(hi - lo);
            const u32x4 x = *(const u32x4*)(P + (size_t)row * NP + 2048 + cg * 8);
            u32x4 o; o.x = pk2(s[0] * inv - bflo(x.x), s[1] * inv - bfhi(x.x)); o.y = pk2(s[2] * inv - bflo(x.y), s[3] * inv - bfhi(x.y));
            o.z = pk2(s[4] * inv - bflo(x.z), s[5] * inv - bfhi(x.z)); o.w = pk2(s[6] * inv - bflo(x.w), s[7] * inv - bfhi(x.w));
            *(u32x4*)(A2 + (size_t)row * D + 512 + cg * 8) = o;
        }
    }
}

__device__ __forceinline__ void p3b_retention(const Frame& F, int l) {
    const bf16_t* P = (const bf16_t*)(F.ws + WS_P);
    const bf16_t* ST = (const bf16_t*)(F.ws + WS_ACT);
    bf16_t* A2 = (bf16_t*)(F.ws + WS_H);
    const int c_lo = (l == DEPTH - 1) ? 2 : 0, ncu = NCHUNK - c_lo, nunits = 64 * ncu;
    const unsigned kimg = 0u, pimg = 65536u + (unsigned)F.wave * 4096u;
    const int fr = F.lane & 15, fq = F.lane >> 4;
    for (int unit = F.vcu; unit < nunits; unit += F.G) {
        unsigned rr0 = off_b((unsigned)fr, (unsigned)fq), tq0 = (unsigned)(size_t)F.lds + tr_base(F.lane, 0), tq1 = (unsigned)(size_t)F.lds + tr_base(F.lane, 1);
        asm volatile("" : "+v"(rr0), "+v"(tq0), "+v"(tq1));
        const int bh = unit / ncu, ci = c_lo + unit % ncu, b = bh >> 2, h = bh & 3;
        const float lgf = log2_gamma(F.in[I_DF][l * NH + h]), lgb = log2_gamma(F.in[I_DB][l * NH + h]);
        const int row0 = chunk_row0(b, ci);
        __syncthreads();
#pragma unroll
        for (int q = 0; q < 4; ++q) { const int p = F.tid + 512 * q, j = p >> 4, ch = p & 15;
            const u32x4 kk = *(const u32x4*)(P + (size_t)(row0 + j) * NP + 512 + h * 128 + ch * 8);
            const u32x4 vv = *(const u32x4*)(P + (size_t)(row0 + j) * NP + 1024 + h * 128 + ch * 8);
            *(LAS u32x4*)(F.lds + kimg + off_b(j, ch)) = kk; *(LAS u32x4*)(F.lds + 32768u + off_b(j, ch)) = vv; }
        int il = F.wave * 16 + fr;
        asm volatile("" : "+v"(il));
        bf16x8 qf[4];
#pragma unroll
        for (int ks = 0; ks < 4; ++ks) qf[ks] = *(const bf16x8*)(P + (size_t)(row0 + il) * NP + h * 128 + ks * 32 + fq * 8);
        __syncthreads();
#pragma unroll
        for (int jt = 0; jt < 8; ++jt) {
            asm volatile("" ::: "memory");
            f32x4 sa = (f32x4){0.f, 0.f, 0.f, 0.f};
#pragma unroll
            for (int ks = 0; ks < 4; ++ks) { const bf16x8 ka = *(const LAS bf16x8*)(F.lds + kimg + ((rr0 ^ ((unsigned)ks << 6)) + 4096u * jt)); sa = __builtin_amdgcn_mfma_f32_16x16x32_bf16(ka, qf[ks], sa, 0, 0, 0); }
            float pv[4];
#pragma unroll
            for (int r = 0; r < 4; ++r) { const int j = 16 * jt + 4 * fq + r, df = il - j; const float w = df > 0 ? exp2f(lgf * (float)df) : (df < 0 ? exp2f(lgb * (float)(-df)) : 2.0f); pv[r] = sa[r] * w; }
            u32x2 w; w.x = pk2(pv[0], pv[1]); w.y = pk2(pv[2], pv[3]);
            *(LAS u32x2*)(F.lds + pimg + off_b(fr, 2 * jt + (fq >> 1)) + 8 * (fq & 1)) = w;
        }
        asm volatile("s_waitcnt lgkmcnt(0)" ::: "memory");
        bf16x8 pf[4];
#pragma unroll
        for (int ks = 0; ks < 4; ++ks) pf[ks] = *(const LAS bf16x8*)(F.lds + pimg + (rr0 ^ ((unsigned)ks << 6)));
        const bf16_t* sf = ST + ((size_t)((bh * 2 + 0) * NCHUNK + ci) * 128) * 128; const bf16_t* sb = ST + ((size_t)((bh * 2 + 1) * NCHUNK + ci) * 128) * 128;
        const float qdf = exp2f(lgf * (float)(il + 1)), qdb = exp2f(lgb * (float)(128 - il));
        float o[8][4]; float ss = 0.f;
#pragma unroll
        for (int et = 0; et < 8; ++et) {
            asm volatile("" ::: "memory");
            f32x4 ao = (f32x4){0.f, 0.f, 0.f, 0.f}, af = ao, ab = ao;
            bf16x8 va[4]; { const unsigned a0 = tq0 ^ ((unsigned)et << 5), a1 = tq1 ^ ((unsigned)et << 5);
                tr_frag4<32768, 32768 + 8192, 32768 + 16384, 32768 + 24576>(va, a0, a1, a0, a1, a0, a1, a0, a1); }
#pragma unroll
            for (int ks = 0; ks < 4; ++ks) {
                ao = __builtin_amdgcn_mfma_f32_16x16x32_bf16(va[ks], pf[ks], ao, 0, 0, 0);
                const bf16x8 fa = *(const bf16x8*)(sf + (size_t)(et * 16 + fr) * 128 + ks * 32 + fq * 8);
                af = __builtin_amdgcn_mfma_f32_16x16x32_bf16(fa, qf[ks], af, 0, 0, 0);
                const bf16x8 ba = *(const bf16x8*)(sb + (size_t)(et * 16 + fr) * 128 + ks * 32 + fq * 8);
                ab = __builtin_amdgcn_mfma_f32_16x16x32_bf16(ba, qf[ks], ab, 0, 0, 0);
            }
#pragma unroll
            for (int r = 0; r < 4; ++r) { o[et][r] = ao[r] + qdf * af[r] + qdb * ab[r]; ss += o[et][r] * o[et][r]; }
        }
        ss += __shfl_xor(ss, 16); ss += __shfl_xor(ss, 32);
        const float rstd = 1.0f / sqrtf(ss * (1.0f / 128.0f) + EPS);
        const bf16_t* gp = P + (size_t)(row0 + il) * NP + 1536 + h * 128 + 4 * fq; bf16_t* op = A2 + (size_t)(row0 + il) * D + h * 128 + 4 * fq;
#pragma unroll
        for (int et = 0; et < 8; ++et) { const u32x2 g = *(const u32x2*)(gp + et * 16);
            u32x2 w; w.x = pk2(silu_f(bflo(g.x)) * o[et][0] * rstd, silu_f(bfhi(g.x)) * o[et][1] * rstd); w.y = pk2(silu_f(bflo(g.y)) * o[et][2] * rstd, silu_f(bfhi(g.y)) * o[et][3] * rstd);
            *(u32x2*)(op + et * 16) = w; }
    }
    __syncthreads();
}

__global__ void __launch_bounds__(512, 2) fwd_kernel(Args args) {
    extern __shared__ __attribute__((aligned(16))) unsigned char lds_raw[];
    Frame F;
    F.lds = (LAS unsigned char*)lds_raw; F.tid = threadIdx.x; F.lane = F.tid & 63; F.wave = __builtin_amdgcn_readfirstlane(F.tid >> 6);
    F.G = gridDim.x; F.bx = blockIdx.x; F.vcu = (F.G % 8 == 0) ? (F.bx % 8) * (F.G / 8) + F.bx / 8 : F.bx;
    F.in = args.in; F.out = args.out; F.ws = args.ws;
    volatile LAS unsigned* MISC = (volatile LAS unsigned*)(F.lds + MISC_OFF);
    if (F.tid < 4) MISC[F.tid] = 0u;
    __syncthreads();
    unsigned* ctl = (unsigned*)(F.ws + WS_CTL);
    XcdBarrier bar; bar.bar = ctl + CW_BAR; bar.x = 0; bar.st = nullptr;
    const int lo = args.ph_lo, hi = args.ph_hi;
    const bool multi = (hi - lo) > 1;
    if (multi) bar = xcd_barrier_post(ctl + CW_BAR, MISC);
#ifndef TYPE_MASK
#define TYPE_MASK 0x3ff
#endif
#define PTYPE(k) ((k) == 0 ? 0 : ((k) == 17 ? 9 : 1 + (((k) - 1) & 7)))
#define ENTER() do { int _t = threadIdx.x; asm volatile("" : "+v"(_t)); F.tid = _t; F.lane = _t & 63; F.wave = __builtin_amdgcn_readfirstlane(_t >> 6); } while (0)
#define IN(k) (((TYPE_MASK >> PTYPE(k)) & 1) && lo <= (k) && (k) < hi)
#define SEAM(k) do { if (IN(k) && IN((k) + 1)) xcd_barrier(bar); } while (0)

    if (IN(0)) { ENTER(); p0_prologue(F); }
    SEAM(0);
    for (int l = 0; l < DEPTH; ++l) {
        const int pb = 1 + 8 * l;
        const bool last = (l == DEPTH - 1);
        const int Mrows = last ? NLAT : NTOK;
        if (IN(pb + 0)) { ENTER(); row_op_a(F, l == 0 ? 0 : 1); }
        SEAM(pb + 0);
        if (IN(pb + 1)) { ENTER();
            pg8::SchedDense S; S.init(NTOK, NP, D, F.G, F.bx);
            pg8::EpiInProj E{(bf16_t*)(F.ws + WS_P), (const float*)(F.ws + WS_ROPE), (const float*)(F.ws + WS_ROPE) + 96 * 32};
            pg8::gemm_phase<pg8::EpiInProj, pg8::SchedDense, true, true>(F.lds, F.tid, (const char*)(F.ws + WS_H), (const char*)(F.ws + WS_WIN) + (size_t)l * NP * D * 2, D, S, E);
        }
        SEAM(pb + 1);
        if (IN(pb + 2)) { ENTER(); p3a_states_pool(F, l); }
        SEAM(pb + 2);
        if (IN(pb + 3)) { ENTER(); p3b_retention(F, l); }
        SEAM(pb + 3);
        if (IN(pb + 4)) { ENTER();
            pg8::SchedDense S; S.init(Mrows, D, D, F.G, F.bx);
            pg8::EpiResid E;
            if (l == 0) { E.rl = F.in[I_X]; E.rc = F.in[I_CTX]; } else { E.rl = F.out; E.rc = (const float*)(F.ws + WS_XC); }
            E.ol = F.out; E.oc = (float*)(F.ws + WS_XC); E.gmod = mod_ptr(F, l, 0, 2);
            pg8::gemm_phase<pg8::EpiResid, pg8::SchedDense, true, true>(F.lds, F.tid, (const char*)(F.ws + WS_H), (const char*)(F.ws + WS_WOUT) + (size_t)l * D * D * 2, D, S, E);
        }
        SEAM(pb + 4);
        if (IN(pb + 5)) { ENTER(); row_op_b(F, l); }
        SEAM(pb + 5);
        if (IN(pb + 6)) { ENTER();
            LAS int* tb = build_tb(F, l);
            LAS int* tokt = (LAS int*)(F.lds + TOKT_OFF);
            const int* list = (const int*)(F.ws + WS_LIST);
            pg8::SchedGroup S; S.tb = tb; S.tokt = tokt; S.G = F.G; S.c = F.vcu; S.K = D; S.gather = 1;
            { pg8::Unit u; for (int i = 0; i < 8 && S.next(i, u); ++i) { const int g = u.pm; int e = 0; while (tb[e + 1] <= g) ++e; const int rt = g - tb[e], cnt = tb[64 + e];
                if (F.tid < 256) { int r = rt * 256 + F.tid; if (r >= cnt) r = cnt - 1; tokt[i * 256 + F.tid] = list[(size_t)e * NTOK + r]; } } }
            __syncthreads();
            pg8::EpiSwiGLU E{(bf16_t*)(F.ws + WS_ACT)};
            pg8::gemm_phase<pg8::EpiSwiGLU, pg8::SchedGroup, true, true>(F.lds, F.tid, (const char*)(F.ws + WS_H), (const char*)(F.ws + WS_WGU) + (size_t)l * NE * 1024 * D * 2, D, S, E);
        }
        SEAM(pb + 6);
        if (IN(pb + 7)) { ENTER();
            LAS int* tb = build_tb(F, l);
            pg8::SchedGroup S; S.tb = tb; S.tokt = nullptr; S.G = F.G; S.c = F.vcu; S.K = FF; S.gather = 0;
            pg8::EpiBf16 E{(bf16_t*)(F.ws + WS_P), D};
            pg8::gemm_phase<pg8::EpiBf16, pg8::SchedGroup, true, true>(F.lds, F.tid, (const char*)(F.ws + WS_ACT), (const char*)(F.ws + WS_WD) + (size_t)l * NE * D * FF * 2, FF, S, E);
        }
        SEAM(pb + 7);
    }
    if (IN(17)) { ENTER(); row_op_a(F, 2); }
#undef IN
#undef SEAM
}

extern "C" void kernel_launch(void* const* d_in, const int* in_sizes, int n_in, void* d_out, int out_size, void* d_ws, size_t ws_size, hipStream_t stream) {
    static int grid = 0;
    if (grid == 0) {
        if (n_in != 22 || out_size != NLAT * D || ws_size < WS_END) { fprintf(stderr, "kernel_launch: unexpected shapes (n_in %d, out %d, ws %zu)\n", n_in, out_size, ws_size); grid = -1; return; }
        int dev = 0, cus = 0, per_cu = 0;
        if (hipGetDevice(&dev) != hipSuccess || hipDeviceGetAttribute(&cus, hipDeviceAttributeMultiprocessorCount, dev) != hipSuccess) { grid = -1; return; }
        if (hipFuncSetAttribute((const void*)fwd_kernel, hipFuncAttributeMaxDynamicSharedMemorySize, LDS_BYTES) != hipSuccess) { fprintf(stderr, "kernel_launch: hipFuncSetAttribute failed\n"); grid = -1; return; }
        if (hipOccupancyMaxActiveBlocksPerMultiprocessor(&per_cu, (const void*)fwd_kernel, 512, LDS_BYTES) != hipSuccess || per_cu < 1) { fprintf(stderr, "kernel_launch: occupancy query says %d\n", per_cu); }
        (void)hipGetLastError();
        grid = cus;
    }
    if (grid < 0) return;
    (void)hipMemsetAsync((char*)d_ws + WS_CTL, 0, CTL_ZERO_BYTES, stream);
    Args a{};
    for (int i = 0; i < 22; ++i) a.in[i] = (const float*)d_in[i];
    a.out = (float*)d_out; a.ws = (unsigned char*)d_ws;
    if (MK_N_LAUNCHES == 1) { a.ph_lo = 0; a.ph_hi = N_PHASES; hipLaunchKernelGGL(fwd_kernel, dim3(grid), dim3(512), LDS_BYTES, stream, a); }
    else { for (int p = 0; p < N_PHASES; ++p) { a.ph_lo = p; a.ph_hi = p + 1; hipLaunchKernelGGL(fwd_kernel, dim3(grid), dim3(512), LDS_BYTES, stream, a); } }
}
```

```cpp
#include <hip/hip_runtime.h>
#include <cstdio>
#include <cstdint>

#ifndef MK_N_LAUNCHES
#define MK_N_LAUNCHES 1
#endif

#ifndef PROBE_REPEAT
#define PROBE_REPEAT -1
#endif
#define LAS __attribute__((address_space(3)))
#define GAS __attribute__((address_space(1)))
typedef unsigned short bf16_t;
typedef short bf16x8 __attribute__((ext_vector_type(8)));
typedef short s16x4 __attribute__((ext_vector_type(4)));
typedef float f32x4 __attribute__((ext_vector_type(4)));
typedef float f32x2 __attribute__((ext_vector_type(2)));
typedef unsigned u32x4 __attribute__((ext_vector_type(4)));
typedef unsigned u32x2 __attribute__((ext_vector_type(2)));

constexpr int Bn = 16, TL = 2048, CT = 256, D = 1024, DEPTH = 2;
constexpr int NLAT = Bn * TL, NCTX = Bn * CT, NTOK = NLAT + NCTX;
constexpr int NP = 2560;
constexpr int NE = 32, FF = 512, NH = 4, HD = 128;
constexpr int NCHUNK = 18;
constexpr float EPS = 1e-6f;
constexpr int MAXTILES = 320;
constexpr int N_PHASES = 18;

constexpr size_t MiB = 1u << 20;
constexpr size_t WS_CTL = 0, CTL_ZERO_BYTES = 1 * MiB;
constexpr size_t WS_MOD = 1 * MiB;
constexpr size_t WS_ROPE = 2 * MiB;
constexpr size_t WS_TOKINFO = 3 * MiB;
constexpr size_t WS_LIST = 5 * MiB;
constexpr size_t WS_WIN = 10 * MiB;
constexpr size_t WS_WOUT = 20 * MiB;
constexpr size_t WS_WGU = 24 * MiB;
constexpr size_t WS_WD = 152 * MiB;
constexpr size_t WS_XC = 216 * MiB;
constexpr size_t WS_H = 232 * MiB;
constexpr size_t WS_P = 304 * MiB;
constexpr size_t WS_ACT = 484 * MiB;
constexpr size_t WS_END = 564 * MiB;
constexpr int CW_TMO = 0;
constexpr int CW_QUEUE = 512;
constexpr int CW_CNT = 1024;
constexpr int CW_BAR = 4096;

constexpr int RING_BYTES = 131072;
constexpr int TOKT_OFF = RING_BYTES;
constexpr int MISC_OFF = 161792;
constexpr int RW_PITCH = 2064;
constexpr int RW_LO = 36 * RW_PITCH, RW_EX = 2 * 36 * RW_PITCH;
constexpr int LDS_BYTES = 163840;

__device__ __forceinline__ unsigned f2bf(float f) { unsigned u = __builtin_bit_cast(unsigned, f); return (u + 0x7fffu + ((u >> 16) & 1u)) >> 16; }
__device__ __forceinline__ unsigned pk2(float lo, float hi) { return f2bf(lo) | (f2bf(hi) << 16); }
__device__ __forceinline__ float bflo(unsigned w) { return __builtin_bit_cast(float, w << 16); }
__device__ __forceinline__ float bfhi(unsigned w) { return __builtin_bit_cast(float, w & 0xffff0000u); }
__device__ __forceinline__ float wave_sum(float v) {
#pragma unroll
    for (int o = 1; o < 64; o <<= 1) v += __shfl_xor(v, o);
    return v;
}
__device__ __forceinline__ float silu_f(float x) { return x / (1.0f + __expf(-x)); }

#define XB_TMO      128
#define XB_XCNT(j)  (256  + 64 * (j))
#define XB_XSUB(j)  (1280 + 64 * (j))
#define XB_XGEN(j)  (2304 + 64 * (j))
#define XB_TOP      3328
#define XB_TOPGEN   3392
#define XCD_BAR_WORDS 3456
#define XB_SPIN_CAP (1u << 18)
__device__ __forceinline__ unsigned xb_ld(unsigned* p)              { return __hip_atomic_load(p, __ATOMIC_RELAXED, __HIP_MEMORY_SCOPE_AGENT); }
__device__ __forceinline__ unsigned xb_add(unsigned* p, unsigned v) { return __hip_atomic_fetch_add(p, v, __ATOMIC_RELAXED, __HIP_MEMORY_SCOPE_AGENT); }
__device__ __forceinline__ unsigned xb_xcc_id() { return (unsigned)__builtin_amdgcn_s_getreg((3 << 11) | 20) & 0xFu; }
#define XB_SPIN(cond, bar) do { unsigned _sp = 0; while (cond) { __builtin_amdgcn_s_sleep(1); \
    if ((++_sp & 255u) == 0u) { if (xb_ld(&(bar)[XB_TMO])) break; if (_sp > XB_SPIN_CAP) { atomicAdd(&(bar)[XB_TMO], 1u); break; } } } } while (0)
struct XcdBarrier { unsigned* bar; unsigned x; volatile LAS unsigned* st; };
__device__ __forceinline__ XcdBarrier xcd_barrier_post(unsigned* bar, volatile LAS unsigned* st) {
    XcdBarrier b; b.bar = bar; b.x = xb_xcc_id(); b.st = st;
    if (threadIdx.x == 0) (void)xb_add(&bar[XB_XCNT(b.x)], 1u);
    return b;
}
__device__ __forceinline__ void xcd_barrier_complete(unsigned* bar, unsigned x, unsigned& nloc, unsigned& nx) {
    const unsigned G = gridDim.x * gridDim.y * gridDim.z;
    unsigned sum, cnt, mine, sp = 0u;
    for (;;) {
        sum = 0u; cnt = 0u; mine = 0u;
#pragma unroll
        for (unsigned j = 0; j < 16; ++j) { const unsigned c = xb_ld(&bar[XB_XCNT(j)]); sum += c; cnt += (c > 0u) ? 1u : 0u; mine = (j == x) ? c : mine; }
        if (sum == G) break;
        __builtin_amdgcn_s_sleep(1);
        if ((++sp & 255u) == 0u) { if (xb_ld(&bar[XB_TMO])) break; if (sp > XB_SPIN_CAP) { atomicAdd(&bar[XB_TMO], 1u); break; } }
    }
    nloc = mine > 0u ? mine : 1u; nx = cnt > 0u ? cnt : 1u;
}
__device__ __forceinline__ void xcd_barrier(const XcdBarrier& b) {
    asm volatile("s_waitcnt vmcnt(0)" ::: "memory");
    __syncthreads();
    if (threadIdx.x == 0) {
        unsigned* bar = b.bar;
        __builtin_amdgcn_s_waitcnt(0);
        unsigned nloc = b.st[0], nx = b.st[1];
        if (nloc == 0u) { xcd_barrier_complete(bar, b.x, nloc, nx); b.st[0] = nloc; b.st[1] = nx; }
        const unsigned old = xb_add(&bar[XB_XSUB(b.x)], 1u);
        const unsigned gen = old / nloc;
        if (old + 1u == (gen + 1u) * nloc) {
            __builtin_amdgcn_fence(__ATOMIC_RELEASE, "agent");
            asm volatile("s_waitcnt vmcnt(0)" ::: "memory");
            const unsigned og = xb_add(&bar[XB_TOP], 1u);
            const unsigned tg = og / nx;
            if (og + 1u == (tg + 1u) * nx) xb_add(&bar[XB_TOPGEN], 1u);
            else XB_SPIN(xb_ld(&bar[XB_TOPGEN]) == tg, bar);
            __builtin_amdgcn_fence(__ATOMIC_ACQUIRE, "agent");
            xb_add(&bar[XB_XGEN(b.x)], 1u);
            asm volatile("s_waitcnt vmcnt(0)" ::: "memory");
        } else {
            XB_SPIN(xb_ld(&bar[XB_XGEN(b.x)]) == gen, bar);
            __builtin_amdgcn_fence(__ATOMIC_ACQUIRE, "agent");
            asm volatile("s_waitcnt vmcnt(0)" ::: "memory");
        }
    }
    __syncthreads();
}

namespace pg8 {
constexpr int BM = 256, BK = 64, HALF = 128, HTB = HALF * BK * 2, STAGE_BYTES = 8 * HTB, NXCD = 8, WGM = 8;
__device__ __forceinline__ int lds_byte(int r, int c) { const int st = (r >> 4) * 2 + (c >> 5), rr = r & 15, cc = c & 31, ob = rr * 64 + cc * 2; return st * 1024 + (ob ^ (((ob >> 9) & 1) << 5)); }
__device__ __forceinline__ void stage_rc(int b, int& R, int& C) { const int st = b / 1024, sb = b % 1024, swz = sb ^ (((sb >> 9) & 1) << 5); R = (st >> 1) * 16 + swz / 64; C = (st & 1) * 32 + (swz % 64) / 2; }
__device__ __forceinline__ int perm32(int rho) { const int n = rho >> 4, i = rho & 15; return 8 * (i >> 2) + 4 * n + (i & 3); }

struct Unit { int pm, pn; unsigned bofs; int aux; };

struct SchedDense {
    int nM, nN, nwg, G, c, K;
    __device__ void init(int M, int N, int K_, int G_, int c_) { nM = M / BM; nN = N / BM; nwg = nM * nN; G = G_; c = c_; K = K_; }
    __device__ bool next(int i, Unit& u) const {
        const long L = (long)i * G + c; if (L >= nwg) return false;
        int wgid = (int)L; { const int q = nwg / NXCD, r = nwg % NXCD, xcd = wgid % NXCD, off = wgid / NXCD; wgid = (xcd < r ? xcd * (q + 1) : r * (q + 1) + (xcd - r) * q) + off; }
        const int nig = WGM * nN, gid = wgid / nig, fm = gid * WGM, gsz = (nM - fm) < WGM ? (nM - fm) : WGM;
        u.pm = fm + ((wgid % nig) % gsz); u.pn = (wgid % nig) / gsz; u.bofs = (unsigned)u.pn * (unsigned)(BM * K * 2); u.aux = 0; return true;
    }
    __device__ __forceinline__ unsigned a_row(const Unit& u, int r) const { return (unsigned)(u.pm * BM + r); }
};
struct SchedGroup {
    const LAS int* tb; const LAS int* tokt; int G, c, K, gather;
    __device__ bool next(int i, Unit& u) const {
        const int L = i * G + c, nt = tb[NE]; if (L >= nt * 4) return false;
        const int g = L >> 2; int e = 0; while (tb[e + 1] <= g) ++e;
        u.pm = g; u.pn = L & 3; u.bofs = (unsigned)(e * 1024 + u.pn * BM) * (unsigned)(K * 2); u.aux = i; return true;
    }
    __device__ __forceinline__ unsigned a_row(const Unit& u, int r) const { return gather ? (unsigned)tokt[u.aux * 256 + r] : (unsigned)(u.pm * BM + r); }
};

__device__ __forceinline__ unsigned cvt_pk_bf16(float lo, float hi) { unsigned r; asm volatile("v_cvt_pk_bf16_f32 %0, %1, %2" : "=v"(r) : "v"(lo), "v"(hi)); return r; }

template <class Epi, class Sched, bool ALIGN_EPI, bool SP2>
__device__ __forceinline__ void gemm_phase(LAS unsigned char* lds, const int tid, const char* Abase, const char* Bbase, const int K, const Sched& S, const Epi& E) {
    const int wid = __builtin_amdgcn_readfirstlane(tid >> 6), lane = tid & 63, wr = wid >> 2, wc = wid & 3, fr = lane & 15, fq = lane >> 4;
    const int nt = K / BK;
    int Rr[2], Cc[2]; unsigned voffB[2];
#pragma unroll
    for (int i = 0; i < 2; ++i) { int R, C; stage_rc(tid * 16 + i * 8192, R, C); const int Rb = Epi::PERM ? ((R & ~31) + perm32(R & 31)) : R;
        Rr[i] = R; Cc[i] = C; voffB[i] = (unsigned)(Rb * K + C) * 2u; }
    const size_t kstep = (size_t)(BK * 2);
    const size_t hstep = (size_t)HALF * K * 2;
    const unsigned ldsw = (unsigned)wid * 1024u;
    const int aoff = lds_byte(wr * 64 + fr, fq * 8), boff = lds_byte(wc * 32 + fr, fq * 8);
#define PG8_SA(b, h) (((b) * 2 + (h)) * HTB)
#define PG8_SB(b, h) ((4 + (b) * 2 + (h)) * HTB)
#define PG8_STAGE(bufoff, gbase, voff) do { _Pragma("unroll") for (int _i = 0; _i < 2; ++_i) \
        __builtin_amdgcn_global_load_lds((const unsigned*)((const char*)(gbase) + (voff)[_i]), (LAS unsigned*)(lds + (bufoff) + ldsw + _i * 8192), 16, 0, 0); } while (0)
#define PG8_LDA(dst, b, h) do { _Pragma("unroll") for (int m = 0; m < 4; ++m) _Pragma("unroll") for (int k = 0; k < 2; ++k) dst[m][k] = *(const LAS bf16x8*)(lds + PG8_SA(b, h) + aoff + m * 2048 + k * 1024); } while (0)
#define PG8_LDB(dst, b, h) do { _Pragma("unroll") for (int n = 0; n < 2; ++n) _Pragma("unroll") for (int k = 0; k < 2; ++k) dst[n][k] = *(const LAS bf16x8*)(lds + PG8_SB(b, h) + boff + n * 2048 + k * 1024); } while (0)
#define PG8_MMA(ai, bj, At, Bt) do { __builtin_amdgcn_s_setprio(1); _Pragma("unroll") for (int m = 0; m < 4; ++m) _Pragma("unroll") for (int n = 0; n < 2; ++n) _Pragma("unroll") for (int k = 0; k < 2; ++k) \
        acc[ai][bj][m][n] = __builtin_amdgcn_mfma_f32_16x16x32_bf16(Bt[n][k], At[m][k], acc[ai][bj][m][n], 0, 0, 0); __builtin_amdgcn_s_setprio(0); } while (0)
#define PG8_WAIT_V(n) asm volatile("s_waitcnt vmcnt(" #n ")" ::: "memory")
#define PG8_WAIT_L(n) asm volatile("s_waitcnt lgkmcnt(" #n ")" ::: "memory")
#define PG8_BAR __builtin_amdgcn_s_barrier()
#define PG8_SCHED __builtin_amdgcn_sched_barrier(0)
#define PG8_AOFF(dst, u) do { _Pragma("unroll") for (int _h = 0; _h < 2; ++_h) _Pragma("unroll") for (int _i = 0; _i < 2; ++_i) \
        dst[_h][_i] = (S.a_row(u, _h * HALF + Rr[_i]) * (unsigned)K + (unsigned)Cc[_i]) * 2u; } while (0)
    Unit cur, nxt; int ui = 0;
    if (!S.next(0, cur)) return;
    f32x4 acc[2][2][4][2];
#pragma unroll
    for (int a = 0; a < 2; ++a)
#pragma unroll
        for (int b = 0; b < 2; ++b)
#pragma unroll
            for (int m = 0; m < 4; ++m)
#pragma unroll
                for (int n = 0; n < 2; ++n) acc[a][b][m][n] = (f32x4){0.f, 0.f, 0.f, 0.f};
    bf16x8 At[4][2], B0[2][2], B1[2][2];
    unsigned co[2][2], no[2][2];
    PG8_AOFF(co, cur);
    const char* cB = Bbase + cur.bofs;
    if constexpr (SP2) {
        PG8_STAGE(PG8_SB(0, 0), cB, voffB); PG8_STAGE(PG8_SB(0, 1), cB + hstep, voffB); PG8_STAGE(PG8_SA(0, 0), Abase, co[0]); PG8_STAGE(PG8_SA(0, 1), Abase, co[1]);
        if (wr == 1) PG8_BAR;
        PG8_WAIT_V(2); PG8_BAR;
        PG8_STAGE(PG8_SB(1, 0), cB + kstep, voffB); PG8_STAGE(PG8_SA(1, 0), Abase + kstep, co[0]); PG8_STAGE(PG8_SB(1, 1), cB + hstep + kstep, voffB);
        PG8_WAIT_V(6); PG8_BAR;
    } else {
        PG8_STAGE(PG8_SB(0, 0), cB, voffB); PG8_STAGE(PG8_SA(0, 0), Abase, co[0]); PG8_STAGE(PG8_SB(0, 1), cB + hstep, voffB); PG8_STAGE(PG8_SA(0, 1), Abase, co[1]);
        if (wr == 1) PG8_BAR;
        PG8_WAIT_V(4); PG8_BAR;
        PG8_STAGE(PG8_SB(1, 0), cB + kstep, voffB); PG8_STAGE(PG8_SA(1, 0), Abase + kstep, co[0]); PG8_STAGE(PG8_SB(1, 1), cB + hstep + kstep, voffB);
        PG8_WAIT_V(6); PG8_BAR;
    }
    for (;;) {
        const bool has_next = S.next(ui + 1, nxt);
        const char* nB = has_next ? Bbase + nxt.bofs : cB;
        if (has_next) { PG8_AOFF(no, nxt); } else {
#pragma unroll
            for (int h = 0; h < 2; ++h)
#pragma unroll
                for (int i = 0; i < 2; ++i) no[h][i] = co[h][i]; }
        for (int t = 0; t < nt; t += 2) {
            const bool last = (t == nt - 2);
            const char* a1 = Abase + (size_t)(t + 1) * kstep;
            const char* a2 = last ? Abase : Abase + (size_t)(t + 2) * kstep; const char* b2 = last ? nB : cB + (size_t)(t + 2) * kstep;
            const char* a3 = a2 + kstep; const char* b3 = b2 + kstep;
            unsigned o2[2][2];
#pragma unroll
            for (int h = 0; h < 2; ++h)
#pragma unroll
                for (int i = 0; i < 2; ++i) o2[h][i] = last ? no[h][i] : co[h][i];
            if constexpr (SP2) {
            PG8_LDB(B0, 0, 0); PG8_LDB(B1, 0, 1); PG8_SCHED; PG8_LDA(At, 0, 0); PG8_STAGE(PG8_SA(1, 1), a1, co[1]);
            PG8_WAIT_V(8); PG8_WAIT_L(0); PG8_BAR; PG8_MMA(0, 0, At, B0); PG8_MMA(0, 1, At, B1); PG8_BAR; PG8_SCHED;
            PG8_LDA(At, 0, 1); PG8_STAGE(PG8_SB(0, 0), b2, voffB); PG8_STAGE(PG8_SB(0, 1), b2 + hstep, voffB); PG8_STAGE(PG8_SA(0, 0), a2, o2[0]);
            PG8_WAIT_V(8); PG8_WAIT_L(0); PG8_BAR; PG8_MMA(1, 0, At, B0); PG8_MMA(1, 1, At, B1); PG8_BAR; PG8_SCHED;
            PG8_LDB(B0, 1, 0); PG8_LDB(B1, 1, 1); PG8_SCHED; PG8_LDA(At, 1, 0); PG8_STAGE(PG8_SA(0, 1), a2, o2[1]);
            PG8_WAIT_V(8); PG8_WAIT_L(0); PG8_BAR; PG8_MMA(0, 0, At, B0); PG8_MMA(0, 1, At, B1); PG8_BAR; PG8_SCHED;
            PG8_LDA(At, 1, 1); PG8_STAGE(PG8_SB(1, 0), b3, voffB); PG8_STAGE(PG8_SB(1, 1), b3 + hstep, voffB); PG8_STAGE(PG8_SA(1, 0), a3, o2[0]);
            PG8_WAIT_V(8); PG8_WAIT_L(0); PG8_BAR; PG8_MMA(1, 0, At, B0); PG8_MMA(1, 1, At, B1); PG8_BAR; PG8_SCHED;
            } else {
            PG8_LDB(B0, 0, 0); PG8_SCHED; PG8_LDA(At, 0, 0); PG8_STAGE(PG8_SA(1, 1), a1, co[1]);
            PG8_WAIT_L(8); PG8_BAR; PG8_WAIT_L(0); PG8_MMA(0, 0, At, B0); PG8_BAR; PG8_SCHED;
            PG8_LDB(B1, 0, 1); PG8_STAGE(PG8_SB(0, 0), b2, voffB);
            PG8_BAR; PG8_WAIT_L(0); PG8_MMA(0, 1, At, B1); PG8_BAR;
            PG8_LDA(At, 0, 1); PG8_STAGE(PG8_SA(0, 0), a2, o2[0]);
            PG8_BAR; PG8_WAIT_L(0); PG8_MMA(1, 0, At, B0); PG8_BAR; PG8_SCHED;
            PG8_STAGE(PG8_SB(0, 1), b2 + hstep, voffB);
            PG8_WAIT_V(6); PG8_BAR; PG8_MMA(1, 1, At, B1); PG8_BAR;
            PG8_LDB(B0, 1, 0); PG8_SCHED; PG8_LDA(At, 1, 0); PG8_STAGE(PG8_SA(0, 1), a2, o2[1]);
            PG8_WAIT_L(8); PG8_BAR; PG8_WAIT_L(0); PG8_MMA(0, 0, At, B0); PG8_BAR; PG8_SCHED;
            PG8_LDB(B1, 1, 1); PG8_STAGE(PG8_SB(1, 0), b3, voffB);
            PG8_BAR; PG8_WAIT_L(0); PG8_MMA(0, 1, At, B1); PG8_BAR;
            PG8_LDA(At, 1, 1); PG8_STAGE(PG8_SA(1, 0), a3, o2[0]);
            PG8_BAR; PG8_WAIT_L(0); PG8_MMA(1, 0, At, B0); PG8_BAR; PG8_SCHED;
            PG8_STAGE(PG8_SB(1, 1), b3 + hstep, voffB);
            PG8_WAIT_V(6); PG8_BAR; PG8_MMA(1, 1, At, B1); PG8_BAR;
            }
        }
        if constexpr (ALIGN_EPI) { if (wr == 0) PG8_BAR; }
        E(acc, cur, wr, wc, fr, fq);
        if (!has_next) break;
#pragma unroll
        for (int a = 0; a < 2; ++a)
#pragma unroll
            for (int b = 0; b < 2; ++b)
#pragma unroll
                for (int m = 0; m < 4; ++m)
#pragma unroll
                    for (int n = 0; n < 2; ++n) acc[a][b][m][n] = (f32x4){0.f, 0.f, 0.f, 0.f};
        cur = nxt; cB = nB; ++ui;
#pragma unroll
        for (int h = 0; h < 2; ++h)
#pragma unroll
            for (int i = 0; i < 2; ++i) co[h][i] = no[h][i];
        if constexpr (ALIGN_EPI) { if (wr == 1) PG8_BAR; }
    }
    PG8_WAIT_V(0);
    if constexpr (!ALIGN_EPI) { if (wr == 0) PG8_BAR; }
    PG8_BAR;
#undef PG8_SA
#undef PG8_SB
#undef PG8_STAGE
#undef PG8_LDA
#undef PG8_LDB
#undef PG8_MMA
#undef PG8_WAIT_V
#undef PG8_WAIT_L
#undef PG8_BAR
#undef PG8_SCHED
#undef PG8_AOFF
}

struct EpiInProj {
    static constexpr bool PERM = true;
    bf16_t* P; const float* ropeC; const float* ropeS;
    __device__ __forceinline__ void operator()(const f32x4 (&acc)[2][2][4][2], const Unit& u, int wr, int wc, int fr, int fq) const {
        const int row0 = u.pm * BM + wr * 64 + fr, col0 = u.pn * BM + wc * 32 + 8 * fq;
        const bool qk = u.pn < 4, rope = qk && (u.pm < NLAT / BM);
        const float ks = (u.pn >= 2 && u.pn < 4) ? 0.08838834764831845f : 1.0f;
        const int sec = wc >> 1, i0 = (wc & 1) * 16 + 4 * fq;
#pragma unroll
        for (int ai = 0; ai < 2; ++ai)
#pragma unroll
            for (int m = 0; m < 4; ++m) {
                const int row = row0 + ai * HALF + m * 16;
                asm volatile("" ::: "memory");
                f32x4 c4 = (f32x4){1.f, 1.f, 1.f, 1.f}, s4 = (f32x4){0.f, 0.f, 0.f, 0.f};
                if (rope) { const int t = row & (TL - 1), pos = sec ? (t & 63) : (t >> 6); const int ti = (sec ? 1024 : 0) + pos * 32 + i0;
                    c4 = *(const f32x4*)(ropeC + ti); s4 = *(const f32x4*)(ropeS + ti); }
                bf16_t* rowp = P + (size_t)row * NP + col0;
#pragma unroll
                for (int bj = 0; bj < 2; ++bj) {
                    f32x4 v0 = acc[ai][bj][m][0], v1 = acc[ai][bj][m][1];
                    if (qk) {
                        const float a0 = v0[0] * c4[0] - v0[1] * s4[0], b0 = v0[0] * s4[0] + v0[1] * c4[0];
                        const float a1 = v0[2] * c4[1] - v0[3] * s4[1], b1 = v0[2] * s4[1] + v0[3] * c4[1];
                        const float a2 = v1[0] * c4[2] - v1[1] * s4[2], b2 = v1[0] * s4[2] + v1[1] * c4[2];
                        const float a3 = v1[2] * c4[3] - v1[3] * s4[3], b3 = v1[2] * s4[3] + v1[3] * c4[3];
                        v0 = (f32x4){a0 * ks, b0 * ks, a1 * ks, b1 * ks}; v1 = (f32x4){a2 * ks, b2 * ks, a3 * ks, b3 * ks};
                    }
                    u32x4 w; w.x = cvt_pk_bf16(v0[0], v0[1]); w.y = cvt_pk_bf16(v0[2], v0[3]); w.z = cvt_pk_bf16(v1[0], v1[1]); w.w = cvt_pk_bf16(v1[2], v1[3]);
                    *(u32x4*)(rowp + bj * HALF) = w;
                }
            }
    }
};
struct EpiResid {
    static constexpr bool PERM = false;
    const float* rl; const float* rc; float* ol; float* oc; const float* gmod;
    __device__ __forceinline__ void operator()(const f32x4 (&acc)[2][2][4][2], const Unit& u, int wr, int wc, int fr, int fq) const {
        const int row0 = u.pm * BM + wr * 64 + fr, col0 = u.pn * BM + wc * 32 + 4 * fq;
        const bool lat = u.pm < NLAT / BM; const int b = lat ? (u.pm >> 3) : 16;
        const float* rbase = lat ? rl : rc - (size_t)NLAT * D; float* obase = lat ? ol : oc - (size_t)NLAT * D;
        f32x4 gv[2][2];
#pragma unroll
        for (int bj = 0; bj < 2; ++bj)
#pragma unroll
            for (int n = 0; n < 2; ++n) gv[bj][n] = *(const f32x4*)(gmod + (size_t)b * 6 * D + col0 + bj * HALF + n * 16);
#pragma unroll
        for (int ai = 0; ai < 2; ++ai)
#pragma unroll
            for (int m = 0; m < 4; ++m) { const size_t off = (size_t)(row0 + ai * HALF + m * 16) * D + col0;
#pragma unroll
                for (int bj = 0; bj < 2; ++bj)
#pragma unroll
                    for (int n = 0; n < 2; ++n) { const f32x4 r = *(const f32x4*)(rbase + off + bj * HALF + n * 16);
                        *(f32x4*)(obase + off + bj * HALF + n * 16) = r + gv[bj][n] * acc[ai][bj][m][n]; }
                if (m & 1) asm volatile("" ::: "memory"); }
    }
};
struct EpiSwiGLU {
    static constexpr bool PERM = true;
    bf16_t* O;
    __device__ __forceinline__ void operator()(const f32x4 (&acc)[2][2][4][2], const Unit& u, int wr, int wc, int fr, int fq) const {
        const int row0 = u.pm * BM + wr * 64 + fr, col0 = u.pn * 128 + wc * 16 + 4 * fq;
#pragma unroll
        for (int ai = 0; ai < 2; ++ai)
#pragma unroll
            for (int m = 0; m < 4; ++m) { bf16_t* rowp = O + (size_t)(row0 + ai * HALF + m * 16) * FF + col0;
#pragma unroll
                for (int bj = 0; bj < 2; ++bj) { const f32x4 g = acc[ai][bj][m][0], up = acc[ai][bj][m][1];
                    u32x2 w; w.x = cvt_pk_bf16(silu_f(g[0]) * up[0], silu_f(g[1]) * up[1]); w.y = cvt_pk_bf16(silu_f(g[2]) * up[2], silu_f(g[3]) * up[3]);
                    *(u32x2*)(rowp + bj * 64) = w; } }
    }
};
struct EpiBf16 {
    static constexpr bool PERM = true;
    bf16_t* O; int ldc;
    __device__ __forceinline__ void operator()(const f32x4 (&acc)[2][2][4][2], const Unit& u, int wr, int wc, int fr, int fq) const {
        const int row0 = u.pm * BM + wr * 64 + fr, col0 = u.pn * BM + wc * 32 + 8 * fq;
#pragma unroll
        for (int ai = 0; ai < 2; ++ai)
#pragma unroll
            for (int m = 0; m < 4; ++m) { bf16_t* rowp = O + (size_t)(row0 + ai * HALF + m * 16) * ldc + col0;
#pragma unroll
                for (int bj = 0; bj < 2; ++bj) { const f32x4 v0 = acc[ai][bj][m][0], v1 = acc[ai][bj][m][1];
                    u32x4 w; w.x = cvt_pk_bf16(v0[0], v0[1]); w.y = cvt_pk_bf16(v0[2], v0[3]); w.z = cvt_pk_bf16(v1[0], v1[1]); w.w = cvt_pk_bf16(v1[2], v1[3]);
                    *(u32x4*)(rowp + bj * HALF) = w; } }
    }
};
}

struct Args { const float* in[22]; float* out; unsigned char* ws; int ph_lo, ph_hi; };
enum { I_X = 0, I_C, I_CTX, I_CCTX, I_ADAW, I_ADAB, I_N1G, I_WIN, I_DF, I_DB, I_POOLW, I_POOLS, I_WOUT, I_N2G, I_RGW, I_RGB, I_REW, I_REB, I_WG, I_WU, I_WDN, I_FNG };

struct Frame {
    LAS unsigned char* lds; int tid, lane, wave, G, bx, vcu;
    const float* const* in; float* out; unsigned char* ws;
};
__device__ __forceinline__ float* xa_row(const Frame& F, int row) { return row < NLAT ? F.out + (size_t)row * D : (float*)(F.ws + WS_XC) + (size_t)(row - NLAT) * D; }
__device__ __forceinline__ const float* mod_ptr(const Frame& F, int l, int b, int which) { return (const float*)(F.ws + WS_MOD) + ((size_t)(l * 17 + b) * 6 + which) * D; }

__device__ __forceinline__ void tr_item(const float* colp, size_t ldw, int k0, bf16_t* WT, int K, int n0, LAS float* scr, int lane) {
#pragma unroll
    for (int hb = 0; hb < 2; ++hb) { float v[16];
#pragma unroll
        for (int i = 0; i < 16; ++i) v[i] = colp[(size_t)(k0 + 2 * (hb * 16 + i) + (lane >> 5)) * ldw];
#pragma unroll
        for (int i = 0; i < 16; ++i) scr[(2 * (hb * 16 + i) + (lane >> 5)) * 33 + (lane & 31)] = v[i]; }
    asm volatile("s_waitcnt lgkmcnt(0)" ::: "memory");
    const int c = lane & 7;
#pragma unroll
    for (int j = 0; j < 4; ++j) { const int n = (lane >> 3) + 8 * j; const LAS float* s = scr + (8 * c) * 33 + n;
        u32x4 o; o.x = pk2(s[0 * 33], s[1 * 33]); o.y = pk2(s[2 * 33], s[3 * 33]); o.z = pk2(s[4 * 33], s[5 * 33]); o.w = pk2(s[6 * 33], s[7 * 33]);
        *(u32x4*)(WT + (size_t)(n0 + n) * K + k0 + 8 * c) = o; }
    asm volatile("s_waitcnt lgkmcnt(0)" ::: "memory");
}
__device__ __forceinline__ void fold_item(const float* win, const float* pw, const float* ps, int k0, bf16_t* WT, int n0, LAS float* scr, int lane) {
    const int n = n0 + (lane & 31), g = n >> 7, nn = n & 127;
    const float* pwc = pw + (size_t)g * 128 * 128 + nn; const float sc = ps[n];
    float acc[32];
#pragma unroll
    for (int i = 0; i < 32; ++i) acc[i] = 0.f;
    for (int hc = 0; hc < 8; ++hc) {
        float pc[16];
#pragma unroll
        for (int c = 0; c < 16; ++c) pc[c] = pwc[(size_t)(hc * 16 + c) * 128];
#pragma unroll
        for (int i = 0; i < 32; ++i) { const f32x4* wr = (const f32x4*)(win + (size_t)(k0 + 2 * i + (lane >> 5)) * NP + 2048 + g * 128 + hc * 16);
            float a = acc[i];
#pragma unroll
            for (int c4 = 0; c4 < 4; ++c4) { const f32x4 w = wr[c4]; a += w[0] * pc[4 * c4] + w[1] * pc[4 * c4 + 1] + w[2] * pc[4 * c4 + 2] + w[3] * pc[4 * c4 + 3]; }
            acc[i] = a; }
    }
#pragma unroll
    for (int i = 0; i < 32; ++i) scr[(2 * i + (lane >> 5)) * 33 + (lane & 31)] = acc[i] * sc;
    asm volatile("s_waitcnt lgkmcnt(0)" ::: "memory");
    const int c = lane & 7;
#pragma unroll
    for (int j = 0; j < 4; ++j) { const int nl = (lane >> 3) + 8 * j; const LAS float* s = scr + (8 * c) * 33 + nl;
        u32x4 o; o.x = pk2(s[0 * 33], s[1 * 33]); o.y = pk2(s[2 * 33], s[3 * 33]); o.z = pk2(s[4 * 33], s[5 * 33]); o.w = pk2(s[6 * 33], s[7 * 33]);
        *(u32x4*)(WT + (size_t)(2048 + n0 + nl) * D + k0 + 8 * c) = o; }
    asm volatile("s_waitcnt lgkmcnt(0)" ::: "memory");
}
__device__ __forceinline__ void p0_prologue(const Frame& F, int qsel) {
    for (int task = F.bx; task < 2 * 96; task += F.G) {
        const int l = task / 96, cg = task % 96;
        LAS float* sc = (LAS float*)F.lds;
        LAS float* part = (LAS float*)(F.lds + 17 * 1024 * 4);
        for (int i = F.tid; i < 17 * 1024; i += 512) { const int b = i >> 10, k = i & 1023; const float v = b < 16 ? F.in[I_C][b * D + k] : F.in[I_CCTX][k]; sc[i] = silu_f(v); }
        __syncthreads();
        float acc[17];
#pragma unroll
        for (int b = 0; b < 17; ++b) acc[b] = 0.f;
        const float* aw = F.in[I_ADAW] + (size_t)l * D * 6 * D + cg * 64 + F.lane;
        for (int k0 = F.wave * 128; k0 < F.wave * 128 + 128; k0 += 16) { float w[16];
#pragma unroll
            for (int u = 0; u < 16; ++u) w[u] = aw[(size_t)(k0 + u) * 6 * D];
#pragma unroll
            for (int u = 0; u < 16; ++u) {
#pragma unroll
                for (int b = 0; b < 17; ++b) acc[b] += sc[b * 1024 + k0 + u] * w[u]; } }
#pragma unroll
        for (int b = 0; b < 17; ++b) part[(F.wave * 17 + b) * 64 + F.lane] = acc[b];
        __syncthreads();
        for (int i = F.tid; i < 17 * 64; i += 512) { const int b = i >> 6, n = i & 63; float s = F.in[I_ADAB][l * 6 * D + cg * 64 + n];
#pragma unroll
            for (int w = 0; w < 8; ++w) s += part[(w * 17 + b) * 64 + n];
            const int col = cg * 64 + n; ((float*)(F.ws + WS_MOD))[((size_t)(l * 17 + b) * 6 + (col >> 10)) * D + (col & 1023)] = s; }
        __syncthreads();
    }
    if (F.bx == F.G - 1) {
        float* rc = (float*)(F.ws + WS_ROPE); float* rs = rc + 96 * 32;
        for (int i = F.tid; i < 96 * 32; i += 512) { const int p = i >> 5, f = i & 31; const int pos = p < 32 ? p : p - 32;
            const float inv = powf(10000.0f, -(float)f / 32.0f); const float ang = (float)pos * inv; rc[i] = cosf(ang); rs[i] = sinf(ang); }
    }
    LAS float* scr = (LAS float*)(F.lds + F.wave * 8448);
    constexpr int IT_WIN = 16 * 80, IT_WOUT = 16 * 32, IT_GU = 16 * 32, IT_DN = 8 * 32;
    constexpr int N_WIN = DEPTH * IT_WIN, N_WOUT = DEPTH * IT_WOUT, N_GU = DEPTH * NE * IT_GU, N_DN = DEPTH * NE * IT_DN;
    unsigned* qhead = (unsigned*)(F.ws + WS_CTL) + CW_QUEUE + 16 * qsel;
    constexpr int N_ALL = N_WIN + N_WOUT + N_GU + N_DN, QB = 16, NBATCH = N_ALL / QB;
    static_assert(N_ALL % QB == 0, "queue batches");
    for (;;) {
        int bq = 0; if (F.lane == 0) bq = (int)__hip_atomic_fetch_add(qhead, 1u, __ATOMIC_RELAXED, __HIP_MEMORY_SCOPE_AGENT);
        bq = __builtin_amdgcn_readfirstlane(bq);
        if (bq >= NBATCH) break;
      for (int qi = 0; qi < QB; ++qi) {
        int r = bq + qi * NBATCH;
        if (r < N_WIN) { const int l = r / IT_WIN; r %= IT_WIN; const int kb = r & 15, nb = 79 - (r >> 4), n0 = nb * 32;
            const float* win = F.in[I_WIN] + (size_t)l * D * NP; bf16_t* WT = (bf16_t*)(F.ws + WS_WIN) + (size_t)l * NP * D;
            if (n0 >= 2048) { fold_item(win, F.in[I_POOLW] + (size_t)l * 4 * 128 * 128, F.in[I_POOLS] + l * 512, kb * 64, WT, n0 - 2048, scr, F.lane); continue; }
            const int n = n0 + (F.lane & 31); int src = n;
            if (n < 1024) { const int hh = n >> 7, j = n & 127, sec = j >> 6, jj = j & 63; src = (n & 512) + (hh & 3) * 128 + sec * 64 + (jj & 1) * 32 + (jj >> 1); }
            tr_item(win + src, NP, kb * 64, WT, D, n0, scr, F.lane); continue; }
        r -= N_WIN;
        if (r < N_WOUT) { const int l = r / IT_WOUT; r %= IT_WOUT; const int kb = r / 32, nb = r % 32, n0 = nb * 32;
            tr_item(F.in[I_WOUT] + (size_t)l * D * D + n0 + (F.lane & 31), D, kb * 64, (bf16_t*)(F.ws + WS_WOUT) + (size_t)l * D * D, D, n0, scr, F.lane); continue; }
        r -= N_WOUT;
        if (r < N_GU) { const int le = r / IT_GU; r %= IT_GU; const int kb = r / 32, nb = r % 32, n0 = nb * 32;
            const int n = n0 + (F.lane & 31), col = (n >> 3) * 4 + (n & 3); const float* src = ((n & 4) ? F.in[I_WU] : F.in[I_WG]) + (size_t)le * D * FF + col;
            tr_item(src, FF, kb * 64, (bf16_t*)(F.ws + WS_WGU) + (size_t)le * 1024 * D, D, n0, scr, F.lane); continue; }
        r -= N_GU;
        { const int le = r / IT_DN; r %= IT_DN; const int kb = r / 32, nb = r % 32, n0 = nb * 32;
            tr_item(F.in[I_WDN] + (size_t)le * FF * D + n0 + (F.lane & 31), D, kb * 64, (bf16_t*)(F.ws + WS_WD) + (size_t)le * D * FF, FF, n0, scr, F.lane); }
      }
    }
}

__device__ __forceinline__ LAS int* build_tb(const Frame& F, int l) {
    LAS int* tb = (LAS int*)(F.lds + MISC_OFF + 64);
    if (F.tid == 0) { const unsigned* cnt = (const unsigned*)(F.ws + WS_CTL) + CW_CNT + l * NE * 16; int s = 0;
        for (int e = 0; e < NE; ++e) { tb[e] = s; const int c = (int)__hip_atomic_load(cnt + e * 16, __ATOMIC_RELAXED, __HIP_MEMORY_SCOPE_AGENT); tb[64 + e] = c; s += (c + 255) >> 8; }
        tb[NE] = s; }
    __syncthreads();
    return tb;
}

__device__ __forceinline__ void row_op_a(const Frame& F, int mode, bool dry) {
    const int gw = F.vcu * 8 + F.wave, NGW = F.G * 8;
    const int nrows = (mode == 2) ? NLAT : NTOK; const int l = (mode == 0) ? 0 : 1, lp = mode - 1;
    const LAS int* tb = nullptr; if (mode != 0) tb = build_tb(F, lp);
    const bf16_t* YB = (const bf16_t*)(F.ws + WS_P); bf16_t* H = (bf16_t*)(F.ws + WS_H);
    const float* gain = (mode == 2) ? F.in[I_FNG] : F.in[I_N1G] + l * D;
    int4 ti = make_int4(0, 0, 0, 0), nti = ti; f32x2 tw = (f32x2){0.f, 0.f}, ntw = tw;
    if (mode != 0 && gw < nrows) { ti = *(const int4*)(F.ws + WS_TOKINFO + (size_t)gw * 32); tw = *(const f32x2*)(F.ws + WS_TOKINFO + (size_t)gw * 32 + 16); }
    for (int row = gw; row < nrows; row += NGW) {
        const int b = row < NLAT ? (row >> 11) : 16;
        if (mode != 0 && row + NGW < nrows) { nti = *(const int4*)(F.ws + WS_TOKINFO + (size_t)(row + NGW) * 32); ntw = *(const f32x2*)(F.ws + WS_TOKINFO + (size_t)(row + NGW) * 32 + 16); }
        f32x4 v[4];
        if (mode == 0) { const f32x4* src = (const f32x4*)(row < NLAT ? F.in[I_X] + (size_t)row * D : F.in[I_CTX] + (size_t)(row - NLAT) * D) + F.lane;
#pragma unroll
            for (int j = 0; j < 4; ++j) v[j] = src[64 * j];
        } else {
            const size_t s1 = (size_t)(tb[ti.x] * 256 + ti.y), s2 = (size_t)(tb[ti.z] * 256 + ti.w);
            float* xr = xa_row(F, row); const f32x4* g2 = (const f32x4*)mod_ptr(F, lp, b, 5) + F.lane;
            const u32x2* y1 = (const u32x2*)(YB + s1 * D) + F.lane; const u32x2* y2 = (const u32x2*)(YB + s2 * D) + F.lane;
#pragma unroll
            for (int j = 0; j < 4; ++j) { const f32x4 x = ((const f32x4*)xr)[F.lane + 64 * j]; const u32x2 a = y1[64 * j], c = y2[64 * j]; const f32x4 g = g2[64 * j];
                f32x4 y; y[0] = tw.x * bflo(a.x) + tw.y * bflo(c.x); y[1] = tw.x * bfhi(a.x) + tw.y * bfhi(c.x); y[2] = tw.x * bflo(a.y) + tw.y * bflo(c.y); y[3] = tw.x * bfhi(a.y) + tw.y * bfhi(c.y);
                v[j] = x + g * y; if (mode == 1 && !dry) ((f32x4*)xr)[F.lane + 64 * j] = v[j]; }
        }
        float ss = 0.f;
#pragma unroll
        for (int j = 0; j < 4; ++j) ss += (v[j][0] * v[j][0] + v[j][1] * v[j][1]) + (v[j][2] * v[j][2] + v[j][3] * v[j][3]);
        const float rstd = 1.0f / sqrtf(wave_sum(ss) * (1.0f / D) + EPS);
        if (mode == 2) {
#pragma unroll
            for (int j = 0; j < 4; ++j) { const f32x4 g = ((const f32x4*)gain)[F.lane + 64 * j]; ((f32x4*)((dry ? (float*)(F.ws + WS_WGU) : F.out) + (size_t)row * D))[F.lane + 64 * j] = v[j] * rstd * g; }
        } else {
            const f32x4* sh = (const f32x4*)mod_ptr(F, l, b, 0) + F.lane; const f32x4* sc = (const f32x4*)mod_ptr(F, l, b, 1) + F.lane;
            u32x2* o = (u32x2*)(H + (size_t)row * D) + F.lane;
#pragma unroll
            for (int j = 0; j < 4; ++j) { const f32x4 g = ((const f32x4*)gain)[F.lane + 64 * j]; const f32x4 h = v[j] * rstd * g * (sc[64 * j] + 1.0f) + sh[64 * j];
                u32x2 w; w.x = pk2(h[0], h[1]); w.y = pk2(h[2], h[3]); o[64 * j] = w; }
        }
        ti = nti; tw = ntw;
    }
}

template <bool DRY> __device__ __forceinline__ void route_row(const Frame& F, int l, int row, const float (&s)[36], unsigned* cnt, int* list) {
    const float* rgb = F.in[I_RGB] + l * 4; const float* reb = F.in[I_REB] + l * NE;
    float gl[4];
#pragma unroll
    for (int i = 0; i < 4; ++i) gl[i] = s[i] + rgb[i];
    int gt = 0; float gm = gl[0];
#pragma unroll
    for (int i = 1; i < 4; ++i) if (gl[i] > gm) { gm = gl[i]; gt = i; }
    float gs = 0.f;
#pragma unroll
    for (int i = 0; i < 4; ++i) gs += expf(gl[i] - gm);
    const float gwt = 1.0f / gs;
    float el[8];
#pragma unroll
    for (int j = 0; j < 8; ++j) { const float a = gt == 0 ? s[4 + j] : gt == 1 ? s[12 + j] : gt == 2 ? s[20 + j] : s[28 + j]; el[j] = a + reb[gt * 8 + j]; }
    int i1 = 0; float v1 = el[0];
#pragma unroll
    for (int j = 1; j < 8; ++j) if (el[j] > v1) { v1 = el[j]; i1 = j; }
    int i2 = -1; float v2 = -3.0e38f;
#pragma unroll
    for (int j = 0; j < 8; ++j) if (j != i1 && el[j] > v2) { v2 = el[j]; i2 = j; }
    const float e2 = expf(v2 - v1); const float w1 = gwt / (1.0f + e2), w2 = gwt * e2 / (1.0f + e2);
    if (!DRY) {
        const int x1 = gt * 8 + i1, x2 = gt * 8 + i2;
        const int r1 = (int)__hip_atomic_fetch_add(cnt + x1 * 16, 1u, __ATOMIC_RELAXED, __HIP_MEMORY_SCOPE_AGENT);
        const int r2 = (int)__hip_atomic_fetch_add(cnt + x2 * 16, 1u, __ATOMIC_RELAXED, __HIP_MEMORY_SCOPE_AGENT);
        list[(size_t)x1 * NTOK + r1] = row; list[(size_t)x2 * NTOK + r2] = row;
        *(int4*)(F.ws + WS_TOKINFO + (size_t)row * 32) = make_int4(x1, r1, x2, r2); *(f32x2*)(F.ws + WS_TOKINFO + (size_t)row * 32 + 16) = (f32x2){w1, w2};
    }
}
template <bool DRY> __device__ __forceinline__ void row_op_b(const Frame& F, int l) {
    const int gw = F.vcu * 8 + F.wave, NGW = F.G * 8;
    const int ngroups = ((l == 0) ? NTOK : NLAT) / 16;
    { const float* rg = F.in[I_RGW] + (size_t)l * D * 4; const float* re = F.in[I_REW] + (size_t)l * D * NE;
      for (int i = F.tid; i < 1024 * 36; i += 512) { const int k = i / 36, n = i % 36; const float w = n < 4 ? rg[k * 4 + n] : re[k * NE + (n - 4)];
          const unsigned hi = f2bf(w), lo = f2bf(w - bflo(hi));
          *(LAS bf16_t*)(F.lds + n * RW_PITCH + k * 2) = (bf16_t)hi; *(LAS bf16_t*)(F.lds + RW_LO + n * RW_PITCH + k * 2) = (bf16_t)lo; } }
    __syncthreads();
    bf16_t* H = (bf16_t*)(F.ws + WS_H);
    const float* gain = F.in[I_N2G] + l * D;
    unsigned* cnt = (unsigned*)(F.ws + WS_CTL) + CW_CNT + l * NE * 16;
    int* list = (int*)(F.ws + WS_LIST);
    const int fr = F.lane & 15, fq = F.lane >> 4;
    unsigned bo[3];
#pragma unroll
    for (int nt = 0; nt < 3; ++nt) { const int n = 16 * nt + fr; bo[nt] = (unsigned)((n < 36 ? n : 35) * RW_PITCH + fq * 16); }
    LAS float* ex = (LAS float*)(F.lds + RW_EX + F.wave * 1152);
    for (int gi = gw; gi < ngroups; gi += NGW) {
        const int row = gi * 16 + fr, b = row < NLAT ? (row >> 11) : 16;
        const float* xr = xa_row(F, row) + fq * 8;
        float ss = 0.f;
#pragma unroll 8
        for (int s = 0; s < 32; ++s) { const f32x4 a = *(const f32x4*)(xr + 32 * s), c = *(const f32x4*)(xr + 32 * s + 4);
            ss += (a[0] * a[0] + a[1] * a[1]) + (a[2] * a[2] + a[3] * a[3]) + (c[0] * c[0] + c[1] * c[1]) + (c[2] * c[2] + c[3] * c[3]); }
        ss += __shfl_xor(ss, 16); ss += __shfl_xor(ss, 32);
        const float rstd = 1.0f / sqrtf(ss * (1.0f / D) + EPS);
        const float* shp = mod_ptr(F, l, b, 3) + fq * 8; const float* scp = mod_ptr(F, l, b, 4) + fq * 8; const float* gp = gain + fq * 8;
        bf16_t* hp = H + (size_t)row * D + fq * 8;
        f32x4 acc[3];
#pragma unroll
        for (int nt = 0; nt < 3; ++nt) acc[nt] = (f32x4){0.f, 0.f, 0.f, 0.f};
#pragma unroll 2
        for (int s = 0; s < 32; ++s) {
            const f32x4 x0 = *(const f32x4*)(xr + 32 * s), x1 = *(const f32x4*)(xr + 32 * s + 4);
            const f32x4 g0 = *(const f32x4*)(gp + 32 * s), g1 = *(const f32x4*)(gp + 32 * s + 4);
            const f32x4 c0 = *(const f32x4*)(scp + 32 * s), c1 = *(const f32x4*)(scp + 32 * s + 4);
            const f32x4 s0 = *(const f32x4*)(shp + 32 * s), s1 = *(const f32x4*)(shp + 32 * s + 4);
            const f32x4 h0 = x0 * rstd * g0 * (c0 + 1.0f) + s0, h1 = x1 * rstd * g1 * (c1 + 1.0f) + s1;
            u32x4 hi, lo;
            hi.x = pk2(h0[0], h0[1]); hi.y = pk2(h0[2], h0[3]); hi.z = pk2(h1[0], h1[1]); hi.w = pk2(h1[2], h1[3]);
            lo.x = pk2(h0[0] - bflo(hi.x), h0[1] - bfhi(hi.x)); lo.y = pk2(h0[2] - bflo(hi.y), h0[3] - bfhi(hi.y));
            lo.z = pk2(h1[0] - bflo(hi.z), h1[1] - bfhi(hi.z)); lo.w = pk2(h1[2] - bflo(hi.w), h1[3] - bfhi(hi.w));
            *(u32x4*)(hp + 32 * s) = hi;
            const bf16x8 ah = __builtin_bit_cast(bf16x8, hi), al = __builtin_bit_cast(bf16x8, lo);
#pragma unroll
            for (int nt = 0; nt < 3; ++nt) {
                const bf16x8 bh = *(const LAS bf16x8*)(F.lds + bo[nt] + s * 64), bl = *(const LAS bf16x8*)(F.lds + RW_LO + bo[nt] + s * 64);
                acc[nt] = __builtin_amdgcn_mfma_f32_16x16x32_bf16(ah, bh, acc[nt], 0, 0, 0);
                acc[nt] = __builtin_amdgcn_mfma_f32_16x16x32_bf16(ah, bl, acc[nt], 0, 0, 0);
                acc[nt] = __builtin_amdgcn_mfma_f32_16x16x32_bf16(al, bh, acc[nt], 0, 0, 0);
            }
        }
#pragma unroll
        for (int hf = 0; hf < 2; ++hf) {
            if ((fq >> 1) == hf) {
#pragma unroll
                for (int nt = 0; nt < 3; ++nt) { const int n = 16 * nt + fr;
                    if (n < 36) {
#pragma unroll
                        for (int r = 0; r < 4; ++r) ex[((fq & 1) * 4 + r) * 36 + n] = acc[nt][r]; } }
            }
            asm volatile("s_waitcnt lgkmcnt(0)" ::: "memory");
            if (F.lane < 8) { float sl[36];
#pragma unroll
                for (int n = 0; n < 36; ++n) sl[n] = ex[F.lane * 36 + n];
                route_row<DRY>(F, l, gi * 16 + hf * 8 + F.lane, sl, cnt, list); }
            asm volatile("s_waitcnt lgkmcnt(0)" ::: "memory");
        }
    }
    __syncthreads();
}

__device__ __forceinline__ unsigned off_b(unsigned row, unsigned ch) { return 256u * row + 16u * (ch ^ (((row & 3) << 2) | ((row >> 2) & 3))); }
__device__ __forceinline__ unsigned tr_base_p(unsigned lane) { const unsigned g = lane >> 4, q = (lane & 15) >> 2, p = lane & 3; return off_b(4 * g + q, (p >> 1)) + 8 * (p & 1); }
template <int O0, int O1, int O2, int O3>
__device__ __forceinline__ void tr_frag4(bf16x8 (&f)[4], unsigned a0, unsigned a1, unsigned a2, unsigned a3) {
    s16x4 l0, h0, l1, h1, l2, h2, l3, h3;
    asm volatile("ds_read_b64_tr_b16 %0, %8 offset:%12\n\tds_read_b64_tr_b16 %1, %8 offset:%16\n\t"
                 "ds_read_b64_tr_b16 %2, %9 offset:%13\n\tds_read_b64_tr_b16 %3, %9 offset:%17\n\t"
                 "ds_read_b64_tr_b16 %4, %10 offset:%14\n\tds_read_b64_tr_b16 %5, %10 offset:%18\n\t"
                 "ds_read_b64_tr_b16 %6, %11 offset:%15\n\tds_read_b64_tr_b16 %7, %11 offset:%19\n\ts_waitcnt lgkmcnt(0)"
                 : "=&v"(l0), "=&v"(h0), "=&v"(l1), "=&v"(h1), "=&v"(l2), "=&v"(h2), "=&v"(l3), "=&v"(h3)
                 : "v"(a0), "v"(a1), "v"(a2), "v"(a3), "n"(O0), "n"(O1), "n"(O2), "n"(O3), "n"(O0 + 4096), "n"(O1 + 4096), "n"(O2 + 4096), "n"(O3 + 4096) : "memory");
    f[0] = __builtin_shufflevector(l0, h0, 0, 1, 2, 3, 4, 5, 6, 7); f[1] = __builtin_shufflevector(l1, h1, 0, 1, 2, 3, 4, 5, 6, 7);
    f[2] = __builtin_shufflevector(l2, h2, 0, 1, 2, 3, 4, 5, 6, 7); f[3] = __builtin_shufflevector(l3, h3, 0, 1, 2, 3, 4, 5, 6, 7);
}
template <int O>
__device__ __forceinline__ void tr_frag8(bf16x8 (&f)[8], unsigned a) {
    s16x4 l0, h0, l1, h1, l2, h2, l3, h3, l4, h4, l5, h5, l6, h6, l7, h7;
    const unsigned a1 = a ^ 32u, a2 = a ^ 64u, a3 = a ^ 96u, a4 = a ^ 128u, a5 = a ^ 160u, a6 = a ^ 192u, a7 = a ^ 224u;
    asm volatile("ds_read_b64_tr_b16 %0, %8 offset:%12\n\tds_read_b64_tr_b16 %1, %8 offset:%13\n\t"
                 "ds_read_b64_tr_b16 %2, %9 offset:%12\n\tds_read_b64_tr_b16 %3, %9 offset:%13\n\t"
                 "ds_read_b64_tr_b16 %4, %10 offset:%12\n\tds_read_b64_tr_b16 %5, %10 offset:%13\n\t"
                 "ds_read_b64_tr_b16 %6, %11 offset:%12\n\tds_read_b64_tr_b16 %7, %11 offset:%13"
                 : "=&v"(l0), "=&v"(h0), "=&v"(l1), "=&v"(h1), "=&v"(l2), "=&v"(h2), "=&v"(l3), "=&v"(h3)
                 : "v"(a), "v"(a1), "v"(a2), "v"(a3), "n"(O), "n"(O + 4096) : "memory");
    asm volatile("ds_read_b64_tr_b16 %0, %16 offset:%20\n\tds_read_b64_tr_b16 %1, %16 offset:%21\n\t"
                 "ds_read_b64_tr_b16 %2, %17 offset:%20\n\tds_read_b64_tr_b16 %3, %17 offset:%21\n\t"
                 "ds_read_b64_tr_b16 %4, %18 offset:%20\n\tds_read_b64_tr_b16 %5, %18 offset:%21\n\t"
                 "ds_read_b64_tr_b16 %6, %19 offset:%20\n\tds_read_b64_tr_b16 %7, %19 offset:%21\n\ts_waitcnt lgkmcnt(0)"
                 : "=&v"(l4), "=&v"(h4), "=&v"(l5), "=&v"(h5), "=&v"(l6), "=&v"(h6), "=&v"(l7), "=&v"(h7),
                   "+v"(l0), "+v"(h0), "+v"(l1), "+v"(h1), "+v"(l2), "+v"(h2), "+v"(l3), "+v"(h3)
                 : "v"(a4), "v"(a5), "v"(a6), "v"(a7), "n"(O), "n"(O + 4096) : "memory");
    f[0] = __builtin_shufflevector(l0, h0, 0, 1, 2, 3, 4, 5, 6, 7); f[1] = __builtin_shufflevector(l1, h1, 0, 1, 2, 3, 4, 5, 6, 7);
    f[2] = __builtin_shufflevector(l2, h2, 0, 1, 2, 3, 4, 5, 6, 7); f[3] = __builtin_shufflevector(l3, h3, 0, 1, 2, 3, 4, 5, 6, 7);
    f[4] = __builtin_shufflevector(l4, h4, 0, 1, 2, 3, 4, 5, 6, 7); f[5] = __builtin_shufflevector(l5, h5, 0, 1, 2, 3, 4, 5, 6, 7);
    f[6] = __builtin_shufflevector(l6, h6, 0, 1, 2, 3, 4, 5, 6, 7); f[7] = __builtin_shufflevector(l7, h7, 0, 1, 2, 3, 4, 5, 6, 7);
}
#define LBAR() do { asm volatile("s_waitcnt lgkmcnt(0)" ::: "memory"); __builtin_amdgcn_s_barrier(); asm volatile("" ::: "memory"); } while (0)
__device__ __forceinline__ int chunk_row0(int b, int ci) { return ci < 2 ? NLAT + b * CT + ci * 128 : b * TL + (ci - 2) * 128; }
__device__ __forceinline__ float log2_gamma(float decay) { return -log1pf(expf(-decay)) * 1.4426950408889634f; }

template <int HALF>
__device__ __forceinline__ void pool_item(const LAS unsigned char* tile, bf16_t* A2, int t0, int T, int rbase, int rl, int cg) {
    const int t = t0 + rl; int cnt = 0;
    float s[8];
#pragma unroll
    for (int i = 0; i < 8; ++i) s[i] = 0.f;
    u32x4 c = (u32x4){0u, 0u, 0u, 0u};
#pragma unroll
    for (int w = 0; w < 2 * HALF; ++w) { const int tt = t - HALF + w; const bool ok = tt >= 0 && tt < T;
        u32x4 x = *(const LAS u32x4*)(tile + (rl + 8 - HALF + w) * 1024 + cg * 16); if (!ok) x = (u32x4){0u, 0u, 0u, 0u}; cnt += ok ? 1 : 0; if (w == HALF) c = x;
        s[0] += bflo(x.x); s[1] += bfhi(x.x); s[2] += bflo(x.y); s[3] += bfhi(x.y); s[4] += bflo(x.z); s[5] += bfhi(x.z); s[6] += bflo(x.w); s[7] += bfhi(x.w); }
    const float inv = 1.0f / (float)cnt;
    u32x4 o; o.x = pk2(s[0] * inv - bflo(c.x), s[1] * inv - bfhi(c.x)); o.y = pk2(s[2] * inv - bflo(c.y), s[3] * inv - bfhi(c.y));
    o.z = pk2(s[4] * inv - bflo(c.z), s[5] * inv - bfhi(c.z)); o.w = pk2(s[6] * inv - bflo(c.w), s[7] * inv - bfhi(c.w));
    *(u32x4*)(A2 + (size_t)(rbase + t) * D + 512 + cg * 8) = o;
}

__device__ __forceinline__ void p3a_states_pool(const Frame& F, int l) {
    const bf16_t* P = (const bf16_t*)(F.ws + WS_P);
    bf16_t* ST = (bf16_t*)(F.ws + WS_ACT);
    bf16_t* A2 = (bf16_t*)(F.ws + WS_H);
    const int nstate = (F.G > 128) ? 128 : F.G;
    if (F.bx < nstate) {
        for (int unit = F.bx; unit < 128; unit += nstate) {
            const int dir = unit & 1, bh = unit >> 1, b = bh >> 2, h = bh & 3;
            const float lg2 = log2_gamma((dir ? F.in[I_DB] : F.in[I_DF])[l * NH + h]);
            const float gC = exp2f(lg2 * 128.0f);
            f32x4 acc[8];
#pragma unroll
            for (int dt = 0; dt < 8; ++dt) acc[dt] = (f32x4){0.f, 0.f, 0.f, 0.f};
            u32x4 kr[8], vr[8];
#define P3A_CI(n_) (dir ? ((n_) < 2 ? 1 - (n_) : 19 - (n_)) : (n_))
#define P3A_LOAD(st_) do { _Pragma("unroll") for (int sub = 0; sub < 2; ++sub) { const int r0_ = chunk_row0(b, P3A_CI(2 * (st_) + sub)); \
                _Pragma("unroll") for (int q = 0; q < 4; ++q) { const int p = F.tid + 512 * q, j = p >> 4, ch = p & 15; \
                    kr[sub * 4 + q] = *(const u32x4*)(P + (size_t)(r0_ + j) * NP + 512 + h * 128 + ch * 8); vr[sub * 4 + q] = *(const u32x4*)(P + (size_t)(r0_ + j) * NP + 1024 + h * 128 + ch * 8); } } } while (0)
#define P3A_STORE(n_) do { bf16_t* sp = ST + ((size_t)((bh * 2 + dir) * NCHUNK + P3A_CI(n_)) * 128 + (F.wave * 16 + (F.lane & 15))) * 128 + 4 * (F.lane >> 4); \
                _Pragma("unroll") for (int dt = 0; dt < 8; ++dt) { u32x2 w; w.x = pk2(acc[dt][0], acc[dt][1]); w.y = pk2(acc[dt][2], acc[dt][3]); *(u32x2*)(sp + dt * 16) = w; } } while (0)
#define P3A_KS(KO, VO, ks) do { bf16x8 ka[8]; tr_frag8<(KO) + (ks) * 8192>(ka, tpk); \
                _Pragma("unroll") for (int dt = 0; dt < 8; ++dt) acc[dt] = __builtin_amdgcn_mfma_f32_16x16x32_bf16(ka[dt], vb[ks], acc[dt], 0, 0, 0); } while (0)
#define P3A_SUB(KO, VO) do { _Pragma("unroll") for (int dt = 0; dt < 8; ++dt) acc[dt] *= gC; \
                bf16x8 vb[4]; tr_frag4<(VO), (VO) + 8192, (VO) + 16384, (VO) + 24576>(vb, tpv, tpv, tpv, tpv); \
                P3A_KS(KO, VO, 0); P3A_KS(KO, VO, 1); P3A_KS(KO, VO, 2); P3A_KS(KO, VO, 3); } while (0)
            P3A_LOAD(0);
            for (int st = 0; st < 9; ++st) {
#pragma unroll
                for (int sub = 0; sub < 2; ++sub)
#pragma unroll
                    for (int q = 0; q < 4; ++q) { const int p = F.tid + 512 * q, j = p >> 4, ch = p & 15;
                        const float kd = __builtin_amdgcn_exp2f(lg2 * (float)(dir ? j : 127 - j));
                        const u32x4 kk = kr[sub * 4 + q];
                        u32x4 ks; ks.x = pk2(bflo(kk.x) * kd, bfhi(kk.x) * kd); ks.y = pk2(bflo(kk.y) * kd, bfhi(kk.y) * kd); ks.z = pk2(bflo(kk.z) * kd, bfhi(kk.z) * kd); ks.w = pk2(bflo(kk.w) * kd, bfhi(kk.w) * kd);
                        *(LAS u32x4*)(F.lds + sub * 32768 + off_b(j, ch)) = ks; *(LAS u32x4*)(F.lds + 65536 + sub * 32768 + off_b(j, ch)) = vr[sub * 4 + q]; }
                LBAR();
                if (st < 8) P3A_LOAD(st + 1);
                const unsigned tpk = (unsigned)(size_t)F.lds + tr_base_p(F.lane); const unsigned tpv = (tpk ^ ((unsigned)F.wave << 5)) + 65536u;
                P3A_STORE(2 * st);
                P3A_SUB(0, 0);
                P3A_STORE(2 * st + 1);
                if (st < 8) P3A_SUB(32768, 32768);
                LBAR();
            }
#undef P3A_SUB
#undef P3A_KS
#undef P3A_STORE
#undef P3A_LOAD
#undef P3A_CI
        }
    } else {
        const int pb = F.bx - nstate, npb = F.G - nstate;
        u32x4 ld[10];
#define POOL_LOAD(tile_) do { const int r0_ = (tile_) * 64; int t0_, T_, rb_; if (r0_ < NLAT) { t0_ = r0_ & (TL - 1); T_ = TL; } else { t0_ = (r0_ - NLAT) & (CT - 1); T_ = CT; } rb_ = r0_ - t0_; \
            _Pragma("unroll") for (int q = 0; q < 10; ++q) { const int p = F.tid + 512 * q, rr = p >> 6, ch = p & 63; int tt = t0_ - 8 + rr; tt = tt < 0 ? 0 : (tt >= T_ ? T_ - 1 : tt); \
                ld[q] = *(const u32x4*)(P + (size_t)(rb_ + tt) * NP + 2048 + ch * 8); } } while (0)
        if (pb < 576) POOL_LOAD(pb);
        for (int tile = pb; tile < 576; tile += npb) {
            const int r0 = tile * 64; int t0, T; if (r0 < NLAT) { t0 = r0 & (TL - 1); T = TL; } else { t0 = (r0 - NLAT) & (CT - 1); T = CT; } const int rbase = r0 - t0;
            LBAR();
#pragma unroll
            for (int q = 0; q < 10; ++q) { const int p = F.tid + 512 * q; *(LAS u32x4*)(F.lds + (p >> 6) * 1024 + (p & 63) * 16) = ld[q]; }
            LBAR();
            if (tile + npb < 576) POOL_LOAD(tile + npb);
            for (int wi = F.wave; wi < 64; wi += 8) { const int g = wi & 3, rl = (wi >> 2) * 4 + (F.lane >> 4), cg = g * 16 + (F.lane & 15);
                if (g == 0) pool_item<1>(F.lds, A2, t0, T, rbase, rl, cg); else if (g == 1) pool_item<2>(F.lds, A2, t0, T, rbase, rl, cg);
                else if (g == 2) pool_item<4>(F.lds, A2, t0, T, rbase, rl, cg); else pool_item<8>(F.lds, A2, t0, T, rbase, rl, cg); }
        }
#undef POOL_LOAD
    }
    __syncthreads();
}

__device__ __forceinline__ void p3b_retention(const Frame& F, int l) {
    const bf16_t* P = (const bf16_t*)(F.ws + WS_P);
    const bf16_t* ST = (const bf16_t*)(F.ws + WS_ACT);
    bf16_t* A2 = (bf16_t*)(F.ws + WS_H);
    const int c_lo = (l == DEPTH - 1) ? 2 : 0, ncu = NCHUNK - c_lo, nunits = 64 * ncu;
    u32x4 ld[8], st[8]; bf16x8 qf[4];
#define P3B_LOAD(unit_) do { const int bh_ = (unit_) / ncu, ci_ = c_lo + (unit_) % ncu, h_ = bh_ & 3; const int r0_ = chunk_row0(bh_ >> 2, ci_); \
        _Pragma("unroll") for (int q = 0; q < 4; ++q) { const int p = F.tid + 512 * q, j = p >> 4, ch = p & 15; \
            ld[q] = *(const u32x4*)(P + (size_t)(r0_ + j) * NP + 512 + h_ * 128 + ch * 8); ld[4 + q] = *(const u32x4*)(P + (size_t)(r0_ + j) * NP + 1024 + h_ * 128 + ch * 8); } } while (0)
#define P3B_LOADQ(unit_) do { const int bh_ = (unit_) / ncu, ci_ = c_lo + (unit_) % ncu, h_ = bh_ & 3; const int r0_ = chunk_row0(bh_ >> 2, ci_); \
        _Pragma("unroll") for (int ks = 0; ks < 4; ++ks) qf[ks] = *(const bf16x8*)(P + (size_t)(r0_ + F.wave * 16 + (F.lane & 15)) * NP + h_ * 128 + ks * 32 + (F.lane >> 4) * 8); } while (0)
    if (F.vcu < nunits) { P3B_LOAD(F.vcu); P3B_LOADQ(F.vcu); }
    for (int unit = F.vcu; unit < nunits; unit += F.G) {
        int lane_o = F.lane; asm volatile("" : "+v"(lane_o));
        const int fr = lane_o & 15, fq = lane_o >> 4;
        const unsigned rr0 = off_b((unsigned)fr, (unsigned)fq), tp = (unsigned)(size_t)F.lds + tr_base_p((unsigned)lane_o);
        const int il = F.wave * 16 + fr;
        const int bh = unit / ncu, ci = c_lo + unit % ncu, b = bh >> 2, h = bh & 3;
        const float lgf = log2_gamma(F.in[I_DF][l * NH + h]), lgb = log2_gamma(F.in[I_DB][l * NH + h]);
        const int row0 = chunk_row0(b, ci);
        { const bf16_t* sf = ST + ((size_t)((bh * 2 + 0) * NCHUNK + ci) * 128) * 128; const bf16_t* sb = ST + ((size_t)((bh * 2 + 1) * NCHUNK + ci) * 128) * 128;
#pragma unroll
          for (int q = 0; q < 4; ++q) { const int p = F.tid + 512 * q, j = p >> 4, ch = p & 15; st[q] = *(const u32x4*)(sf + (size_t)j * 128 + ch * 8); st[4 + q] = *(const u32x4*)(sb + (size_t)j * 128 + ch * 8); } }
        LBAR();
#pragma unroll
        for (int q = 0; q < 4; ++q) { const int p = F.tid + 512 * q, j = p >> 4, ch = p & 15; const unsigned o = off_b(j, ch);
            *(LAS u32x4*)(F.lds + o) = ld[q]; *(LAS u32x4*)(F.lds + 32768u + o) = ld[4 + q]; }
        LBAR();
        if (unit + F.G < nunits) P3B_LOAD(unit + F.G);
        u32x2 gg[8];
#pragma unroll
        for (int et = 0; et < 8; ++et) gg[et] = *(const u32x2*)(P + (size_t)(row0 + il) * NP + 1536 + h * 128 + 4 * fq + et * 16);
        bf16x8 pf[4];
#pragma unroll
        for (int ks2 = 0; ks2 < 4; ++ks2) {
            u32x2 half[2];
#pragma unroll
            for (int t = 0; t < 2; ++t) { const int jt = 2 * ks2 + t;
                asm volatile("" ::: "memory");
                f32x4 sa = (f32x4){0.f, 0.f, 0.f, 0.f};
#pragma unroll
                for (int ks = 0; ks < 4; ++ks) { const bf16x8 ka = *(const LAS bf16x8*)(F.lds + ((rr0 ^ ((unsigned)ks << 6)) + 4096u * jt)); sa = __builtin_amdgcn_mfma_f32_16x16x32_bf16(ka, qf[ks], sa, 0, 0, 0); }
                float pv[4];
#pragma unroll
                for (int r = 0; r < 4; ++r) { const int j = 16 * jt + 4 * fq + r, df = il - j;
                    const float w = df > 0 ? __builtin_amdgcn_exp2f(lgf * (float)df) : (df < 0 ? __builtin_amdgcn_exp2f(lgb * (float)(-df)) : 2.0f); pv[r] = sa[r] * w; }
                half[t].x = pk2(pv[0], pv[1]); half[t].y = pk2(pv[2], pv[3]); }
            const u32x4 w4 = (u32x4){half[0].x, half[0].y, half[1].x, half[1].y};
            pf[ks2] = __builtin_bit_cast(bf16x8, w4);
        }
#pragma unroll
        for (int q = 0; q < 4; ++q) { const int p = F.tid + 512 * q, j = p >> 4, ch = p & 15; const unsigned o = off_b(j, ch);
            *(LAS u32x4*)(F.lds + 65536u + o) = st[q]; *(LAS u32x4*)(F.lds + 98304u + o) = st[4 + q]; }
        LBAR();
        const float qdf = __builtin_amdgcn_exp2f(lgf * (float)(il + 1)), qdb = __builtin_amdgcn_exp2f(lgb * (float)(128 - il));
        float o[8][4]; float ss = 0.f;
#pragma unroll
        for (int et = 0; et < 8; ++et) {
            f32x4 ao = (f32x4){0.f, 0.f, 0.f, 0.f}, af = ao, ab = ao;
            bf16x8 va[4]; { const unsigned a = tp ^ ((unsigned)et << 5); tr_frag4<32768, 32768 + 8192, 32768 + 16384, 32768 + 24576>(va, a, a, a, a); }
#pragma unroll
            for (int ks = 0; ks < 4; ++ks) {
                ao = __builtin_amdgcn_mfma_f32_16x16x32_bf16(va[ks], pf[ks], ao, 0, 0, 0);
                const unsigned ra = (rr0 ^ ((unsigned)ks << 6)) + 4096u * et;
                const bf16x8 fa = *(const LAS bf16x8*)(F.lds + 65536u + ra);
                af = __builtin_amdgcn_mfma_f32_16x16x32_bf16(fa, qf[ks], af, 0, 0, 0);
                const bf16x8 ba = *(const LAS bf16x8*)(F.lds + 98304u + ra);
                ab = __builtin_amdgcn_mfma_f32_16x16x32_bf16(ba, qf[ks], ab, 0, 0, 0);
            }
#pragma unroll
            for (int r = 0; r < 4; ++r) { o[et][r] = ao[r] + qdf * af[r] + qdb * ab[r]; ss += o[et][r] * o[et][r]; }
        }
        if (unit + F.G < nunits) P3B_LOADQ(unit + F.G);
        ss += __shfl_xor(ss, 16); ss += __shfl_xor(ss, 32);
        const float rstd = 1.0f / sqrtf(ss * (1.0f / 128.0f) + EPS);
        bf16_t* op = A2 + (size_t)(row0 + il) * D + h * 128 + 4 * fq;
#pragma unroll
        for (int et = 0; et < 8; ++et) { const u32x2 g = gg[et];
            u32x2 w; w.x = pk2(silu_f(bflo(g.x)) * o[et][0] * rstd, silu_f(bfhi(g.x)) * o[et][1] * rstd); w.y = pk2(silu_f(bflo(g.y)) * o[et][2] * rstd, silu_f(bfhi(g.y)) * o[et][3] * rstd);
            *(u32x2*)(op + et * 16) = w; }
    }
#undef P3B_LOAD
#undef P3B_LOADQ
    __syncthreads();
}

__global__ void __launch_bounds__(512, 2) fwd_kernel(Args args) {
    extern __shared__ __attribute__((aligned(16))) unsigned char lds_raw[];
    Frame F;
    F.lds = (LAS unsigned char*)lds_raw; F.tid = threadIdx.x; F.lane = F.tid & 63; F.wave = __builtin_amdgcn_readfirstlane(F.tid >> 6);
    F.G = gridDim.x; F.bx = blockIdx.x; F.vcu = (F.G % 8 == 0) ? (F.bx % 8) * (F.G / 8) + F.bx / 8 : F.bx;
    F.in = args.in; F.out = args.out; F.ws = args.ws;
    volatile LAS unsigned* MISC = (volatile LAS unsigned*)(F.lds + MISC_OFF);
    if (F.tid < 4) MISC[F.tid] = 0u;
    __syncthreads();
    unsigned* ctl = (unsigned*)(F.ws + WS_CTL);
    XcdBarrier bar; bar.bar = ctl + CW_BAR; bar.x = 0; bar.st = nullptr;
    const int lo = args.ph_lo, hi = args.ph_hi;
    const bool multi = (hi - lo) > 1;
    if (multi) bar = xcd_barrier_post(ctl + CW_BAR, MISC);
#ifndef TYPE_MASK
#define TYPE_MASK 0x3ff
#endif
#define PTYPE(k) ((k) == 0 ? 0 : ((k) == 17 ? 9 : 1 + (((k) - 1) & 7)))
#define ENTER() do { if (PROBE_REPEAT >= 0) __syncthreads(); int _t = threadIdx.x; asm volatile("" : "+v"(_t)); F.tid = _t; F.lane = _t & 63; F.wave = __builtin_amdgcn_readfirstlane(_t >> 6); } while (0)
#define IN(k) (((TYPE_MASK >> PTYPE(k)) & 1) && lo <= (k) && (k) < hi)
#define SEAM(k) do { if (IN(k) && IN((k) + 1)) xcd_barrier(bar); } while (0)
#define REP(t) for (int rep = (PROBE_REPEAT == (t)) ? 0 : 1; rep < 2; ++rep)

    if (IN(0)) REP(0) { ENTER(); p0_prologue(F, rep); }
    SEAM(0);
    for (int l = 0; l < DEPTH; ++l) {
        const int pb = 1 + 8 * l;
        const bool last = (l == DEPTH - 1);
        const int Mrows = last ? NLAT : NTOK;
        if (IN(pb + 0)) REP(1) { ENTER(); row_op_a(F, l == 0 ? 0 : 1, rep == 0); }
        SEAM(pb + 0);
        if (IN(pb + 1)) REP(2) { ENTER();
            pg8::SchedDense S; S.init(NTOK, NP, D, F.G, F.bx);
            pg8::EpiInProj E{(bf16_t*)(F.ws + WS_P), (const float*)(F.ws + WS_ROPE), (const float*)(F.ws + WS_ROPE) + 96 * 32};
            pg8::gemm_phase<pg8::EpiInProj, pg8::SchedDense, true, true>(F.lds, F.tid, (const char*)(F.ws + WS_H), (const char*)(F.ws + WS_WIN) + (size_t)l * NP * D * 2, D, S, E);
        }
        SEAM(pb + 1);
        if (IN(pb + 2)) REP(3) { ENTER(); p3a_states_pool(F, l); }
        SEAM(pb + 2);
        if (IN(pb + 3)) REP(4) { ENTER(); p3b_retention(F, l); }
        SEAM(pb + 3);
        if (IN(pb + 4)) REP(5) { ENTER();
            pg8::SchedDense S; S.init(Mrows, D, D, F.G, F.bx);
            pg8::EpiResid E;
            if (l == 0) { E.rl = F.in[I_X]; E.rc = F.in[I_CTX]; } else { E.rl = F.out; E.rc = (const float*)(F.ws + WS_XC); }
            E.ol = (rep == 0) ? (float*)(F.ws + WS_P) : F.out; E.oc = (rep == 0) ? (float*)(F.ws + WS_P) + (size_t)NLAT * D : (float*)(F.ws + WS_XC); E.gmod = mod_ptr(F, l, 0, 2);
            pg8::gemm_phase<pg8::EpiResid, pg8::SchedDense, true, true>(F.lds, F.tid, (const char*)(F.ws + WS_H), (const char*)(F.ws + WS_WOUT) + (size_t)l * D * D * 2, D, S, E);
        }
        SEAM(pb + 4);
        if (IN(pb + 5)) REP(6) { ENTER(); if (PROBE_REPEAT == 6 && rep == 0) row_op_b<true>(F, l); else row_op_b<false>(F, l); }
        SEAM(pb + 5);
        if (IN(pb + 6)) REP(7) { ENTER();
            LAS int* tb = build_tb(F, l);
            LAS int* tokt = (LAS int*)(F.lds + TOKT_OFF);
            const int* list = (const int*)(F.ws + WS_LIST);
            pg8::SchedGroup S; S.tb = tb; S.tokt = tokt; S.G = F.G; S.c = F.vcu; S.K = D; S.gather = 1;
            { pg8::Unit u; for (int i = 0; i < 8 && S.next(i, u); ++i) { const int g = u.pm; int e = 0; while (tb[e + 1] <= g) ++e; const int rt = g - tb[e], cnt = tb[64 + e];
                if (F.tid < 256) { int r = rt * 256 + F.tid; if (r >= cnt) r = cnt - 1; tokt[i * 256 + F.tid] = list[(size_t)e * NTOK + r]; } } }
            __syncthreads();
            pg8::EpiSwiGLU E{(bf16_t*)(F.ws + WS_ACT)};
            pg8::gemm_phase<pg8::EpiSwiGLU, pg8::SchedGroup, true, true>(F.lds, F.tid, (const char*)(F.ws + WS_H), (const char*)(F.ws + WS_WGU) + (size_t)l * NE * 1024 * D * 2, D, S, E);
        }
        SEAM(pb + 6);
        if (IN(pb + 7)) REP(8) { ENTER();
            LAS int* tb = build_tb(F, l);
            pg8::SchedGroup S; S.tb = tb; S.tokt = nullptr; S.G = F.G; S.c = F.vcu; S.K = FF; S.gather = 0;
            pg8::EpiBf16 E{(bf16_t*)(F.ws + WS_P), D};
            pg8::gemm_phase<pg8::EpiBf16, pg8::SchedGroup, true, true>(F.lds, F.tid, (const char*)(F.ws + WS_ACT), (const char*)(F.ws + WS_WD) + (size_t)l * NE * D * FF * 2, FF, S, E);
        }
        SEAM(pb + 7);
    }
    if (IN(17)) REP(9) { ENTER(); row_op_a(F, 2, rep == 0); }
#undef IN
#undef SEAM
}

extern "C" void kernel_launch(void* const* d_in, const int* in_sizes, int n_in, void* d_out, int out_size, void* d_ws, size_t ws_size, hipStream_t stream) {
    static int grid = 0;
    if (grid == 0) {
        if (n_in != 22 || out_size != NLAT * D || ws_size < WS_END) { fprintf(stderr, "kernel_launch: unexpected shapes (n_in %d, out %d, ws %zu)\n", n_in, out_size, ws_size); grid = -1; return; }
        int dev = 0, cus = 0, per_cu = 0;
        if (hipGetDevice(&dev) != hipSuccess || hipDeviceGetAttribute(&cus, hipDeviceAttributeMultiprocessorCount, dev) != hipSuccess) { grid = -1; return; }
        if (hipFuncSetAttribute((const void*)fwd_kernel, hipFuncAttributeMaxDynamicSharedMemorySize, LDS_BYTES) != hipSuccess) { fprintf(stderr, "kernel_launch: hipFuncSetAttribute failed\n"); grid = -1; return; }
        if (hipOccupancyMaxActiveBlocksPerMultiprocessor(&per_cu, (const void*)fwd_kernel, 512, LDS_BYTES) != hipSuccess || per_cu < 1) { fprintf(stderr, "kernel_launch: occupancy query says %d\n", per_cu); }
        (void)hipGetLastError();
        grid = cus;
    }
    if (grid < 0) return;
    (void)hipMemsetAsync((char*)d_ws + WS_CTL, 0, CTL_ZERO_BYTES, stream);
    Args a{};
    for (int i = 0; i < 22; ++i) a.in[i] = (const float*)d_in[i];
    a.out = (float*)d_out; a.ws = (unsigned char*)d_ws;
    if (MK_N_LAUNCHES == 1) { a.ph_lo = 0; a.ph_hi = N_PHASES; hipLaunchKernelGGL(fwd_kernel, dim3(grid), dim3(512), LDS_BYTES, stream, a); }
    else { for (int p = 0; p < N_PHASES; ++p) { a.ph_lo = p; a.ph_hi = p + 1; hipLaunchKernelGGL(fwd_kernel, dim3(grid), dim3(512), LDS_BYTES, stream, a); } }
}
```

```cpp
#include <hip/hip_runtime.h>
#include <cstdio>
#include <cstdint>

#ifndef MK_N_LAUNCHES
#define MK_N_LAUNCHES 1
#endif

#ifndef PROBE_REPEAT
#define PROBE_REPEAT -1
#endif
#define LAS __attribute__((address_space(3)))
#define GAS __attribute__((address_space(1)))
typedef unsigned short bf16_t;
typedef short bf16x8 __attribute__((ext_vector_type(8)));
typedef short s16x4 __attribute__((ext_vector_type(4)));
typedef float f32x4 __attribute__((ext_vector_type(4)));
typedef float f32x2 __attribute__((ext_vector_type(2)));
typedef unsigned u32x4 __attribute__((ext_vector_type(4)));
typedef unsigned u32x2 __attribute__((ext_vector_type(2)));

constexpr int Bn = 16, TL = 2048, CT = 256, D = 1024, DEPTH = 2;
constexpr int NLAT = Bn * TL, NCTX = Bn * CT, NTOK = NLAT + NCTX;
constexpr int NP = 2560;
constexpr int NE = 32, FF = 512, NH = 4, HD = 128;
constexpr int NCHUNK = 18;
constexpr float EPS = 1e-6f;
constexpr int MAXTILES = 320;
constexpr int N_PHASES = 18;

constexpr size_t MiB = 1u << 20;
constexpr size_t WS_CTL = 0, CTL_ZERO_BYTES = 1 * MiB;
constexpr size_t WS_MOD = 1 * MiB;
constexpr size_t WS_ROPE = 2 * MiB;
constexpr size_t WS_TOKINFO = 3 * MiB;
constexpr size_t WS_LIST = 5 * MiB;
constexpr size_t WS_WIN = 10 * MiB;
constexpr size_t WS_WOUT = 20 * MiB;
constexpr size_t WS_WGU = 24 * MiB;
constexpr size_t WS_WD = 152 * MiB;
constexpr size_t WS_SSQ = 216 * MiB;
constexpr size_t WS_XB = 232 * MiB;
constexpr size_t WS_P = 304 * MiB;
constexpr size_t WS_ACT = 484 * MiB;
constexpr size_t WS_END = 564 * MiB;
constexpr int CW_TMO = 0;
constexpr int CW_QUEUE = 512;
constexpr int CW_CNT = 1024;
constexpr int CW_BAR = 4096;

constexpr int RING_BYTES = 131072;
constexpr int TOKT_OFF = RING_BYTES;
constexpr int MISC_OFF = 161792;
constexpr int RW_PITCH = 2064;
constexpr int RW_LO = 36 * RW_PITCH, RW_EX = 2 * 36 * RW_PITCH;
constexpr int LDS_BYTES = 163840;

__device__ __forceinline__ unsigned f2bf(float f) { unsigned u = __builtin_bit_cast(unsigned, f); return (u + 0x7fffu + ((u >> 16) & 1u)) >> 16; }
__device__ __forceinline__ unsigned pk2(float lo, float hi) { return f2bf(lo) | (f2bf(hi) << 16); }
__device__ __forceinline__ float bflo(unsigned w) { return __builtin_bit_cast(float, w << 16); }
__device__ __forceinline__ float bfhi(unsigned w) { return __builtin_bit_cast(float, w & 0xffff0000u); }
__device__ __forceinline__ float wave_sum(float v) {
#pragma unroll
    for (int o = 1; o < 64; o <<= 1) v += __shfl_xor(v, o);
    return v;
}
__device__ __forceinline__ float silu_f(float x) { return x / (1.0f + __expf(-x)); }

#define XB_TMO      128
#define XB_XCNT(j)  (256  + 64 * (j))
#define XB_XSUB(j)  (1280 + 64 * (j))
#define XB_XGEN(j)  (2304 + 64 * (j))
#define XB_TOP      3328
#define XB_TOPGEN   3392
#define XCD_BAR_WORDS 3456
#define XB_SPIN_CAP (1u << 18)
__device__ __forceinline__ unsigned xb_ld(unsigned* p)              { return __hip_atomic_load(p, __ATOMIC_RELAXED, __HIP_MEMORY_SCOPE_AGENT); }
__device__ __forceinline__ unsigned xb_add(unsigned* p, unsigned v) { return __hip_atomic_fetch_add(p, v, __ATOMIC_RELAXED, __HIP_MEMORY_SCOPE_AGENT); }
__device__ __forceinline__ unsigned xb_xcc_id() { return (unsigned)__builtin_amdgcn_s_getreg((3 << 11) | 20) & 0xFu; }
#define XB_SPIN(cond, bar) do { unsigned _sp = 0; while (cond) { __builtin_amdgcn_s_sleep(1); \
    if ((++_sp & 255u) == 0u) { if (xb_ld(&(bar)[XB_TMO])) break; if (_sp > XB_SPIN_CAP) { atomicAdd(&(bar)[XB_TMO], 1u); break; } } } } while (0)
struct XcdBarrier { unsigned* bar; unsigned x; volatile LAS unsigned* st; };
__device__ __forceinline__ XcdBarrier xcd_barrier_post(unsigned* bar, volatile LAS unsigned* st) {
    XcdBarrier b; b.bar = bar; b.x = xb_xcc_id(); b.st = st;
    if (threadIdx.x == 0) (void)xb_add(&bar[XB_XCNT(b.x)], 1u);
    return b;
}
__device__ __forceinline__ void xcd_barrier_complete(unsigned* bar, unsigned x, unsigned& nloc, unsigned& nx) {
    const unsigned G = gridDim.x * gridDim.y * gridDim.z;
    unsigned sum, cnt, mine, sp = 0u;
    for (;;) {
        sum = 0u; cnt = 0u; mine = 0u;
#pragma unroll 1
        for (unsigned j = 0; j < 16; ++j) { const unsigned c = xb_ld(&bar[XB_XCNT(j)]); sum += c; cnt += (c > 0u) ? 1u : 0u; mine = (j == x) ? c : mine; }
        if (sum == G) break;
        __builtin_amdgcn_s_sleep(1);
        if ((++sp & 255u) == 0u) { if (xb_ld(&bar[XB_TMO])) break; if (sp > XB_SPIN_CAP) { atomicAdd(&bar[XB_TMO], 1u); break; } }
    }
    nloc = mine > 0u ? mine : 1u; nx = cnt > 0u ? cnt : 1u;
}
__device__ __forceinline__ void xcd_barrier(const XcdBarrier& b) {
    asm volatile("s_waitcnt vmcnt(0)" ::: "memory");
    __syncthreads();
    if (threadIdx.x == 0) {
        unsigned* bar = b.bar;
        __builtin_amdgcn_s_waitcnt(0);
        unsigned nloc = b.st[0], nx = b.st[1];
        if (nloc == 0u) { xcd_barrier_complete(bar, b.x, nloc, nx); b.st[0] = nloc; b.st[1] = nx; }
        const unsigned old = xb_add(&bar[XB_XSUB(b.x)], 1u);
        const unsigned gen = old / nloc;
        if (old + 1u == (gen + 1u) * nloc) {
            __builtin_amdgcn_fence(__ATOMIC_RELEASE, "agent");
            asm volatile("s_waitcnt vmcnt(0)" ::: "memory");
            const unsigned og = xb_add(&bar[XB_TOP], 1u);
            const unsigned tg = og / nx;
            if (og + 1u == (tg + 1u) * nx) xb_add(&bar[XB_TOPGEN], 1u);
            else XB_SPIN(xb_ld(&bar[XB_TOPGEN]) == tg, bar);
            __builtin_amdgcn_fence(__ATOMIC_ACQUIRE, "agent");
            xb_add(&bar[XB_XGEN(b.x)], 1u);
            asm volatile("s_waitcnt vmcnt(0)" ::: "memory");
        } else {
            XB_SPIN(xb_ld(&bar[XB_XGEN(b.x)]) == gen, bar);
            __builtin_amdgcn_fence(__ATOMIC_ACQUIRE, "agent");
            asm volatile("s_waitcnt vmcnt(0)" ::: "memory");
        }
    }
    __syncthreads();
}

namespace pg8 {
constexpr int BM = 256, BK = 64, HALF = 128, HTB = HALF * BK * 2, STAGE_BYTES = 8 * HTB, NXCD = 8, WGM = 8;
__device__ __forceinline__ int lds_byte(int r, int c) { const int st = (r >> 4) * 2 + (c >> 5), rr = r & 15, cc = c & 31, ob = rr * 64 + cc * 2; return st * 1024 + (ob ^ (((ob >> 9) & 1) << 5)); }
__device__ __forceinline__ void stage_rc(int b, int& R, int& C) { const int st = b / 1024, sb = b % 1024, swz = sb ^ (((sb >> 9) & 1) << 5); R = (st >> 1) * 16 + swz / 64; C = (st & 1) * 32 + (swz % 64) / 2; }
__device__ __forceinline__ int perm32(int rho) { const int n = rho >> 4, i = rho & 15; return 8 * (i >> 2) + 4 * n + (i & 3); }

struct Unit { int pm, pn; unsigned bofs; int aux; };

struct SchedDense {
    int nM, nN, nwg, G, c, K;
    __device__ void init(int M, int N, int K_, int G_, int c_) { nM = M / BM; nN = N / BM; nwg = nM * nN; G = G_; c = c_; K = K_; }
    __device__ bool next(int i, Unit& u) const {
        const long L = (long)i * G + c; if (L >= nwg) return false;
        int wgid = (int)L; { const int q = nwg / NXCD, r = nwg % NXCD, xcd = wgid % NXCD, off = wgid / NXCD; wgid = (xcd < r ? xcd * (q + 1) : r * (q + 1) + (xcd - r) * q) + off; }
        const int nig = WGM * nN, gid = wgid / nig, fm = gid * WGM, gsz = (nM - fm) < WGM ? (nM - fm) : WGM;
        u.pm = fm + ((wgid % nig) % gsz); u.pn = (wgid % nig) / gsz; u.bofs = (unsigned)u.pn * (unsigned)(BM * K * 2); u.aux = 0; return true;
    }
    __device__ __forceinline__ unsigned a_row(const Unit& u, int r) const { return (unsigned)(u.pm * BM + r); }
};
struct SchedGroup {
    const LAS int* tb; const LAS int* tokt; int G, c, K, gather;
    __device__ bool next(int i, Unit& u) const {
        const int L = i * G + c, nt = tb[NE]; if (L >= nt * 4) return false;
        const int g = L >> 2; int e = 0; while (tb[e + 1] <= g) ++e;
        u.pm = g; u.pn = L & 3; u.bofs = (unsigned)(e * 1024 + u.pn * BM) * (unsigned)(K * 2); u.aux = i; return true;
    }
    __device__ __forceinline__ unsigned a_row(const Unit& u, int r) const { return gather ? (unsigned)tokt[u.aux * 256 + r] : (unsigned)(u.pm * BM + r); }
};

__device__ __forceinline__ unsigned cvt_pk_bf16(float lo, float hi) { unsigned r; asm volatile("v_cvt_pk_bf16_f32 %0, %1, %2" : "=v"(r) : "v"(lo), "v"(hi)); return r; }

template <class Epi, class Sched, bool ALIGN_EPI, bool SP2>
__device__ __forceinline__ void gemm_phase(LAS unsigned char* lds, const int tid, const char* Abase, const char* Bbase, const int K, const Sched& S, const Epi& E) {
    const int wid = __builtin_amdgcn_readfirstlane(tid >> 6), lane = tid & 63, wr = wid >> 2, wc = wid & 3, fr = lane & 15, fq = lane >> 4;
    const int nt = K / BK;
    int Rr[2], Cc[2]; unsigned voffB[2];
#pragma unroll
    for (int i = 0; i < 2; ++i) { int R, C; stage_rc(tid * 16 + i * 8192, R, C); const int Rb = Epi::PERM ? ((R & ~31) + perm32(R & 31)) : R;
        Rr[i] = R; Cc[i] = C; voffB[i] = (unsigned)(Rb * K + C) * 2u; }
    const size_t kstep = (size_t)(BK * 2);
    const size_t hstep = (size_t)HALF * K * 2;
    const unsigned ldsw = (unsigned)wid * 1024u;
    const int aoff = lds_byte(wr * 64 + fr, fq * 8), boff = lds_byte(wc * 32 + fr, fq * 8);
#define PG8_SA(b, h) (((b) * 2 + (h)) * HTB)
#define PG8_SB(b, h) ((4 + (b) * 2 + (h)) * HTB)
#define PG8_STAGE(bufoff, gbase, voff) do { _Pragma("unroll") for (int _i = 0; _i < 2; ++_i) \
        __builtin_amdgcn_global_load_lds((const unsigned*)((const char*)(gbase) + (voff)[_i]), (LAS unsigned*)(lds + (bufoff) + ldsw + _i * 8192), 16, 0, 0); } while (0)
#define PG8_LDA(dst, b, h) do { _Pragma("unroll") for (int m = 0; m < 4; ++m) _Pragma("unroll") for (int k = 0; k < 2; ++k) dst[m][k] = *(const LAS bf16x8*)(lds + PG8_SA(b, h) + aoff + m * 2048 + k * 1024); } while (0)
#define PG8_LDB(dst, b, h) do { _Pragma("unroll") for (int n = 0; n < 2; ++n) _Pragma("unroll") for (int k = 0; k < 2; ++k) dst[n][k] = *(const LAS bf16x8*)(lds + PG8_SB(b, h) + boff + n * 2048 + k * 1024); } while (0)
#define PG8_MMA(ai, bj, At, Bt) do { __builtin_amdgcn_s_setprio(1); _Pragma("unroll") for (int m = 0; m < 4; ++m) _Pragma("unroll") for (int n = 0; n < 2; ++n) _Pragma("unroll") for (int k = 0; k < 2; ++k) \
        acc[ai][bj][m][n] = __builtin_amdgcn_mfma_f32_16x16x32_bf16(Bt[n][k], At[m][k], acc[ai][bj][m][n], 0, 0, 0); __builtin_amdgcn_s_setprio(0); } while (0)
#define PG8_WAIT_V(n) asm volatile("s_waitcnt vmcnt(" #n ")" ::: "memory")
#define PG8_WAIT_L(n) asm volatile("s_waitcnt lgkmcnt(" #n ")" ::: "memory")
#define PG8_BAR __builtin_amdgcn_s_barrier()
#define PG8_SCHED __builtin_amdgcn_sched_barrier(0)
#define PG8_AOFF(dst, u) do { _Pragma("unroll") for (int _h = 0; _h < 2; ++_h) _Pragma("unroll") for (int _i = 0; _i < 2; ++_i) \
        dst[_h][_i] = (S.a_row(u, _h * HALF + Rr[_i]) * (unsigned)K + (unsigned)Cc[_i]) * 2u; } while (0)
    Unit cur, nxt; int ui = 0;
    if (!S.next(0, cur)) return;
    f32x4 acc[2][2][4][2];
#pragma unroll
    for (int a = 0; a < 2; ++a)
#pragma unroll
        for (int b = 0; b < 2; ++b)
#pragma unroll
            for (int m = 0; m < 4; ++m)
#pragma unroll
                for (int n = 0; n < 2; ++n) acc[a][b][m][n] = (f32x4){0.f, 0.f, 0.f, 0.f};
    bf16x8 At[4][2], B0[2][2], B1[2][2];
    unsigned co[2][2], no[2][2];
    PG8_AOFF(co, cur);
    const char* cB = Bbase + cur.bofs;
    if constexpr (SP2) {
        PG8_STAGE(PG8_SB(0, 0), cB, voffB); PG8_STAGE(PG8_SB(0, 1), cB + hstep, voffB); PG8_STAGE(PG8_SA(0, 0), Abase, co[0]); PG8_STAGE(PG8_SA(0, 1), Abase, co[1]);
        if (wr == 1) PG8_BAR;
        PG8_WAIT_V(2); PG8_BAR;
        PG8_STAGE(PG8_SB(1, 0), cB + kstep, voffB); PG8_STAGE(PG8_SA(1, 0), Abase + kstep, co[0]); PG8_STAGE(PG8_SB(1, 1), cB + hstep + kstep, voffB);
        PG8_WAIT_V(6); PG8_BAR;
    } else {
        PG8_STAGE(PG8_SB(0, 0), cB, voffB); PG8_STAGE(PG8_SA(0, 0), Abase, co[0]); PG8_STAGE(PG8_SB(0, 1), cB + hstep, voffB); PG8_STAGE(PG8_SA(0, 1), Abase, co[1]);
        if (wr == 1) PG8_BAR;
        PG8_WAIT_V(4); PG8_BAR;
        PG8_STAGE(PG8_SB(1, 0), cB + kstep, voffB); PG8_STAGE(PG8_SA(1, 0), Abase + kstep, co[0]); PG8_STAGE(PG8_SB(1, 1), cB + hstep + kstep, voffB);
        PG8_WAIT_V(6); PG8_BAR;
    }
    for (;;) {
        const bool has_next = S.next(ui + 1, nxt);
        const char* nB = has_next ? Bbase + nxt.bofs : cB;
        if (has_next) { PG8_AOFF(no, nxt); } else {
#pragma unroll
            for (int h = 0; h < 2; ++h)
#pragma unroll
                for (int i = 0; i < 2; ++i) no[h][i] = co[h][i]; }
        for (int t = 0; t < nt; t += 2) {
            const bool last = (t == nt - 2);
            const char* a1 = Abase + (size_t)(t + 1) * kstep;
            const char* a2 = last ? Abase : Abase + (size_t)(t + 2) * kstep; const char* b2 = last ? nB : cB + (size_t)(t + 2) * kstep;
            const char* a3 = a2 + kstep; const char* b3 = b2 + kstep;
            unsigned o2[2][2];
#pragma unroll
            for (int h = 0; h < 2; ++h)
#pragma unroll
                for (int i = 0; i < 2; ++i) o2[h][i] = last ? no[h][i] : co[h][i];
            if constexpr (SP2) {
            PG8_LDB(B0, 0, 0); PG8_LDB(B1, 0, 1); PG8_SCHED; PG8_LDA(At, 0, 0); PG8_STAGE(PG8_SA(1, 1), a1, co[1]);
            PG8_WAIT_V(8); PG8_WAIT_L(0); PG8_BAR; PG8_MMA(0, 0, At, B0); PG8_MMA(0, 1, At, B1); PG8_BAR; PG8_SCHED;
            PG8_LDA(At, 0, 1); PG8_STAGE(PG8_SB(0, 0), b2, voffB); PG8_STAGE(PG8_SB(0, 1), b2 + hstep, voffB); PG8_STAGE(PG8_SA(0, 0), a2, o2[0]);
            PG8_WAIT_V(8); PG8_WAIT_L(0); PG8_BAR; PG8_MMA(1, 0, At, B0); PG8_MMA(1, 1, At, B1); PG8_BAR; PG8_SCHED;
            PG8_LDB(B0, 1, 0); PG8_LDB(B1, 1, 1); PG8_SCHED; PG8_LDA(At, 1, 0); PG8_STAGE(PG8_SA(0, 1), a2, o2[1]);
            PG8_WAIT_V(8); PG8_WAIT_L(0); PG8_BAR; PG8_MMA(0, 0, At, B0); PG8_MMA(0, 1, At, B1); PG8_BAR; PG8_SCHED;
            PG8_LDA(At, 1, 1); PG8_STAGE(PG8_SB(1, 0), b3, voffB); PG8_STAGE(PG8_SB(1, 1), b3 + hstep, voffB); PG8_STAGE(PG8_SA(1, 0), a3, o2[0]);
            PG8_WAIT_V(8); PG8_WAIT_L(0); PG8_BAR; PG8_MMA(1, 0, At, B0); PG8_MMA(1, 1, At, B1); PG8_BAR; PG8_SCHED;
            } else {
            PG8_LDB(B0, 0, 0); PG8_SCHED; PG8_LDA(At, 0, 0); PG8_STAGE(PG8_SA(1, 1), a1, co[1]);
            PG8_WAIT_L(8); PG8_BAR; PG8_WAIT_L(0); PG8_MMA(0, 0, At, B0); PG8_BAR; PG8_SCHED;
            PG8_LDB(B1, 0, 1); PG8_STAGE(PG8_SB(0, 0), b2, voffB);
            PG8_BAR; PG8_WAIT_L(0); PG8_MMA(0, 1, At, B1); PG8_BAR;
            PG8_LDA(At, 0, 1); PG8_STAGE(PG8_SA(0, 0), a2, o2[0]);
            PG8_BAR; PG8_WAIT_L(0); PG8_MMA(1, 0, At, B0); PG8_BAR; PG8_SCHED;
            PG8_STAGE(PG8_SB(0, 1), b2 + hstep, voffB);
            PG8_WAIT_V(6); PG8_BAR; PG8_MMA(1, 1, At, B1); PG8_BAR;
            PG8_LDB(B0, 1, 0); PG8_SCHED; PG8_LDA(At, 1, 0); PG8_STAGE(PG8_SA(0, 1), a2, o2[1]);
            PG8_WAIT_L(8); PG8_BAR; PG8_WAIT_L(0); PG8_MMA(0, 0, At, B0); PG8_BAR; PG8_SCHED;
            PG8_LDB(B1, 1, 1); PG8_STAGE(PG8_SB(1, 0), b3, voffB);
            PG8_BAR; PG8_WAIT_L(0); PG8_MMA(0, 1, At, B1); PG8_BAR;
            PG8_LDA(At, 1, 1); PG8_STAGE(PG8_SA(1, 0), a3, o2[0]);
            PG8_BAR; PG8_WAIT_L(0); PG8_MMA(1, 0, At, B0); PG8_BAR; PG8_SCHED;
            PG8_STAGE(PG8_SB(1, 1), b3 + hstep, voffB);
            PG8_WAIT_V(6); PG8_BAR; PG8_MMA(1, 1, At, B1); PG8_BAR;
            }
        }
        if constexpr (ALIGN_EPI) { if (wr == 0) PG8_BAR; }
        E(acc, cur, wr, wc, fr, fq);
        if (!has_next) break;
#pragma unroll
        for (int a = 0; a < 2; ++a)
#pragma unroll
            for (int b = 0; b < 2; ++b)
#pragma unroll
                for (int m = 0; m < 4; ++m)
#pragma unroll
                    for (int n = 0; n < 2; ++n) acc[a][b][m][n] = (f32x4){0.f, 0.f, 0.f, 0.f};
        cur = nxt; cB = nB; ++ui;
#pragma unroll
        for (int h = 0; h < 2; ++h)
#pragma unroll
            for (int i = 0; i < 2; ++i) co[h][i] = no[h][i];
        if constexpr (ALIGN_EPI) { if (wr == 1) PG8_BAR; }
    }
    PG8_WAIT_V(0);
    if constexpr (!ALIGN_EPI) { if (wr == 0) PG8_BAR; }
    PG8_BAR;
#undef PG8_SA
#undef PG8_SB
#undef PG8_STAGE
#undef PG8_LDA
#undef PG8_LDB
#undef PG8_MMA
#undef PG8_WAIT_V
#undef PG8_WAIT_L
#undef PG8_BAR
#undef PG8_SCHED
#undef PG8_AOFF
}

struct EpiInProj {
    static constexpr bool PERM = true;
    bf16_t* P; const float* ropeC; const float* ropeS;
    __device__ __forceinline__ void operator()(const f32x4 (&acc)[2][2][4][2], const Unit& u, int wr, int wc, int fr, int fq) const {
        const int row0 = u.pm * BM + wr * 64 + fr, col0 = u.pn * BM + wc * 32 + 8 * fq;
        const bool qk = u.pn < 4, rope = qk && (u.pm < NLAT / BM);
        const float ks = (u.pn >= 2 && u.pn < 4) ? 0.08838834764831845f : 1.0f;
        const int sec = wc >> 1, i0 = (wc & 1) * 16 + 4 * fq;
#pragma unroll
        for (int ai = 0; ai < 2; ++ai)
#pragma unroll
            for (int m = 0; m < 4; ++m) {
                const int row = row0 + ai * HALF + m * 16;
                asm volatile("" ::: "memory");
                f32x4 c4 = (f32x4){1.f, 1.f, 1.f, 1.f}, s4 = (f32x4){0.f, 0.f, 0.f, 0.f};
                if (rope) { const int t = row & (TL - 1), pos = sec ? (t & 63) : (t >> 6); const int ti = (sec ? 1024 : 0) + pos * 32 + i0;
                    c4 = *(const f32x4*)(ropeC + ti); s4 = *(const f32x4*)(ropeS + ti); }
                bf16_t* rowp = P + (size_t)row * NP + col0;
#pragma unroll
                for (int bj = 0; bj < 2; ++bj) {
                    f32x4 v0 = acc[ai][bj][m][0], v1 = acc[ai][bj][m][1];
                    if (qk) {
                        const float a0 = v0[0] * c4[0] - v0[1] * s4[0], b0 = v0[0] * s4[0] + v0[1] * c4[0];
                        const float a1 = v0[2] * c4[1] - v0[3] * s4[1], b1 = v0[2] * s4[1] + v0[3] * c4[1];
                        const float a2 = v1[0] * c4[2] - v1[1] * s4[2], b2 = v1[0] * s4[2] + v1[1] * c4[2];
                        const float a3 = v1[2] * c4[3] - v1[3] * s4[3], b3 = v1[2] * s4[3] + v1[3] * c4[3];
                        v0 = (f32x4){a0 * ks, b0 * ks, a1 * ks, b1 * ks}; v1 = (f32x4){a2 * ks, b2 * ks, a3 * ks, b3 * ks};
                    }
                    u32x4 w; w.x = cvt_pk_bf16(v0[0], v0[1]); w.y = cvt_pk_bf16(v0[2], v0[3]); w.z = cvt_pk_bf16(v1[0], v1[1]); w.w = cvt_pk_bf16(v1[2], v1[3]);
                    *(u32x4*)(rowp + bj * HALF) = w;
                }
            }
    }
};
struct EpiResid {
    static constexpr bool PERM = true;
    const float* rl; const float* rc; const bf16_t* rb; bf16_t* ob; float* ssq; const float* gmod;
    __device__ __forceinline__ void operator()(const f32x4 (&acc)[2][2][4][2], const Unit& u, int wr, int wc, int fr, int fq) const {
        const int row0 = u.pm * BM + wr * 64 + fr, col0 = u.pn * BM + wc * 32 + 8 * fq;
        const bool lat = u.pm < NLAT / BM; const int b = lat ? (u.pm >> 3) : 16;
        const float* rbase = rl ? (lat ? rl : rc - (size_t)NLAT * D) : nullptr;
        f32x4 gv[2][2];
#pragma unroll
        for (int bj = 0; bj < 2; ++bj)
#pragma unroll
            for (int n = 0; n < 2; ++n) gv[bj][n] = *(const f32x4*)(gmod + (size_t)b * 6 * D + col0 + bj * HALF + 4 * n);
#pragma unroll
        for (int ai = 0; ai < 2; ++ai)
#pragma unroll
            for (int m = 0; m < 4; ++m) { const int row = row0 + ai * HALF + m * 16; const size_t off = (size_t)row * D + col0; float ss = 0.f;
#pragma unroll
                for (int bj = 0; bj < 2; ++bj) { f32x4 r0, r1;
                    if (rbase) { r0 = *(const f32x4*)(rbase + off + bj * HALF); r1 = *(const f32x4*)(rbase + off + bj * HALF + 4); }
                    else { const u32x4 w = *(const u32x4*)(rb + off + bj * HALF); r0 = (f32x4){bflo(w.x), bfhi(w.x), bflo(w.y), bfhi(w.y)}; r1 = (f32x4){bflo(w.z), bfhi(w.z), bflo(w.w), bfhi(w.w)}; }
                    const f32x4 v0 = r0 + gv[bj][0] * acc[ai][bj][m][0], v1 = r1 + gv[bj][1] * acc[ai][bj][m][1];
                    ss += (v0[0] * v0[0] + v0[1] * v0[1]) + (v0[2] * v0[2] + v0[3] * v0[3]) + (v1[0] * v1[0] + v1[1] * v1[1]) + (v1[2] * v1[2] + v1[3] * v1[3]);
                    u32x4 w; w.x = cvt_pk_bf16(v0[0], v0[1]); w.y = cvt_pk_bf16(v0[2], v0[3]); w.z = cvt_pk_bf16(v1[0], v1[1]); w.w = cvt_pk_bf16(v1[2], v1[3]);
                    *(u32x4*)(ob + off + bj * HALF) = w; }
                ss += __shfl_xor(ss, 16); ss += __shfl_xor(ss, 32);
                if (fq == 0) ssq[(size_t)row * 16 + u.pn * 4 + wc] = ss;
                if (m & 1) asm volatile("" ::: "memory"); }
    }
};
struct EpiSwiGLU {
    static constexpr bool PERM = true;
    bf16_t* O;
    __device__ __forceinline__ void operator()(const f32x4 (&acc)[2][2][4][2], const Unit& u, int wr, int wc, int fr, int fq) const {
        const int row0 = u.pm * BM + wr * 64 + fr, col0 = u.pn * 128 + wc * 16 + 4 * fq;
#pragma unroll
        for (int ai = 0; ai < 2; ++ai)
#pragma unroll
            for (int m = 0; m < 4; ++m) { bf16_t* rowp = O + (size_t)(row0 + ai * HALF + m * 16) * FF + col0;
#pragma unroll
                for (int bj = 0; bj < 2; ++bj) { const f32x4 g = acc[ai][bj][m][0], up = acc[ai][bj][m][1];
                    u32x2 w; w.x = cvt_pk_bf16(silu_f(g[0]) * up[0], silu_f(g[1]) * up[1]); w.y = cvt_pk_bf16(silu_f(g[2]) * up[2], silu_f(g[3]) * up[3]);
                    *(u32x2*)(rowp + bj * 64) = w; } }
    }
};
struct EpiBf16 {
    static constexpr bool PERM = true;
    bf16_t* O; int ldc;
    __device__ __forceinline__ void operator()(const f32x4 (&acc)[2][2][4][2], const Unit& u, int wr, int wc, int fr, int fq) const {
        const int row0 = u.pm * BM + wr * 64 + fr, col0 = u.pn * BM + wc * 32 + 8 * fq;
#pragma unroll
        for (int ai = 0; ai < 2; ++ai)
#pragma unroll
            for (int m = 0; m < 4; ++m) { bf16_t* rowp = O + (size_t)(row0 + ai * HALF + m * 16) * ldc + col0;
#pragma unroll
                for (int bj = 0; bj < 2; ++bj) { const f32x4 v0 = acc[ai][bj][m][0], v1 = acc[ai][bj][m][1];
                    u32x4 w; w.x = cvt_pk_bf16(v0[0], v0[1]); w.y = cvt_pk_bf16(v0[2], v0[3]); w.z = cvt_pk_bf16(v1[0], v1[1]); w.w = cvt_pk_bf16(v1[2], v1[3]);
                    *(u32x4*)(rowp + bj * HALF) = w; } }
    }
};
}

struct Args { const float* in[22]; float* out; unsigned char* ws; int ph_lo, ph_hi; };
enum { I_X = 0, I_C, I_CTX, I_CCTX, I_ADAW, I_ADAB, I_N1G, I_WIN, I_DF, I_DB, I_POOLW, I_POOLS, I_WOUT, I_N2G, I_RGW, I_RGB, I_REW, I_REB, I_WG, I_WU, I_WDN, I_FNG };

struct Frame {
    LAS unsigned char* lds; int tid, lane, wave, G, bx, vcu;
    const float* const* in; float* out; unsigned char* ws;
};
__device__ __forceinline__ bf16_t* xb_row(const Frame& F, int row) { return (bf16_t*)(F.ws + WS_XB) + (size_t)row * D; }
__device__ __forceinline__ bf16_t* hbuf(const Frame& F) { return (bf16_t*)F.out; }
__device__ __forceinline__ const float* mod_ptr(const Frame& F, int l, int b, int which) { return (const float*)(F.ws + WS_MOD) + ((size_t)(l * 17 + b) * 6 + which) * D; }

__device__ __forceinline__ void tr_item(const float* colp, size_t ldw, int k0, bf16_t* WT, int K, int n0, LAS float* scr, int lane) {
#pragma unroll
    for (int hb = 0; hb < 2; ++hb) { float v[16];
#pragma unroll
        for (int i = 0; i < 16; ++i) v[i] = colp[(size_t)(k0 + 2 * (hb * 16 + i) + (lane >> 5)) * ldw];
#pragma unroll
        for (int i = 0; i < 16; ++i) scr[(2 * (hb * 16 + i) + (lane >> 5)) * 33 + (lane & 31)] = v[i]; }
    asm volatile("s_waitcnt lgkmcnt(0)" ::: "memory");
    const int c = lane & 7;
#pragma unroll
    for (int j = 0; j < 4; ++j) { const int n = (lane >> 3) + 8 * j; const LAS float* s = scr + (8 * c) * 33 + n;
        u32x4 o; o.x = pk2(s[0 * 33], s[1 * 33]); o.y = pk2(s[2 * 33], s[3 * 33]); o.z = pk2(s[4 * 33], s[5 * 33]); o.w = pk2(s[6 * 33], s[7 * 33]);
        *(u32x4*)(WT + (size_t)(n0 + n) * K + k0 + 8 * c) = o; }
    asm volatile("s_waitcnt lgkmcnt(0)" ::: "memory");
}
__device__ __forceinline__ void fold_item(const float* win, const float* pw, const float* ps, int k0, bf16_t* WT, int n0, LAS float* scr, int lane) {
    const int n = n0 + (lane & 31), g = n >> 7, nn = n & 127;
    const float* pwc = pw + (size_t)g * 128 * 128 + nn; const float sc = ps[n];
    float acc[32];
#pragma unroll
    for (int i = 0; i < 32; ++i) acc[i] = 0.f;
    for (int hc = 0; hc < 8; ++hc) {
        float pc[16];
#pragma unroll
        for (int c = 0; c < 16; ++c) pc[c] = pwc[(size_t)(hc * 16 + c) * 128];
#pragma unroll
        for (int i = 0; i < 32; ++i) { const f32x4* wr = (const f32x4*)(win + (size_t)(k0 + 2 * i + (lane >> 5)) * NP + 2048 + g * 128 + hc * 16);
            float a = acc[i];
#pragma unroll
            for (int c4 = 0; c4 < 4; ++c4) { const f32x4 w = wr[c4]; a += w[0] * pc[4 * c4] + w[1] * pc[4 * c4 + 1] + w[2] * pc[4 * c4 + 2] + w[3] * pc[4 * c4 + 3]; }
            acc[i] = a; }
    }
#pragma unroll
    for (int i = 0; i < 32; ++i) scr[(2 * i + (lane >> 5)) * 33 + (lane & 31)] = acc[i] * sc;
    asm volatile("s_waitcnt lgkmcnt(0)" ::: "memory");
    const int c = lane & 7;
#pragma unroll
    for (int j = 0; j < 4; ++j) { const int nl = (lane >> 3) + 8 * j; const LAS float* s = scr + (8 * c) * 33 + nl;
        u32x4 o; o.x = pk2(s[0 * 33], s[1 * 33]); o.y = pk2(s[2 * 33], s[3 * 33]); o.z = pk2(s[4 * 33], s[5 * 33]); o.w = pk2(s[6 * 33], s[7 * 33]);
        *(u32x4*)(WT + (size_t)(2048 + n0 + nl) * D + k0 + 8 * c) = o; }
    asm volatile("s_waitcnt lgkmcnt(0)" ::: "memory");
}
__device__ __forceinline__ void p0_prologue(const Frame& F, int qsel) {
    for (int task = F.bx; task < 2 * 96; task += F.G) {
        const int l = task / 96, cg = task % 96;
        LAS float* sc = (LAS float*)F.lds;
        LAS float* part = (LAS float*)(F.lds + 17 * 1024 * 4);
        for (int i = F.tid; i < 17 * 1024; i += 512) { const int b = i >> 10, k = i & 1023; const float v = b < 16 ? F.in[I_C][b * D + k] : F.in[I_CCTX][k]; sc[i] = silu_f(v); }
        __syncthreads();
        float acc[17];
#pragma unroll
        for (int b = 0; b < 17; ++b) acc[b] = 0.f;
        const float* aw = F.in[I_ADAW] + (size_t)l * D * 6 * D + cg * 64 + F.lane;
        for (int k0 = F.wave * 128; k0 < F.wave * 128 + 128; k0 += 16) { float w[16];
#pragma unroll
            for (int u = 0; u < 16; ++u) w[u] = aw[(size_t)(k0 + u) * 6 * D];
#pragma unroll
            for (int u = 0; u < 16; ++u) {
#pragma unroll
                for (int b = 0; b < 17; ++b) acc[b] += sc[b * 1024 + k0 + u] * w[u]; } }
#pragma unroll
        for (int b = 0; b < 17; ++b) part[(F.wave * 17 + b) * 64 + F.lane] = acc[b];
        __syncthreads();
        for (int i = F.tid; i < 17 * 64; i += 512) { const int b = i >> 6, n = i & 63; float s = F.in[I_ADAB][l * 6 * D + cg * 64 + n];
#pragma unroll
            for (int w = 0; w < 8; ++w) s += part[(w * 17 + b) * 64 + n];
            const int col = cg * 64 + n; ((float*)(F.ws + WS_MOD))[((size_t)(l * 17 + b) * 6 + (col >> 10)) * D + (col & 1023)] = s; }
        __syncthreads();
    }
    if (F.bx == F.G - 1) {
        float* rc = (float*)(F.ws + WS_ROPE); float* rs = rc + 96 * 32;
        for (int i = F.tid; i < 96 * 32; i += 512) { const int p = i >> 5, f = i & 31; const int pos = p < 32 ? p : p - 32;
            const float inv = powf(10000.0f, -(float)f / 32.0f); const float ang = (float)pos * inv; rc[i] = cosf(ang); rs[i] = sinf(ang); }
    }
    LAS float* scr = (LAS float*)(F.lds + F.wave * 8448);
    constexpr int IT_WIN = 16 * 80, IT_WOUT = 16 * 32, IT_GU = 16 * 32, IT_DN = 8 * 32;
    constexpr int N_WIN = DEPTH * IT_WIN, N_WOUT = DEPTH * IT_WOUT, N_GU = DEPTH * NE * IT_GU, N_DN = DEPTH * NE * IT_DN;
    unsigned* qhead = (unsigned*)(F.ws + WS_CTL) + CW_QUEUE + 16 * qsel;
    constexpr int N_ALL = N_WIN + N_WOUT + N_GU + N_DN, QB = 16, NBATCH = N_ALL / QB;
    static_assert(N_ALL % QB == 0, "queue batches");
    for (;;) {
        int bq = 0; if (F.lane == 0) bq = (int)__hip_atomic_fetch_add(qhead, 1u, __ATOMIC_RELAXED, __HIP_MEMORY_SCOPE_AGENT);
        bq = __builtin_amdgcn_readfirstlane(bq);
        if (bq >= NBATCH) break;
      for (int qi = 0; qi < QB; ++qi) {
        int r = bq + qi * NBATCH;
        if (r < N_WIN) { const int l = r / IT_WIN; r %= IT_WIN; const int kb = r & 15, nb = 79 - (r >> 4), n0 = nb * 32;
            const float* win = F.in[I_WIN] + (size_t)l * D * NP; bf16_t* WT = (bf16_t*)(F.ws + WS_WIN) + (size_t)l * NP * D;
            if (n0 >= 2048) { fold_item(win, F.in[I_POOLW] + (size_t)l * 4 * 128 * 128, F.in[I_POOLS] + l * 512, kb * 64, WT, n0 - 2048, scr, F.lane); continue; }
            const int n = n0 + (F.lane & 31); int src = n;
            if (n < 1024) { const int hh = n >> 7, j = n & 127, sec = j >> 6, jj = j & 63; src = (n & 512) + (hh & 3) * 128 + sec * 64 + (jj & 1) * 32 + (jj >> 1); }
            tr_item(win + src, NP, kb * 64, WT, D, n0, scr, F.lane); continue; }
        r -= N_WIN;
        if (r < N_WOUT) { const int l = r / IT_WOUT; r %= IT_WOUT; const int kb = r / 32, nb = r % 32, n0 = nb * 32;
            tr_item(F.in[I_WOUT] + (size_t)l * D * D + n0 + (F.lane & 31), D, kb * 64, (bf16_t*)(F.ws + WS_WOUT) + (size_t)l * D * D, D, n0, scr, F.lane); continue; }
        r -= N_WOUT;
        if (r < N_GU) { const int le = r / IT_GU; r %= IT_GU; const int kb = r / 32, nb = r % 32, n0 = nb * 32;
            const int n = n0 + (F.lane & 31), col = (n >> 3) * 4 + (n & 3); const float* src = ((n & 4) ? F.in[I_WU] : F.in[I_WG]) + (size_t)le * D * FF + col;
            tr_item(src, FF, kb * 64, (bf16_t*)(F.ws + WS_WGU) + (size_t)le * 1024 * D, D, n0, scr, F.lane); continue; }
        r -= N_GU;
        { const int le = r / IT_DN; r %= IT_DN; const int kb = r / 32, nb = r % 32, n0 = nb * 32;
            tr_item(F.in[I_WDN] + (size_t)le * FF * D + n0 + (F.lane & 31), D, kb * 64, (bf16_t*)(F.ws + WS_WD) + (size_t)le * D * FF, FF, n0, scr, F.lane); }
      }
    }
}

__device__ __forceinline__ LAS int* build_tb(const Frame& F, int l) {
    LAS int* tb = (LAS int*)(F.lds + MISC_OFF + 64);
    if (F.tid == 0) { const unsigned* cnt = (const unsigned*)(F.ws + WS_CTL) + CW_CNT + l * NE * 16; int s = 0;
#pragma unroll 1
        for (int e = 0; e < NE; ++e) { tb[e] = s; const int c = (int)__hip_atomic_load(cnt + e * 16, __ATOMIC_RELAXED, __HIP_MEMORY_SCOPE_AGENT); tb[64 + e] = c; s += (c + 255) >> 8; }
        tb[NE] = s; }
    __syncthreads();
    return tb;
}

__device__ __forceinline__ void row_op_a(const Frame& F, int mode, bool dry) {
    const int gw = F.vcu * 8 + F.wave, NGW = F.G * 8;
    const int nrows = (mode == 2) ? NLAT : NTOK; const int l = (mode == 0) ? 0 : 1, lp = mode - 1;
    const LAS int* tb = nullptr; if (mode != 0) tb = build_tb(F, lp);
    const bf16_t* YB = (const bf16_t*)(F.ws + WS_P); bf16_t* H = hbuf(F);
    const float* gain = (mode == 2) ? F.in[I_FNG] : F.in[I_N1G] + l * D;
    int4 ti = make_int4(0, 0, 0, 0), nti = ti; f32x2 tw = (f32x2){0.f, 0.f}, ntw = tw;
    if (mode != 0 && gw < nrows) { ti = *(const int4*)(F.ws + WS_TOKINFO + (size_t)gw * 32); tw = *(const f32x2*)(F.ws + WS_TOKINFO + (size_t)gw * 32 + 16); }
    for (int row = gw; row < nrows; row += NGW) {
        const int b = row < NLAT ? (row >> 11) : 16;
        if (mode != 0 && row + NGW < nrows) { nti = *(const int4*)(F.ws + WS_TOKINFO + (size_t)(row + NGW) * 32); ntw = *(const f32x2*)(F.ws + WS_TOKINFO + (size_t)(row + NGW) * 32 + 16); }
        f32x4 v[4];
        if (mode == 0) { const f32x4* src = (const f32x4*)(row < NLAT ? F.in[I_X] + (size_t)row * D : F.in[I_CTX] + (size_t)(row - NLAT) * D) + F.lane;
#pragma unroll
            for (int j = 0; j < 4; ++j) v[j] = src[64 * j];
        } else {
            const size_t s1 = (size_t)(tb[ti.x] * 256 + ti.y), s2 = (size_t)(tb[ti.z] * 256 + ti.w);
            bf16_t* xr = xb_row(F, row); const f32x4* g2 = (const f32x4*)mod_ptr(F, lp, b, 5) + F.lane;
            const u32x2* y1 = (const u32x2*)(YB + s1 * D) + F.lane; const u32x2* y2 = (const u32x2*)(YB + s2 * D) + F.lane;
#pragma unroll
            for (int j = 0; j < 4; ++j) { const u32x2 xw = ((const u32x2*)xr)[F.lane + 64 * j]; const f32x4 x = (f32x4){bflo(xw.x), bfhi(xw.x), bflo(xw.y), bfhi(xw.y)};
                const u32x2 a = y1[64 * j], c = y2[64 * j]; const f32x4 g = g2[64 * j];
                f32x4 y; y[0] = tw.x * bflo(a.x) + tw.y * bflo(c.x); y[1] = tw.x * bfhi(a.x) + tw.y * bfhi(c.x); y[2] = tw.x * bflo(a.y) + tw.y * bflo(c.y); y[3] = tw.x * bfhi(a.y) + tw.y * bfhi(c.y);
                v[j] = x + g * y; if (mode == 1 && !dry) { u32x2 w; w.x = pk2(v[j][0], v[j][1]); w.y = pk2(v[j][2], v[j][3]); ((u32x2*)xr)[F.lane + 64 * j] = w; } }
        }
        float ss = 0.f;
#pragma unroll
        for (int j = 0; j < 4; ++j) ss += (v[j][0] * v[j][0] + v[j][1] * v[j][1]) + (v[j][2] * v[j][2] + v[j][3] * v[j][3]);
        const float rstd = 1.0f / sqrtf(wave_sum(ss) * (1.0f / D) + EPS);
        if (mode == 2) {
#pragma unroll
            for (int j = 0; j < 4; ++j) { const f32x4 g = ((const f32x4*)gain)[F.lane + 64 * j]; ((f32x4*)((dry ? (float*)(F.ws + WS_WGU) : F.out) + (size_t)row * D))[F.lane + 64 * j] = v[j] * rstd * g; }
        } else {
            const f32x4* sh = (const f32x4*)mod_ptr(F, l, b, 0) + F.lane; const f32x4* sc = (const f32x4*)mod_ptr(F, l, b, 1) + F.lane;
            u32x2* o = (u32x2*)(H + (size_t)row * D) + F.lane;
#pragma unroll
            for (int j = 0; j < 4; ++j) { const f32x4 g = ((const f32x4*)gain)[F.lane + 64 * j]; const f32x4 h = v[j] * rstd * g * (sc[64 * j] + 1.0f) + sh[64 * j];
                u32x2 w; w.x = pk2(h[0], h[1]); w.y = pk2(h[2], h[3]); o[64 * j] = w; }
        }
        ti = nti; tw = ntw;
    }
}

template <bool DRY> __device__ __forceinline__ void route_row(const Frame& F, int l, int row, const float (&s)[36], unsigned* cnt, int* list) {
    const float* rgb = F.in[I_RGB] + l * 4; const float* reb = F.in[I_REB] + l * NE;
    float gl[4];
#pragma unroll
    for (int i = 0; i < 4; ++i) gl[i] = s[i] + rgb[i];
    int gt = 0; float gm = gl[0];
#pragma unroll
    for (int i = 1; i < 4; ++i) if (gl[i] > gm) { gm = gl[i]; gt = i; }
    float gs = 0.f;
#pragma unroll
    for (int i = 0; i < 4; ++i) gs += expf(gl[i] - gm);
    const float gwt = 1.0f / gs;
    float el[8];
#pragma unroll
    for (int j = 0; j < 8; ++j) { const float a = gt == 0 ? s[4 + j] : gt == 1 ? s[12 + j] : gt == 2 ? s[20 + j] : s[28 + j]; el[j] = a + reb[gt * 8 + j]; }
    int i1 = 0; float v1 = el[0];
#pragma unroll
    for (int j = 1; j < 8; ++j) if (el[j] > v1) { v1 = el[j]; i1 = j; }
    int i2 = -1; float v2 = -3.0e38f;
#pragma unroll
    for (int j = 0; j < 8; ++j) if (j != i1 && el[j] > v2) { v2 = el[j]; i2 = j; }
    const float e2 = expf(v2 - v1); const float w1 = gwt / (1.0f + e2), w2 = gwt * e2 / (1.0f + e2);
    if (!DRY) {
        const int x1 = gt * 8 + i1, x2 = gt * 8 + i2;
        const int r1 = (int)__hip_atomic_fetch_add(cnt + x1 * 16, 1u, __ATOMIC_RELAXED, __HIP_MEMORY_SCOPE_AGENT);
        const int r2 = (int)__hip_atomic_fetch_add(cnt + x2 * 16, 1u, __ATOMIC_RELAXED, __HIP_MEMORY_SCOPE_AGENT);
        list[(size_t)x1 * NTOK + r1] = row; list[(size_t)x2 * NTOK + r2] = row;
        *(int4*)(F.ws + WS_TOKINFO + (size_t)row * 32) = make_int4(x1, r1, x2, r2); *(f32x2*)(F.ws + WS_TOKINFO + (size_t)row * 32 + 16) = (f32x2){w1, w2};
    }
}
template <bool DRY> __device__ __forceinline__ void row_op_b(const Frame& F, int l) {
    const int gw = F.vcu * 8 + F.wave, NGW = F.G * 8;
    const int ngroups = ((l == 0) ? NTOK : NLAT) / 16;
    { const float* rg = F.in[I_RGW] + (size_t)l * D * 4; const float* re = F.in[I_REW] + (size_t)l * D * NE;
      for (int i = F.tid; i < 1024 * 36; i += 512) { const int k = i / 36, n = i % 36; const float w = n < 4 ? rg[k * 4 + n] : re[k * NE + (n - 4)];
          const unsigned hi = f2bf(w), lo = f2bf(w - bflo(hi));
          *(LAS bf16_t*)(F.lds + n * RW_PITCH + k * 2) = (bf16_t)hi; *(LAS bf16_t*)(F.lds + RW_LO + n * RW_PITCH + k * 2) = (bf16_t)lo; } }
    __syncthreads();
    bf16_t* H = hbuf(F);
    const float* gain = F.in[I_N2G] + l * D;
    unsigned* cnt = (unsigned*)(F.ws + WS_CTL) + CW_CNT + l * NE * 16;
    int* list = (int*)(F.ws + WS_LIST);
    const int fr = F.lane & 15, fq = F.lane >> 4;
    unsigned bo[3];
#pragma unroll
    for (int nt = 0; nt < 3; ++nt) { const int n = 16 * nt + fr; bo[nt] = (unsigned)((n < 36 ? n : 35) * RW_PITCH + fq * 16); }
    LAS float* ex = (LAS float*)(F.lds + RW_EX + F.wave * 1152);
    for (int gi = gw; gi < ngroups; gi += NGW) {
        const int row = gi * 16 + fr, b = row < NLAT ? (row >> 11) : 16;
        const bf16_t* xr = xb_row(F, row) + fq * 8;
        float ss;
        { const f32x4* sp = (const f32x4*)((const float*)(F.ws + WS_SSQ) + (size_t)row * 16); const f32x4 p0 = sp[0], p1 = sp[1], p2 = sp[2], p3 = sp[3];
          ss = ((p0[0] + p0[1]) + (p0[2] + p0[3])) + ((p1[0] + p1[1]) + (p1[2] + p1[3])) + ((p2[0] + p2[1]) + (p2[2] + p2[3])) + ((p3[0] + p3[1]) + (p3[2] + p3[3])); }
        const float rstd = 1.0f / sqrtf(ss * (1.0f / D) + EPS);
        const float* shp = mod_ptr(F, l, b, 3) + fq * 8; const float* scp = mod_ptr(F, l, b, 4) + fq * 8; const float* gp = gain + fq * 8;
        bf16_t* hp = H + (size_t)row * D + fq * 8;
        f32x4 acc[3];
#pragma unroll
        for (int nt = 0; nt < 3; ++nt) acc[nt] = (f32x4){0.f, 0.f, 0.f, 0.f};
#pragma unroll 2
        for (int s = 0; s < 32; ++s) {
            const u32x4 xw = *(const u32x4*)(xr + 32 * s);
            const f32x4 x0 = (f32x4){bflo(xw.x), bfhi(xw.x), bflo(xw.y), bfhi(xw.y)}, x1 = (f32x4){bflo(xw.z), bfhi(xw.z), bflo(xw.w), bfhi(xw.w)};
            const f32x4 g0 = *(const f32x4*)(gp + 32 * s), g1 = *(const f32x4*)(gp + 32 * s + 4);
            const f32x4 c0 = *(const f32x4*)(scp + 32 * s), c1 = *(const f32x4*)(scp + 32 * s + 4);
            const f32x4 s0 = *(const f32x4*)(shp + 32 * s), s1 = *(const f32x4*)(shp + 32 * s + 4);
            const f32x4 h0 = x0 * rstd * g0 * (c0 + 1.0f) + s0, h1 = x1 * rstd * g1 * (c1 + 1.0f) + s1;
            u32x4 hi, lo;
            hi.x = pk2(h0[0], h0[1]); hi.y = pk2(h0[2], h0[3]); hi.z = pk2(h1[0], h1[1]); hi.w = pk2(h1[2], h1[3]);
            lo.x = pk2(h0[0] - bflo(hi.x), h0[1] - bfhi(hi.x)); lo.y = pk2(h0[2] - bflo(hi.y), h0[3] - bfhi(hi.y));
            lo.z = pk2(h1[0] - bflo(hi.z), h1[1] - bfhi(hi.z)); lo.w = pk2(h1[2] - bflo(hi.w), h1[3] - bfhi(hi.w));
            *(u32x4*)(hp + 32 * s) = hi;
            const bf16x8 ah = __builtin_bit_cast(bf16x8, hi), al = __builtin_bit_cast(bf16x8, lo);
#pragma unroll
            for (int nt = 0; nt < 3; ++nt) {
                const bf16x8 bh = *(const LAS bf16x8*)(F.lds + bo[nt] + s * 64), bl = *(const LAS bf16x8*)(F.lds + RW_LO + bo[nt] + s * 64);
                acc[nt] = __builtin_amdgcn_mfma_f32_16x16x32_bf16(ah, bh, acc[nt], 0, 0, 0);
                acc[nt] = __builtin_amdgcn_mfma_f32_16x16x32_bf16(ah, bl, acc[nt], 0, 0, 0);
                acc[nt] = __builtin_amdgcn_mfma_f32_16x16x32_bf16(al, bh, acc[nt], 0, 0, 0);
            }
        }
#pragma unroll
        for (int hf = 0; hf < 2; ++hf) {
            if ((fq >> 1) == hf) {
#pragma unroll
                for (int nt = 0; nt < 3; ++nt) { const int n = 16 * nt + fr;
                    if (n < 36) {
#pragma unroll
                        for (int r = 0; r < 4; ++r) ex[((fq & 1) * 4 + r) * 36 + n] = acc[nt][r]; } }
            }
            asm volatile("s_waitcnt lgkmcnt(0)" ::: "memory");
            if (F.lane < 8) { float sl[36];
#pragma unroll
                for (int n = 0; n < 36; ++n) sl[n] = ex[F.lane * 36 + n];
                route_row<DRY>(F, l, gi * 16 + hf * 8 + F.lane, sl, cnt, list); }
            asm volatile("s_waitcnt lgkmcnt(0)" ::: "memory");
        }
    }
    __syncthreads();
}

__device__ __forceinline__ unsigned off_b(unsigned row, unsigned ch) { return 256u * row + 16u * (ch ^ (((row & 3) << 2) | ((row >> 2) & 3))); }
__device__ __forceinline__ unsigned tr_base_p(unsigned lane) { const unsigned g = lane >> 4, q = (lane & 15) >> 2, p = lane & 3; return off_b(4 * g + q, (p >> 1)) + 8 * (p & 1); }
template <int O0, int O1, int O2, int O3>
__device__ __forceinline__ void tr_frag4(bf16x8 (&f)[4], unsigned a0, unsigned a1, unsigned a2, unsigned a3) {
    s16x4 l0, h0, l1, h1, l2, h2, l3, h3;
    asm volatile("ds_read_b64_tr_b16 %0, %8 offset:%12\n\tds_read_b64_tr_b16 %1, %8 offset:%16\n\t"
                 "ds_read_b64_tr_b16 %2, %9 offset:%13\n\tds_read_b64_tr_b16 %3, %9 offset:%17\n\t"
                 "ds_read_b64_tr_b16 %4, %10 offset:%14\n\tds_read_b64_tr_b16 %5, %10 offset:%18\n\t"
                 "ds_read_b64_tr_b16 %6, %11 offset:%15\n\tds_read_b64_tr_b16 %7, %11 offset:%19\n\ts_waitcnt lgkmcnt(0)"
                 : "=&v"(l0), "=&v"(h0), "=&v"(l1), "=&v"(h1), "=&v"(l2), "=&v"(h2), "=&v"(l3), "=&v"(h3)
                 : "v"(a0), "v"(a1), "v"(a2), "v"(a3), "n"(O0), "n"(O1), "n"(O2), "n"(O3), "n"(O0 + 4096), "n"(O1 + 4096), "n"(O2 + 4096), "n"(O3 + 4096) : "memory");
    f[0] = __builtin_shufflevector(l0, h0, 0, 1, 2, 3, 4, 5, 6, 7); f[1] = __builtin_shufflevector(l1, h1, 0, 1, 2, 3, 4, 5, 6, 7);
    f[2] = __builtin_shufflevector(l2, h2, 0, 1, 2, 3, 4, 5, 6, 7); f[3] = __builtin_shufflevector(l3, h3, 0, 1, 2, 3, 4, 5, 6, 7);
}
template <int O>
__device__ __forceinline__ void tr_frag8(bf16x8 (&f)[8], unsigned a) {
    s16x4 l0, h0, l1, h1, l2, h2, l3, h3, l4, h4, l5, h5, l6, h6, l7, h7;
    const unsigned a1 = a ^ 32u, a2 = a ^ 64u, a3 = a ^ 96u, a4 = a ^ 128u, a5 = a ^ 160u, a6 = a ^ 192u, a7 = a ^ 224u;
    asm volatile("ds_read_b64_tr_b16 %0, %8 offset:%12\n\tds_read_b64_tr_b16 %1, %8 offset:%13\n\t"
                 "ds_read_b64_tr_b16 %2, %9 offset:%12\n\tds_read_b64_tr_b16 %3, %9 offset:%13\n\t"
                 "ds_read_b64_tr_b16 %4, %10 offset:%12\n\tds_read_b64_tr_b16 %5, %10 offset:%13\n\t"
                 "ds_read_b64_tr_b16 %6, %11 offset:%12\n\tds_read_b64_tr_b16 %7, %11 offset:%13"
                 : "=&v"(l0), "=&v"(h0), "=&v"(l1), "=&v"(h1), "=&v"(l2), "=&v"(h2), "=&v"(l3), "=&v"(h3)
                 : "v"(a), "v"(a1), "v"(a2), "v"(a3), "n"(O), "n"(O + 4096) : "memory");
    asm volatile("ds_read_b64_tr_b16 %0, %16 offset:%20\n\tds_read_b64_tr_b16 %1, %16 offset:%21\n\t"
                 "ds_read_b64_tr_b16 %2, %17 offset:%20\n\tds_read_b64_tr_b16 %3, %17 offset:%21\n\t"
                 "ds_read_b64_tr_b16 %4, %18 offset:%20\n\tds_read_b64_tr_b16 %5, %18 offset:%21\n\t"
                 "ds_read_b64_tr_b16 %6, %19 offset:%20\n\tds_read_b64_tr_b16 %7, %19 offset:%21\n\ts_waitcnt lgkmcnt(0)"
                 : "=&v"(l4), "=&v"(h4), "=&v"(l5), "=&v"(h5), "=&v"(l6), "=&v"(h6), "=&v"(l7), "=&v"(h7),
                   "+v"(l0), "+v"(h0), "+v"(l1), "+v"(h1), "+v"(l2), "+v"(h2), "+v"(l3), "+v"(h3)
                 : "v"(a4), "v"(a5), "v"(a6), "v"(a7), "n"(O), "n"(O + 4096) : "memory");
    f[0] = __builtin_shufflevector(l0, h0, 0, 1, 2, 3, 4, 5, 6, 7); f[1] = __builtin_shufflevector(l1, h1, 0, 1, 2, 3, 4, 5, 6, 7);
    f[2] = __builtin_shufflevector(l2, h2, 0, 1, 2, 3, 4, 5, 6, 7); f[3] = __builtin_shufflevector(l3, h3, 0, 1, 2, 3, 4, 5, 6, 7);
    f[4] = __builtin_shufflevector(l4, h4, 0, 1, 2, 3, 4, 5, 6, 7); f[5] = __builtin_shufflevector(l5, h5, 0, 1, 2, 3, 4, 5, 6, 7);
    f[6] = __builtin_shufflevector(l6, h6, 0, 1, 2, 3, 4, 5, 6, 7); f[7] = __builtin_shufflevector(l7, h7, 0, 1, 2, 3, 4, 5, 6, 7);
}
#define LBAR() do { asm volatile("s_waitcnt lgkmcnt(0)" ::: "memory"); __builtin_amdgcn_s_barrier(); asm volatile("" ::: "memory"); } while (0)
__device__ __forceinline__ int chunk_row0(int b, int ci) { return ci < 2 ? NLAT + b * CT + ci * 128 : b * TL + (ci - 2) * 128; }
__device__ __forceinline__ float log2_gamma(float decay) { return -log1pf(expf(-decay)) * 1.4426950408889634f; }

template <int HALF>
__device__ __forceinline__ void pool_item(const LAS unsigned char* tile, bf16_t* A2, int t0, int T, int rbase, int rl, int cg) {
    const int t = t0 + rl; int cnt = 0;
    float s[8];
#pragma unroll
    for (int i = 0; i < 8; ++i) s[i] = 0.f;
    u32x4 c = (u32x4){0u, 0u, 0u, 0u};
#pragma unroll
    for (int w = 0; w < 2 * HALF; ++w) { const int tt = t - HALF + w; const bool ok = tt >= 0 && tt < T;
        u32x4 x = *(const LAS u32x4*)(tile + (rl + 8 - HALF + w) * 1024 + cg * 16); if (!ok) x = (u32x4){0u, 0u, 0u, 0u}; cnt += ok ? 1 : 0; if (w == HALF) c = x;
        s[0] += bflo(x.x); s[1] += bfhi(x.x); s[2] += bflo(x.y); s[3] += bfhi(x.y); s[4] += bflo(x.z); s[5] += bfhi(x.z); s[6] += bflo(x.w); s[7] += bfhi(x.w); }
    const float inv = 1.0f / (float)cnt;
    u32x4 o; o.x = pk2(s[0] * inv - bflo(c.x), s[1] * inv - bfhi(c.x)); o.y = pk2(s[2] * inv - bflo(c.y), s[3] * inv - bfhi(c.y));
    o.z = pk2(s[4] * inv - bflo(c.z), s[5] * inv - bfhi(c.z)); o.w = pk2(s[6] * inv - bflo(c.w), s[7] * inv - bfhi(c.w));
    *(u32x4*)(A2 + (size_t)(rbase + t) * D + 512 + cg * 8) = o;
}

__device__ __forceinline__ void p3a_states_pool(const Frame& F, int l) {
    const bf16_t* P = (const bf16_t*)(F.ws + WS_P);
    bf16_t* ST = (bf16_t*)(F.ws + WS_ACT);
    bf16_t* A2 = hbuf(F);
    const int nstate = (F.G > 128) ? 128 : F.G;
    if (F.bx < nstate) {
        for (int unit = F.bx; unit < 128; unit += nstate) {
            const int dir = unit & 1, bh = unit >> 1, b = bh >> 2, h = bh & 3;
            const float lg2 = log2_gamma((dir ? F.in[I_DB] : F.in[I_DF])[l * NH + h]);
            const float gC = exp2f(lg2 * 128.0f);
            f32x4 acc[8];
#pragma unroll
            for (int dt = 0; dt < 8; ++dt) acc[dt] = (f32x4){0.f, 0.f, 0.f, 0.f};
            u32x4 kr[8], vr[8];
#define P3A_CI(n_) (dir ? ((n_) < 2 ? 1 - (n_) : 19 - (n_)) : (n_))
#define P3A_LOAD(st_) do { _Pragma("unroll") for (int sub = 0; sub < 2; ++sub) { const int r0_ = chunk_row0(b, P3A_CI(2 * (st_) + sub)); \
                _Pragma("unroll") for (int q = 0; q < 4; ++q) { const int p = F.tid + 512 * q, j = p >> 4, ch = p & 15; \
                    kr[sub * 4 + q] = *(const u32x4*)(P + (size_t)(r0_ + j) * NP + 512 + h * 128 + ch * 8); vr[sub * 4 + q] = *(const u32x4*)(P + (size_t)(r0_ + j) * NP + 1024 + h * 128 + ch * 8); } } } while (0)
#define P3A_STORE(n_) do { bf16_t* sp = ST + ((size_t)((bh * 2 + dir) * NCHUNK + P3A_CI(n_)) * 128 + (F.wave * 16 + (F.lane & 15))) * 128 + 4 * (F.lane >> 4); \
                _Pragma("unroll") for (int dt = 0; dt < 8; ++dt) { u32x2 w; w.x = pk2(acc[dt][0], acc[dt][1]); w.y = pk2(acc[dt][2], acc[dt][3]); *(u32x2*)(sp + dt * 16) = w; } } while (0)
#define P3A_KS(KO, VO, ks) do { bf16x8 ka[8]; tr_frag8<(KO) + (ks) * 8192>(ka, tpk); \
                _Pragma("unroll") for (int dt = 0; dt < 8; ++dt) acc[dt] = __builtin_amdgcn_mfma_f32_16x16x32_bf16(ka[dt], vb[ks], acc[dt], 0, 0, 0); } while (0)
#define P3A_SUB(KO, VO) do { _Pragma("unroll") for (int dt = 0; dt < 8; ++dt) acc[dt] *= gC; \
                bf16x8 vb[4]; tr_frag4<(VO), (VO) + 8192, (VO) + 16384, (VO) + 24576>(vb, tpv, tpv, tpv, tpv); \
                P3A_KS(KO, VO, 0); P3A_KS(KO, VO, 1); P3A_KS(KO, VO, 2); P3A_KS(KO, VO, 3); } while (0)
            P3A_LOAD(0);
            for (int st = 0; st < 9; ++st) {
#pragma unroll
                for (int sub = 0; sub < 2; ++sub)
#pragma unroll
                    for (int q = 0; q < 4; ++q) { const int p = F.tid + 512 * q, j = p >> 4, ch = p & 15;
                        const float kd = __builtin_amdgcn_exp2f(lg2 * (float)(dir ? j : 127 - j));
                        const u32x4 kk = kr[sub * 4 + q];
                        u32x4 ks; ks.x = pk2(bflo(kk.x) * kd, bfhi(kk.x) * kd); ks.y = pk2(bflo(kk.y) * kd, bfhi(kk.y) * kd); ks.z = pk2(bflo(kk.z) * kd, bfhi(kk.z) * kd); ks.w = pk2(bflo(kk.w) * kd, bfhi(kk.w) * kd);
                        *(LAS u32x4*)(F.lds + sub * 32768 + off_b(j, ch)) = ks; *(LAS u32x4*)(F.lds + 65536 + sub * 32768 + off_b(j, ch)) = vr[sub * 4 + q]; }
                LBAR();
                if (st < 8) P3A_LOAD(st + 1);
                const unsigned tpk = (unsigned)(size_t)F.lds + tr_base_p(F.lane); const unsigned tpv = (tpk ^ ((unsigned)F.wave << 5)) + 65536u;
                P3A_STORE(2 * st);
                P3A_SUB(0, 0);
                P3A_STORE(2 * st + 1);
                if (st < 8) P3A_SUB(32768, 32768);
                LBAR();
            }
#undef P3A_SUB
#undef P3A_KS
#undef P3A_STORE
#undef P3A_LOAD
#undef P3A_CI
        }
    } else {
        const int pb = F.bx - nstate, npb = F.G - nstate;
        u32x4 ld[10];
#define POOL_LOAD(tile_) do { const int r0_ = (tile_) * 64; int t0_, T_, rb_; if (r0_ < NLAT) { t0_ = r0_ & (TL - 1); T_ = TL; } else { t0_ = (r0_ - NLAT) & (CT - 1); T_ = CT; } rb_ = r0_ - t0_; \
            _Pragma("unroll") for (int q = 0; q < 10; ++q) { const int p = F.tid + 512 * q, rr = p >> 6, ch = p & 63; int tt = t0_ - 8 + rr; tt = tt < 0 ? 0 : (tt >= T_ ? T_ - 1 : tt); \
                ld[q] = *(const u32x4*)(P + (size_t)(rb_ + tt) * NP + 2048 + ch * 8); } } while (0)
        if (pb < 576) POOL_LOAD(pb);
        for (int tile = pb; tile < 576; tile += npb) {
            const int r0 = tile * 64; int t0, T; if (r0 < NLAT) { t0 = r0 & (TL - 1); T = TL; } else { t0 = (r0 - NLAT) & (CT - 1); T = CT; } const int rbase = r0 - t0;
            LBAR();
#pragma unroll
            for (int q = 0; q < 10; ++q) { const int p = F.tid + 512 * q; *(LAS u32x4*)(F.lds + (p >> 6) * 1024 + (p & 63) * 16) = ld[q]; }
            LBAR();
            if (tile + npb < 576) POOL_LOAD(tile + npb);
            for (int wi = F.wave; wi < 64; wi += 8) { const int g = wi & 3, rl = (wi >> 2) * 4 + (F.lane >> 4), cg = g * 16 + (F.lane & 15);
                if (g == 0) pool_item<1>(F.lds, A2, t0, T, rbase, rl, cg); else if (g == 1) pool_item<2>(F.lds, A2, t0, T, rbase, rl, cg);
                else if (g == 2) pool_item<4>(F.lds, A2, t0, T, rbase, rl, cg); else pool_item<8>(F.lds, A2, t0, T, rbase, rl, cg); }
        }
#undef POOL_LOAD
    }
    __syncthreads();
}

__device__ __forceinline__ void p3b_retention(const Frame& F, int l) {
    const bf16_t* P = (const bf16_t*)(F.ws + WS_P);
    const bf16_t* ST = (const bf16_t*)(F.ws + WS_ACT);
    bf16_t* A2 = hbuf(F);
    const int c_lo = (l == DEPTH - 1) ? 2 : 0, ncu = NCHUNK - c_lo, nunits = 64 * ncu;
    u32x4 ld[8], st[8]; bf16x8 qf[4];
#define P3B_LOAD(unit_) do { const int bh_ = (unit_) / ncu, ci_ = c_lo + (unit_) % ncu, h_ = bh_ & 3; const int r0_ = chunk_row0(bh_ >> 2, ci_); \
        _Pragma("unroll") for (int q = 0; q < 4; ++q) { const int p = F.tid + 512 * q, j = p >> 4, ch = p & 15; \
            ld[q] = *(const u32x4*)(P + (size_t)(r0_ + j) * NP + 512 + h_ * 128 + ch * 8); ld[4 + q] = *(const u32x4*)(P + (size_t)(r0_ + j) * NP + 1024 + h_ * 128 + ch * 8); } } while (0)
#define P3B_LOADQ(unit_) do { const int bh_ = (unit_) / ncu, ci_ = c_lo + (unit_) % ncu, h_ = bh_ & 3; const int r0_ = chunk_row0(bh_ >> 2, ci_); \
        _Pragma("unroll") for (int ks = 0; ks < 4; ++ks) qf[ks] = *(const bf16x8*)(P + (size_t)(r0_ + F.wave * 16 + (F.lane & 15)) * NP + h_ * 128 + ks * 32 + (F.lane >> 4) * 8); } while (0)
    if (F.vcu < nunits) { P3B_LOAD(F.vcu); P3B_LOADQ(F.vcu); }
    for (int unit = F.vcu; unit < nunits; unit += F.G) {
        int lane_o = F.lane; asm volatile("" : "+v"(lane_o));
        const int fr = lane_o & 15, fq = lane_o >> 4;
        const unsigned rr0 = off_b((unsigned)fr, (unsigned)fq), tp = (unsigned)(size_t)F.lds + tr_base_p((unsigned)lane_o);
        const int il = F.wave * 16 + fr;
        const int bh = unit / ncu, ci = c_lo + unit % ncu, b = bh >> 2, h = bh & 3;
        const float lgf = log2_gamma(F.in[I_DF][l * NH + h]), lgb = log2_gamma(F.in[I_DB][l * NH + h]);
        const int row0 = chunk_row0(b, ci);
        { const bf16_t* sf = ST + ((size_t)((bh * 2 + 0) * NCHUNK + ci) * 128) * 128; const bf16_t* sb = ST + ((size_t)((bh * 2 + 1) * NCHUNK + ci) * 128) * 128;
#pragma unroll
          for (int q = 0; q < 4; ++q) { const int p = F.tid + 512 * q, j = p >> 4, ch = p & 15; st[q] = *(const u32x4*)(sf + (size_t)j * 128 + ch * 8); st[4 + q] = *(const u32x4*)(sb + (size_t)j * 128 + ch * 8); } }
        LBAR();
#pragma unroll
        for (int q = 0; q < 4; ++q) { const int p = F.tid + 512 * q, j = p >> 4, ch = p & 15; const unsigned o = off_b(j, ch);
            *(LAS u32x4*)(F.lds + o) = ld[q]; *(LAS u32x4*)(F.lds + 32768u + o) = ld[4 + q]; }
        LBAR();
        if (unit + F.G < nunits) P3B_LOAD(unit + F.G);
        u32x2 gg[8];
#pragma unroll
        for (int et = 0; et < 8; ++et) gg[et] = *(const u32x2*)(P + (size_t)(row0 + il) * NP + 1536 + h * 128 + 4 * fq + et * 16);
        bf16x8 pf[4];
#pragma unroll
        for (int ks2 = 0; ks2 < 4; ++ks2) {
            u32x2 half[2];
#pragma unroll
            for (int t = 0; t < 2; ++t) { const int jt = 2 * ks2 + t;
                asm volatile("" ::: "memory");
                f32x4 sa = (f32x4){0.f, 0.f, 0.f, 0.f};
#pragma unroll
                for (int ks = 0; ks < 4; ++ks) { const bf16x8 ka = *(const LAS bf16x8*)(F.lds + ((rr0 ^ ((unsigned)ks << 6)) + 4096u * jt)); sa = __builtin_amdgcn_mfma_f32_16x16x32_bf16(ka, qf[ks], sa, 0, 0, 0); }
                float pv[4];
#pragma unroll
                for (int r = 0; r < 4; ++r) { const int j = 16 * jt + 4 * fq + r, df = il - j;
                    const float w = df > 0 ? __builtin_amdgcn_exp2f(lgf * (float)df) : (df < 0 ? __builtin_amdgcn_exp2f(lgb * (float)(-df)) : 2.0f); pv[r] = sa[r] * w; }
                half[t].x = pk2(pv[0], pv[1]); half[t].y = pk2(pv[2], pv[3]); }
            const u32x4 w4 = (u32x4){half[0].x, half[0].y, half[1].x, half[1].y};
            pf[ks2] = __builtin_bit_cast(bf16x8, w4);
        }
#pragma unroll
        for (int q = 0; q < 4; ++q) { const int p = F.tid + 512 * q, j = p >> 4, ch = p & 15; const unsigned o = off_b(j, ch);
            *(LAS u32x4*)(F.lds + 65536u + o) = st[q]; *(LAS u32x4*)(F.lds + 98304u + o) = st[4 + q]; }
        LBAR();
        const float qdf = __builtin_amdgcn_exp2f(lgf * (float)(il + 1)), qdb = __builtin_amdgcn_exp2f(lgb * (float)(128 - il));
        float o[8][4]; float ss = 0.f;
#pragma unroll
        for (int et = 0; et < 8; ++et) {
            f32x4 ao = (f32x4){0.f, 0.f, 0.f, 0.f}, af = ao, ab = ao;
            bf16x8 va[4]; { const unsigned a = tp ^ ((unsigned)et << 5); tr_frag4<32768, 32768 + 8192, 32768 + 16384, 32768 + 24576>(va, a, a, a, a); }
#pragma unroll
            for (int ks = 0; ks < 4; ++ks) {
                ao = __builtin_amdgcn_mfma_f32_16x16x32_bf16(va[ks], pf[ks], ao, 0, 0, 0);
                const unsigned ra = (rr0 ^ ((unsigned)ks << 6)) + 4096u * et;
                const bf16x8 fa = *(const LAS bf16x8*)(F.lds + 65536u + ra);
                af = __builtin_amdgcn_mfma_f32_16x16x32_bf16(fa, qf[ks], af, 0, 0, 0);
                const bf16x8 ba = *(const LAS bf16x8*)(F.lds + 98304u + ra);
                ab = __builtin_amdgcn_mfma_f32_16x16x32_bf16(ba, qf[ks], ab, 0, 0, 0);
            }
#pragma unroll
            for (int r = 0; r < 4; ++r) { o[et][r] = ao[r] + qdf * af[r] + qdb * ab[r]; ss += o[et][r] * o[et][r]; }
        }
        if (unit + F.G < nunits) P3B_LOADQ(unit + F.G);
        ss += __shfl_xor(ss, 16); ss += __shfl_xor(ss, 32);
        const float rstd = 1.0f / sqrtf(ss * (1.0f / 128.0f) + EPS);
        bf16_t* op = A2 + (size_t)(row0 + il) * D + h * 128 + 4 * fq;
#pragma unroll
        for (int et = 0; et < 8; ++et) { const u32x2 g = gg[et];
            u32x2 w; w.x = pk2(silu_f(bflo(g.x)) * o[et][0] * rstd, silu_f(bfhi(g.x)) * o[et][1] * rstd); w.y = pk2(silu_f(bflo(g.y)) * o[et][2] * rstd, silu_f(bfhi(g.y)) * o[et][3] * rstd);
            *(u32x2*)(op + et * 16) = w; }
    }
#undef P3B_LOAD
#undef P3B_LOADQ
    __syncthreads();
}

#ifndef TYPE_MASK
#define TYPE_MASK 0x3ff
#endif
#define PTYPE(k) ((k) == 0 ? 0 : ((k) == 17 ? 9 : 1 + (((k) - 1) & 7)))
#define ENTER() do { if (PROBE_REPEAT >= 0) __syncthreads(); int _t = threadIdx.x; asm volatile("" : "+v"(_t)); F.tid = _t; F.lane = _t & 63; F.wave = __builtin_amdgcn_readfirstlane(_t >> 6); } while (0)
#define IN(k) (((TYPE_MASK >> PTYPE(k)) & 1) && lo <= (k) && (k) < hi)
#define SEAM(k) do { if (IN(k) && IN((k) + 1)) xcd_barrier(bar); } while (0)
#define REP(t) for (int rep = (PROBE_REPEAT == (t)) ? 0 : 1; rep < 2; ++rep)


template <int l> __device__ __forceinline__ void layer_phases(Frame& F, const XcdBarrier& bar, const int lo, const int hi) {
        const int pb = 1 + 8 * l;
        const bool last = (l == DEPTH - 1);
        const int Mrows = last ? NLAT : NTOK;
        if (IN(pb + 0)) REP(1) { ENTER(); row_op_a(F, l == 0 ? 0 : 1, rep == 0); }
        SEAM(pb + 0);
        if (IN(pb + 1)) REP(2) { ENTER();
            pg8::SchedDense S; S.init(NTOK, NP, D, F.G, F.bx);
            pg8::EpiInProj E{(bf16_t*)(F.ws + WS_P), (const float*)(F.ws + WS_ROPE), (const float*)(F.ws + WS_ROPE) + 96 * 32};
            pg8::gemm_phase<pg8::EpiInProj, pg8::SchedDense, true, true>(F.lds, F.tid, (const char*)hbuf(F), (const char*)(F.ws + WS_WIN) + (size_t)l * NP * D * 2, D, S, E);
        }
        SEAM(pb + 1);
        if (IN(pb + 2)) REP(3) { ENTER(); p3a_states_pool(F, l); }
        SEAM(pb + 2);
        if (IN(pb + 3)) REP(4) { ENTER(); p3b_retention(F, l); }
        SEAM(pb + 3);
        if (IN(pb + 4)) REP(5) { ENTER();
            pg8::SchedDense S; S.init(Mrows, D, D, F.G, F.bx);
            pg8::EpiResid E;
            if (l == 0) { E.rl = F.in[I_X]; E.rc = F.in[I_CTX]; E.rb = nullptr; } else { E.rl = nullptr; E.rc = nullptr; E.rb = (const bf16_t*)(F.ws + WS_XB); }
            E.ob = (rep == 0) ? (bf16_t*)(F.ws + WS_P) : (bf16_t*)(F.ws + WS_XB); E.ssq = (float*)(F.ws + WS_SSQ); E.gmod = mod_ptr(F, l, 0, 2);
            pg8::gemm_phase<pg8::EpiResid, pg8::SchedDense, true, true>(F.lds, F.tid, (const char*)hbuf(F), (const char*)(F.ws + WS_WOUT) + (size_t)l * D * D * 2, D, S, E);
        }
        SEAM(pb + 4);
        if (IN(pb + 5)) REP(6) { ENTER(); if (PROBE_REPEAT == 6 && rep == 0) row_op_b<true>(F, l); else row_op_b<false>(F, l); }
        SEAM(pb + 5);
        if (IN(pb + 6)) REP(7) { ENTER();
            LAS int* tb = build_tb(F, l);
            LAS int* tokt = (LAS int*)(F.lds + TOKT_OFF);
            const int* list = (const int*)(F.ws + WS_LIST);
            pg8::SchedGroup S; S.tb = tb; S.tokt = tokt; S.G = F.G; S.c = F.vcu; S.K = D; S.gather = 1;
            { pg8::Unit u; for (int i = 0; i < 8 && S.next(i, u); ++i) { const int g = u.pm; int e = 0; while (tb[e + 1] <= g) ++e; const int rt = g - tb[e], cnt = tb[64 + e];
                if (F.tid < 256) { int r = rt * 256 + F.tid; if (r >= cnt) r = cnt - 1; tokt[i * 256 + F.tid] = list[(size_t)e * NTOK + r]; } } }
            __syncthreads();
            pg8::EpiSwiGLU E{(bf16_t*)(F.ws + WS_ACT)};
            pg8::gemm_phase<pg8::EpiSwiGLU, pg8::SchedGroup, true, true>(F.lds, F.tid, (const char*)hbuf(F), (const char*)(F.ws + WS_WGU) + (size_t)l * NE * 1024 * D * 2, D, S, E);
        }
        SEAM(pb + 6);
        if (IN(pb + 7)) REP(8) { ENTER();
            LAS int* tb = build_tb(F, l);
            pg8::SchedGroup S; S.tb = tb; S.tokt = nullptr; S.G = F.G; S.c = F.vcu; S.K = FF; S.gather = 0;
            pg8::EpiBf16 E{(bf16_t*)(F.ws + WS_P), D};
            pg8::gemm_phase<pg8::EpiBf16, pg8::SchedGroup, true, true>(F.lds, F.tid, (const char*)(F.ws + WS_ACT), (const char*)(F.ws + WS_WD) + (size_t)l * NE * D * FF * 2, FF, S, E);
        }
        SEAM(pb + 7);
}

__global__ void __launch_bounds__(512, 2) fwd_kernel(Args args) {
    extern __shared__ __attribute__((aligned(16))) unsigned char lds_raw[];
    Frame F;
    F.lds = (LAS unsigned char*)lds_raw; F.tid = threadIdx.x; F.lane = F.tid & 63; F.wave = __builtin_amdgcn_readfirstlane(F.tid >> 6);
    F.G = gridDim.x; F.bx = blockIdx.x; F.vcu = (F.G % 8 == 0) ? (F.bx % 8) * (F.G / 8) + F.bx / 8 : F.bx;
    F.in = args.in; F.out = args.out; F.ws = args.ws;
    volatile LAS unsigned* MISC = (volatile LAS unsigned*)(F.lds + MISC_OFF);
    if (F.tid < 4) MISC[F.tid] = 0u;
    __syncthreads();
    unsigned* ctl = (unsigned*)(F.ws + WS_CTL);
    XcdBarrier bar; bar.bar = ctl + CW_BAR; bar.x = 0; bar.st = nullptr;
    const int lo = args.ph_lo, hi = args.ph_hi;
    const bool multi = (hi - lo) > 1;
    if (multi) bar = xcd_barrier_post(ctl + CW_BAR, MISC);
    if (IN(0)) REP(0) { ENTER(); p0_prologue(F, rep); }
    SEAM(0);
    layer_phases<0>(F, bar, lo, hi);
    layer_phases<1>(F, bar, lo, hi);
    if (IN(17)) REP(9) { ENTER(); row_op_a(F, 2, rep == 0); }
#undef IN
#undef SEAM
}

extern "C" void kernel_launch(void* const* d_in, const int* in_sizes, int n_in, void* d_out, int out_size, void* d_ws, size_t ws_size, hipStream_t stream) {
    static int grid = 0;
    if (grid == 0) {
        if (n_in != 22 || out_size != NLAT * D || ws_size < WS_END) { fprintf(stderr, "kernel_launch: unexpected shapes (n_in %d, out %d, ws %zu)\n", n_in, out_size, ws_size); grid = -1; return; }
        int dev = 0, cus = 0, per_cu = 0;
        if (hipGetDevice(&dev) != hipSuccess || hipDeviceGetAttribute(&cus, hipDeviceAttributeMultiprocessorCount, dev) != hipSuccess) { grid = -1; return; }
        if (hipFuncSetAttribute((const void*)fwd_kernel, hipFuncAttributeMaxDynamicSharedMemorySize, LDS_BYTES) != hipSuccess) { fprintf(stderr, "kernel_launch: hipFuncSetAttribute failed\n"); grid = -1; return; }
        if (hipOccupancyMaxActiveBlocksPerMultiprocessor(&per_cu, (const void*)fwd_kernel, 512, LDS_BYTES) != hipSuccess || per_cu < 1) { fprintf(stderr, "kernel_launch: occupancy query says %d\n", per_cu); }
        (void)hipGetLastError();
        grid = cus;
    }
    if (grid < 0) return;
    (void)hipMemsetAsync((char*)d_ws + WS_CTL, 0, CTL_ZERO_BYTES, stream);
    Args a{};
    for (int i = 0; i < 22; ++i) a.in[i] = (const float*)d_in[i];
    a.out = (float*)d_out; a.ws = (unsigned char*)d_ws;
    if (MK_N_LAUNCHES == 1) { a.ph_lo = 0; a.ph_hi = N_PHASES; hipLaunchKernelGGL(fwd_kernel, dim3(grid), dim3(512), LDS_BYTES, stream, a); }
    else { for (int p = 0; p < N_PHASES; ++p) { a.ph_lo = p; a.ph_hi = p + 1; hipLaunchKernelGGL(fwd_kernel, dim3(grid), dim3(512), LDS_BYTES, stream, a); } }
}
```

```cpp
#include <hip/hip_runtime.h>
#include <cstdio>
#include <cstdint>

#ifndef MK_N_LAUNCHES
#define MK_N_LAUNCHES 1
#endif

#ifndef PROBE_REPEAT
#define PROBE_REPEAT -1
#endif
#define LAS __attribute__((address_space(3)))
#define GAS __attribute__((address_space(1)))
typedef unsigned short bf16_t;
typedef short bf16x8 __attribute__((ext_vector_type(8)));
typedef short s16x4 __attribute__((ext_vector_type(4)));
typedef float f32x4 __attribute__((ext_vector_type(4)));
typedef float f32x2 __attribute__((ext_vector_type(2)));
typedef unsigned u32x4 __attribute__((ext_vector_type(4)));
typedef unsigned u32x2 __attribute__((ext_vector_type(2)));

constexpr int Bn = 16, TL = 2048, CT = 256, D = 1024, DEPTH = 2;
constexpr int NLAT = Bn * TL, NCTX = Bn * CT, NTOK = NLAT + NCTX;
constexpr int NP = 2560;
constexpr int NE = 32, FF = 512, NH = 4, HD = 128;
constexpr int NCHUNK = 18;
constexpr float EPS = 1e-6f;
constexpr int MAXTILES = 320;
constexpr int N_PHASES = 18;

constexpr size_t MiB = 1u << 20;
constexpr size_t WS_CTL = 0, CTL_ZERO_BYTES = 1 * MiB;
constexpr size_t WS_MOD = 1 * MiB;
constexpr size_t WS_ROPE = 2 * MiB;
constexpr size_t WS_TOKINFO = 3 * MiB;
constexpr size_t WS_LIST = 5 * MiB;
constexpr size_t WS_WIN = 10 * MiB;
constexpr size_t WS_WOUT = 20 * MiB;
constexpr size_t WS_WGU = 24 * MiB;
constexpr size_t WS_WD = 152 * MiB;
constexpr size_t WS_SSQ = 216 * MiB;
constexpr size_t WS_XB = 232 * MiB;
constexpr size_t WS_P = 304 * MiB;
constexpr size_t WS_ACT = 484 * MiB;
constexpr size_t WS_END = 564 * MiB;
constexpr int CW_TMO = 0;
constexpr int CW_QUEUE = 512;
constexpr int CW_CNT = 1024;
constexpr int CW_BAR = 4096;

constexpr int RING_BYTES = 131072;
constexpr int TOKT_OFF = RING_BYTES;
constexpr int MISC_OFF = 161792;
constexpr int RW_PITCH = 2064;
constexpr int RW_LO = 36 * RW_PITCH, RW_EX = 2 * 36 * RW_PITCH;
constexpr int LDS_BYTES = 163840;

__device__ __forceinline__ unsigned f2bf(float f) { unsigned u = __builtin_bit_cast(unsigned, f); return (u + 0x7fffu + ((u >> 16) & 1u)) >> 16; }
typedef __bf16 bf16x2_t __attribute__((ext_vector_type(2)));
__device__ __forceinline__ unsigned pk2(float lo, float hi) { const f32x2 f = {lo, hi}; const bf16x2_t v = __builtin_convertvector(f, bf16x2_t); return __builtin_bit_cast(unsigned, v); }
__device__ __forceinline__ float bflo(unsigned w) { return __builtin_bit_cast(float, w << 16); }
__device__ __forceinline__ float bfhi(unsigned w) { return __builtin_bit_cast(float, w & 0xffff0000u); }
__device__ __forceinline__ float wave_sum(float v) {
#pragma unroll
    for (int o = 1; o < 64; o <<= 1) v += __shfl_xor(v, o);
    return v;
}
__device__ __forceinline__ float silu_f(float x) { return x * __builtin_amdgcn_rcpf(1.0f + __builtin_amdgcn_exp2f(-1.4426950408889634f * x)); }

#define XB_TMO      128
#define XB_XCNT(j)  (256  + 64 * (j))
#define XB_XSUB(j)  (1280 + 64 * (j))
#define XB_XGEN(j)  (2304 + 64 * (j))
#define XB_TOP      3328
#define XB_TOPGEN   3392
#define XCD_BAR_WORDS 3456
#define XB_SPIN_CAP (1u << 18)
__device__ __forceinline__ unsigned xb_ld(unsigned* p)              { return __hip_atomic_load(p, __ATOMIC_RELAXED, __HIP_MEMORY_SCOPE_AGENT); }
__device__ __forceinline__ unsigned xb_add(unsigned* p, unsigned v) { return __hip_atomic_fetch_add(p, v, __ATOMIC_RELAXED, __HIP_MEMORY_SCOPE_AGENT); }
__device__ __forceinline__ unsigned xb_xcc_id() { return (unsigned)__builtin_amdgcn_s_getreg((3 << 11) | 20) & 0xFu; }
#define XB_SPIN(cond, bar) do { unsigned _sp = 0; while (cond) { __builtin_amdgcn_s_sleep(1); \
    if ((++_sp & 255u) == 0u) { if (xb_ld(&(bar)[XB_TMO])) break; if (_sp > XB_SPIN_CAP) { atomicAdd(&(bar)[XB_TMO], 1u); break; } } } } while (0)
struct XcdBarrier { unsigned* bar; unsigned x; volatile LAS unsigned* st; };
__device__ __forceinline__ XcdBarrier xcd_barrier_post(unsigned* bar, volatile LAS unsigned* st) {
    XcdBarrier b; b.bar = bar; b.x = xb_xcc_id(); b.st = st;
    if (threadIdx.x == 0) (void)xb_add(&bar[XB_XCNT(b.x)], 1u);
    return b;
}
__device__ __forceinline__ void xcd_barrier_complete(unsigned* bar, unsigned x, unsigned& nloc, unsigned& nx) {
    const unsigned G = gridDim.x * gridDim.y * gridDim.z;
    unsigned sum, cnt, mine, sp = 0u;
    for (;;) {
        sum = 0u; cnt = 0u; mine = 0u;
#pragma unroll 1
        for (unsigned j = 0; j < 16; ++j) { const unsigned c = xb_ld(&bar[XB_XCNT(j)]); sum += c; cnt += (c > 0u) ? 1u : 0u; mine = (j == x) ? c : mine; }
        if (sum == G) break;
        __builtin_amdgcn_s_sleep(1);
        if ((++sp & 255u) == 0u) { if (xb_ld(&bar[XB_TMO])) break; if (sp > XB_SPIN_CAP) { atomicAdd(&bar[XB_TMO], 1u); break; } }
    }
    nloc = mine > 0u ? mine : 1u; nx = cnt > 0u ? cnt : 1u;
}
__device__ __forceinline__ void xcd_barrier(const XcdBarrier& b) {
    asm volatile("s_waitcnt vmcnt(0)" ::: "memory");
    __syncthreads();
    if (threadIdx.x == 0) {
        unsigned* bar = b.bar;
        __builtin_amdgcn_s_waitcnt(0);
        unsigned nloc = b.st[0], nx = b.st[1];
        if (nloc == 0u) { xcd_barrier_complete(bar, b.x, nloc, nx); b.st[0] = nloc; b.st[1] = nx; }
        const unsigned old = xb_add(&bar[XB_XSUB(b.x)], 1u);
        const unsigned gen = old / nloc;
        if (old + 1u == (gen + 1u) * nloc) {
            __builtin_amdgcn_fence(__ATOMIC_RELEASE, "agent");
            asm volatile("s_waitcnt vmcnt(0)" ::: "memory");
            const unsigned og = xb_add(&bar[XB_TOP], 1u);
            const unsigned tg = og / nx;
            if (og + 1u == (tg + 1u) * nx) xb_add(&bar[XB_TOPGEN], 1u);
            else XB_SPIN(xb_ld(&bar[XB_TOPGEN]) == tg, bar);
            __builtin_amdgcn_fence(__ATOMIC_ACQUIRE, "agent");
            xb_add(&bar[XB_XGEN(b.x)], 1u);
            asm volatile("s_waitcnt vmcnt(0)" ::: "memory");
        } else {
            XB_SPIN(xb_ld(&bar[XB_XGEN(b.x)]) == gen, bar);
            __builtin_amdgcn_fence(__ATOMIC_ACQUIRE, "agent");
            asm volatile("s_waitcnt vmcnt(0)" ::: "memory");
        }
    }
    __syncthreads();
}

namespace pg8 {
constexpr int BM = 256, BK = 64, HALF = 128, HTB = HALF * BK * 2, STAGE_BYTES = 8 * HTB, NXCD = 8, WGM = 8;
__device__ __forceinline__ int lds_byte(int r, int c) { const int st = (r >> 4) * 2 + (c >> 5), rr = r & 15, cc = c & 31, ob = rr * 64 + cc * 2; return st * 1024 + (ob ^ (((ob >> 9) & 1) << 5)); }
__device__ __forceinline__ void stage_rc(int b, int& R, int& C) { const int st = b / 1024, sb = b % 1024, swz = sb ^ (((sb >> 9) & 1) << 5); R = (st >> 1) * 16 + swz / 64; C = (st & 1) * 32 + (swz % 64) / 2; }
__device__ __forceinline__ int perm32(int rho) { const int n = rho >> 4, i = rho & 15; return 8 * (i >> 2) + 4 * n + (i & 3); }

struct Unit { int pm, pn; unsigned bofs; int aux; };

struct SchedDense {
    int nM, nN, nwg, G, c, K;
    __device__ void init(int M, int N, int K_, int G_, int c_) { nM = M / BM; nN = N / BM; nwg = nM * nN; G = G_; c = c_; K = K_; }
    __device__ bool next(int i, Unit& u) const {
        const long L = (long)i * G + c; if (L >= nwg) return false;
        int wgid = (int)L; { const int q = nwg / NXCD, r = nwg % NXCD, xcd = wgid % NXCD, off = wgid / NXCD; wgid = (xcd < r ? xcd * (q + 1) : r * (q + 1) + (xcd - r) * q) + off; }
        const int nig = WGM * nN, gid = wgid / nig, fm = gid * WGM, gsz = (nM - fm) < WGM ? (nM - fm) : WGM;
        u.pm = fm + ((wgid % nig) % gsz); u.pn = (wgid % nig) / gsz; u.bofs = (unsigned)u.pn * (unsigned)(BM * K * 2); u.aux = 0; return true;
    }
    __device__ __forceinline__ unsigned a_row(const Unit& u, int r) const { return (unsigned)(u.pm * BM + r); }
};
struct SchedGroup {
    const LAS int* tb; const LAS int* tokt; int G, c, pitch, gather;
    __device__ bool next(int i, Unit& u) const {
        const int L = i * G + c, nt = tb[NE]; if (L >= nt * 4) return false;
        const int g = L >> 2; int e = 0; while (tb[e + 1] <= g) ++e;
        u.pm = g; u.pn = L & 3; u.bofs = (unsigned)(e * 1024 + u.pn * BM) * (unsigned)pitch; u.aux = i; return true;
    }
    __device__ __forceinline__ unsigned a_row(const Unit& u, int r) const { return gather ? (unsigned)tokt[u.aux * 256 + r] : (unsigned)(u.pm * BM + r); }
};

__device__ __forceinline__ unsigned cvt_pk_bf16(float lo, float hi) { unsigned r; asm volatile("v_cvt_pk_bf16_f32 %0, %1, %2" : "=v"(r) : "v"(lo), "v"(hi)); return r; }

typedef int i32x4 __attribute__((ext_vector_type(4)));
typedef int i32x8 __attribute__((ext_vector_type(8)));
template <bool F8> struct Frag { bf16x8 k[2]; };
template <> struct Frag<true> { i32x8 v; };
template <class Epi, class Sched, bool ALIGN_EPI, bool SP2, bool F8 = false>
__device__ __forceinline__ void gemm_phase(LAS unsigned char* lds, const int tid, const char* Abase, const char* Bbase, const int K, const Sched& S, const Epi& E) {
    const int wid = __builtin_amdgcn_readfirstlane(tid >> 6), lane = tid & 63, wr = wid >> 2, wc = wid & 3, fr = lane & 15, fq = lane >> 4;
    const int nt = F8 ? K / 128 : K / BK; const unsigned pitch = F8 ? (unsigned)K : 2u * (unsigned)K;
    int Rr[2], Cc[2]; unsigned voffB[2];
#pragma unroll
    for (int i = 0; i < 2; ++i) { int R, C; stage_rc(tid * 16 + i * 8192, R, C); const int Rb = Epi::PERM ? ((R & ~31) + perm32(R & 31)) : R;
        Rr[i] = R; Cc[i] = C; voffB[i] = (unsigned)Rb * pitch + 2u * (unsigned)C; }
    const size_t kstep = (size_t)(BK * 2);
    const size_t hstep = (size_t)HALF * pitch;
    const unsigned ldsw = (unsigned)wid * 1024u;
    const int fcol = F8 ? (fq >> 1) * 32 + (fq & 1) * 16 : fq * 8;
    const int aoff = lds_byte(wr * 64 + fr, fcol), boff = lds_byte(wc * 32 + fr, fcol);
#define PG8_SA(b, h) (((b) * 2 + (h)) * HTB)
#define PG8_SB(b, h) ((4 + (b) * 2 + (h)) * HTB)
#define PG8_STAGE(bufoff, gbase, voff) do { _Pragma("unroll") for (int _i = 0; _i < 2; ++_i) \
        __builtin_amdgcn_global_load_lds((const unsigned*)((const char*)(gbase) + (voff)[_i]), (LAS unsigned*)(lds + (bufoff) + ldsw + _i * 8192), 16, 0, 0); } while (0)
#define PG8_LDF(dstf, off_) do { if constexpr (F8) { const i32x4 _lo = *(const LAS i32x4*)(lds + (off_)), _hi = *(const LAS i32x4*)(lds + (off_) + 16); dstf.v = __builtin_shufflevector(_lo, _hi, 0, 1, 2, 3, 4, 5, 6, 7); } \
        else { dstf.k[0] = *(const LAS bf16x8*)(lds + (off_)); dstf.k[1] = *(const LAS bf16x8*)(lds + (off_) + 1024); } } while (0)
#define PG8_LDA(dst, b, h) do { _Pragma("unroll") for (int m = 0; m < 4; ++m) PG8_LDF(dst[m], PG8_SA(b, h) + aoff + m * 2048); } while (0)
#define PG8_LDB(dst, b, h) do { _Pragma("unroll") for (int n = 0; n < 2; ++n) PG8_LDF(dst[n], PG8_SB(b, h) + boff + n * 2048); } while (0)
#define PG8_MMA(ai, bj, At, Bt) do { __builtin_amdgcn_s_setprio(1); _Pragma("unroll") for (int m = 0; m < 4; ++m) _Pragma("unroll") for (int n = 0; n < 2; ++n) { \
        if constexpr (F8) asm volatile("v_mfma_f32_16x16x128_f8f6f4 %0, %1, %2, %0" : "+v"(acc[ai][bj][m][n]) : "v"(Bt[n].v), "v"(At[m].v));   \
        else { _Pragma("unroll") for (int k = 0; k < 2; ++k) acc[ai][bj][m][n] = __builtin_amdgcn_mfma_f32_16x16x32_bf16(Bt[n].k[k], At[m].k[k], acc[ai][bj][m][n], 0, 0, 0); } } \
        __builtin_amdgcn_s_setprio(0); } while (0)
#define PG8_WAIT_V(n) asm volatile("s_waitcnt vmcnt(" #n ")" ::: "memory")
#define PG8_WAIT_L(n) asm volatile("s_waitcnt lgkmcnt(" #n ")" ::: "memory")
#define PG8_BAR __builtin_amdgcn_s_barrier()
#define PG8_SCHED __builtin_amdgcn_sched_barrier(0)
#define PG8_AOFF(dst, u) do { _Pragma("unroll") for (int _h = 0; _h < 2; ++_h) _Pragma("unroll") for (int _i = 0; _i < 2; ++_i) \
        dst[_h][_i] = S.a_row(u, _h * HALF + Rr[_i]) * pitch + 2u * (unsigned)Cc[_i]; } while (0)
    Unit cur, nxt; int ui = 0;
    if (!S.next(0, cur)) return;
    f32x4 acc[2][2][4][2];
#pragma unroll
    for (int a = 0; a < 2; ++a)
#pragma unroll
        for (int b = 0; b < 2; ++b)
#pragma unroll
            for (int m = 0; m < 4; ++m)
#pragma unroll
                for (int n = 0; n < 2; ++n) acc[a][b][m][n] = (f32x4){0.f, 0.f, 0.f, 0.f};
    Frag<F8> At[4], B0[2], B1[2];
    unsigned co[2][2], no[2][2];
    PG8_AOFF(co, cur);
    const char* cB = Bbase + cur.bofs;
    if constexpr (SP2) {
        PG8_STAGE(PG8_SB(0, 0), cB, voffB); PG8_STAGE(PG8_SB(0, 1), cB + hstep, voffB); PG8_STAGE(PG8_SA(0, 0), Abase, co[0]); PG8_STAGE(PG8_SA(0, 1), Abase, co[1]);
        if (wr == 1) PG8_BAR;
        PG8_WAIT_V(2); PG8_BAR;
        PG8_STAGE(PG8_SB(1, 0), cB + kstep, voffB); PG8_STAGE(PG8_SA(1, 0), Abase + kstep, co[0]); PG8_STAGE(PG8_SB(1, 1), cB + hstep + kstep, voffB);
        PG8_WAIT_V(6); PG8_BAR;
    } else {
        PG8_STAGE(PG8_SB(0, 0), cB, voffB); PG8_STAGE(PG8_SA(0, 0), Abase, co[0]); PG8_STAGE(PG8_SB(0, 1), cB + hstep, voffB); PG8_STAGE(PG8_SA(0, 1), Abase, co[1]);
        if (wr == 1) PG8_BAR;
        PG8_WAIT_V(4); PG8_BAR;
        PG8_STAGE(PG8_SB(1, 0), cB + kstep, voffB); PG8_STAGE(PG8_SA(1, 0), Abase + kstep, co[0]); PG8_STAGE(PG8_SB(1, 1), cB + hstep + kstep, voffB);
        PG8_WAIT_V(6); PG8_BAR;
    }
    for (;;) {
        const bool has_next = S.next(ui + 1, nxt);
        const char* nB = has_next ? Bbase + nxt.bofs : cB;
        if (has_next) { PG8_AOFF(no, nxt); } else {
#pragma unroll
            for (int h = 0; h < 2; ++h)
#pragma unroll
                for (int i = 0; i < 2; ++i) no[h][i] = co[h][i]; }
#pragma unroll 1
        for (int t = 0; t < nt; t += 2) {
            const bool last = (t == nt - 2);
            const char* a1 = Abase + (size_t)(t + 1) * kstep;
            const char* a2 = last ? Abase : Abase + (size_t)(t + 2) * kstep; const char* b2 = last ? nB : cB + (size_t)(t + 2) * kstep;
            const char* a3 = a2 + kstep; const char* b3 = b2 + kstep;
            unsigned o2[2][2];
#pragma unroll
            for (int h = 0; h < 2; ++h)
#pragma unroll
                for (int i = 0; i < 2; ++i) o2[h][i] = last ? no[h][i] : co[h][i];
            if constexpr (SP2) {
            PG8_LDB(B0, 0, 0); PG8_LDB(B1, 0, 1); PG8_SCHED; PG8_LDA(At, 0, 0); PG8_STAGE(PG8_SA(1, 1), a1, co[1]);
            PG8_WAIT_V(8); PG8_WAIT_L(0); PG8_BAR; PG8_MMA(0, 0, At, B0); PG8_MMA(0, 1, At, B1); PG8_BAR; PG8_SCHED;
            PG8_LDA(At, 0, 1); PG8_STAGE(PG8_SB(0, 0), b2, voffB); PG8_STAGE(PG8_SB(0, 1), b2 + hstep, voffB); PG8_STAGE(PG8_SA(0, 0), a2, o2[0]);
            PG8_WAIT_V(8); PG8_WAIT_L(0); PG8_BAR; PG8_MMA(1, 0, At, B0); PG8_MMA(1, 1, At, B1); PG8_BAR; PG8_SCHED;
            PG8_LDB(B0, 1, 0); PG8_LDB(B1, 1, 1); PG8_SCHED; PG8_LDA(At, 1, 0); PG8_STAGE(PG8_SA(0, 1), a2, o2[1]);
            PG8_WAIT_V(8); PG8_WAIT_L(0); PG8_BAR; PG8_MMA(0, 0, At, B0); PG8_MMA(0, 1, At, B1); PG8_BAR; PG8_SCHED;
            PG8_LDA(At, 1, 1); PG8_STAGE(PG8_SB(1, 0), b3, voffB); PG8_STAGE(PG8_SB(1, 1), b3 + hstep, voffB); PG8_STAGE(PG8_SA(1, 0), a3, o2[0]);
            PG8_WAIT_V(8); PG8_WAIT_L(0); PG8_BAR; PG8_MMA(1, 0, At, B0); PG8_MMA(1, 1, At, B1); PG8_BAR; PG8_SCHED;
            } else {
            PG8_LDB(B0, 0, 0); PG8_SCHED; PG8_LDA(At, 0, 0); PG8_STAGE(PG8_SA(1, 1), a1, co[1]);
            PG8_WAIT_L(8); PG8_BAR; PG8_WAIT_L(0); PG8_MMA(0, 0, At, B0); PG8_BAR; PG8_SCHED;
            PG8_LDB(B1, 0, 1); PG8_STAGE(PG8_SB(0, 0), b2, voffB);
            PG8_BAR; PG8_WAIT_L(0); PG8_MMA(0, 1, At, B1); PG8_BAR;
            PG8_LDA(At, 0, 1); PG8_STAGE(PG8_SA(0, 0), a2, o2[0]);
            PG8_BAR; PG8_WAIT_L(0); PG8_MMA(1, 0, At, B0); PG8_BAR; PG8_SCHED;
            PG8_STAGE(PG8_SB(0, 1), b2 + hstep, voffB);
            PG8_WAIT_V(6); PG8_BAR; PG8_MMA(1, 1, At, B1); PG8_BAR;
            PG8_LDB(B0, 1, 0); PG8_SCHED; PG8_LDA(At, 1, 0); PG8_STAGE(PG8_SA(0, 1), a2, o2[1]);
            PG8_WAIT_L(8); PG8_BAR; PG8_WAIT_L(0); PG8_MMA(0, 0, At, B0); PG8_BAR; PG8_SCHED;
            PG8_LDB(B1, 1, 1); PG8_STAGE(PG8_SB(1, 0), b3, voffB);
            PG8_BAR; PG8_WAIT_L(0); PG8_MMA(0, 1, At, B1); PG8_BAR;
            PG8_LDA(At, 1, 1); PG8_STAGE(PG8_SA(1, 0), a3, o2[0]);
            PG8_BAR; PG8_WAIT_L(0); PG8_MMA(1, 0, At, B0); PG8_BAR; PG8_SCHED;
            PG8_STAGE(PG8_SB(1, 1), b3 + hstep, voffB);
            PG8_WAIT_V(6); PG8_BAR; PG8_MMA(1, 1, At, B1); PG8_BAR;
            }
        }
        if constexpr (ALIGN_EPI) { if (wr == 0) PG8_BAR; }
        if constexpr (F8) asm volatile("s_nop 15\n\ts_nop 15\n\ts_nop 7" ::: "memory");
        E(acc, cur, wr, wc, fr, fq);
        if (!has_next) break;
#pragma unroll
        for (int a = 0; a < 2; ++a)
#pragma unroll
            for (int b = 0; b < 2; ++b)
#pragma unroll
                for (int m = 0; m < 4; ++m)
#pragma unroll
                    for (int n = 0; n < 2; ++n) acc[a][b][m][n] = (f32x4){0.f, 0.f, 0.f, 0.f};
        cur = nxt; cB = nB; ++ui;
#pragma unroll
        for (int h = 0; h < 2; ++h)
#pragma unroll
            for (int i = 0; i < 2; ++i) co[h][i] = no[h][i];
        if constexpr (ALIGN_EPI) { if (wr == 1) PG8_BAR; }
    }
    PG8_WAIT_V(0);
    if constexpr (!ALIGN_EPI) { if (wr == 0) PG8_BAR; }
    PG8_BAR;
#undef PG8_SA
#undef PG8_SB
#undef PG8_STAGE
#undef PG8_LDA
#undef PG8_LDF
#undef PG8_LDB
#undef PG8_MMA
#undef PG8_WAIT_V
#undef PG8_WAIT_L
#undef PG8_BAR
#undef PG8_SCHED
#undef PG8_AOFF
}

struct EpiInProj {
    static constexpr bool PERM = true;
    bf16_t* P; const float* ropeC; const float* ropeS;
    __device__ __forceinline__ void operator()(const f32x4 (&acc)[2][2][4][2], const Unit& u, int wr, int wc, int fr, int fq) const {
        const int row0 = u.pm * BM + wr * 64 + fr, col0 = u.pn * BM + wc * 32 + 8 * fq;
        const bool qk = u.pn < 4, rope = qk && (u.pm < NLAT / BM);
        const float ks = (u.pn >= 2 && u.pn < 4) ? 0.08838834764831845f : 1.0f;
        const int sec = wc >> 1, i0 = (wc & 1) * 16 + 4 * fq;
#pragma unroll
        for (int ai = 0; ai < 2; ++ai)
#pragma unroll
            for (int m = 0; m < 4; ++m) {
                const int row = row0 + ai * HALF + m * 16;
                asm volatile("" ::: "memory");
                f32x4 c4 = (f32x4){1.f, 1.f, 1.f, 1.f}, s4 = (f32x4){0.f, 0.f, 0.f, 0.f};
                if (rope) { const int t = row & (TL - 1), pos = sec ? (t & 63) : (t >> 6); const int ti = (sec ? 1024 : 0) + pos * 32 + i0;
                    c4 = *(const f32x4*)(ropeC + ti); s4 = *(const f32x4*)(ropeS + ti); }
                bf16_t* rowp = P + (size_t)row * NP + col0;
#pragma unroll
                for (int bj = 0; bj < 2; ++bj) {
                    f32x4 v0 = acc[ai][bj][m][0], v1 = acc[ai][bj][m][1];
                    if (qk) {
                        const float a0 = v0[0] * c4[0] - v0[1] * s4[0], b0 = v0[0] * s4[0] + v0[1] * c4[0];
                        const float a1 = v0[2] * c4[1] - v0[3] * s4[1], b1 = v0[2] * s4[1] + v0[3] * c4[1];
                        const float a2 = v1[0] * c4[2] - v1[1] * s4[2], b2 = v1[0] * s4[2] + v1[1] * c4[2];
                        const float a3 = v1[2] * c4[3] - v1[3] * s4[3], b3 = v1[2] * s4[3] + v1[3] * c4[3];
                        v0 = (f32x4){a0 * ks, b0 * ks, a1 * ks, b1 * ks}; v1 = (f32x4){a2 * ks, b2 * ks, a3 * ks, b3 * ks};
                    }
                    u32x4 w; w.x = cvt_pk_bf16(v0[0], v0[1]); w.y = cvt_pk_bf16(v0[2], v0[3]); w.z = cvt_pk_bf16(v1[0], v1[1]); w.w = cvt_pk_bf16(v1[2], v1[3]);
                    *(u32x4*)(rowp + bj * HALF) = w;
                }
            }
    }
};
struct EpiResid {
    static constexpr bool PERM = true;
    const float* rl; const float* rc; const bf16_t* rb; bf16_t* ob; float* ssq; const float* gmod;
    __device__ __forceinline__ void operator()(const f32x4 (&acc)[2][2][4][2], const Unit& u, int wr, int wc, int fr, int fq) const {
        const int row0 = u.pm * BM + wr * 64 + fr, col0 = u.pn * BM + wc * 32 + 8 * fq;
        const bool lat = u.pm < NLAT / BM; const int b = lat ? (u.pm >> 3) : 16;
        const float* rbase = rl ? (lat ? rl : rc - (size_t)NLAT * D) : nullptr;
        f32x4 gv[2][2];
#pragma unroll
        for (int bj = 0; bj < 2; ++bj)
#pragma unroll
            for (int n = 0; n < 2; ++n) gv[bj][n] = *(const f32x4*)(gmod + (size_t)b * 6 * D + col0 + bj * HALF + 4 * n);
#pragma unroll
        for (int ai = 0; ai < 2; ++ai)
#pragma unroll
            for (int m = 0; m < 4; ++m) { const int row = row0 + ai * HALF + m * 16; const size_t off = (size_t)row * D + col0; float ss = 0.f;
#pragma unroll
                for (int bj = 0; bj < 2; ++bj) { f32x4 r0, r1;
                    if (rbase) { r0 = *(const f32x4*)(rbase + off + bj * HALF); r1 = *(const f32x4*)(rbase + off + bj * HALF + 4); }
                    else { const u32x4 w = *(const u32x4*)(rb + off + bj * HALF); r0 = (f32x4){bflo(w.x), bfhi(w.x), bflo(w.y), bfhi(w.y)}; r1 = (f32x4){bflo(w.z), bfhi(w.z), bflo(w.w), bfhi(w.w)}; }
                    const f32x4 v0 = r0 + gv[bj][0] * acc[ai][bj][m][0], v1 = r1 + gv[bj][1] * acc[ai][bj][m][1];
                    ss += (v0[0] * v0[0] + v0[1] * v0[1]) + (v0[2] * v0[2] + v0[3] * v0[3]) + (v1[0] * v1[0] + v1[1] * v1[1]) + (v1[2] * v1[2] + v1[3] * v1[3]);
                    u32x4 w; w.x = cvt_pk_bf16(v0[0], v0[1]); w.y = cvt_pk_bf16(v0[2], v0[3]); w.z = cvt_pk_bf16(v1[0], v1[1]); w.w = cvt_pk_bf16(v1[2], v1[3]);
                    *(u32x4*)(ob + off + bj * HALF) = w; }
                ss += __shfl_xor(ss, 16); ss += __shfl_xor(ss, 32);
                if (fq == 0) ssq[(size_t)row * 16 + u.pn * 4 + wc] = ss;
                if (m & 1) asm volatile("" ::: "memory"); }
    }
};
struct EpiSwiGLU {
    static constexpr bool PERM = true;
    bf16_t* O;
    __device__ __forceinline__ void operator()(const f32x4 (&acc)[2][2][4][2], const Unit& u, int wr, int wc, int fr, int fq) const {
        const int row0 = u.pm * BM + wr * 64 + fr, col0 = u.pn * 128 + wc * 16 + 4 * fq;
#pragma unroll
        for (int ai = 0; ai < 2; ++ai)
#pragma unroll
            for (int m = 0; m < 4; ++m) { bf16_t* rowp = O + (size_t)(row0 + ai * HALF + m * 16) * FF + col0;
#pragma unroll
                for (int bj = 0; bj < 2; ++bj) { const f32x4 g = acc[ai][bj][m][0], up = acc[ai][bj][m][1];
                    u32x2 w; w.x = cvt_pk_bf16(silu_f(g[0]) * up[0], silu_f(g[1]) * up[1]); w.y = cvt_pk_bf16(silu_f(g[2]) * up[2], silu_f(g[3]) * up[3]);
                    *(u32x2*)(rowp + bj * 64) = w; } }
    }
};
__device__ __forceinline__ unsigned pk4_fp8(float a, float b, float c, float d) { int p = __builtin_amdgcn_cvt_pk_fp8_f32(a, b, 0, false); p = __builtin_amdgcn_cvt_pk_fp8_f32(c, d, p, true); return (unsigned)p; }
struct EpiSwiGLU8 {
    static constexpr bool PERM = true;
    unsigned char* O; float inv;
    __device__ __forceinline__ void operator()(const f32x4 (&acc)[2][2][4][2], const Unit& u, int wr, int wc, int fr, int fq) const {
        const int row0 = u.pm * BM + wr * 64 + fr, col0 = u.pn * 128 + wc * 32 + 8 * fq;
#pragma unroll
        for (int ai = 0; ai < 2; ++ai)
#pragma unroll
            for (int m = 0; m < 4; ++m) { unsigned char* rowp = O + (size_t)(row0 + ai * HALF + m * 16) * FF + col0;
                const f32x4 g0 = acc[ai][0][m][0] * inv, g1 = acc[ai][0][m][1] * inv, u0 = acc[ai][1][m][0] * inv, u1 = acc[ai][1][m][1] * inv;
                u32x2 w; w.x = pk4_fp8(silu_f(g0[0]) * u0[0], silu_f(g0[1]) * u0[1], silu_f(g0[2]) * u0[2], silu_f(g0[3]) * u0[3]);
                w.y = pk4_fp8(silu_f(g1[0]) * u1[0], silu_f(g1[1]) * u1[1], silu_f(g1[2]) * u1[2], silu_f(g1[3]) * u1[3]);
                *(u32x2*)rowp = w; }
    }
};
struct EpiBf16S {
    static constexpr bool PERM = true;
    bf16_t* O; int ldc; float inv;
    __device__ __forceinline__ void operator()(const f32x4 (&acc)[2][2][4][2], const Unit& u, int wr, int wc, int fr, int fq) const {
        const int row0 = u.pm * BM + wr * 64 + fr, col0 = u.pn * BM + wc * 32 + 8 * fq;
#pragma unroll
        for (int ai = 0; ai < 2; ++ai)
#pragma unroll
            for (int m = 0; m < 4; ++m) { bf16_t* rowp = O + (size_t)(row0 + ai * HALF + m * 16) * ldc + col0;
#pragma unroll
                for (int bj = 0; bj < 2; ++bj) { const f32x4 v0 = acc[ai][bj][m][0] * inv, v1 = acc[ai][bj][m][1] * inv;
                    u32x4 w; w.x = cvt_pk_bf16(v0[0], v0[1]); w.y = cvt_pk_bf16(v0[2], v0[3]); w.z = cvt_pk_bf16(v1[0], v1[1]); w.w = cvt_pk_bf16(v1[2], v1[3]);
                    *(u32x4*)(rowp + bj * HALF) = w; } }
    }
};
struct EpiBf16 {
    static constexpr bool PERM = true;
    bf16_t* O; int ldc;
    __device__ __forceinline__ void operator()(const f32x4 (&acc)[2][2][4][2], const Unit& u, int wr, int wc, int fr, int fq) const {
        const int row0 = u.pm * BM + wr * 64 + fr, col0 = u.pn * BM + wc * 32 + 8 * fq;
#pragma unroll
        for (int ai = 0; ai < 2; ++ai)
#pragma unroll
            for (int m = 0; m < 4; ++m) { bf16_t* rowp = O + (size_t)(row0 + ai * HALF + m * 16) * ldc + col0;
#pragma unroll
                for (int bj = 0; bj < 2; ++bj) { const f32x4 v0 = acc[ai][bj][m][0], v1 = acc[ai][bj][m][1];
                    u32x4 w; w.x = cvt_pk_bf16(v0[0], v0[1]); w.y = cvt_pk_bf16(v0[2], v0[3]); w.z = cvt_pk_bf16(v1[0], v1[1]); w.w = cvt_pk_bf16(v1[2], v1[3]);
                    *(u32x4*)(rowp + bj * HALF) = w; } }
    }
};
}

struct Args { const float* in[22]; float* out; unsigned char* ws; int ph_lo, ph_hi; };
enum { I_X = 0, I_C, I_CTX, I_CCTX, I_ADAW, I_ADAB, I_N1G, I_WIN, I_DF, I_DB, I_POOLW, I_POOLS, I_WOUT, I_N2G, I_RGW, I_RGB, I_REW, I_REB, I_WG, I_WU, I_WDN, I_FNG };

struct Frame {
    LAS unsigned char* lds; int tid, lane, wave, G, bx, vcu;
    const float* const* in; float* out; unsigned char* ws;
};
__device__ __forceinline__ bf16_t* xb_row(const Frame& F, int row) { return (bf16_t*)(F.ws + WS_XB) + (size_t)row * D; }
__device__ __forceinline__ bf16_t* hbuf(const Frame& F) { return (bf16_t*)F.out; }
__device__ __forceinline__ const float* mod_ptr(const Frame& F, int l, int b, int which) { return (const float*)(F.ws + WS_MOD) + ((size_t)(l * 17 + b) * 6 + which) * D; }

__device__ __forceinline__ void tr_item(const float* colp, size_t ldw, int k0, bf16_t* WT, int K, int n0, LAS float* scr, int lane) {
    { float v[32];
#pragma unroll
        for (int i = 0; i < 32; ++i) v[i] = colp[(size_t)(k0 + 2 * i + (lane >> 5)) * ldw];
#pragma unroll
        for (int i = 0; i < 32; ++i) scr[(2 * i + (lane >> 5)) * 33 + (lane & 31)] = v[i]; }
    asm volatile("s_waitcnt lgkmcnt(0)" ::: "memory");
    const int c = lane & 7;
#pragma unroll
    for (int j = 0; j < 4; ++j) { const int n = (lane >> 3) + 8 * j; const LAS float* s = scr + (8 * c) * 33 + n;
        u32x4 o; o.x = pk2(s[0 * 33], s[1 * 33]); o.y = pk2(s[2 * 33], s[3 * 33]); o.z = pk2(s[4 * 33], s[5 * 33]); o.w = pk2(s[6 * 33], s[7 * 33]);
        *(u32x4*)(WT + (size_t)(n0 + n) * K + k0 + 8 * c) = o; }
    asm volatile("s_waitcnt lgkmcnt(0)" ::: "memory");
}
constexpr float WGU_SCALE = 64.0f, WD_SCALE = 32.0f;
__device__ __forceinline__ void tr_item8(const float* colp, size_t ldw, int k0, unsigned char* WT, int K, int n0, LAS float* scr, int lane, float qs) {
    { float v[32];
#pragma unroll
        for (int i = 0; i < 32; ++i) v[i] = colp[(size_t)(k0 + 2 * i + (lane >> 5)) * ldw];
#pragma unroll
        for (int i = 0; i < 32; ++i) scr[(2 * i + (lane >> 5)) * 33 + (lane & 31)] = v[i] * qs; }
    asm volatile("s_waitcnt lgkmcnt(0)" ::: "memory");
    const int c = lane & 7;
#pragma unroll
    for (int j = 0; j < 4; ++j) { const int n = (lane >> 3) + 8 * j; const LAS float* s = scr + (8 * c) * 33 + n;
        u32x2 o; o.x = pg8::pk4_fp8(s[0 * 33], s[1 * 33], s[2 * 33], s[3 * 33]); o.y = pg8::pk4_fp8(s[4 * 33], s[5 * 33], s[6 * 33], s[7 * 33]);
        *(u32x2*)(WT + (size_t)(n0 + n) * K + k0 + 8 * c) = o; }
    asm volatile("s_waitcnt lgkmcnt(0)" ::: "memory");
}
__device__ __forceinline__ void fold_item(const float* win, const float* pw, const float* ps, int k0, bf16_t* WT, int n0, LAS float* scr, int lane) {
    const int n = n0 + (lane & 31), g = n >> 7, nn = n & 127;
    const float* pwc = pw + (size_t)g * 128 * 128 + nn; const float sc = ps[n];
    float acc[32];
#pragma unroll
    for (int i = 0; i < 32; ++i) acc[i] = 0.f;
    for (int hc = 0; hc < 8; ++hc) {
        float pc[16];
#pragma unroll
        for (int c = 0; c < 16; ++c) pc[c] = pwc[(size_t)(hc * 16 + c) * 128];
#pragma unroll
        for (int i = 0; i < 32; ++i) { const f32x4* wr = (const f32x4*)(win + (size_t)(k0 + 2 * i + (lane >> 5)) * NP + 2048 + g * 128 + hc * 16);
            float a = acc[i];
#pragma unroll
            for (int c4 = 0; c4 < 4; ++c4) { const f32x4 w = wr[c4]; a += w[0] * pc[4 * c4] + w[1] * pc[4 * c4 + 1] + w[2] * pc[4 * c4 + 2] + w[3] * pc[4 * c4 + 3]; }
            acc[i] = a; }
    }
#pragma unroll
    for (int i = 0; i < 32; ++i) scr[(2 * i + (lane >> 5)) * 33 + (lane & 31)] = acc[i] * sc;
    asm volatile("s_waitcnt lgkmcnt(0)" ::: "memory");
    const int c = lane & 7;
#pragma unroll
    for (int j = 0; j < 4; ++j) { const int nl = (lane >> 3) + 8 * j; const LAS float* s = scr + (8 * c) * 33 + nl;
        u32x4 o; o.x = pk2(s[0 * 33], s[1 * 33]); o.y = pk2(s[2 * 33], s[3 * 33]); o.z = pk2(s[4 * 33], s[5 * 33]); o.w = pk2(s[6 * 33], s[7 * 33]);
        *(u32x4*)(WT + (size_t)(2048 + n0 + nl) * D + k0 + 8 * c) = o; }
    asm volatile("s_waitcnt lgkmcnt(0)" ::: "memory");
}
__device__ __forceinline__ void p0_prologue(const Frame& F, int qsel) {
    for (int task = F.bx; task < 2 * 96; task += F.G) {
        const int l = task / 96, cg = task % 96;
        LAS float* sc = (LAS float*)F.lds;
        LAS float* part = (LAS float*)(F.lds + 17 * 1024 * 4);
        for (int i = F.tid; i < 17 * 1024; i += 512) { const int b = i >> 10, k = i & 1023; const float v = b < 16 ? F.in[I_C][b * D + k] : F.in[I_CCTX][k]; sc[i] = silu_f(v); }
        __syncthreads();
        float acc[17];
#pragma unroll
        for (int b = 0; b < 17; ++b) acc[b] = 0.f;
        const float* aw = F.in[I_ADAW] + (size_t)l * D * 6 * D + cg * 64 + F.lane;
        for (int k0 = F.wave * 128; k0 < F.wave * 128 + 128; k0 += 16) { float w[16];
#pragma unroll
            for (int u = 0; u < 16; ++u) w[u] = aw[(size_t)(k0 + u) * 6 * D];
#pragma unroll
            for (int u = 0; u < 16; ++u) {
#pragma unroll
                for (int b = 0; b < 17; ++b) acc[b] += sc[b * 1024 + k0 + u] * w[u]; } }
#pragma unroll
        for (int b = 0; b < 17; ++b) part[(F.wave * 17 + b) * 64 + F.lane] = acc[b];
        __syncthreads();
        for (int i = F.tid; i < 17 * 64; i += 512) { const int b = i >> 6, n = i & 63; float s = F.in[I_ADAB][l * 6 * D + cg * 64 + n];
#pragma unroll
            for (int w = 0; w < 8; ++w) s += part[(w * 17 + b) * 64 + n];
            const int col = cg * 64 + n; ((float*)(F.ws + WS_MOD))[((size_t)(l * 17 + b) * 6 + (col >> 10)) * D + (col & 1023)] = s; }
        __syncthreads();
    }
    if (F.bx == F.G - 1) {
        float* rc = (float*)(F.ws + WS_ROPE); float* rs = rc + 96 * 32;
        for (int i = F.tid; i < 96 * 32; i += 512) { const int p = i >> 5, f = i & 31; const int pos = p < 32 ? p : p - 32;
            const float inv = powf(10000.0f, -(float)f / 32.0f); const float ang = (float)pos * inv; rc[i] = cosf(ang); rs[i] = sinf(ang); }
    }
    LAS float* scr = (LAS float*)(F.lds + F.wave * 8448);
    constexpr int IT_WIN = 16 * 80, IT_WOUT = 16 * 32, IT_GU = 16 * 32, IT_DN = 8 * 32;
    constexpr int N_WIN = DEPTH * IT_WIN, N_WOUT = DEPTH * IT_WOUT, N_GU = DEPTH * NE * IT_GU, N_DN = DEPTH * NE * IT_DN;
    unsigned* qhead = (unsigned*)(F.ws + WS_CTL) + CW_QUEUE + 16 * qsel;
    constexpr int N_ALL = N_WIN + N_WOUT + N_GU + N_DN, QB = 16, NBATCH = N_ALL / QB;
    static_assert(N_ALL % QB == 0, "queue batches");
    for (;;) {
        int bq = 0; if (F.lane == 0) bq = (int)__hip_atomic_fetch_add(qhead, 1u, __ATOMIC_RELAXED, __HIP_MEMORY_SCOPE_AGENT);
        bq = __builtin_amdgcn_readfirstlane(bq);
        if (bq >= NBATCH) break;
      for (int qi = 0; qi < QB; ++qi) {
        int r = bq + qi * NBATCH;
        if (r < N_WIN) { const int l = r / IT_WIN; r %= IT_WIN; const int kb = r & 15, nb = 79 - (r >> 4), n0 = nb * 32;
            const float* win = F.in[I_WIN] + (size_t)l * D * NP; bf16_t* WT = (bf16_t*)(F.ws + WS_WIN) + (size_t)l * NP * D;
            if (n0 >= 2048) { fold_item(win, F.in[I_POOLW] + (size_t)l * 4 * 128 * 128, F.in[I_POOLS] + l * 512, kb * 64, WT, n0 - 2048, scr, F.lane); continue; }
            const int n = n0 + (F.lane & 31); int src = n;
            if (n < 1024) { const int hh = n >> 7, j = n & 127, sec = j >> 6, jj = j & 63; src = (n & 512) + (hh & 3) * 128 + sec * 64 + (jj & 1) * 32 + (jj >> 1); }
            tr_item(win + src, NP, kb * 64, WT, D, n0, scr, F.lane); continue; }
        r -= N_WIN;
        if (r < N_WOUT) { const int l = r / IT_WOUT; r %= IT_WOUT; const int kb = r / 32, nb = r % 32, n0 = nb * 32;
            tr_item(F.in[I_WOUT] + (size_t)l * D * D + n0 + (F.lane & 31), D, kb * 64, (bf16_t*)(F.ws + WS_WOUT) + (size_t)l * D * D, D, n0, scr, F.lane); continue; }
        r -= N_WOUT;
        if (r < N_GU) { const int le = r / IT_GU; r %= IT_GU; const int kb = r / 32, nb = r % 32, n0 = nb * 32;
            const int n = n0 + (F.lane & 31), col = (n >> 8) * 128 + (n & 127); const float* src = ((n & 128) ? F.in[I_WU] : F.in[I_WG]) + (size_t)le * D * FF + col;
            tr_item8(src, FF, kb * 64, (unsigned char*)(F.ws + WS_WGU) + (size_t)le * 1024 * D, D, n0, scr, F.lane, WGU_SCALE); continue; }
        r -= N_GU;
        { const int le = r / IT_DN; r %= IT_DN; const int kb = r / 32, nb = r % 32, n0 = nb * 32;
            tr_item8(F.in[I_WDN] + (size_t)le * FF * D + n0 + (F.lane & 31), D, kb * 64, (unsigned char*)(F.ws + WS_WD) + (size_t)le * D * FF, FF, n0, scr, F.lane, WD_SCALE); }
      }
    }
}

__device__ __forceinline__ LAS int* build_tb(const Frame& F, int l) {
    LAS int* tb = (LAS int*)(F.lds + MISC_OFF + 64);
    if (F.tid == 0) { const unsigned* cnt = (const unsigned*)(F.ws + WS_CTL) + CW_CNT + l * NE * 16; int s = 0;
#pragma unroll 1
        for (int e = 0; e < NE; ++e) { tb[e] = s; const int c = (int)__hip_atomic_load(cnt + e * 16, __ATOMIC_RELAXED, __HIP_MEMORY_SCOPE_AGENT); tb[64 + e] = c; s += (c + 255) >> 8; }
        tb[NE] = s; }
    __syncthreads();
    return tb;
}

__device__ __forceinline__ void row_op_a(const Frame& F, int mode, bool dry) {
    const int gw = F.vcu * 8 + F.wave, NGW = F.G * 8;
    const int nrows = (mode == 2) ? NLAT : NTOK; const int l = (mode == 0) ? 0 : 1, lp = mode - 1;
    const LAS int* tb = nullptr; if (mode != 0) tb = build_tb(F, lp);
    const bf16_t* YB = (const bf16_t*)(F.ws + WS_P); bf16_t* H = hbuf(F);
    const float* gain = (mode == 2) ? F.in[I_FNG] : F.in[I_N1G] + l * D;
    int4 ti = make_int4(0, 0, 0, 0), nti = ti; f32x2 tw = (f32x2){0.f, 0.f}, ntw = tw;
    if (mode != 0 && gw < nrows) { ti = *(const int4*)(F.ws + WS_TOKINFO + (size_t)gw * 32); tw = *(const f32x2*)(F.ws + WS_TOKINFO + (size_t)gw * 32 + 16); }
    for (int row = gw; row < nrows; row += NGW) {
        const int b = row < NLAT ? (row >> 11) : 16;
        if (mode != 0 && row + NGW < nrows) { nti = *(const int4*)(F.ws + WS_TOKINFO + (size_t)(row + NGW) * 32); ntw = *(const f32x2*)(F.ws + WS_TOKINFO + (size_t)(row + NGW) * 32 + 16); }
        f32x4 v[4];
        if (mode == 0) { const f32x4* src = (const f32x4*)(row < NLAT ? F.in[I_X] + (size_t)row * D : F.in[I_CTX] + (size_t)(row - NLAT) * D) + F.lane;
#pragma unroll
            for (int j = 0; j < 4; ++j) v[j] = src[64 * j];
        } else {
            const size_t s1 = (size_t)(tb[ti.x] * 256 + ti.y), s2 = (size_t)(tb[ti.z] * 256 + ti.w);
            bf16_t* xr = xb_row(F, row); const f32x4* g2 = (const f32x4*)mod_ptr(F, lp, b, 5) + F.lane;
            const u32x2* y1 = (const u32x2*)(YB + s1 * D) + F.lane; const u32x2* y2 = (const u32x2*)(YB + s2 * D) + F.lane;
#pragma unroll
            for (int j = 0; j < 4; ++j) { const u32x2 xw = ((const u32x2*)xr)[F.lane + 64 * j]; const f32x4 x = (f32x4){bflo(xw.x), bfhi(xw.x), bflo(xw.y), bfhi(xw.y)};
                const u32x2 a = y1[64 * j], c = y2[64 * j]; const f32x4 g = g2[64 * j];
                f32x4 y; y[0] = tw.x * bflo(a.x) + tw.y * bflo(c.x); y[1] = tw.x * bfhi(a.x) + tw.y * bfhi(c.x); y[2] = tw.x * bflo(a.y) + tw.y * bflo(c.y); y[3] = tw.x * bfhi(a.y) + tw.y * bfhi(c.y);
                v[j] = x + g * y; if (mode == 1 && !dry) { u32x2 w; w.x = pk2(v[j][0], v[j][1]); w.y = pk2(v[j][2], v[j][3]); ((u32x2*)xr)[F.lane + 64 * j] = w; } }
        }
        float ss = 0.f;
#pragma unroll
        for (int j = 0; j < 4; ++j) ss += (v[j][0] * v[j][0] + v[j][1] * v[j][1]) + (v[j][2] * v[j][2] + v[j][3] * v[j][3]);
        const float rstd = 1.0f / sqrtf(wave_sum(ss) * (1.0f / D) + EPS);
        if (mode == 2) {
#pragma unroll
            for (int j = 0; j < 4; ++j) { const f32x4 g = ((const f32x4*)gain)[F.lane + 64 * j]; ((f32x4*)((dry ? (float*)(F.ws + WS_WGU) : F.out) + (size_t)row * D))[F.lane + 64 * j] = v[j] * rstd * g; }
        } else {
            const f32x4* sh = (const f32x4*)mod_ptr(F, l, b, 0) + F.lane; const f32x4* sc = (const f32x4*)mod_ptr(F, l, b, 1) + F.lane;
            u32x2* o = (u32x2*)(H + (size_t)row * D) + F.lane;
#pragma unroll
            for (int j = 0; j < 4; ++j) { const f32x4 g = ((const f32x4*)gain)[F.lane + 64 * j]; const f32x4 h = v[j] * rstd * g * (sc[64 * j] + 1.0f) + sh[64 * j];
                u32x2 w; w.x = pk2(h[0], h[1]); w.y = pk2(h[2], h[3]); o[64 * j] = w; }
        }
        ti = nti; tw = ntw;
    }
}

template <bool DRY> __device__ __forceinline__ void route_row(const Frame& F, int l, int row, const float (&s)[36], unsigned* cnt, int* list) {
    const float* rgb = F.in[I_RGB] + l * 4; const float* reb = F.in[I_REB] + l * NE;
    float gl[4];
#pragma unroll
    for (int i = 0; i < 4; ++i) gl[i] = s[i] + rgb[i];
    int gt = 0; float gm = gl[0];
#pragma unroll
    for (int i = 1; i < 4; ++i) if (gl[i] > gm) { gm = gl[i]; gt = i; }
    float gs = 0.f;
#pragma unroll
    for (int i = 0; i < 4; ++i) gs += expf(gl[i] - gm);
    const float gwt = 1.0f / gs;
    float el[8];
#pragma unroll
    for (int j = 0; j < 8; ++j) { const float a = gt == 0 ? s[4 + j] : gt == 1 ? s[12 + j] : gt == 2 ? s[20 + j] : s[28 + j]; el[j] = a + reb[gt * 8 + j]; }
    int i1 = 0; float v1 = el[0];
#pragma unroll
    for (int j = 1; j < 8; ++j) if (el[j] > v1) { v1 = el[j]; i1 = j; }
    int i2 = -1; float v2 = -3.0e38f;
#pragma unroll
    for (int j = 0; j < 8; ++j) if (j != i1 && el[j] > v2) { v2 = el[j]; i2 = j; }
    const float e2 = expf(v2 - v1); const float w1 = gwt / (1.0f + e2), w2 = gwt * e2 / (1.0f + e2);
    if (!DRY) {
        const int x1 = gt * 8 + i1, x2 = gt * 8 + i2;
        const int r1 = (int)__hip_atomic_fetch_add(cnt + x1 * 16, 1u, __ATOMIC_RELAXED, __HIP_MEMORY_SCOPE_AGENT);
        const int r2 = (int)__hip_atomic_fetch_add(cnt + x2 * 16, 1u, __ATOMIC_RELAXED, __HIP_MEMORY_SCOPE_AGENT);
        list[(size_t)x1 * NTOK + r1] = row; list[(size_t)x2 * NTOK + r2] = row;
        *(int4*)(F.ws + WS_TOKINFO + (size_t)row * 32) = make_int4(x1, r1, x2, r2); *(f32x2*)(F.ws + WS_TOKINFO + (size_t)row * 32 + 16) = (f32x2){w1, w2};
    }
}
template <bool DRY> __device__ __forceinline__ void row_op_b(const Frame& F, int l) {
    const int gw = F.vcu * 8 + F.wave, NGW = F.G * 8;
    const int ngroups = ((l == 0) ? NTOK : NLAT) / 16;
    { const float* rg = F.in[I_RGW] + (size_t)l * D * 4; const float* re = F.in[I_REW] + (size_t)l * D * NE;
      for (int i = F.tid; i < 1024 * 36; i += 512) { const int k = i / 36, n = i % 36; const float w = n < 4 ? rg[k * 4 + n] : re[k * NE + (n - 4)];
          const unsigned hi = f2bf(w), lo = f2bf(w - bflo(hi));
          *(LAS bf16_t*)(F.lds + n * RW_PITCH + k * 2) = (bf16_t)hi; *(LAS bf16_t*)(F.lds + RW_LO + n * RW_PITCH + k * 2) = (bf16_t)lo; } }
    __syncthreads();
    bf16_t* H = hbuf(F);
    const float* gain = F.in[I_N2G] + l * D;
    unsigned* cnt = (unsigned*)(F.ws + WS_CTL) + CW_CNT + l * NE * 16;
    int* list = (int*)(F.ws + WS_LIST);
    const int fr = F.lane & 15, fq = F.lane >> 4;
    unsigned bo[3];
#pragma unroll
    for (int nt = 0; nt < 3; ++nt) { const int n = 16 * nt + fr; bo[nt] = (unsigned)((n < 36 ? n : 35) * RW_PITCH + fq * 16); }
    LAS float* ex = (LAS float*)(F.lds + RW_EX + F.wave * 1152);
    for (int gi = gw; gi < ngroups; gi += NGW) {
        const int row = gi * 16 + fr, b = row < NLAT ? (row >> 11) : 16;
        const bf16_t* xr = xb_row(F, row) + fq * 8;
        float ss;
        { const f32x4* sp = (const f32x4*)((const float*)(F.ws + WS_SSQ) + (size_t)row * 16); const f32x4 p0 = sp[0], p1 = sp[1], p2 = sp[2], p3 = sp[3];
          ss = ((p0[0] + p0[1]) + (p0[2] + p0[3])) + ((p1[0] + p1[1]) + (p1[2] + p1[3])) + ((p2[0] + p2[1]) + (p2[2] + p2[3])) + ((p3[0] + p3[1]) + (p3[2] + p3[3])); }
        const float rstd = 1.0f / sqrtf(ss * (1.0f / D) + EPS);
        const float* shp = mod_ptr(F, l, b, 3) + fq * 8; const float* scp = mod_ptr(F, l, b, 4) + fq * 8; const float* gp = gain + fq * 8;
        unsigned char* hp = (unsigned char*)H + (size_t)row * D + fq * 8;
        f32x4 acc[3];
#pragma unroll
        for (int nt = 0; nt < 3; ++nt) acc[nt] = (f32x4){0.f, 0.f, 0.f, 0.f};
#pragma unroll 2
        for (int s = 0; s < 32; ++s) {
            const u32x4 xw = *(const u32x4*)(xr + 32 * s);
            const f32x4 x0 = (f32x4){bflo(xw.x), bfhi(xw.x), bflo(xw.y), bfhi(xw.y)}, x1 = (f32x4){bflo(xw.z), bfhi(xw.z), bflo(xw.w), bfhi(xw.w)};
            const f32x4 g0 = *(const f32x4*)(gp + 32 * s), g1 = *(const f32x4*)(gp + 32 * s + 4);
            const f32x4 c0 = *(const f32x4*)(scp + 32 * s), c1 = *(const f32x4*)(scp + 32 * s + 4);
            const f32x4 s0 = *(const f32x4*)(shp + 32 * s), s1 = *(const f32x4*)(shp + 32 * s + 4);
            const f32x4 h0 = x0 * rstd * g0 * (c0 + 1.0f) + s0, h1 = x1 * rstd * g1 * (c1 + 1.0f) + s1;
            u32x4 hi, lo;
            hi.x = pk2(h0[0], h0[1]); hi.y = pk2(h0[2], h0[3]); hi.z = pk2(h1[0], h1[1]); hi.w = pk2(h1[2], h1[3]);
            lo.x = pk2(h0[0] - bflo(hi.x), h0[1] - bfhi(hi.x)); lo.y = pk2(h0[2] - bflo(hi.y), h0[3] - bfhi(hi.y));
            lo.z = pk2(h1[0] - bflo(hi.z), h1[1] - bfhi(hi.z)); lo.w = pk2(h1[2] - bflo(hi.w), h1[3] - bfhi(hi.w));
            { u32x2 h8; h8.x = pg8::pk4_fp8(h0[0], h0[1], h0[2], h0[3]); h8.y = pg8::pk4_fp8(h1[0], h1[1], h1[2], h1[3]); *(u32x2*)(hp + 32 * s) = h8; }
            const bf16x8 ah = __builtin_bit_cast(bf16x8, hi), al = __builtin_bit_cast(bf16x8, lo);
#pragma unroll
            for (int nt = 0; nt < 3; ++nt) {
                const bf16x8 bh = *(const LAS bf16x8*)(F.lds + bo[nt] + s * 64), bl = *(const LAS bf16x8*)(F.lds + RW_LO + bo[nt] + s * 64);
                acc[nt] = __builtin_amdgcn_mfma_f32_16x16x32_bf16(ah, bh, acc[nt], 0, 0, 0);
                acc[nt] = __builtin_amdgcn_mfma_f32_16x16x32_bf16(ah, bl, acc[nt], 0, 0, 0);
                acc[nt] = __builtin_amdgcn_mfma_f32_16x16x32_bf16(al, bh, acc[nt], 0, 0, 0);
            }
        }
#pragma unroll
        for (int hf = 0; hf < 2; ++hf) {
            if ((fq >> 1) == hf) {
#pragma unroll
                for (int nt = 0; nt < 3; ++nt) { const int n = 16 * nt + fr;
                    if (n < 36) {
#pragma unroll
                        for (int r = 0; r < 4; ++r) ex[((fq & 1) * 4 + r) * 36 + n] = acc[nt][r]; } }
            }
            asm volatile("s_waitcnt lgkmcnt(0)" ::: "memory");
            if (F.lane < 8) { float sl[36];
#pragma unroll
                for (int n = 0; n < 36; ++n) sl[n] = ex[F.lane * 36 + n];
                route_row<DRY>(F, l, gi * 16 + hf * 8 + F.lane, sl, cnt, list); }
            asm volatile("s_waitcnt lgkmcnt(0)" ::: "memory");
        }
    }
    __syncthreads();
}

__device__ __forceinline__ unsigned off_b(unsigned row, unsigned ch) { return 256u * row + 16u * (ch ^ (((row & 3) << 2) | ((row >> 2) & 3))); }
__device__ __forceinline__ unsigned tr_base_p(unsigned lane) { const unsigned g = lane >> 4, q = (lane & 15) >> 2, p = lane & 3; return off_b(4 * g + q, (p >> 1)) + 8 * (p & 1); }
template <int O0, int O1, int O2, int O3>
__device__ __forceinline__ void tr_frag4(bf16x8 (&f)[4], unsigned a0, unsigned a1, unsigned a2, unsigned a3) {
    s16x4 l0, h0, l1, h1, l2, h2, l3, h3;
    asm volatile("ds_read_b64_tr_b16 %0, %8 offset:%12\n\tds_read_b64_tr_b16 %1, %8 offset:%16\n\t"
                 "ds_read_b64_tr_b16 %2, %9 offset:%13\n\tds_read_b64_tr_b16 %3, %9 offset:%17\n\t"
                 "ds_read_b64_tr_b16 %4, %10 offset:%14\n\tds_read_b64_tr_b16 %5, %10 offset:%18\n\t"
                 "ds_read_b64_tr_b16 %6, %11 offset:%15\n\tds_read_b64_tr_b16 %7, %11 offset:%19\n\ts_waitcnt lgkmcnt(0)"
                 : "=&v"(l0), "=&v"(h0), "=&v"(l1), "=&v"(h1), "=&v"(l2), "=&v"(h2), "=&v"(l3), "=&v"(h3)
                 : "v"(a0), "v"(a1), "v"(a2), "v"(a3), "n"(O0), "n"(O1), "n"(O2), "n"(O3), "n"(O0 + 4096), "n"(O1 + 4096), "n"(O2 + 4096), "n"(O3 + 4096) : "memory");
    f[0] = __builtin_shufflevector(l0, h0, 0, 1, 2, 3, 4, 5, 6, 7); f[1] = __builtin_shufflevector(l1, h1, 0, 1, 2, 3, 4, 5, 6, 7);
    f[2] = __builtin_shufflevector(l2, h2, 0, 1, 2, 3, 4, 5, 6, 7); f[3] = __builtin_shufflevector(l3, h3, 0, 1, 2, 3, 4, 5, 6, 7);
}
template <int O>
__device__ __forceinline__ void tr_frag8(bf16x8 (&f)[8], unsigned a) {
    s16x4 l0, h0, l1, h1, l2, h2, l3, h3, l4, h4, l5, h5, l6, h6, l7, h7;
    const unsigned a1 = a ^ 32u, a2 = a ^ 64u, a3 = a ^ 96u, a4 = a ^ 128u, a5 = a ^ 160u, a6 = a ^ 192u, a7 = a ^ 224u;
    asm volatile("ds_read_b64_tr_b16 %0, %8 offset:%12\n\tds_read_b64_tr_b16 %1, %8 offset:%13\n\t"
                 "ds_read_b64_tr_b16 %2, %9 offset:%12\n\tds_read_b64_tr_b16 %3, %9 offset:%13\n\t"
                 "ds_read_b64_tr_b16 %4, %10 offset:%12\n\tds_read_b64_tr_b16 %5, %10 offset:%13\n\t"
                 "ds_read_b64_tr_b16 %6, %11 offset:%12\n\tds_read_b64_tr_b16 %7, %11 offset:%13"
                 : "=&v"(l0), "=&v"(h0), "=&v"(l1), "=&v"(h1), "=&v"(l2), "=&v"(h2), "=&v"(l3), "=&v"(h3)
                 : "v"(a), "v"(a1), "v"(a2), "v"(a3), "n"(O), "n"(O + 4096) : "memory");
    asm volatile("ds_read_b64_tr_b16 %0, %16 offset:%20\n\tds_read_b64_tr_b16 %1, %16 offset:%21\n\t"
                 "ds_read_b64_tr_b16 %2, %17 offset:%20\n\tds_read_b64_tr_b16 %3, %17 offset:%21\n\t"
                 "ds_read_b64_tr_b16 %4, %18 offset:%20\n\tds_read_b64_tr_b16 %5, %18 offset:%21\n\t"
                 "ds_read_b64_tr_b16 %6, %19 offset:%20\n\tds_read_b64_tr_b16 %7, %19 offset:%21\n\ts_waitcnt lgkmcnt(0)"
                 : "=&v"(l4), "=&v"(h4), "=&v"(l5), "=&v"(h5), "=&v"(l6), "=&v"(h6), "=&v"(l7), "=&v"(h7),
                   "+v"(l0), "+v"(h0), "+v"(l1), "+v"(h1), "+v"(l2), "+v"(h2), "+v"(l3), "+v"(h3)
                 : "v"(a4), "v"(a5), "v"(a6), "v"(a7), "n"(O), "n"(O + 4096) : "memory");
    f[0] = __builtin_shufflevector(l0, h0, 0, 1, 2, 3, 4, 5, 6, 7); f[1] = __builtin_shufflevector(l1, h1, 0, 1, 2, 3, 4, 5, 6, 7);
    f[2] = __builtin_shufflevector(l2, h2, 0, 1, 2, 3, 4, 5, 6, 7); f[3] = __builtin_shufflevector(l3, h3, 0, 1, 2, 3, 4, 5, 6, 7);
    f[4] = __builtin_shufflevector(l4, h4, 0, 1, 2, 3, 4, 5, 6, 7); f[5] = __builtin_shufflevector(l5, h5, 0, 1, 2, 3, 4, 5, 6, 7);
    f[6] = __builtin_shufflevector(l6, h6, 0, 1, 2, 3, 4, 5, 6, 7); f[7] = __builtin_shufflevector(l7, h7, 0, 1, 2, 3, 4, 5, 6, 7);
}
#define LBAR() do { asm volatile("s_waitcnt lgkmcnt(0)" ::: "memory"); __builtin_amdgcn_s_barrier(); asm volatile("" ::: "memory"); } while (0)
__device__ __forceinline__ int chunk_row0(int b, int ci) { return ci < 2 ? NLAT + b * CT + ci * 128 : b * TL + (ci - 2) * 128; }
__device__ __forceinline__ float log2_gamma(float decay) { return -log1pf(expf(-decay)) * 1.4426950408889634f; }

template <int HALF>
__device__ __forceinline__ void pool_item(const LAS unsigned char* tile, bf16_t* A2, int t0, int T, int rbase, int rl, int cg) {
    const int t = t0 + rl; int cnt = 0;
    float s[8];
#pragma unroll
    for (int i = 0; i < 8; ++i) s[i] = 0.f;
    u32x4 c = (u32x4){0u, 0u, 0u, 0u};
#pragma unroll
    for (int w = 0; w < 2 * HALF; ++w) { const int tt = t - HALF + w; const bool ok = tt >= 0 && tt < T;
        u32x4 x = *(const LAS u32x4*)(tile + (rl + 8 - HALF + w) * 1024 + cg * 16); if (!ok) x = (u32x4){0u, 0u, 0u, 0u}; cnt += ok ? 1 : 0; if (w == HALF) c = x;
        s[0] += bflo(x.x); s[1] += bfhi(x.x); s[2] += bflo(x.y); s[3] += bfhi(x.y); s[4] += bflo(x.z); s[5] += bfhi(x.z); s[6] += bflo(x.w); s[7] += bfhi(x.w); }
    const float inv = 1.0f / (float)cnt;
    u32x4 o; o.x = pk2(s[0] * inv - bflo(c.x), s[1] * inv - bfhi(c.x)); o.y = pk2(s[2] * inv - bflo(c.y), s[3] * inv - bfhi(c.y));
    o.z = pk2(s[4] * inv - bflo(c.z), s[5] * inv - bfhi(c.z)); o.w = pk2(s[6] * inv - bflo(c.w), s[7] * inv - bfhi(c.w));
    *(u32x4*)(A2 + (size_t)(rbase + t) * D + 512 + cg * 8) = o;
}

__device__ __forceinline__ void p3a_states_pool(const Frame& F, int l) {
    const bf16_t* P = (const bf16_t*)(F.ws + WS_P);
    bf16_t* ST = (bf16_t*)(F.ws + WS_ACT);
    bf16_t* A2 = hbuf(F);
    const int nstate = (F.G > 128) ? 128 : F.G;
    if (F.bx < nstate) {
        for (int unit = F.bx; unit < 128; unit += nstate) {
            const int dir = unit & 1, bh = unit >> 1, b = bh >> 2, h = bh & 3;
            const float lg2 = log2_gamma((dir ? F.in[I_DB] : F.in[I_DF])[l * NH + h]);
            const float gC = exp2f(lg2 * 128.0f);
            f32x4 acc[8];
#pragma unroll
            for (int dt = 0; dt < 8; ++dt) acc[dt] = (f32x4){0.f, 0.f, 0.f, 0.f};
            u32x4 kr[8], vr[8];
#define P3A_CI(n_) (dir ? ((n_) < 2 ? 1 - (n_) : 19 - (n_)) : (n_))
#define P3A_LOAD(st_) do { _Pragma("unroll") for (int sub = 0; sub < 2; ++sub) { const int r0_ = chunk_row0(b, P3A_CI(2 * (st_) + sub)); \
                _Pragma("unroll") for (int q = 0; q < 4; ++q) { const int p = F.tid + 512 * q, j = p >> 4, ch = p & 15; \
                    kr[sub * 4 + q] = *(const u32x4*)(P + (size_t)(r0_ + j) * NP + 512 + h * 128 + ch * 8); vr[sub * 4 + q] = *(const u32x4*)(P + (size_t)(r0_ + j) * NP + 1024 + h * 128 + ch * 8); } } } while (0)
#define P3A_STORE(n_) do { bf16_t* sp = ST + ((size_t)((bh * 2 + dir) * NCHUNK + P3A_CI(n_)) * 128 + (F.wave * 16 + (F.lane & 15))) * 128 + 4 * (F.lane >> 4); \
                _Pragma("unroll") for (int dt = 0; dt < 8; ++dt) { u32x2 w; w.x = pk2(acc[dt][0], acc[dt][1]); w.y = pk2(acc[dt][2], acc[dt][3]); *(u32x2*)(sp + dt * 16) = w; } } while (0)
#define P3A_KS(KO, VO, ks) do { bf16x8 ka[8]; tr_frag8<(KO) + (ks) * 8192>(ka, tpk); \
                _Pragma("unroll") for (int dt = 0; dt < 8; ++dt) acc[dt] = __builtin_amdgcn_mfma_f32_16x16x32_bf16(ka[dt], vb[ks], acc[dt], 0, 0, 0); } while (0)
#define P3A_SUB(KO, VO) do { _Pragma("unroll") for (int dt = 0; dt < 8; ++dt) acc[dt] *= gC; \
                bf16x8 vb[4]; tr_frag4<(VO), (VO) + 8192, (VO) + 16384, (VO) + 24576>(vb, tpv, tpv, tpv, tpv); \
                P3A_KS(KO, VO, 0); P3A_KS(KO, VO, 1); P3A_KS(KO, VO, 2); P3A_KS(KO, VO, 3); } while (0)
            P3A_LOAD(0);
            for (int st = 0; st < 9; ++st) {
#pragma unroll
                for (int sub = 0; sub < 2; ++sub)
#pragma unroll
                    for (int q = 0; q < 4; ++q) { const int p = F.tid + 512 * q, j = p >> 4, ch = p & 15;
                        const float kd = __builtin_amdgcn_exp2f(lg2 * (float)(dir ? j : 127 - j));
                        const u32x4 kk = kr[sub * 4 + q];
                        u32x4 ks; ks.x = pk2(bflo(kk.x) * kd, bfhi(kk.x) * kd); ks.y = pk2(bflo(kk.y) * kd, bfhi(kk.y) * kd); ks.z = pk2(bflo(kk.z) * kd, bfhi(kk.z) * kd); ks.w = pk2(bflo(kk.w) * kd, bfhi(kk.w) * kd);
                        *(LAS u32x4*)(F.lds + sub * 32768 + off_b(j, ch)) = ks; *(LAS u32x4*)(F.lds + 65536 + sub * 32768 + off_b(j, ch)) = vr[sub * 4 + q]; }
                LBAR();
                if (st < 8) P3A_LOAD(st + 1);
                const unsigned tpk = (unsigned)(size_t)F.lds + tr_base_p(F.lane); const unsigned tpv = (tpk ^ ((unsigned)F.wave << 5)) + 65536u;
                P3A_STORE(2 * st);
                P3A_SUB(0, 0);
                P3A_STORE(2 * st + 1);
                if (st < 8) P3A_SUB(32768, 32768);
                LBAR();
            }
#undef P3A_SUB
#undef P3A_KS
#undef P3A_STORE
#undef P3A_LOAD
#undef P3A_CI
        }
    } else {
        const int pb = F.bx - nstate, npb = F.G - nstate;
        u32x4 ld[10];
#define POOL_LOAD(tile_) do { const int r0_ = (tile_) * 64; int t0_, T_, rb_; if (r0_ < NLAT) { t0_ = r0_ & (TL - 1); T_ = TL; } else { t0_ = (r0_ - NLAT) & (CT - 1); T_ = CT; } rb_ = r0_ - t0_; \
            _Pragma("unroll") for (int q = 0; q < 10; ++q) { const int p = F.tid + 512 * q, rr = p >> 6, ch = p & 63; int tt = t0_ - 8 + rr; tt = tt < 0 ? 0 : (tt >= T_ ? T_ - 1 : tt); \
                ld[q] = *(const u32x4*)(P + (size_t)(rb_ + tt) * NP + 2048 + ch * 8); } } while (0)
        if (pb < 576) POOL_LOAD(pb);
        for (int tile = pb; tile < 576; tile += npb) {
            const int r0 = tile * 64; int t0, T; if (r0 < NLAT) { t0 = r0 & (TL - 1); T = TL; } else { t0 = (r0 - NLAT) & (CT - 1); T = CT; } const int rbase = r0 - t0;
            LBAR();
#pragma unroll
            for (int q = 0; q < 10; ++q) { const int p = F.tid + 512 * q; *(LAS u32x4*)(F.lds + (p >> 6) * 1024 + (p & 63) * 16) = ld[q]; }
            LBAR();
            if (tile + npb < 576) POOL_LOAD(tile + npb);
            for (int wi = F.wave; wi < 64; wi += 8) { const int g = wi & 3, rl = (wi >> 2) * 4 + (F.lane >> 4), cg = g * 16 + (F.lane & 15);
                if (g == 0) pool_item<1>(F.lds, A2, t0, T, rbase, rl, cg); else if (g == 1) pool_item<2>(F.lds, A2, t0, T, rbase, rl, cg);
                else if (g == 2) pool_item<4>(F.lds, A2, t0, T, rbase, rl, cg); else pool_item<8>(F.lds, A2, t0, T, rbase, rl, cg); }
        }
#undef POOL_LOAD
    }
    __syncthreads();
}

__device__ __forceinline__ void p3b_retention(const Frame& F, int l) {
    const bf16_t* P = (const bf16_t*)(F.ws + WS_P);
    const bf16_t* ST = (const bf16_t*)(F.ws + WS_ACT);
    bf16_t* A2 = hbuf(F);
    const int c_lo = (l == DEPTH - 1) ? 2 : 0, ncu = NCHUNK - c_lo, nunits = 64 * ncu;
    u32x4 ld[8], st[8]; bf16x8 qf[4];
#define P3B_LOAD(unit_) do { const int bh_ = (unit_) / ncu, ci_ = c_lo + (unit_) % ncu, h_ = bh_ & 3; const int r0_ = chunk_row0(bh_ >> 2, ci_); \
        _Pragma("unroll") for (int q = 0; q < 4; ++q) { const int p = F.tid + 512 * q, j = p >> 4, ch = p & 15; \
            ld[q] = *(const u32x4*)(P + (size_t)(r0_ + j) * NP + 512 + h_ * 128 + ch * 8); ld[4 + q] = *(const u32x4*)(P + (size_t)(r0_ + j) * NP + 1024 + h_ * 128 + ch * 8); } } while (0)
#define P3B_LOADQ(unit_) do { const int bh_ = (unit_) / ncu, ci_ = c_lo + (unit_) % ncu, h_ = bh_ & 3; const int r0_ = chunk_row0(bh_ >> 2, ci_); \
        _Pragma("unroll") for (int ks = 0; ks < 4; ++ks) qf[ks] = *(const bf16x8*)(P + (size_t)(r0_ + F.wave * 16 + (F.lane & 15)) * NP + h_ * 128 + ks * 32 + (F.lane >> 4) * 8); } while (0)
    if (F.vcu < nunits) { P3B_LOAD(F.vcu); P3B_LOADQ(F.vcu); }
    for (int unit = F.vcu; unit < nunits; unit += F.G) {
        int lane_o = F.lane; asm volatile("" : "+v"(lane_o));
        const int fr = lane_o & 15, fq = lane_o >> 4;
        const unsigned rr0 = off_b((unsigned)fr, (unsigned)fq), tp = (unsigned)(size_t)F.lds + tr_base_p((unsigned)lane_o);
        const int il = F.wave * 16 + fr;
        const int bh = unit / ncu, ci = c_lo + unit % ncu, b = bh >> 2, h = bh & 3;
        const float lgf = log2_gamma(F.in[I_DF][l * NH + h]), lgb = log2_gamma(F.in[I_DB][l * NH + h]);
        const int row0 = chunk_row0(b, ci);
        { const bf16_t* sf = ST + ((size_t)((bh * 2 + 0) * NCHUNK + ci) * 128) * 128; const bf16_t* sb = ST + ((size_t)((bh * 2 + 1) * NCHUNK + ci) * 128) * 128;
#pragma unroll
          for (int q = 0; q < 4; ++q) { const int p = F.tid + 512 * q, j = p >> 4, ch = p & 15; st[q] = *(const u32x4*)(sf + (size_t)j * 128 + ch * 8); st[4 + q] = *(const u32x4*)(sb + (size_t)j * 128 + ch * 8); } }
        LBAR();
#pragma unroll
        for (int q = 0; q < 4; ++q) { const int p = F.tid + 512 * q, j = p >> 4, ch = p & 15; const unsigned o = off_b(j, ch);
            *(LAS u32x4*)(F.lds + o) = ld[q]; *(LAS u32x4*)(F.lds + 32768u + o) = ld[4 + q]; }
        LBAR();
        if (unit + F.G < nunits) P3B_LOAD(unit + F.G);
        u32x2 gg[8];
#pragma unroll
        for (int et = 0; et < 8; ++et) gg[et] = *(const u32x2*)(P + (size_t)(row0 + il) * NP + 1536 + h * 128 + 4 * fq + et * 16);
        bf16x8 pf[4];
#pragma unroll
        for (int ks2 = 0; ks2 < 4; ++ks2) {
            u32x2 half[2];
#pragma unroll
            for (int t = 0; t < 2; ++t) { const int jt = 2 * ks2 + t;
                asm volatile("" ::: "memory");
                f32x4 sa = (f32x4){0.f, 0.f, 0.f, 0.f};
#pragma unroll
                for (int ks = 0; ks < 4; ++ks) { const bf16x8 ka = *(const LAS bf16x8*)(F.lds + ((rr0 ^ ((unsigned)ks << 6)) + 4096u * jt)); sa = __builtin_amdgcn_mfma_f32_16x16x32_bf16(ka, qf[ks], sa, 0, 0, 0); }
                float pv[4];
#pragma unroll
                for (int r = 0; r < 4; ++r) { const int j = 16 * jt + 4 * fq + r, df = il - j;
                    const float w = df > 0 ? __builtin_amdgcn_exp2f(lgf * (float)df) : (df < 0 ? __builtin_amdgcn_exp2f(lgb * (float)(-df)) : 2.0f); pv[r] = sa[r] * w; }
                half[t].x = pk2(pv[0], pv[1]); half[t].y = pk2(pv[2], pv[3]); }
            const u32x4 w4 = (u32x4){half[0].x, half[0].y, half[1].x, half[1].y};
            pf[ks2] = __builtin_bit_cast(bf16x8, w4);
        }
#pragma unroll
        for (int q = 0; q < 4; ++q) { const int p = F.tid + 512 * q, j = p >> 4, ch = p & 15; const unsigned o = off_b(j, ch);
            *(LAS u32x4*)(F.lds + 65536u + o) = st[q]; *(LAS u32x4*)(F.lds + 98304u + o) = st[4 + q]; }
        LBAR();
        const float qdf = __builtin_amdgcn_exp2f(lgf * (float)(il + 1)), qdb = __builtin_amdgcn_exp2f(lgb * (float)(128 - il));
        float o[8][4]; float ss = 0.f;
#pragma unroll
        for (int et = 0; et < 8; ++et) {
            f32x4 ao = (f32x4){0.f, 0.f, 0.f, 0.f}, af = ao, ab = ao;
            bf16x8 va[4]; { const unsigned a = tp ^ ((unsigned)et << 5); tr_frag4<32768, 32768 + 8192, 32768 + 16384, 32768 + 24576>(va, a, a, a, a); }
#pragma unroll
            for (int ks = 0; ks < 4; ++ks) {
                ao = __builtin_amdgcn_mfma_f32_16x16x32_bf16(va[ks], pf[ks], ao, 0, 0, 0);
                const unsigned ra = (rr0 ^ ((unsigned)ks << 6)) + 4096u * et;
                const bf16x8 fa = *(const LAS bf16x8*)(F.lds + 65536u + ra);
                af = __builtin_amdgcn_mfma_f32_16x16x32_bf16(fa, qf[ks], af, 0, 0, 0);
                const bf16x8 ba = *(const LAS bf16x8*)(F.lds + 98304u + ra);
                ab = __builtin_amdgcn_mfma_f32_16x16x32_bf16(ba, qf[ks], ab, 0, 0, 0);
            }
#pragma unroll
            for (int r = 0; r < 4; ++r) { o[et][r] = ao[r] + qdf * af[r] + qdb * ab[r]; ss += o[et][r] * o[et][r]; }
        }
        if (unit + F.G < nunits) P3B_LOADQ(unit + F.G);
        ss += __shfl_xor(ss, 16); ss += __shfl_xor(ss, 32);
        const float rstd = 1.0f / sqrtf(ss * (1.0f / 128.0f) + EPS);
        bf16_t* op = A2 + (size_t)(row0 + il) * D + h * 128 + 4 * fq;
#pragma unroll
        for (int et = 0; et < 8; ++et) { const u32x2 g = gg[et];
            u32x2 w; w.x = pk2(silu_f(bflo(g.x)) * o[et][0] * rstd, silu_f(bfhi(g.x)) * o[et][1] * rstd); w.y = pk2(silu_f(bflo(g.y)) * o[et][2] * rstd, silu_f(bfhi(g.y)) * o[et][3] * rstd);
            *(u32x2*)(op + et * 16) = w; }
    }
#undef P3B_LOAD
#undef P3B_LOADQ
    __syncthreads();
}

#ifndef TYPE_MASK
#define TYPE_MASK 0x3ff
#endif
#define PTYPE(k) ((k) == 0 ? 0 : ((k) == 17 ? 9 : 1 + (((k) - 1) & 7)))
#define ENTER() do { if (PROBE_REPEAT >= 0) __syncthreads(); int _t = threadIdx.x; asm volatile("" : "+v"(_t)); F.tid = _t; F.lane = _t & 63; F.wave = __builtin_amdgcn_readfirstlane(_t >> 6); } while (0)
#define IN(k) (((TYPE_MASK >> PTYPE(k)) & 1) && lo <= (k) && (k) < hi)
#define SEAM(k) do { if (IN(k) && IN((k) + 1)) xcd_barrier(bar); } while (0)
#define REP(t) for (int rep = (PROBE_REPEAT == (t)) ? 0 : 1; rep < 2; ++rep)


template <int l> __device__ __forceinline__ void layer_phases(Frame& F, const XcdBarrier& bar, const int lo, const int hi) {
        const int pb = 1 + 8 * l;
        const bool last = (l == DEPTH - 1);
        const int Mrows = last ? NLAT : NTOK;
        if (IN(pb + 0)) REP(1) { ENTER(); row_op_a(F, l == 0 ? 0 : 1, rep == 0); }
        SEAM(pb + 0);
        if (IN(pb + 1)) REP(2) { ENTER();
            pg8::SchedDense S; S.init(NTOK, NP, D, F.G, F.bx);
            pg8::EpiInProj E{(bf16_t*)(F.ws + WS_P), (const float*)(F.ws + WS_ROPE), (const float*)(F.ws + WS_ROPE) + 96 * 32};
            pg8::gemm_phase<pg8::EpiInProj, pg8::SchedDense, true, true>(F.lds, F.tid, (const char*)hbuf(F), (const char*)(F.ws + WS_WIN) + (size_t)l * NP * D * 2, D, S, E);
        }
        SEAM(pb + 1);
        if (IN(pb + 2)) REP(3) { ENTER(); p3a_states_pool(F, l); }
        SEAM(pb + 2);
        if (IN(pb + 3)) REP(4) { ENTER(); p3b_retention(F, l); }
        SEAM(pb + 3);
        if (IN(pb + 4)) REP(5) { ENTER();
            pg8::SchedDense S; S.init(Mrows, D, D, F.G, F.bx);
            pg8::EpiResid E;
            if (l == 0) { E.rl = F.in[I_X]; E.rc = F.in[I_CTX]; E.rb = nullptr; } else { E.rl = nullptr; E.rc = nullptr; E.rb = (const bf16_t*)(F.ws + WS_XB); }
            E.ob = (rep == 0) ? (bf16_t*)(F.ws + WS_P) : (bf16_t*)(F.ws + WS_XB); E.ssq = (float*)(F.ws + WS_SSQ); E.gmod = mod_ptr(F, l, 0, 2);
            pg8::gemm_phase<pg8::EpiResid, pg8::SchedDense, true, true>(F.lds, F.tid, (const char*)hbuf(F), (const char*)(F.ws + WS_WOUT) + (size_t)l * D * D * 2, D, S, E);
        }
        SEAM(pb + 4);
        if (IN(pb + 5)) REP(6) { ENTER(); if (PROBE_REPEAT == 6 && rep == 0) row_op_b<true>(F, l); else row_op_b<false>(F, l); }
        SEAM(pb + 5);
        if (IN(pb + 6)) REP(7) { ENTER();
            LAS int* tb = build_tb(F, l);
            LAS int* tokt = (LAS int*)(F.lds + TOKT_OFF);
            const int* list = (const int*)(F.ws + WS_LIST);
            pg8::SchedGroup S; S.tb = tb; S.tokt = tokt; S.G = F.G; S.c = F.vcu; S.pitch = D; S.gather = 1;
            { pg8::Unit u; for (int i = 0; i < 8 && S.next(i, u); ++i) { const int g = u.pm; int e = 0; while (tb[e + 1] <= g) ++e; const int rt = g - tb[e], cnt = tb[64 + e];
                if (F.tid < 256) { int r = rt * 256 + F.tid; if (r >= cnt) r = cnt - 1; tokt[i * 256 + F.tid] = list[(size_t)e * NTOK + r]; } } }
            __syncthreads();
            pg8::EpiSwiGLU8 E{(unsigned char*)(F.ws + WS_ACT), 1.0f / WGU_SCALE};
            pg8::gemm_phase<pg8::EpiSwiGLU8, pg8::SchedGroup, true, true, true>(F.lds, F.tid, (const char*)hbuf(F), (const char*)(F.ws + WS_WGU) + (size_t)l * NE * 1024 * D, D, S, E);
        }
        SEAM(pb + 6);
        if (IN(pb + 7)) REP(8) { ENTER();
            LAS int* tb = build_tb(F, l);
            pg8::SchedGroup S; S.tb = tb; S.tokt = nullptr; S.G = F.G; S.c = F.vcu; S.pitch = FF; S.gather = 0;
            pg8::EpiBf16S E{(bf16_t*)(F.ws + WS_P), D, 1.0f / WD_SCALE};
            pg8::gemm_phase<pg8::EpiBf16S, pg8::SchedGroup, true, true, true>(F.lds, F.tid, (const char*)(F.ws + WS_ACT), (const char*)(F.ws + WS_WD) + (size_t)l * NE * D * FF, FF, S, E);
        }
        SEAM(pb + 7);
}

__global__ void __launch_bounds__(512, 2) fwd_kernel(Args args) {
    extern __shared__ __attribute__((aligned(16))) unsigned char lds_raw[];
    Frame F;
    F.lds = (LAS unsigned char*)lds_raw; F.tid = threadIdx.x; F.lane = F.tid & 63; F.wave = __builtin_amdgcn_readfirstlane(F.tid >> 6);
    F.G = gridDim.x; F.bx = blockIdx.x; F.vcu = (F.G % 8 == 0) ? (F.bx % 8) * (F.G / 8) + F.bx / 8 : F.bx;
    F.in = args.in; F.out = args.out; F.ws = args.ws;
    volatile LAS unsigned* MISC = (volatile LAS unsigned*)(F.lds + MISC_OFF);
    if (F.tid < 4) MISC[F.tid] = 0u;
    __syncthreads();
    unsigned* ctl = (unsigned*)(F.ws + WS_CTL);
    XcdBarrier bar; bar.bar = ctl + CW_BAR; bar.x = 0; bar.st = nullptr;
    const int lo = args.ph_lo, hi = args.ph_hi;
    const bool multi = (hi - lo) > 1;
    if (multi) bar = xcd_barrier_post(ctl + CW_BAR, MISC);
    if (IN(0)) REP(0) { ENTER(); p0_prologue(F, rep); }
    SEAM(0);
    layer_phases<0>(F, bar, lo, hi);
    layer_phases<1>(F, bar, lo, hi);
    if (IN(17)) REP(9) { ENTER(); row_op_a(F, 2, rep == 0); }
#undef IN
#undef SEAM
}

extern "C" void kernel_launch(void* const* d_in, const int* in_sizes, int n_in, void* d_out, int out_size, void* d_ws, size_t ws_size, hipStream_t stream) {
    static int grid = 0;
    if (grid == 0) {
        if (n_in != 22 || out_size != NLAT * D || ws_size < WS_END) { fprintf(stderr, "kernel_launch: unexpected shapes (n_in %d, out %d, ws %zu)\n", n_in, out_size, ws_size); grid = -1; return; }
        int dev = 0, cus = 0, per_cu = 0;
        if (hipGetDevice(&dev) != hipSuccess || hipDeviceGetAttribute(&cus, hipDeviceAttributeMultiprocessorCount, dev) != hipSuccess) { grid = -1; return; }
        if (hipFuncSetAttribute((const void*)fwd_kernel, hipFuncAttributeMaxDynamicSharedMemorySize, LDS_BYTES) != hipSuccess) { fprintf(stderr, "kernel_launch: hipFuncSetAttribute failed\n"); grid = -1; return; }
        if (hipOccupancyMaxActiveBlocksPerMultiprocessor(&per_cu, (const void*)fwd_kernel, 512, LDS_BYTES) != hipSuccess || per_cu < 1) { fprintf(stderr, "kernel_launch: occupancy query says %d\n", per_cu); }
        (void)hipGetLastError();
        grid = cus;
    }
    if (grid < 0) return;
    (void)hipMemsetAsync((char*)d_ws + WS_CTL, 0, CTL_ZERO_BYTES, stream);
    Args a{};
    for (int i = 0; i < 22; ++i) a.in[i] = (const float*)d_in[i];
    a.out = (float*)d_out; a.ws = (unsigned char*)d_ws;
    if (MK_N_LAUNCHES == 1) { a.ph_lo = 0; a.ph_hi = N_PHASES; hipLaunchKernelGGL(fwd_kernel, dim3(grid), dim3(512), LDS_BYTES, stream, a); }
    else { for (int p = 0; p < N_PHASES; ++p) { a.ph_lo = p; a.ph_hi = p + 1; hipLaunchKernelGGL(fwd_kernel, dim3(grid), dim3(512), LDS_BYTES, stream, a); } }
}
```

```cpp
#include <hip/hip_runtime.h>
#include <cstdio>
#include <cstdint>

#ifndef MK_N_LAUNCHES
#define MK_N_LAUNCHES 1
#endif

#ifndef PROBE_REPEAT
#define PROBE_REPEAT -1
#endif
#define LAS __attribute__((address_space(3)))
#define GAS __attribute__((address_space(1)))
typedef unsigned short bf16_t;
typedef short bf16x8 __attribute__((ext_vector_type(8)));
typedef short s16x4 __attribute__((ext_vector_type(4)));
typedef float f32x4 __attribute__((ext_vector_type(4)));
typedef float f32x2 __attribute__((ext_vector_type(2)));
typedef unsigned u32x4 __attribute__((ext_vector_type(4)));
typedef unsigned u32x2 __attribute__((ext_vector_type(2)));

constexpr int Bn = 16, TL = 2048, CT = 256, D = 1024, DEPTH = 2;
constexpr int NLAT = Bn * TL, NCTX = Bn * CT, NTOK = NLAT + NCTX;
constexpr int NP = 2560;
constexpr int NE = 32, FF = 512, NH = 4, HD = 128;
constexpr int NCHUNK = 18;
constexpr float EPS = 1e-6f;
constexpr int MAXTILES = 320;
constexpr int N_PHASES = 18;

constexpr size_t MiB = 1u << 20;
constexpr size_t WS_CTL = 0, CTL_ZERO_BYTES = 1 * MiB;
constexpr size_t WS_MOD = 1 * MiB;
constexpr size_t WS_ROPE = 2 * MiB;
constexpr size_t WS_RIMG = 2 * MiB + 65536;
constexpr size_t WS_TOKINFO = 3 * MiB;
constexpr size_t WS_LIST = 5 * MiB;
constexpr size_t WS_WIN = 10 * MiB;
constexpr size_t WS_WOUT = 20 * MiB;
constexpr size_t WS_WGU = 24 * MiB;
constexpr size_t WS_WD = 152 * MiB;
constexpr size_t WS_SSQ = 216 * MiB;
constexpr size_t WS_XB = 232 * MiB;
constexpr size_t WS_P = 304 * MiB;
constexpr size_t WS_ACT = 484 * MiB;
constexpr size_t WS_END = 564 * MiB;
constexpr int CW_TMO = 0;
constexpr int CW_QUEUE = 512;
constexpr int CW_CNT = 1024;
constexpr int CW_BAR = 4096;

constexpr int RING_BYTES = 131072;
constexpr int TOKT_OFF = RING_BYTES;
constexpr int MISC_OFF = 161792;
constexpr int RW_PITCH = 2064;
constexpr int RW_LO = 36 * RW_PITCH, RW_EX = 2 * 36 * RW_PITCH;
constexpr int LDS_BYTES = 163840;

__device__ __forceinline__ unsigned f2bf(float f) { unsigned u = __builtin_bit_cast(unsigned, f); return (u + 0x7fffu + ((u >> 16) & 1u)) >> 16; }
typedef __bf16 bf16x2_t __attribute__((ext_vector_type(2)));
__device__ __forceinline__ unsigned pk2(float lo, float hi) { const f32x2 f = {lo, hi}; const bf16x2_t v = __builtin_convertvector(f, bf16x2_t); return __builtin_bit_cast(unsigned, v); }
__device__ __forceinline__ float bflo(unsigned w) { return __builtin_bit_cast(float, w << 16); }
__device__ __forceinline__ float bfhi(unsigned w) { return __builtin_bit_cast(float, w & 0xffff0000u); }
__device__ __forceinline__ float wave_sum(float v) {
#pragma unroll
    for (int o = 1; o < 64; o <<= 1) v += __shfl_xor(v, o);
    return v;
}
__device__ __forceinline__ float silu_f(float x) { return x * __builtin_amdgcn_rcpf(1.0f + __builtin_amdgcn_exp2f(-1.4426950408889634f * x)); }

#define XB_TMO      128
#define XB_XCNT(j)  (256  + 64 * (j))
#define XB_XSUB(j)  (1280 + 64 * (j))
#define XB_XGEN(j)  (2304 + 64 * (j))
#define XB_TOP      3328
#define XB_TOPGEN   3392
#define XCD_BAR_WORDS 3456
#define XB_SPIN_CAP (1u << 18)
__device__ __forceinline__ unsigned xb_ld(unsigned* p)              { return __hip_atomic_load(p, __ATOMIC_RELAXED, __HIP_MEMORY_SCOPE_AGENT); }
__device__ __forceinline__ unsigned xb_add(unsigned* p, unsigned v) { return __hip_atomic_fetch_add(p, v, __ATOMIC_RELAXED, __HIP_MEMORY_SCOPE_AGENT); }
__device__ __forceinline__ unsigned xb_xcc_id() { return (unsigned)__builtin_amdgcn_s_getreg((3 << 11) | 20) & 0xFu; }
#define XB_SPIN(cond, bar) do { unsigned _sp = 0; while (cond) { __builtin_amdgcn_s_sleep(1); \
    if ((++_sp & 255u) == 0u) { if (xb_ld(&(bar)[XB_TMO])) break; if (_sp > XB_SPIN_CAP) { atomicAdd(&(bar)[XB_TMO], 1u); break; } } } } while (0)
struct XcdBarrier { unsigned* bar; unsigned x; volatile LAS unsigned* st; };
__device__ __forceinline__ XcdBarrier xcd_barrier_post(unsigned* bar, volatile LAS unsigned* st) {
    XcdBarrier b; b.bar = bar; b.x = xb_xcc_id(); b.st = st;
    if (threadIdx.x == 0) (void)xb_add(&bar[XB_XCNT(b.x)], 1u);
    return b;
}
__device__ __forceinline__ void xcd_barrier_complete(unsigned* bar, unsigned x, unsigned& nloc, unsigned& nx) {
    const unsigned G = gridDim.x * gridDim.y * gridDim.z;
    unsigned sum, cnt, mine, sp = 0u;
    for (;;) {
        sum = 0u; cnt = 0u; mine = 0u;
#pragma unroll
        for (unsigned j = 0; j < 16; ++j) { const unsigned c = xb_ld(&bar[XB_XCNT(j)]); sum += c; cnt += (c > 0u) ? 1u : 0u; mine = (j == x) ? c : mine; }
        if (sum == G) break;
        __builtin_amdgcn_s_sleep(1);
        if ((++sp & 255u) == 0u) { if (xb_ld(&bar[XB_TMO])) break; if (sp > XB_SPIN_CAP) { atomicAdd(&bar[XB_TMO], 1u); break; } }
    }
    nloc = mine > 0u ? mine : 1u; nx = cnt > 0u ? cnt : 1u;
}
__device__ __forceinline__ void xcd_barrier(const XcdBarrier& b) {
    asm volatile("s_waitcnt vmcnt(0)" ::: "memory");
    __syncthreads();
    if (threadIdx.x == 0) {
        unsigned* bar = b.bar;
        __builtin_amdgcn_s_waitcnt(0);
        unsigned nloc = b.st[0], nx = b.st[1];
        if (nloc == 0u) { xcd_barrier_complete(bar, b.x, nloc, nx); b.st[0] = nloc; b.st[1] = nx; }
        const unsigned old = xb_add(&bar[XB_XSUB(b.x)], 1u);
        const unsigned gen = old / nloc;
        if (old + 1u == (gen + 1u) * nloc) {
            __builtin_amdgcn_fence(__ATOMIC_RELEASE, "agent");
            asm volatile("s_waitcnt vmcnt(0)" ::: "memory");
            const unsigned og = xb_add(&bar[XB_TOP], 1u);
            const unsigned tg = og / nx;
            if (og + 1u == (tg + 1u) * nx) xb_add(&bar[XB_TOPGEN], 1u);
            else XB_SPIN(xb_ld(&bar[XB_TOPGEN]) == tg, bar);
            __builtin_amdgcn_fence(__ATOMIC_ACQUIRE, "agent");
            xb_add(&bar[XB_XGEN(b.x)], 1u);
            asm volatile("s_waitcnt vmcnt(0)" ::: "memory");
        } else {
            XB_SPIN(xb_ld(&bar[XB_XGEN(b.x)]) == gen, bar);
            __builtin_amdgcn_fence(__ATOMIC_ACQUIRE, "agent");
            asm volatile("s_waitcnt vmcnt(0)" ::: "memory");
        }
    }
    __syncthreads();
}

namespace pg8 {
constexpr int BM = 256, BK = 64, HALF = 128, HTB = HALF * BK * 2, STAGE_BYTES = 8 * HTB, NXCD = 8, WGM = 8;
__device__ __forceinline__ int lds_byte(int r, int c) { const int st = (r >> 4) * 2 + (c >> 5), rr = r & 15, cc = c & 31, ob = rr * 64 + cc * 2; return st * 1024 + (ob ^ (((ob >> 9) & 1) << 5)); }
__device__ __forceinline__ void stage_rc(int b, int& R, int& C) { const int st = b / 1024, sb = b % 1024, swz = sb ^ (((sb >> 9) & 1) << 5); R = (st >> 1) * 16 + swz / 64; C = (st & 1) * 32 + (swz % 64) / 2; }
__device__ __forceinline__ int perm32(int rho) { const int n = rho >> 4, i = rho & 15; return 8 * (i >> 2) + 4 * n + (i & 3); }

struct Unit { int pm, pn; unsigned bofs; int aux; };

struct SchedDense {
    int nM, nN, nwg, G, c, K;
    __device__ void init(int M, int N, int K_, int G_, int c_) { nM = M / BM; nN = N / BM; nwg = nM * nN; G = G_; c = c_; K = K_; }
    __device__ bool next(int i, Unit& u) const {
        const long L = (long)i * G + c; if (L >= nwg) return false;
        int wgid = (int)L; { const int q = nwg / NXCD, r = nwg % NXCD, xcd = wgid % NXCD, off = wgid / NXCD; wgid = (xcd < r ? xcd * (q + 1) : r * (q + 1) + (xcd - r) * q) + off; }
        const int nig = WGM * nN, gid = wgid / nig, fm = gid * WGM, gsz = (nM - fm) < WGM ? (nM - fm) : WGM;
        u.pm = fm + ((wgid % nig) % gsz); u.pn = (wgid % nig) / gsz; u.bofs = (unsigned)u.pn * (unsigned)(BM * K * 2); u.aux = 0; return true;
    }
    __device__ __forceinline__ unsigned a_row(const Unit& u, int r) const { return (unsigned)(u.pm * BM + r); }
};
struct SchedGroup {
    const LAS int* tb; const LAS int* tokt; int G, c, pitch, gather;
    __device__ bool next(int i, Unit& u) const {
        const int L = i * G + c, nt = tb[NE]; if (L >= nt * 4) return false;
        const int g = L >> 2; const int ln = (int)(threadIdx.x & 63u);
        const int e = (int)__popcll(__ballot(ln < NE && tb[ln + 1] <= g));
        u.pm = g; u.pn = L & 3; u.bofs = (unsigned)(e * 1024 + u.pn * BM) * (unsigned)pitch; u.aux = i; return true;
    }
    __device__ __forceinline__ unsigned a_row(const Unit& u, int r) const { return gather ? (unsigned)tokt[u.aux * 256 + r] : (unsigned)(u.pm * BM + r); }
};

__device__ __forceinline__ unsigned cvt_pk_bf16(float lo, float hi) { unsigned r; asm volatile("v_cvt_pk_bf16_f32 %0, %1, %2" : "=v"(r) : "v"(lo), "v"(hi)); return r; }

typedef int i32x4 __attribute__((ext_vector_type(4)));
typedef int i32x8 __attribute__((ext_vector_type(8)));
template <bool F8> struct Frag { bf16x8 k[2]; };
template <> struct Frag<true> { i32x8 v; };
template <class Epi, class Sched, bool ALIGN_EPI, bool SP2, bool F8 = false>
__device__ __forceinline__ void gemm_phase(LAS unsigned char* lds, const int tid, const char* Abase, const char* Bbase, const int K, const Sched& S, const Epi& E) {
    const int wid = __builtin_amdgcn_readfirstlane(tid >> 6), lane = tid & 63, wr = wid >> 2, wc = wid & 3, fr = lane & 15, fq = lane >> 4;
    const int nt = F8 ? K / 128 : K / BK; const unsigned pitch = F8 ? (unsigned)K : 2u * (unsigned)K;
    int Rr[2], Cc[2]; unsigned voffB[2];
#pragma unroll
    for (int i = 0; i < 2; ++i) { int R, C; stage_rc(tid * 16 + i * 8192, R, C); const int Rb = Epi::PERM ? ((R & ~31) + perm32(R & 31)) : R;
        Rr[i] = R; Cc[i] = C; voffB[i] = (unsigned)Rb * pitch + 2u * (unsigned)C; }
    const size_t kstep = (size_t)(BK * 2);
    const size_t hstep = (size_t)HALF * pitch;
    const unsigned ldsw = (unsigned)wid * 1024u;
    const int fcol = F8 ? (fq >> 1) * 32 + (fq & 1) * 16 : fq * 8;
    const int aoff = lds_byte(wr * 64 + fr, fcol), boff = lds_byte(wc * 32 + fr, fcol);
#define PG8_SA(b, h) (((b) * 2 + (h)) * HTB)
#define PG8_SB(b, h) ((4 + (b) * 2 + (h)) * HTB)
#define PG8_STAGE(bufoff, gbase, voff) do { _Pragma("unroll") for (int _i = 0; _i < 2; ++_i) \
        __builtin_amdgcn_global_load_lds((const unsigned*)((const char*)(gbase) + (voff)[_i]), (LAS unsigned*)(lds + (bufoff) + ldsw + _i * 8192), 16, 0, 0); } while (0)
#define PG8_LDF(dstf, off_) do { if constexpr (F8) { const i32x4 _lo = *(const LAS i32x4*)(lds + (off_)), _hi = *(const LAS i32x4*)(lds + (off_) + 16); dstf.v = __builtin_shufflevector(_lo, _hi, 0, 1, 2, 3, 4, 5, 6, 7); } \
        else { dstf.k[0] = *(const LAS bf16x8*)(lds + (off_)); dstf.k[1] = *(const LAS bf16x8*)(lds + (off_) + 1024); } } while (0)
#define PG8_LDA(dst, b, h) do { _Pragma("unroll") for (int m = 0; m < 4; ++m) PG8_LDF(dst[m], PG8_SA(b, h) + aoff + m * 2048); } while (0)
#define PG8_LDB(dst, b, h) do { _Pragma("unroll") for (int n = 0; n < 2; ++n) PG8_LDF(dst[n], PG8_SB(b, h) + boff + n * 2048); } while (0)
#define PG8_MMA(ai, bj, At, Bt) do { __builtin_amdgcn_s_setprio(1); _Pragma("unroll") for (int m = 0; m < 4; ++m) _Pragma("unroll") for (int n = 0; n < 2; ++n) { \
        if constexpr (F8) asm volatile("v_mfma_f32_16x16x128_f8f6f4 %0, %1, %2, %0" : "+v"(acc[ai][bj][m][n]) : "v"(Bt[n].v), "v"(At[m].v));   \
        else { _Pragma("unroll") for (int k = 0; k < 2; ++k) acc[ai][bj][m][n] = __builtin_amdgcn_mfma_f32_16x16x32_bf16(Bt[n].k[k], At[m].k[k], acc[ai][bj][m][n], 0, 0, 0); } } \
        __builtin_amdgcn_s_setprio(0); } while (0)
#define PG8_WAIT_V(n) asm volatile("s_waitcnt vmcnt(" #n ")" ::: "memory")
#define PG8_WAIT_L(n) asm volatile("s_waitcnt lgkmcnt(" #n ")" ::: "memory")
#define PG8_BAR __builtin_amdgcn_s_barrier()
#define PG8_SCHED __builtin_amdgcn_sched_barrier(0)
#define PG8_AOFF(dst, u) do { _Pragma("unroll") for (int _h = 0; _h < 2; ++_h) _Pragma("unroll") for (int _i = 0; _i < 2; ++_i) \
        dst[_h][_i] = S.a_row(u, _h * HALF + Rr[_i]) * pitch + 2u * (unsigned)Cc[_i]; } while (0)
    Unit cur, nxt; int ui = 0;
    if (!S.next(0, cur)) return;
    f32x4 acc[2][2][4][2];
#pragma unroll
    for (int a = 0; a < 2; ++a)
#pragma unroll
        for (int b = 0; b < 2; ++b)
#pragma unroll
            for (int m = 0; m < 4; ++m)
#pragma unroll
                for (int n = 0; n < 2; ++n) acc[a][b][m][n] = (f32x4){0.f, 0.f, 0.f, 0.f};
    Frag<F8> At[4], B0[2], B1[2];
    unsigned co[2][2], no[2][2];
    PG8_AOFF(co, cur);
    const char* cB = Bbase + cur.bofs;
    if constexpr (SP2) {
        PG8_STAGE(PG8_SB(0, 0), cB, voffB); PG8_STAGE(PG8_SB(0, 1), cB + hstep, voffB); PG8_STAGE(PG8_SA(0, 0), Abase, co[0]); PG8_STAGE(PG8_SA(0, 1), Abase, co[1]);
        if (wr == 1) PG8_BAR;
        PG8_WAIT_V(2); PG8_BAR;
        PG8_STAGE(PG8_SB(1, 0), cB + kstep, voffB); PG8_STAGE(PG8_SA(1, 0), Abase + kstep, co[0]); PG8_STAGE(PG8_SB(1, 1), cB + hstep + kstep, voffB);
        PG8_WAIT_V(6); PG8_BAR;
    } else {
        PG8_STAGE(PG8_SB(0, 0), cB, voffB); PG8_STAGE(PG8_SA(0, 0), Abase, co[0]); PG8_STAGE(PG8_SB(0, 1), cB + hstep, voffB); PG8_STAGE(PG8_SA(0, 1), Abase, co[1]);
        if (wr == 1) PG8_BAR;
        PG8_WAIT_V(4); PG8_BAR;
        PG8_STAGE(PG8_SB(1, 0), cB + kstep, voffB); PG8_STAGE(PG8_SA(1, 0), Abase + kstep, co[0]); PG8_STAGE(PG8_SB(1, 1), cB + hstep + kstep, voffB);
        PG8_WAIT_V(6); PG8_BAR;
    }
    for (;;) {
        const bool has_next = S.next(ui + 1, nxt);
        const char* nB = has_next ? Bbase + nxt.bofs : cB;
        if (has_next) { PG8_AOFF(no, nxt); } else {
#pragma unroll
            for (int h = 0; h < 2; ++h)
#pragma unroll
                for (int i = 0; i < 2; ++i) no[h][i] = co[h][i]; }
#pragma unroll 1
        for (int t = 0; t < nt; t += 2) {
            const bool last = (t == nt - 2);
            const char* a1 = Abase + (size_t)(t + 1) * kstep;
            const char* a2 = last ? Abase : Abase + (size_t)(t + 2) * kstep; const char* b2 = last ? nB : cB + (size_t)(t + 2) * kstep;
            const char* a3 = a2 + kstep; const char* b3 = b2 + kstep;
            unsigned o2[2][2];
#pragma unroll
            for (int h = 0; h < 2; ++h)
#pragma unroll
                for (int i = 0; i < 2; ++i) o2[h][i] = last ? no[h][i] : co[h][i];
            if constexpr (SP2) {
            PG8_LDB(B0, 0, 0); PG8_LDB(B1, 0, 1); PG8_SCHED; PG8_LDA(At, 0, 0); PG8_STAGE(PG8_SA(1, 1), a1, co[1]);
            PG8_WAIT_V(8); PG8_WAIT_L(0); PG8_BAR; PG8_MMA(0, 0, At, B0); PG8_MMA(0, 1, At, B1); PG8_BAR; PG8_SCHED;
            PG8_LDA(At, 0, 1); PG8_STAGE(PG8_SB(0, 0), b2, voffB); PG8_STAGE(PG8_SB(0, 1), b2 + hstep, voffB); PG8_STAGE(PG8_SA(0, 0), a2, o2[0]);
            PG8_WAIT_V(8); PG8_WAIT_L(0); PG8_BAR; PG8_MMA(1, 0, At, B0); PG8_MMA(1, 1, At, B1); PG8_BAR; PG8_SCHED;
            PG8_LDB(B0, 1, 0); PG8_LDB(B1, 1, 1); PG8_SCHED; PG8_LDA(At, 1, 0); PG8_STAGE(PG8_SA(0, 1), a2, o2[1]);
            PG8_WAIT_V(8); PG8_WAIT_L(0); PG8_BAR; PG8_MMA(0, 0, At, B0); PG8_MMA(0, 1, At, B1); PG8_BAR; PG8_SCHED;
            PG8_LDA(At, 1, 1); PG8_STAGE(PG8_SB(1, 0), b3, voffB); PG8_STAGE(PG8_SB(1, 1), b3 + hstep, voffB); PG8_STAGE(PG8_SA(1, 0), a3, o2[0]);
            PG8_WAIT_V(8); PG8_WAIT_L(0); PG8_BAR; PG8_MMA(1, 0, At, B0); PG8_MMA(1, 1, At, B1); PG8_BAR; PG8_SCHED;
            } else {
            PG8_LDB(B0, 0, 0); PG8_SCHED; PG8_LDA(At, 0, 0); PG8_STAGE(PG8_SA(1, 1), a1, co[1]);
            PG8_WAIT_L(8); PG8_BAR; PG8_WAIT_L(0); PG8_MMA(0, 0, At, B0); PG8_BAR; PG8_SCHED;
            PG8_LDB(B1, 0, 1); PG8_STAGE(PG8_SB(0, 0), b2, voffB);
            PG8_BAR; PG8_WAIT_L(0); PG8_MMA(0, 1, At, B1); PG8_BAR;
            PG8_LDA(At, 0, 1); PG8_STAGE(PG8_SA(0, 0), a2, o2[0]);
            PG8_BAR; PG8_WAIT_L(0); PG8_MMA(1, 0, At, B0); PG8_BAR; PG8_SCHED;
            PG8_STAGE(PG8_SB(0, 1), b2 + hstep, voffB);
            PG8_WAIT_V(6); PG8_BAR; PG8_MMA(1, 1, At, B1); PG8_BAR;
            PG8_LDB(B0, 1, 0); PG8_SCHED; PG8_LDA(At, 1, 0); PG8_STAGE(PG8_SA(0, 1), a2, o2[1]);
            PG8_WAIT_L(8); PG8_BAR; PG8_WAIT_L(0); PG8_MMA(0, 0, At, B0); PG8_BAR; PG8_SCHED;
            PG8_LDB(B1, 1, 1); PG8_STAGE(PG8_SB(1, 0), b3, voffB);
            PG8_BAR; PG8_WAIT_L(0); PG8_MMA(0, 1, At, B1); PG8_BAR;
            PG8_LDA(At, 1, 1); PG8_STAGE(PG8_SA(1, 0), a3, o2[0]);
            PG8_BAR; PG8_WAIT_L(0); PG8_MMA(1, 0, At, B0); PG8_BAR; PG8_SCHED;
            PG8_STAGE(PG8_SB(1, 1), b3 + hstep, voffB);
            PG8_WAIT_V(6); PG8_BAR; PG8_MMA(1, 1, At, B1); PG8_BAR;
            }
        }
        if constexpr (ALIGN_EPI) { if (wr == 0) PG8_BAR; }
        if constexpr (F8) { __builtin_amdgcn_sched_barrier(0); asm volatile("s_nop 15\n\ts_nop 15\n\ts_nop 7" ::: "memory"); __builtin_amdgcn_sched_barrier(0); }
        E(acc, cur, wr, wc, fr, fq);
        if (!has_next) break;
#pragma unroll
        for (int a = 0; a < 2; ++a)
#pragma unroll
            for (int b = 0; b < 2; ++b)
#pragma unroll
                for (int m = 0; m < 4; ++m)
#pragma unroll
                    for (int n = 0; n < 2; ++n) acc[a][b][m][n] = (f32x4){0.f, 0.f, 0.f, 0.f};
        cur = nxt; cB = nB; ++ui;
#pragma unroll
        for (int h = 0; h < 2; ++h)
#pragma unroll
            for (int i = 0; i < 2; ++i) co[h][i] = no[h][i];
        if constexpr (ALIGN_EPI) { if (wr == 1) PG8_BAR; }
    }
    PG8_WAIT_V(0);
    if constexpr (!ALIGN_EPI) { if (wr == 0) PG8_BAR; }
    PG8_BAR;
#undef PG8_SA
#undef PG8_SB
#undef PG8_STAGE
#undef PG8_LDA
#undef PG8_LDF
#undef PG8_LDB
#undef PG8_MMA
#undef PG8_WAIT_V
#undef PG8_WAIT_L
#undef PG8_BAR
#undef PG8_SCHED
#undef PG8_AOFF
}

struct EpiInProj {
    static constexpr bool PERM = true;
    bf16_t* P; const float* ropeC; const float* ropeS;
    __device__ __forceinline__ void operator()(const f32x4 (&acc)[2][2][4][2], const Unit& u, int wr, int wc, int fr, int fq) const {
        const int row0 = u.pm * BM + wr * 64 + fr, col0 = u.pn * BM + wc * 32 + 8 * fq;
        const bool qk = u.pn < 4, rope = qk && (u.pm < NLAT / BM);
        const float ks = (u.pn >= 2 && u.pn < 4) ? 0.08838834764831845f : 1.0f;
        const int sec = wc >> 1, i0 = (wc & 1) * 16 + 4 * fq;
#pragma unroll
        for (int ai = 0; ai < 2; ++ai)
#pragma unroll
            for (int m = 0; m < 4; ++m) {
                const int row = row0 + ai * HALF + m * 16;
                asm volatile("" ::: "memory");
                f32x4 c4 = (f32x4){1.f, 1.f, 1.f, 1.f}, s4 = (f32x4){0.f, 0.f, 0.f, 0.f};
                if (rope) { const int t = row & (TL - 1), pos = sec ? (t & 63) : (t >> 6); const int ti = (sec ? 1024 : 0) + pos * 32 + i0;
                    c4 = *(const f32x4*)(ropeC + ti); s4 = *(const f32x4*)(ropeS + ti); }
                bf16_t* rowp = P + (size_t)row * NP + col0;
#pragma unroll
                for (int bj = 0; bj < 2; ++bj) {
                    f32x4 v0 = acc[ai][bj][m][0], v1 = acc[ai][bj][m][1];
                    if (qk) {
                        const float a0 = v0[0] * c4[0] - v0[1] * s4[0], b0 = v0[0] * s4[0] + v0[1] * c4[0];
                        const float a1 = v0[2] * c4[1] - v0[3] * s4[1], b1 = v0[2] * s4[1] + v0[3] * c4[1];
                        const float a2 = v1[0] * c4[2] - v1[1] * s4[2], b2 = v1[0] * s4[2] + v1[1] * c4[2];
                        const float a3 = v1[2] * c4[3] - v1[3] * s4[3], b3 = v1[2] * s4[3] + v1[3] * c4[3];
                        v0 = (f32x4){a0 * ks, b0 * ks, a1 * ks, b1 * ks}; v1 = (f32x4){a2 * ks, b2 * ks, a3 * ks, b3 * ks};
                    }
                    u32x4 w; w.x = cvt_pk_bf16(v0[0], v0[1]); w.y = cvt_pk_bf16(v0[2], v0[3]); w.z = cvt_pk_bf16(v1[0], v1[1]); w.w = cvt_pk_bf16(v1[2], v1[3]);
                    *(u32x4*)(rowp + bj * HALF) = w;
                }
            }
    }
};
struct EpiResid {
    static constexpr bool PERM = true;
    const float* rl; const float* rc; const bf16_t* rb; bf16_t* ob; float* ssq; const float* gmod;
    __device__ __forceinline__ void operator()(const f32x4 (&acc)[2][2][4][2], const Unit& u, int wr, int wc, int fr, int fq) const {
        const int row0 = u.pm * BM + wr * 64 + fr, col0 = u.pn * BM + wc * 32 + 8 * fq;
        const bool lat = u.pm < NLAT / BM; const int b = lat ? (u.pm >> 3) : 16;
        const float* rbase = rl ? (lat ? rl : rc - (size_t)NLAT * D) : nullptr;
        f32x4 gv[2][2];
#pragma unroll
        for (int bj = 0; bj < 2; ++bj)
#pragma unroll
            for (int n = 0; n < 2; ++n) gv[bj][n] = *(const f32x4*)(gmod + (size_t)b * 6 * D + col0 + bj * HALF + 4 * n);
#pragma unroll
        for (int ai = 0; ai < 2; ++ai)
#pragma unroll
            for (int m = 0; m < 4; ++m) { const int row = row0 + ai * HALF + m * 16; const size_t off = (size_t)row * D + col0; float ss = 0.f;
#pragma unroll
                for (int bj = 0; bj < 2; ++bj) { f32x4 r0, r1;
                    if (rbase) { r0 = *(const f32x4*)(rbase + off + bj * HALF); r1 = *(const f32x4*)(rbase + off + bj * HALF + 4); }
                    else { const u32x4 w = *(const u32x4*)(rb + off + bj * HALF); r0 = (f32x4){bflo(w.x), bfhi(w.x), bflo(w.y), bfhi(w.y)}; r1 = (f32x4){bflo(w.z), bfhi(w.z), bflo(w.w), bfhi(w.w)}; }
                    const f32x4 v0 = r0 + gv[bj][0] * acc[ai][bj][m][0], v1 = r1 + gv[bj][1] * acc[ai][bj][m][1];
                    ss += (v0[0] * v0[0] + v0[1] * v0[1]) + (v0[2] * v0[2] + v0[3] * v0[3]) + (v1[0] * v1[0] + v1[1] * v1[1]) + (v1[2] * v1[2] + v1[3] * v1[3]);
                    u32x4 w; w.x = cvt_pk_bf16(v0[0], v0[1]); w.y = cvt_pk_bf16(v0[2], v0[3]); w.z = cvt_pk_bf16(v1[0], v1[1]); w.w = cvt_pk_bf16(v1[2], v1[3]);
                    *(u32x4*)(ob + off + bj * HALF) = w; }
                ss += __shfl_xor(ss, 16); ss += __shfl_xor(ss, 32);
                if (fq == 0) ssq[(size_t)row * 16 + u.pn * 4 + wc] = ss;
                if (m & 1) asm volatile("" ::: "memory"); }
    }
};
struct EpiSwiGLU {
    static constexpr bool PERM = true;
    bf16_t* O;
    __device__ __forceinline__ void operator()(const f32x4 (&acc)[2][2][4][2], const Unit& u, int wr, int wc, int fr, int fq) const {
        const int row0 = u.pm * BM + wr * 64 + fr, col0 = u.pn * 128 + wc * 16 + 4 * fq;
#pragma unroll
        for (int ai = 0; ai < 2; ++ai)
#pragma unroll
            for (int m = 0; m < 4; ++m) { bf16_t* rowp = O + (size_t)(row0 + ai * HALF + m * 16) * FF + col0;
#pragma unroll
                for (int bj = 0; bj < 2; ++bj) { const f32x4 g = acc[ai][bj][m][0], up = acc[ai][bj][m][1];
                    u32x2 w; w.x = cvt_pk_bf16(silu_f(g[0]) * up[0], silu_f(g[1]) * up[1]); w.y = cvt_pk_bf16(silu_f(g[2]) * up[2], silu_f(g[3]) * up[3]);
                    *(u32x2*)(rowp + bj * 64) = w; } }
    }
};
__device__ __forceinline__ unsigned pk4_fp8(float a, float b, float c, float d) { int p = __builtin_amdgcn_cvt_pk_fp8_f32(a, b, 0, false); p = __builtin_amdgcn_cvt_pk_fp8_f32(c, d, p, true); return (unsigned)p; }
struct EpiSwiGLU8 {
    static constexpr bool PERM = true;
    unsigned char* O; float inv;
    __device__ __forceinline__ void operator()(const f32x4 (&acc)[2][2][4][2], const Unit& u, int wr, int wc, int fr, int fq) const {
        const int row0 = u.pm * BM + wr * 64 + fr, col0 = u.pn * 128 + wc * 32 + 8 * fq;
#pragma unroll
        for (int ai = 0; ai < 2; ++ai)
#pragma unroll
            for (int m = 0; m < 4; ++m) { unsigned char* rowp = O + (size_t)(row0 + ai * HALF + m * 16) * FF + col0;
                const f32x4 g0 = acc[ai][0][m][0] * inv, g1 = acc[ai][0][m][1] * inv, u0 = acc[ai][1][m][0] * inv, u1 = acc[ai][1][m][1] * inv;
                u32x2 w; w.x = pk4_fp8(silu_f(g0[0]) * u0[0], silu_f(g0[1]) * u0[1], silu_f(g0[2]) * u0[2], silu_f(g0[3]) * u0[3]);
                w.y = pk4_fp8(silu_f(g1[0]) * u1[0], silu_f(g1[1]) * u1[1], silu_f(g1[2]) * u1[2], silu_f(g1[3]) * u1[3]);
                *(u32x2*)rowp = w; }
    }
};
struct EpiBf16S {
    static constexpr bool PERM = true;
    bf16_t* O; int ldc; float inv;
    __device__ __forceinline__ void operator()(const f32x4 (&acc)[2][2][4][2], const Unit& u, int wr, int wc, int fr, int fq) const {
        const int row0 = u.pm * BM + wr * 64 + fr, col0 = u.pn * BM + wc * 32 + 8 * fq;
#pragma unroll
        for (int ai = 0; ai < 2; ++ai)
#pragma unroll
            for (int m = 0; m < 4; ++m) { bf16_t* rowp = O + (size_t)(row0 + ai * HALF + m * 16) * ldc + col0;
#pragma unroll
                for (int bj = 0; bj < 2; ++bj) { const f32x4 v0 = acc[ai][bj][m][0] * inv, v1 = acc[ai][bj][m][1] * inv;
                    u32x4 w; w.x = cvt_pk_bf16(v0[0], v0[1]); w.y = cvt_pk_bf16(v0[2], v0[3]); w.z = cvt_pk_bf16(v1[0], v1[1]); w.w = cvt_pk_bf16(v1[2], v1[3]);
                    *(u32x4*)(rowp + bj * HALF) = w; } }
    }
};
struct EpiBf16 {
    static constexpr bool PERM = true;
    bf16_t* O; int ldc;
    __device__ __forceinline__ void operator()(const f32x4 (&acc)[2][2][4][2], const Unit& u, int wr, int wc, int fr, int fq) const {
        const int row0 = u.pm * BM + wr * 64 + fr, col0 = u.pn * BM + wc * 32 + 8 * fq;
#pragma unroll
        for (int ai = 0; ai < 2; ++ai)
#pragma unroll
            for (int m = 0; m < 4; ++m) { bf16_t* rowp = O + (size_t)(row0 + ai * HALF + m * 16) * ldc + col0;
#pragma unroll
                for (int bj = 0; bj < 2; ++bj) { const f32x4 v0 = acc[ai][bj][m][0], v1 = acc[ai][bj][m][1];
                    u32x4 w; w.x = cvt_pk_bf16(v0[0], v0[1]); w.y = cvt_pk_bf16(v0[2], v0[3]); w.z = cvt_pk_bf16(v1[0], v1[1]); w.w = cvt_pk_bf16(v1[2], v1[3]);
                    *(u32x4*)(rowp + bj * HALF) = w; } }
    }
};
}

struct Args { const float* in[22]; float* out; unsigned char* ws; int ph_lo, ph_hi; };
enum { I_X = 0, I_C, I_CTX, I_CCTX, I_ADAW, I_ADAB, I_N1G, I_WIN, I_DF, I_DB, I_POOLW, I_POOLS, I_WOUT, I_N2G, I_RGW, I_RGB, I_REW, I_REB, I_WG, I_WU, I_WDN, I_FNG };

struct Frame {
    LAS unsigned char* lds; int tid, lane, wave, G, bx, vcu;
    const float* const* in; float* out; unsigned char* ws;
};
__device__ __forceinline__ bf16_t* xb_row(const Frame& F, int row) { return (bf16_t*)(F.ws + WS_XB) + (size_t)row * D; }
__device__ __forceinline__ bf16_t* hbuf(const Frame& F) { return (bf16_t*)F.out; }
__device__ __forceinline__ const float* mod_ptr(const Frame& F, int l, int b, int which) { return (const float*)(F.ws + WS_MOD) + ((size_t)(l * 17 + b) * 6 + which) * D; }

__device__ __forceinline__ void tr_item(const float* colp, size_t ldw, int k0, bf16_t* WT, int K, int n0, LAS float* scr, int lane) {
    { float v[32];
#pragma unroll
        for (int i = 0; i < 32; ++i) v[i] = colp[(size_t)(k0 + 2 * i + (lane >> 5)) * ldw];
#pragma unroll
        for (int i = 0; i < 32; ++i) scr[(2 * i + (lane >> 5)) * 33 + (lane & 31)] = v[i]; }
    asm volatile("s_waitcnt lgkmcnt(0)" ::: "memory");
    const int c = lane & 7;
#pragma unroll
    for (int j = 0; j < 4; ++j) { const int n = (lane >> 3) + 8 * j; const LAS float* s = scr + (8 * c) * 33 + n;
        u32x4 o; o.x = pk2(s[0 * 33], s[1 * 33]); o.y = pk2(s[2 * 33], s[3 * 33]); o.z = pk2(s[4 * 33], s[5 * 33]); o.w = pk2(s[6 * 33], s[7 * 33]);
        *(u32x4*)(WT + (size_t)(n0 + n) * K + k0 + 8 * c) = o; }
    asm volatile("s_waitcnt lgkmcnt(0)" ::: "memory");
}
constexpr float WGU_SCALE = 64.0f, WD_SCALE = 32.0f;
__device__ __forceinline__ void tr_item8(const float* colp, size_t ldw, int k0, unsigned char* WT, int K, int n0, LAS float* scr, int lane, float qs) {
    { float v[32];
#pragma unroll
        for (int i = 0; i < 32; ++i) v[i] = colp[(size_t)(k0 + 2 * i + (lane >> 5)) * ldw];
#pragma unroll
        for (int i = 0; i < 32; ++i) scr[(2 * i + (lane >> 5)) * 33 + (lane & 31)] = v[i] * qs; }
    asm volatile("s_waitcnt lgkmcnt(0)" ::: "memory");
    const int c = lane & 7;
#pragma unroll
    for (int j = 0; j < 4; ++j) { const int n = (lane >> 3) + 8 * j; const LAS float* s = scr + (8 * c) * 33 + n;
        u32x2 o; o.x = pg8::pk4_fp8(s[0 * 33], s[1 * 33], s[2 * 33], s[3 * 33]); o.y = pg8::pk4_fp8(s[4 * 33], s[5 * 33], s[6 * 33], s[7 * 33]);
        *(u32x2*)(WT + (size_t)(n0 + n) * K + k0 + 8 * c) = o; }
    asm volatile("s_waitcnt lgkmcnt(0)" ::: "memory");
}
__device__ __forceinline__ void fold_item(const float* win, const float* pw, const float* ps, int k0, bf16_t* WT, int n0, LAS float* scr, int lane) {
    const int n = n0 + (lane & 31), g = n >> 7, nn = n & 127;
    const float* pwc = pw + (size_t)g * 128 * 128 + nn; const float sc = ps[n];
    float acc[32];
#pragma unroll
    for (int i = 0; i < 32; ++i) acc[i] = 0.f;
    for (int hc = 0; hc < 8; ++hc) {
        float pc[16];
#pragma unroll
        for (int c = 0; c < 16; ++c) pc[c] = pwc[(size_t)(hc * 16 + c) * 128];
#pragma unroll
        for (int i = 0; i < 32; ++i) { const f32x4* wr = (const f32x4*)(win + (size_t)(k0 + 2 * i + (lane >> 5)) * NP + 2048 + g * 128 + hc * 16);
            float a = acc[i];
#pragma unroll
            for (int c4 = 0; c4 < 4; ++c4) { const f32x4 w = wr[c4]; a += w[0] * pc[4 * c4] + w[1] * pc[4 * c4 + 1] + w[2] * pc[4 * c4 + 2] + w[3] * pc[4 * c4 + 3]; }
            acc[i] = a; }
    }
#pragma unroll
    for (int i = 0; i < 32; ++i) scr[(2 * i + (lane >> 5)) * 33 + (lane & 31)] = acc[i] * sc;
    asm volatile("s_waitcnt lgkmcnt(0)" ::: "memory");
    const int c = lane & 7;
#pragma unroll
    for (int j = 0; j < 4; ++j) { const int nl = (lane >> 3) + 8 * j; const LAS float* s = scr + (8 * c) * 33 + nl;
        u32x4 o; o.x = pk2(s[0 * 33], s[1 * 33]); o.y = pk2(s[2 * 33], s[3 * 33]); o.z = pk2(s[4 * 33], s[5 * 33]); o.w = pk2(s[6 * 33], s[7 * 33]);
        *(u32x4*)(WT + (size_t)(2048 + n0 + nl) * D + k0 + 8 * c) = o; }
    asm volatile("s_waitcnt lgkmcnt(0)" ::: "memory");
}
__device__ __forceinline__ void p0_prologue(const Frame& F, int qsel) {
    for (int task = F.bx; task < 2 * 96; task += F.G) {
        const int l = task / 96, cg = task % 96;
        LAS float* sc = (LAS float*)F.lds;
        LAS float* part = (LAS float*)(F.lds + 17 * 1024 * 4);
        { float cv[34];
#pragma unroll
          for (int q = 0; q < 34; ++q) { const int i = F.tid + 512 * q, b = i >> 10, k = i & 1023; cv[q] = b < 16 ? F.in[I_C][b * D + k] : F.in[I_CCTX][k]; }
#pragma unroll
          for (int q = 0; q < 34; ++q) sc[F.tid + 512 * q] = silu_f(cv[q]); }
        __syncthreads();
        float acc[17];
#pragma unroll
        for (int b = 0; b < 17; ++b) acc[b] = 0.f;
        const float* aw = F.in[I_ADAW] + (size_t)l * D * 6 * D + cg * 64 + F.lane;
        for (int k0 = F.wave * 128; k0 < F.wave * 128 + 128; k0 += 16) { float w[16];
#pragma unroll
            for (int u = 0; u < 16; ++u) w[u] = aw[(size_t)(k0 + u) * 6 * D];
#pragma unroll
            for (int u = 0; u < 16; ++u) {
#pragma unroll
                for (int b = 0; b < 17; ++b) acc[b] += sc[b * 1024 + k0 + u] * w[u]; } }
#pragma unroll
        for (int b = 0; b < 17; ++b) part[(F.wave * 17 + b) * 64 + F.lane] = acc[b];
        __syncthreads();
        for (int i = F.tid; i < 17 * 64; i += 512) { const int b = i >> 6, n = i & 63; float s = F.in[I_ADAB][l * 6 * D + cg * 64 + n];
#pragma unroll
            for (int w = 0; w < 8; ++w) s += part[(w * 17 + b) * 64 + n];
            const int col = cg * 64 + n; ((float*)(F.ws + WS_MOD))[((size_t)(l * 17 + b) * 6 + (col >> 10)) * D + (col & 1023)] = s; }
        __syncthreads();
    }
    if (F.bx >= F.G - 3 && F.bx < F.G - 1) { const int l = F.G - 2 - F.bx; unsigned char* img = F.ws + WS_RIMG + (size_t)l * RW_EX;
        const float* rg = F.in[I_RGW] + (size_t)l * D * 4; const float* re = F.in[I_REW] + (size_t)l * D * NE;
        for (int i0 = F.tid; i0 < 1024 * 36; i0 += 512 * 8) { float w[8];
#pragma unroll
            for (int q = 0; q < 8; ++q) { const int i = i0 + 512 * q, k = i / 36, n = i % 36; w[q] = n < 4 ? rg[k * 4 + n] : re[k * NE + (n - 4)]; }
#pragma unroll
            for (int q = 0; q < 8; ++q) { const int i = i0 + 512 * q, k = i / 36, n = i % 36; const unsigned hi = f2bf(w[q]), lo = f2bf(w[q] - bflo(hi));
                *(bf16_t*)(img + n * RW_PITCH + k * 2) = (bf16_t)hi; *(bf16_t*)(img + RW_LO + n * RW_PITCH + k * 2) = (bf16_t)lo; } }
        for (int i = F.tid; i < 2 * 36 * 8; i += 512) { const int r = i >> 3; *(bf16_t*)(img + r * RW_PITCH + 2048 + (i & 7) * 2) = 0; }
    }
    if (F.bx == F.G - 1) {
        float* rc = (float*)(F.ws + WS_ROPE); float* rs = rc + 96 * 32;
        for (int i = F.tid; i < 96 * 32; i += 512) { const int p = i >> 5, f = i & 31; const int pos = p < 32 ? p : p - 32;
            const float inv = powf(10000.0f, -(float)f / 32.0f); const float ang = (float)pos * inv; rc[i] = cosf(ang); rs[i] = sinf(ang); }
    }
    LAS float* scr = (LAS float*)(F.lds + F.wave * 8448);
    constexpr int IT_WIN = 16 * 80, IT_WOUT = 16 * 32, IT_GU = 16 * 32, IT_DN = 8 * 32;
    constexpr int N_WIN = DEPTH * IT_WIN, N_WOUT = DEPTH * IT_WOUT, N_GU = DEPTH * NE * IT_GU, N_DN = DEPTH * NE * IT_DN;
    unsigned* qhead = (unsigned*)(F.ws + WS_CTL) + CW_QUEUE + 16 * qsel;
    constexpr int N_ALL = N_WIN + N_WOUT + N_GU + N_DN, QB = 16, NBATCH = N_ALL / QB;
    static_assert(N_ALL % QB == 0, "queue batches");
    for (;;) {
        int bq = 0; if (F.lane == 0) bq = (int)__hip_atomic_fetch_add(qhead, 1u, __ATOMIC_RELAXED, __HIP_MEMORY_SCOPE_AGENT);
        bq = __builtin_amdgcn_readfirstlane(bq);
        if (bq >= NBATCH) break;
      for (int qi = 0; qi < QB; ++qi) {
        int r = bq + qi * NBATCH;
        if (r < N_WIN) { const int l = r / IT_WIN; r %= IT_WIN; const int kb = r & 15, nb = 79 - (r >> 4), n0 = nb * 32;
            const float* win = F.in[I_WIN] + (size_t)l * D * NP; bf16_t* WT = (bf16_t*)(F.ws + WS_WIN) + (size_t)l * NP * D;
            if (n0 >= 2048) { fold_item(win, F.in[I_POOLW] + (size_t)l * 4 * 128 * 128, F.in[I_POOLS] + l * 512, kb * 64, WT, n0 - 2048, scr, F.lane); continue; }
            const int n = n0 + (F.lane & 31); int src = n;
            if (n < 1024) { const int hh = n >> 7, j = n & 127, sec = j >> 6, jj = j & 63; src = (n & 512) + (hh & 3) * 128 + sec * 64 + (jj & 1) * 32 + (jj >> 1); }
            tr_item(win + src, NP, kb * 64, WT, D, n0, scr, F.lane); continue; }
        r -= N_WIN;
        if (r < N_WOUT) { const int l = r / IT_WOUT; r %= IT_WOUT; const int kb = r / 32, nb = r % 32, n0 = nb * 32;
            tr_item(F.in[I_WOUT] + (size_t)l * D * D + n0 + (F.lane & 31), D, kb * 64, (bf16_t*)(F.ws + WS_WOUT) + (size_t)l * D * D, D, n0, scr, F.lane); continue; }
        r -= N_WOUT;
        if (r < N_GU) { const int le = r / IT_GU; r %= IT_GU; const int kb = r / 32, nb = r % 32, n0 = nb * 32;
            const int n = n0 + (F.lane & 31), col = (n >> 8) * 128 + (n & 127); const float* src = ((n & 128) ? F.in[I_WU] : F.in[I_WG]) + (size_t)le * D * FF + col;
            tr_item8(src, FF, kb * 64, (unsigned char*)(F.ws + WS_WGU) + (size_t)le * 1024 * D, D, n0, scr, F.lane, WGU_SCALE); continue; }
        r -= N_GU;
        { const int le = r / IT_DN; r %= IT_DN; const int kb = r / 32, nb = r % 32, n0 = nb * 32;
            tr_item8(F.in[I_WDN] + (size_t)le * FF * D + n0 + (F.lane & 31), D, kb * 64, (unsigned char*)(F.ws + WS_WD) + (size_t)le * D * FF, FF, n0, scr, F.lane, WD_SCALE); }
      }
    }
}

__device__ __forceinline__ LAS int* build_tb(const Frame& F, int l) {
    LAS int* tb = (LAS int*)(F.lds + MISC_OFF + 64);
    if (F.tid < 64) {
        const unsigned* cnt = (const unsigned*)(F.ws + WS_CTL) + CW_CNT + l * NE * 16;
        const int e = F.tid & 31; const int c = (int)__hip_atomic_load(cnt + e * 16, __ATOMIC_RELAXED, __HIP_MEMORY_SCOPE_AGENT);
        const int t = (c + 255) >> 8; int incl = t;
#pragma unroll
        for (int o = 1; o < 32; o <<= 1) { const int v = __shfl_up(incl, o, 32); if (e >= o) incl += v; }
        if (F.tid < 32) { tb[e] = incl - t; tb[64 + e] = c; if (e == 31) tb[NE] = incl; }
    }
    __syncthreads();
    return tb;
}

__device__ __forceinline__ void row_op_a(const Frame& F, int mode, bool dry) {
    const int gw = F.vcu * 8 + F.wave, NGW = F.G * 8;
    const int nrows = (mode == 2) ? NLAT : NTOK; const int l = (mode == 0) ? 0 : 1, lp = mode - 1;
    const LAS int* tb = nullptr; if (mode != 0) tb = build_tb(F, lp);
    const bf16_t* YB = (const bf16_t*)(F.ws + WS_P); bf16_t* H = hbuf(F);
    const float* gain = (mode == 2) ? F.in[I_FNG] : F.in[I_N1G] + l * D;
    int4 ti1 = make_int4(0, 0, 0, 0), ti2 = ti1; f32x2 tw0 = (f32x2){0.f, 0.f}, tw1 = tw0, tw2 = tw0;
    f32x4 xf[4]; u32x2 xq[4], ya[4], yc[4];
#define ROWA_INFO(r_, ti_, tw_) do { if (mode != 0 && (r_) < nrows) { ti_ = *(const int4*)(F.ws + WS_TOKINFO + (size_t)(r_) * 32); tw_ = *(const f32x2*)(F.ws + WS_TOKINFO + (size_t)(r_) * 32 + 16); } } while (0)
#define ROWA_DATA(r_, ti_) do { if ((r_) < nrows) { if (mode == 0) { const f32x4* src = (const f32x4*)((r_) < NLAT ? F.in[I_X] + (size_t)(r_) * D : F.in[I_CTX] + (size_t)((r_) - NLAT) * D) + F.lane; \
            _Pragma("unroll") for (int j = 0; j < 4; ++j) xf[j] = src[64 * j]; } \
        else { const size_t s1 = (size_t)(tb[ti_.x] * 256 + ti_.y), s2 = (size_t)(tb[ti_.z] * 256 + ti_.w); const u32x2* xr_ = (const u32x2*)xb_row(F, (r_)) + F.lane; \
            const u32x2* y1 = (const u32x2*)(YB + s1 * D) + F.lane; const u32x2* y2 = (const u32x2*)(YB + s2 * D) + F.lane; \
            _Pragma("unroll") for (int j = 0; j < 4; ++j) { xq[j] = xr_[64 * j]; ya[j] = y1[64 * j]; yc[j] = y2[64 * j]; } } } } while (0)
    ROWA_INFO(gw, ti1, tw1); ROWA_INFO(gw + NGW, ti2, tw2);
    ROWA_DATA(gw, ti1); tw0 = tw1; ti1 = ti2; tw1 = tw2;
    for (int row = gw; row < nrows; row += NGW) {
        const int b = row < NLAT ? (row >> 11) : 16;
        ROWA_INFO(row + 2 * NGW, ti2, tw2);
        f32x4 v[4];
        if (mode == 0) {
#pragma unroll
            for (int j = 0; j < 4; ++j) v[j] = xf[j];
        } else {
            const f32x4* g2 = (const f32x4*)mod_ptr(F, lp, b, 5) + F.lane;
#pragma unroll
            for (int j = 0; j < 4; ++j) { const u32x2 xw = xq[j]; const f32x4 x = (f32x4){bflo(xw.x), bfhi(xw.x), bflo(xw.y), bfhi(xw.y)};
                const u32x2 a = ya[j], c = yc[j]; const f32x4 g = g2[64 * j];
                f32x4 y; y[0] = tw0.x * bflo(a.x) + tw0.y * bflo(c.x); y[1] = tw0.x * bfhi(a.x) + tw0.y * bfhi(c.x); y[2] = tw0.x * bflo(a.y) + tw0.y * bflo(c.y); y[3] = tw0.x * bfhi(a.y) + tw0.y * bfhi(c.y);
                v[j] = x + g * y; }
        }
        ROWA_DATA(row + NGW, ti1);
        if (mode == 1 && !dry) { u32x2* xr = (u32x2*)xb_row(F, row) + F.lane;
#pragma unroll
            for (int j = 0; j < 4; ++j) { u32x2 w; w.x = pk2(v[j][0], v[j][1]); w.y = pk2(v[j][2], v[j][3]); xr[64 * j] = w; } }
        float ss = 0.f;
#pragma unroll
        for (int j = 0; j < 4; ++j) ss += (v[j][0] * v[j][0] + v[j][1] * v[j][1]) + (v[j][2] * v[j][2] + v[j][3] * v[j][3]);
        const float rstd = 1.0f / sqrtf(wave_sum(ss) * (1.0f / D) + EPS);
        if (mode == 2) {
#pragma unroll
            for (int j = 0; j < 4; ++j) { const f32x4 g = ((const f32x4*)gain)[F.lane + 64 * j]; ((f32x4*)((dry ? (float*)(F.ws + WS_WGU) : F.out) + (size_t)row * D))[F.lane + 64 * j] = v[j] * rstd * g; }
        } else {
            const f32x4* sh = (const f32x4*)mod_ptr(F, l, b, 0) + F.lane; const f32x4* sc = (const f32x4*)mod_ptr(F, l, b, 1) + F.lane;
            u32x2* o = (u32x2*)(H + (size_t)row * D) + F.lane;
#pragma unroll
            for (int j = 0; j < 4; ++j) { const f32x4 g = ((const f32x4*)gain)[F.lane + 64 * j]; const f32x4 h = v[j] * rstd * g * (sc[64 * j] + 1.0f) + sh[64 * j];
                u32x2 w; w.x = pk2(h[0], h[1]); w.y = pk2(h[2], h[3]); o[64 * j] = w; }
        }
        tw0 = tw1; ti1 = ti2; tw1 = tw2;
    }
#undef ROWA_INFO
#undef ROWA_DATA
}

template <bool DRY> __device__ __forceinline__ void route_row(const Frame& F, int l, int row, const float (&s)[36], unsigned* cnt, int* list) {
    float gl[4];
#pragma unroll
    for (int i = 0; i < 4; ++i) gl[i] = s[i];
    int gt = 0; float gm = gl[0];
#pragma unroll
    for (int i = 1; i < 4; ++i) if (gl[i] > gm) { gm = gl[i]; gt = i; }
    float gs = 0.f;
#pragma unroll
    for (int i = 0; i < 4; ++i) gs += expf(gl[i] - gm);
    const float gwt = 1.0f / gs;
    float el[8];
#pragma unroll
    for (int j = 0; j < 8; ++j) el[j] = gt == 0 ? s[4 + j] : gt == 1 ? s[12 + j] : gt == 2 ? s[20 + j] : s[28 + j];
    int i1 = 0; float v1 = el[0];
#pragma unroll
    for (int j = 1; j < 8; ++j) if (el[j] > v1) { v1 = el[j]; i1 = j; }
    int i2 = -1; float v2 = -3.0e38f;
#pragma unroll
    for (int j = 0; j < 8; ++j) if (j != i1 && el[j] > v2) { v2 = el[j]; i2 = j; }
    const float e2 = expf(v2 - v1); const float w1 = gwt / (1.0f + e2), w2 = gwt * e2 / (1.0f + e2);
    if (!DRY) {
        const int x1 = gt * 8 + i1, x2 = gt * 8 + i2;
        const int r1 = (int)__hip_atomic_fetch_add(cnt + x1 * 16, 1u, __ATOMIC_RELAXED, __HIP_MEMORY_SCOPE_AGENT);
        const int r2 = (int)__hip_atomic_fetch_add(cnt + x2 * 16, 1u, __ATOMIC_RELAXED, __HIP_MEMORY_SCOPE_AGENT);
        list[(size_t)x1 * NTOK + r1] = row; list[(size_t)x2 * NTOK + r2] = row;
        *(int4*)(F.ws + WS_TOKINFO + (size_t)row * 32) = make_int4(x1, r1, x2, r2); *(f32x2*)(F.ws + WS_TOKINFO + (size_t)row * 32 + 16) = (f32x2){w1, w2};
    }
}
template <bool DRY> __device__ __forceinline__ void row_op_b(const Frame& F, int l) {
    const int gw = F.vcu * 8 + F.wave, NGW = F.G * 8;
    const int ngroups = ((l == 0) ? NTOK : NLAT) / 16;
    { const u32x4* img = (const u32x4*)(F.ws + WS_RIMG + (size_t)l * RW_EX);
      u32x4 t[19];
#pragma unroll
      for (int q = 0; q < 19; ++q) { const int i = F.tid + 512 * q; t[q] = img[i < RW_EX / 16 ? i : 0]; }
#pragma unroll
      for (int q = 0; q < 19; ++q) { const int i = F.tid + 512 * q; if (i < RW_EX / 16) *(LAS u32x4*)(F.lds + i * 16) = t[q]; } }
    __syncthreads();
    bf16_t* H = hbuf(F);
    const float* gain = F.in[I_N2G] + l * D;
    unsigned* cnt = (unsigned*)(F.ws + WS_CTL) + CW_CNT + l * NE * 16;
    int* list = (int*)(F.ws + WS_LIST);
    const int fr = F.lane & 15, fq = F.lane >> 4;
    unsigned bo[3];
#pragma unroll
    for (int nt = 0; nt < 3; ++nt) { const int n = 16 * nt + fr; bo[nt] = (unsigned)((n < 36 ? n : 35) * RW_PITCH + fq * 16); }
    LAS float* ex = (LAS float*)(F.lds + RW_EX + F.wave * 1152);
    float rbias[36];
#pragma unroll
    for (int n = 0; n < 36; ++n) rbias[n] = n < 4 ? F.in[I_RGB][l * 4 + n] : F.in[I_REB][l * NE + (n - 4)];
    for (int gi = gw; gi < ngroups; gi += NGW) {
        const int row = gi * 16 + fr, b = row < NLAT ? (row >> 11) : 16;
        const bf16_t* xr = xb_row(F, row) + fq * 8;
        float ss;
        { const f32x4* sp = (const f32x4*)((const float*)(F.ws + WS_SSQ) + (size_t)row * 16); const f32x4 p0 = sp[0], p1 = sp[1], p2 = sp[2], p3 = sp[3];
          ss = ((p0[0] + p0[1]) + (p0[2] + p0[3])) + ((p1[0] + p1[1]) + (p1[2] + p1[3])) + ((p2[0] + p2[1]) + (p2[2] + p2[3])) + ((p3[0] + p3[1]) + (p3[2] + p3[3])); }
        const float rstd = 1.0f / sqrtf(ss * (1.0f / D) + EPS);
        const float* shp = mod_ptr(F, l, b, 3) + fq * 8; const float* scp = mod_ptr(F, l, b, 4) + fq * 8; const float* gp = gain + fq * 8;
        unsigned char* hp = (unsigned char*)H + (size_t)row * D + fq * 8;
        f32x4 acc[3];
#pragma unroll
        for (int nt = 0; nt < 3; ++nt) acc[nt] = (f32x4){0.f, 0.f, 0.f, 0.f};
#pragma unroll 2
        for (int s = 0; s < 32; ++s) {
            const u32x4 xw = *(const u32x4*)(xr + 32 * s);
            const f32x4 x0 = (f32x4){bflo(xw.x), bfhi(xw.x), bflo(xw.y), bfhi(xw.y)}, x1 = (f32x4){bflo(xw.z), bfhi(xw.z), bflo(xw.w), bfhi(xw.w)};
            const f32x4 g0 = *(const f32x4*)(gp + 32 * s), g1 = *(const f32x4*)(gp + 32 * s + 4);
            const f32x4 c0 = *(const f32x4*)(scp + 32 * s), c1 = *(const f32x4*)(scp + 32 * s + 4);
            const f32x4 s0 = *(const f32x4*)(shp + 32 * s), s1 = *(const f32x4*)(shp + 32 * s + 4);
            const f32x4 h0 = x0 * rstd * g0 * (c0 + 1.0f) + s0, h1 = x1 * rstd * g1 * (c1 + 1.0f) + s1;
            u32x4 hi, lo;
            hi.x = pk2(h0[0], h0[1]); hi.y = pk2(h0[2], h0[3]); hi.z = pk2(h1[0], h1[1]); hi.w = pk2(h1[2], h1[3]);
            lo.x = pk2(h0[0] - bflo(hi.x), h0[1] - bfhi(hi.x)); lo.y = pk2(h0[2] - bflo(hi.y), h0[3] - bfhi(hi.y));
            lo.z = pk2(h1[0] - bflo(hi.z), h1[1] - bfhi(hi.z)); lo.w = pk2(h1[2] - bflo(hi.w), h1[3] - bfhi(hi.w));
            { u32x2 h8; h8.x = pg8::pk4_fp8(h0[0], h0[1], h0[2], h0[3]); h8.y = pg8::pk4_fp8(h1[0], h1[1], h1[2], h1[3]); *(u32x2*)(hp + 32 * s) = h8; }
            const bf16x8 ah = __builtin_bit_cast(bf16x8, hi), al = __builtin_bit_cast(bf16x8, lo);
#pragma unroll
            for (int nt = 0; nt < 3; ++nt) {
                const bf16x8 bh = *(const LAS bf16x8*)(F.lds + bo[nt] + s * 64), bl = *(const LAS bf16x8*)(F.lds + RW_LO + bo[nt] + s * 64);
                acc[nt] = __builtin_amdgcn_mfma_f32_16x16x32_bf16(ah, bh, acc[nt], 0, 0, 0);
                acc[nt] = __builtin_amdgcn_mfma_f32_16x16x32_bf16(ah, bl, acc[nt], 0, 0, 0);
                acc[nt] = __builtin_amdgcn_mfma_f32_16x16x32_bf16(al, bh, acc[nt], 0, 0, 0);
            }
        }
#pragma unroll
        for (int hf = 0; hf < 2; ++hf) {
            if ((fq >> 1) == hf) {
#pragma unroll
                for (int nt = 0; nt < 3; ++nt) { const int n = 16 * nt + fr;
                    if (n < 36) {
#pragma unroll
                        for (int r = 0; r < 4; ++r) ex[((fq & 1) * 4 + r) * 36 + n] = acc[nt][r]; } }
            }
            asm volatile("s_waitcnt lgkmcnt(0)" ::: "memory");
            if (F.lane < 8) { float sl[36];
#pragma unroll
                for (int n = 0; n < 36; ++n) sl[n] = ex[F.lane * 36 + n] + rbias[n];
                route_row<DRY>(F, l, gi * 16 + hf * 8 + F.lane, sl, cnt, list); }
            asm volatile("s_waitcnt lgkmcnt(0)" ::: "memory");
        }
    }
    __syncthreads();
}

__device__ __forceinline__ unsigned off_b(unsigned row, unsigned ch) { return 256u * row + 16u * (ch ^ (((row & 3) << 2) | ((row >> 2) & 3))); }
__device__ __forceinline__ unsigned tr_base_p(unsigned lane) { const unsigned g = lane >> 4, q = (lane & 15) >> 2, p = lane & 3; return off_b(4 * g + q, (p >> 1)) + 8 * (p & 1); }
template <int O0, int O1, int O2, int O3>
__device__ __forceinline__ void tr_frag4(bf16x8 (&f)[4], unsigned a0, unsigned a1, unsigned a2, unsigned a3) {
    s16x4 l0, h0, l1, h1, l2, h2, l3, h3;
    asm volatile("ds_read_b64_tr_b16 %0, %8 offset:%12\n\tds_read_b64_tr_b16 %1, %8 offset:%16\n\t"
                 "ds_read_b64_tr_b16 %2, %9 offset:%13\n\tds_read_b64_tr_b16 %3, %9 offset:%17\n\t"
                 "ds_read_b64_tr_b16 %4, %10 offset:%14\n\tds_read_b64_tr_b16 %5, %10 offset:%18\n\t"
                 "ds_read_b64_tr_b16 %6, %11 offset:%15\n\tds_read_b64_tr_b16 %7, %11 offset:%19\n\ts_waitcnt lgkmcnt(0)"
                 : "=&v"(l0), "=&v"(h0), "=&v"(l1), "=&v"(h1), "=&v"(l2), "=&v"(h2), "=&v"(l3), "=&v"(h3)
                 : "v"(a0), "v"(a1), "v"(a2), "v"(a3), "n"(O0), "n"(O1), "n"(O2), "n"(O3), "n"(O0 + 4096), "n"(O1 + 4096), "n"(O2 + 4096), "n"(O3 + 4096) : "memory");
    f[0] = __builtin_shufflevector(l0, h0, 0, 1, 2, 3, 4, 5, 6, 7); f[1] = __builtin_shufflevector(l1, h1, 0, 1, 2, 3, 4, 5, 6, 7);
    f[2] = __builtin_shufflevector(l2, h2, 0, 1, 2, 3, 4, 5, 6, 7); f[3] = __builtin_shufflevector(l3, h3, 0, 1, 2, 3, 4, 5, 6, 7);
}
template <int O>
__device__ __forceinline__ void tr_frag8(bf16x8 (&f)[8], unsigned a) {
    s16x4 l0, h0, l1, h1, l2, h2, l3, h3, l4, h4, l5, h5, l6, h6, l7, h7;
    const unsigned a1 = a ^ 32u, a2 = a ^ 64u, a3 = a ^ 96u, a4 = a ^ 128u, a5 = a ^ 160u, a6 = a ^ 192u, a7 = a ^ 224u;
    asm volatile("ds_read_b64_tr_b16 %0, %8 offset:%12\n\tds_read_b64_tr_b16 %1, %8 offset:%13\n\t"
                 "ds_read_b64_tr_b16 %2, %9 offset:%12\n\tds_read_b64_tr_b16 %3, %9 offset:%13\n\t"
                 "ds_read_b64_tr_b16 %4, %10 offset:%12\n\tds_read_b64_tr_b16 %5, %10 offset:%13\n\t"
                 "ds_read_b64_tr_b16 %6, %11 offset:%12\n\tds_read_b64_tr_b16 %7, %11 offset:%13"
                 : "=&v"(l0), "=&v"(h0), "=&v"(l1), "=&v"(h1), "=&v"(l2), "=&v"(h2), "=&v"(l3), "=&v"(h3)
                 : "v"(a), "v"(a1), "v"(a2), "v"(a3), "n"(O), "n"(O + 4096) : "memory");
    asm volatile("ds_read_b64_tr_b16 %0, %16 offset:%20\n\tds_read_b64_tr_b16 %1, %16 offset:%21\n\t"
                 "ds_read_b64_tr_b16 %2, %17 offset:%20\n\tds_read_b64_tr_b16 %3, %17 offset:%21\n\t"
                 "ds_read_b64_tr_b16 %4, %18 offset:%20\n\tds_read_b64_tr_b16 %5, %18 offset:%21\n\t"
                 "ds_read_b64_tr_b16 %6, %19 offset:%20\n\tds_read_b64_tr_b16 %7, %19 offset:%21\n\ts_waitcnt lgkmcnt(0)"
                 : "=&v"(l4), "=&v"(h4), "=&v"(l5), "=&v"(h5), "=&v"(l6), "=&v"(h6), "=&v"(l7), "=&v"(h7),
                   "+v"(l0), "+v"(h0), "+v"(l1), "+v"(h1), "+v"(l2), "+v"(h2), "+v"(l3), "+v"(h3)
                 : "v"(a4), "v"(a5), "v"(a6), "v"(a7), "n"(O), "n"(O + 4096) : "memory");
    f[0] = __builtin_shufflevector(l0, h0, 0, 1, 2, 3, 4, 5, 6, 7); f[1] = __builtin_shufflevector(l1, h1, 0, 1, 2, 3, 4, 5, 6, 7);
    f[2] = __builtin_shufflevector(l2, h2, 0, 1, 2, 3, 4, 5, 6, 7); f[3] = __builtin_shufflevector(l3, h3, 0, 1, 2, 3, 4, 5, 6, 7);
    f[4] = __builtin_shufflevector(l4, h4, 0, 1, 2, 3, 4, 5, 6, 7); f[5] = __builtin_shufflevector(l5, h5, 0, 1, 2, 3, 4, 5, 6, 7);
    f[6] = __builtin_shufflevector(l6, h6, 0, 1, 2, 3, 4, 5, 6, 7); f[7] = __builtin_shufflevector(l7, h7, 0, 1, 2, 3, 4, 5, 6, 7);
}
#define LBAR() do { asm volatile("s_waitcnt lgkmcnt(0)" ::: "memory"); __builtin_amdgcn_s_barrier(); asm volatile("" ::: "memory"); } while (0)
__device__ __forceinline__ int chunk_row0(int b, int ci) { return ci < 2 ? NLAT + b * CT + ci * 128 : b * TL + (ci - 2) * 128; }
__device__ __forceinline__ float log2_gamma(float decay) { return -log1pf(expf(-decay)) * 1.4426950408889634f; }

template <int HALF>
__device__ __forceinline__ void pool_item(const LAS unsigned char* tile, bf16_t* A2, int t0, int T, int rbase, int rl, int cg) {
    const int t = t0 + rl; int cnt = 0;
    float s[8];
#pragma unroll
    for (int i = 0; i < 8; ++i) s[i] = 0.f;
    u32x4 c = (u32x4){0u, 0u, 0u, 0u};
#pragma unroll
    for (int w = 0; w < 2 * HALF; ++w) { const int tt = t - HALF + w; const bool ok = tt >= 0 && tt < T;
        u32x4 x = *(const LAS u32x4*)(tile + (rl + 8 - HALF + w) * 1024 + cg * 16); if (!ok) x = (u32x4){0u, 0u, 0u, 0u}; cnt += ok ? 1 : 0; if (w == HALF) c = x;
        s[0] += bflo(x.x); s[1] += bfhi(x.x); s[2] += bflo(x.y); s[3] += bfhi(x.y); s[4] += bflo(x.z); s[5] += bfhi(x.z); s[6] += bflo(x.w); s[7] += bfhi(x.w); }
    const float inv = 1.0f / (float)cnt;
    u32x4 o; o.x = pk2(s[0] * inv - bflo(c.x), s[1] * inv - bfhi(c.x)); o.y = pk2(s[2] * inv - bflo(c.y), s[3] * inv - bfhi(c.y));
    o.z = pk2(s[4] * inv - bflo(c.z), s[5] * inv - bfhi(c.z)); o.w = pk2(s[6] * inv - bflo(c.w), s[7] * inv - bfhi(c.w));
    *(u32x4*)(A2 + (size_t)(rbase + t) * D + 512 + cg * 8) = o;
}

__device__ __forceinline__ void p3a_states_pool(const Frame& F, int l) {
    const bf16_t* P = (const bf16_t*)(F.ws + WS_P);
    bf16_t* ST = (bf16_t*)(F.ws + WS_ACT);
    bf16_t* A2 = hbuf(F);
    const int nstate = (F.G > 128) ? 128 : F.G;
    if (F.bx < nstate) {
        for (int unit = F.bx; unit < 128; unit += nstate) {
            const int dir = unit & 1, bh = unit >> 1, b = bh >> 2, h = bh & 3;
            const float lg2 = log2_gamma((dir ? F.in[I_DB] : F.in[I_DF])[l * NH + h]);
            const float gC = exp2f(lg2 * 128.0f);
            f32x4 acc[8];
#pragma unroll
            for (int dt = 0; dt < 8; ++dt) acc[dt] = (f32x4){0.f, 0.f, 0.f, 0.f};
            u32x4 kr[8], vr[8];
#define P3A_CI(n_) (dir ? ((n_) < 2 ? 1 - (n_) : 19 - (n_)) : (n_))
#define P3A_LOAD(st_) do { _Pragma("unroll") for (int sub = 0; sub < 2; ++sub) { const int r0_ = chunk_row0(b, P3A_CI(2 * (st_) + sub)); \
                _Pragma("unroll") for (int q = 0; q < 4; ++q) { const int p = F.tid + 512 * q, j = p >> 4, ch = p & 15; \
                    kr[sub * 4 + q] = *(const u32x4*)(P + (size_t)(r0_ + j) * NP + 512 + h * 128 + ch * 8); vr[sub * 4 + q] = *(const u32x4*)(P + (size_t)(r0_ + j) * NP + 1024 + h * 128 + ch * 8); } } } while (0)
#define P3A_STORE(n_) do { bf16_t* sp = ST + ((size_t)((bh * 2 + dir) * NCHUNK + P3A_CI(n_)) * 128 + (F.wave * 16 + (F.lane & 15))) * 128 + 4 * (F.lane >> 4); \
                _Pragma("unroll") for (int dt = 0; dt < 8; ++dt) { u32x2 w; w.x = pk2(acc[dt][0], acc[dt][1]); w.y = pk2(acc[dt][2], acc[dt][3]); *(u32x2*)(sp + dt * 16) = w; } } while (0)
#define P3A_KS(KO, VO, ks) do { bf16x8 ka[8]; tr_frag8<(KO) + (ks) * 8192>(ka, tpk); \
                _Pragma("unroll") for (int dt = 0; dt < 8; ++dt) acc[dt] = __builtin_amdgcn_mfma_f32_16x16x32_bf16(ka[dt], vb[ks], acc[dt], 0, 0, 0); } while (0)
#define P3A_SUB(KO, VO) do { _Pragma("unroll") for (int dt = 0; dt < 8; ++dt) acc[dt] *= gC; \
                bf16x8 vb[4]; tr_frag4<(VO), (VO) + 8192, (VO) + 16384, (VO) + 24576>(vb, tpv, tpv, tpv, tpv); \
                P3A_KS(KO, VO, 0); P3A_KS(KO, VO, 1); P3A_KS(KO, VO, 2); P3A_KS(KO, VO, 3); } while (0)
            P3A_LOAD(0);
            for (int st = 0; st < 9; ++st) {
#pragma unroll
                for (int sub = 0; sub < 2; ++sub)
#pragma unroll
                    for (int q = 0; q < 4; ++q) { const int p = F.tid + 512 * q, j = p >> 4, ch = p & 15;
                        const float kd = __builtin_amdgcn_exp2f(lg2 * (float)(dir ? j : 127 - j));
                        const u32x4 kk = kr[sub * 4 + q];
                        u32x4 ks; ks.x = pk2(bflo(kk.x) * kd, bfhi(kk.x) * kd); ks.y = pk2(bflo(kk.y) * kd, bfhi(kk.y) * kd); ks.z = pk2(bflo(kk.z) * kd, bfhi(kk.z) * kd); ks.w = pk2(bflo(kk.w) * kd, bfhi(kk.w) * kd);
                        *(LAS u32x4*)(F.lds + sub * 32768 + off_b(j, ch)) = ks; *(LAS u32x4*)(F.lds + 65536 + sub * 32768 + off_b(j, ch)) = vr[sub * 4 + q]; }
                LBAR();
                if (st < 8) P3A_LOAD(st + 1);
                const unsigned tpk = (unsigned)(size_t)F.lds + tr_base_p(F.lane); const unsigned tpv = (tpk ^ ((unsigned)F.wave << 5)) + 65536u;
                P3A_STORE(2 * st);
                P3A_SUB(0, 0);
                P3A_STORE(2 * st + 1);
                if (st < 8) P3A_SUB(32768, 32768);
                LBAR();
            }
#undef P3A_SUB
#undef P3A_KS
#undef P3A_STORE
#undef P3A_LOAD
#undef P3A_CI
        }
    } else {
        const int pb = F.bx - nstate, npb = F.G - nstate;
        u32x4 ld[10];
#define POOL_LOAD(tile_) do { const int r0_ = (tile_) * 64; int t0_, T_, rb_; if (r0_ < NLAT) { t0_ = r0_ & (TL - 1); T_ = TL; } else { t0_ = (r0_ - NLAT) & (CT - 1); T_ = CT; } rb_ = r0_ - t0_; \
            _Pragma("unroll") for (int q = 0; q < 10; ++q) { const int p = F.tid + 512 * q, rr = p >> 6, ch = p & 63; int tt = t0_ - 8 + rr; tt = tt < 0 ? 0 : (tt >= T_ ? T_ - 1 : tt); \
                ld[q] = *(const u32x4*)(P + (size_t)(rb_ + tt) * NP + 2048 + ch * 8); } } while (0)
        if (pb < 576) POOL_LOAD(pb);
        for (int tile = pb; tile < 576; tile += npb) {
            const int r0 = tile * 64; int t0, T; if (r0 < NLAT) { t0 = r0 & (TL - 1); T = TL; } else { t0 = (r0 - NLAT) & (CT - 1); T = CT; } const int rbase = r0 - t0;
            LBAR();
#pragma unroll
            for (int q = 0; q < 10; ++q) { const int p = F.tid + 512 * q; *(LAS u32x4*)(F.lds + (p >> 6) * 1024 + (p & 63) * 16) = ld[q]; }
            LBAR();
            if (tile + npb < 576) POOL_LOAD(tile + npb);
            for (int wi = F.wave; wi < 64; wi += 8) { const int g = wi & 3, rl = (wi >> 2) * 4 + (F.lane >> 4), cg = g * 16 + (F.lane & 15);
                if (g == 0) pool_item<1>(F.lds, A2, t0, T, rbase, rl, cg); else if (g == 1) pool_item<2>(F.lds, A2, t0, T, rbase, rl, cg);
                else if (g == 2) pool_item<4>(F.lds, A2, t0, T, rbase, rl, cg); else pool_item<8>(F.lds, A2, t0, T, rbase, rl, cg); }
        }
#undef POOL_LOAD
    }
    __syncthreads();
}

__device__ __forceinline__ void p3b_retention(const Frame& F, int l) {
    const bf16_t* P = (const bf16_t*)(F.ws + WS_P);
    const bf16_t* ST = (const bf16_t*)(F.ws + WS_ACT);
    bf16_t* A2 = hbuf(F);
    const int c_lo = (l == DEPTH - 1) ? 2 : 0, ncu = NCHUNK - c_lo, nunits = 64 * ncu;
    u32x4 ld[8], st[8]; bf16x8 qf[4];
#define P3B_LOAD(unit_) do { const int bh_ = (unit_) / ncu, ci_ = c_lo + (unit_) % ncu, h_ = bh_ & 3; const int r0_ = chunk_row0(bh_ >> 2, ci_); \
        _Pragma("unroll") for (int q = 0; q < 4; ++q) { const int p = F.tid + 512 * q, j = p >> 4, ch = p & 15; \
            ld[q] = *(const u32x4*)(P + (size_t)(r0_ + j) * NP + 512 + h_ * 128 + ch * 8); ld[4 + q] = *(const u32x4*)(P + (size_t)(r0_ + j) * NP + 1024 + h_ * 128 + ch * 8); } } while (0)
#define P3B_LOADQ(unit_) do { const int bh_ = (unit_) / ncu, ci_ = c_lo + (unit_) % ncu, h_ = bh_ & 3; const int r0_ = chunk_row0(bh_ >> 2, ci_); \
        _Pragma("unroll") for (int ks = 0; ks < 4; ++ks) qf[ks] = *(const bf16x8*)(P + (size_t)(r0_ + F.wave * 16 + (F.lane & 15)) * NP + h_ * 128 + ks * 32 + (F.lane >> 4) * 8); } while (0)
    if (F.vcu < nunits) { P3B_LOAD(F.vcu); P3B_LOADQ(F.vcu); }
    for (int unit = F.vcu; unit < nunits; unit += F.G) {
        int lane_o = F.lane; asm volatile("" : "+v"(lane_o));
        const int fr = lane_o & 15, fq = lane_o >> 4;
        const unsigned rr0 = off_b((unsigned)fr, (unsigned)fq), tp = (unsigned)(size_t)F.lds + tr_base_p((unsigned)lane_o);
        const int il = F.wave * 16 + fr;
        const int bh = unit / ncu, ci = c_lo + unit % ncu, b = bh >> 2, h = bh & 3;
        const float lgf = log2_gamma(F.in[I_DF][l * NH + h]), lgb = log2_gamma(F.in[I_DB][l * NH + h]);
        const int row0 = chunk_row0(b, ci);
        { const bf16_t* sf = ST + ((size_t)((bh * 2 + 0) * NCHUNK + ci) * 128) * 128; const bf16_t* sb = ST + ((size_t)((bh * 2 + 1) * NCHUNK + ci) * 128) * 128;
#pragma unroll
          for (int q = 0; q < 4; ++q) { const int p = F.tid + 512 * q, j = p >> 4, ch = p & 15; st[q] = *(const u32x4*)(sf + (size_t)j * 128 + ch * 8); st[4 + q] = *(const u32x4*)(sb + (size_t)j * 128 + ch * 8); } }
        LBAR();
#pragma unroll
        for (int q = 0; q < 4; ++q) { const int p = F.tid + 512 * q, j = p >> 4, ch = p & 15; const unsigned o = off_b(j, ch);
            *(LAS u32x4*)(F.lds + o) = ld[q]; *(LAS u32x4*)(F.lds + 32768u + o) = ld[4 + q]; }
        LBAR();
        if (unit + F.G < nunits) P3B_LOAD(unit + F.G);
        u32x2 gg[8];
#pragma unroll
        for (int et = 0; et < 8; ++et) gg[et] = *(const u32x2*)(P + (size_t)(row0 + il) * NP + 1536 + h * 128 + 4 * fq + et * 16);
        bf16x8 pf[4];
#pragma unroll
        for (int ks2 = 0; ks2 < 4; ++ks2) {
            u32x2 half[2];
#pragma unroll
            for (int t = 0; t < 2; ++t) { const int jt = 2 * ks2 + t;
                asm volatile("" ::: "memory");
                f32x4 sa = (f32x4){0.f, 0.f, 0.f, 0.f};
#pragma unroll
                for (int ks = 0; ks < 4; ++ks) { const bf16x8 ka = *(const LAS bf16x8*)(F.lds + ((rr0 ^ ((unsigned)ks << 6)) + 4096u * jt)); sa = __builtin_amdgcn_mfma_f32_16x16x32_bf16(ka, qf[ks], sa, 0, 0, 0); }
                float pv[4];
#pragma unroll
                for (int r = 0; r < 4; ++r) { const int j = 16 * jt + 4 * fq + r, df = il - j;
                    const float w = df > 0 ? __builtin_amdgcn_exp2f(lgf * (float)df) : (df < 0 ? __builtin_amdgcn_exp2f(lgb * (float)(-df)) : 2.0f); pv[r] = sa[r] * w; }
                half[t].x = pk2(pv[0], pv[1]); half[t].y = pk2(pv[2], pv[3]); }
            const u32x4 w4 = (u32x4){half[0].x, half[0].y, half[1].x, half[1].y};
            pf[ks2] = __builtin_bit_cast(bf16x8, w4);
        }
#pragma unroll
        for (int q = 0; q < 4; ++q) { const int p = F.tid + 512 * q, j = p >> 4, ch = p & 15; const unsigned o = off_b(j, ch);
            *(LAS u32x4*)(F.lds + 65536u + o) = st[q]; *(LAS u32x4*)(F.lds + 98304u + o) = st[4 + q]; }
        LBAR();
        const float qdf = __builtin_amdgcn_exp2f(lgf * (float)(il + 1)), qdb = __builtin_amdgcn_exp2f(lgb * (float)(128 - il));
        float o[8][4]; float ss = 0.f;
#pragma unroll
        for (int et = 0; et < 8; ++et) {
            f32x4 ao = (f32x4){0.f, 0.f, 0.f, 0.f}, af = ao, ab = ao;
            bf16x8 va[4]; { const unsigned a = tp ^ ((unsigned)et << 5); tr_frag4<32768, 32768 + 8192, 32768 + 16384, 32768 + 24576>(va, a, a, a, a); }
#pragma unroll
            for (int ks = 0; ks < 4; ++ks) {
                ao = __builtin_amdgcn_mfma_f32_16x16x32_bf16(va[ks], pf[ks], ao, 0, 0, 0);
                const unsigned ra = (rr0 ^ ((unsigned)ks << 6)) + 4096u * et;
                const bf16x8 fa = *(const LAS bf16x8*)(F.lds + 65536u + ra);
                af = __builtin_amdgcn_mfma_f32_16x16x32_bf16(fa, qf[ks], af, 0, 0, 0);
                const bf16x8 ba = *(const LAS bf16x8*)(F.lds + 98304u + ra);
                ab = __builtin_amdgcn_mfma_f32_16x16x32_bf16(ba, qf[ks], ab, 0, 0, 0);
            }
#pragma unroll
            for (int r = 0; r < 4; ++r) { o[et][r] = ao[r] + qdf * af[r] + qdb * ab[r]; ss += o[et][r] * o[et][r]; }
        }
        if (unit + F.G < nunits) P3B_LOADQ(unit + F.G);
        ss += __shfl_xor(ss, 16); ss += __shfl_xor(ss, 32);
        const float rstd = 1.0f / sqrtf(ss * (1.0f / 128.0f) + EPS);
        bf16_t* op = A2 + (size_t)(row0 + il) * D + h * 128 + 4 * fq;
#pragma unroll
        for (int et = 0; et < 8; ++et) { const u32x2 g = gg[et];
            u32x2 w; w.x = pk2(silu_f(bflo(g.x)) * o[et][0] * rstd, silu_f(bfhi(g.x)) * o[et][1] * rstd); w.y = pk2(silu_f(bflo(g.y)) * o[et][2] * rstd, silu_f(bfhi(g.y)) * o[et][3] * rstd);
            *(u32x2*)(op + et * 16) = w; }
    }
#undef P3B_LOAD
#undef P3B_LOADQ
    __syncthreads();
}

#ifndef TYPE_MASK
#define TYPE_MASK 0x3ff
#endif
#define PTYPE(k) ((k) == 0 ? 0 : ((k) == 17 ? 9 : 1 + (((k) - 1) & 7)))
#define ENTER() do { if (PROBE_REPEAT >= 0) __syncthreads(); int _t = threadIdx.x; asm volatile("" : "+v"(_t)); F.tid = _t; F.lane = _t & 63; F.wave = __builtin_amdgcn_readfirstlane(_t >> 6); } while (0)
#define IN(k) (((TYPE_MASK >> PTYPE(k)) & 1) && lo <= (k) && (k) < hi)
#define SEAM(k) do { if (IN(k) && IN((k) + 1)) xcd_barrier(bar); } while (0)
#define REP(t) for (int rep = (PROBE_REPEAT == (t)) ? 0 : 1; rep < 2; ++rep)


template <int l> __device__ __forceinline__ void layer_phases(Frame& F, const XcdBarrier& bar, const int lo, const int hi) {
        const int pb = 1 + 8 * l;
        const bool last = (l == DEPTH - 1);
        const int Mrows = last ? NLAT : NTOK;
        if (IN(pb + 0)) REP(1) { ENTER(); row_op_a(F, l == 0 ? 0 : 1, rep == 0); }
        SEAM(pb + 0);
        if (IN(pb + 1)) REP(2) { ENTER();
            pg8::SchedDense S; S.init(NTOK, NP, D, F.G, F.bx);
            pg8::EpiInProj E{(bf16_t*)(F.ws + WS_P), (const float*)(F.ws + WS_ROPE), (const float*)(F.ws + WS_ROPE) + 96 * 32};
            pg8::gemm_phase<pg8::EpiInProj, pg8::SchedDense, true, true>(F.lds, F.tid, (const char*)hbuf(F), (const char*)(F.ws + WS_WIN) + (size_t)l * NP * D * 2, D, S, E);
        }
        SEAM(pb + 1);
        if (IN(pb + 2)) REP(3) { ENTER(); p3a_states_pool(F, l); }
        SEAM(pb + 2);
        if (IN(pb + 3)) REP(4) { ENTER(); p3b_retention(F, l); }
        SEAM(pb + 3);
        if (IN(pb + 4)) REP(5) { ENTER();
            pg8::SchedDense S; S.init(Mrows, D, D, F.G, F.bx);
            pg8::EpiResid E;
            if (l == 0) { E.rl = F.in[I_X]; E.rc = F.in[I_CTX]; E.rb = nullptr; } else { E.rl = nullptr; E.rc = nullptr; E.rb = (const bf16_t*)(F.ws + WS_XB); }
            E.ob = (rep == 0) ? (bf16_t*)(F.ws + WS_P) : (bf16_t*)(F.ws + WS_XB); E.ssq = (float*)(F.ws + WS_SSQ); E.gmod = mod_ptr(F, l, 0, 2);
            pg8::gemm_phase<pg8::EpiResid, pg8::SchedDense, true, true>(F.lds, F.tid, (const char*)hbuf(F), (const char*)(F.ws + WS_WOUT) + (size_t)l * D * D * 2, D, S, E);
        }
        SEAM(pb + 4);
        if (IN(pb + 5)) REP(6) { ENTER(); if (PROBE_REPEAT == 6 && rep == 0) row_op_b<true>(F, l); else row_op_b<false>(F, l); }
        SEAM(pb + 5);
        if (IN(pb + 6)) REP(7) { ENTER();
            LAS int* tb = build_tb(F, l);
            LAS int* tokt = (LAS int*)(F.lds + TOKT_OFF);
            const int* list = (const int*)(F.ws + WS_LIST);
            pg8::SchedGroup S; S.tb = tb; S.tokt = tokt; S.G = F.G; S.c = F.vcu; S.pitch = D; S.gather = 1;
            { int tokv[8];
#pragma unroll
              for (int i = 0; i < 8; ++i) { pg8::Unit u; tokv[i] = -1;
                  if (S.next(i, u)) { const int g = u.pm; const int e = (int)__popcll(__ballot(F.lane < NE && tb[F.lane + 1] <= g)); const int rt = g - tb[e], cnt = tb[64 + e];
                      if (F.tid < 256) { int r = rt * 256 + F.tid; if (r >= cnt) r = cnt - 1; tokv[i] = list[(size_t)e * NTOK + r]; } } }
#pragma unroll
              for (int i = 0; i < 8; ++i) if (F.tid < 256 && tokv[i] >= 0) tokt[i * 256 + F.tid] = tokv[i]; }
            __syncthreads();
            pg8::EpiSwiGLU8 E{(unsigned char*)(F.ws + WS_ACT), 1.0f / WGU_SCALE};
            pg8::gemm_phase<pg8::EpiSwiGLU8, pg8::SchedGroup, true, true, true>(F.lds, F.tid, (const char*)hbuf(F), (const char*)(F.ws + WS_WGU) + (size_t)l * NE * 1024 * D, D, S, E);
        }
        SEAM(pb + 6);
        if (IN(pb + 7)) REP(8) { ENTER();
            LAS int* tb = build_tb(F, l);
            pg8::SchedGroup S; S.tb = tb; S.tokt = nullptr; S.G = F.G; S.c = F.vcu; S.pitch = FF; S.gather = 0;
            pg8::EpiBf16S E{(bf16_t*)(F.ws + WS_P), D, 1.0f / WD_SCALE};
            pg8::gemm_phase<pg8::EpiBf16S, pg8::SchedGroup, true, true, true>(F.lds, F.tid, (const char*)(F.ws + WS_ACT), (const char*)(F.ws + WS_WD) + (size_t)l * NE * D * FF, FF, S, E);
        }
        SEAM(pb + 7);
}

__global__ void __launch_bounds__(512, 2) fwd_kernel(Args args) {
    extern __shared__ __attribute__((aligned(16))) unsigned char lds_raw[];
    Frame F;
    F.lds = (LAS unsigned char*)lds_raw; F.tid = threadIdx.x; F.lane = F.tid & 63; F.wave = __builtin_amdgcn_readfirstlane(F.tid >> 6);
    F.G = gridDim.x; F.bx = blockIdx.x; F.vcu = (F.G % 8 == 0) ? (F.bx % 8) * (F.G / 8) + F.bx / 8 : F.bx;
    F.in = args.in; F.out = args.out; F.ws = args.ws;
    volatile LAS unsigned* MISC = (volatile LAS unsigned*)(F.lds + MISC_OFF);
    if (F.tid < 4) MISC[F.tid] = 0u;
    __syncthreads();
    unsigned* ctl = (unsigned*)(F.ws + WS_CTL);
    XcdBarrier bar; bar.bar = ctl + CW_BAR; bar.x = 0; bar.st = nullptr;
    const int lo = args.ph_lo, hi = args.ph_hi;
    const bool multi = (hi - lo) > 1;
    if (multi) bar = xcd_barrier_post(ctl + CW_BAR, MISC);
    if (IN(0)) REP(0) { ENTER(); p0_prologue(F, rep); }
    SEAM(0);
    layer_phases<0>(F, bar, lo, hi);
    layer_phases<1>(F, bar, lo, hi);
    if (IN(17)) REP(9) { ENTER(); row_op_a(F, 2, rep == 0); }
#undef IN
#undef SEAM
}

extern "C" void kernel_launch(void* const* d_in, const int* in_sizes, int n_in, void* d_out, int out_size, void* d_ws, size_t ws_size, hipStream_t stream) {
    static int grid = 0;
    if (grid == 0) {
        if (n_in != 22 || out_size != NLAT * D || ws_size < WS_END) { fprintf(stderr, "kernel_launch: unexpected shapes (n_in %d, out %d, ws %zu)\n", n_in, out_size, ws_size); grid = -1; return; }
        int dev = 0, cus = 0, per_cu = 0;
        if (hipGetDevice(&dev) != hipSuccess || hipDeviceGetAttribute(&cus, hipDeviceAttributeMultiprocessorCount, dev) != hipSuccess) { grid = -1; return; }
        if (hipFuncSetAttribute((const void*)fwd_kernel, hipFuncAttributeMaxDynamicSharedMemorySize, LDS_BYTES) != hipSuccess) { fprintf(stderr, "kernel_launch: hipFuncSetAttribute failed\n"); grid = -1; return; }
        if (hipOccupancyMaxActiveBlocksPerMultiprocessor(&per_cu, (const void*)fwd_kernel, 512, LDS_BYTES) != hipSuccess || per_cu < 1) { fprintf(stderr, "kernel_launch: occupancy query says %d\n", per_cu); }
        (void)hipGetLastError();
        grid = cus;
    }
    if (grid < 0) return;
    (void)hipMemsetAsync((char*)d_ws + WS_CTL, 0, CTL_ZERO_BYTES, stream);
    Args a{};
    for (int i = 0; i < 22; ++i) a.in[i] = (const float*)d_in[i];
    a.out = (float*)d_out; a.ws = (unsigned char*)d_ws;
    if (MK_N_LAUNCHES == 1) { a.ph_lo = 0; a.ph_hi = N_PHASES; hipLaunchKernelGGL(fwd_kernel, dim3(grid), dim3(512), LDS_BYTES, stream, a); }
    else { for (int p = 0; p < N_PHASES; ++p) { a.ph_lo = p; a.ph_hi = p + 1; hipLaunchKernelGGL(fwd_kernel, dim3(grid), dim3(512), LDS_BYTES, stream, a); } }
}
```

```cpp
#include <hip/hip_runtime.h>
#include <cstdio>
#include <cstdint>

#ifndef MK_N_LAUNCHES
#define MK_N_LAUNCHES 1
#endif

#ifndef PROBE_REPEAT
#define PROBE_REPEAT -1
#endif
#define LAS __attribute__((address_space(3)))
#define GAS __attribute__((address_space(1)))
typedef unsigned short bf16_t;
typedef short bf16x8 __attribute__((ext_vector_type(8)));
typedef short s16x4 __attribute__((ext_vector_type(4)));
typedef float f32x4 __attribute__((ext_vector_type(4)));
typedef float f32x2 __attribute__((ext_vector_type(2)));
typedef unsigned u32x4 __attribute__((ext_vector_type(4)));
typedef unsigned u32x2 __attribute__((ext_vector_type(2)));

constexpr int Bn = 16, TL = 2048, CT = 256, D = 1024, DEPTH = 2;
constexpr int NLAT = Bn * TL, NCTX = Bn * CT, NTOK = NLAT + NCTX;
constexpr int NP = 2560;
constexpr int NE = 32, FF = 512, NH = 4, HD = 128;
constexpr int NCHUNK = 18;
constexpr float EPS = 1e-6f;
constexpr int MAXTILES = 320;
constexpr int N_PHASES = 18;

constexpr size_t MiB = 1u << 20;
constexpr size_t WS_CTL = 0, CTL_ZERO_BYTES = 1 * MiB;
constexpr size_t WS_MOD = 1 * MiB;
constexpr size_t WS_ROPE = 2 * MiB;
constexpr size_t WS_RIMG = 2 * MiB + 65536;
constexpr size_t WS_TOKINFO = 3 * MiB;
constexpr size_t WS_LIST = 5 * MiB;
constexpr size_t WS_WIN = 10 * MiB;
constexpr size_t WS_WOUT = 20 * MiB;
constexpr size_t WS_WGU = 24 * MiB;
constexpr size_t WS_WD = 152 * MiB;
constexpr size_t WS_SSQ = 216 * MiB;
constexpr size_t WS_XB = 232 * MiB;
constexpr size_t WS_P = 304 * MiB;
constexpr size_t WS_ACT = 484 * MiB;
constexpr size_t WS_END = 564 * MiB;
constexpr int CW_TMO = 0;
constexpr int CW_QUEUE = 512;
constexpr int CW_CNT = 1024;
constexpr int CW_BAR = 4096;

constexpr int RING_BYTES = 131072;
constexpr int TOKT_OFF = RING_BYTES;
constexpr int MISC_OFF = 161792;
constexpr int RW_PITCH = 2064;
constexpr int RW_LO = 36 * RW_PITCH, RW_EX = 2 * 36 * RW_PITCH;
constexpr int LDS_BYTES = 163840;

__device__ __forceinline__ unsigned f2bf(float f) { unsigned u = __builtin_bit_cast(unsigned, f); return (u + 0x7fffu + ((u >> 16) & 1u)) >> 16; }
typedef __bf16 bf16x2_t __attribute__((ext_vector_type(2)));
__device__ __forceinline__ unsigned pk2(float lo, float hi) { const f32x2 f = {lo, hi}; const bf16x2_t v = __builtin_convertvector(f, bf16x2_t); return __builtin_bit_cast(unsigned, v); }
__device__ __forceinline__ float bflo(unsigned w) { return __builtin_bit_cast(float, w << 16); }
__device__ __forceinline__ float bfhi(unsigned w) { return __builtin_bit_cast(float, w & 0xffff0000u); }
__device__ __forceinline__ float wave_sum(float v) {
#pragma unroll
    for (int o = 1; o < 64; o <<= 1) v += __shfl_xor(v, o);
    return v;
}
__device__ __forceinline__ float silu_f(float x) { return x * __builtin_amdgcn_rcpf(1.0f + __builtin_amdgcn_exp2f(-1.4426950408889634f * x)); }

#define XB_TMO      128
#define XB_XCNT(j)  (256  + 64 * (j))
#define XB_XSUB(j)  (1280 + 64 * (j))
#define XB_XGEN(j)  (2304 + 64 * (j))
#define XB_TOP      3328
#define XB_TOPGEN   3392
#define XCD_BAR_WORDS 3456
#define XB_SPIN_CAP (1u << 18)
__device__ __forceinline__ unsigned xb_ld(unsigned* p)              { return __hip_atomic_load(p, __ATOMIC_RELAXED, __HIP_MEMORY_SCOPE_AGENT); }
__device__ __forceinline__ unsigned xb_add(unsigned* p, unsigned v) { return __hip_atomic_fetch_add(p, v, __ATOMIC_RELAXED, __HIP_MEMORY_SCOPE_AGENT); }
__device__ __forceinline__ unsigned xb_xcc_id() { return (unsigned)__builtin_amdgcn_s_getreg((3 << 11) | 20) & 0xFu; }
#define XB_SPIN(cond, bar) do { unsigned _sp = 0; while (cond) { __builtin_amdgcn_s_sleep(1); \
    if ((++_sp & 255u) == 0u) { if (xb_ld(&(bar)[XB_TMO])) break; if (_sp > XB_SPIN_CAP) { atomicAdd(&(bar)[XB_TMO], 1u); break; } } } } while (0)
struct XcdBarrier { unsigned* bar; unsigned x; volatile LAS unsigned* st; };
__device__ __forceinline__ XcdBarrier xcd_barrier_post(unsigned* bar, volatile LAS unsigned* st) {
    XcdBarrier b; b.bar = bar; b.x = xb_xcc_id(); b.st = st;
    if (threadIdx.x == 0) (void)xb_add(&bar[XB_XCNT(b.x)], 1u);
    return b;
}
__device__ __forceinline__ void xcd_barrier_complete(unsigned* bar, unsigned x, unsigned& nloc, unsigned& nx) {
    const unsigned G = gridDim.x * gridDim.y * gridDim.z;
    unsigned sum, cnt, mine, sp = 0u;
    for (;;) {
        sum = 0u; cnt = 0u; mine = 0u;
#pragma unroll
        for (unsigned j = 0; j < 16; ++j) { const unsigned c = xb_ld(&bar[XB_XCNT(j)]); sum += c; cnt += (c > 0u) ? 1u : 0u; mine = (j == x) ? c : mine; }
        if (sum == G) break;
        __builtin_amdgcn_s_sleep(1);
        if ((++sp & 255u) == 0u) { if (xb_ld(&bar[XB_TMO])) break; if (sp > XB_SPIN_CAP) { atomicAdd(&bar[XB_TMO], 1u); break; } }
    }
    nloc = mine > 0u ? mine : 1u; nx = cnt > 0u ? cnt : 1u;
}
__device__ __forceinline__ void xcd_barrier(const XcdBarrier& b) {
    asm volatile("s_waitcnt vmcnt(0)" ::: "memory");
    __syncthreads();
    if (threadIdx.x == 0) {
        unsigned* bar = b.bar;
        __builtin_amdgcn_s_waitcnt(0);
        unsigned nloc = b.st[0], nx = b.st[1];
        if (nloc == 0u) { xcd_barrier_complete(bar, b.x, nloc, nx); b.st[0] = nloc; b.st[1] = nx; }
        const unsigned old = xb_add(&bar[XB_XSUB(b.x)], 1u);
        const unsigned gen = old / nloc;
        if (old + 1u == (gen + 1u) * nloc) {
            __builtin_amdgcn_fence(__ATOMIC_RELEASE, "agent");
            asm volatile("s_waitcnt vmcnt(0)" ::: "memory");
            const unsigned og = xb_add(&bar[XB_TOP], 1u);
            const unsigned tg = og / nx;
            if (og + 1u == (tg + 1u) * nx) xb_add(&bar[XB_TOPGEN], 1u);
            else XB_SPIN(xb_ld(&bar[XB_TOPGEN]) == tg, bar);
            __builtin_amdgcn_fence(__ATOMIC_ACQUIRE, "agent");
            xb_add(&bar[XB_XGEN(b.x)], 1u);
            asm volatile("s_waitcnt vmcnt(0)" ::: "memory");
        } else {
            XB_SPIN(xb_ld(&bar[XB_XGEN(b.x)]) == gen, bar);
            __builtin_amdgcn_fence(__ATOMIC_ACQUIRE, "agent");
            asm volatile("s_waitcnt vmcnt(0)" ::: "memory");
        }
    }
    __syncthreads();
}

namespace pg8 {
constexpr int BM = 256, BK = 64, HALF = 128, HTB = HALF * BK * 2, STAGE_BYTES = 8 * HTB, NXCD = 8, WGM = 8;
__device__ __forceinline__ int lds_byte(int r, int c) { const int st = (r >> 4) * 2 + (c >> 5), rr = r & 15, cc = c & 31, ob = rr * 64 + cc * 2; return st * 1024 + (ob ^ (((ob >> 9) & 1) << 5)); }
__device__ __forceinline__ void stage_rc(int b, int& R, int& C) { const int st = b / 1024, sb = b % 1024, swz = sb ^ (((sb >> 9) & 1) << 5); R = (st >> 1) * 16 + swz / 64; C = (st & 1) * 32 + (swz % 64) / 2; }
__device__ __forceinline__ int perm32(int rho) { const int n = rho >> 4, i = rho & 15; return 8 * (i >> 2) + 4 * n + (i & 3); }

struct Unit { int pm, pn; unsigned bofs; int aux; };

struct SchedDense {
    int nM, nN, nwg, G, c, K;
    __device__ void init(int M, int N, int K_, int G_, int c_) { nM = M / BM; nN = N / BM; nwg = nM * nN; G = G_; c = c_; K = K_; }
    __device__ bool next(int i, Unit& u) const {
        const long L = (long)i * G + c; if (L >= nwg) return false;
        int wgid = (int)L; { const int q = nwg / NXCD, r = nwg % NXCD, xcd = wgid % NXCD, off = wgid / NXCD; wgid = (xcd < r ? xcd * (q + 1) : r * (q + 1) + (xcd - r) * q) + off; }
        const int nig = WGM * nN, gid = wgid / nig, fm = gid * WGM, gsz = (nM - fm) < WGM ? (nM - fm) : WGM;
        u.pm = fm + ((wgid % nig) % gsz); u.pn = (wgid % nig) / gsz; u.bofs = (unsigned)u.pn * (unsigned)(BM * K * 2); u.aux = 0; return true;
    }
    __device__ __forceinline__ unsigned a_row(const Unit& u, int r) const { return (unsigned)(u.pm * BM + r); }
};
struct SchedGroup {
    const LAS int* tb; const LAS int* tokt; int G, c, pitch, gather;
    __device__ bool next(int i, Unit& u) const {
        const int L = i * G + c, nt = tb[NE]; if (L >= nt * 4) return false;
        const int g = L >> 2; const int ln = (int)(threadIdx.x & 63u);
        const int e = (int)__popcll(__ballot(ln < NE && tb[ln + 1] <= g));
        u.pm = g; u.pn = L & 3; u.bofs = (unsigned)(e * 1024 + u.pn * BM) * (unsigned)pitch; u.aux = i; return true;
    }
    __device__ __forceinline__ unsigned a_row(const Unit& u, int r) const { return gather ? (unsigned)tokt[u.aux * 256 + r] : (unsigned)(u.pm * BM + r); }
};

__device__ __forceinline__ unsigned cvt_pk_bf16(float lo, float hi) { unsigned r; asm volatile("v_cvt_pk_bf16_f32 %0, %1, %2" : "=v"(r) : "v"(lo), "v"(hi)); return r; }

typedef int i32x4 __attribute__((ext_vector_type(4)));
typedef int i32x8 __attribute__((ext_vector_type(8)));
template <bool F8> struct Frag { bf16x8 k[2]; };
template <> struct Frag<true> { i32x8 v; };
template <class Epi, class Sched, bool ALIGN_EPI, bool SP2, bool F8 = false>
__device__ __forceinline__ void gemm_phase(LAS unsigned char* lds, const int tid, const char* Abase, const char* Bbase, const int K, const Sched& S, const Epi& E) {
    const int wid = __builtin_amdgcn_readfirstlane(tid >> 6), lane = tid & 63, wr = wid >> 2, wc = wid & 3, fr = lane & 15, fq = lane >> 4;
    const int nt = F8 ? K / 128 : K / BK; const unsigned pitch = F8 ? (unsigned)K : 2u * (unsigned)K;
    int Rr[2], Cc[2]; unsigned voffB[2];
#pragma unroll
    for (int i = 0; i < 2; ++i) { int R, C; stage_rc(tid * 16 + i * 8192, R, C); const int Rb = Epi::PERM ? ((R & ~31) + perm32(R & 31)) : R;
        Rr[i] = R; Cc[i] = C; voffB[i] = (unsigned)Rb * pitch + 2u * (unsigned)C; }
    const size_t kstep = (size_t)(BK * 2);
    const size_t hstep = (size_t)HALF * pitch;
    const unsigned ldsw = (unsigned)wid * 1024u;
    const int fcol = F8 ? (fq >> 1) * 32 + (fq & 1) * 16 : fq * 8;
    const int aoff = lds_byte(wr * 64 + fr, fcol), boff = lds_byte(wc * 32 + fr, fcol);
#define PG8_SA(b, h) (((b) * 2 + (h)) * HTB)
#define PG8_SB(b, h) ((4 + (b) * 2 + (h)) * HTB)
#define PG8_STAGE(bufoff, gbase, voff) do { _Pragma("unroll") for (int _i = 0; _i < 2; ++_i) \
        __builtin_amdgcn_global_load_lds((const unsigned*)((const char*)(gbase) + (voff)[_i]), (LAS unsigned*)(lds + (bufoff) + ldsw + _i * 8192), 16, 0, 0); } while (0)
#define PG8_LDF(dstf, off_) do { if constexpr (F8) { const i32x4 _lo = *(const LAS i32x4*)(lds + (off_)), _hi = *(const LAS i32x4*)(lds + (off_) + 16); dstf.v = __builtin_shufflevector(_lo, _hi, 0, 1, 2, 3, 4, 5, 6, 7); } \
        else { dstf.k[0] = *(const LAS bf16x8*)(lds + (off_)); dstf.k[1] = *(const LAS bf16x8*)(lds + (off_) + 1024); } } while (0)
#define PG8_LDA(dst, b, h) do { _Pragma("unroll") for (int m = 0; m < 4; ++m) PG8_LDF(dst[m], PG8_SA(b, h) + aoff + m * 2048); } while (0)
#define PG8_LDB(dst, b, h) do { _Pragma("unroll") for (int n = 0; n < 2; ++n) PG8_LDF(dst[n], PG8_SB(b, h) + boff + n * 2048); } while (0)
#define PG8_MMA(ai, bj, At, Bt) do { __builtin_amdgcn_s_setprio(1); _Pragma("unroll") for (int m = 0; m < 4; ++m) _Pragma("unroll") for (int n = 0; n < 2; ++n) { \
        if constexpr (F8) asm volatile("v_mfma_f32_16x16x128_f8f6f4 %0, %1, %2, %0" : "+v"(acc[ai][bj][m][n]) : "v"(Bt[n].v), "v"(At[m].v));   \
        else { _Pragma("unroll") for (int k = 0; k < 2; ++k) acc[ai][bj][m][n] = __builtin_amdgcn_mfma_f32_16x16x32_bf16(Bt[n].k[k], At[m].k[k], acc[ai][bj][m][n], 0, 0, 0); } } \
        __builtin_amdgcn_s_setprio(0); } while (0)
#define PG8_WAIT_V(n) asm volatile("s_waitcnt vmcnt(" #n ")" ::: "memory")
#define PG8_WAIT_L(n) asm volatile("s_waitcnt lgkmcnt(" #n ")" ::: "memory")
#define PG8_BAR __builtin_amdgcn_s_barrier()
#define PG8_SCHED __builtin_amdgcn_sched_barrier(0)
#define PG8_AOFF(dst, u) do { _Pragma("unroll") for (int _h = 0; _h < 2; ++_h) _Pragma("unroll") for (int _i = 0; _i < 2; ++_i) \
        dst[_h][_i] = S.a_row(u, _h * HALF + Rr[_i]) * pitch + 2u * (unsigned)Cc[_i]; } while (0)
    Unit cur, nxt; int ui = 0;
    if (!S.next(0, cur)) return;
    f32x4 acc[2][2][4][2];
#pragma unroll
    for (int a = 0; a < 2; ++a)
#pragma unroll
        for (int b = 0; b < 2; ++b)
#pragma unroll
            for (int m = 0; m < 4; ++m)
#pragma unroll
                for (int n = 0; n < 2; ++n) acc[a][b][m][n] = (f32x4){0.f, 0.f, 0.f, 0.f};
    Frag<F8> At[4], B0[2], B1[2];
    unsigned co[2][2], no[2][2];
    PG8_AOFF(co, cur);
    const char* cB = Bbase + cur.bofs;
    if constexpr (SP2) {
        PG8_STAGE(PG8_SB(0, 0), cB, voffB); PG8_STAGE(PG8_SB(0, 1), cB + hstep, voffB); PG8_STAGE(PG8_SA(0, 0), Abase, co[0]); PG8_STAGE(PG8_SA(0, 1), Abase, co[1]);
        if (wr == 1) PG8_BAR;
        PG8_WAIT_V(2); PG8_BAR;
        PG8_STAGE(PG8_SB(1, 0), cB + kstep, voffB); PG8_STAGE(PG8_SA(1, 0), Abase + kstep, co[0]); PG8_STAGE(PG8_SB(1, 1), cB + hstep + kstep, voffB);
        PG8_WAIT_V(6); PG8_BAR;
    } else {
        PG8_STAGE(PG8_SB(0, 0), cB, voffB); PG8_STAGE(PG8_SA(0, 0), Abase, co[0]); PG8_STAGE(PG8_SB(0, 1), cB + hstep, voffB); PG8_STAGE(PG8_SA(0, 1), Abase, co[1]);
        if (wr == 1) PG8_BAR;
        PG8_WAIT_V(4); PG8_BAR;
        PG8_STAGE(PG8_SB(1, 0), cB + kstep, voffB); PG8_STAGE(PG8_SA(1, 0), Abase + kstep, co[0]); PG8_STAGE(PG8_SB(1, 1), cB + hstep + kstep, voffB);
        PG8_WAIT_V(6); PG8_BAR;
    }
    for (;;) {
        const bool has_next = S.next(ui + 1, nxt);
        const char* nB = has_next ? Bbase + nxt.bofs : cB;
        if (has_next) { PG8_AOFF(no, nxt); } else {
#pragma unroll
            for (int h = 0; h < 2; ++h)
#pragma unroll
                for (int i = 0; i < 2; ++i) no[h][i] = co[h][i]; }
#pragma unroll 1
        for (int t = 0; t < nt; t += 2) {
            const bool last = (t == nt - 2);
            const char* a1 = Abase + (size_t)(t + 1) * kstep;
            const char* a2 = last ? Abase : Abase + (size_t)(t + 2) * kstep; const char* b2 = last ? nB : cB + (size_t)(t + 2) * kstep;
            const char* a3 = a2 + kstep; const char* b3 = b2 + kstep;
            unsigned o2[2][2];
#pragma unroll
            for (int h = 0; h < 2; ++h)
#pragma unroll
                for (int i = 0; i < 2; ++i) o2[h][i] = last ? no[h][i] : co[h][i];
            if constexpr (SP2) {
            PG8_LDB(B0, 0, 0); PG8_LDB(B1, 0, 1); PG8_SCHED; PG8_LDA(At, 0, 0); PG8_STAGE(PG8_SA(1, 1), a1, co[1]);
            PG8_WAIT_V(8); PG8_WAIT_L(0); PG8_BAR; PG8_MMA(0, 0, At, B0); PG8_MMA(0, 1, At, B1); PG8_BAR; PG8_SCHED;
            PG8_LDA(At, 0, 1); PG8_STAGE(PG8_SB(0, 0), b2, voffB); PG8_STAGE(PG8_SB(0, 1), b2 + hstep, voffB); PG8_STAGE(PG8_SA(0, 0), a2, o2[0]);
            PG8_WAIT_V(8); PG8_WAIT_L(0); PG8_BAR; PG8_MMA(1, 0, At, B0); PG8_MMA(1, 1, At, B1); PG8_BAR; PG8_SCHED;
            PG8_LDB(B0, 1, 0); PG8_LDB(B1, 1, 1); PG8_SCHED; PG8_LDA(At, 1, 0); PG8_STAGE(PG8_SA(0, 1), a2, o2[1]);
            PG8_WAIT_V(8); PG8_WAIT_L(0); PG8_BAR; PG8_MMA(0, 0, At, B0); PG8_MMA(0, 1, At, B1); PG8_BAR; PG8_SCHED;
            PG8_LDA(At, 1, 1); PG8_STAGE(PG8_SB(1, 0), b3, voffB); PG8_STAGE(PG8_SB(1, 1), b3 + hstep, voffB); PG8_STAGE(PG8_SA(1, 0), a3, o2[0]);
            PG8_WAIT_V(8); PG8_WAIT_L(0); PG8_BAR; PG8_MMA(1, 0, At, B0); PG8_MMA(1, 1, At, B1); PG8_BAR; PG8_SCHED;
            } else {
            PG8_LDB(B0, 0, 0); PG8_SCHED; PG8_LDA(At, 0, 0); PG8_STAGE(PG8_SA(1, 1), a1, co[1]);
            PG8_WAIT_L(8); PG8_BAR; PG8_WAIT_L(0); PG8_MMA(0, 0, At, B0); PG8_BAR; PG8_SCHED;
            PG8_LDB(B1, 0, 1); PG8_STAGE(PG8_SB(0, 0), b2, voffB);
            PG8_BAR; PG8_WAIT_L(0); PG8_MMA(0, 1, At, B1); PG8_BAR;
            PG8_LDA(At, 0, 1); PG8_STAGE(PG8_SA(0, 0), a2, o2[0]);
            PG8_BAR; PG8_WAIT_L(0); PG8_MMA(1, 0, At, B0); PG8_BAR; PG8_SCHED;
            PG8_STAGE(PG8_SB(0, 1), b2 + hstep, voffB);
            PG8_WAIT_V(6); PG8_BAR; PG8_MMA(1, 1, At, B1); PG8_BAR;
            PG8_LDB(B0, 1, 0); PG8_SCHED; PG8_LDA(At, 1, 0); PG8_STAGE(PG8_SA(0, 1), a2, o2[1]);
            PG8_WAIT_L(8); PG8_BAR; PG8_WAIT_L(0); PG8_MMA(0, 0, At, B0); PG8_BAR; PG8_SCHED;
            PG8_LDB(B1, 1, 1); PG8_STAGE(PG8_SB(1, 0), b3, voffB);
            PG8_BAR; PG8_WAIT_L(0); PG8_MMA(0, 1, At, B1); PG8_BAR;
            PG8_LDA(At, 1, 1); PG8_STAGE(PG8_SA(1, 0), a3, o2[0]);
            PG8_BAR; PG8_WAIT_L(0); PG8_MMA(1, 0, At, B0); PG8_BAR; PG8_SCHED;
            PG8_STAGE(PG8_SB(1, 1), b3 + hstep, voffB);
            PG8_WAIT_V(6); PG8_BAR; PG8_MMA(1, 1, At, B1); PG8_BAR;
            }
        }
        if constexpr (ALIGN_EPI) { if (wr == 0) PG8_BAR; }
        if constexpr (F8) { __builtin_amdgcn_sched_barrier(0); asm volatile("s_nop 15\n\ts_nop 15\n\ts_nop 7" ::: "memory"); __builtin_amdgcn_sched_barrier(0); }
        E(acc, cur, wr, wc, fr, fq);
        if (!has_next) break;
#pragma unroll
        for (int a = 0; a < 2; ++a)
#pragma unroll
            for (int b = 0; b < 2; ++b)
#pragma unroll
                for (int m = 0; m < 4; ++m)
#pragma unroll
                    for (int n = 0; n < 2; ++n) acc[a][b][m][n] = (f32x4){0.f, 0.f, 0.f, 0.f};
        cur = nxt; cB = nB; ++ui;
#pragma unroll
        for (int h = 0; h < 2; ++h)
#pragma unroll
            for (int i = 0; i < 2; ++i) co[h][i] = no[h][i];
        if constexpr (ALIGN_EPI) { if (wr == 1) PG8_BAR; }
    }
    PG8_WAIT_V(0);
    if constexpr (!ALIGN_EPI) { if (wr == 0) PG8_BAR; }
    PG8_BAR;
#undef PG8_SA
#undef PG8_SB
#undef PG8_STAGE
#undef PG8_LDA
#undef PG8_LDF
#undef PG8_LDB
#undef PG8_MMA
#undef PG8_WAIT_V
#undef PG8_WAIT_L
#undef PG8_BAR
#undef PG8_SCHED
#undef PG8_AOFF
}

struct EpiInProj {
    static constexpr bool PERM = true;
    bf16_t* P; const float* ropeC; const float* ropeS;
    __device__ __forceinline__ void operator()(const f32x4 (&acc)[2][2][4][2], const Unit& u, int wr, int wc, int fr, int fq) const {
        const int row0 = u.pm * BM + wr * 64 + fr, col0 = u.pn * BM + wc * 32 + 8 * fq;
        const bool qk = u.pn < 4, rope = qk && (u.pm < NLAT / BM);
        const float ks = (u.pn >= 2 && u.pn < 4) ? 0.08838834764831845f : 1.0f;
        const int sec = wc >> 1, i0 = (wc & 1) * 16 + 4 * fq;
#pragma unroll
        for (int ai = 0; ai < 2; ++ai)
#pragma unroll
            for (int m = 0; m < 4; ++m) {
                const int row = row0 + ai * HALF + m * 16;
                asm volatile("" ::: "memory");
                f32x4 c4 = (f32x4){1.f, 1.f, 1.f, 1.f}, s4 = (f32x4){0.f, 0.f, 0.f, 0.f};
                if (rope) { const int t = row & (TL - 1), pos = sec ? (t & 63) : (t >> 6); const int ti = (sec ? 1024 : 0) + pos * 32 + i0;
                    c4 = *(const f32x4*)(ropeC + ti); s4 = *(const f32x4*)(ropeS + ti); }
                bf16_t* rowp = P + (size_t)row * NP + col0;
#pragma unroll
                for (int bj = 0; bj < 2; ++bj) {
                    f32x4 v0 = acc[ai][bj][m][0], v1 = acc[ai][bj][m][1];
                    if (qk) {
                        const float a0 = v0[0] * c4[0] - v0[1] * s4[0], b0 = v0[0] * s4[0] + v0[1] * c4[0];
                        const float a1 = v0[2] * c4[1] - v0[3] * s4[1], b1 = v0[2] * s4[1] + v0[3] * c4[1];
                        const float a2 = v1[0] * c4[2] - v1[1] * s4[2], b2 = v1[0] * s4[2] + v1[1] * c4[2];
                        const float a3 = v1[2] * c4[3] - v1[3] * s4[3], b3 = v1[2] * s4[3] + v1[3] * c4[3];
                        v0 = (f32x4){a0 * ks, b0 * ks, a1 * ks, b1 * ks}; v1 = (f32x4){a2 * ks, b2 * ks, a3 * ks, b3 * ks};
                    }
                    u32x4 w; w.x = cvt_pk_bf16(v0[0], v0[1]); w.y = cvt_pk_bf16(v0[2], v0[3]); w.z = cvt_pk_bf16(v1[0], v1[1]); w.w = cvt_pk_bf16(v1[2], v1[3]);
                    *(u32x4*)(rowp + bj * HALF) = w;
                }
            }
    }
};
struct EpiResid {
    static constexpr bool PERM = true;
    const float* rl; const float* rc; const bf16_t* rb; bf16_t* ob; float* ssq; const float* gmod;
    __device__ __forceinline__ void operator()(const f32x4 (&acc)[2][2][4][2], const Unit& u, int wr, int wc, int fr, int fq) const {
        const int row0 = u.pm * BM + wr * 64 + fr, col0 = u.pn * BM + wc * 32 + 8 * fq;
        const bool lat = u.pm < NLAT / BM; const int b = lat ? (u.pm >> 3) : 16;
        const float* rbase = rl ? (lat ? rl : rc - (size_t)NLAT * D) : nullptr;
        f32x4 gv[2][2];
#pragma unroll
        for (int bj = 0; bj < 2; ++bj)
#pragma unroll
            for (int n = 0; n < 2; ++n) gv[bj][n] = *(const f32x4*)(gmod + (size_t)b * 6 * D + col0 + bj * HALF + 4 * n);
#pragma unroll
        for (int ai = 0; ai < 2; ++ai)
#pragma unroll
            for (int m = 0; m < 4; ++m) { const int row = row0 + ai * HALF + m * 16; const size_t off = (size_t)row * D + col0; float ss = 0.f;
#pragma unroll
                for (int bj = 0; bj < 2; ++bj) { f32x4 r0, r1;
                    if (rbase) { r0 = *(const f32x4*)(rbase + off + bj * HALF); r1 = *(const f32x4*)(rbase + off + bj * HALF + 4); }
                    else { const u32x4 w = *(const u32x4*)(rb + off + bj * HALF); r0 = (f32x4){bflo(w.x), bfhi(w.x), bflo(w.y), bfhi(w.y)}; r1 = (f32x4){bflo(w.z), bfhi(w.z), bflo(w.w), bfhi(w.w)}; }
                    const f32x4 v0 = r0 + gv[bj][0] * acc[ai][bj][m][0], v1 = r1 + gv[bj][1] * acc[ai][bj][m][1];
                    ss += (v0[0] * v0[0] + v0[1] * v0[1]) + (v0[2] * v0[2] + v0[3] * v0[3]) + (v1[0] * v1[0] + v1[1] * v1[1]) + (v1[2] * v1[2] + v1[3] * v1[3]);
                    u32x4 w; w.x = cvt_pk_bf16(v0[0], v0[1]); w.y = cvt_pk_bf16(v0[2], v0[3]); w.z = cvt_pk_bf16(v1[0], v1[1]); w.w = cvt_pk_bf16(v1[2], v1[3]);
                    *(u32x4*)(ob + off + bj * HALF) = w; }
                ss += __shfl_xor(ss, 16); ss += __shfl_xor(ss, 32);
                if (fq == 0) ssq[(size_t)row * 16 + u.pn * 4 + wc] = ss;
                if (m & 1) asm volatile("" ::: "memory"); }
    }
};
struct EpiSwiGLU {
    static constexpr bool PERM = true;
    bf16_t* O;
    __device__ __forceinline__ void operator()(const f32x4 (&acc)[2][2][4][2], const Unit& u, int wr, int wc, int fr, int fq) const {
        const int row0 = u.pm * BM + wr * 64 + fr, col0 = u.pn * 128 + wc * 16 + 4 * fq;
#pragma unroll
        for (int ai = 0; ai < 2; ++ai)
#pragma unroll
            for (int m = 0; m < 4; ++m) { bf16_t* rowp = O + (size_t)(row0 + ai * HALF + m * 16) * FF + col0;
#pragma unroll
                for (int bj = 0; bj < 2; ++bj) { const f32x4 g = acc[ai][bj][m][0], up = acc[ai][bj][m][1];
                    u32x2 w; w.x = cvt_pk_bf16(silu_f(g[0]) * up[0], silu_f(g[1]) * up[1]); w.y = cvt_pk_bf16(silu_f(g[2]) * up[2], silu_f(g[3]) * up[3]);
                    *(u32x2*)(rowp + bj * 64) = w; } }
    }
};
__device__ __forceinline__ unsigned pk4_fp8(float a, float b, float c, float d) { int p = __builtin_amdgcn_cvt_pk_fp8_f32(a, b, 0, false); p = __builtin_amdgcn_cvt_pk_fp8_f32(c, d, p, true); return (unsigned)p; }
struct EpiSwiGLU8 {
    static constexpr bool PERM = true;
    unsigned char* O; float inv;
    __device__ __forceinline__ void operator()(const f32x4 (&acc)[2][2][4][2], const Unit& u, int wr, int wc, int fr, int fq) const {
        const int row0 = u.pm * BM + wr * 64 + fr, col0 = u.pn * 128 + wc * 32 + 8 * fq;
#pragma unroll
        for (int ai = 0; ai < 2; ++ai)
#pragma unroll
            for (int m = 0; m < 4; ++m) { unsigned char* rowp = O + (size_t)(row0 + ai * HALF + m * 16) * FF + col0;
                const f32x4 g0 = acc[ai][0][m][0] * inv, g1 = acc[ai][0][m][1] * inv, u0 = acc[ai][1][m][0] * inv, u1 = acc[ai][1][m][1] * inv;
                u32x2 w; w.x = pk4_fp8(silu_f(g0[0]) * u0[0], silu_f(g0[1]) * u0[1], silu_f(g0[2]) * u0[2], silu_f(g0[3]) * u0[3]);
                w.y = pk4_fp8(silu_f(g1[0]) * u1[0], silu_f(g1[1]) * u1[1], silu_f(g1[2]) * u1[2], silu_f(g1[3]) * u1[3]);
                *(u32x2*)rowp = w; }
    }
};
struct EpiFp8S {
    static constexpr bool PERM = true;
    unsigned char* O; int ldc; float inv;
    __device__ __forceinline__ void operator()(const f32x4 (&acc)[2][2][4][2], const Unit& u, int wr, int wc, int fr, int fq) const {
        const int row0 = u.pm * BM + wr * 64 + fr, col0 = u.pn * BM + wc * 32 + 8 * fq;
#pragma unroll
        for (int ai = 0; ai < 2; ++ai)
#pragma unroll
            for (int m = 0; m < 4; ++m) { unsigned char* rowp = O + (size_t)(row0 + ai * HALF + m * 16) * ldc + col0;
#pragma unroll
                for (int bj = 0; bj < 2; ++bj) { const f32x4 v0 = acc[ai][bj][m][0] * inv, v1 = acc[ai][bj][m][1] * inv;
                    u32x2 w; w.x = pk4_fp8(v0[0], v0[1], v0[2], v0[3]); w.y = pk4_fp8(v1[0], v1[1], v1[2], v1[3]);
                    *(u32x2*)(rowp + bj * HALF) = w; } }
    }
};
struct EpiBf16S {
    static constexpr bool PERM = true;
    bf16_t* O; int ldc; float inv;
    __device__ __forceinline__ void operator()(const f32x4 (&acc)[2][2][4][2], const Unit& u, int wr, int wc, int fr, int fq) const {
        const int row0 = u.pm * BM + wr * 64 + fr, col0 = u.pn * BM + wc * 32 + 8 * fq;
#pragma unroll
        for (int ai = 0; ai < 2; ++ai)
#pragma unroll
            for (int m = 0; m < 4; ++m) { bf16_t* rowp = O + (size_t)(row0 + ai * HALF + m * 16) * ldc + col0;
#pragma unroll
                for (int bj = 0; bj < 2; ++bj) { const f32x4 v0 = acc[ai][bj][m][0] * inv, v1 = acc[ai][bj][m][1] * inv;
                    u32x4 w; w.x = cvt_pk_bf16(v0[0], v0[1]); w.y = cvt_pk_bf16(v0[2], v0[3]); w.z = cvt_pk_bf16(v1[0], v1[1]); w.w = cvt_pk_bf16(v1[2], v1[3]);
                    *(u32x4*)(rowp + bj * HALF) = w; } }
    }
};
struct EpiBf16 {
    static constexpr bool PERM = true;
    bf16_t* O; int ldc;
    __device__ __forceinline__ void operator()(const f32x4 (&acc)[2][2][4][2], const Unit& u, int wr, int wc, int fr, int fq) const {
        const int row0 = u.pm * BM + wr * 64 + fr, col0 = u.pn * BM + wc * 32 + 8 * fq;
#pragma unroll
        for (int ai = 0; ai < 2; ++ai)
#pragma unroll
            for (int m = 0; m < 4; ++m) { bf16_t* rowp = O + (size_t)(row0 + ai * HALF + m * 16) * ldc + col0;
#pragma unroll
                for (int bj = 0; bj < 2; ++bj) { const f32x4 v0 = acc[ai][bj][m][0], v1 = acc[ai][bj][m][1];
                    u32x4 w; w.x = cvt_pk_bf16(v0[0], v0[1]); w.y = cvt_pk_bf16(v0[2], v0[3]); w.z = cvt_pk_bf16(v1[0], v1[1]); w.w = cvt_pk_bf16(v1[2], v1[3]);
                    *(u32x4*)(rowp + bj * HALF) = w; } }
    }
};
}

struct Args { const float* in[22]; float* out; unsigned char* ws; int ph_lo, ph_hi; };
enum { I_X = 0, I_C, I_CTX, I_CCTX, I_ADAW, I_ADAB, I_N1G, I_WIN, I_DF, I_DB, I_POOLW, I_POOLS, I_WOUT, I_N2G, I_RGW, I_RGB, I_REW, I_REB, I_WG, I_WU, I_WDN, I_FNG };

struct Frame {
    LAS unsigned char* lds; int tid, lane, wave, G, bx, vcu;
    const float* const* in; float* out; unsigned char* ws;
};
__device__ __forceinline__ bf16_t* xb_row(const Frame& F, int row) { return (bf16_t*)(F.ws + WS_XB) + (size_t)row * D; }
__device__ __forceinline__ bf16_t* hbuf(const Frame& F) { return (bf16_t*)F.out; }
__device__ __forceinline__ const float* mod_ptr(const Frame& F, int l, int b, int which) { return (const float*)(F.ws + WS_MOD) + ((size_t)(l * 17 + b) * 6 + which) * D; }

__device__ __forceinline__ void tr_item(const float* colp, size_t ldw, int k0, bf16_t* WT, int K, int n0, LAS float* scr, int lane) {
    { float v[32];
#pragma unroll
        for (int i = 0; i < 32; ++i) v[i] = colp[(size_t)(k0 + 2 * i + (lane >> 5)) * ldw];
#pragma unroll
        for (int i = 0; i < 32; ++i) scr[(2 * i + (lane >> 5)) * 33 + (lane & 31)] = v[i]; }
    asm volatile("s_waitcnt lgkmcnt(0)" ::: "memory");
    const int c = lane & 7;
#pragma unroll
    for (int j = 0; j < 4; ++j) { const int n = (lane >> 3) + 8 * j; const LAS float* s = scr + (8 * c) * 33 + n;
        u32x4 o; o.x = pk2(s[0 * 33], s[1 * 33]); o.y = pk2(s[2 * 33], s[3 * 33]); o.z = pk2(s[4 * 33], s[5 * 33]); o.w = pk2(s[6 * 33], s[7 * 33]);
        *(u32x4*)(WT + (size_t)(n0 + n) * K + k0 + 8 * c) = o; }
    asm volatile("s_waitcnt lgkmcnt(0)" ::: "memory");
}
constexpr float WGU_SCALE = 64.0f, WD_SCALE = 32.0f;
__device__ __forceinline__ void tr_item8(const float* colp, size_t ldw, int k0, unsigned char* WT, int K, int n0, LAS float* scr, int lane, float qs) {
    { float v[32];
#pragma unroll
        for (int i = 0; i < 32; ++i) v[i] = colp[(size_t)(k0 + 2 * i + (lane >> 5)) * ldw];
#pragma unroll
        for (int i = 0; i < 32; ++i) scr[(2 * i + (lane >> 5)) * 33 + (lane & 31)] = v[i] * qs; }
    asm volatile("s_waitcnt lgkmcnt(0)" ::: "memory");
    const int c = lane & 7;
#pragma unroll
    for (int j = 0; j < 4; ++j) { const int n = (lane >> 3) + 8 * j; const LAS float* s = scr + (8 * c) * 33 + n;
        u32x2 o; o.x = pg8::pk4_fp8(s[0 * 33], s[1 * 33], s[2 * 33], s[3 * 33]); o.y = pg8::pk4_fp8(s[4 * 33], s[5 * 33], s[6 * 33], s[7 * 33]);
        *(u32x2*)(WT + (size_t)(n0 + n) * K + k0 + 8 * c) = o; }
    asm volatile("s_waitcnt lgkmcnt(0)" ::: "memory");
}
__device__ __forceinline__ void fold_item(const float* win, const float* pw, const float* ps, int k0, bf16_t* WT, int n0, LAS float* scr, int lane) {
    const int n = n0 + (lane & 31), g = n >> 7, nn = n & 127;
    const float* pwc = pw + (size_t)g * 128 * 128 + nn; const float sc = ps[n];
    float acc[32];
#pragma unroll
    for (int i = 0; i < 32; ++i) acc[i] = 0.f;
    for (int hc = 0; hc < 8; ++hc) {
        float pc[16];
#pragma unroll
        for (int c = 0; c < 16; ++c) pc[c] = pwc[(size_t)(hc * 16 + c) * 128];
#pragma unroll
        for (int i = 0; i < 32; ++i) { const f32x4* wr = (const f32x4*)(win + (size_t)(k0 + 2 * i + (lane >> 5)) * NP + 2048 + g * 128 + hc * 16);
            float a = acc[i];
#pragma unroll
            for (int c4 = 0; c4 < 4; ++c4) { const f32x4 w = wr[c4]; a += w[0] * pc[4 * c4] + w[1] * pc[4 * c4 + 1] + w[2] * pc[4 * c4 + 2] + w[3] * pc[4 * c4 + 3]; }
            acc[i] = a; }
    }
#pragma unroll
    for (int i = 0; i < 32; ++i) scr[(2 * i + (lane >> 5)) * 33 + (lane & 31)] = acc[i] * sc;
    asm volatile("s_waitcnt lgkmcnt(0)" ::: "memory");
    const int c = lane & 7;
#pragma unroll
    for (int j = 0; j < 4; ++j) { const int nl = (lane >> 3) + 8 * j; const LAS float* s = scr + (8 * c) * 33 + nl;
        u32x4 o; o.x = pk2(s[0 * 33], s[1 * 33]); o.y = pk2(s[2 * 33], s[3 * 33]); o.z = pk2(s[4 * 33], s[5 * 33]); o.w = pk2(s[6 * 33], s[7 * 33]);
        *(u32x4*)(WT + (size_t)(2048 + n0 + nl) * D + k0 + 8 * c) = o; }
    asm volatile("s_waitcnt lgkmcnt(0)" ::: "memory");
}
__device__ __forceinline__ void p0_prologue(const Frame& F, int qsel) {
    for (int task = F.bx; task < 2 * 96; task += F.G) {
        const int l = task / 96, cg = task % 96;
        LAS float* sc = (LAS float*)F.lds;
        LAS float* part = (LAS float*)(F.lds + 17 * 1024 * 4);
        { float cv[34];
#pragma unroll
          for (int q = 0; q < 34; ++q) { const int i = F.tid + 512 * q, b = i >> 10, k = i & 1023; cv[q] = b < 16 ? F.in[I_C][b * D + k] : F.in[I_CCTX][k]; }
#pragma unroll
          for (int q = 0; q < 34; ++q) sc[F.tid + 512 * q] = silu_f(cv[q]); }
        __syncthreads();
        float acc[17];
#pragma unroll
        for (int b = 0; b < 17; ++b) acc[b] = 0.f;
        const float* aw = F.in[I_ADAW] + (size_t)l * D * 6 * D + cg * 64 + F.lane;
        for (int k0 = F.wave * 128; k0 < F.wave * 128 + 128; k0 += 16) { float w[16];
#pragma unroll
            for (int u = 0; u < 16; ++u) w[u] = aw[(size_t)(k0 + u) * 6 * D];
#pragma unroll
            for (int u = 0; u < 16; ++u) {
#pragma unroll
                for (int b = 0; b < 17; ++b) acc[b] += sc[b * 1024 + k0 + u] * w[u]; } }
#pragma unroll
        for (int b = 0; b < 17; ++b) part[(F.wave * 17 + b) * 64 + F.lane] = acc[b];
        __syncthreads();
        for (int i = F.tid; i < 17 * 64; i += 512) { const int b = i >> 6, n = i & 63; float s = F.in[I_ADAB][l * 6 * D + cg * 64 + n];
#pragma unroll
            for (int w = 0; w < 8; ++w) s += part[(w * 17 + b) * 64 + n];
            const int col = cg * 64 + n; ((float*)(F.ws + WS_MOD))[((size_t)(l * 17 + b) * 6 + (col >> 10)) * D + (col & 1023)] = s; }
        __syncthreads();
    }
    if (F.bx >= F.G - 3 && F.bx < F.G - 1) { const int l = F.G - 2 - F.bx; unsigned char* img = F.ws + WS_RIMG + (size_t)l * RW_EX;
        const float* rg = F.in[I_RGW] + (size_t)l * D * 4; const float* re = F.in[I_REW] + (size_t)l * D * NE;
        for (int i0 = F.tid; i0 < 1024 * 36; i0 += 512 * 8) { float w[8];
#pragma unroll
            for (int q = 0; q < 8; ++q) { const int i = i0 + 512 * q, k = i / 36, n = i % 36; w[q] = n < 4 ? rg[k * 4 + n] : re[k * NE + (n - 4)]; }
#pragma unroll
            for (int q = 0; q < 8; ++q) { const int i = i0 + 512 * q, k = i / 36, n = i % 36; const unsigned hi = f2bf(w[q]), lo = f2bf(w[q] - bflo(hi));
                *(bf16_t*)(img + n * RW_PITCH + k * 2) = (bf16_t)hi; *(bf16_t*)(img + RW_LO + n * RW_PITCH + k * 2) = (bf16_t)lo; } }
        for (int i = F.tid; i < 2 * 36 * 8; i += 512) { const int r = i >> 3; *(bf16_t*)(img + r * RW_PITCH + 2048 + (i & 7) * 2) = 0; }
    }
    if (F.bx == F.G - 1) {
        float* rc = (float*)(F.ws + WS_ROPE); float* rs = rc + 96 * 32;
        for (int i = F.tid; i < 96 * 32; i += 512) { const int p = i >> 5, f = i & 31; const int pos = p < 32 ? p : p - 32;
            const float inv = powf(10000.0f, -(float)f / 32.0f); const float ang = (float)pos * inv; rc[i] = cosf(ang); rs[i] = sinf(ang); }
    }
    LAS float* scr = (LAS float*)(F.lds + F.wave * 8448);
    constexpr int IT_WIN = 16 * 80, IT_WOUT = 16 * 32, IT_GU = 16 * 32, IT_DN = 8 * 32;
    constexpr int N_WIN = DEPTH * IT_WIN, N_WOUT = DEPTH * IT_WOUT, N_GU = DEPTH * NE * IT_GU, N_DN = DEPTH * NE * IT_DN;
    unsigned* qhead = (unsigned*)(F.ws + WS_CTL) + CW_QUEUE + 16 * qsel;
    constexpr int N_ALL = N_WIN + N_WOUT + N_GU + N_DN, QB = 16, NBATCH = N_ALL / QB;
    static_assert(N_ALL % QB == 0, "queue batches");
    for (;;) {
        int bq = 0; if (F.lane == 0) bq = (int)__hip_atomic_fetch_add(qhead, 1u, __ATOMIC_RELAXED, __HIP_MEMORY_SCOPE_AGENT);
        bq = __builtin_amdgcn_readfirstlane(bq);
        if (bq >= NBATCH) break;
      for (int qi = 0; qi < QB; ++qi) {
        int r = bq + qi * NBATCH;
        if (r < N_WIN) { const int l = r / IT_WIN; r %= IT_WIN; const int kb = r & 15, nb = 79 - (r >> 4), n0 = nb * 32;
            const float* win = F.in[I_WIN] + (size_t)l * D * NP; bf16_t* WT = (bf16_t*)(F.ws + WS_WIN) + (size_t)l * NP * D;
            if (n0 >= 2048) { fold_item(win, F.in[I_POOLW] + (size_t)l * 4 * 128 * 128, F.in[I_POOLS] + l * 512, kb * 64, WT, n0 - 2048, scr, F.lane); continue; }
            const int n = n0 + (F.lane & 31); int src = n;
            if (n < 1024) { const int hh = n >> 7, j = n & 127, sec = j >> 6, jj = j & 63; src = (n & 512) + (hh & 3) * 128 + sec * 64 + (jj & 1) * 32 + (jj >> 1); }
            tr_item(win + src, NP, kb * 64, WT, D, n0, scr, F.lane); continue; }
        r -= N_WIN;
        if (r < N_WOUT) { const int l = r / IT_WOUT; r %= IT_WOUT; const int kb = r / 32, nb = r % 32, n0 = nb * 32;
            tr_item(F.in[I_WOUT] + (size_t)l * D * D + n0 + (F.lane & 31), D, kb * 64, (bf16_t*)(F.ws + WS_WOUT) + (size_t)l * D * D, D, n0, scr, F.lane); continue; }
        r -= N_WOUT;
        if (r < N_GU) { const int le = r / IT_GU; r %= IT_GU; const int kb = r / 32, nb = r % 32, n0 = nb * 32;
            const int n = n0 + (F.lane & 31), col = (n >> 8) * 128 + (n & 127); const float* src = ((n & 128) ? F.in[I_WU] : F.in[I_WG]) + (size_t)le * D * FF + col;
            tr_item8(src, FF, kb * 64, (unsigned char*)(F.ws + WS_WGU) + (size_t)le * 1024 * D, D, n0, scr, F.lane, WGU_SCALE); continue; }
        r -= N_GU;
        { const int le = r / IT_DN; r %= IT_DN; const int kb = r / 32, nb = r % 32, n0 = nb * 32;
            tr_item8(F.in[I_WDN] + (size_t)le * FF * D + n0 + (F.lane & 31), D, kb * 64, (unsigned char*)(F.ws + WS_WD) + (size_t)le * D * FF, FF, n0, scr, F.lane, WD_SCALE); }
      }
    }
}

__device__ __forceinline__ LAS int* build_tb(const Frame& F, int l) {
    LAS int* tb = (LAS int*)(F.lds + MISC_OFF + 64);
    if (F.tid < 64) {
        const unsigned* cnt = (const unsigned*)(F.ws + WS_CTL) + CW_CNT + l * NE * 16;
        const int e = F.tid & 31; const int c = (int)__hip_atomic_load(cnt + e * 16, __ATOMIC_RELAXED, __HIP_MEMORY_SCOPE_AGENT);
        const int t = (c + 255) >> 8; int incl = t;
#pragma unroll
        for (int o = 1; o < 32; o <<= 1) { const int v = __shfl_up(incl, o, 32); if (e >= o) incl += v; }
        if (F.tid < 32) { tb[e] = incl - t; tb[64 + e] = c; if (e == 31) tb[NE] = incl; }
    }
    __syncthreads();
    return tb;
}

__device__ __forceinline__ void row_op_a(const Frame& F, int mode, bool dry) {
    const int gw = F.vcu * 8 + F.wave, NGW = F.G * 8;
    const int nrows = (mode == 2) ? NLAT : NTOK; const int l = (mode == 0) ? 0 : 1, lp = mode - 1;
    const LAS int* tb = nullptr; if (mode != 0) tb = build_tb(F, lp);
    const unsigned char* YB = (const unsigned char*)(F.ws + WS_P); bf16_t* H = hbuf(F);
    const float* gain = (mode == 2) ? F.in[I_FNG] : F.in[I_N1G] + l * D;
    int4 ti1 = make_int4(0, 0, 0, 0), ti2 = ti1; f32x2 tw0 = (f32x2){0.f, 0.f}, tw1 = tw0, tw2 = tw0;
    f32x4 xf[4]; u32x2 xq[4]; unsigned ya[4], yc[4];
#define ROWA_INFO(r_, ti_, tw_) do { if (mode != 0 && (r_) < nrows) { ti_ = *(const int4*)(F.ws + WS_TOKINFO + (size_t)(r_) * 32); tw_ = *(const f32x2*)(F.ws + WS_TOKINFO + (size_t)(r_) * 32 + 16); } } while (0)
#define ROWA_DATA(r_, ti_) do { if ((r_) < nrows) { if (mode == 0) { const f32x4* src = (const f32x4*)((r_) < NLAT ? F.in[I_X] + (size_t)(r_) * D : F.in[I_CTX] + (size_t)((r_) - NLAT) * D) + F.lane; \
            _Pragma("unroll") for (int j = 0; j < 4; ++j) xf[j] = src[64 * j]; } \
        else { const size_t s1 = (size_t)(tb[ti_.x] * 256 + ti_.y), s2 = (size_t)(tb[ti_.z] * 256 + ti_.w); const u32x2* xr_ = (const u32x2*)xb_row(F, (r_)) + F.lane; \
            const unsigned* y1 = (const unsigned*)(YB + s1 * D) + F.lane; const unsigned* y2 = (const unsigned*)(YB + s2 * D) + F.lane; \
            _Pragma("unroll") for (int j = 0; j < 4; ++j) { xq[j] = xr_[64 * j]; ya[j] = y1[64 * j]; yc[j] = y2[64 * j]; } } } } while (0)
    ROWA_INFO(gw, ti1, tw1); ROWA_INFO(gw + NGW, ti2, tw2);
    ROWA_DATA(gw, ti1); tw0 = tw1; ti1 = ti2; tw1 = tw2;
    for (int row = gw; row < nrows; row += NGW) {
        const int b = row < NLAT ? (row >> 11) : 16;
        ROWA_INFO(row + 2 * NGW, ti2, tw2);
        f32x4 v[4];
        if (mode == 0) {
#pragma unroll
            for (int j = 0; j < 4; ++j) v[j] = xf[j];
        } else {
            const f32x4* g2 = (const f32x4*)mod_ptr(F, lp, b, 5) + F.lane;
#pragma unroll
            for (int j = 0; j < 4; ++j) { const u32x2 xw = xq[j]; const f32x4 x = (f32x4){bflo(xw.x), bfhi(xw.x), bflo(xw.y), bfhi(xw.y)};
                const int a = (int)ya[j], c = (int)yc[j]; const f32x4 g = g2[64 * j];
                f32x4 y; y[0] = tw0.x * __builtin_amdgcn_cvt_f32_fp8(a, 0) + tw0.y * __builtin_amdgcn_cvt_f32_fp8(c, 0); y[1] = tw0.x * __builtin_amdgcn_cvt_f32_fp8(a, 1) + tw0.y * __builtin_amdgcn_cvt_f32_fp8(c, 1);
                y[2] = tw0.x * __builtin_amdgcn_cvt_f32_fp8(a, 2) + tw0.y * __builtin_amdgcn_cvt_f32_fp8(c, 2); y[3] = tw0.x * __builtin_amdgcn_cvt_f32_fp8(a, 3) + tw0.y * __builtin_amdgcn_cvt_f32_fp8(c, 3);
                v[j] = x + g * y; }
        }
        ROWA_DATA(row + NGW, ti1);
        if (mode == 1 && !dry) { u32x2* xr = (u32x2*)xb_row(F, row) + F.lane;
#pragma unroll
            for (int j = 0; j < 4; ++j) { u32x2 w; w.x = pk2(v[j][0], v[j][1]); w.y = pk2(v[j][2], v[j][3]); xr[64 * j] = w; } }
        float ss = 0.f;
#pragma unroll
        for (int j = 0; j < 4; ++j) ss += (v[j][0] * v[j][0] + v[j][1] * v[j][1]) + (v[j][2] * v[j][2] + v[j][3] * v[j][3]);
        const float rstd = 1.0f / sqrtf(wave_sum(ss) * (1.0f / D) + EPS);
        if (mode == 2) {
#pragma unroll
            for (int j = 0; j < 4; ++j) { const f32x4 g = ((const f32x4*)gain)[F.lane + 64 * j]; ((f32x4*)((dry ? (float*)(F.ws + WS_WGU) : F.out) + (size_t)row * D))[F.lane + 64 * j] = v[j] * rstd * g; }
        } else {
            const f32x4* sh = (const f32x4*)mod_ptr(F, l, b, 0) + F.lane; const f32x4* sc = (const f32x4*)mod_ptr(F, l, b, 1) + F.lane;
            u32x2* o = (u32x2*)(H + (size_t)row * D) + F.lane;
#pragma unroll
            for (int j = 0; j < 4; ++j) { const f32x4 g = ((const f32x4*)gain)[F.lane + 64 * j]; const f32x4 h = v[j] * rstd * g * (sc[64 * j] + 1.0f) + sh[64 * j];
                u32x2 w; w.x = pk2(h[0], h[1]); w.y = pk2(h[2], h[3]); o[64 * j] = w; }
        }
        tw0 = tw1; ti1 = ti2; tw1 = tw2;
    }
#undef ROWA_INFO
#undef ROWA_DATA
}

template <bool DRY> __device__ __forceinline__ void route_row(const Frame& F, int l, int row, const float (&s)[36], unsigned* cnt, int* list) {
    float gl[4];
#pragma unroll
    for (int i = 0; i < 4; ++i) gl[i] = s[i];
    int gt = 0; float gm = gl[0];
#pragma unroll
    for (int i = 1; i < 4; ++i) if (gl[i] > gm) { gm = gl[i]; gt = i; }
    float gs = 0.f;
#pragma unroll
    for (int i = 0; i < 4; ++i) gs += expf(gl[i] - gm);
    const float gwt = 1.0f / gs;
    float el[8];
#pragma unroll
    for (int j = 0; j < 8; ++j) el[j] = gt == 0 ? s[4 + j] : gt == 1 ? s[12 + j] : gt == 2 ? s[20 + j] : s[28 + j];
    int i1 = 0; float v1 = el[0];
#pragma unroll
    for (int j = 1; j < 8; ++j) if (el[j] > v1) { v1 = el[j]; i1 = j; }
    int i2 = -1; float v2 = -3.0e38f;
#pragma unroll
    for (int j = 0; j < 8; ++j) if (j != i1 && el[j] > v2) { v2 = el[j]; i2 = j; }
    const float e2 = expf(v2 - v1); const float w1 = gwt / (1.0f + e2), w2 = gwt * e2 / (1.0f + e2);
    if (!DRY) {
        const int x1 = gt * 8 + i1, x2 = gt * 8 + i2;
        const int r1 = (int)__hip_atomic_fetch_add(cnt + x1 * 16, 1u, __ATOMIC_RELAXED, __HIP_MEMORY_SCOPE_AGENT);
        const int r2 = (int)__hip_atomic_fetch_add(cnt + x2 * 16, 1u, __ATOMIC_RELAXED, __HIP_MEMORY_SCOPE_AGENT);
        list[(size_t)x1 * NTOK + r1] = row; list[(size_t)x2 * NTOK + r2] = row;
        *(int4*)(F.ws + WS_TOKINFO + (size_t)row * 32) = make_int4(x1, r1, x2, r2); *(f32x2*)(F.ws + WS_TOKINFO + (size_t)row * 32 + 16) = (f32x2){w1, w2};
    }
}
template <bool DRY> __device__ __forceinline__ void row_op_b(const Frame& F, int l) {
    const int gw = F.vcu * 8 + F.wave, NGW = F.G * 8;
    const int ngroups = ((l == 0) ? NTOK : NLAT) / 16;
    { const u32x4* img = (const u32x4*)(F.ws + WS_RIMG + (size_t)l * RW_EX);
      u32x4 t[19];
#pragma unroll
      for (int q = 0; q < 19; ++q) { const int i = F.tid + 512 * q; t[q] = img[i < RW_EX / 16 ? i : 0]; }
#pragma unroll
      for (int q = 0; q < 19; ++q) { const int i = F.tid + 512 * q; if (i < RW_EX / 16) *(LAS u32x4*)(F.lds + i * 16) = t[q]; } }
    __syncthreads();
    bf16_t* H = hbuf(F);
    const float* gain = F.in[I_N2G] + l * D;
    unsigned* cnt = (unsigned*)(F.ws + WS_CTL) + CW_CNT + l * NE * 16;
    int* list = (int*)(F.ws + WS_LIST);
    const int fr = F.lane & 15, fq = F.lane >> 4;
    unsigned bo[3];
#pragma unroll
    for (int nt = 0; nt < 3; ++nt) { const int n = 16 * nt + fr; bo[nt] = (unsigned)((n < 36 ? n : 35) * RW_PITCH + fq * 16); }
    LAS float* ex = (LAS float*)(F.lds + RW_EX + F.wave * 1152);
    float rbias[36];
#pragma unroll
    for (int n = 0; n < 36; ++n) rbias[n] = n < 4 ? F.in[I_RGB][l * 4 + n] : F.in[I_REB][l * NE + (n - 4)];
    for (int gi = gw; gi < ngroups; gi += NGW) {
        const int row = gi * 16 + fr, b = row < NLAT ? (row >> 11) : 16;
        const bf16_t* xr = xb_row(F, row) + fq * 8;
        float ss;
        { const f32x4* sp = (const f32x4*)((const float*)(F.ws + WS_SSQ) + (size_t)row * 16); const f32x4 p0 = sp[0], p1 = sp[1], p2 = sp[2], p3 = sp[3];
          ss = ((p0[0] + p0[1]) + (p0[2] + p0[3])) + ((p1[0] + p1[1]) + (p1[2] + p1[3])) + ((p2[0] + p2[1]) + (p2[2] + p2[3])) + ((p3[0] + p3[1]) + (p3[2] + p3[3])); }
        const float rstd = 1.0f / sqrtf(ss * (1.0f / D) + EPS);
        const float* shp = mod_ptr(F, l, b, 3) + fq * 8; const float* scp = mod_ptr(F, l, b, 4) + fq * 8; const float* gp = gain + fq * 8;
        unsigned char* hp = (unsigned char*)H + (size_t)row * D + fq * 8;
        f32x4 acc[3];
#pragma unroll
        for (int nt = 0; nt < 3; ++nt) acc[nt] = (f32x4){0.f, 0.f, 0.f, 0.f};
#pragma unroll 2
        for (int s = 0; s < 32; ++s) {
            const u32x4 xw = *(const u32x4*)(xr + 32 * s);
            const f32x4 x0 = (f32x4){bflo(xw.x), bfhi(xw.x), bflo(xw.y), bfhi(xw.y)}, x1 = (f32x4){bflo(xw.z), bfhi(xw.z), bflo(xw.w), bfhi(xw.w)};
            const f32x4 g0 = *(const f32x4*)(gp + 32 * s), g1 = *(const f32x4*)(gp + 32 * s + 4);
            const f32x4 c0 = *(const f32x4*)(scp + 32 * s), c1 = *(const f32x4*)(scp + 32 * s + 4);
            const f32x4 s0 = *(const f32x4*)(shp + 32 * s), s1 = *(const f32x4*)(shp + 32 * s + 4);
            const f32x4 h0 = x0 * rstd * g0 * (c0 + 1.0f) + s0, h1 = x1 * rstd * g1 * (c1 + 1.0f) + s1;
            u32x4 hi, lo;
            hi.x = pk2(h0[0], h0[1]); hi.y = pk2(h0[2], h0[3]); hi.z = pk2(h1[0], h1[1]); hi.w = pk2(h1[2], h1[3]);
            lo.x = pk2(h0[0] - bflo(hi.x), h0[1] - bfhi(hi.x)); lo.y = pk2(h0[2] - bflo(hi.y), h0[3] - bfhi(hi.y));
            lo.z = pk2(h1[0] - bflo(hi.z), h1[1] - bfhi(hi.z)); lo.w = pk2(h1[2] - bflo(hi.w), h1[3] - bfhi(hi.w));
            { u32x2 h8; h8.x = pg8::pk4_fp8(h0[0], h0[1], h0[2], h0[3]); h8.y = pg8::pk4_fp8(h1[0], h1[1], h1[2], h1[3]); *(u32x2*)(hp + 32 * s) = h8; }
            const bf16x8 ah = __builtin_bit_cast(bf16x8, hi), al = __builtin_bit_cast(bf16x8, lo);
#pragma unroll
            for (int nt = 0; nt < 3; ++nt) {
                const bf16x8 bh = *(const LAS bf16x8*)(F.lds + bo[nt] + s * 64), bl = *(const LAS bf16x8*)(F.lds + RW_LO + bo[nt] + s * 64);
                acc[nt] = __builtin_amdgcn_mfma_f32_16x16x32_bf16(ah, bh, acc[nt], 0, 0, 0);
                acc[nt] = __builtin_amdgcn_mfma_f32_16x16x32_bf16(ah, bl, acc[nt], 0, 0, 0);
                acc[nt] = __builtin_amdgcn_mfma_f32_16x16x32_bf16(al, bh, acc[nt], 0, 0, 0);
            }
        }
#pragma unroll
        for (int hf = 0; hf < 2; ++hf) {
            if ((fq >> 1) == hf) {
#pragma unroll
                for (int nt = 0; nt < 3; ++nt) { const int n = 16 * nt + fr;
                    if (n < 36) {
#pragma unroll
                        for (int r = 0; r < 4; ++r) ex[((fq & 1) * 4 + r) * 36 + n] = acc[nt][r]; } }
            }
            asm volatile("s_waitcnt lgkmcnt(0)" ::: "memory");
            if (F.lane < 8) { float sl[36];
#pragma unroll
                for (int n = 0; n < 36; ++n) sl[n] = ex[F.lane * 36 + n] + rbias[n];
                route_row<DRY>(F, l, gi * 16 + hf * 8 + F.lane, sl, cnt, list); }
            asm volatile("s_waitcnt lgkmcnt(0)" ::: "memory");
        }
    }
    __syncthreads();
}

__device__ __forceinline__ unsigned off_b(unsigned row, unsigned ch) { return 256u * row + 16u * (ch ^ (((row & 3) << 2) | ((row >> 2) & 3))); }
__device__ __forceinline__ unsigned tr_base_p(unsigned lane) { const unsigned g = lane >> 4, q = (lane & 15) >> 2, p = lane & 3; return off_b(4 * g + q, (p >> 1)) + 8 * (p & 1); }
template <int O0, int O1, int O2, int O3>
__device__ __forceinline__ void tr_frag4(bf16x8 (&f)[4], unsigned a0, unsigned a1, unsigned a2, unsigned a3) {
    s16x4 l0, h0, l1, h1, l2, h2, l3, h3;
    asm volatile("ds_read_b64_tr_b16 %0, %8 offset:%12\n\tds_read_b64_tr_b16 %1, %8 offset:%16\n\t"
                 "ds_read_b64_tr_b16 %2, %9 offset:%13\n\tds_read_b64_tr_b16 %3, %9 offset:%17\n\t"
                 "ds_read_b64_tr_b16 %4, %10 offset:%14\n\tds_read_b64_tr_b16 %5, %10 offset:%18\n\t"
                 "ds_read_b64_tr_b16 %6, %11 offset:%15\n\tds_read_b64_tr_b16 %7, %11 offset:%19\n\ts_waitcnt lgkmcnt(0)"
                 : "=&v"(l0), "=&v"(h0), "=&v"(l1), "=&v"(h1), "=&v"(l2), "=&v"(h2), "=&v"(l3), "=&v"(h3)
                 : "v"(a0), "v"(a1), "v"(a2), "v"(a3), "n"(O0), "n"(O1), "n"(O2), "n"(O3), "n"(O0 + 4096), "n"(O1 + 4096), "n"(O2 + 4096), "n"(O3 + 4096) : "memory");
    f[0] = __builtin_shufflevector(l0, h0, 0, 1, 2, 3, 4, 5, 6, 7); f[1] = __builtin_shufflevector(l1, h1, 0, 1, 2, 3, 4, 5, 6, 7);
    f[2] = __builtin_shufflevector(l2, h2, 0, 1, 2, 3, 4, 5, 6, 7); f[3] = __builtin_shufflevector(l3, h3, 0, 1, 2, 3, 4, 5, 6, 7);
}
template <int O>
__device__ __forceinline__ void tr_frag8(bf16x8 (&f)[8], unsigned a) {
    s16x4 l0, h0, l1, h1, l2, h2, l3, h3, l4, h4, l5, h5, l6, h6, l7, h7;
    const unsigned a1 = a ^ 32u, a2 = a ^ 64u, a3 = a ^ 96u, a4 = a ^ 128u, a5 = a ^ 160u, a6 = a ^ 192u, a7 = a ^ 224u;
    asm volatile("ds_read_b64_tr_b16 %0, %8 offset:%12\n\tds_read_b64_tr_b16 %1, %8 offset:%13\n\t"
                 "ds_read_b64_tr_b16 %2, %9 offset:%12\n\tds_read_b64_tr_b16 %3, %9 offset:%13\n\t"
                 "ds_read_b64_tr_b16 %4, %10 offset:%12\n\tds_read_b64_tr_b16 %5, %10 offset:%13\n\t"
                 "ds_read_b64_tr_b16 %6, %11 offset:%12\n\tds_read_b64_tr_b16 %7, %11 offset:%13"
                 : "=&v"(l0), "=&v"(h0), "=&v"(l1), "=&v"(h1), "=&v"(l2), "=&v"(h2), "=&v"(l3), "=&v"(h3)
                 : "v"(a), "v"(a1), "v"(a2), "v"(a3), "n"(O), "n"(O + 4096) : "memory");
    asm volatile("ds_read_b64_tr_b16 %0, %16 offset:%20\n\tds_read_b64_tr_b16 %1, %16 offset:%21\n\t"
                 "ds_read_b64_tr_b16 %2, %17 offset:%20\n\tds_read_b64_tr_b16 %3, %17 offset:%21\n\t"
                 "ds_read_b64_tr_b16 %4, %18 offset:%20\n\tds_read_b64_tr_b16 %5, %18 offset:%21\n\t"
                 "ds_read_b64_tr_b16 %6, %19 offset:%20\n\tds_read_b64_tr_b16 %7, %19 offset:%21\n\ts_waitcnt lgkmcnt(0)"
                 : "=&v"(l4), "=&v"(h4), "=&v"(l5), "=&v"(h5), "=&v"(l6), "=&v"(h6), "=&v"(l7), "=&v"(h7),
                   "+v"(l0), "+v"(h0), "+v"(l1), "+v"(h1), "+v"(l2), "+v"(h2), "+v"(l3), "+v"(h3)
                 : "v"(a4), "v"(a5), "v"(a6), "v"(a7), "n"(O), "n"(O + 4096) : "memory");
    f[0] = __builtin_shufflevector(l0, h0, 0, 1, 2, 3, 4, 5, 6, 7); f[1] = __builtin_shufflevector(l1, h1, 0, 1, 2, 3, 4, 5, 6, 7);
    f[2] = __builtin_shufflevector(l2, h2, 0, 1, 2, 3, 4, 5, 6, 7); f[3] = __builtin_shufflevector(l3, h3, 0, 1, 2, 3, 4, 5, 6, 7);
    f[4] = __builtin_shufflevector(l4, h4, 0, 1, 2, 3, 4, 5, 6, 7); f[5] = __builtin_shufflevector(l5, h5, 0, 1, 2, 3, 4, 5, 6, 7);
    f[6] = __builtin_shufflevector(l6, h6, 0, 1, 2, 3, 4, 5, 6, 7); f[7] = __builtin_shufflevector(l7, h7, 0, 1, 2, 3, 4, 5, 6, 7);
}
#define LBAR() do { asm volatile("s_waitcnt lgkmcnt(0)" ::: "memory"); __builtin_amdgcn_s_barrier(); asm volatile("" ::: "memory"); } while (0)
__device__ __forceinline__ int chunk_row0(int b, int ci) { return ci < 2 ? NLAT + b * CT + ci * 128 : b * TL + (ci - 2) * 128; }
__device__ __forceinline__ float log2_gamma(float decay) { return -log1pf(expf(-decay)) * 1.4426950408889634f; }

template <int HALF>
__device__ __forceinline__ void pool_item(const LAS unsigned char* tile, bf16_t* A2, int t0, int T, int rbase, int rl, int cg) {
    const int t = t0 + rl; int cnt = 0;
    float s[8];
#pragma unroll
    for (int i = 0; i < 8; ++i) s[i] = 0.f;
    u32x4 c = (u32x4){0u, 0u, 0u, 0u};
#pragma unroll
    for (int w = 0; w < 2 * HALF; ++w) { const int tt = t - HALF + w; const bool ok = tt >= 0 && tt < T;
        u32x4 x = *(const LAS u32x4*)(tile + (rl + 8 - HALF + w) * 1024 + cg * 16); if (!ok) x = (u32x4){0u, 0u, 0u, 0u}; cnt += ok ? 1 : 0; if (w == HALF) c = x;
        s[0] += bflo(x.x); s[1] += bfhi(x.x); s[2] += bflo(x.y); s[3] += bfhi(x.y); s[4] += bflo(x.z); s[5] += bfhi(x.z); s[6] += bflo(x.w); s[7] += bfhi(x.w); }
    const float inv = 1.0f / (float)cnt;
    u32x4 o; o.x = pk2(s[0] * inv - bflo(c.x), s[1] * inv - bfhi(c.x)); o.y = pk2(s[2] * inv - bflo(c.y), s[3] * inv - bfhi(c.y));
    o.z = pk2(s[4] * inv - bflo(c.z), s[5] * inv - bfhi(c.z)); o.w = pk2(s[6] * inv - bflo(c.w), s[7] * inv - bfhi(c.w));
    *(u32x4*)(A2 + (size_t)(rbase + t) * D + 512 + cg * 8) = o;
}

__device__ __forceinline__ void p3a_states_pool(const Frame& F, int l) {
    const bf16_t* P = (const bf16_t*)(F.ws + WS_P);
    bf16_t* ST = (bf16_t*)(F.ws + WS_ACT);
    bf16_t* A2 = hbuf(F);
    const int nstate = (F.G > 128) ? 128 : F.G;
    if (F.bx < nstate) {
        for (int unit = F.bx; unit < 128; unit += nstate) {
            const int dir = unit & 1, bh = unit >> 1, b = bh >> 2, h = bh & 3;
            const float lg2 = log2_gamma((dir ? F.in[I_DB] : F.in[I_DF])[l * NH + h]);
            const float gC = exp2f(lg2 * 128.0f);
            f32x4 acc[8];
#pragma unroll
            for (int dt = 0; dt < 8; ++dt) acc[dt] = (f32x4){0.f, 0.f, 0.f, 0.f};
            u32x4 kr[8], vr[8];
#define P3A_CI(n_) (dir ? ((n_) < 2 ? 1 - (n_) : 19 - (n_)) : (n_))
#define P3A_LOAD(st_) do { _Pragma("unroll") for (int sub = 0; sub < 2; ++sub) { const int r0_ = chunk_row0(b, P3A_CI(2 * (st_) + sub)); \
                _Pragma("unroll") for (int q = 0; q < 4; ++q) { const int p = F.tid + 512 * q, j = p >> 4, ch = p & 15; \
                    kr[sub * 4 + q] = *(const u32x4*)(P + (size_t)(r0_ + j) * NP + 512 + h * 128 + ch * 8); vr[sub * 4 + q] = *(const u32x4*)(P + (size_t)(r0_ + j) * NP + 1024 + h * 128 + ch * 8); } } } while (0)
#define P3A_STORE(n_) do { bf16_t* sp = ST + ((size_t)((bh * 2 + dir) * NCHUNK + P3A_CI(n_)) * 128 + (F.wave * 16 + (F.lane & 15))) * 128 + 4 * (F.lane >> 4); \
                _Pragma("unroll") for (int dt = 0; dt < 8; ++dt) { u32x2 w; w.x = pk2(acc[dt][0], acc[dt][1]); w.y = pk2(acc[dt][2], acc[dt][3]); *(u32x2*)(sp + dt * 16) = w; } } while (0)
#define P3A_KS(KO, VO, ks) do { bf16x8 ka[8]; tr_frag8<(KO) + (ks) * 8192>(ka, tpk); \
                _Pragma("unroll") for (int dt = 0; dt < 8; ++dt) acc[dt] = __builtin_amdgcn_mfma_f32_16x16x32_bf16(ka[dt], vb[ks], acc[dt], 0, 0, 0); } while (0)
#define P3A_SUB(KO, VO) do { _Pragma("unroll") for (int dt = 0; dt < 8; ++dt) acc[dt] *= gC; \
                bf16x8 vb[4]; tr_frag4<(VO), (VO) + 8192, (VO) + 16384, (VO) + 24576>(vb, tpv, tpv, tpv, tpv); \
                P3A_KS(KO, VO, 0); P3A_KS(KO, VO, 1); P3A_KS(KO, VO, 2); P3A_KS(KO, VO, 3); } while (0)
            P3A_LOAD(0);
            for (int st = 0; st < 9; ++st) {
#pragma unroll
                for (int sub = 0; sub < 2; ++sub)
#pragma unroll
                    for (int q = 0; q < 4; ++q) { const int p = F.tid + 512 * q, j = p >> 4, ch = p & 15;
                        const float kd = __builtin_amdgcn_exp2f(lg2 * (float)(dir ? j : 127 - j));
                        const u32x4 kk = kr[sub * 4 + q];
                        u32x4 ks; ks.x = pk2(bflo(kk.x) * kd, bfhi(kk.x) * kd); ks.y = pk2(bflo(kk.y) * kd, bfhi(kk.y) * kd); ks.z = pk2(bflo(kk.z) * kd, bfhi(kk.z) * kd); ks.w = pk2(bflo(kk.w) * kd, bfhi(kk.w) * kd);
                        *(LAS u32x4*)(F.lds + sub * 32768 + off_b(j, ch)) = ks; *(LAS u32x4*)(F.lds + 65536 + sub * 32768 + off_b(j, ch)) = vr[sub * 4 + q]; }
                LBAR();
                if (st < 8) P3A_LOAD(st + 1);
                const unsigned tpk = (unsigned)(size_t)F.lds + tr_base_p(F.lane); const unsigned tpv = (tpk ^ ((unsigned)F.wave << 5)) + 65536u;
                P3A_STORE(2 * st);
                P3A_SUB(0, 0);
                P3A_STORE(2 * st + 1);
                if (st < 8) P3A_SUB(32768, 32768);
                LBAR();
            }
#undef P3A_SUB
#undef P3A_KS
#undef P3A_STORE
#undef P3A_LOAD
#undef P3A_CI
        }
    } else {
        const int pb = F.bx - nstate, npb = F.G - nstate;
        u32x4 ld[10];
#define POOL_LOAD(tile_) do { const int r0_ = (tile_) * 64; int t0_, T_, rb_; if (r0_ < NLAT) { t0_ = r0_ & (TL - 1); T_ = TL; } else { t0_ = (r0_ - NLAT) & (CT - 1); T_ = CT; } rb_ = r0_ - t0_; \
            _Pragma("unroll") for (int q = 0; q < 10; ++q) { const int p = F.tid + 512 * q, rr = p >> 6, ch = p & 63; int tt = t0_ - 8 + rr; tt = tt < 0 ? 0 : (tt >= T_ ? T_ - 1 : tt); \
                ld[q] = *(const u32x4*)(P + (size_t)(rb_ + tt) * NP + 2048 + ch * 8); } } while (0)
        if (pb < 576) POOL_LOAD(pb);
        for (int tile = pb; tile < 576; tile += npb) {
            const int r0 = tile * 64; int t0, T; if (r0 < NLAT) { t0 = r0 & (TL - 1); T = TL; } else { t0 = (r0 - NLAT) & (CT - 1); T = CT; } const int rbase = r0 - t0;
            LBAR();
#pragma unroll
            for (int q = 0; q < 10; ++q) { const int p = F.tid + 512 * q; *(LAS u32x4*)(F.lds + (p >> 6) * 1024 + (p & 63) * 16) = ld[q]; }
            LBAR();
            if (tile + npb < 576) POOL_LOAD(tile + npb);
            for (int wi = F.wave; wi < 64; wi += 8) { const int g = wi & 3, rl = (wi >> 2) * 4 + (F.lane >> 4), cg = g * 16 + (F.lane & 15);
                if (g == 0) pool_item<1>(F.lds, A2, t0, T, rbase, rl, cg); else if (g == 1) pool_item<2>(F.lds, A2, t0, T, rbase, rl, cg);
                else if (g == 2) pool_item<4>(F.lds, A2, t0, T, rbase, rl, cg); else pool_item<8>(F.lds, A2, t0, T, rbase, rl, cg); }
        }
#undef POOL_LOAD
    }
    __syncthreads();
}

__device__ __forceinline__ void p3b_retention(const Frame& F, int l) {
    const bf16_t* P = (const bf16_t*)(F.ws + WS_P);
    const bf16_t* ST = (const bf16_t*)(F.ws + WS_ACT);
    bf16_t* A2 = hbuf(F);
    const int c_lo = (l == DEPTH - 1) ? 2 : 0, ncu = NCHUNK - c_lo, nunits = 64 * ncu;
    u32x4 ld[8], st[8]; bf16x8 qf[4];
#define P3B_LOAD(unit_) do { const int bh_ = (unit_) / ncu, ci_ = c_lo + (unit_) % ncu, h_ = bh_ & 3; const int r0_ = chunk_row0(bh_ >> 2, ci_); \
        _Pragma("unroll") for (int q = 0; q < 4; ++q) { const int p = F.tid + 512 * q, j = p >> 4, ch = p & 15; \
            ld[q] = *(const u32x4*)(P + (size_t)(r0_ + j) * NP + 512 + h_ * 128 + ch * 8); ld[4 + q] = *(const u32x4*)(P + (size_t)(r0_ + j) * NP + 1024 + h_ * 128 + ch * 8); } } while (0)
#define P3B_LOADQ(unit_) do { const int bh_ = (unit_) / ncu, ci_ = c_lo + (unit_) % ncu, h_ = bh_ & 3; const int r0_ = chunk_row0(bh_ >> 2, ci_); \
        _Pragma("unroll") for (int ks = 0; ks < 4; ++ks) qf[ks] = *(const bf16x8*)(P + (size_t)(r0_ + F.wave * 16 + (F.lane & 15)) * NP + h_ * 128 + ks * 32 + (F.lane >> 4) * 8); } while (0)
    if (F.vcu < nunits) { P3B_LOAD(F.vcu); P3B_LOADQ(F.vcu); }
    for (int unit = F.vcu; unit < nunits; unit += F.G) {
        int lane_o = F.lane; asm volatile("" : "+v"(lane_o));
        const int fr = lane_o & 15, fq = lane_o >> 4;
        const unsigned rr0 = off_b((unsigned)fr, (unsigned)fq), tp = (unsigned)(size_t)F.lds + tr_base_p((unsigned)lane_o);
        const int il = F.wave * 16 + fr;
        const int bh = unit / ncu, ci = c_lo + unit % ncu, b = bh >> 2, h = bh & 3;
        const float lgf = log2_gamma(F.in[I_DF][l * NH + h]), lgb = log2_gamma(F.in[I_DB][l * NH + h]);
        const int row0 = chunk_row0(b, ci);
        { const bf16_t* sf = ST + ((size_t)((bh * 2 + 0) * NCHUNK + ci) * 128) * 128; const bf16_t* sb = ST + ((size_t)((bh * 2 + 1) * NCHUNK + ci) * 128) * 128;
#pragma unroll
          for (int q = 0; q < 4; ++q) { const int p = F.tid + 512 * q, j = p >> 4, ch = p & 15; st[q] = *(const u32x4*)(sf + (size_t)j * 128 + ch * 8); st[4 + q] = *(const u32x4*)(sb + (size_t)j * 128 + ch * 8); } }
        LBAR();
#pragma unroll
        for (int q = 0; q < 4; ++q) { const int p = F.tid + 512 * q, j = p >> 4, ch = p & 15; const unsigned o = off_b(j, ch);
            *(LAS u32x4*)(F.lds + o) = ld[q]; *(LAS u32x4*)(F.lds + 32768u + o) = ld[4 + q]; }
        LBAR();
        if (unit + F.G < nunits) P3B_LOAD(unit + F.G);
        u32x2 gg[8];
#pragma unroll
        for (int et = 0; et < 8; ++et) gg[et] = *(const u32x2*)(P + (size_t)(row0 + il) * NP + 1536 + h * 128 + 4 * fq + et * 16);
        bf16x8 pf[4];
#pragma unroll
        for (int ks2 = 0; ks2 < 4; ++ks2) {
            u32x2 half[2];
#pragma unroll
            for (int t = 0; t < 2; ++t) { const int jt = 2 * ks2 + t;
                asm volatile("" ::: "memory");
                f32x4 sa = (f32x4){0.f, 0.f, 0.f, 0.f};
#pragma unroll
                for (int ks = 0; ks < 4; ++ks) { const bf16x8 ka = *(const LAS bf16x8*)(F.lds + ((rr0 ^ ((unsigned)ks << 6)) + 4096u * jt)); sa = __builtin_amdgcn_mfma_f32_16x16x32_bf16(ka, qf[ks], sa, 0, 0, 0); }
                float pv[4];
#pragma unroll
                for (int r = 0; r < 4; ++r) { const int j = 16 * jt + 4 * fq + r, df = il - j;
                    const float w = df > 0 ? __builtin_amdgcn_exp2f(lgf * (float)df) : (df < 0 ? __builtin_amdgcn_exp2f(lgb * (float)(-df)) : 2.0f); pv[r] = sa[r] * w; }
                half[t].x = pk2(pv[0], pv[1]); half[t].y = pk2(pv[2], pv[3]); }
            const u32x4 w4 = (u32x4){half[0].x, half[0].y, half[1].x, half[1].y};
            pf[ks2] = __builtin_bit_cast(bf16x8, w4);
        }
#pragma unroll
        for (int q = 0; q < 4; ++q) { const int p = F.tid + 512 * q, j = p >> 4, ch = p & 15; const unsigned o = off_b(j, ch);
            *(LAS u32x4*)(F.lds + 65536u + o) = st[q]; *(LAS u32x4*)(F.lds + 98304u + o) = st[4 + q]; }
        LBAR();
        const float qdf = __builtin_amdgcn_exp2f(lgf * (float)(il + 1)), qdb = __builtin_amdgcn_exp2f(lgb * (float)(128 - il));
        float o[8][4]; float ss = 0.f;
#pragma unroll
        for (int et = 0; et < 8; ++et) {
            f32x4 ao = (f32x4){0.f, 0.f, 0.f, 0.f}, af = ao, ab = ao;
            bf16x8 va[4]; { const unsigned a = tp ^ ((unsigned)et << 5); tr_frag4<32768, 32768 + 8192, 32768 + 16384, 32768 + 24576>(va, a, a, a, a); }
#pragma unroll
            for (int ks = 0; ks < 4; ++ks) {
                ao = __builtin_amdgcn_mfma_f32_16x16x32_bf16(va[ks], pf[ks], ao, 0, 0, 0);
                const unsigned ra = (rr0 ^ ((unsigned)ks << 6)) + 4096u * et;
                const bf16x8 fa = *(const LAS bf16x8*)(F.lds + 65536u + ra);
                af = __builtin_amdgcn_mfma_f32_16x16x32_bf16(fa, qf[ks], af, 0, 0, 0);
                const bf16x8 ba = *(const LAS bf16x8*)(F.lds + 98304u + ra);
                ab = __builtin_amdgcn_mfma_f32_16x16x32_bf16(ba, qf[ks], ab, 0, 0, 0);
            }
#pragma unroll
            for (int r = 0; r < 4; ++r) { o[et][r] = ao[r] + qdf * af[r] + qdb * ab[r]; ss += o[et][r] * o[et][r]; }
        }
        if (unit + F.G < nunits) P3B_LOADQ(unit + F.G);
        ss += __shfl_xor(ss, 16); ss += __shfl_xor(ss, 32);
        const float rstd = 1.0f / sqrtf(ss * (1.0f / 128.0f) + EPS);
        bf16_t* op = A2 + (size_t)(row0 + il) * D + h * 128 + 4 * fq;
#pragma unroll
        for (int et = 0; et < 8; ++et) { const u32x2 g = gg[et];
            u32x2 w; w.x = pk2(silu_f(bflo(g.x)) * o[et][0] * rstd, silu_f(bfhi(g.x)) * o[et][1] * rstd); w.y = pk2(silu_f(bflo(g.y)) * o[et][2] * rstd, silu_f(bfhi(g.y)) * o[et][3] * rstd);
            *(u32x2*)(op + et * 16) = w; }
    }
#undef P3B_LOAD
#undef P3B_LOADQ
    __syncthreads();
}

#ifndef TYPE_MASK
#define TYPE_MASK 0x3ff
#endif
#define PTYPE(k) ((k) == 0 ? 0 : ((k) == 17 ? 9 : 1 + (((k) - 1) & 7)))
#define ENTER() do { if (PROBE_REPEAT >= 0) __syncthreads(); int _t = threadIdx.x; asm volatile("" : "+v"(_t)); F.tid = _t; F.lane = _t & 63; F.wave = __builtin_amdgcn_readfirstlane(_t >> 6); } while (0)
#define IN(k) (((TYPE_MASK >> PTYPE(k)) & 1) && lo <= (k) && (k) < hi)
#define SEAM(k) do { if (IN(k) && IN((k) + 1)) xcd_barrier(bar); } while (0)
#define REP(t) for (int rep = (PROBE_REPEAT == (t)) ? 0 : 1; rep < 2; ++rep)


template <int l> __device__ __forceinline__ void layer_phases(Frame& F, const XcdBarrier& bar, const int lo, const int hi) {
        const int pb = 1 + 8 * l;
        const bool last = (l == DEPTH - 1);
        const int Mrows = last ? NLAT : NTOK;
        if (IN(pb + 0)) REP(1) { ENTER(); row_op_a(F, l == 0 ? 0 : 1, rep == 0); }
        SEAM(pb + 0);
        if (IN(pb + 1)) REP(2) { ENTER();
            pg8::SchedDense S; S.init(NTOK, NP, D, F.G, F.bx);
            pg8::EpiInProj E{(bf16_t*)(F.ws + WS_P), (const float*)(F.ws + WS_ROPE), (const float*)(F.ws + WS_ROPE) + 96 * 32};
            pg8::gemm_phase<pg8::EpiInProj, pg8::SchedDense, true, true>(F.lds, F.tid, (const char*)hbuf(F), (const char*)(F.ws + WS_WIN) + (size_t)l * NP * D * 2, D, S, E);
        }
        SEAM(pb + 1);
        if (IN(pb + 2)) REP(3) { ENTER(); p3a_states_pool(F, l); }
        SEAM(pb + 2);
        if (IN(pb + 3)) REP(4) { ENTER(); p3b_retention(F, l); }
        SEAM(pb + 3);
        if (IN(pb + 4)) REP(5) { ENTER();
            pg8::SchedDense S; S.init(Mrows, D, D, F.G, F.bx);
            pg8::EpiResid E;
            if (l == 0) { E.rl = F.in[I_X]; E.rc = F.in[I_CTX]; E.rb = nullptr; } else { E.rl = nullptr; E.rc = nullptr; E.rb = (const bf16_t*)(F.ws + WS_XB); }
            E.ob = (rep == 0) ? (bf16_t*)(F.ws + WS_P) : (bf16_t*)(F.ws + WS_XB); E.ssq = (float*)(F.ws + WS_SSQ); E.gmod = mod_ptr(F, l, 0, 2);
            pg8::gemm_phase<pg8::EpiResid, pg8::SchedDense, true, true>(F.lds, F.tid, (const char*)hbuf(F), (const char*)(F.ws + WS_WOUT) + (size_t)l * D * D * 2, D, S, E);
        }
        SEAM(pb + 4);
        if (IN(pb + 5)) REP(6) { ENTER(); if (PROBE_REPEAT == 6 && rep == 0) row_op_b<true>(F, l); else row_op_b<false>(F, l); }
        SEAM(pb + 5);
        if (IN(pb + 6)) REP(7) { ENTER();
            LAS int* tb = build_tb(F, l);
            LAS int* tokt = (LAS int*)(F.lds + TOKT_OFF);
            const int* list = (const int*)(F.ws + WS_LIST);
            pg8::SchedGroup S; S.tb = tb; S.tokt = tokt; S.G = F.G; S.c = F.vcu; S.pitch = D; S.gather = 1;
            { int tokv[8];
#pragma unroll
              for (int i = 0; i < 8; ++i) { pg8::Unit u; tokv[i] = -1;
                  if (S.next(i, u)) { const int g = u.pm; const int e = (int)__popcll(__ballot(F.lane < NE && tb[F.lane + 1] <= g)); const int rt = g - tb[e], cnt = tb[64 + e];
                      if (F.tid < 256) { int r = rt * 256 + F.tid; if (r >= cnt) r = cnt - 1; tokv[i] = list[(size_t)e * NTOK + r]; } } }
#pragma unroll
              for (int i = 0; i < 8; ++i) if (F.tid < 256 && tokv[i] >= 0) tokt[i * 256 + F.tid] = tokv[i]; }
            __syncthreads();
            pg8::EpiSwiGLU8 E{(unsigned char*)(F.ws + WS_ACT), 1.0f / WGU_SCALE};
            pg8::gemm_phase<pg8::EpiSwiGLU8, pg8::SchedGroup, true, true, true>(F.lds, F.tid, (const char*)hbuf(F), (const char*)(F.ws + WS_WGU) + (size_t)l * NE * 1024 * D, D, S, E);
        }
        SEAM(pb + 6);
        if (IN(pb + 7)) REP(8) { ENTER();
            LAS int* tb = build_tb(F, l);
            pg8::SchedGroup S; S.tb = tb; S.tokt = nullptr; S.G = F.G; S.c = F.vcu; S.pitch = FF; S.gather = 0;
            pg8::EpiFp8S E{(unsigned char*)(F.ws + WS_P), D, 1.0f / WD_SCALE};
            pg8::gemm_phase<pg8::EpiFp8S, pg8::SchedGroup, true, true, true>(F.lds, F.tid, (const char*)(F.ws + WS_ACT), (const char*)(F.ws + WS_WD) + (size_t)l * NE * D * FF, FF, S, E);
        }
        SEAM(pb + 7);
}

__global__ void __launch_bounds__(512, 2) fwd_kernel(Args args) {
    extern __shared__ __attribute__((aligned(16))) unsigned char lds_raw[];
    Frame F;
    F.lds = (LAS unsigned char*)lds_raw; F.tid = threadIdx.x; F.lane = F.tid & 63; F.wave = __builtin_amdgcn_readfirstlane(F.tid >> 6);
    F.G = gridDim.x; F.bx = blockIdx.x; F.vcu = (F.G % 8 == 0) ? (F.bx % 8) * (F.G / 8) + F.bx / 8 : F.bx;
    F.in = args.in; F.out = args.out; F.ws = args.ws;
    volatile LAS unsigned* MISC = (volatile LAS unsigned*)(F.lds + MISC_OFF);
    if (F.tid < 4) MISC[F.tid] = 0u;
    __syncthreads();
    unsigned* ctl = (unsigned*)(F.ws + WS_CTL);
    XcdBarrier bar; bar.bar = ctl + CW_BAR; bar.x = 0; bar.st = nullptr;
    const int lo = args.ph_lo, hi = args.ph_hi;
    const bool multi = (hi - lo) > 1;
    if (multi) bar = xcd_barrier_post(ctl + CW_BAR, MISC);
    if (IN(0)) REP(0) { ENTER(); p0_prologue(F, rep); }
    SEAM(0);
    layer_phases<0>(F, bar, lo, hi);
    layer_phases<1>(F, bar, lo, hi);
    if (IN(17)) REP(9) { ENTER(); row_op_a(F, 2, rep == 0); }
#undef IN
#undef SEAM
}

extern "C" void kernel_launch(void* const* d_in, const int* in_sizes, int n_in, void* d_out, int out_size, void* d_ws, size_t ws_size, hipStream_t stream) {
    static int grid = 0;
    if (grid == 0) {
        if (n_in != 22 || out_size != NLAT * D || ws_size < WS_END) { fprintf(stderr, "kernel_launch: unexpected shapes (n_in %d, out %d, ws %zu)\n", n_in, out_size, ws_size); grid = -1; return; }
        int dev = 0, cus = 0, per_cu = 0;
        if (hipGetDevice(&dev) != hipSuccess || hipDeviceGetAttribute(&cus, hipDeviceAttributeMultiprocessorCount, dev) != hipSuccess) { grid = -1; return; }
        if (hipFuncSetAttribute((const void*)fwd_kernel, hipFuncAttributeMaxDynamicSharedMemorySize, LDS_BYTES) != hipSuccess) { fprintf(stderr, "kernel_launch: hipFuncSetAttribute failed\n"); grid = -1; return; }
        if (hipOccupancyMaxActiveBlocksPerMultiprocessor(&per_cu, (const void*)fwd_kernel, 512, LDS_BYTES) != hipSuccess || per_cu < 1) { fprintf(stderr, "kernel_launch: occupancy query says %d\n", per_cu); }
        (void)hipGetLastError();
        grid = cus;
    }
    if (grid < 0) return;
    (void)hipMemsetAsync((char*)d_ws + WS_CTL, 0, CTL_ZERO_BYTES, stream);
    Args a{};
    for (int i = 0; i < 22; ++i) a.in[i] = (const float*)d_in[i];
    a.out = (float*)d_out; a.ws = (unsigned char*)d_ws;
    if (MK_N_LAUNCHES == 1) { a.ph_lo = 0; a.ph_hi = N_PHASES; hipLaunchKernelGGL(fwd_kernel, dim3(grid), dim3(512), LDS_BYTES, stream, a); }
    else { for (int p = 0; p < N_PHASES; ++p) { a.ph_lo = p; a.ph_hi = p + 1; hipLaunchKernelGGL(fwd_kernel, dim3(grid), dim3(512), LDS_BYTES, stream, a); } }
}
```

```cpp
#include <hip/hip_runtime.h>
#include <cstdio>
#include <cstdint>

#ifndef MK_N_LAUNCHES
#define MK_N_LAUNCHES 1
#endif

#ifndef PROBE_REPEAT
#define PROBE_REPEAT -1
#endif
#define LAS __attribute__((address_space(3)))
#define GAS __attribute__((address_space(1)))
typedef unsigned short bf16_t;
typedef short bf16x8 __attribute__((ext_vector_type(8)));
typedef short s16x4 __attribute__((ext_vector_type(4)));
typedef float f32x4 __attribute__((ext_vector_type(4)));
typedef float f32x2 __attribute__((ext_vector_type(2)));
typedef unsigned u32x4 __attribute__((ext_vector_type(4)));
typedef unsigned u32x2 __attribute__((ext_vector_type(2)));

constexpr int Bn = 16, TL = 2048, CT = 256, D = 1024, DEPTH = 2;
constexpr int NLAT = Bn * TL, NCTX = Bn * CT, NTOK = NLAT + NCTX;
constexpr int NP = 2560;
constexpr int NE = 32, FF = 512, NH = 4, HD = 128;
constexpr int NCHUNK = 18;
constexpr float EPS = 1e-6f;
constexpr int MAXTILES = 320;
constexpr int N_PHASES = 18;

constexpr size_t MiB = 1u << 20;
constexpr size_t WS_CTL = 0, CTL_ZERO_BYTES = 1 * MiB;
constexpr size_t WS_MOD = 1 * MiB;
constexpr size_t WS_ROPE = 2 * MiB;
constexpr size_t WS_RIMG = 2 * MiB + 65536;
constexpr size_t WS_TOKINFO = 3 * MiB;
constexpr size_t WS_LIST = 5 * MiB;
constexpr size_t WS_WIN = 10 * MiB;
constexpr size_t WS_WOUT = 20 * MiB;
constexpr size_t WS_WGU = 24 * MiB;
constexpr size_t WS_WD = 152 * MiB;
constexpr size_t WS_SSQ = 216 * MiB;
constexpr size_t WS_XB = 232 * MiB;
constexpr size_t WS_P = 304 * MiB;
constexpr size_t WS_ACT = 484 * MiB;
constexpr size_t WS_END = 564 * MiB;
constexpr int CW_TMO = 0;
constexpr int CW_QUEUE = 512;
constexpr int CW_CNT = 1024;
constexpr int CW_BAR = 4096;

constexpr int RING_BYTES = 131072;
constexpr int TOKT_OFF = RING_BYTES;
constexpr int MISC_OFF = 161792;
constexpr int RW_PITCH = 2064;
constexpr int RW_LO = 36 * RW_PITCH, RW_EX = 2 * 36 * RW_PITCH;
constexpr int LDS_BYTES = 163840;

__device__ __forceinline__ unsigned f2bf(float f) { unsigned u = __builtin_bit_cast(unsigned, f); return (u + 0x7fffu + ((u >> 16) & 1u)) >> 16; }
typedef __bf16 bf16x2_t __attribute__((ext_vector_type(2)));
__device__ __forceinline__ unsigned pk2(float lo, float hi) { const f32x2 f = {lo, hi}; const bf16x2_t v = __builtin_convertvector(f, bf16x2_t); return __builtin_bit_cast(unsigned, v); }
__device__ __forceinline__ float bflo(unsigned w) { return __builtin_bit_cast(float, w << 16); }
__device__ __forceinline__ float bfhi(unsigned w) { return __builtin_bit_cast(float, w & 0xffff0000u); }
__device__ __forceinline__ float wave_sum(float v) {
#pragma unroll
    for (int o = 1; o < 64; o <<= 1) v += __shfl_xor(v, o);
    return v;
}
__device__ __forceinline__ float silu_f(float x) { return x * __builtin_amdgcn_rcpf(1.0f + __builtin_amdgcn_exp2f(-1.4426950408889634f * x)); }

#define XB_TMO      128
#define XB_XCNT(j)  (256  + 64 * (j))
#define XB_XSUB(j)  (1280 + 64 * (j))
#define XB_XGEN(j)  (2304 + 64 * (j))
#define XB_TOP      3328
#define XB_TOPGEN   3392
#define XCD_BAR_WORDS 3456
#define XB_SPIN_CAP (1u << 18)
__device__ __forceinline__ unsigned xb_ld(unsigned* p)              { return __hip_atomic_load(p, __ATOMIC_RELAXED, __HIP_MEMORY_SCOPE_AGENT); }
__device__ __forceinline__ unsigned xb_add(unsigned* p, unsigned v) { return __hip_atomic_fetch_add(p, v, __ATOMIC_RELAXED, __HIP_MEMORY_SCOPE_AGENT); }
__device__ __forceinline__ unsigned xb_xcc_id() { return (unsigned)__builtin_amdgcn_s_getreg((3 << 11) | 20) & 0xFu; }
#define XB_SPIN(cond, bar) do { unsigned _sp = 0; while (cond) { __builtin_amdgcn_s_sleep(1); \
    if ((++_sp & 255u) == 0u) { if (xb_ld(&(bar)[XB_TMO])) break; if (_sp > XB_SPIN_CAP) { atomicAdd(&(bar)[XB_TMO], 1u); break; } } } } while (0)
struct XcdBarrier { unsigned* bar; unsigned x; volatile LAS unsigned* st; };
__device__ __forceinline__ XcdBarrier xcd_barrier_post(unsigned* bar, volatile LAS unsigned* st) {
    XcdBarrier b; b.bar = bar; b.x = xb_xcc_id(); b.st = st;
    if (threadIdx.x == 0) (void)xb_add(&bar[XB_XCNT(b.x)], 1u);
    return b;
}
__device__ __forceinline__ void xcd_barrier_complete(unsigned* bar, unsigned x, unsigned& nloc, unsigned& nx) {
    const unsigned G = gridDim.x * gridDim.y * gridDim.z;
    unsigned sum, cnt, mine, sp = 0u;
    for (;;) {
        sum = 0u; cnt = 0u; mine = 0u;
#pragma unroll
        for (unsigned j = 0; j < 16; ++j) { const unsigned c = xb_ld(&bar[XB_XCNT(j)]); sum += c; cnt += (c > 0u) ? 1u : 0u; mine = (j == x) ? c : mine; }
        if (sum == G) break;
        __builtin_amdgcn_s_sleep(1);
        if ((++sp & 255u) == 0u) { if (xb_ld(&bar[XB_TMO])) break; if (sp > XB_SPIN_CAP) { atomicAdd(&bar[XB_TMO], 1u); break; } }
    }
    nloc = mine > 0u ? mine : 1u; nx = cnt > 0u ? cnt : 1u;
}
__device__ __forceinline__ void xcd_barrier(const XcdBarrier& b) {
    asm volatile("s_waitcnt vmcnt(0)" ::: "memory");
    __syncthreads();
    if (threadIdx.x == 0) {
        unsigned* bar = b.bar;
        __builtin_amdgcn_s_waitcnt(0);
        unsigned nloc = b.st[0], nx = b.st[1];
        if (nloc == 0u) { xcd_barrier_complete(bar, b.x, nloc, nx); b.st[0] = nloc; b.st[1] = nx; }
        const unsigned old = xb_add(&bar[XB_XSUB(b.x)], 1u);
        const unsigned gen = old / nloc;
        if (old + 1u == (gen + 1u) * nloc) {
            __builtin_amdgcn_fence(__ATOMIC_RELEASE, "agent");
            asm volatile("s_waitcnt vmcnt(0)" ::: "memory");
            const unsigned og = xb_add(&bar[XB_TOP], 1u);
            const unsigned tg = og / nx;
            if (og + 1u == (tg + 1u) * nx) xb_add(&bar[XB_TOPGEN], 1u);
            else XB_SPIN(xb_ld(&bar[XB_TOPGEN]) == tg, bar);
            __builtin_amdgcn_fence(__ATOMIC_ACQUIRE, "agent");
            xb_add(&bar[XB_XGEN(b.x)], 1u);
            asm volatile("s_waitcnt vmcnt(0)" ::: "memory");
        } else {
            XB_SPIN(xb_ld(&bar[XB_XGEN(b.x)]) == gen, bar);
            __builtin_amdgcn_fence(__ATOMIC_ACQUIRE, "agent");
            asm volatile("s_waitcnt vmcnt(0)" ::: "memory");
        }
    }
    __syncthreads();
}

namespace pg8 {
constexpr int BM = 256, BK = 64, HALF = 128, HTB = HALF * BK * 2, STAGE_BYTES = 8 * HTB, NXCD = 8, WGM = 8;
__device__ __forceinline__ int lds_byte(int r, int c) { const int st = (r >> 4) * 2 + (c >> 5), rr = r & 15, cc = c & 31, ob = rr * 64 + cc * 2; return st * 1024 + (ob ^ (((ob >> 9) & 1) << 5)); }
__device__ __forceinline__ void stage_rc(int b, int& R, int& C) { const int st = b / 1024, sb = b % 1024, swz = sb ^ (((sb >> 9) & 1) << 5); R = (st >> 1) * 16 + swz / 64; C = (st & 1) * 32 + (swz % 64) / 2; }
__device__ __forceinline__ int perm32(int rho) { const int n = rho >> 4, i = rho & 15; return 8 * (i >> 2) + 4 * n + (i & 3); }

struct Unit { int pm, pn; unsigned bofs; int aux; };

struct SchedDense {
    int nM, nN, nwg, G, c, K;
    __device__ void init(int M, int N, int K_, int G_, int c_) { nM = M / BM; nN = N / BM; nwg = nM * nN; G = G_; c = c_; K = K_; }
    __device__ bool next(int i, Unit& u) const {
        const long L = (long)i * G + c; if (L >= nwg) return false;
        int wgid = (int)L; { const int q = nwg / NXCD, r = nwg % NXCD, xcd = wgid % NXCD, off = wgid / NXCD; wgid = (xcd < r ? xcd * (q + 1) : r * (q + 1) + (xcd - r) * q) + off; }
        const int nig = WGM * nN, gid = wgid / nig, fm = gid * WGM, gsz = (nM - fm) < WGM ? (nM - fm) : WGM;
        u.pm = fm + ((wgid % nig) % gsz); u.pn = (wgid % nig) / gsz; u.bofs = (unsigned)u.pn * (unsigned)(BM * K * 2); u.aux = 0; return true;
    }
    __device__ __forceinline__ unsigned a_row(const Unit& u, int r) const { return (unsigned)(u.pm * BM + r); }
};
struct SchedGroup {
    const LAS int* tb; const LAS int* tokt; int G, c, pitch, gather;
    __device__ bool next(int i, Unit& u) const {
        const int L = i * G + c, nt = tb[NE]; if (L >= nt * 4) return false;
        const int g = L >> 2; const int ln = (int)(threadIdx.x & 63u);
        const int e = (int)__popcll(__ballot(ln < NE && tb[ln + 1] <= g));
        u.pm = g; u.pn = L & 3; u.bofs = (unsigned)(e * 1024 + u.pn * BM) * (unsigned)pitch; u.aux = i; return true;
    }
    __device__ __forceinline__ unsigned a_row(const Unit& u, int r) const { return gather ? (unsigned)tokt[u.aux * 256 + r] : (unsigned)(u.pm * BM + r); }
};

__device__ __forceinline__ unsigned cvt_pk_bf16(float lo, float hi) { unsigned r; asm volatile("v_cvt_pk_bf16_f32 %0, %1, %2" : "=v"(r) : "v"(lo), "v"(hi)); return r; }

typedef int i32x4 __attribute__((ext_vector_type(4)));
typedef int i32x8 __attribute__((ext_vector_type(8)));
template <bool F8> struct Frag { bf16x8 k[2]; };
template <> struct Frag<true> { i32x8 v; };
template <class Epi, class Sched, bool ALIGN_EPI, bool SP2, bool F8 = false>
__device__ __forceinline__ void gemm_phase(LAS unsigned char* lds, const int tid, const char* Abase, const char* Bbase, const int K, const Sched& S, const Epi& E) {
    const int wid = __builtin_amdgcn_readfirstlane(tid >> 6), lane = tid & 63, wr = wid >> 2, wc = wid & 3, fr = lane & 15, fq = lane >> 4;
    const int nt = F8 ? K / 128 : K / BK; const unsigned pitch = F8 ? (unsigned)K : 2u * (unsigned)K;
    int Rr[2], Cc[2]; unsigned voffB[2];
#pragma unroll
    for (int i = 0; i < 2; ++i) { int R, C; stage_rc(tid * 16 + i * 8192, R, C); const int Rb = Epi::PERM ? ((R & ~31) + perm32(R & 31)) : R;
        Rr[i] = R; Cc[i] = C; voffB[i] = (unsigned)Rb * pitch + 2u * (unsigned)C; }
    const size_t kstep = (size_t)(BK * 2);
    const size_t hstep = (size_t)HALF * pitch;
    const unsigned ldsw = (unsigned)wid * 1024u;
    const int fcol = F8 ? (fq >> 1) * 32 + (fq & 1) * 16 : fq * 8;
    const int aoff = lds_byte(wr * 64 + fr, fcol), boff = lds_byte(wc * 32 + fr, fcol);
#define PG8_SA(b, h) (((b) * 2 + (h)) * HTB)
#define PG8_SB(b, h) ((4 + (b) * 2 + (h)) * HTB)
#define PG8_STAGE(bufoff, gbase, voff) do { _Pragma("unroll") for (int _i = 0; _i < 2; ++_i) \
        __builtin_amdgcn_global_load_lds((const unsigned*)((const char*)(gbase) + (voff)[_i]), (LAS unsigned*)(lds + (bufoff) + ldsw + _i * 8192), 16, 0, 0); } while (0)
#define PG8_LDF(dstf, off_) do { if constexpr (F8) { const i32x4 _lo = *(const LAS i32x4*)(lds + (off_)), _hi = *(const LAS i32x4*)(lds + (off_) + 16); dstf.v = __builtin_shufflevector(_lo, _hi, 0, 1, 2, 3, 4, 5, 6, 7); } \
        else { dstf.k[0] = *(const LAS bf16x8*)(lds + (off_)); dstf.k[1] = *(const LAS bf16x8*)(lds + (off_) + 1024); } } while (0)
#define PG8_LDA(dst, b, h) do { _Pragma("unroll") for (int m = 0; m < 4; ++m) PG8_LDF(dst[m], PG8_SA(b, h) + aoff + m * 2048); } while (0)
#define PG8_LDB(dst, b, h) do { _Pragma("unroll") for (int n = 0; n < 2; ++n) PG8_LDF(dst[n], PG8_SB(b, h) + boff + n * 2048); } while (0)
#define PG8_MMA(ai, bj, At, Bt) do { __builtin_amdgcn_s_setprio(1); _Pragma("unroll") for (int m = 0; m < 4; ++m) _Pragma("unroll") for (int n = 0; n < 2; ++n) { \
        if constexpr (F8) asm volatile("v_mfma_f32_16x16x128_f8f6f4 %0, %1, %2, %0" : "+v"(acc[ai][bj][m][n]) : "v"(Bt[n].v), "v"(At[m].v));   \
        else { _Pragma("unroll") for (int k = 0; k < 2; ++k) acc[ai][bj][m][n] = __builtin_amdgcn_mfma_f32_16x16x32_bf16(Bt[n].k[k], At[m].k[k], acc[ai][bj][m][n], 0, 0, 0); } } \
        __builtin_amdgcn_s_setprio(0); } while (0)
#define PG8_WAIT_V(n) asm volatile("s_waitcnt vmcnt(" #n ")" ::: "memory")
#define PG8_WAIT_L(n) asm volatile("s_waitcnt lgkmcnt(" #n ")" ::: "memory")
#define PG8_BAR __builtin_amdgcn_s_barrier()
#define PG8_SCHED __builtin_amdgcn_sched_barrier(0)
#define PG8_AOFF(dst, u) do { _Pragma("unroll") for (int _h = 0; _h < 2; ++_h) _Pragma("unroll") for (int _i = 0; _i < 2; ++_i) \
        dst[_h][_i] = S.a_row(u, _h * HALF + Rr[_i]) * pitch + 2u * (unsigned)Cc[_i]; } while (0)
    Unit cur, nxt; int ui = 0;
    if (!S.next(0, cur)) return;
    f32x4 acc[2][2][4][2];
#pragma unroll
    for (int a = 0; a < 2; ++a)
#pragma unroll
        for (int b = 0; b < 2; ++b)
#pragma unroll
            for (int m = 0; m < 4; ++m)
#pragma unroll
                for (int n = 0; n < 2; ++n) acc[a][b][m][n] = (f32x4){0.f, 0.f, 0.f, 0.f};
    Frag<F8> At[4], B0[2], B1[2];
    unsigned co[2][2], no[2][2];
    PG8_AOFF(co, cur);
    const char* cB = Bbase + cur.bofs;
    if constexpr (SP2) {
        PG8_STAGE(PG8_SB(0, 0), cB, voffB); PG8_STAGE(PG8_SB(0, 1), cB + hstep, voffB); PG8_STAGE(PG8_SA(0, 0), Abase, co[0]); PG8_STAGE(PG8_SA(0, 1), Abase, co[1]);
        if (wr == 1) PG8_BAR;
        PG8_WAIT_V(2); PG8_BAR;
        PG8_STAGE(PG8_SB(1, 0), cB + kstep, voffB); PG8_STAGE(PG8_SA(1, 0), Abase + kstep, co[0]); PG8_STAGE(PG8_SB(1, 1), cB + hstep + kstep, voffB);
        PG8_WAIT_V(6); PG8_BAR;
    } else {
        PG8_STAGE(PG8_SB(0, 0), cB, voffB); PG8_STAGE(PG8_SA(0, 0), Abase, co[0]); PG8_STAGE(PG8_SB(0, 1), cB + hstep, voffB); PG8_STAGE(PG8_SA(0, 1), Abase, co[1]);
        if (wr == 1) PG8_BAR;
        PG8_WAIT_V(4); PG8_BAR;
        PG8_STAGE(PG8_SB(1, 0), cB + kstep, voffB); PG8_STAGE(PG8_SA(1, 0), Abase + kstep, co[0]); PG8_STAGE(PG8_SB(1, 1), cB + hstep + kstep, voffB);
        PG8_WAIT_V(6); PG8_BAR;
    }
    for (;;) {
        const bool has_next = S.next(ui + 1, nxt);
        const char* nB = has_next ? Bbase + nxt.bofs : cB;
        if (has_next) { PG8_AOFF(no, nxt); } else {
#pragma unroll
            for (int h = 0; h < 2; ++h)
#pragma unroll
                for (int i = 0; i < 2; ++i) no[h][i] = co[h][i]; }
#pragma unroll 1
        for (int t = 0; t < nt; t += 2) {
            const bool last = (t == nt - 2);
            const char* a1 = Abase + (size_t)(t + 1) * kstep;
            const char* a2 = last ? Abase : Abase + (size_t)(t + 2) * kstep; const char* b2 = last ? nB : cB + (size_t)(t + 2) * kstep;
            const char* a3 = a2 + kstep; const char* b3 = b2 + kstep;
            unsigned o2[2][2];
#pragma unroll
            for (int h = 0; h < 2; ++h)
#pragma unroll
                for (int i = 0; i < 2; ++i) o2[h][i] = last ? no[h][i] : co[h][i];
            if constexpr (SP2) {
            PG8_LDB(B0, 0, 0); PG8_LDB(B1, 0, 1); PG8_SCHED; PG8_LDA(At, 0, 0); PG8_STAGE(PG8_SA(1, 1), a1, co[1]);
            PG8_WAIT_V(8); PG8_WAIT_L(0); PG8_BAR; PG8_MMA(0, 0, At, B0); PG8_MMA(0, 1, At, B1); PG8_BAR; PG8_SCHED;
            PG8_LDA(At, 0, 1); PG8_STAGE(PG8_SB(0, 0), b2, voffB); PG8_STAGE(PG8_SB(0, 1), b2 + hstep, voffB); PG8_STAGE(PG8_SA(0, 0), a2, o2[0]);
            PG8_WAIT_V(8); PG8_WAIT_L(0); PG8_BAR; PG8_MMA(1, 0, At, B0); PG8_MMA(1, 1, At, B1); PG8_BAR; PG8_SCHED;
            PG8_LDB(B0, 1, 0); PG8_LDB(B1, 1, 1); PG8_SCHED; PG8_LDA(At, 1, 0); PG8_STAGE(PG8_SA(0, 1), a2, o2[1]);
            PG8_WAIT_V(8); PG8_WAIT_L(0); PG8_BAR; PG8_MMA(0, 0, At, B0); PG8_MMA(0, 1, At, B1); PG8_BAR; PG8_SCHED;
            PG8_LDA(At, 1, 1); PG8_STAGE(PG8_SB(1, 0), b3, voffB); PG8_STAGE(PG8_SB(1, 1), b3 + hstep, voffB); PG8_STAGE(PG8_SA(1, 0), a3, o2[0]);
            PG8_WAIT_V(8); PG8_WAIT_L(0); PG8_BAR; PG8_MMA(1, 0, At, B0); PG8_MMA(1, 1, At, B1); PG8_BAR; PG8_SCHED;
            } else {
            PG8_LDB(B0, 0, 0); PG8_SCHED; PG8_LDA(At, 0, 0); PG8_STAGE(PG8_SA(1, 1), a1, co[1]);
            PG8_WAIT_L(8); PG8_BAR; PG8_WAIT_L(0); PG8_MMA(0, 0, At, B0); PG8_BAR; PG8_SCHED;
            PG8_LDB(B1, 0, 1); PG8_STAGE(PG8_SB(0, 0), b2, voffB);
            PG8_BAR; PG8_WAIT_L(0); PG8_MMA(0, 1, At, B1); PG8_BAR;
            PG8_LDA(At, 0, 1); PG8_STAGE(PG8_SA(0, 0), a2, o2[0]);
            PG8_BAR; PG8_WAIT_L(0); PG8_MMA(1, 0, At, B0); PG8_BAR; PG8_SCHED;
            PG8_STAGE(PG8_SB(0, 1), b2 + hstep, voffB);
            PG8_WAIT_V(6); PG8_BAR; PG8_MMA(1, 1, At, B1); PG8_BAR;
            PG8_LDB(B0, 1, 0); PG8_SCHED; PG8_LDA(At, 1, 0); PG8_STAGE(PG8_SA(0, 1), a2, o2[1]);
            PG8_WAIT_L(8); PG8_BAR; PG8_WAIT_L(0); PG8_MMA(0, 0, At, B0); PG8_BAR; PG8_SCHED;
            PG8_LDB(B1, 1, 1); PG8_STAGE(PG8_SB(1, 0), b3, voffB);
            PG8_BAR; PG8_WAIT_L(0); PG8_MMA(0, 1, At, B1); PG8_BAR;
            PG8_LDA(At, 1, 1); PG8_STAGE(PG8_SA(1, 0), a3, o2[0]);
            PG8_BAR; PG8_WAIT_L(0); PG8_MMA(1, 0, At, B0); PG8_BAR; PG8_SCHED;
            PG8_STAGE(PG8_SB(1, 1), b3 + hstep, voffB);
            PG8_WAIT_V(6); PG8_BAR; PG8_MMA(1, 1, At, B1); PG8_BAR;
            }
        }
        if constexpr (ALIGN_EPI) { if (wr == 0) PG8_BAR; }
        if constexpr (F8) { __builtin_amdgcn_sched_barrier(0); asm volatile("s_nop 15\n\ts_nop 15\n\ts_nop 7" ::: "memory"); __builtin_amdgcn_sched_barrier(0); }
        E(acc, cur, wr, wc, fr, fq);
        if (!has_next) break;
#pragma unroll
        for (int a = 0; a < 2; ++a)
#pragma unroll
            for (int b = 0; b < 2; ++b)
#pragma unroll
                for (int m = 0; m < 4; ++m)
#pragma unroll
                    for (int n = 0; n < 2; ++n) acc[a][b][m][n] = (f32x4){0.f, 0.f, 0.f, 0.f};
        cur = nxt; cB = nB; ++ui;
#pragma unroll
        for (int h = 0; h < 2; ++h)
#pragma unroll
            for (int i = 0; i < 2; ++i) co[h][i] = no[h][i];
        if constexpr (ALIGN_EPI) { if (wr == 1) PG8_BAR; }
    }
    PG8_WAIT_V(0);
    if constexpr (!ALIGN_EPI) { if (wr == 0) PG8_BAR; }
    PG8_BAR;
#undef PG8_SA
#undef PG8_SB
#undef PG8_STAGE
#undef PG8_LDA
#undef PG8_LDF
#undef PG8_LDB
#undef PG8_MMA
#undef PG8_WAIT_V
#undef PG8_WAIT_L
#undef PG8_BAR
#undef PG8_SCHED
#undef PG8_AOFF
}

struct EpiInProj {
    static constexpr bool PERM = true;
    bf16_t* P; const float* ropeC; const float* ropeS;
    __device__ __forceinline__ void operator()(const f32x4 (&acc)[2][2][4][2], const Unit& u, int wr, int wc, int fr, int fq) const {
        const int row0 = u.pm * BM + wr * 64 + fr, col0 = u.pn * BM + wc * 32 + 8 * fq;
        const bool qk = u.pn < 4, rope = qk && (u.pm < NLAT / BM);
        const float ks = (u.pn >= 2 && u.pn < 4) ? 0.08838834764831845f : 1.0f;
        const int sec = wc >> 1, i0 = (wc & 1) * 16 + 4 * fq;
#pragma unroll
        for (int ai = 0; ai < 2; ++ai)
#pragma unroll
            for (int m = 0; m < 4; ++m) {
                const int row = row0 + ai * HALF + m * 16;
                asm volatile("" ::: "memory");
                f32x4 c4 = (f32x4){1.f, 1.f, 1.f, 1.f}, s4 = (f32x4){0.f, 0.f, 0.f, 0.f};
                if (rope) { const int t = row & (TL - 1), pos = sec ? (t & 63) : (t >> 6); const int ti = (sec ? 1024 : 0) + pos * 32 + i0;
                    c4 = *(const f32x4*)(ropeC + ti); s4 = *(const f32x4*)(ropeS + ti); }
                bf16_t* rowp = P + (size_t)row * NP + col0;
#pragma unroll
                for (int bj = 0; bj < 2; ++bj) {
                    f32x4 v0 = acc[ai][bj][m][0], v1 = acc[ai][bj][m][1];
                    if (qk) {
                        const float a0 = v0[0] * c4[0] - v0[1] * s4[0], b0 = v0[0] * s4[0] + v0[1] * c4[0];
                        const float a1 = v0[2] * c4[1] - v0[3] * s4[1], b1 = v0[2] * s4[1] + v0[3] * c4[1];
                        const float a2 = v1[0] * c4[2] - v1[1] * s4[2], b2 = v1[0] * s4[2] + v1[1] * c4[2];
                        const float a3 = v1[2] * c4[3] - v1[3] * s4[3], b3 = v1[2] * s4[3] + v1[3] * c4[3];
                        v0 = (f32x4){a0 * ks, b0 * ks, a1 * ks, b1 * ks}; v1 = (f32x4){a2 * ks, b2 * ks, a3 * ks, b3 * ks};
                    }
                    u32x4 w; w.x = cvt_pk_bf16(v0[0], v0[1]); w.y = cvt_pk_bf16(v0[2], v0[3]); w.z = cvt_pk_bf16(v1[0], v1[1]); w.w = cvt_pk_bf16(v1[2], v1[3]);
                    *(u32x4*)(rowp + bj * HALF) = w;
                }
            }
    }
};
struct EpiResid {
    static constexpr bool PERM = true;
    const float* rl; const float* rc; const bf16_t* rb; bf16_t* ob; float* ssq; const float* gmod;
    __device__ __forceinline__ void operator()(const f32x4 (&acc)[2][2][4][2], const Unit& u, int wr, int wc, int fr, int fq) const {
        const int row0 = u.pm * BM + wr * 64 + fr, col0 = u.pn * BM + wc * 32 + 8 * fq;
        const bool lat = u.pm < NLAT / BM; const int b = lat ? (u.pm >> 3) : 16;
        const float* rbase = rl ? (lat ? rl : rc - (size_t)NLAT * D) : nullptr;
        f32x4 gv[2][2];
#pragma unroll
        for (int bj = 0; bj < 2; ++bj)
#pragma unroll
            for (int n = 0; n < 2; ++n) gv[bj][n] = *(const f32x4*)(gmod + (size_t)b * 6 * D + col0 + bj * HALF + 4 * n);
#pragma unroll
        for (int ai = 0; ai < 2; ++ai)
#pragma unroll
            for (int m = 0; m < 4; ++m) { const int row = row0 + ai * HALF + m * 16; const size_t off = (size_t)row * D + col0; float ss = 0.f;
#pragma unroll
                for (int bj = 0; bj < 2; ++bj) { f32x4 r0, r1;
                    if (rbase) { r0 = *(const f32x4*)(rbase + off + bj * HALF); r1 = *(const f32x4*)(rbase + off + bj * HALF + 4); }
                    else { const u32x4 w = *(const u32x4*)(rb + off + bj * HALF); r0 = (f32x4){bflo(w.x), bfhi(w.x), bflo(w.y), bfhi(w.y)}; r1 = (f32x4){bflo(w.z), bfhi(w.z), bflo(w.w), bfhi(w.w)}; }
                    const f32x4 v0 = r0 + gv[bj][0] * acc[ai][bj][m][0], v1 = r1 + gv[bj][1] * acc[ai][bj][m][1];
                    ss += (v0[0] * v0[0] + v0[1] * v0[1]) + (v0[2] * v0[2] + v0[3] * v0[3]) + (v1[0] * v1[0] + v1[1] * v1[1]) + (v1[2] * v1[2] + v1[3] * v1[3]);
                    u32x4 w; w.x = cvt_pk_bf16(v0[0], v0[1]); w.y = cvt_pk_bf16(v0[2], v0[3]); w.z = cvt_pk_bf16(v1[0], v1[1]); w.w = cvt_pk_bf16(v1[2], v1[3]);
                    *(u32x4*)(ob + off + bj * HALF) = w; }
                ss += __shfl_xor(ss, 16); ss += __shfl_xor(ss, 32);
                if (fq == 0) ssq[(size_t)row * 16 + u.pn * 4 + wc] = ss;
                if (m & 1) asm volatile("" ::: "memory"); }
    }
};
struct EpiSwiGLU {
    static constexpr bool PERM = true;
    bf16_t* O;
    __device__ __forceinline__ void operator()(const f32x4 (&acc)[2][2][4][2], const Unit& u, int wr, int wc, int fr, int fq) const {
        const int row0 = u.pm * BM + wr * 64 + fr, col0 = u.pn * 128 + wc * 16 + 4 * fq;
#pragma unroll
        for (int ai = 0; ai < 2; ++ai)
#pragma unroll
            for (int m = 0; m < 4; ++m) { bf16_t* rowp = O + (size_t)(row0 + ai * HALF + m * 16) * FF + col0;
#pragma unroll
                for (int bj = 0; bj < 2; ++bj) { const f32x4 g = acc[ai][bj][m][0], up = acc[ai][bj][m][1];
                    u32x2 w; w.x = cvt_pk_bf16(silu_f(g[0]) * up[0], silu_f(g[1]) * up[1]); w.y = cvt_pk_bf16(silu_f(g[2]) * up[2], silu_f(g[3]) * up[3]);
                    *(u32x2*)(rowp + bj * 64) = w; } }
    }
};
__device__ __forceinline__ unsigned pk4_fp8(float a, float b, float c, float d) { int p = __builtin_amdgcn_cvt_pk_fp8_f32(a, b, 0, false); p = __builtin_amdgcn_cvt_pk_fp8_f32(c, d, p, true); return (unsigned)p; }
struct EpiSwiGLU8 {
    static constexpr bool PERM = true;
    unsigned char* O; float inv;
    __device__ __forceinline__ void operator()(const f32x4 (&acc)[2][2][4][2], const Unit& u, int wr, int wc, int fr, int fq) const {
        const int row0 = u.pm * BM + wr * 64 + fr, col0 = u.pn * 128 + wc * 32 + 8 * fq;
#pragma unroll
        for (int ai = 0; ai < 2; ++ai)
#pragma unroll
            for (int m = 0; m < 4; ++m) { unsigned char* rowp = O + (size_t)(row0 + ai * HALF + m * 16) * FF + col0;
                const f32x4 g0 = acc[ai][0][m][0] * inv, g1 = acc[ai][0][m][1] * inv, u0 = acc[ai][1][m][0] * inv, u1 = acc[ai][1][m][1] * inv;
                u32x2 w; w.x = pk4_fp8(silu_f(g0[0]) * u0[0], silu_f(g0[1]) * u0[1], silu_f(g0[2]) * u0[2], silu_f(g0[3]) * u0[3]);
                w.y = pk4_fp8(silu_f(g1[0]) * u1[0], silu_f(g1[1]) * u1[1], silu_f(g1[2]) * u1[2], silu_f(g1[3]) * u1[3]);
                *(u32x2*)rowp = w; }
    }
};
struct EpiFp8S {
    static constexpr bool PERM = true;
    unsigned char* O; int ldc; float inv;
    __device__ __forceinline__ void operator()(const f32x4 (&acc)[2][2][4][2], const Unit& u, int wr, int wc, int fr, int fq) const {
        const int row0 = u.pm * BM + wr * 64 + fr, col0 = u.pn * BM + wc * 32 + 8 * fq;
#pragma unroll
        for (int ai = 0; ai < 2; ++ai)
#pragma unroll
            for (int m = 0; m < 4; ++m) { unsigned char* rowp = O + (size_t)(row0 + ai * HALF + m * 16) * ldc + col0;
#pragma unroll
                for (int bj = 0; bj < 2; ++bj) { const f32x4 v0 = acc[ai][bj][m][0] * inv, v1 = acc[ai][bj][m][1] * inv;
                    u32x2 w; w.x = pk4_fp8(v0[0], v0[1], v0[2], v0[3]); w.y = pk4_fp8(v1[0], v1[1], v1[2], v1[3]);
                    *(u32x2*)(rowp + bj * HALF) = w; } }
    }
};
struct EpiBf16S {
    static constexpr bool PERM = true;
    bf16_t* O; int ldc; float inv;
    __device__ __forceinline__ void operator()(const f32x4 (&acc)[2][2][4][2], const Unit& u, int wr, int wc, int fr, int fq) const {
        const int row0 = u.pm * BM + wr * 64 + fr, col0 = u.pn * BM + wc * 32 + 8 * fq;
#pragma unroll
        for (int ai = 0; ai < 2; ++ai)
#pragma unroll
            for (int m = 0; m < 4; ++m) { bf16_t* rowp = O + (size_t)(row0 + ai * HALF + m * 16) * ldc + col0;
#pragma unroll
                for (int bj = 0; bj < 2; ++bj) { const f32x4 v0 = acc[ai][bj][m][0] * inv, v1 = acc[ai][bj][m][1] * inv;
                    u32x4 w; w.x = cvt_pk_bf16(v0[0], v0[1]); w.y = cvt_pk_bf16(v0[2], v0[3]); w.z = cvt_pk_bf16(v1[0], v1[1]); w.w = cvt_pk_bf16(v1[2], v1[3]);
                    *(u32x4*)(rowp + bj * HALF) = w; } }
    }
};
struct EpiBf16 {
    static constexpr bool PERM = true;
    bf16_t* O; int ldc;
    __device__ __forceinline__ void operator()(const f32x4 (&acc)[2][2][4][2], const Unit& u, int wr, int wc, int fr, int fq) const {
        const int row0 = u.pm * BM + wr * 64 + fr, col0 = u.pn * BM + wc * 32 + 8 * fq;
#pragma unroll
        for (int ai = 0; ai < 2; ++ai)
#pragma unroll
            for (int m = 0; m < 4; ++m) { bf16_t* rowp = O + (size_t)(row0 + ai * HALF + m * 16) * ldc + col0;
#pragma unroll
                for (int bj = 0; bj < 2; ++bj) { const f32x4 v0 = acc[ai][bj][m][0], v1 = acc[ai][bj][m][1];
                    u32x4 w; w.x = cvt_pk_bf16(v0[0], v0[1]); w.y = cvt_pk_bf16(v0[2], v0[3]); w.z = cvt_pk_bf16(v1[0], v1[1]); w.w = cvt_pk_bf16(v1[2], v1[3]);
                    *(u32x4*)(rowp + bj * HALF) = w; } }
    }
};
}

struct Args { const float* in[22]; float* out; unsigned char* ws; int ph_lo, ph_hi; };
enum { I_X = 0, I_C, I_CTX, I_CCTX, I_ADAW, I_ADAB, I_N1G, I_WIN, I_DF, I_DB, I_POOLW, I_POOLS, I_WOUT, I_N2G, I_RGW, I_RGB, I_REW, I_REB, I_WG, I_WU, I_WDN, I_FNG };

struct Frame {
    LAS unsigned char* lds; int tid, lane, wave, G, bx, vcu;
    const float* const* in; float* out; unsigned char* ws;
};
__device__ __forceinline__ bf16_t* xb_row(const Frame& F, int row) { return (bf16_t*)(F.ws + WS_XB) + (size_t)row * D; }
__device__ __forceinline__ bf16_t* hbuf(const Frame& F) { return (bf16_t*)F.out; }
__device__ __forceinline__ const float* mod_ptr(const Frame& F, int l, int b, int which) { return (const float*)(F.ws + WS_MOD) + ((size_t)(l * 17 + b) * 6 + which) * D; }

__device__ __forceinline__ void tr_item(const float* colp, size_t ldw, int k0, bf16_t* WT, int K, int n0, LAS float* scr, int lane) {
    { float v[32];
#pragma unroll
        for (int i = 0; i < 32; ++i) v[i] = colp[(size_t)(k0 + 2 * i + (lane >> 5)) * ldw];
#pragma unroll
        for (int i = 0; i < 32; ++i) scr[(2 * i + (lane >> 5)) * 33 + (lane & 31)] = v[i]; }
    asm volatile("s_waitcnt lgkmcnt(0)" ::: "memory");
    const int c = lane & 7;
#pragma unroll
    for (int j = 0; j < 4; ++j) { const int n = (lane >> 3) + 8 * j; const LAS float* s = scr + (8 * c) * 33 + n;
        u32x4 o; o.x = pk2(s[0 * 33], s[1 * 33]); o.y = pk2(s[2 * 33], s[3 * 33]); o.z = pk2(s[4 * 33], s[5 * 33]); o.w = pk2(s[6 * 33], s[7 * 33]);
        *(u32x4*)(WT + (size_t)(n0 + n) * K + k0 + 8 * c) = o; }
    asm volatile("s_waitcnt lgkmcnt(0)" ::: "memory");
}
constexpr float WGU_SCALE = 64.0f, WD_SCALE = 32.0f;
__device__ __forceinline__ void tr_item8(const float* colp, size_t ldw, int k0, unsigned char* WT, int K, int n0, LAS float* scr, int lane, float qs) {
    { float v[32];
#pragma unroll
        for (int i = 0; i < 32; ++i) v[i] = colp[(size_t)(k0 + 2 * i + (lane >> 5)) * ldw];
#pragma unroll
        for (int i = 0; i < 32; ++i) scr[(2 * i + (lane >> 5)) * 33 + (lane & 31)] = v[i] * qs; }
    asm volatile("s_waitcnt lgkmcnt(0)" ::: "memory");
    const int c = lane & 7;
#pragma unroll
    for (int j = 0; j < 4; ++j) { const int n = (lane >> 3) + 8 * j; const LAS float* s = scr + (8 * c) * 33 + n;
        u32x2 o; o.x = pg8::pk4_fp8(s[0 * 33], s[1 * 33], s[2 * 33], s[3 * 33]); o.y = pg8::pk4_fp8(s[4 * 33], s[5 * 33], s[6 * 33], s[7 * 33]);
        *(u32x2*)(WT + (size_t)(n0 + n) * K + k0 + 8 * c) = o; }
    asm volatile("s_waitcnt lgkmcnt(0)" ::: "memory");
}
__device__ __forceinline__ void fold_item(const float* win, const float* pw, const float* ps, int k0, bf16_t* WT, int n0, LAS float* scr, int lane) {
    const int n = n0 + (lane & 31), g = n >> 7, nn = n & 127;
    const float* pwc = pw + (size_t)g * 128 * 128 + nn; const float sc = ps[n];
    float acc[32];
#pragma unroll
    for (int i = 0; i < 32; ++i) acc[i] = 0.f;
    for (int hc = 0; hc < 8; ++hc) {
        float pc[16];
#pragma unroll
        for (int c = 0; c < 16; ++c) pc[c] = pwc[(size_t)(hc * 16 + c) * 128];
#pragma unroll
        for (int i = 0; i < 32; ++i) { const f32x4* wr = (const f32x4*)(win + (size_t)(k0 + 2 * i + (lane >> 5)) * NP + 2048 + g * 128 + hc * 16);
            float a = acc[i];
#pragma unroll
            for (int c4 = 0; c4 < 4; ++c4) { const f32x4 w = wr[c4]; a += w[0] * pc[4 * c4] + w[1] * pc[4 * c4 + 1] + w[2] * pc[4 * c4 + 2] + w[3] * pc[4 * c4 + 3]; }
            acc[i] = a; }
    }
#pragma unroll
    for (int i = 0; i < 32; ++i) scr[(2 * i + (lane >> 5)) * 33 + (lane & 31)] = acc[i] * sc;
    asm volatile("s_waitcnt lgkmcnt(0)" ::: "memory");
    const int c = lane & 7;
#pragma unroll
    for (int j = 0; j < 4; ++j) { const int nl = (lane >> 3) + 8 * j; const LAS float* s = scr + (8 * c) * 33 + nl;
        u32x4 o; o.x = pk2(s[0 * 33], s[1 * 33]); o.y = pk2(s[2 * 33], s[3 * 33]); o.z = pk2(s[4 * 33], s[5 * 33]); o.w = pk2(s[6 * 33], s[7 * 33]);
        *(u32x4*)(WT + (size_t)(2048 + n0 + nl) * D + k0 + 8 * c) = o; }
    asm volatile("s_waitcnt lgkmcnt(0)" ::: "memory");
}
__device__ __forceinline__ void p0_prologue(const Frame& F, int qsel) {
    for (int task = F.bx; task < 2 * 96; task += F.G) {
        const int l = task / 96, cg = task % 96;
        LAS float* sc = (LAS float*)F.lds;
        LAS float* part = (LAS float*)(F.lds + 17 * 1024 * 4);
        { float cv[34];
#pragma unroll
          for (int q = 0; q < 34; ++q) { const int i = F.tid + 512 * q, b = i >> 10, k = i & 1023; cv[q] = b < 16 ? F.in[I_C][b * D + k] : F.in[I_CCTX][k]; }
#pragma unroll
          for (int q = 0; q < 34; ++q) sc[F.tid + 512 * q] = silu_f(cv[q]); }
        __syncthreads();
        float acc[17];
#pragma unroll
        for (int b = 0; b < 17; ++b) acc[b] = 0.f;
        const float* aw = F.in[I_ADAW] + (size_t)l * D * 6 * D + cg * 64 + F.lane;
        for (int k0 = F.wave * 128; k0 < F.wave * 128 + 128; k0 += 16) { float w[16];
#pragma unroll
            for (int u = 0; u < 16; ++u) w[u] = aw[(size_t)(k0 + u) * 6 * D];
#pragma unroll
            for (int u = 0; u < 16; ++u) {
#pragma unroll
                for (int b = 0; b < 17; ++b) acc[b] += sc[b * 1024 + k0 + u] * w[u]; } }
#pragma unroll
        for (int b = 0; b < 17; ++b) part[(F.wave * 17 + b) * 64 + F.lane] = acc[b];
        __syncthreads();
        for (int i = F.tid; i < 17 * 64; i += 512) { const int b = i >> 6, n = i & 63; float s = F.in[I_ADAB][l * 6 * D + cg * 64 + n];
#pragma unroll
            for (int w = 0; w < 8; ++w) s += part[(w * 17 + b) * 64 + n];
            const int col = cg * 64 + n; ((float*)(F.ws + WS_MOD))[((size_t)(l * 17 + b) * 6 + (col >> 10)) * D + (col & 1023)] = s; }
        __syncthreads();
    }
    if (F.bx >= F.G - 3 && F.bx < F.G - 1) { const int l = F.G - 2 - F.bx; unsigned char* img = F.ws + WS_RIMG + (size_t)l * RW_EX;
        const float* rg = F.in[I_RGW] + (size_t)l * D * 4; const float* re = F.in[I_REW] + (size_t)l * D * NE;
        for (int i0 = F.tid; i0 < 1024 * 36; i0 += 512 * 8) { float w[8];
#pragma unroll
            for (int q = 0; q < 8; ++q) { const int i = i0 + 512 * q, k = i / 36, n = i % 36; w[q] = n < 4 ? rg[k * 4 + n] : re[k * NE + (n - 4)]; }
#pragma unroll
            for (int q = 0; q < 8; ++q) { const int i = i0 + 512 * q, k = i / 36, n = i % 36; const unsigned hi = f2bf(w[q]), lo = f2bf(w[q] - bflo(hi));
                *(bf16_t*)(img + n * RW_PITCH + k * 2) = (bf16_t)hi; *(bf16_t*)(img + RW_LO + n * RW_PITCH + k * 2) = (bf16_t)lo; } }
        for (int i = F.tid; i < 2 * 36 * 8; i += 512) { const int r = i >> 3; *(bf16_t*)(img + r * RW_PITCH + 2048 + (i & 7) * 2) = 0; }
    }
    if (F.bx == F.G - 1) {
        float* rc = (float*)(F.ws + WS_ROPE); float* rs = rc + 96 * 32;
        for (int i = F.tid; i < 96 * 32; i += 512) { const int p = i >> 5, f = i & 31; const int pos = p < 32 ? p : p - 32;
            const float inv = powf(10000.0f, -(float)f / 32.0f); const float ang = (float)pos * inv; rc[i] = cosf(ang); rs[i] = sinf(ang); }
    }
    LAS float* scr = (LAS float*)(F.lds + F.wave * 8448);
    constexpr int IT_WIN = 16 * 80, IT_WOUT = 16 * 32, IT_GU = 16 * 32, IT_DN = 8 * 32;
    constexpr int N_WIN = DEPTH * IT_WIN, N_WOUT = DEPTH * IT_WOUT, N_GU = DEPTH * NE * IT_GU, N_DN = DEPTH * NE * IT_DN;
    unsigned* qhead = (unsigned*)(F.ws + WS_CTL) + CW_QUEUE + 16 * qsel;
    constexpr int N_ALL = N_WIN + N_WOUT + N_GU + N_DN, QB = 16, NBATCH = N_ALL / QB;
    static_assert(N_ALL % QB == 0, "queue batches");
    for (;;) {
        int bq = 0; if (F.lane == 0) bq = (int)__hip_atomic_fetch_add(qhead, 1u, __ATOMIC_RELAXED, __HIP_MEMORY_SCOPE_AGENT);
        bq = __builtin_amdgcn_readfirstlane(bq);
        if (bq >= NBATCH) break;
      for (int qi = 0; qi < QB; ++qi) {
        int r = bq + qi * NBATCH;
        if (r < N_WIN) { const int l = r / IT_WIN; r %= IT_WIN; const int kb = r & 15, nb = 79 - (r >> 4), n0 = nb * 32;
            const float* win = F.in[I_WIN] + (size_t)l * D * NP; bf16_t* WT = (bf16_t*)(F.ws + WS_WIN) + (size_t)l * NP * D;
            if (n0 >= 2048) { fold_item(win, F.in[I_POOLW] + (size_t)l * 4 * 128 * 128, F.in[I_POOLS] + l * 512, kb * 64, WT, n0 - 2048, scr, F.lane); continue; }
            const int n = n0 + (F.lane & 31); int src = n;
            if (n < 1024) { const int hh = n >> 7, j = n & 127, sec = j >> 6, jj = j & 63; src = (n & 512) + (hh & 3) * 128 + sec * 64 + (jj & 1) * 32 + (jj >> 1); }
            tr_item(win + src, NP, kb * 64, WT, D, n0, scr, F.lane); continue; }
        r -= N_WIN;
        if (r < N_WOUT) { const int l = r / IT_WOUT; r %= IT_WOUT; const int kb = r / 32, nb = r % 32, n0 = nb * 32;
            tr_item(F.in[I_WOUT] + (size_t)l * D * D + n0 + (F.lane & 31), D, kb * 64, (bf16_t*)(F.ws + WS_WOUT) + (size_t)l * D * D, D, n0, scr, F.lane); continue; }
        r -= N_WOUT;
        if (r < N_GU) { const int le = r / IT_GU; r %= IT_GU; const int kb = r / 32, nb = r % 32, n0 = nb * 32;
            const int n = n0 + (F.lane & 31), col = (n >> 8) * 128 + (n & 127); const float* src = ((n & 128) ? F.in[I_WU] : F.in[I_WG]) + (size_t)le * D * FF + col;
            tr_item8(src, FF, kb * 64, (unsigned char*)(F.ws + WS_WGU) + (size_t)le * 1024 * D, D, n0, scr, F.lane, WGU_SCALE); continue; }
        r -= N_GU;
        { const int le = r / IT_DN; r %= IT_DN; const int kb = r / 32, nb = r % 32, n0 = nb * 32;
            tr_item8(F.in[I_WDN] + (size_t)le * FF * D + n0 + (F.lane & 31), D, kb * 64, (unsigned char*)(F.ws + WS_WD) + (size_t)le * D * FF, FF, n0, scr, F.lane, WD_SCALE); }
      }
    }
}

__device__ __forceinline__ LAS int* build_tb(const Frame& F, int l) {
    LAS int* tb = (LAS int*)(F.lds + MISC_OFF + 64);
    if (F.tid < 64) {
        const unsigned* cnt = (const unsigned*)(F.ws + WS_CTL) + CW_CNT + l * NE * 16;
        const int e = F.tid & 31; const int c = (int)__hip_atomic_load(cnt + e * 16, __ATOMIC_RELAXED, __HIP_MEMORY_SCOPE_AGENT);
        const int t = (c + 255) >> 8; int incl = t;
#pragma unroll
        for (int o = 1; o < 32; o <<= 1) { const int v = __shfl_up(incl, o, 32); if (e >= o) incl += v; }
        if (F.tid < 32) { tb[e] = incl - t; tb[64 + e] = c; if (e == 31) tb[NE] = incl; }
    }
    __syncthreads();
    return tb;
}

__device__ __forceinline__ void row_op_a(const Frame& F, int mode, bool dry) {
    const int gw = F.vcu * 8 + F.wave, NGW = F.G * 8;
    const int nrows = (mode == 2) ? NLAT : NTOK; const int l = (mode == 0) ? 0 : 1, lp = mode - 1;
    const LAS int* tb = nullptr; if (mode != 0) tb = build_tb(F, lp);
    const unsigned char* YB = (const unsigned char*)(F.ws + WS_P); bf16_t* H = hbuf(F);
    const float* gain = (mode == 2) ? F.in[I_FNG] : F.in[I_N1G] + l * D;
    int4 ti1 = make_int4(0, 0, 0, 0), ti2 = ti1; f32x2 tw0 = (f32x2){0.f, 0.f}, tw1 = tw0, tw2 = tw0;
    f32x4 xf[4]; u32x2 xq[4]; unsigned ya[4], yc[4];
#define ROWA_INFO(r_, ti_, tw_) do { if (mode != 0 && (r_) < nrows) { ti_ = *(const int4*)(F.ws + WS_TOKINFO + (size_t)(r_) * 32); tw_ = *(const f32x2*)(F.ws + WS_TOKINFO + (size_t)(r_) * 32 + 16); } } while (0)
#define ROWA_DATA(r_, ti_) do { if ((r_) < nrows) { if (mode == 0) { const f32x4* src = (const f32x4*)((r_) < NLAT ? F.in[I_X] + (size_t)(r_) * D : F.in[I_CTX] + (size_t)((r_) - NLAT) * D) + F.lane; \
            _Pragma("unroll") for (int j = 0; j < 4; ++j) xf[j] = src[64 * j]; } \
        else { const size_t s1 = (size_t)(tb[ti_.x] * 256 + ti_.y), s2 = (size_t)(tb[ti_.z] * 256 + ti_.w); const u32x2* xr_ = (const u32x2*)xb_row(F, (r_)) + F.lane; \
            const unsigned* y1 = (const unsigned*)(YB + s1 * D) + F.lane; const unsigned* y2 = (const unsigned*)(YB + s2 * D) + F.lane; \
            _Pragma("unroll") for (int j = 0; j < 4; ++j) { xq[j] = xr_[64 * j]; ya[j] = y1[64 * j]; yc[j] = y2[64 * j]; } } } } while (0)
    ROWA_INFO(gw, ti1, tw1); ROWA_INFO(gw + NGW, ti2, tw2);
    ROWA_DATA(gw, ti1); tw0 = tw1; ti1 = ti2; tw1 = tw2;
    for (int row = gw; row < nrows; row += NGW) {
        const int b = row < NLAT ? (row >> 11) : 16;
        ROWA_INFO(row + 2 * NGW, ti2, tw2);
        f32x4 v[4];
        if (mode == 0) {
#pragma unroll
            for (int j = 0; j < 4; ++j) v[j] = xf[j];
        } else {
            const f32x4* g2 = (const f32x4*)mod_ptr(F, lp, b, 5) + F.lane;
#pragma unroll
            for (int j = 0; j < 4; ++j) { const u32x2 xw = xq[j]; const f32x4 x = (f32x4){bflo(xw.x), bfhi(xw.x), bflo(xw.y), bfhi(xw.y)};
                const int a = (int)ya[j], c = (int)yc[j]; const f32x4 g = g2[64 * j];
                f32x4 y; y[0] = tw0.x * __builtin_amdgcn_cvt_f32_fp8(a, 0) + tw0.y * __builtin_amdgcn_cvt_f32_fp8(c, 0); y[1] = tw0.x * __builtin_amdgcn_cvt_f32_fp8(a, 1) + tw0.y * __builtin_amdgcn_cvt_f32_fp8(c, 1);
                y[2] = tw0.x * __builtin_amdgcn_cvt_f32_fp8(a, 2) + tw0.y * __builtin_amdgcn_cvt_f32_fp8(c, 2); y[3] = tw0.x * __builtin_amdgcn_cvt_f32_fp8(a, 3) + tw0.y * __builtin_amdgcn_cvt_f32_fp8(c, 3);
                v[j] = x + g * y; }
        }
        ROWA_DATA(row + NGW, ti1);
        if (mode == 1 && !dry) { u32x2* xr = (u32x2*)xb_row(F, row) + F.lane;
#pragma unroll
            for (int j = 0; j < 4; ++j) { u32x2 w; w.x = pk2(v[j][0], v[j][1]); w.y = pk2(v[j][2], v[j][3]); xr[64 * j] = w; } }
        float ss = 0.f;
#pragma unroll
        for (int j = 0; j < 4; ++j) ss += (v[j][0] * v[j][0] + v[j][1] * v[j][1]) + (v[j][2] * v[j][2] + v[j][3] * v[j][3]);
        const float rstd = 1.0f / sqrtf(wave_sum(ss) * (1.0f / D) + EPS);
        if (mode == 2) {
#pragma unroll
            for (int j = 0; j < 4; ++j) { const f32x4 g = ((const f32x4*)gain)[F.lane + 64 * j]; ((f32x4*)((dry ? (float*)(F.ws + WS_WGU) : F.out) + (size_t)row * D))[F.lane + 64 * j] = v[j] * rstd * g; }
        } else {
            const f32x4* sh = (const f32x4*)mod_ptr(F, l, b, 0) + F.lane; const f32x4* sc = (const f32x4*)mod_ptr(F, l, b, 1) + F.lane;
            u32x2* o = (u32x2*)(H + (size_t)row * D) + F.lane;
#pragma unroll
            for (int j = 0; j < 4; ++j) { const f32x4 g = ((const f32x4*)gain)[F.lane + 64 * j]; const f32x4 h = v[j] * rstd * g * (sc[64 * j] + 1.0f) + sh[64 * j];
                u32x2 w; w.x = pk2(h[0], h[1]); w.y = pk2(h[2], h[3]); o[64 * j] = w; }
        }
        tw0 = tw1; ti1 = ti2; tw1 = tw2;
    }
#undef ROWA_INFO
#undef ROWA_DATA
}

template <bool DRY> __device__ __forceinline__ void route_row(const Frame& F, int l, int row, const float (&s)[36], unsigned* cnt, int* list) {
    float gl[4];
#pragma unroll
    for (int i = 0; i < 4; ++i) gl[i] = s[i];
    int gt = 0; float gm = gl[0];
#pragma unroll
    for (int i = 1; i < 4; ++i) if (gl[i] > gm) { gm = gl[i]; gt = i; }
    float gs = 0.f;
#pragma unroll
    for (int i = 0; i < 4; ++i) gs += expf(gl[i] - gm);
    const float gwt = 1.0f / gs;
    float el[8];
#pragma unroll
    for (int j = 0; j < 8; ++j) el[j] = gt == 0 ? s[4 + j] : gt == 1 ? s[12 + j] : gt == 2 ? s[20 + j] : s[28 + j];
    int i1 = 0; float v1 = el[0];
#pragma unroll
    for (int j = 1; j < 8; ++j) if (el[j] > v1) { v1 = el[j]; i1 = j; }
    int i2 = -1; float v2 = -3.0e38f;
#pragma unroll
    for (int j = 0; j < 8; ++j) if (j != i1 && el[j] > v2) { v2 = el[j]; i2 = j; }
    const float e2 = expf(v2 - v1); const float w1 = gwt / (1.0f + e2), w2 = gwt * e2 / (1.0f + e2);
    if (!DRY) {
        const int x1 = gt * 8 + i1, x2 = gt * 8 + i2;
        const int r1 = (int)__hip_atomic_fetch_add(cnt + x1 * 16, 1u, __ATOMIC_RELAXED, __HIP_MEMORY_SCOPE_AGENT);
        const int r2 = (int)__hip_atomic_fetch_add(cnt + x2 * 16, 1u, __ATOMIC_RELAXED, __HIP_MEMORY_SCOPE_AGENT);
        list[(size_t)x1 * NTOK + r1] = row; list[(size_t)x2 * NTOK + r2] = row;
        *(int4*)(F.ws + WS_TOKINFO + (size_t)row * 32) = make_int4(x1, r1, x2, r2); *(f32x2*)(F.ws + WS_TOKINFO + (size_t)row * 32 + 16) = (f32x2){w1, w2};
    }
}
template <bool DRY> __device__ __forceinline__ void row_op_b(const Frame& F, int l) {
    const int gw = F.vcu * 8 + F.wave, NGW = F.G * 8;
    const int ngroups = ((l == 0) ? NTOK : NLAT) / 16;
    { const u32x4* img = (const u32x4*)(F.ws + WS_RIMG + (size_t)l * RW_EX);
      u32x4 t[19];
#pragma unroll
      for (int q = 0; q < 19; ++q) { const int i = F.tid + 512 * q; t[q] = img[i < RW_EX / 16 ? i : 0]; }
#pragma unroll
      for (int q = 0; q < 19; ++q) { const int i = F.tid + 512 * q; if (i < RW_EX / 16) *(LAS u32x4*)(F.lds + i * 16) = t[q]; } }
    __syncthreads();
    bf16_t* H = hbuf(F);
    const float* gain = F.in[I_N2G] + l * D;
    unsigned* cnt = (unsigned*)(F.ws + WS_CTL) + CW_CNT + l * NE * 16;
    int* list = (int*)(F.ws + WS_LIST);
    const int fr = F.lane & 15, fq = F.lane >> 4;
    unsigned bo[3];
#pragma unroll
    for (int nt = 0; nt < 3; ++nt) { const int n = 16 * nt + fr; bo[nt] = (unsigned)((n < 36 ? n : 35) * RW_PITCH + fq * 16); }
    LAS float* ex = (LAS float*)(F.lds + RW_EX + F.wave * 1152);
    float rbias[36];
#pragma unroll
    for (int n = 0; n < 36; ++n) rbias[n] = n < 4 ? F.in[I_RGB][l * 4 + n] : F.in[I_REB][l * NE + (n - 4)];
    for (int gi = gw; gi < ngroups; gi += NGW) {
        const int row = gi * 16 + fr, b = row < NLAT ? (row >> 11) : 16;
        const bf16_t* xr = xb_row(F, row) + fq * 8;
        float ss;
        { const f32x4* sp = (const f32x4*)((const float*)(F.ws + WS_SSQ) + (size_t)row * 16); const f32x4 p0 = sp[0], p1 = sp[1], p2 = sp[2], p3 = sp[3];
          ss = ((p0[0] + p0[1]) + (p0[2] + p0[3])) + ((p1[0] + p1[1]) + (p1[2] + p1[3])) + ((p2[0] + p2[1]) + (p2[2] + p2[3])) + ((p3[0] + p3[1]) + (p3[2] + p3[3])); }
        const float rstd = 1.0f / sqrtf(ss * (1.0f / D) + EPS);
        const float* shp = mod_ptr(F, l, b, 3) + fq * 8; const float* scp = mod_ptr(F, l, b, 4) + fq * 8; const float* gp = gain + fq * 8;
        unsigned char* hp = (unsigned char*)H + (size_t)row * D + fq * 8;
        f32x4 acc[3];
#pragma unroll
        for (int nt = 0; nt < 3; ++nt) acc[nt] = (f32x4){0.f, 0.f, 0.f, 0.f};
#pragma unroll 2
        for (int s = 0; s < 32; ++s) {
            const u32x4 xw = *(const u32x4*)(xr + 32 * s);
            const f32x4 x0 = (f32x4){bflo(xw.x), bfhi(xw.x), bflo(xw.y), bfhi(xw.y)}, x1 = (f32x4){bflo(xw.z), bfhi(xw.z), bflo(xw.w), bfhi(xw.w)};
            const f32x4 g0 = *(const f32x4*)(gp + 32 * s), g1 = *(const f32x4*)(gp + 32 * s + 4);
            const f32x4 c0 = *(const f32x4*)(scp + 32 * s), c1 = *(const f32x4*)(scp + 32 * s + 4);
            const f32x4 s0 = *(const f32x4*)(shp + 32 * s), s1 = *(const f32x4*)(shp + 32 * s + 4);
            const f32x4 h0 = x0 * rstd * g0 * (c0 + 1.0f) + s0, h1 = x1 * rstd * g1 * (c1 + 1.0f) + s1;
            u32x4 hi, lo;
            hi.x = pk2(h0[0], h0[1]); hi.y = pk2(h0[2], h0[3]); hi.z = pk2(h1[0], h1[1]); hi.w = pk2(h1[2], h1[3]);
            lo.x = pk2(h0[0] - bflo(hi.x), h0[1] - bfhi(hi.x)); lo.y = pk2(h0[2] - bflo(hi.y), h0[3] - bfhi(hi.y));
            lo.z = pk2(h1[0] - bflo(hi.z), h1[1] - bfhi(hi.z)); lo.w = pk2(h1[2] - bflo(hi.w), h1[3] - bfhi(hi.w));
            { u32x2 h8; h8.x = pg8::pk4_fp8(h0[0], h0[1], h0[2], h0[3]); h8.y = pg8::pk4_fp8(h1[0], h1[1], h1[2], h1[3]); *(u32x2*)(hp + 32 * s) = h8; }
            const bf16x8 ah = __builtin_bit_cast(bf16x8, hi), al = __builtin_bit_cast(bf16x8, lo);
#pragma unroll
            for (int nt = 0; nt < 3; ++nt) {
                const bf16x8 bh = *(const LAS bf16x8*)(F.lds + bo[nt] + s * 64), bl = *(const LAS bf16x8*)(F.lds + RW_LO + bo[nt] + s * 64);
                acc[nt] = __builtin_amdgcn_mfma_f32_16x16x32_bf16(ah, bh, acc[nt], 0, 0, 0);
                acc[nt] = __builtin_amdgcn_mfma_f32_16x16x32_bf16(ah, bl, acc[nt], 0, 0, 0);
                acc[nt] = __builtin_amdgcn_mfma_f32_16x16x32_bf16(al, bh, acc[nt], 0, 0, 0);
            }
        }
#pragma unroll
        for (int hf = 0; hf < 2; ++hf) {
            if ((fq >> 1) == hf) {
#pragma unroll
                for (int nt = 0; nt < 3; ++nt) { const int n = 16 * nt + fr;
                    if (n < 36) {
#pragma unroll
                        for (int r = 0; r < 4; ++r) ex[((fq & 1) * 4 + r) * 36 + n] = acc[nt][r]; } }
            }
            asm volatile("s_waitcnt lgkmcnt(0)" ::: "memory");
            if (F.lane < 8) { float sl[36];
#pragma unroll
                for (int n = 0; n < 36; ++n) sl[n] = ex[F.lane * 36 + n] + rbias[n];
                route_row<DRY>(F, l, gi * 16 + hf * 8 + F.lane, sl, cnt, list); }
            asm volatile("s_waitcnt lgkmcnt(0)" ::: "memory");
        }
    }
    __syncthreads();
}

__device__ __forceinline__ unsigned off_b(unsigned row, unsigned ch) { return 256u * row + 16u * (ch ^ (((row & 3) << 2) | ((row >> 2) & 3))); }
__device__ __forceinline__ unsigned tr_base_p(unsigned lane) { const unsigned g = lane >> 4, q = (lane & 15) >> 2, p = lane & 3; return off_b(4 * g + q, (p >> 1)) + 8 * (p & 1); }
template <int O0, int O1, int O2, int O3>
__device__ __forceinline__ void tr_frag4(bf16x8 (&f)[4], unsigned a0, unsigned a1, unsigned a2, unsigned a3) {
    s16x4 l0, h0, l1, h1, l2, h2, l3, h3;
    asm volatile("ds_read_b64_tr_b16 %0, %8 offset:%12\n\tds_read_b64_tr_b16 %1, %8 offset:%16\n\t"
                 "ds_read_b64_tr_b16 %2, %9 offset:%13\n\tds_read_b64_tr_b16 %3, %9 offset:%17\n\t"
                 "ds_read_b64_tr_b16 %4, %10 offset:%14\n\tds_read_b64_tr_b16 %5, %10 offset:%18\n\t"
                 "ds_read_b64_tr_b16 %6, %11 offset:%15\n\tds_read_b64_tr_b16 %7, %11 offset:%19\n\ts_waitcnt lgkmcnt(0)"
                 : "=&v"(l0), "=&v"(h0), "=&v"(l1), "=&v"(h1), "=&v"(l2), "=&v"(h2), "=&v"(l3), "=&v"(h3)
                 : "v"(a0), "v"(a1), "v"(a2), "v"(a3), "n"(O0), "n"(O1), "n"(O2), "n"(O3), "n"(O0 + 4096), "n"(O1 + 4096), "n"(O2 + 4096), "n"(O3 + 4096) : "memory");
    f[0] = __builtin_shufflevector(l0, h0, 0, 1, 2, 3, 4, 5, 6, 7); f[1] = __builtin_shufflevector(l1, h1, 0, 1, 2, 3, 4, 5, 6, 7);
    f[2] = __builtin_shufflevector(l2, h2, 0, 1, 2, 3, 4, 5, 6, 7); f[3] = __builtin_shufflevector(l3, h3, 0, 1, 2, 3, 4, 5, 6, 7);
}
template <int O>
__device__ __forceinline__ void tr_frag8(bf16x8 (&f)[8], unsigned a) {
    s16x4 l0, h0, l1, h1, l2, h2, l3, h3, l4, h4, l5, h5, l6, h6, l7, h7;
    const unsigned a1 = a ^ 32u, a2 = a ^ 64u, a3 = a ^ 96u, a4 = a ^ 128u, a5 = a ^ 160u, a6 = a ^ 192u, a7 = a ^ 224u;
    asm volatile("ds_read_b64_tr_b16 %0, %8 offset:%12\n\tds_read_b64_tr_b16 %1, %8 offset:%13\n\t"
                 "ds_read_b64_tr_b16 %2, %9 offset:%12\n\tds_read_b64_tr_b16 %3, %9 offset:%13\n\t"
                 "ds_read_b64_tr_b16 %4, %10 offset:%12\n\tds_read_b64_tr_b16 %5, %10 offset:%13\n\t"
                 "ds_read_b64_tr_b16 %6, %11 offset:%12\n\tds_read_b64_tr_b16 %7, %11 offset:%13"
                 : "=&v"(l0), "=&v"(h0), "=&v"(l1), "=&v"(h1), "=&v"(l2), "=&v"(h2), "=&v"(l3), "=&v"(h3)
                 : "v"(a), "v"(a1), "v"(a2), "v"(a3), "n"(O), "n"(O + 4096) : "memory");
    asm volatile("ds_read_b64_tr_b16 %0, %16 offset:%20\n\tds_read_b64_tr_b16 %1, %16 offset:%21\n\t"
                 "ds_read_b64_tr_b16 %2, %17 offset:%20\n\tds_read_b64_tr_b16 %3, %17 offset:%21\n\t"
                 "ds_read_b64_tr_b16 %4, %18 offset:%20\n\tds_read_b64_tr_b16 %5, %18 offset:%21\n\t"
                 "ds_read_b64_tr_b16 %6, %19 offset:%20\n\tds_read_b64_tr_b16 %7, %19 offset:%21\n\ts_waitcnt lgkmcnt(0)"
                 : "=&v"(l4), "=&v"(h4), "=&v"(l5), "=&v"(h5), "=&v"(l6), "=&v"(h6), "=&v"(l7), "=&v"(h7),
                   "+v"(l0), "+v"(h0), "+v"(l1), "+v"(h1), "+v"(l2), "+v"(h2), "+v"(l3), "+v"(h3)
                 : "v"(a4), "v"(a5), "v"(a6), "v"(a7), "n"(O), "n"(O + 4096) : "memory");
    f[0] = __builtin_shufflevector(l0, h0, 0, 1, 2, 3, 4, 5, 6, 7); f[1] = __builtin_shufflevector(l1, h1, 0, 1, 2, 3, 4, 5, 6, 7);
    f[2] = __builtin_shufflevector(l2, h2, 0, 1, 2, 3, 4, 5, 6, 7); f[3] = __builtin_shufflevector(l3, h3, 0, 1, 2, 3, 4, 5, 6, 7);
    f[4] = __builtin_shufflevector(l4, h4, 0, 1, 2, 3, 4, 5, 6, 7); f[5] = __builtin_shufflevector(l5, h5, 0, 1, 2, 3, 4, 5, 6, 7);
    f[6] = __builtin_shufflevector(l6, h6, 0, 1, 2, 3, 4, 5, 6, 7); f[7] = __builtin_shufflevector(l7, h7, 0, 1, 2, 3, 4, 5, 6, 7);
}
#define LBAR() do { asm volatile("s_waitcnt lgkmcnt(0)" ::: "memory"); __builtin_amdgcn_s_barrier(); asm volatile("" ::: "memory"); } while (0)
__device__ __forceinline__ int chunk_row0(int b, int ci) { return ci < 2 ? NLAT + b * CT + ci * 128 : b * TL + (ci - 2) * 128; }
__device__ __forceinline__ float log2_gamma(float decay) { return -log1pf(expf(-decay)) * 1.4426950408889634f; }

template <int HALF>
__device__ __forceinline__ void pool_item(const LAS unsigned char* tile, bf16_t* A2, int t0, int T, int rbase, int rl, int cg) {
    const int t = t0 + rl; int cnt = 0;
    float s[8];
#pragma unroll
    for (int i = 0; i < 8; ++i) s[i] = 0.f;
    u32x4 c = (u32x4){0u, 0u, 0u, 0u};
#pragma unroll
    for (int w = 0; w < 2 * HALF; ++w) { const int tt = t - HALF + w; const bool ok = tt >= 0 && tt < T;
        u32x4 x = *(const LAS u32x4*)(tile + (rl + 8 - HALF + w) * 1024 + cg * 16); if (!ok) x = (u32x4){0u, 0u, 0u, 0u}; cnt += ok ? 1 : 0; if (w == HALF) c = x;
        s[0] += bflo(x.x); s[1] += bfhi(x.x); s[2] += bflo(x.y); s[3] += bfhi(x.y); s[4] += bflo(x.z); s[5] += bfhi(x.z); s[6] += bflo(x.w); s[7] += bfhi(x.w); }
    const float inv = 1.0f / (float)cnt;
    u32x4 o; o.x = pk2(s[0] * inv - bflo(c.x), s[1] * inv - bfhi(c.x)); o.y = pk2(s[2] * inv - bflo(c.y), s[3] * inv - bfhi(c.y));
    o.z = pk2(s[4] * inv - bflo(c.z), s[5] * inv - bfhi(c.z)); o.w = pk2(s[6] * inv - bflo(c.w), s[7] * inv - bfhi(c.w));
    *(u32x4*)(A2 + (size_t)(rbase + t) * D + 512 + cg * 8) = o;
}

__device__ __forceinline__ void p3a_states_pool(const Frame& F, int l) {
    const bf16_t* P = (const bf16_t*)(F.ws + WS_P);
    bf16_t* ST = (bf16_t*)(F.ws + WS_ACT);
    bf16_t* A2 = hbuf(F);
    const int nstate = (F.G > 128) ? 128 : F.G;
    if (F.bx < nstate) {
        for (int unit = F.bx; unit < 128; unit += nstate) {
            const int dir = unit & 1, bh = unit >> 1, b = bh >> 2, h = bh & 3;
            const float lg2 = log2_gamma((dir ? F.in[I_DB] : F.in[I_DF])[l * NH + h]);
            const float gC = exp2f(lg2 * 128.0f);
            f32x4 acc[8];
#pragma unroll
            for (int dt = 0; dt < 8; ++dt) acc[dt] = (f32x4){0.f, 0.f, 0.f, 0.f};
            u32x4 kr[8], vr[8];
#define P3A_CI(n_) (dir ? ((n_) < 2 ? 1 - (n_) : 19 - (n_)) : (n_))
#define P3A_LOAD(st_) do { _Pragma("unroll") for (int sub = 0; sub < 2; ++sub) { const int r0_ = chunk_row0(b, P3A_CI(2 * (st_) + sub)); \
                _Pragma("unroll") for (int q = 0; q < 4; ++q) { const int p = F.tid + 512 * q, j = p >> 4, ch = p & 15; \
                    kr[sub * 4 + q] = *(const u32x4*)(P + (size_t)(r0_ + j) * NP + 512 + h * 128 + ch * 8); vr[sub * 4 + q] = *(const u32x4*)(P + (size_t)(r0_ + j) * NP + 1024 + h * 128 + ch * 8); } } } while (0)
#define P3A_STORE(n_) do { bf16_t* sp = ST + ((size_t)((bh * 2 + dir) * NCHUNK + P3A_CI(n_)) * 128 + (F.wave * 16 + (F.lane & 15))) * 128 + 4 * (F.lane >> 4); \
                _Pragma("unroll") for (int dt = 0; dt < 8; ++dt) { u32x2 w; w.x = pk2(acc[dt][0], acc[dt][1]); w.y = pk2(acc[dt][2], acc[dt][3]); *(u32x2*)(sp + dt * 16) = w; } } while (0)
#define P3A_KS(KO, VO, ks) do { bf16x8 ka[8]; tr_frag8<(KO) + (ks) * 8192>(ka, tpk); \
                _Pragma("unroll") for (int dt = 0; dt < 8; ++dt) acc[dt] = __builtin_amdgcn_mfma_f32_16x16x32_bf16(ka[dt], vb[ks], acc[dt], 0, 0, 0); } while (0)
#define P3A_SUB(KO, VO) do { _Pragma("unroll") for (int dt = 0; dt < 8; ++dt) acc[dt] *= gC; \
                bf16x8 vb[4]; tr_frag4<(VO), (VO) + 8192, (VO) + 16384, (VO) + 24576>(vb, tpv, tpv, tpv, tpv); \
                P3A_KS(KO, VO, 0); P3A_KS(KO, VO, 1); P3A_KS(KO, VO, 2); P3A_KS(KO, VO, 3); } while (0)
            P3A_LOAD(0);
            for (int st = 0; st < 9; ++st) {
#pragma unroll
                for (int sub = 0; sub < 2; ++sub)
#pragma unroll
                    for (int q = 0; q < 4; ++q) { const int p = F.tid + 512 * q, j = p >> 4, ch = p & 15;
                        const float kd = __builtin_amdgcn_exp2f(lg2 * (float)(dir ? j : 127 - j));
                        const u32x4 kk = kr[sub * 4 + q];
                        u32x4 ks; ks.x = pk2(bflo(kk.x) * kd, bfhi(kk.x) * kd); ks.y = pk2(bflo(kk.y) * kd, bfhi(kk.y) * kd); ks.z = pk2(bflo(kk.z) * kd, bfhi(kk.z) * kd); ks.w = pk2(bflo(kk.w) * kd, bfhi(kk.w) * kd);
                        *(LAS u32x4*)(F.lds + sub * 32768 + off_b(j, ch)) = ks; *(LAS u32x4*)(F.lds + 65536 + sub * 32768 + off_b(j, ch)) = vr[sub * 4 + q]; }
                LBAR();
                if (st < 8) P3A_LOAD(st + 1);
                const unsigned tpk = (unsigned)(size_t)F.lds + tr_base_p(F.lane); const unsigned tpv = (tpk ^ ((unsigned)F.wave << 5)) + 65536u;
                P3A_STORE(2 * st);
                P3A_SUB(0, 0);
                P3A_STORE(2 * st + 1);
                if (st < 8) P3A_SUB(32768, 32768);
                LBAR();
            }
#undef P3A_SUB
#undef P3A_KS
#undef P3A_STORE
#undef P3A_LOAD
#undef P3A_CI
        }
    } else {
        const int pb = F.bx - nstate, npb = F.G - nstate;
        u32x4 ld[10];
#define POOL_LOAD(tile_) do { const int r0_ = (tile_) * 64; int t0_, T_, rb_; if (r0_ < NLAT) { t0_ = r0_ & (TL - 1); T_ = TL; } else { t0_ = (r0_ - NLAT) & (CT - 1); T_ = CT; } rb_ = r0_ - t0_; \
            _Pragma("unroll") for (int q = 0; q < 10; ++q) { const int p = F.tid + 512 * q, rr = p >> 6, ch = p & 63; int tt = t0_ - 8 + rr; tt = tt < 0 ? 0 : (tt >= T_ ? T_ - 1 : tt); \
                ld[q] = *(const u32x4*)(P + (size_t)(rb_ + tt) * NP + 2048 + ch * 8); } } while (0)
        if (pb < 576) POOL_LOAD(pb);
        for (int tile = pb; tile < 576; tile += npb) {
            const int r0 = tile * 64; int t0, T; if (r0 < NLAT) { t0 = r0 & (TL - 1); T = TL; } else { t0 = (r0 - NLAT) & (CT - 1); T = CT; } const int rbase = r0 - t0;
            LBAR();
#pragma unroll
            for (int q = 0; q < 10; ++q) { const int p = F.tid + 512 * q; *(LAS u32x4*)(F.lds + (p >> 6) * 1024 + (p & 63) * 16) = ld[q]; }
            LBAR();
            if (tile + npb < 576) POOL_LOAD(tile + npb);
            for (int wi = F.wave; wi < 64; wi += 8) { const int g = wi & 3, rl = (wi >> 2) * 4 + (F.lane >> 4), cg = g * 16 + (F.lane & 15);
                if (g == 0) pool_item<1>(F.lds, A2, t0, T, rbase, rl, cg); else if (g == 1) pool_item<2>(F.lds, A2, t0, T, rbase, rl, cg);
                else if (g == 2) pool_item<4>(F.lds, A2, t0, T, rbase, rl, cg); else pool_item<8>(F.lds, A2, t0, T, rbase, rl, cg); }
        }
#undef POOL_LOAD
    }
    __syncthreads();
}

__device__ __forceinline__ void p3b_retention(const Frame& F, int l) {
    const bf16_t* P = (const bf16_t*)(F.ws + WS_P);
    const bf16_t* ST = (const bf16_t*)(F.ws + WS_ACT);
    bf16_t* A2 = hbuf(F);
    const int c_lo = (l == DEPTH - 1) ? 2 : 0, ncu = NCHUNK - c_lo, nunits = 64 * ncu;
    float lgF[NH], lgB[NH];
#pragma unroll
    for (int hh = 0; hh < NH; ++hh) { lgF[hh] = log2_gamma(F.in[I_DF][l * NH + hh]); lgB[hh] = log2_gamma(F.in[I_DB][l * NH + hh]); }
    u32x4 ld[8], st[8]; bf16x8 qf[4];
#define P3B_LOAD(unit_) do { const int bh_ = (unit_) / ncu, ci_ = c_lo + (unit_) % ncu, h_ = bh_ & 3; const int r0_ = chunk_row0(bh_ >> 2, ci_); \
        _Pragma("unroll") for (int q = 0; q < 4; ++q) { const int p = F.tid + 512 * q, j = p >> 4, ch = p & 15; \
            ld[q] = *(const u32x4*)(P + (size_t)(r0_ + j) * NP + 512 + h_ * 128 + ch * 8); ld[4 + q] = *(const u32x4*)(P + (size_t)(r0_ + j) * NP + 1024 + h_ * 128 + ch * 8); } } while (0)
#define P3B_LOADQ(unit_) do { const int bh_ = (unit_) / ncu, ci_ = c_lo + (unit_) % ncu, h_ = bh_ & 3; const int r0_ = chunk_row0(bh_ >> 2, ci_); \
        _Pragma("unroll") for (int ks = 0; ks < 4; ++ks) qf[ks] = *(const bf16x8*)(P + (size_t)(r0_ + F.wave * 16 + (F.lane & 15)) * NP + h_ * 128 + ks * 32 + (F.lane >> 4) * 8); } while (0)
    if (F.vcu < nunits) { P3B_LOAD(F.vcu); P3B_LOADQ(F.vcu); }
    for (int unit = F.vcu; unit < nunits; unit += F.G) {
        int lane_o = F.lane; asm volatile("" : "+v"(lane_o));
        const int fr = lane_o & 15, fq = lane_o >> 4;
        const unsigned rr0 = off_b((unsigned)fr, (unsigned)fq), tp = (unsigned)(size_t)F.lds + tr_base_p((unsigned)lane_o);
        const int il = F.wave * 16 + fr;
        const int bh = unit / ncu, ci = c_lo + unit % ncu, b = bh >> 2, h = bh & 3;
        const float lgf = h == 0 ? lgF[0] : h == 1 ? lgF[1] : h == 2 ? lgF[2] : lgF[3], lgb = h == 0 ? lgB[0] : h == 1 ? lgB[1] : h == 2 ? lgB[2] : lgB[3];
        const int row0 = chunk_row0(b, ci);
        { const bf16_t* sf = ST + ((size_t)((bh * 2 + 0) * NCHUNK + ci) * 128) * 128; const bf16_t* sb = ST + ((size_t)((bh * 2 + 1) * NCHUNK + ci) * 128) * 128;
#pragma unroll
          for (int q = 0; q < 4; ++q) { const int p = F.tid + 512 * q, j = p >> 4, ch = p & 15; st[q] = *(const u32x4*)(sf + (size_t)j * 128 + ch * 8); st[4 + q] = *(const u32x4*)(sb + (size_t)j * 128 + ch * 8); } }
        LBAR();
#pragma unroll
        for (int q = 0; q < 4; ++q) { const int p = F.tid + 512 * q, j = p >> 4, ch = p & 15; const unsigned o = off_b(j, ch);
            *(LAS u32x4*)(F.lds + o) = ld[q]; *(LAS u32x4*)(F.lds + 32768u + o) = ld[4 + q]; }
        LBAR();
        if (unit + F.G < nunits) P3B_LOAD(unit + F.G);
        u32x2 gg[8];
#pragma unroll
        for (int et = 0; et < 8; ++et) gg[et] = *(const u32x2*)(P + (size_t)(row0 + il) * NP + 1536 + h * 128 + 4 * fq + et * 16);
        bf16x8 pf[4];
#pragma unroll
        for (int ks2 = 0; ks2 < 4; ++ks2) {
            u32x2 half[2];
#pragma unroll
            for (int t = 0; t < 2; ++t) { const int jt = 2 * ks2 + t;
                asm volatile("" ::: "memory");
                f32x4 sa = (f32x4){0.f, 0.f, 0.f, 0.f};
#pragma unroll
                for (int ks = 0; ks < 4; ++ks) { const bf16x8 ka = *(const LAS bf16x8*)(F.lds + ((rr0 ^ ((unsigned)ks << 6)) + 4096u * jt)); sa = __builtin_amdgcn_mfma_f32_16x16x32_bf16(ka, qf[ks], sa, 0, 0, 0); }
                float pv[4];
#pragma unroll
                for (int r = 0; r < 4; ++r) { const int j = 16 * jt + 4 * fq + r, df = il - j;
                    const float w = df > 0 ? __builtin_amdgcn_exp2f(lgf * (float)df) : (df < 0 ? __builtin_amdgcn_exp2f(lgb * (float)(-df)) : 2.0f); pv[r] = sa[r] * w; }
                half[t].x = pk2(pv[0], pv[1]); half[t].y = pk2(pv[2], pv[3]); }
            const u32x4 w4 = (u32x4){half[0].x, half[0].y, half[1].x, half[1].y};
            pf[ks2] = __builtin_bit_cast(bf16x8, w4);
        }
#pragma unroll
        for (int q = 0; q < 4; ++q) { const int p = F.tid + 512 * q, j = p >> 4, ch = p & 15; const unsigned o = off_b(j, ch);
            *(LAS u32x4*)(F.lds + 65536u + o) = st[q]; *(LAS u32x4*)(F.lds + 98304u + o) = st[4 + q]; }
        LBAR();
        const float qdf = __builtin_amdgcn_exp2f(lgf * (float)(il + 1)), qdb = __builtin_amdgcn_exp2f(lgb * (float)(128 - il));
        float o[8][4]; float ss = 0.f;
#pragma unroll
        for (int et = 0; et < 8; ++et) {
            f32x4 ao = (f32x4){0.f, 0.f, 0.f, 0.f}, af = ao, ab = ao;
            bf16x8 va[4]; { const unsigned a = tp ^ ((unsigned)et << 5); tr_frag4<32768, 32768 + 8192, 32768 + 16384, 32768 + 24576>(va, a, a, a, a); }
#pragma unroll
            for (int ks = 0; ks < 4; ++ks) {
                ao = __builtin_amdgcn_mfma_f32_16x16x32_bf16(va[ks], pf[ks], ao, 0, 0, 0);
                const unsigned ra = (rr0 ^ ((unsigned)ks << 6)) + 4096u * et;
                const bf16x8 fa = *(const LAS bf16x8*)(F.lds + 65536u + ra);
                af = __builtin_amdgcn_mfma_f32_16x16x32_bf16(fa, qf[ks], af, 0, 0, 0);
                const bf16x8 ba = *(const LAS bf16x8*)(F.lds + 98304u + ra);
                ab = __builtin_amdgcn_mfma_f32_16x16x32_bf16(ba, qf[ks], ab, 0, 0, 0);
            }
#pragma unroll
            for (int r = 0; r < 4; ++r) { o[et][r] = ao[r] + qdf * af[r] + qdb * ab[r]; ss += o[et][r] * o[et][r]; }
        }
        if (unit + F.G < nunits) P3B_LOADQ(unit + F.G);
        ss += __shfl_xor(ss, 16); ss += __shfl_xor(ss, 32);
        const float rstd = 1.0f / sqrtf(ss * (1.0f / 128.0f) + EPS);
        bf16_t* op = A2 + (size_t)(row0 + il) * D + h * 128 + 4 * fq;
#pragma unroll
        for (int et = 0; et < 8; ++et) { const u32x2 g = gg[et];
            u32x2 w; w.x = pk2(silu_f(bflo(g.x)) * o[et][0] * rstd, silu_f(bfhi(g.x)) * o[et][1] * rstd); w.y = pk2(silu_f(bflo(g.y)) * o[et][2] * rstd, silu_f(bfhi(g.y)) * o[et][3] * rstd);
            *(u32x2*)(op + et * 16) = w; }
    }
#undef P3B_LOAD
#undef P3B_LOADQ
    __syncthreads();
}

#ifndef TYPE_MASK
#define TYPE_MASK 0x3ff
#endif
#define PTYPE(k) ((k) == 0 ? 0 : ((k) == 17 ? 9 : 1 + (((k) - 1) & 7)))
#define ENTER() do { if (PROBE_REPEAT >= 0) __syncthreads(); int _t = threadIdx.x; asm volatile("" : "+v"(_t)); F.tid = _t; F.lane = _t & 63; F.wave = __builtin_amdgcn_readfirstlane(_t >> 6); } while (0)
#define IN(k) (((TYPE_MASK >> PTYPE(k)) & 1) && lo <= (k) && (k) < hi)
#define SEAM(k) do { if (IN(k) && IN((k) + 1)) xcd_barrier(bar); } while (0)
#define REP(t) for (int rep = (PROBE_REPEAT == (t)) ? 0 : 1; rep < 2; ++rep)


template <int l> __device__ __forceinline__ void layer_phases(Frame& F, const XcdBarrier& bar, const int lo, const int hi) {
        const int pb = 1 + 8 * l;
        const bool last = (l == DEPTH - 1);
        const int Mrows = last ? NLAT : NTOK;
        if (IN(pb + 0)) REP(1) { ENTER(); row_op_a(F, l == 0 ? 0 : 1, rep == 0); }
        SEAM(pb + 0);
        if (IN(pb + 1)) REP(2) { ENTER();
            pg8::SchedDense S; S.init(NTOK, NP, D, F.G, F.bx);
            pg8::EpiInProj E{(bf16_t*)(F.ws + WS_P), (const float*)(F.ws + WS_ROPE), (const float*)(F.ws + WS_ROPE) + 96 * 32};
            pg8::gemm_phase<pg8::EpiInProj, pg8::SchedDense, true, true>(F.lds, F.tid, (const char*)hbuf(F), (const char*)(F.ws + WS_WIN) + (size_t)l * NP * D * 2, D, S, E);
        }
        SEAM(pb + 1);
        if (IN(pb + 2)) REP(3) { ENTER(); p3a_states_pool(F, l); }
        SEAM(pb + 2);
        if (IN(pb + 3)) REP(4) { ENTER(); p3b_retention(F, l); }
        SEAM(pb + 3);
        if (IN(pb + 4)) REP(5) { ENTER();
            pg8::SchedDense S; S.init(Mrows, D, D, F.G, F.bx);
            pg8::EpiResid E;
            if (l == 0) { E.rl = F.in[I_X]; E.rc = F.in[I_CTX]; E.rb = nullptr; } else { E.rl = nullptr; E.rc = nullptr; E.rb = (const bf16_t*)(F.ws + WS_XB); }
            E.ob = (rep == 0) ? (bf16_t*)(F.ws + WS_P) : (bf16_t*)(F.ws + WS_XB); E.ssq = (float*)(F.ws + WS_SSQ); E.gmod = mod_ptr(F, l, 0, 2);
            pg8::gemm_phase<pg8::EpiResid, pg8::SchedDense, true, true>(F.lds, F.tid, (const char*)hbuf(F), (const char*)(F.ws + WS_WOUT) + (size_t)l * D * D * 2, D, S, E);
        }
        SEAM(pb + 4);
        if (IN(pb + 5)) REP(6) { ENTER(); if (PROBE_REPEAT == 6 && rep == 0) row_op_b<true>(F, l); else row_op_b<false>(F, l); }
        SEAM(pb + 5);
        if (IN(pb + 6)) REP(7) { ENTER();
            LAS int* tb = build_tb(F, l);
            LAS int* tokt = (LAS int*)(F.lds + TOKT_OFF);
            const int* list = (const int*)(F.ws + WS_LIST);
            pg8::SchedGroup S; S.tb = tb; S.tokt = tokt; S.G = F.G; S.c = F.vcu; S.pitch = D; S.gather = 1;
            { int tokv[8];
#pragma unroll
              for (int i = 0; i < 8; ++i) { pg8::Unit u; tokv[i] = -1;
                  if (S.next(i, u)) { const int g = u.pm; const int e = (int)__popcll(__ballot(F.lane < NE && tb[F.lane + 1] <= g)); const int rt = g - tb[e], cnt = tb[64 + e];
                      if (F.tid < 256) { int r = rt * 256 + F.tid; if (r >= cnt) r = cnt - 1; tokv[i] = list[(size_t)e * NTOK + r]; } } }
#pragma unroll
              for (int i = 0; i < 8; ++i) if (F.tid < 256 && tokv[i] >= 0) tokt[i * 256 + F.tid] = tokv[i]; }
            __syncthreads();
            pg8::EpiSwiGLU8 E{(unsigned char*)(F.ws + WS_ACT), 1.0f / WGU_SCALE};
            pg8::gemm_phase<pg8::EpiSwiGLU8, pg8::SchedGroup, true, true, true>(F.lds, F.tid, (const char*)hbuf(F), (const char*)(F.ws + WS_WGU) + (size_t)l * NE * 1024 * D, D, S, E);
        }
        SEAM(pb + 6);
        if (IN(pb + 7)) REP(8) { ENTER();
            LAS int* tb = build_tb(F, l);
            pg8::SchedGroup S; S.tb = tb; S.tokt = nullptr; S.G = F.G; S.c = F.vcu; S.pitch = FF; S.gather = 0;
            pg8::EpiFp8S E{(unsigned char*)(F.ws + WS_P), D, 1.0f / WD_SCALE};
            pg8::gemm_phase<pg8::EpiFp8S, pg8::SchedGroup, true, true, true>(F.lds, F.tid, (const char*)(F.ws + WS_ACT), (const char*)(F.ws + WS_WD) + (size_t)l * NE * D * FF, FF, S, E);
        }
        SEAM(pb + 7);
}

__global__ void __launch_bounds__(512, 2) fwd_kernel(Args args) {
    extern __shared__ __attribute__((aligned(16))) unsigned char lds_raw[];
    Frame F;
    F.lds = (LAS unsigned char*)lds_raw; F.tid = threadIdx.x; F.lane = F.tid & 63; F.wave = __builtin_amdgcn_readfirstlane(F.tid >> 6);
    F.G = gridDim.x; F.bx = blockIdx.x; F.vcu = (F.G % 8 == 0) ? (F.bx % 8) * (F.G / 8) + F.bx / 8 : F.bx;
    F.in = args.in; F.out = args.out; F.ws = args.ws;
    volatile LAS unsigned* MISC = (volatile LAS unsigned*)(F.lds + MISC_OFF);
    if (F.tid < 4) MISC[F.tid] = 0u;
    __syncthreads();
    unsigned* ctl = (unsigned*)(F.ws + WS_CTL);
    XcdBarrier bar; bar.bar = ctl + CW_BAR; bar.x = 0; bar.st = nullptr;
    const int lo = args.ph_lo, hi = args.ph_hi;
    const bool multi = (hi - lo) > 1;
    if (multi) bar = xcd_barrier_post(ctl + CW_BAR, MISC);
    if (IN(0)) REP(0) { ENTER(); p0_prologue(F, rep); }
    SEAM(0);
    layer_phases<0>(F, bar, lo, hi);
    layer_phases<1>(F, bar, lo, hi);
    if (IN(17)) REP(9) { ENTER(); row_op_a(F, 2, rep == 0); }
#undef IN
#undef SEAM
}

extern "C" void kernel_launch(void* const* d_in, const int* in_sizes, int n_in, void* d_out, int out_size, void* d_ws, size_t ws_size, hipStream_t stream) {
    static int grid = 0;
    if (grid == 0) {
        if (n_in != 22 || out_size != NLAT * D || ws_size < WS_END) { fprintf(stderr, "kernel_launch: unexpected shapes (n_in %d, out %d, ws %zu)\n", n_in, out_size, ws_size); grid = -1; return; }
        int dev = 0, cus = 0, per_cu = 0;
        if (hipGetDevice(&dev) != hipSuccess || hipDeviceGetAttribute(&cus, hipDeviceAttributeMultiprocessorCount, dev) != hipSuccess) { grid = -1; return; }
        if (hipFuncSetAttribute((const void*)fwd_kernel, hipFuncAttributeMaxDynamicSharedMemorySize, LDS_BYTES) != hipSuccess) { fprintf(stderr, "kernel_launch: hipFuncSetAttribute failed\n"); grid = -1; return; }
        if (hipOccupancyMaxActiveBlocksPerMultiprocessor(&per_cu, (const void*)fwd_kernel, 512, LDS_BYTES) != hipSuccess || per_cu < 1) { fprintf(stderr, "kernel_launch: occupancy query says %d\n", per_cu); }
        (void)hipGetLastError();
        grid = cus;
    }
    if (grid < 0) return;
    (void)hipMemsetAsync((char*)d_ws + WS_CTL, 0, CTL_ZERO_BYTES, stream);
    Args a{};
    for (int i = 0; i < 22; ++i) a.in[i] = (const float*)d_in[i];
    a.out = (float*)d_out; a.ws = (unsigned char*)d_ws;
    if (MK_N_LAUNCHES == 1) { a.ph_lo = 0; a.ph_hi = N_PHASES; hipLaunchKernelGGL(fwd_kernel, dim3(grid), dim3(512), LDS_BYTES, stream, a); }
    else { for (int p = 0; p < N_PHASES; ++p) { a.ph_lo = p; a.ph_hi = p + 1; hipLaunchKernelGGL(fwd_kernel, dim3(grid), dim3(512), LDS_BYTES, stream, a); } }
}
```

```cpp
#include <hip/hip_runtime.h>
#include <cstdio>
#include <cstdint>

#ifndef MK_N_LAUNCHES
#define MK_N_LAUNCHES 1
#endif

#ifndef PROBE_REPEAT
#define PROBE_REPEAT -1
#endif
#define LAS __attribute__((address_space(3)))
#define GAS __attribute__((address_space(1)))
typedef unsigned short bf16_t;
typedef short bf16x8 __attribute__((ext_vector_type(8)));
typedef short s16x4 __attribute__((ext_vector_type(4)));
typedef float f32x4 __attribute__((ext_vector_type(4)));
typedef float f32x2 __attribute__((ext_vector_type(2)));
typedef unsigned u32x4 __attribute__((ext_vector_type(4)));
typedef unsigned u32x2 __attribute__((ext_vector_type(2)));

constexpr int Bn = 16, TL = 2048, CT = 256, D = 1024, DEPTH = 2;
constexpr int NLAT = Bn * TL, NCTX = Bn * CT, NTOK = NLAT + NCTX;
constexpr int NP = 2560;
constexpr int NE = 32, FF = 512, NH = 4, HD = 128;
constexpr int NCHUNK = 18;
constexpr float EPS = 1e-6f;
constexpr int MAXTILES = 320;
constexpr int N_PHASES = 18;

constexpr size_t MiB = 1u << 20;
constexpr size_t WS_CTL = 0, CTL_ZERO_BYTES = 1 * MiB;
constexpr size_t WS_MOD = 1 * MiB;
constexpr size_t WS_ROPE = 2 * MiB;
constexpr size_t WS_RIMG = 2 * MiB + 65536;
constexpr size_t WS_TOKINFO = 3 * MiB;
constexpr size_t WS_LIST = 5 * MiB;
constexpr size_t WS_WIN = 10 * MiB;
constexpr size_t WS_WOUT = 20 * MiB;
constexpr size_t WS_WGU = 24 * MiB;
constexpr size_t WS_WD = 152 * MiB;
constexpr size_t WS_SSQ = 216 * MiB;
constexpr size_t WS_XB = 232 * MiB;
constexpr size_t WS_P = 304 * MiB;
constexpr size_t WS_ACT = 484 * MiB;
constexpr size_t WS_END = 564 * MiB;
constexpr int CW_TMO = 0;
constexpr int CW_QUEUE = 512;
constexpr int CW_CNT = 1024;
constexpr int CW_BAR = 4096;

constexpr int RING_BYTES = 131072;
constexpr int TOKT_OFF = RING_BYTES;
constexpr int MISC_OFF = 161792;
constexpr int RW_PITCH = 2064;
constexpr int RW_LO = 36 * RW_PITCH, RW_EX = 2 * 36 * RW_PITCH;
constexpr int LDS_BYTES = 163840;

__device__ __forceinline__ unsigned f2bf(float f) { unsigned u = __builtin_bit_cast(unsigned, f); return (u + 0x7fffu + ((u >> 16) & 1u)) >> 16; }
typedef __bf16 bf16x2_t __attribute__((ext_vector_type(2)));
__device__ __forceinline__ unsigned pk2(float lo, float hi) { const f32x2 f = {lo, hi}; const bf16x2_t v = __builtin_convertvector(f, bf16x2_t); return __builtin_bit_cast(unsigned, v); }
__device__ __forceinline__ float bflo(unsigned w) { return __builtin_bit_cast(float, w << 16); }
__device__ __forceinline__ float bfhi(unsigned w) { return __builtin_bit_cast(float, w & 0xffff0000u); }
__device__ __forceinline__ float wave_sum(float v) {
#pragma unroll
    for (int o = 1; o < 64; o <<= 1) v += __shfl_xor(v, o);
    return v;
}
__device__ __forceinline__ float silu_f(float x) { return x * __builtin_amdgcn_rcpf(1.0f + __builtin_amdgcn_exp2f(-1.4426950408889634f * x)); }

#define XB_TMO      128
#define XB_XCNT(j)  (256  + 64 * (j))
#define XB_XSUB(j)  (1280 + 64 * (j))
#define XB_XGEN(j)  (2304 + 64 * (j))
#define XB_TOP      3328
#define XB_TOPGEN   3392
#define XCD_BAR_WORDS 3456
#define XB_SPIN_CAP (1u << 18)
__device__ __forceinline__ unsigned xb_ld(unsigned* p)              { return __hip_atomic_load(p, __ATOMIC_RELAXED, __HIP_MEMORY_SCOPE_AGENT); }
__device__ __forceinline__ unsigned xb_add(unsigned* p, unsigned v) { return __hip_atomic_fetch_add(p, v, __ATOMIC_RELAXED, __HIP_MEMORY_SCOPE_AGENT); }
__device__ __forceinline__ unsigned xb_xcc_id() { return (unsigned)__builtin_amdgcn_s_getreg((3 << 11) | 20) & 0xFu; }
#define XB_SPIN(cond, bar) do { unsigned _sp = 0; while (cond) { __builtin_amdgcn_s_sleep(1); \
    if ((++_sp & 255u) == 0u) { if (xb_ld(&(bar)[XB_TMO])) break; if (_sp > XB_SPIN_CAP) { atomicAdd(&(bar)[XB_TMO], 1u); break; } } } } while (0)
struct XcdBarrier { unsigned* bar; unsigned x; volatile LAS unsigned* st; };
__device__ __forceinline__ XcdBarrier xcd_barrier_post(unsigned* bar, volatile LAS unsigned* st) {
    XcdBarrier b; b.bar = bar; b.x = xb_xcc_id(); b.st = st;
    if (threadIdx.x == 0) (void)xb_add(&bar[XB_XCNT(b.x)], 1u);
    return b;
}
__device__ __forceinline__ void xcd_barrier_complete(unsigned* bar, unsigned x, unsigned& nloc, unsigned& nx) {
    const unsigned G = gridDim.x * gridDim.y * gridDim.z;
    unsigned sum, cnt, mine, sp = 0u;
    for (;;) {
        sum = 0u; cnt = 0u; mine = 0u;
#pragma unroll
        for (unsigned j = 0; j < 16; ++j) { const unsigned c = xb_ld(&bar[XB_XCNT(j)]); sum += c; cnt += (c > 0u) ? 1u : 0u; mine = (j == x) ? c : mine; }
        if (sum == G) break;
        __builtin_amdgcn_s_sleep(1);
        if ((++sp & 255u) == 0u) { if (xb_ld(&bar[XB_TMO])) break; if (sp > XB_SPIN_CAP) { atomicAdd(&bar[XB_TMO], 1u); break; } }
    }
    nloc = mine > 0u ? mine : 1u; nx = cnt > 0u ? cnt : 1u;
}
__device__ __forceinline__ void xcd_barrier(const XcdBarrier& b) {
    asm volatile("s_waitcnt vmcnt(0)" ::: "memory");
    __syncthreads();
    if (threadIdx.x == 0) {
        unsigned* bar = b.bar;
        __builtin_amdgcn_s_waitcnt(0);
        unsigned nloc = b.st[0], nx = b.st[1];
        if (nloc == 0u) { xcd_barrier_complete(bar, b.x, nloc, nx); b.st[0] = nloc; b.st[1] = nx; }
        const unsigned old = xb_add(&bar[XB_XSUB(b.x)], 1u);
        const unsigned gen = old / nloc;
        if (old + 1u == (gen + 1u) * nloc) {
            __builtin_amdgcn_fence(__ATOMIC_RELEASE, "agent");
            asm volatile("s_waitcnt vmcnt(0)" ::: "memory");
            const unsigned og = xb_add(&bar[XB_TOP], 1u);
            const unsigned tg = og / nx;
            if (og + 1u == (tg + 1u) * nx) xb_add(&bar[XB_TOPGEN], 1u);
            else XB_SPIN(xb_ld(&bar[XB_TOPGEN]) == tg, bar);
            __builtin_amdgcn_fence(__ATOMIC_ACQUIRE, "agent");
            xb_add(&bar[XB_XGEN(b.x)], 1u);
            asm volatile("s_waitcnt vmcnt(0)" ::: "memory");
        } else {
            XB_SPIN(xb_ld(&bar[XB_XGEN(b.x)]) == gen, bar);
            __builtin_amdgcn_fence(__ATOMIC_ACQUIRE, "agent");
            asm volatile("s_waitcnt vmcnt(0)" ::: "memory");
        }
    }
    __syncthreads();
}

namespace pg8 {
constexpr int BM = 256, BK = 64, HALF = 128, HTB = HALF * BK * 2, STAGE_BYTES = 8 * HTB, NXCD = 8, WGM = 8;
__device__ __forceinline__ int lds_byte(int r, int c) { const int st = (r >> 4) * 2 + (c >> 5), rr = r & 15, cc = c & 31, ob = rr * 64 + cc * 2; return st * 1024 + (ob ^ (((ob >> 9) & 1) << 5)); }
__device__ __forceinline__ void stage_rc(int b, int& R, int& C) { const int st = b / 1024, sb = b % 1024, swz = sb ^ (((sb >> 9) & 1) << 5); R = (st >> 1) * 16 + swz / 64; C = (st & 1) * 32 + (swz % 64) / 2; }
__device__ __forceinline__ int perm32(int rho) { const int n = rho >> 4, i = rho & 15; return 8 * (i >> 2) + 4 * n + (i & 3); }

struct Unit { int pm, pn; unsigned bofs; int aux; };

struct SchedDense {
    int nM, nN, nwg, G, c, K;
    __device__ void init(int M, int N, int K_, int G_, int c_) { nM = M / BM; nN = N / BM; nwg = nM * nN; G = G_; c = c_; K = K_; }
    __device__ bool next(int i, Unit& u) const {
        const long L = (long)i * G + c; if (L >= nwg) return false;
        int wgid = (int)L; { const int q = nwg / NXCD, r = nwg % NXCD, xcd = wgid % NXCD, off = wgid / NXCD; wgid = (xcd < r ? xcd * (q + 1) : r * (q + 1) + (xcd - r) * q) + off; }
        const int nig = WGM * nN, gid = wgid / nig, fm = gid * WGM, gsz = (nM - fm) < WGM ? (nM - fm) : WGM;
        u.pm = fm + ((wgid % nig) % gsz); u.pn = (wgid % nig) / gsz; u.bofs = (unsigned)u.pn * (unsigned)(BM * K * 2); u.aux = 0; return true;
    }
    __device__ __forceinline__ unsigned a_row(const Unit& u, int r) const { return (unsigned)(u.pm * BM + r); }
};
struct SchedGroup {
    const LAS int* tb; const LAS int* tokt; int G, c, pitch, gather;
    __device__ bool next(int i, Unit& u) const {
        const int L = i * G + c, nt = tb[NE]; if (L >= nt * 4) return false;
        const int g = L >> 2; const int ln = (int)(threadIdx.x & 63u);
        const int e = (int)__popcll(__ballot(ln < NE && tb[ln + 1] <= g));
        u.pm = g; u.pn = L & 3; u.bofs = (unsigned)(e * 1024 + u.pn * BM) * (unsigned)pitch; u.aux = i; return true;
    }
    __device__ __forceinline__ unsigned a_row(const Unit& u, int r) const { return gather ? (unsigned)tokt[u.aux * 256 + r] : (unsigned)(u.pm * BM + r); }
};

__device__ __forceinline__ unsigned cvt_pk_bf16(float lo, float hi) { unsigned r; asm volatile("v_cvt_pk_bf16_f32 %0, %1, %2" : "=v"(r) : "v"(lo), "v"(hi)); return r; }

typedef int i32x4 __attribute__((ext_vector_type(4)));
typedef int i32x8 __attribute__((ext_vector_type(8)));
template <bool F8> struct Frag { bf16x8 k[2]; };
template <> struct Frag<true> { i32x8 v; };
template <class Epi, class Sched, bool ALIGN_EPI, bool SP2, bool F8 = false>
__device__ __forceinline__ void gemm_phase(LAS unsigned char* lds, const int tid, const char* Abase, const char* Bbase, const int K, const Sched& S, const Epi& E) {
    const int wid = __builtin_amdgcn_readfirstlane(tid >> 6), lane = tid & 63, wr = wid >> 2, wc = wid & 3, fr = lane & 15, fq = lane >> 4;
    const int nt = F8 ? K / 128 : K / BK; const unsigned pitch = F8 ? (unsigned)K : 2u * (unsigned)K;
    int Rr[2], Cc[2]; unsigned voffB[2];
#pragma unroll
    for (int i = 0; i < 2; ++i) { int R, C; stage_rc(tid * 16 + i * 8192, R, C); const int Rb = Epi::PERM ? ((R & ~31) + perm32(R & 31)) : R;
        Rr[i] = R; Cc[i] = C; voffB[i] = (unsigned)Rb * pitch + 2u * (unsigned)C; }
    const size_t kstep = (size_t)(BK * 2);
    const size_t hstep = (size_t)HALF * pitch;
    const unsigned ldsw = (unsigned)wid * 1024u;
    const int fcol = F8 ? (fq >> 1) * 32 + (fq & 1) * 16 : fq * 8;
    const int aoff = lds_byte(wr * 64 + fr, fcol), boff = lds_byte(wc * 32 + fr, fcol);
#define PG8_SA(b, h) (((b) * 2 + (h)) * HTB)
#define PG8_SB(b, h) ((4 + (b) * 2 + (h)) * HTB)
#define PG8_STAGE(bufoff, gbase, voff) do { _Pragma("unroll") for (int _i = 0; _i < 2; ++_i) \
        __builtin_amdgcn_global_load_lds((const unsigned*)((const char*)(gbase) + (voff)[_i]), (LAS unsigned*)(lds + (bufoff) + ldsw + _i * 8192), 16, 0, 0); } while (0)
#define PG8_LDF(dstf, off_) do { if constexpr (F8) { const i32x4 _lo = *(const LAS i32x4*)(lds + (off_)), _hi = *(const LAS i32x4*)(lds + (off_) + 16); dstf.v = __builtin_shufflevector(_lo, _hi, 0, 1, 2, 3, 4, 5, 6, 7); } \
        else { dstf.k[0] = *(const LAS bf16x8*)(lds + (off_)); dstf.k[1] = *(const LAS bf16x8*)(lds + (off_) + 1024); } } while (0)
#define PG8_LDA(dst, b, h) do { _Pragma("unroll") for (int m = 0; m < 4; ++m) PG8_LDF(dst[m], PG8_SA(b, h) + aoff + m * 2048); } while (0)
#define PG8_LDB(dst, b, h) do { _Pragma("unroll") for (int n = 0; n < 2; ++n) PG8_LDF(dst[n], PG8_SB(b, h) + boff + n * 2048); } while (0)
#define PG8_MMA(ai, bj, At, Bt) do { __builtin_amdgcn_s_setprio(1); _Pragma("unroll") for (int m = 0; m < 4; ++m) _Pragma("unroll") for (int n = 0; n < 2; ++n) { \
        if constexpr (F8) asm volatile("v_mfma_f32_16x16x128_f8f6f4 %0, %1, %2, %0" : "+v"(acc[ai][bj][m][n]) : "v"(Bt[n].v), "v"(At[m].v));   \
        else { _Pragma("unroll") for (int k = 0; k < 2; ++k) acc[ai][bj][m][n] = __builtin_amdgcn_mfma_f32_16x16x32_bf16(Bt[n].k[k], At[m].k[k], acc[ai][bj][m][n], 0, 0, 0); } } \
        __builtin_amdgcn_s_setprio(0); } while (0)
#define PG8_WAIT_V(n) asm volatile("s_waitcnt vmcnt(" #n ")" ::: "memory")
#define PG8_WAIT_L(n) asm volatile("s_waitcnt lgkmcnt(" #n ")" ::: "memory")
#define PG8_BAR __builtin_amdgcn_s_barrier()
#define PG8_SCHED __builtin_amdgcn_sched_barrier(0)
#define PG8_AOFF(dst, u) do { _Pragma("unroll") for (int _h = 0; _h < 2; ++_h) _Pragma("unroll") for (int _i = 0; _i < 2; ++_i) \
        dst[_h][_i] = S.a_row(u, _h * HALF + Rr[_i]) * pitch + 2u * (unsigned)Cc[_i]; } while (0)
    Unit cur, nxt; int ui = 0;
    if (!S.next(0, cur)) return;
    f32x4 acc[2][2][4][2];
#pragma unroll
    for (int a = 0; a < 2; ++a)
#pragma unroll
        for (int b = 0; b < 2; ++b)
#pragma unroll
            for (int m = 0; m < 4; ++m)
#pragma unroll
                for (int n = 0; n < 2; ++n) acc[a][b][m][n] = (f32x4){0.f, 0.f, 0.f, 0.f};
    Frag<F8> At[4], B0[2], B1[2];
    unsigned co[2][2], no[2][2];
    PG8_AOFF(co, cur);
    const char* cB = Bbase + cur.bofs;
    if constexpr (SP2) {
        PG8_STAGE(PG8_SB(0, 0), cB, voffB); PG8_STAGE(PG8_SB(0, 1), cB + hstep, voffB); PG8_STAGE(PG8_SA(0, 0), Abase, co[0]); PG8_STAGE(PG8_SA(0, 1), Abase, co[1]);
        if (wr == 1) PG8_BAR;
        PG8_WAIT_V(2); PG8_BAR;
        PG8_STAGE(PG8_SB(1, 0), cB + kstep, voffB); PG8_STAGE(PG8_SA(1, 0), Abase + kstep, co[0]); PG8_STAGE(PG8_SB(1, 1), cB + hstep + kstep, voffB);
        PG8_WAIT_V(6); PG8_BAR;
    } else {
        PG8_STAGE(PG8_SB(0, 0), cB, voffB); PG8_STAGE(PG8_SA(0, 0), Abase, co[0]); PG8_STAGE(PG8_SB(0, 1), cB + hstep, voffB); PG8_STAGE(PG8_SA(0, 1), Abase, co[1]);
        if (wr == 1) PG8_BAR;
        PG8_WAIT_V(4); PG8_BAR;
        PG8_STAGE(PG8_SB(1, 0), cB + kstep, voffB); PG8_STAGE(PG8_SA(1, 0), Abase + kstep, co[0]); PG8_STAGE(PG8_SB(1, 1), cB + hstep + kstep, voffB);
        PG8_WAIT_V(6); PG8_BAR;
    }
    for (;;) {
        const bool has_next = S.next(ui + 1, nxt);
        const char* nB = has_next ? Bbase + nxt.bofs : cB;
        if (has_next) { PG8_AOFF(no, nxt); } else {
#pragma unroll
            for (int h = 0; h < 2; ++h)
#pragma unroll
                for (int i = 0; i < 2; ++i) no[h][i] = co[h][i]; }
#pragma unroll 1
        for (int t = 0; t < nt; t += 2) {
            const bool last = (t == nt - 2);
            const char* a1 = Abase + (size_t)(t + 1) * kstep;
            const char* a2 = last ? Abase : Abase + (size_t)(t + 2) * kstep; const char* b2 = last ? nB : cB + (size_t)(t + 2) * kstep;
            const char* a3 = a2 + kstep; const char* b3 = b2 + kstep;
            unsigned o2[2][2];
#pragma unroll
            for (int h = 0; h < 2; ++h)
#pragma unroll
                for (int i = 0; i < 2; ++i) o2[h][i] = last ? no[h][i] : co[h][i];
            if constexpr (SP2) {
            PG8_LDB(B0, 0, 0); PG8_LDB(B1, 0, 1); PG8_SCHED; PG8_LDA(At, 0, 0); PG8_STAGE(PG8_SA(1, 1), a1, co[1]);
            PG8_WAIT_V(8); PG8_WAIT_L(0); PG8_BAR; PG8_MMA(0, 0, At, B0); PG8_MMA(0, 1, At, B1); PG8_BAR; PG8_SCHED;
            PG8_LDA(At, 0, 1); PG8_STAGE(PG8_SB(0, 0), b2, voffB); PG8_STAGE(PG8_SB(0, 1), b2 + hstep, voffB); PG8_STAGE(PG8_SA(0, 0), a2, o2[0]);
            PG8_WAIT_V(8); PG8_WAIT_L(0); PG8_BAR; PG8_MMA(1, 0, At, B0); PG8_MMA(1, 1, At, B1); PG8_BAR; PG8_SCHED;
            PG8_LDB(B0, 1, 0); PG8_LDB(B1, 1, 1); PG8_SCHED; PG8_LDA(At, 1, 0); PG8_STAGE(PG8_SA(0, 1), a2, o2[1]);
            PG8_WAIT_V(8); PG8_WAIT_L(0); PG8_BAR; PG8_MMA(0, 0, At, B0); PG8_MMA(0, 1, At, B1); PG8_BAR; PG8_SCHED;
            PG8_LDA(At, 1, 1); PG8_STAGE(PG8_SB(1, 0), b3, voffB); PG8_STAGE(PG8_SB(1, 1), b3 + hstep, voffB); PG8_STAGE(PG8_SA(1, 0), a3, o2[0]);
            PG8_WAIT_V(8); PG8_WAIT_L(0); PG8_BAR; PG8_MMA(1, 0, At, B0); PG8_MMA(1, 1, At, B1); PG8_BAR; PG8_SCHED;
            } else {
            PG8_LDB(B0, 0, 0); PG8_SCHED; PG8_LDA(At, 0, 0); PG8_STAGE(PG8_SA(1, 1), a1, co[1]);
            PG8_WAIT_L(8); PG8_BAR; PG8_WAIT_L(0); PG8_MMA(0, 0, At, B0); PG8_BAR; PG8_SCHED;
            PG8_LDB(B1, 0, 1); PG8_STAGE(PG8_SB(0, 0), b2, voffB);
            PG8_BAR; PG8_WAIT_L(0); PG8_MMA(0, 1, At, B1); PG8_BAR;
            PG8_LDA(At, 0, 1); PG8_STAGE(PG8_SA(0, 0), a2, o2[0]);
            PG8_BAR; PG8_WAIT_L(0); PG8_MMA(1, 0, At, B0); PG8_BAR; PG8_SCHED;
            PG8_STAGE(PG8_SB(0, 1), b2 + hstep, voffB);
            PG8_WAIT_V(6); PG8_BAR; PG8_MMA(1, 1, At, B1); PG8_BAR;
            PG8_LDB(B0, 1, 0); PG8_SCHED; PG8_LDA(At, 1, 0); PG8_STAGE(PG8_SA(0, 1), a2, o2[1]);
            PG8_WAIT_L(8); PG8_BAR; PG8_WAIT_L(0); PG8_MMA(0, 0, At, B0); PG8_BAR; PG8_SCHED;
            PG8_LDB(B1, 1, 1); PG8_STAGE(PG8_SB(1, 0), b3, voffB);
            PG8_BAR; PG8_WAIT_L(0); PG8_MMA(0, 1, At, B1); PG8_BAR;
            PG8_LDA(At, 1, 1); PG8_STAGE(PG8_SA(1, 0), a3, o2[0]);
            PG8_BAR; PG8_WAIT_L(0); PG8_MMA(1, 0, At, B0); PG8_BAR; PG8_SCHED;
            PG8_STAGE(PG8_SB(1, 1), b3 + hstep, voffB);
            PG8_WAIT_V(6); PG8_BAR; PG8_MMA(1, 1, At, B1); PG8_BAR;
            }
        }
        if constexpr (ALIGN_EPI) { if (wr == 0) PG8_BAR; }
        if constexpr (F8) { __builtin_amdgcn_sched_barrier(0); asm volatile("s_nop 15\n\ts_nop 15\n\ts_nop 7" ::: "memory"); __builtin_amdgcn_sched_barrier(0); }
        E(acc, cur, wr, wc, fr, fq);
        if (!has_next) break;
#pragma unroll
        for (int a = 0; a < 2; ++a)
#pragma unroll
            for (int b = 0; b < 2; ++b)
#pragma unroll
                for (int m = 0; m < 4; ++m)
#pragma unroll
                    for (int n = 0; n < 2; ++n) acc[a][b][m][n] = (f32x4){0.f, 0.f, 0.f, 0.f};
        cur = nxt; cB = nB; ++ui;
#pragma unroll
        for (int h = 0; h < 2; ++h)
#pragma unroll
            for (int i = 0; i < 2; ++i) co[h][i] = no[h][i];
        if constexpr (ALIGN_EPI) { if (wr == 1) PG8_BAR; }
    }
    PG8_WAIT_V(0);
    if constexpr (!ALIGN_EPI) { if (wr == 0) PG8_BAR; }
    PG8_BAR;
#undef PG8_SA
#undef PG8_SB
#undef PG8_STAGE
#undef PG8_LDA
#undef PG8_LDF
#undef PG8_LDB
#undef PG8_MMA
#undef PG8_WAIT_V
#undef PG8_WAIT_L
#undef PG8_BAR
#undef PG8_SCHED
#undef PG8_AOFF
}

struct EpiInProj {
    static constexpr bool PERM = true;
    bf16_t* P; const float* ropeC; const float* ropeS;
    __device__ __forceinline__ void operator()(const f32x4 (&acc)[2][2][4][2], const Unit& u, int wr, int wc, int fr, int fq) const {
        const int row0 = u.pm * BM + wr * 64 + fr, col0 = u.pn * BM + wc * 32 + 8 * fq;
        const bool qk = u.pn < 4, rope = qk && (u.pm < NLAT / BM);
        const float ks = (u.pn >= 2 && u.pn < 4) ? 0.08838834764831845f : 1.0f;
        const int sec = wc >> 1, i0 = (wc & 1) * 16 + 4 * fq;
#pragma unroll
        for (int ai = 0; ai < 2; ++ai)
#pragma unroll
            for (int m = 0; m < 4; ++m) {
                const int row = row0 + ai * HALF + m * 16;
                asm volatile("" ::: "memory");
                f32x4 c4 = (f32x4){1.f, 1.f, 1.f, 1.f}, s4 = (f32x4){0.f, 0.f, 0.f, 0.f};
                if (rope) { const int t = row & (TL - 1), pos = sec ? (t & 63) : (t >> 6); const int ti = (sec ? 1024 : 0) + pos * 32 + i0;
                    c4 = *(const f32x4*)(ropeC + ti); s4 = *(const f32x4*)(ropeS + ti); }
                bf16_t* rowp = P + (size_t)row * NP + col0;
#pragma unroll
                for (int bj = 0; bj < 2; ++bj) {
                    f32x4 v0 = acc[ai][bj][m][0], v1 = acc[ai][bj][m][1];
                    if (qk) {
                        const float a0 = v0[0] * c4[0] - v0[1] * s4[0], b0 = v0[0] * s4[0] + v0[1] * c4[0];
                        const float a1 = v0[2] * c4[1] - v0[3] * s4[1], b1 = v0[2] * s4[1] + v0[3] * c4[1];
                        const float a2 = v1[0] * c4[2] - v1[1] * s4[2], b2 = v1[0] * s4[2] + v1[1] * c4[2];
                        const float a3 = v1[2] * c4[3] - v1[3] * s4[3], b3 = v1[2] * s4[3] + v1[3] * c4[3];
                        v0 = (f32x4){a0 * ks, b0 * ks, a1 * ks, b1 * ks}; v1 = (f32x4){a2 * ks, b2 * ks, a3 * ks, b3 * ks};
                    }
                    u32x4 w; w.x = cvt_pk_bf16(v0[0], v0[1]); w.y = cvt_pk_bf16(v0[2], v0[3]); w.z = cvt_pk_bf16(v1[0], v1[1]); w.w = cvt_pk_bf16(v1[2], v1[3]);
                    *(u32x4*)(rowp + bj * HALF) = w;
                }
            }
    }
};
struct EpiResid {
    static constexpr bool PERM = true;
    const float* rl; const float* rc; const bf16_t* rb; bf16_t* ob; float* ssq; const float* gmod;
    __device__ __forceinline__ void operator()(const f32x4 (&acc)[2][2][4][2], const Unit& u, int wr, int wc, int fr, int fq) const {
        const int row0 = u.pm * BM + wr * 64 + fr, col0 = u.pn * BM + wc * 32 + 8 * fq;
        const bool lat = u.pm < NLAT / BM; const int b = lat ? (u.pm >> 3) : 16;
        const float* rbase = rl ? (lat ? rl : rc - (size_t)NLAT * D) : nullptr;
        f32x4 gv[2][2];
#pragma unroll
        for (int bj = 0; bj < 2; ++bj)
#pragma unroll
            for (int n = 0; n < 2; ++n) gv[bj][n] = *(const f32x4*)(gmod + (size_t)b * 6 * D + col0 + bj * HALF + 4 * n);
#pragma unroll
        for (int ai = 0; ai < 2; ++ai)
#pragma unroll
            for (int m = 0; m < 4; ++m) { const int row = row0 + ai * HALF + m * 16; const size_t off = (size_t)row * D + col0; float ss = 0.f;
#pragma unroll
                for (int bj = 0; bj < 2; ++bj) { f32x4 r0, r1;
                    if (rbase) { r0 = *(const f32x4*)(rbase + off + bj * HALF); r1 = *(const f32x4*)(rbase + off + bj * HALF + 4); }
                    else { const u32x4 w = *(const u32x4*)(rb + off + bj * HALF); r0 = (f32x4){bflo(w.x), bfhi(w.x), bflo(w.y), bfhi(w.y)}; r1 = (f32x4){bflo(w.z), bfhi(w.z), bflo(w.w), bfhi(w.w)}; }
                    const f32x4 v0 = r0 + gv[bj][0] * acc[ai][bj][m][0], v1 = r1 + gv[bj][1] * acc[ai][bj][m][1];
                    ss += (v0[0] * v0[0] + v0[1] * v0[1]) + (v0[2] * v0[2] + v0[3] * v0[3]) + (v1[0] * v1[0] + v1[1] * v1[1]) + (v1[2] * v1[2] + v1[3] * v1[3]);
                    u32x4 w; w.x = cvt_pk_bf16(v0[0], v0[1]); w.y = cvt_pk_bf16(v0[2], v0[3]); w.z = cvt_pk_bf16(v1[0], v1[1]); w.w = cvt_pk_bf16(v1[2], v1[3]);
                    *(u32x4*)(ob + off + bj * HALF) = w; }
                ss += __shfl_xor(ss, 16); ss += __shfl_xor(ss, 32);
                if (fq == 0) ssq[(size_t)row * 16 + u.pn * 4 + wc] = ss;
                if (m & 1) asm volatile("" ::: "memory"); }
    }
};
struct EpiSwiGLU {
    static constexpr bool PERM = true;
    bf16_t* O;
    __device__ __forceinline__ void operator()(const f32x4 (&acc)[2][2][4][2], const Unit& u, int wr, int wc, int fr, int fq) const {
        const int row0 = u.pm * BM + wr * 64 + fr, col0 = u.pn * 128 + wc * 16 + 4 * fq;
#pragma unroll
        for (int ai = 0; ai < 2; ++ai)
#pragma unroll
            for (int m = 0; m < 4; ++m) { bf16_t* rowp = O + (size_t)(row0 + ai * HALF + m * 16) * FF + col0;
#pragma unroll
                for (int bj = 0; bj < 2; ++bj) { const f32x4 g = acc[ai][bj][m][0], up = acc[ai][bj][m][1];
                    u32x2 w; w.x = cvt_pk_bf16(silu_f(g[0]) * up[0], silu_f(g[1]) * up[1]); w.y = cvt_pk_bf16(silu_f(g[2]) * up[2], silu_f(g[3]) * up[3]);
                    *(u32x2*)(rowp + bj * 64) = w; } }
    }
};
__device__ __forceinline__ unsigned pk4_fp8(float a, float b, float c, float d) { int p = __builtin_amdgcn_cvt_pk_fp8_f32(a, b, 0, false); p = __builtin_amdgcn_cvt_pk_fp8_f32(c, d, p, true); return (unsigned)p; }
struct EpiSwiGLU8 {
    static constexpr bool PERM = true;
    unsigned char* O; float inv;
    __device__ __forceinline__ void operator()(const f32x4 (&acc)[2][2][4][2], const Unit& u, int wr, int wc, int fr, int fq) const {
        const int row0 = u.pm * BM + wr * 64 + fr, col0 = u.pn * 128 + wc * 32 + 8 * fq;
#pragma unroll
        for (int ai = 0; ai < 2; ++ai)
#pragma unroll
            for (int m = 0; m < 4; ++m) { unsigned char* rowp = O + (size_t)(row0 + ai * HALF + m * 16) * FF + col0;
                const f32x4 g0 = acc[ai][0][m][0] * inv, g1 = acc[ai][0][m][1] * inv, u0 = acc[ai][1][m][0] * inv, u1 = acc[ai][1][m][1] * inv;
                u32x2 w; w.x = pk4_fp8(silu_f(g0[0]) * u0[0], silu_f(g0[1]) * u0[1], silu_f(g0[2]) * u0[2], silu_f(g0[3]) * u0[3]);
                w.y = pk4_fp8(silu_f(g1[0]) * u1[0], silu_f(g1[1]) * u1[1], silu_f(g1[2]) * u1[2], silu_f(g1[3]) * u1[3]);
                *(u32x2*)rowp = w; }
    }
};
struct EpiFp8S {
    static constexpr bool PERM = true;
    unsigned char* O; int ldc; float inv;
    __device__ __forceinline__ void operator()(const f32x4 (&acc)[2][2][4][2], const Unit& u, int wr, int wc, int fr, int fq) const {
        const int row0 = u.pm * BM + wr * 64 + fr, col0 = u.pn * BM + wc * 32 + 8 * fq;
#pragma unroll
        for (int ai = 0; ai < 2; ++ai)
#pragma unroll
            for (int m = 0; m < 4; ++m) { unsigned char* rowp = O + (size_t)(row0 + ai * HALF + m * 16) * ldc + col0;
#pragma unroll
                for (int bj = 0; bj < 2; ++bj) { const f32x4 v0 = acc[ai][bj][m][0] * inv, v1 = acc[ai][bj][m][1] * inv;
                    u32x2 w; w.x = pk4_fp8(v0[0], v0[1], v0[2], v0[3]); w.y = pk4_fp8(v1[0], v1[1], v1[2], v1[3]);
                    *(u32x2*)(rowp + bj * HALF) = w; } }
    }
};
struct EpiBf16S {
    static constexpr bool PERM = true;
    bf16_t* O; int ldc; float inv;
    __device__ __forceinline__ void operator()(const f32x4 (&acc)[2][2][4][2], const Unit& u, int wr, int wc, int fr, int fq) const {
        const int row0 = u.pm * BM + wr * 64 + fr, col0 = u.pn * BM + wc * 32 + 8 * fq;
#pragma unroll
        for (int ai = 0; ai < 2; ++ai)
#pragma unroll
            for (int m = 0; m < 4; ++m) { bf16_t* rowp = O + (size_t)(row0 + ai * HALF + m * 16) * ldc + col0;
#pragma unroll
                for (int bj = 0; bj < 2; ++bj) { const f32x4 v0 = acc[ai][bj][m][0] * inv, v1 = acc[ai][bj][m][1] * inv;
                    u32x4 w; w.x = cvt_pk_bf16(v0[0], v0[1]); w.y = cvt_pk_bf16(v0[2], v0[3]); w.z = cvt_pk_bf16(v1[0], v1[1]); w.w = cvt_pk_bf16(v1[2], v1[3]);
                    *(u32x4*)(rowp + bj * HALF) = w; } }
    }
};
struct EpiBf16 {
    static constexpr bool PERM = true;
    bf16_t* O; int ldc;
    __device__ __forceinline__ void operator()(const f32x4 (&acc)[2][2][4][2], const Unit& u, int wr, int wc, int fr, int fq) const {
        const int row0 = u.pm * BM + wr * 64 + fr, col0 = u.pn * BM + wc * 32 + 8 * fq;
#pragma unroll
        for (int ai = 0; ai < 2; ++ai)
#pragma unroll
            for (int m = 0; m < 4; ++m) { bf16_t* rowp = O + (size_t)(row0 + ai * HALF + m * 16) * ldc + col0;
#pragma unroll
                for (int bj = 0; bj < 2; ++bj) { const f32x4 v0 = acc[ai][bj][m][0], v1 = acc[ai][bj][m][1];
                    u32x4 w; w.x = cvt_pk_bf16(v0[0], v0[1]); w.y = cvt_pk_bf16(v0[2], v0[3]); w.z = cvt_pk_bf16(v1[0], v1[1]); w.w = cvt_pk_bf16(v1[2], v1[3]);
                    *(u32x4*)(rowp + bj * HALF) = w; } }
    }
};
}

struct Args { const float* in[22]; float* out; unsigned char* ws; int ph_lo, ph_hi; };
enum { I_X = 0, I_C, I_CTX, I_CCTX, I_ADAW, I_ADAB, I_N1G, I_WIN, I_DF, I_DB, I_POOLW, I_POOLS, I_WOUT, I_N2G, I_RGW, I_RGB, I_REW, I_REB, I_WG, I_WU, I_WDN, I_FNG };

struct Frame {
    LAS unsigned char* lds; int tid, lane, wave, G, bx, vcu;
    const float* const* in; float* out; unsigned char* ws;
};
__device__ __forceinline__ bf16_t* xb_row(const Frame& F, int row) { return (bf16_t*)(F.ws + WS_XB) + (size_t)row * D; }
__device__ __forceinline__ bf16_t* hbuf(const Frame& F) { return (bf16_t*)F.out; }
__device__ __forceinline__ const float* mod_ptr(const Frame& F, int l, int b, int which) { return (const float*)(F.ws + WS_MOD) + ((size_t)(l * 17 + b) * 6 + which) * D; }

__device__ __forceinline__ void tr_item(const float* colp, size_t ldw, int k0, bf16_t* WT, int K, int n0, LAS float* scr, int lane) {
    { float v[32];
#pragma unroll
        for (int i = 0; i < 32; ++i) v[i] = colp[(size_t)(k0 + 2 * i + (lane >> 5)) * ldw];
#pragma unroll
        for (int i = 0; i < 32; ++i) scr[(2 * i + (lane >> 5)) * 33 + (lane & 31)] = v[i]; }
    asm volatile("s_waitcnt lgkmcnt(0)" ::: "memory");
    const int c = lane & 7;
#pragma unroll
    for (int j = 0; j < 4; ++j) { const int n = (lane >> 3) + 8 * j; const LAS float* s = scr + (8 * c) * 33 + n;
        u32x4 o; o.x = pk2(s[0 * 33], s[1 * 33]); o.y = pk2(s[2 * 33], s[3 * 33]); o.z = pk2(s[4 * 33], s[5 * 33]); o.w = pk2(s[6 * 33], s[7 * 33]);
        *(u32x4*)(WT + (size_t)(n0 + n) * K + k0 + 8 * c) = o; }
    asm volatile("s_waitcnt lgkmcnt(0)" ::: "memory");
}
constexpr float WGU_SCALE = 64.0f, WD_SCALE = 32.0f;
__device__ __forceinline__ void tr_item8(const float* colp, size_t ldw, int k0, unsigned char* WT, int K, int n0, LAS float* scr, int lane, float qs) {
    { float v[32];
#pragma unroll
        for (int i = 0; i < 32; ++i) v[i] = colp[(size_t)(k0 + 2 * i + (lane >> 5)) * ldw];
#pragma unroll
        for (int i = 0; i < 32; ++i) scr[(2 * i + (lane >> 5)) * 33 + (lane & 31)] = v[i] * qs; }
    asm volatile("s_waitcnt lgkmcnt(0)" ::: "memory");
    const int c = lane & 7;
#pragma unroll
    for (int j = 0; j < 4; ++j) { const int n = (lane >> 3) + 8 * j; const LAS float* s = scr + (8 * c) * 33 + n;
        u32x2 o; o.x = pg8::pk4_fp8(s[0 * 33], s[1 * 33], s[2 * 33], s[3 * 33]); o.y = pg8::pk4_fp8(s[4 * 33], s[5 * 33], s[6 * 33], s[7 * 33]);
        *(u32x2*)(WT + (size_t)(n0 + n) * K + k0 + 8 * c) = o; }
    asm volatile("s_waitcnt lgkmcnt(0)" ::: "memory");
}
__device__ __forceinline__ void fold_item(const float* win, const float* pw, const float* ps, int k0, bf16_t* WT, int n0, LAS float* scr, int lane) {
    const int n = n0 + (lane & 31), g = n >> 7, nn = n & 127;
    const float* pwc = pw + (size_t)g * 128 * 128 + nn; const float sc = ps[n];
    float acc[32];
#pragma unroll
    for (int i = 0; i < 32; ++i) acc[i] = 0.f;
    for (int hc = 0; hc < 8; ++hc) {
        float pc[16];
#pragma unroll
        for (int c = 0; c < 16; ++c) pc[c] = pwc[(size_t)(hc * 16 + c) * 128];
#pragma unroll
        for (int i = 0; i < 32; ++i) { const f32x4* wr = (const f32x4*)(win + (size_t)(k0 + 2 * i + (lane >> 5)) * NP + 2048 + g * 128 + hc * 16);
            float a = acc[i];
#pragma unroll
            for (int c4 = 0; c4 < 4; ++c4) { const f32x4 w = wr[c4]; a += w[0] * pc[4 * c4] + w[1] * pc[4 * c4 + 1] + w[2] * pc[4 * c4 + 2] + w[3] * pc[4 * c4 + 3]; }
            acc[i] = a; }
    }
#pragma unroll
    for (int i = 0; i < 32; ++i) scr[(2 * i + (lane >> 5)) * 33 + (lane & 31)] = acc[i] * sc;
    asm volatile("s_waitcnt lgkmcnt(0)" ::: "memory");
    const int c = lane & 7;
#pragma unroll
    for (int j = 0; j < 4; ++j) { const int nl = (lane >> 3) + 8 * j; const LAS float* s = scr + (8 * c) * 33 + nl;
        u32x4 o; o.x = pk2(s[0 * 33], s[1 * 33]); o.y = pk2(s[2 * 33], s[3 * 33]); o.z = pk2(s[4 * 33], s[5 * 33]); o.w = pk2(s[6 * 33], s[7 * 33]);
        *(u32x4*)(WT + (size_t)(2048 + n0 + nl) * D + k0 + 8 * c) = o; }
    asm volatile("s_waitcnt lgkmcnt(0)" ::: "memory");
}
__device__ __forceinline__ void p0_prologue(const Frame& F, int qsel) {
    for (int task = F.bx; task < 2 * 96; task += F.G) {
        const int l = task / 96, cg = task % 96;
        LAS float* sc = (LAS float*)F.lds;
        LAS float* part = (LAS float*)(F.lds + 17 * 1024 * 4);
        { float cv[34];
#pragma unroll
          for (int q = 0; q < 34; ++q) { const int i = F.tid + 512 * q, b = i >> 10, k = i & 1023; cv[q] = b < 16 ? F.in[I_C][b * D + k] : F.in[I_CCTX][k]; }
#pragma unroll
          for (int q = 0; q < 34; ++q) sc[F.tid + 512 * q] = silu_f(cv[q]); }
        __syncthreads();
        float acc[17];
#pragma unroll
        for (int b = 0; b < 17; ++b) acc[b] = 0.f;
        const float* aw = F.in[I_ADAW] + (size_t)l * D * 6 * D + cg * 64 + F.lane;
        for (int k0 = F.wave * 128; k0 < F.wave * 128 + 128; k0 += 16) { float w[16];
#pragma unroll
            for (int u = 0; u < 16; ++u) w[u] = aw[(size_t)(k0 + u) * 6 * D];
#pragma unroll
            for (int u = 0; u < 16; ++u) {
#pragma unroll
                for (int b = 0; b < 17; ++b) acc[b] += sc[b * 1024 + k0 + u] * w[u]; } }
#pragma unroll
        for (int b = 0; b < 17; ++b) part[(F.wave * 17 + b) * 64 + F.lane] = acc[b];
        __syncthreads();
        for (int i = F.tid; i < 17 * 64; i += 512) { const int b = i >> 6, n = i & 63; float s = F.in[I_ADAB][l * 6 * D + cg * 64 + n];
#pragma unroll
            for (int w = 0; w < 8; ++w) s += part[(w * 17 + b) * 64 + n];
            const int col = cg * 64 + n; ((float*)(F.ws + WS_MOD))[((size_t)(l * 17 + b) * 6 + (col >> 10)) * D + (col & 1023)] = s; }
        __syncthreads();
    }
    if (F.bx >= F.G - 3 && F.bx < F.G - 1) { const int l = F.G - 2 - F.bx; unsigned char* img = F.ws + WS_RIMG + (size_t)l * RW_EX;
        const float* rg = F.in[I_RGW] + (size_t)l * D * 4; const float* re = F.in[I_REW] + (size_t)l * D * NE;
        for (int i0 = F.tid; i0 < 1024 * 36; i0 += 512 * 8) { float w[8];
#pragma unroll
            for (int q = 0; q < 8; ++q) { const int i = i0 + 512 * q, k = i / 36, n = i % 36; w[q] = n < 4 ? rg[k * 4 + n] : re[k * NE + (n - 4)]; }
#pragma unroll
            for (int q = 0; q < 8; ++q) { const int i = i0 + 512 * q, k = i / 36, n = i % 36; const unsigned hi = f2bf(w[q]), lo = f2bf(w[q] - bflo(hi));
                *(bf16_t*)(img + n * RW_PITCH + k * 2) = (bf16_t)hi; *(bf16_t*)(img + RW_LO + n * RW_PITCH + k * 2) = (bf16_t)lo; } }
        for (int i = F.tid; i < 2 * 36 * 8; i += 512) { const int r = i >> 3; *(bf16_t*)(img + r * RW_PITCH + 2048 + (i & 7) * 2) = 0; }
    }
    if (F.bx == F.G - 1) {
        float* rc = (float*)(F.ws + WS_ROPE); float* rs = rc + 96 * 32;
        for (int i = F.tid; i < 96 * 32; i += 512) { const int p = i >> 5, f = i & 31; const int pos = p < 32 ? p : p - 32;
            const float inv = powf(10000.0f, -(float)f / 32.0f); const float ang = (float)pos * inv; rc[i] = cosf(ang); rs[i] = sinf(ang); }
    }
    LAS float* scr = (LAS float*)(F.lds + F.wave * 8448);
    constexpr int IT_WIN = 16 * 80, IT_WOUT = 16 * 32, IT_GU = 16 * 32, IT_DN = 8 * 32;
    constexpr int N_WIN = DEPTH * IT_WIN, N_WOUT = DEPTH * IT_WOUT, N_GU = DEPTH * NE * IT_GU, N_DN = DEPTH * NE * IT_DN;
    unsigned* qhead = (unsigned*)(F.ws + WS_CTL) + CW_QUEUE + 16 * qsel;
    constexpr int N_ALL = N_WIN + N_WOUT + N_GU + N_DN, QB = 16, NBATCH = N_ALL / QB;
    static_assert(N_ALL % QB == 0, "queue batches");
    for (;;) {
        int bq = 0; if (F.lane == 0) bq = (int)__hip_atomic_fetch_add(qhead, 1u, __ATOMIC_RELAXED, __HIP_MEMORY_SCOPE_AGENT);
        bq = __builtin_amdgcn_readfirstlane(bq);
        if (bq >= NBATCH) break;
      for (int qi = 0; qi < QB; ++qi) {
        int r = bq + qi * NBATCH;
        if (r < N_WIN) { const int l = r / IT_WIN; r %= IT_WIN; const int kb = r & 15, nb = 79 - (r >> 4), n0 = nb * 32;
            const float* win = F.in[I_WIN] + (size_t)l * D * NP; bf16_t* WT = (bf16_t*)(F.ws + WS_WIN) + (size_t)l * NP * D;
            if (n0 >= 2048) { fold_item(win, F.in[I_POOLW] + (size_t)l * 4 * 128 * 128, F.in[I_POOLS] + l * 512, kb * 64, WT, n0 - 2048, scr, F.lane); continue; }
            const int n = n0 + (F.lane & 31); int src = n;
            if (n < 1024) { const int hh = n >> 7, j = n & 127, sec = j >> 6, jj = j & 63; src = (n & 512) + (hh & 3) * 128 + sec * 64 + (jj & 1) * 32 + (jj >> 1); }
            tr_item(win + src, NP, kb * 64, WT, D, n0, scr, F.lane); continue; }
        r -= N_WIN;
        if (r < N_WOUT) { const int l = r / IT_WOUT; r %= IT_WOUT; const int kb = r / 32, nb = r % 32, n0 = nb * 32;
            tr_item(F.in[I_WOUT] + (size_t)l * D * D + n0 + (F.lane & 31), D, kb * 64, (bf16_t*)(F.ws + WS_WOUT) + (size_t)l * D * D, D, n0, scr, F.lane); continue; }
        r -= N_WOUT;
        if (r < N_GU) { const int le = r / IT_GU; r %= IT_GU; const int kb = r / 32, nb = r % 32, n0 = nb * 32;
            const int n = n0 + (F.lane & 31), col = (n >> 8) * 128 + (n & 127); const float* src = ((n & 128) ? F.in[I_WU] : F.in[I_WG]) + (size_t)le * D * FF + col;
            tr_item8(src, FF, kb * 64, (unsigned char*)(F.ws + WS_WGU) + (size_t)le * 1024 * D, D, n0, scr, F.lane, WGU_SCALE); continue; }
        r -= N_GU;
        { const int le = r / IT_DN; r %= IT_DN; const int kb = r / 32, nb = r % 32, n0 = nb * 32;
            tr_item8(F.in[I_WDN] + (size_t)le * FF * D + n0 + (F.lane & 31), D, kb * 64, (unsigned char*)(F.ws + WS_WD) + (size_t)le * D * FF, FF, n0, scr, F.lane, WD_SCALE); }
      }
    }
}

__device__ __forceinline__ LAS int* build_tb(const Frame& F, int l) {
    LAS int* tb = (LAS int*)(F.lds + MISC_OFF + 64);
    if (F.tid < 64) {
        const unsigned* cnt = (const unsigned*)(F.ws + WS_CTL) + CW_CNT + l * NE * 16;
        const int e = F.tid & 31; const int c = (int)__hip_atomic_load(cnt + e * 16, __ATOMIC_RELAXED, __HIP_MEMORY_SCOPE_AGENT);
        const int t = (c + 255) >> 8; int incl = t;
#pragma unroll
        for (int o = 1; o < 32; o <<= 1) { const int v = __shfl_up(incl, o, 32); if (e >= o) incl += v; }
        if (F.tid < 32) { tb[e] = incl - t; tb[64 + e] = c; if (e == 31) tb[NE] = incl; }
    }
    __syncthreads();
    return tb;
}

__device__ __forceinline__ void row_op_a(const Frame& F, int mode, bool dry) {
    const int gw = F.vcu * 8 + F.wave, NGW = F.G * 8;
    const int nrows = (mode == 2) ? NLAT : NTOK; const int l = (mode == 0) ? 0 : 1, lp = mode - 1;
    const LAS int* tb = nullptr; if (mode != 0) tb = build_tb(F, lp);
    const unsigned char* YB = (const unsigned char*)(F.ws + WS_P); bf16_t* H = hbuf(F);
    const float* gain = (mode == 2) ? F.in[I_FNG] : F.in[I_N1G] + l * D;
    int4 ti1 = make_int4(0, 0, 0, 0), ti2 = ti1; f32x2 tw0 = (f32x2){0.f, 0.f}, tw1 = tw0, tw2 = tw0;
    f32x4 xf[4]; u32x2 xq[4]; unsigned ya[4], yc[4];
#define ROWA_INFO(r_, ti_, tw_) do { if (mode != 0 && (r_) < nrows) { ti_ = *(const int4*)(F.ws + WS_TOKINFO + (size_t)(r_) * 32); tw_ = *(const f32x2*)(F.ws + WS_TOKINFO + (size_t)(r_) * 32 + 16); } } while (0)
#define ROWA_DATA(r_, ti_) do { if ((r_) < nrows) { if (mode == 0) { const f32x4* src = (const f32x4*)((r_) < NLAT ? F.in[I_X] + (size_t)(r_) * D : F.in[I_CTX] + (size_t)((r_) - NLAT) * D) + F.lane; \
            _Pragma("unroll") for (int j = 0; j < 4; ++j) xf[j] = src[64 * j]; } \
        else { const size_t s1 = (size_t)(tb[ti_.x] * 256 + ti_.y), s2 = (size_t)(tb[ti_.z] * 256 + ti_.w); const u32x2* xr_ = (const u32x2*)xb_row(F, (r_)) + F.lane; \
            const unsigned* y1 = (const unsigned*)(YB + s1 * D) + F.lane; const unsigned* y2 = (const unsigned*)(YB + s2 * D) + F.lane; \
            _Pragma("unroll") for (int j = 0; j < 4; ++j) { xq[j] = xr_[64 * j]; ya[j] = y1[64 * j]; yc[j] = y2[64 * j]; } } } } while (0)
    ROWA_INFO(gw, ti1, tw1); ROWA_INFO(gw + NGW, ti2, tw2);
    ROWA_DATA(gw, ti1); tw0 = tw1; ti1 = ti2; tw1 = tw2;
    for (int row = gw; row < nrows; row += NGW) {
        const int b = row < NLAT ? (row >> 11) : 16;
        ROWA_INFO(row + 2 * NGW, ti2, tw2);
        f32x4 v[4];
        if (mode == 0) {
#pragma unroll
            for (int j = 0; j < 4; ++j) v[j] = xf[j];
        } else {
            const f32x4* g2 = (const f32x4*)mod_ptr(F, lp, b, 5) + F.lane;
#pragma unroll
            for (int j = 0; j < 4; ++j) { const u32x2 xw = xq[j]; const f32x4 x = (f32x4){bflo(xw.x), bfhi(xw.x), bflo(xw.y), bfhi(xw.y)};
                const int a = (int)ya[j], c = (int)yc[j]; const f32x4 g = g2[64 * j];
                f32x4 y; y[0] = tw0.x * __builtin_amdgcn_cvt_f32_fp8(a, 0) + tw0.y * __builtin_amdgcn_cvt_f32_fp8(c, 0); y[1] = tw0.x * __builtin_amdgcn_cvt_f32_fp8(a, 1) + tw0.y * __builtin_amdgcn_cvt_f32_fp8(c, 1);
                y[2] = tw0.x * __builtin_amdgcn_cvt_f32_fp8(a, 2) + tw0.y * __builtin_amdgcn_cvt_f32_fp8(c, 2); y[3] = tw0.x * __builtin_amdgcn_cvt_f32_fp8(a, 3) + tw0.y * __builtin_amdgcn_cvt_f32_fp8(c, 3);
                v[j] = x + g * y; }
        }
        ROWA_DATA(row + NGW, ti1);
        if (mode == 1 && !dry) { u32x2* xr = (u32x2*)xb_row(F, row) + F.lane;
#pragma unroll
            for (int j = 0; j < 4; ++j) { u32x2 w; w.x = pk2(v[j][0], v[j][1]); w.y = pk2(v[j][2], v[j][3]); xr[64 * j] = w; } }
        float ss = 0.f;
#pragma unroll
        for (int j = 0; j < 4; ++j) ss += (v[j][0] * v[j][0] + v[j][1] * v[j][1]) + (v[j][2] * v[j][2] + v[j][3] * v[j][3]);
        const float rstd = 1.0f / sqrtf(wave_sum(ss) * (1.0f / D) + EPS);
        if (mode == 2) {
#pragma unroll
            for (int j = 0; j < 4; ++j) { const f32x4 g = ((const f32x4*)gain)[F.lane + 64 * j]; ((f32x4*)((dry ? (float*)(F.ws + WS_WGU) : F.out) + (size_t)row * D))[F.lane + 64 * j] = v[j] * rstd * g; }
        } else {
            const f32x4* sh = (const f32x4*)mod_ptr(F, l, b, 0) + F.lane; const f32x4* sc = (const f32x4*)mod_ptr(F, l, b, 1) + F.lane;
            u32x2* o = (u32x2*)(H + (size_t)row * D) + F.lane;
#pragma unroll
            for (int j = 0; j < 4; ++j) { const f32x4 g = ((const f32x4*)gain)[F.lane + 64 * j]; const f32x4 h = v[j] * rstd * g * (sc[64 * j] + 1.0f) + sh[64 * j];
                u32x2 w; w.x = pk2(h[0], h[1]); w.y = pk2(h[2], h[3]); o[64 * j] = w; }
        }
        tw0 = tw1; ti1 = ti2; tw1 = tw2;
    }
#undef ROWA_INFO
#undef ROWA_DATA
}

template <bool DRY> __device__ __forceinline__ void route_row(const Frame& F, int l, int row, const float (&s)[36], unsigned* cnt, int* list) {
    float gl[4];
#pragma unroll
    for (int i = 0; i < 4; ++i) gl[i] = s[i];
    int gt = 0; float gm = gl[0];
#pragma unroll
    for (int i = 1; i < 4; ++i) if (gl[i] > gm) { gm = gl[i]; gt = i; }
    float gs = 0.f;
#pragma unroll
    for (int i = 0; i < 4; ++i) gs += expf(gl[i] - gm);
    const float gwt = 1.0f / gs;
    float el[8];
#pragma unroll
    for (int j = 0; j < 8; ++j) el[j] = gt == 0 ? s[4 + j] : gt == 1 ? s[12 + j] : gt == 2 ? s[20 + j] : s[28 + j];
    int i1 = 0; float v1 = el[0];
#pragma unroll
    for (int j = 1; j < 8; ++j) if (el[j] > v1) { v1 = el[j]; i1 = j; }
    int i2 = -1; float v2 = -3.0e38f;
#pragma unroll
    for (int j = 0; j < 8; ++j) if (j != i1 && el[j] > v2) { v2 = el[j]; i2 = j; }
    const float e2 = expf(v2 - v1); const float w1 = gwt / (1.0f + e2), w2 = gwt * e2 / (1.0f + e2);
    if (!DRY) {
        const int x1 = gt * 8 + i1, x2 = gt * 8 + i2;
        const int r1 = (int)__hip_atomic_fetch_add(cnt + x1 * 16, 1u, __ATOMIC_RELAXED, __HIP_MEMORY_SCOPE_AGENT);
        const int r2 = (int)__hip_atomic_fetch_add(cnt + x2 * 16, 1u, __ATOMIC_RELAXED, __HIP_MEMORY_SCOPE_AGENT);
        list[(size_t)x1 * NTOK + r1] = row; list[(size_t)x2 * NTOK + r2] = row;
        *(int4*)(F.ws + WS_TOKINFO + (size_t)row * 32) = make_int4(x1, r1, x2, r2); *(f32x2*)(F.ws + WS_TOKINFO + (size_t)row * 32 + 16) = (f32x2){w1, w2};
    }
}
template <bool DRY> __device__ __forceinline__ void row_op_b(const Frame& F, int l) {
    const int gw = F.vcu * 8 + F.wave, NGW = F.G * 8;
    const int ngroups = ((l == 0) ? NTOK : NLAT) / 16;
    { const u32x4* img = (const u32x4*)(F.ws + WS_RIMG + (size_t)l * RW_EX);
      u32x4 t[19];
#pragma unroll
      for (int q = 0; q < 19; ++q) { const int i = F.tid + 512 * q; t[q] = img[i < RW_EX / 16 ? i : 0]; }
#pragma unroll
      for (int q = 0; q < 19; ++q) { const int i = F.tid + 512 * q; if (i < RW_EX / 16) *(LAS u32x4*)(F.lds + i * 16) = t[q]; } }
    __syncthreads();
    bf16_t* H = hbuf(F);
    const float* gain = F.in[I_N2G] + l * D;
    unsigned* cnt = (unsigned*)(F.ws + WS_CTL) + CW_CNT + l * NE * 16;
    int* list = (int*)(F.ws + WS_LIST);
    const int fr = F.lane & 15, fq = F.lane >> 4;
    unsigned bo[3];
#pragma unroll
    for (int nt = 0; nt < 3; ++nt) { const int n = 16 * nt + fr; bo[nt] = (unsigned)((n < 36 ? n : 35) * RW_PITCH + fq * 16); }
    LAS float* ex = (LAS float*)(F.lds + RW_EX + F.wave * 1152);
    float rbias[36];
#pragma unroll
    for (int n = 0; n < 36; ++n) rbias[n] = n < 4 ? F.in[I_RGB][l * 4 + n] : F.in[I_REB][l * NE + (n - 4)];
    for (int it = 0;; ++it) {
        const int gi = it == 0 ? gw : NGW + F.vcu + (it - 1) * F.G;
        if (gi >= ngroups || (it > 0 && F.wave != 0)) break;
        const int row = gi * 16 + fr, b = row < NLAT ? (row >> 11) : 16;
        const bf16_t* xr = xb_row(F, row) + fq * 8;
        float ss;
        { const f32x4* sp = (const f32x4*)((const float*)(F.ws + WS_SSQ) + (size_t)row * 16); const f32x4 p0 = sp[0], p1 = sp[1], p2 = sp[2], p3 = sp[3];
          ss = ((p0[0] + p0[1]) + (p0[2] + p0[3])) + ((p1[0] + p1[1]) + (p1[2] + p1[3])) + ((p2[0] + p2[1]) + (p2[2] + p2[3])) + ((p3[0] + p3[1]) + (p3[2] + p3[3])); }
        const float rstd = 1.0f / sqrtf(ss * (1.0f / D) + EPS);
        const float* shp = mod_ptr(F, l, b, 3) + fq * 8; const float* scp = mod_ptr(F, l, b, 4) + fq * 8; const float* gp = gain + fq * 8;
        unsigned char* hp = (unsigned char*)H + (size_t)row * D + fq * 8;
        f32x4 acc[3];
#pragma unroll
        for (int nt = 0; nt < 3; ++nt) acc[nt] = (f32x4){0.f, 0.f, 0.f, 0.f};
#pragma unroll 2
        for (int s = 0; s < 32; ++s) {
            const u32x4 xw = *(const u32x4*)(xr + 32 * s);
            const f32x4 x0 = (f32x4){bflo(xw.x), bfhi(xw.x), bflo(xw.y), bfhi(xw.y)}, x1 = (f32x4){bflo(xw.z), bfhi(xw.z), bflo(xw.w), bfhi(xw.w)};
            const f32x4 g0 = *(const f32x4*)(gp + 32 * s), g1 = *(const f32x4*)(gp + 32 * s + 4);
            const f32x4 c0 = *(const f32x4*)(scp + 32 * s), c1 = *(const f32x4*)(scp + 32 * s + 4);
            const f32x4 s0 = *(const f32x4*)(shp + 32 * s), s1 = *(const f32x4*)(shp + 32 * s + 4);
            const f32x4 h0 = x0 * rstd * g0 * (c0 + 1.0f) + s0, h1 = x1 * rstd * g1 * (c1 + 1.0f) + s1;
            u32x4 hi, lo;
            hi.x = pk2(h0[0], h0[1]); hi.y = pk2(h0[2], h0[3]); hi.z = pk2(h1[0], h1[1]); hi.w = pk2(h1[2], h1[3]);
            lo.x = pk2(h0[0] - bflo(hi.x), h0[1] - bfhi(hi.x)); lo.y = pk2(h0[2] - bflo(hi.y), h0[3] - bfhi(hi.y));
            lo.z = pk2(h1[0] - bflo(hi.z), h1[1] - bfhi(hi.z)); lo.w = pk2(h1[2] - bflo(hi.w), h1[3] - bfhi(hi.w));
            { u32x2 h8; h8.x = pg8::pk4_fp8(h0[0], h0[1], h0[2], h0[3]); h8.y = pg8::pk4_fp8(h1[0], h1[1], h1[2], h1[3]); *(u32x2*)(hp + 32 * s) = h8; }
            const bf16x8 ah = __builtin_bit_cast(bf16x8, hi), al = __builtin_bit_cast(bf16x8, lo);
#pragma unroll
            for (int nt = 0; nt < 3; ++nt) {
                const bf16x8 bh = *(const LAS bf16x8*)(F.lds + bo[nt] + s * 64), bl = *(const LAS bf16x8*)(F.lds + RW_LO + bo[nt] + s * 64);
                acc[nt] = __builtin_amdgcn_mfma_f32_16x16x32_bf16(ah, bh, acc[nt], 0, 0, 0);
                acc[nt] = __builtin_amdgcn_mfma_f32_16x16x32_bf16(ah, bl, acc[nt], 0, 0, 0);
                acc[nt] = __builtin_amdgcn_mfma_f32_16x16x32_bf16(al, bh, acc[nt], 0, 0, 0);
            }
        }
#pragma unroll
        for (int hf = 0; hf < 2; ++hf) {
            if ((fq >> 1) == hf) {
#pragma unroll
                for (int nt = 0; nt < 3; ++nt) { const int n = 16 * nt + fr;
                    if (n < 36) {
#pragma unroll
                        for (int r = 0; r < 4; ++r) ex[((fq & 1) * 4 + r) * 36 + n] = acc[nt][r]; } }
            }
            asm volatile("s_waitcnt lgkmcnt(0)" ::: "memory");
            if (F.lane < 8) { float sl[36];
#pragma unroll
                for (int n = 0; n < 36; ++n) sl[n] = ex[F.lane * 36 + n] + rbias[n];
                route_row<DRY>(F, l, gi * 16 + hf * 8 + F.lane, sl, cnt, list); }
            asm volatile("s_waitcnt lgkmcnt(0)" ::: "memory");
        }
    }
    __syncthreads();
}

__device__ __forceinline__ unsigned off_b(unsigned row, unsigned ch) { return 256u * row + 16u * (ch ^ (((row & 3) << 2) | ((row >> 2) & 3))); }
__device__ __forceinline__ unsigned tr_base_p(unsigned lane) { const unsigned g = lane >> 4, q = (lane & 15) >> 2, p = lane & 3; return off_b(4 * g + q, (p >> 1)) + 8 * (p & 1); }
template <int O0, int O1, int O2, int O3>
__device__ __forceinline__ void tr_frag4(bf16x8 (&f)[4], unsigned a0, unsigned a1, unsigned a2, unsigned a3) {
    s16x4 l0, h0, l1, h1, l2, h2, l3, h3;
    asm volatile("ds_read_b64_tr_b16 %0, %8 offset:%12\n\tds_read_b64_tr_b16 %1, %8 offset:%16\n\t"
                 "ds_read_b64_tr_b16 %2, %9 offset:%13\n\tds_read_b64_tr_b16 %3, %9 offset:%17\n\t"
                 "ds_read_b64_tr_b16 %4, %10 offset:%14\n\tds_read_b64_tr_b16 %5, %10 offset:%18\n\t"
                 "ds_read_b64_tr_b16 %6, %11 offset:%15\n\tds_read_b64_tr_b16 %7, %11 offset:%19\n\ts_waitcnt lgkmcnt(0)"
                 : "=&v"(l0), "=&v"(h0), "=&v"(l1), "=&v"(h1), "=&v"(l2), "=&v"(h2), "=&v"(l3), "=&v"(h3)
                 : "v"(a0), "v"(a1), "v"(a2), "v"(a3), "n"(O0), "n"(O1), "n"(O2), "n"(O3), "n"(O0 + 4096), "n"(O1 + 4096), "n"(O2 + 4096), "n"(O3 + 4096) : "memory");
    f[0] = __builtin_shufflevector(l0, h0, 0, 1, 2, 3, 4, 5, 6, 7); f[1] = __builtin_shufflevector(l1, h1, 0, 1, 2, 3, 4, 5, 6, 7);
    f[2] = __builtin_shufflevector(l2, h2, 0, 1, 2, 3, 4, 5, 6, 7); f[3] = __builtin_shufflevector(l3, h3, 0, 1, 2, 3, 4, 5, 6, 7);
}
template <int O>
__device__ __forceinline__ void tr_frag8(bf16x8 (&f)[8], unsigned a) {
    s16x4 l0, h0, l1, h1, l2, h2, l3, h3, l4, h4, l5, h5, l6, h6, l7, h7;
    const unsigned a1 = a ^ 32u, a2 = a ^ 64u, a3 = a ^ 96u, a4 = a ^ 128u, a5 = a ^ 160u, a6 = a ^ 192u, a7 = a ^ 224u;
    asm volatile("ds_read_b64_tr_b16 %0, %8 offset:%12\n\tds_read_b64_tr_b16 %1, %8 offset:%13\n\t"
                 "ds_read_b64_tr_b16 %2, %9 offset:%12\n\tds_read_b64_tr_b16 %3, %9 offset:%13\n\t"
                 "ds_read_b64_tr_b16 %4, %10 offset:%12\n\tds_read_b64_tr_b16 %5, %10 offset:%13\n\t"
                 "ds_read_b64_tr_b16 %6, %11 offset:%12\n\tds_read_b64_tr_b16 %7, %11 offset:%13"
                 : "=&v"(l0), "=&v"(h0), "=&v"(l1), "=&v"(h1), "=&v"(l2), "=&v"(h2), "=&v"(l3), "=&v"(h3)
                 : "v"(a), "v"(a1), "v"(a2), "v"(a3), "n"(O), "n"(O + 4096) : "memory");
    asm volatile("ds_read_b64_tr_b16 %0, %16 offset:%20\n\tds_read_b64_tr_b16 %1, %16 offset:%21\n\t"
                 "ds_read_b64_tr_b16 %2, %17 offset:%20\n\tds_read_b64_tr_b16 %3, %17 offset:%21\n\t"
                 "ds_read_b64_tr_b16 %4, %18 offset:%20\n\tds_read_b64_tr_b16 %5, %18 offset:%21\n\t"
                 "ds_read_b64_tr_b16 %6, %19 offset:%20\n\tds_read_b64_tr_b16 %7, %19 offset:%21\n\ts_waitcnt lgkmcnt(0)"
                 : "=&v"(l4), "=&v"(h4), "=&v"(l5), "=&v"(h5), "=&v"(l6), "=&v"(h6), "=&v"(l7), "=&v"(h7),
                   "+v"(l0), "+v"(h0), "+v"(l1), "+v"(h1), "+v"(l2), "+v"(h2), "+v"(l3), "+v"(h3)
                 : "v"(a4), "v"(a5), "v"(a6), "v"(a7), "n"(O), "n"(O + 4096) : "memory");
    f[0] = __builtin_shufflevector(l0, h0, 0, 1, 2, 3, 4, 5, 6, 7); f[1] = __builtin_shufflevector(l1, h1, 0, 1, 2, 3, 4, 5, 6, 7);
    f[2] = __builtin_shufflevector(l2, h2, 0, 1, 2, 3, 4, 5, 6, 7); f[3] = __builtin_shufflevector(l3, h3, 0, 1, 2, 3, 4, 5, 6, 7);
    f[4] = __builtin_shufflevector(l4, h4, 0, 1, 2, 3, 4, 5, 6, 7); f[5] = __builtin_shufflevector(l5, h5, 0, 1, 2, 3, 4, 5, 6, 7);
    f[6] = __builtin_shufflevector(l6, h6, 0, 1, 2, 3, 4, 5, 6, 7); f[7] = __builtin_shufflevector(l7, h7, 0, 1, 2, 3, 4, 5, 6, 7);
}
#define LBAR() do { asm volatile("s_waitcnt lgkmcnt(0)" ::: "memory"); __builtin_amdgcn_s_barrier(); asm volatile("" ::: "memory"); } while (0)
__device__ __forceinline__ int chunk_row0(int b, int ci) { return ci < 2 ? NLAT + b * CT + ci * 128 : b * TL + (ci - 2) * 128; }
__device__ __forceinline__ float log2_gamma(float decay) { return -log1pf(expf(-decay)) * 1.4426950408889634f; }

template <int HALF>
__device__ __forceinline__ void pool_item(const LAS unsigned char* tile, bf16_t* A2, int t0, int T, int rbase, int rl, int cg) {
    const int t = t0 + rl; int cnt = 0;
    float s[8];
#pragma unroll
    for (int i = 0; i < 8; ++i) s[i] = 0.f;
    u32x4 c = (u32x4){0u, 0u, 0u, 0u};
#pragma unroll
    for (int w = 0; w < 2 * HALF; ++w) { const int tt = t - HALF + w; const bool ok = tt >= 0 && tt < T;
        u32x4 x = *(const LAS u32x4*)(tile + (rl + 8 - HALF + w) * 1024 + cg * 16); if (!ok) x = (u32x4){0u, 0u, 0u, 0u}; cnt += ok ? 1 : 0; if (w == HALF) c = x;
        s[0] += bflo(x.x); s[1] += bfhi(x.x); s[2] += bflo(x.y); s[3] += bfhi(x.y); s[4] += bflo(x.z); s[5] += bfhi(x.z); s[6] += bflo(x.w); s[7] += bfhi(x.w); }
    const float inv = 1.0f / (float)cnt;
    u32x4 o; o.x = pk2(s[0] * inv - bflo(c.x), s[1] * inv - bfhi(c.x)); o.y = pk2(s[2] * inv - bflo(c.y), s[3] * inv - bfhi(c.y));
    o.z = pk2(s[4] * inv - bflo(c.z), s[5] * inv - bfhi(c.z)); o.w = pk2(s[6] * inv - bflo(c.w), s[7] * inv - bfhi(c.w));
    *(u32x4*)(A2 + (size_t)(rbase + t) * D + 512 + cg * 8) = o;
}

__device__ __forceinline__ void p3a_states_pool(const Frame& F, int l) {
    const bf16_t* P = (const bf16_t*)(F.ws + WS_P);
    bf16_t* ST = (bf16_t*)(F.ws + WS_ACT);
    bf16_t* A2 = hbuf(F);
    const int nstate = (F.G > 128) ? 128 : F.G;
    if (F.bx < nstate) {
        for (int unit = F.bx; unit < 128; unit += nstate) {
            const int dir = unit & 1, bh = unit >> 1, b = bh >> 2, h = bh & 3;
            const float lg2 = log2_gamma((dir ? F.in[I_DB] : F.in[I_DF])[l * NH + h]);
            const float gC = exp2f(lg2 * 128.0f);
            f32x4 acc[8];
#pragma unroll
            for (int dt = 0; dt < 8; ++dt) acc[dt] = (f32x4){0.f, 0.f, 0.f, 0.f};
            u32x4 kr[8], vr[8];
#define P3A_CI(n_) (dir ? ((n_) < 2 ? 1 - (n_) : 19 - (n_)) : (n_))
#define P3A_LOAD(st_) do { _Pragma("unroll") for (int sub = 0; sub < 2; ++sub) { const int r0_ = chunk_row0(b, P3A_CI(2 * (st_) + sub)); \
                _Pragma("unroll") for (int q = 0; q < 4; ++q) { const int p = F.tid + 512 * q, j = p >> 4, ch = p & 15; \
                    kr[sub * 4 + q] = *(const u32x4*)(P + (size_t)(r0_ + j) * NP + 512 + h * 128 + ch * 8); vr[sub * 4 + q] = *(const u32x4*)(P + (size_t)(r0_ + j) * NP + 1024 + h * 128 + ch * 8); } } } while (0)
#define P3A_STORE(n_) do { bf16_t* sp = ST + ((size_t)((bh * 2 + dir) * NCHUNK + P3A_CI(n_)) * 128 + (F.wave * 16 + (F.lane & 15))) * 128 + 4 * (F.lane >> 4); \
                _Pragma("unroll") for (int dt = 0; dt < 8; ++dt) { u32x2 w; w.x = pk2(acc[dt][0], acc[dt][1]); w.y = pk2(acc[dt][2], acc[dt][3]); *(u32x2*)(sp + dt * 16) = w; } } while (0)
#define P3A_KS(KO, VO, ks) do { bf16x8 ka[8]; tr_frag8<(KO) + (ks) * 8192>(ka, tpk); \
                _Pragma("unroll") for (int dt = 0; dt < 8; ++dt) acc[dt] = __builtin_amdgcn_mfma_f32_16x16x32_bf16(ka[dt], vb[ks], acc[dt], 0, 0, 0); } while (0)
#define P3A_SUB(KO, VO) do { _Pragma("unroll") for (int dt = 0; dt < 8; ++dt) acc[dt] *= gC; \
                bf16x8 vb[4]; tr_frag4<(VO), (VO) + 8192, (VO) + 16384, (VO) + 24576>(vb, tpv, tpv, tpv, tpv); \
                P3A_KS(KO, VO, 0); P3A_KS(KO, VO, 1); P3A_KS(KO, VO, 2); P3A_KS(KO, VO, 3); } while (0)
            P3A_LOAD(0);
            for (int st = 0; st < 9; ++st) {
#pragma unroll
                for (int sub = 0; sub < 2; ++sub)
#pragma unroll
                    for (int q = 0; q < 4; ++q) { const int p = F.tid + 512 * q, j = p >> 4, ch = p & 15;
                        const float kd = __builtin_amdgcn_exp2f(lg2 * (float)(dir ? j : 127 - j));
                        const u32x4 kk = kr[sub * 4 + q];
                        u32x4 ks; ks.x = pk2(bflo(kk.x) * kd, bfhi(kk.x) * kd); ks.y = pk2(bflo(kk.y) * kd, bfhi(kk.y) * kd); ks.z = pk2(bflo(kk.z) * kd, bfhi(kk.z) * kd); ks.w = pk2(bflo(kk.w) * kd, bfhi(kk.w) * kd);
                        *(LAS u32x4*)(F.lds + sub * 32768 + off_b(j, ch)) = ks; *(LAS u32x4*)(F.lds + 65536 + sub * 32768 + off_b(j, ch)) = vr[sub * 4 + q]; }
                LBAR();
                if (st < 8) P3A_LOAD(st + 1);
                const unsigned tpk = (unsigned)(size_t)F.lds + tr_base_p(F.lane); const unsigned tpv = (tpk ^ ((unsigned)F.wave << 5)) + 65536u;
                P3A_STORE(2 * st);
                P3A_SUB(0, 0);
                P3A_STORE(2 * st + 1);
                if (st < 8) P3A_SUB(32768, 32768);
                LBAR();
            }
#undef P3A_SUB
#undef P3A_KS
#undef P3A_STORE
#undef P3A_LOAD
#undef P3A_CI
        }
    } else {
        const int pb = F.bx - nstate, npb = F.G - nstate;
        u32x4 ld[10];
#define POOL_LOAD(tile_) do { const int r0_ = (tile_) * 64; int t0_, T_, rb_; if (r0_ < NLAT) { t0_ = r0_ & (TL - 1); T_ = TL; } else { t0_ = (r0_ - NLAT) & (CT - 1); T_ = CT; } rb_ = r0_ - t0_; \
            _Pragma("unroll") for (int q = 0; q < 10; ++q) { const int p = F.tid + 512 * q, rr = p >> 6, ch = p & 63; int tt = t0_ - 8 + rr; tt = tt < 0 ? 0 : (tt >= T_ ? T_ - 1 : tt); \
                ld[q] = *(const u32x4*)(P + (size_t)(rb_ + tt) * NP + 2048 + ch * 8); } } while (0)
        if (pb < 576) POOL_LOAD(pb);
        for (int tile = pb; tile < 576; tile += npb) {
            const int r0 = tile * 64; int t0, T; if (r0 < NLAT) { t0 = r0 & (TL - 1); T = TL; } else { t0 = (r0 - NLAT) & (CT - 1); T = CT; } const int rbase = r0 - t0;
            LBAR();
#pragma unroll
            for (int q = 0; q < 10; ++q) { const int p = F.tid + 512 * q; *(LAS u32x4*)(F.lds + (p >> 6) * 1024 + (p & 63) * 16) = ld[q]; }
            LBAR();
            if (tile + npb < 576) POOL_LOAD(tile + npb);
            for (int wi = F.wave; wi < 64; wi += 8) { const int g = wi & 3, rl = (wi >> 2) * 4 + (F.lane >> 4), cg = g * 16 + (F.lane & 15);
                if (g == 0) pool_item<1>(F.lds, A2, t0, T, rbase, rl, cg); else if (g == 1) pool_item<2>(F.lds, A2, t0, T, rbase, rl, cg);
                else if (g == 2) pool_item<4>(F.lds, A2, t0, T, rbase, rl, cg); else pool_item<8>(F.lds, A2, t0, T, rbase, rl, cg); }
        }
#undef POOL_LOAD
    }
    __syncthreads();
}

__device__ __forceinline__ void p3b_retention(const Frame& F, int l) {
    const bf16_t* P = (const bf16_t*)(F.ws + WS_P);
    const bf16_t* ST = (const bf16_t*)(F.ws + WS_ACT);
    bf16_t* A2 = hbuf(F);
    const int c_lo = (l == DEPTH - 1) ? 2 : 0, ncu = NCHUNK - c_lo, nunits = 64 * ncu;
    float lgF[NH], lgB[NH];
#pragma unroll
    for (int hh = 0; hh < NH; ++hh) { lgF[hh] = log2_gamma(F.in[I_DF][l * NH + hh]); lgB[hh] = log2_gamma(F.in[I_DB][l * NH + hh]); }
    u32x4 ld[8], st[8]; bf16x8 qf[4];
#define P3B_LOAD(unit_) do { const int bh_ = (unit_) / ncu, ci_ = c_lo + (unit_) % ncu, h_ = bh_ & 3; const int r0_ = chunk_row0(bh_ >> 2, ci_); \
        _Pragma("unroll") for (int q = 0; q < 4; ++q) { const int p = F.tid + 512 * q, j = p >> 4, ch = p & 15; \
            ld[q] = *(const u32x4*)(P + (size_t)(r0_ + j) * NP + 512 + h_ * 128 + ch * 8); ld[4 + q] = *(const u32x4*)(P + (size_t)(r0_ + j) * NP + 1024 + h_ * 128 + ch * 8); } } while (0)
#define P3B_LOADQ(unit_) do { const int bh_ = (unit_) / ncu, ci_ = c_lo + (unit_) % ncu, h_ = bh_ & 3; const int r0_ = chunk_row0(bh_ >> 2, ci_); \
        _Pragma("unroll") for (int ks = 0; ks < 4; ++ks) qf[ks] = *(const bf16x8*)(P + (size_t)(r0_ + F.wave * 16 + (F.lane & 15)) * NP + h_ * 128 + ks * 32 + (F.lane >> 4) * 8); } while (0)
    if (F.vcu < nunits) { P3B_LOAD(F.vcu); P3B_LOADQ(F.vcu); }
    for (int unit = F.vcu; unit < nunits; unit += F.G) {
        int lane_o = F.lane; asm volatile("" : "+v"(lane_o));
        const int fr = lane_o & 15, fq = lane_o >> 4;
        const unsigned rr0 = off_b((unsigned)fr, (unsigned)fq), tp = (unsigned)(size_t)F.lds + tr_base_p((unsigned)lane_o);
        const int il = F.wave * 16 + fr;
        const int bh = unit / ncu, ci = c_lo + unit % ncu, b = bh >> 2, h = bh & 3;
        const float lgf = h == 0 ? lgF[0] : h == 1 ? lgF[1] : h == 2 ? lgF[2] : lgF[3], lgb = h == 0 ? lgB[0] : h == 1 ? lgB[1] : h == 2 ? lgB[2] : lgB[3];
        const int row0 = chunk_row0(b, ci);
        { const bf16_t* sf = ST + ((size_t)((bh * 2 + 0) * NCHUNK + ci) * 128) * 128; const bf16_t* sb = ST + ((size_t)((bh * 2 + 1) * NCHUNK + ci) * 128) * 128;
#pragma unroll
          for (int q = 0; q < 4; ++q) { const int p = F.tid + 512 * q, j = p >> 4, ch = p & 15; st[q] = *(const u32x4*)(sf + (size_t)j * 128 + ch * 8); st[4 + q] = *(const u32x4*)(sb + (size_t)j * 128 + ch * 8); } }
        LBAR();
#pragma unroll
        for (int q = 0; q < 4; ++q) { const int p = F.tid + 512 * q, j = p >> 4, ch = p & 15; const unsigned o = off_b(j, ch);
            *(LAS u32x4*)(F.lds + o) = ld[q]; *(LAS u32x4*)(F.lds + 32768u + o) = ld[4 + q]; }
        LBAR();
        if (unit + F.G < nunits) P3B_LOAD(unit + F.G);
        u32x2 gg[8];
#pragma unroll
        for (int et = 0; et < 8; ++et) gg[et] = *(const u32x2*)(P + (size_t)(row0 + il) * NP + 1536 + h * 128 + 4 * fq + et * 16);
        bf16x8 pf[4];
#pragma unroll
        for (int ks2 = 0; ks2 < 4; ++ks2) {
            u32x2 half[2];
#pragma unroll
            for (int t = 0; t < 2; ++t) { const int jt = 2 * ks2 + t;
                asm volatile("" ::: "memory");
                f32x4 sa = (f32x4){0.f, 0.f, 0.f, 0.f};
#pragma unroll
                for (int ks = 0; ks < 4; ++ks) { const bf16x8 ka = *(const LAS bf16x8*)(F.lds + ((rr0 ^ ((unsigned)ks << 6)) + 4096u * jt)); sa = __builtin_amdgcn_mfma_f32_16x16x32_bf16(ka, qf[ks], sa, 0, 0, 0); }
                float pv[4];
#pragma unroll
                for (int r = 0; r < 4; ++r) { const int j = 16 * jt + 4 * fq + r, df = il - j;
                    const float w = df > 0 ? __builtin_amdgcn_exp2f(lgf * (float)df) : (df < 0 ? __builtin_amdgcn_exp2f(lgb * (float)(-df)) : 2.0f); pv[r] = sa[r] * w; }
                half[t].x = pk2(pv[0], pv[1]); half[t].y = pk2(pv[2], pv[3]); }
            const u32x4 w4 = (u32x4){half[0].x, half[0].y, half[1].x, half[1].y};
            pf[ks2] = __builtin_bit_cast(bf16x8, w4);
        }
#pragma unroll
        for (int q = 0; q < 4; ++q) { const int p = F.tid + 512 * q, j = p >> 4, ch = p & 15; const unsigned o = off_b(j, ch);
            *(LAS u32x4*)(F.lds + 65536u + o) = st[q]; *(LAS u32x4*)(F.lds + 98304u + o) = st[4 + q]; }
        LBAR();
        const float qdf = __builtin_amdgcn_exp2f(lgf * (float)(il + 1)), qdb = __builtin_amdgcn_exp2f(lgb * (float)(128 - il));
        float o[8][4]; float ss = 0.f;
#pragma unroll
        for (int et = 0; et < 8; ++et) {
            f32x4 ao = (f32x4){0.f, 0.f, 0.f, 0.f}, af = ao, ab = ao;
            bf16x8 va[4]; { const unsigned a = tp ^ ((unsigned)et << 5); tr_frag4<32768, 32768 + 8192, 32768 + 16384, 32768 + 24576>(va, a, a, a, a); }
#pragma unroll
            for (int ks = 0; ks < 4; ++ks) {
                ao = __builtin_amdgcn_mfma_f32_16x16x32_bf16(va[ks], pf[ks], ao, 0, 0, 0);
                const unsigned ra = (rr0 ^ ((unsigned)ks << 6)) + 4096u * et;
                const bf16x8 fa = *(const LAS bf16x8*)(F.lds + 65536u + ra);
                af = __builtin_amdgcn_mfma_f32_16x16x32_bf16(fa, qf[ks], af, 0, 0, 0);
                const bf16x8 ba = *(const LAS bf16x8*)(F.lds + 98304u + ra);
                ab = __builtin_amdgcn_mfma_f32_16x16x32_bf16(ba, qf[ks], ab, 0, 0, 0);
            }
#pragma unroll
            for (int r = 0; r < 4; ++r) { o[et][r] = ao[r] + qdf * af[r] + qdb * ab[r]; ss += o[et][r] * o[et][r]; }
        }
        if (unit + F.G < nunits) P3B_LOADQ(unit + F.G);
        ss += __shfl_xor(ss, 16); ss += __shfl_xor(ss, 32);
        const float rstd = 1.0f / sqrtf(ss * (1.0f / 128.0f) + EPS);
        bf16_t* op = A2 + (size_t)(row0 + il) * D + h * 128 + 4 * fq;
#pragma unroll
        for (int et = 0; et < 8; ++et) { const u32x2 g = gg[et];
            u32x2 w; w.x = pk2(silu_f(bflo(g.x)) * o[et][0] * rstd, silu_f(bfhi(g.x)) * o[et][1] * rstd); w.y = pk2(silu_f(bflo(g.y)) * o[et][2] * rstd, silu_f(bfhi(g.y)) * o[et][3] * rstd);
            *(u32x2*)(op + et * 16) = w; }
    }
#undef P3B_LOAD
#undef P3B_LOADQ
    __syncthreads();
}

#ifndef TYPE_MASK
#define TYPE_MASK 0x3ff
#endif
#define PTYPE(k) ((k) == 0 ? 0 : ((k) == 17 ? 9 : 1 + (((k) - 1) & 7)))
#define ENTER() do { if (PROBE_REPEAT >= 0) __syncthreads(); int _t = threadIdx.x; asm volatile("" : "+v"(_t)); F.tid = _t; F.lane = _t & 63; F.wave = __builtin_amdgcn_readfirstlane(_t >> 6); } while (0)
#define IN(k) (((TYPE_MASK >> PTYPE(k)) & 1) && lo <= (k) && (k) < hi)
#define SEAM(k) do { if (IN(k) && IN((k) + 1)) xcd_barrier(bar); } while (0)
#define REP(t) for (int rep = (PROBE_REPEAT == (t)) ? 0 : 1; rep < 2; ++rep)


template <int l> __device__ __forceinline__ void layer_phases(Frame& F, const XcdBarrier& bar, const int lo, const int hi) {
        const int pb = 1 + 8 * l;
        const bool last = (l == DEPTH - 1);
        const int Mrows = last ? NLAT : NTOK;
        if (IN(pb + 0)) REP(1) { ENTER(); row_op_a(F, l == 0 ? 0 : 1, rep == 0); }
        SEAM(pb + 0);
        if (IN(pb + 1)) REP(2) { ENTER();
            pg8::SchedDense S; S.init(NTOK, NP, D, F.G, F.bx);
            pg8::EpiInProj E{(bf16_t*)(F.ws + WS_P), (const float*)(F.ws + WS_ROPE), (const float*)(F.ws + WS_ROPE) + 96 * 32};
            pg8::gemm_phase<pg8::EpiInProj, pg8::SchedDense, true, true>(F.lds, F.tid, (const char*)hbuf(F), (const char*)(F.ws + WS_WIN) + (size_t)l * NP * D * 2, D, S, E);
        }
        SEAM(pb + 1);
        if (IN(pb + 2)) REP(3) { ENTER(); p3a_states_pool(F, l); }
        SEAM(pb + 2);
        if (IN(pb + 3)) REP(4) { ENTER(); p3b_retention(F, l); }
        SEAM(pb + 3);
        if (IN(pb + 4)) REP(5) { ENTER();
            pg8::SchedDense S; S.init(Mrows, D, D, F.G, F.bx);
            pg8::EpiResid E;
            if (l == 0) { E.rl = F.in[I_X]; E.rc = F.in[I_CTX]; E.rb = nullptr; } else { E.rl = nullptr; E.rc = nullptr; E.rb = (const bf16_t*)(F.ws + WS_XB); }
            E.ob = (rep == 0) ? (bf16_t*)(F.ws + WS_P) : (bf16_t*)(F.ws + WS_XB); E.ssq = (float*)(F.ws + WS_SSQ); E.gmod = mod_ptr(F, l, 0, 2);
            pg8::gemm_phase<pg8::EpiResid, pg8::SchedDense, true, true>(F.lds, F.tid, (const char*)hbuf(F), (const char*)(F.ws + WS_WOUT) + (size_t)l * D * D * 2, D, S, E);
        }
        SEAM(pb + 4);
        if (IN(pb + 5)) REP(6) { ENTER(); if (PROBE_REPEAT == 6 && rep == 0) row_op_b<true>(F, l); else row_op_b<false>(F, l); }
        SEAM(pb + 5);
        if (IN(pb + 6)) REP(7) { ENTER();
            LAS int* tb = build_tb(F, l);
            LAS int* tokt = (LAS int*)(F.lds + TOKT_OFF);
            const int* list = (const int*)(F.ws + WS_LIST);
            pg8::SchedGroup S; S.tb = tb; S.tokt = tokt; S.G = F.G; S.c = F.vcu; S.pitch = D; S.gather = 1;
            { int tokv[8];
#pragma unroll
              for (int i = 0; i < 8; ++i) { pg8::Unit u; tokv[i] = -1;
                  if (S.next(i, u)) { const int g = u.pm; const int e = (int)__popcll(__ballot(F.lane < NE && tb[F.lane + 1] <= g)); const int rt = g - tb[e], cnt = tb[64 + e];
                      if (F.tid < 256) { int r = rt * 256 + F.tid; if (r >= cnt) r = cnt - 1; tokv[i] = list[(size_t)e * NTOK + r]; } } }
#pragma unroll
              for (int i = 0; i < 8; ++i) if (F.tid < 256 && tokv[i] >= 0) tokt[i * 256 + F.tid] = tokv[i]; }
            __syncthreads();
            pg8::EpiSwiGLU8 E{(unsigned char*)(F.ws + WS_ACT), 1.0f / WGU_SCALE};
            pg8::gemm_phase<pg8::EpiSwiGLU8, pg8::SchedGroup, true, true, true>(F.lds, F.tid, (const char*)hbuf(F), (const char*)(F.ws + WS_WGU) + (size_t)l * NE * 1024 * D, D, S, E);
        }
        SEAM(pb + 6);
        if (IN(pb + 7)) REP(8) { ENTER();
            LAS int* tb = build_tb(F, l);
            pg8::SchedGroup S; S.tb = tb; S.tokt = nullptr; S.G = F.G; S.c = F.vcu; S.pitch = FF; S.gather = 0;
            pg8::EpiFp8S E{(unsigned char*)(F.ws + WS_P), D, 1.0f / WD_SCALE};
            pg8::gemm_phase<pg8::EpiFp8S, pg8::SchedGroup, true, true, true>(F.lds, F.tid, (const char*)(F.ws + WS_ACT), (const char*)(F.ws + WS_WD) + (size_t)l * NE * D * FF, FF, S, E);
        }
        SEAM(pb + 7);
}

__global__ void __launch_bounds__(512, 2) fwd_kernel(Args args) {
    extern __shared__ __attribute__((aligned(16))) unsigned char lds_raw[];
    Frame F;
    F.lds = (LAS unsigned char*)lds_raw; F.tid = threadIdx.x; F.lane = F.tid & 63; F.wave = __builtin_amdgcn_readfirstlane(F.tid >> 6);
    F.G = gridDim.x; F.bx = blockIdx.x; F.vcu = (F.G % 8 == 0) ? (F.bx % 8) * (F.G / 8) + F.bx / 8 : F.bx;
    F.in = args.in; F.out = args.out; F.ws = args.ws;
    volatile LAS unsigned* MISC = (volatile LAS unsigned*)(F.lds + MISC_OFF);
    if (F.tid < 4) MISC[F.tid] = 0u;
    __syncthreads();
    unsigned* ctl = (unsigned*)(F.ws + WS_CTL);
    XcdBarrier bar; bar.bar = ctl + CW_BAR; bar.x = 0; bar.st = nullptr;
    const int lo = args.ph_lo, hi = args.ph_hi;
    const bool multi = (hi - lo) > 1;
    if (multi) bar = xcd_barrier_post(ctl + CW_BAR, MISC);
    if (IN(0)) REP(0) { ENTER(); p0_prologue(F, rep); }
    SEAM(0);
    layer_phases<0>(F, bar, lo, hi);
    layer_phases<1>(F, bar, lo, hi);
    if (IN(17)) REP(9) { ENTER(); row_op_a(F, 2, rep == 0); }
#undef IN
#undef SEAM
}

extern "C" void kernel_launch(void* const* d_in, const int* in_sizes, int n_in, void* d_out, int out_size, void* d_ws, size_t ws_size, hipStream_t stream) {
    static int grid = 0;
    if (grid == 0) {
        if (n_in != 22 || out_size != NLAT * D || ws_size < WS_END) { fprintf(stderr, "kernel_launch: unexpected shapes (n_in %d, out %d, ws %zu)\n", n_in, out_size, ws_size); grid = -1; return; }
        int dev = 0, cus = 0, per_cu = 0;
        if (hipGetDevice(&dev) != hipSuccess || hipDeviceGetAttribute(&cus, hipDeviceAttributeMultiprocessorCount, dev) != hipSuccess) { grid = -1; return; }
        if (hipFuncSetAttribute((const void*)fwd_kernel, hipFuncAttributeMaxDynamicSharedMemorySize, LDS_BYTES) != hipSuccess) { fprintf(stderr, "kernel_launch: hipFuncSetAttribute failed\n"); grid = -1; return; }
        if (hipOccupancyMaxActiveBlocksPerMultiprocessor(&per_cu, (const void*)fwd_kernel, 512, LDS_BYTES) != hipSuccess || per_cu < 1) { fprintf(stderr, "kernel_launch: occupancy query says %d\n", per_cu); }
        (void)hipGetLastError();
        grid = cus;
    }
    if (grid < 0) return;
    (void)hipMemsetAsync((char*)d_ws + WS_CTL, 0, CTL_ZERO_BYTES, stream);
    Args a{};
    for (int i = 0; i < 22; ++i) a.in[i] = (const float*)d_in[i];
    a.out = (float*)d_out; a.ws = (unsigned char*)d_ws;
    if (MK_N_LAUNCHES == 1) { a.ph_lo = 0; a.ph_hi = N_PHASES; hipLaunchKernelGGL(fwd_kernel, dim3(grid), dim3(512), LDS_BYTES, stream, a); }
    else { for (int p = 0; p < N_PHASES; ++p) { a.ph_lo = p; a.ph_hi = p + 1; hipLaunchKernelGGL(fwd_kernel, dim3(grid), dim3(512), LDS_BYTES, stream, a); } }
}
```

```cpp
#include <hip/hip_runtime.h>
#include <cstdio>
#include <cstdint>

#ifndef MK_N_LAUNCHES
#define MK_N_LAUNCHES 1
#endif

#ifndef PROBE_REPEAT
#define PROBE_REPEAT -1
#endif
#define LAS __attribute__((address_space(3)))
#define GAS __attribute__((address_space(1)))
typedef unsigned short bf16_t;
typedef short bf16x8 __attribute__((ext_vector_type(8)));
typedef short s16x4 __attribute__((ext_vector_type(4)));
typedef float f32x4 __attribute__((ext_vector_type(4)));
typedef float f32x2 __attribute__((ext_vector_type(2)));
typedef unsigned u32x4 __attribute__((ext_vector_type(4)));
typedef unsigned u32x2 __attribute__((ext_vector_type(2)));

constexpr int Bn = 16, TL = 2048, CT = 256, D = 1024, DEPTH = 2;
constexpr int NLAT = Bn * TL, NCTX = Bn * CT, NTOK = NLAT + NCTX;
constexpr int NP = 2560;
constexpr int NE = 32, FF = 512, NH = 4, HD = 128;
constexpr int NCHUNK = 18;
constexpr float EPS = 1e-6f;
constexpr int MAXTILES = 320;
constexpr int N_PHASES = 18;

constexpr size_t MiB = 1u << 20;
constexpr size_t WS_CTL = 0, CTL_ZERO_BYTES = 1 * MiB;
constexpr size_t WS_MOD = 1 * MiB;
constexpr size_t WS_ROPE = 2 * MiB;
constexpr size_t WS_RIMG = 2 * MiB + 65536;
constexpr size_t WS_TOKINFO = 3 * MiB;
constexpr size_t WS_LIST = 5 * MiB;
constexpr size_t WS_WIN = 10 * MiB;
constexpr size_t WS_WOUT = 20 * MiB;
constexpr size_t WS_WGU = 24 * MiB;
constexpr size_t WS_WD = 152 * MiB;
constexpr size_t WS_SSQ = 216 * MiB;
constexpr size_t WS_XB = 232 * MiB;
constexpr size_t WS_P = 304 * MiB;
constexpr size_t WS_ACT = 484 * MiB;
constexpr size_t WS_END = 564 * MiB;
constexpr int CW_TMO = 0;
constexpr int CW_QUEUE = 512;
constexpr int CW_CNT = 1024;
constexpr int CW_BAR = 4096;

constexpr int RING_BYTES = 131072;
constexpr int TOKT_OFF = RING_BYTES;
constexpr int MISC_OFF = 161792;
constexpr int RW_PITCH = 2064;
constexpr int RW_LO = 36 * RW_PITCH, RW_EX = 2 * 36 * RW_PITCH;
constexpr int LDS_BYTES = 163840;

__device__ __forceinline__ unsigned f2bf(float f) { unsigned u = __builtin_bit_cast(unsigned, f); return (u + 0x7fffu + ((u >> 16) & 1u)) >> 16; }
typedef __bf16 bf16x2_t __attribute__((ext_vector_type(2)));
__device__ __forceinline__ unsigned pk2(float lo, float hi) { const f32x2 f = {lo, hi}; const bf16x2_t v = __builtin_convertvector(f, bf16x2_t); return __builtin_bit_cast(unsigned, v); }
__device__ __forceinline__ float bflo(unsigned w) { return __builtin_bit_cast(float, w << 16); }
__device__ __forceinline__ float bfhi(unsigned w) { return __builtin_bit_cast(float, w & 0xffff0000u); }
__device__ __forceinline__ float wave_sum(float v) {
#pragma unroll
    for (int o = 1; o < 64; o <<= 1) v += __shfl_xor(v, o);
    return v;
}
__device__ __forceinline__ float silu_f(float x) { return x * __builtin_amdgcn_rcpf(1.0f + __builtin_amdgcn_exp2f(-1.4426950408889634f * x)); }

#define XB_TMO      128
#define XB_XCNT(j)  (256  + 64 * (j))
#define XB_XSUB(j)  (1280 + 64 * (j))
#define XB_XGEN(j)  (2304 + 64 * (j))
#define XB_TOP      3328
#define XB_TOPGEN   3392
#define XCD_BAR_WORDS 3456
#define XB_SPIN_CAP (1u << 18)
__device__ __forceinline__ unsigned xb_ld(unsigned* p)              { return __hip_atomic_load(p, __ATOMIC_RELAXED, __HIP_MEMORY_SCOPE_AGENT); }
__device__ __forceinline__ unsigned xb_add(unsigned* p, unsigned v) { return __hip_atomic_fetch_add(p, v, __ATOMIC_RELAXED, __HIP_MEMORY_SCOPE_AGENT); }
__device__ __forceinline__ unsigned xb_xcc_id() { return (unsigned)__builtin_amdgcn_s_getreg((3 << 11) | 20) & 0xFu; }
#define XB_SPIN(cond, bar) do { unsigned _sp = 0; while (cond) { __builtin_amdgcn_s_sleep(1); \
    if ((++_sp & 255u) == 0u) { if (xb_ld(&(bar)[XB_TMO])) break; if (_sp > XB_SPIN_CAP) { atomicAdd(&(bar)[XB_TMO], 1u); break; } } } } while (0)
struct XcdBarrier { unsigned* bar; unsigned x; volatile LAS unsigned* st; };
__device__ __forceinline__ XcdBarrier xcd_barrier_post(unsigned* bar, volatile LAS unsigned* st) {
    XcdBarrier b; b.bar = bar; b.x = xb_xcc_id(); b.st = st;
    if (threadIdx.x == 0) (void)xb_add(&bar[XB_XCNT(b.x)], 1u);
    return b;
}
__device__ __forceinline__ void xcd_barrier_complete(unsigned* bar, unsigned x, unsigned& nloc, unsigned& nx) {
    const unsigned G = gridDim.x * gridDim.y * gridDim.z;
    unsigned sum, cnt, mine, sp = 0u;
    for (;;) {
        sum = 0u; cnt = 0u; mine = 0u;
#pragma unroll
        for (unsigned j = 0; j < 16; ++j) { const unsigned c = xb_ld(&bar[XB_XCNT(j)]); sum += c; cnt += (c > 0u) ? 1u : 0u; mine = (j == x) ? c : mine; }
        if (sum == G) break;
        __builtin_amdgcn_s_sleep(1);
        if ((++sp & 255u) == 0u) { if (xb_ld(&bar[XB_TMO])) break; if (sp > XB_SPIN_CAP) { atomicAdd(&bar[XB_TMO], 1u); break; } }
    }
    nloc = mine > 0u ? mine : 1u; nx = cnt > 0u ? cnt : 1u;
}
__device__ __forceinline__ void xcd_barrier(const XcdBarrier& b) {
    asm volatile("s_waitcnt vmcnt(0)" ::: "memory");
    __syncthreads();
    if (threadIdx.x == 0) {
        unsigned* bar = b.bar;
        __builtin_amdgcn_s_waitcnt(0);
        unsigned nloc = b.st[0], nx = b.st[1];
        if (nloc == 0u) { xcd_barrier_complete(bar, b.x, nloc, nx); b.st[0] = nloc; b.st[1] = nx; }
        const unsigned old = xb_add(&bar[XB_XSUB(b.x)], 1u);
        const unsigned gen = old / nloc;
        if (old + 1u == (gen + 1u) * nloc) {
            __builtin_amdgcn_fence(__ATOMIC_RELEASE, "agent");
            asm volatile("s_waitcnt vmcnt(0)" ::: "memory");
            const unsigned og = xb_add(&bar[XB_TOP], 1u);
            const unsigned tg = og / nx;
            if (og + 1u == (tg + 1u) * nx) xb_add(&bar[XB_TOPGEN], 1u);
            else XB_SPIN(xb_ld(&bar[XB_TOPGEN]) == tg, bar);
            __builtin_amdgcn_fence(__ATOMIC_ACQUIRE, "agent");
            xb_add(&bar[XB_XGEN(b.x)], 1u);
            asm volatile("s_waitcnt vmcnt(0)" ::: "memory");
        } else {
            XB_SPIN(xb_ld(&bar[XB_XGEN(b.x)]) == gen, bar);
            __builtin_amdgcn_fence(__ATOMIC_ACQUIRE, "agent");
            asm volatile("s_waitcnt vmcnt(0)" ::: "memory");
        }
    }
    __syncthreads();
}

namespace pg8 {
constexpr int BM = 256, BK = 64, HALF = 128, HTB = HALF * BK * 2, STAGE_BYTES = 8 * HTB, NXCD = 8, WGM = 8;
__device__ __forceinline__ int lds_byte(int r, int c) { const int st = (r >> 4) * 2 + (c >> 5), rr = r & 15, cc = c & 31, ob = rr * 64 + cc * 2; return st * 1024 + (ob ^ (((ob >> 9) & 1) << 5)); }
__device__ __forceinline__ void stage_rc(int b, int& R, int& C) { const int st = b / 1024, sb = b % 1024, swz = sb ^ (((sb >> 9) & 1) << 5); R = (st >> 1) * 16 + swz / 64; C = (st & 1) * 32 + (swz % 64) / 2; }
__device__ __forceinline__ int perm32(int rho) { const int n = rho >> 4, i = rho & 15; return 8 * (i >> 2) + 4 * n + (i & 3); }

struct Unit { int pm, pn; unsigned bofs; int aux; };

struct SchedDense {
    int nM, nN, nwg, G, c, K;
    __device__ void init(int M, int N, int K_, int G_, int c_) { nM = M / BM; nN = N / BM; nwg = nM * nN; G = G_; c = c_; K = K_; }
    __device__ bool next(int i, Unit& u) const {
        const long L = (long)i * G + c; if (L >= nwg) return false;
        int wgid = (int)L; { const int q = nwg / NXCD, r = nwg % NXCD, xcd = wgid % NXCD, off = wgid / NXCD; wgid = (xcd < r ? xcd * (q + 1) : r * (q + 1) + (xcd - r) * q) + off; }
        const int nig = WGM * nN, gid = wgid / nig, fm = gid * WGM, gsz = (nM - fm) < WGM ? (nM - fm) : WGM;
        u.pm = fm + ((wgid % nig) % gsz); u.pn = (wgid % nig) / gsz; u.bofs = (unsigned)u.pn * (unsigned)(BM * K * 2); u.aux = 0; return true;
    }
    __device__ __forceinline__ unsigned a_row(const Unit& u, int r) const { return (unsigned)(u.pm * BM + r); }
};
struct SchedGroup {
    const LAS int* tb; const LAS int* tokt; int G, c, pitch, gather;
    __device__ bool next(int i, Unit& u) const {
        const int L = i * G + c, nt = tb[NE]; if (L >= nt * 4) return false;
        const int g = L >> 2; const int ln = (int)(threadIdx.x & 63u);
        const int e = (int)__popcll(__ballot(ln < NE && tb[ln + 1] <= g));
        u.pm = g; u.pn = L & 3; u.bofs = (unsigned)(e * 1024 + u.pn * BM) * (unsigned)pitch; u.aux = i; return true;
    }
    __device__ __forceinline__ unsigned a_row(const Unit& u, int r) const { return gather ? (unsigned)tokt[u.aux * 256 + r] : (unsigned)(u.pm * BM + r); }
};

__device__ __forceinline__ unsigned cvt_pk_bf16(float lo, float hi) { unsigned r; asm volatile("v_cvt_pk_bf16_f32 %0, %1, %2" : "=v"(r) : "v"(lo), "v"(hi)); return r; }

typedef int i32x4 __attribute__((ext_vector_type(4)));
typedef int i32x8 __attribute__((ext_vector_type(8)));
template <bool F8> struct Frag { bf16x8 k[2]; };
template <> struct Frag<true> { i32x8 v; };
template <class Epi, class Sched, bool ALIGN_EPI, bool SP2, bool F8 = false>
__device__ __forceinline__ void gemm_phase(LAS unsigned char* lds, const int tid, const char* Abase, const char* Bbase, const int K, const Sched& S, const Epi& E) {
    const int wid = __builtin_amdgcn_readfirstlane(tid >> 6), lane = tid & 63, wr = wid >> 2, wc = wid & 3, fr = lane & 15, fq = lane >> 4;
    const int nt = F8 ? K / 128 : K / BK; const unsigned pitch = F8 ? (unsigned)K : 2u * (unsigned)K;
    int Rr[2], Cc[2]; unsigned voffB[2];
#pragma unroll
    for (int i = 0; i < 2; ++i) { int R, C; stage_rc(tid * 16 + i * 8192, R, C); const int Rb = Epi::PERM ? ((R & ~31) + perm32(R & 31)) : R;
        Rr[i] = R; Cc[i] = C; voffB[i] = (unsigned)Rb * pitch + 2u * (unsigned)C; }
    const size_t kstep = (size_t)(BK * 2);
    const size_t hstep = (size_t)HALF * pitch;
    const unsigned ldsw = (unsigned)wid * 1024u;
    const int fcol = F8 ? (fq >> 1) * 32 + (fq & 1) * 16 : fq * 8;
    const int aoff = lds_byte(wr * 64 + fr, fcol), boff = lds_byte(wc * 32 + fr, fcol);
#define PG8_SA(b, h) (((b) * 2 + (h)) * HTB)
#define PG8_SB(b, h) ((4 + (b) * 2 + (h)) * HTB)
#define PG8_STAGE(bufoff, gbase, voff) do { _Pragma("unroll") for (int _i = 0; _i < 2; ++_i) \
        __builtin_amdgcn_global_load_lds((const unsigned*)((const char*)(gbase) + (voff)[_i]), (LAS unsigned*)(lds + (bufoff) + ldsw + _i * 8192), 16, 0, 0); } while (0)
#define PG8_LDF(dstf, off_) do { if constexpr (F8) { const i32x4 _lo = *(const LAS i32x4*)(lds + (off_)), _hi = *(const LAS i32x4*)(lds + (off_) + 16); dstf.v = __builtin_shufflevector(_lo, _hi, 0, 1, 2, 3, 4, 5, 6, 7); } \
        else { dstf.k[0] = *(const LAS bf16x8*)(lds + (off_)); dstf.k[1] = *(const LAS bf16x8*)(lds + (off_) + 1024); } } while (0)
#define PG8_LDA(dst, b, h) do { _Pragma("unroll") for (int m = 0; m < 4; ++m) PG8_LDF(dst[m], PG8_SA(b, h) + aoff + m * 2048); } while (0)
#define PG8_LDB(dst, b, h) do { _Pragma("unroll") for (int n = 0; n < 2; ++n) PG8_LDF(dst[n], PG8_SB(b, h) + boff + n * 2048); } while (0)
#define PG8_MMA(ai, bj, At, Bt) do { __builtin_amdgcn_s_setprio(1); _Pragma("unroll") for (int m = 0; m < 4; ++m) _Pragma("unroll") for (int n = 0; n < 2; ++n) { \
        if constexpr (F8) asm volatile("v_mfma_f32_16x16x128_f8f6f4 %0, %1, %2, %0" : "+v"(acc[ai][bj][m][n]) : "v"(Bt[n].v), "v"(At[m].v));   \
        else { _Pragma("unroll") for (int k = 0; k < 2; ++k) acc[ai][bj][m][n] = __builtin_amdgcn_mfma_f32_16x16x32_bf16(Bt[n].k[k], At[m].k[k], acc[ai][bj][m][n], 0, 0, 0); } } \
        __builtin_amdgcn_s_setprio(0); } while (0)
#define PG8_WAIT_V(n) asm volatile("s_waitcnt vmcnt(" #n ")" ::: "memory")
#define PG8_WAIT_L(n) asm volatile("s_waitcnt lgkmcnt(" #n ")" ::: "memory")
#define PG8_BAR __builtin_amdgcn_s_barrier()
#define PG8_SCHED __builtin_amdgcn_sched_barrier(0)
#define PG8_AOFF(dst, u) do { _Pragma("unroll") for (int _h = 0; _h < 2; ++_h) _Pragma("unroll") for (int _i = 0; _i < 2; ++_i) \
        dst[_h][_i] = S.a_row(u, _h * HALF + Rr[_i]) * pitch + 2u * (unsigned)Cc[_i]; } while (0)
    Unit cur, nxt; int ui = 0;
    if (!S.next(0, cur)) return;
    f32x4 acc[2][2][4][2];
#pragma unroll
    for (int a = 0; a < 2; ++a)
#pragma unroll
        for (int b = 0; b < 2; ++b)
#pragma unroll
            for (int m = 0; m < 4; ++m)
#pragma unroll
                for (int n = 0; n < 2; ++n) acc[a][b][m][n] = (f32x4){0.f, 0.f, 0.f, 0.f};
    Frag<F8> At[4], B0[2], B1[2];
    unsigned co[2][2], no[2][2];
    PG8_AOFF(co, cur);
    const char* cB = Bbase + cur.bofs;
    if constexpr (SP2) {
        PG8_STAGE(PG8_SB(0, 0), cB, voffB); PG8_STAGE(PG8_SB(0, 1), cB + hstep, voffB); PG8_STAGE(PG8_SA(0, 0), Abase, co[0]); PG8_STAGE(PG8_SA(0, 1), Abase, co[1]);
        if (wr == 1) PG8_BAR;
        PG8_WAIT_V(2); PG8_BAR;
        PG8_STAGE(PG8_SB(1, 0), cB + kstep, voffB); PG8_STAGE(PG8_SA(1, 0), Abase + kstep, co[0]); PG8_STAGE(PG8_SB(1, 1), cB + hstep + kstep, voffB);
        PG8_WAIT_V(6); PG8_BAR;
    } else {
        PG8_STAGE(PG8_SB(0, 0), cB, voffB); PG8_STAGE(PG8_SA(0, 0), Abase, co[0]); PG8_STAGE(PG8_SB(0, 1), cB + hstep, voffB); PG8_STAGE(PG8_SA(0, 1), Abase, co[1]);
        if (wr == 1) PG8_BAR;
        PG8_WAIT_V(4); PG8_BAR;
        PG8_STAGE(PG8_SB(1, 0), cB + kstep, voffB); PG8_STAGE(PG8_SA(1, 0), Abase + kstep, co[0]); PG8_STAGE(PG8_SB(1, 1), cB + hstep + kstep, voffB);
        PG8_WAIT_V(6); PG8_BAR;
    }
    for (;;) {
        const bool has_next = S.next(ui + 1, nxt);
        const char* nB = has_next ? Bbase + nxt.bofs : cB;
        if (has_next) { PG8_AOFF(no, nxt); } else {
#pragma unroll
            for (int h = 0; h < 2; ++h)
#pragma unroll
                for (int i = 0; i < 2; ++i) no[h][i] = co[h][i]; }
#pragma unroll 1
        for (int t = 0; t < nt; t += 2) {
            const bool last = (t == nt - 2);
            const char* a1 = Abase + (size_t)(t + 1) * kstep;
            const char* a2 = last ? Abase : Abase + (size_t)(t + 2) * kstep; const char* b2 = last ? nB : cB + (size_t)(t + 2) * kstep;
            const char* a3 = a2 + kstep; const char* b3 = b2 + kstep;
            unsigned o2[2][2];
#pragma unroll
            for (int h = 0; h < 2; ++h)
#pragma unroll
                for (int i = 0; i < 2; ++i) o2[h][i] = last ? no[h][i] : co[h][i];
            if constexpr (SP2) {
            PG8_LDB(B0, 0, 0); PG8_LDB(B1, 0, 1); PG8_SCHED; PG8_LDA(At, 0, 0); PG8_STAGE(PG8_SA(1, 1), a1, co[1]);
            PG8_WAIT_V(8); PG8_WAIT_L(0); PG8_BAR; PG8_MMA(0, 0, At, B0); PG8_MMA(0, 1, At, B1); PG8_BAR; PG8_SCHED;
            PG8_LDA(At, 0, 1); PG8_STAGE(PG8_SB(0, 0), b2, voffB); PG8_STAGE(PG8_SB(0, 1), b2 + hstep, voffB); PG8_STAGE(PG8_SA(0, 0), a2, o2[0]);
            PG8_WAIT_V(8); PG8_WAIT_L(0); PG8_BAR; PG8_MMA(1, 0, At, B0); PG8_MMA(1, 1, At, B1); PG8_BAR; PG8_SCHED;
            PG8_LDB(B0, 1, 0); PG8_LDB(B1, 1, 1); PG8_SCHED; PG8_LDA(At, 1, 0); PG8_STAGE(PG8_SA(0, 1), a2, o2[1]);
            PG8_WAIT_V(8); PG8_WAIT_L(0); PG8_BAR; PG8_MMA(0, 0, At, B0); PG8_MMA(0, 1, At, B1); PG8_BAR; PG8_SCHED;
            PG8_LDA(At, 1, 1); PG8_STAGE(PG8_SB(1, 0), b3, voffB); PG8_STAGE(PG8_SB(1, 1), b3 + hstep, voffB); PG8_STAGE(PG8_SA(1, 0), a3, o2[0]);
            PG8_WAIT_V(8); PG8_WAIT_L(0); PG8_BAR; PG8_MMA(1, 0, At, B0); PG8_MMA(1, 1, At, B1); PG8_BAR; PG8_SCHED;
            } else {
            PG8_LDB(B0, 0, 0); PG8_SCHED; PG8_LDA(At, 0, 0); PG8_STAGE(PG8_SA(1, 1), a1, co[1]);
            PG8_WAIT_L(8); PG8_BAR; PG8_WAIT_L(0); PG8_MMA(0, 0, At, B0); PG8_BAR; PG8_SCHED;
            PG8_LDB(B1, 0, 1); PG8_STAGE(PG8_SB(0, 0), b2, voffB);
            PG8_BAR; PG8_WAIT_L(0); PG8_MMA(0, 1, At, B1); PG8_BAR;
            PG8_LDA(At, 0, 1); PG8_STAGE(PG8_SA(0, 0), a2, o2[0]);
            PG8_BAR; PG8_WAIT_L(0); PG8_MMA(1, 0, At, B0); PG8_BAR; PG8_SCHED;
            PG8_STAGE(PG8_SB(0, 1), b2 + hstep, voffB);
            PG8_WAIT_V(6); PG8_BAR; PG8_MMA(1, 1, At, B1); PG8_BAR;
            PG8_LDB(B0, 1, 0); PG8_SCHED; PG8_LDA(At, 1, 0); PG8_STAGE(PG8_SA(0, 1), a2, o2[1]);
            PG8_WAIT_L(8); PG8_BAR; PG8_WAIT_L(0); PG8_MMA(0, 0, At, B0); PG8_BAR; PG8_SCHED;
            PG8_LDB(B1, 1, 1); PG8_STAGE(PG8_SB(1, 0), b3, voffB);
            PG8_BAR; PG8_WAIT_L(0); PG8_MMA(0, 1, At, B1); PG8_BAR;
            PG8_LDA(At, 1, 1); PG8_STAGE(PG8_SA(1, 0), a3, o2[0]);
            PG8_BAR; PG8_WAIT_L(0); PG8_MMA(1, 0, At, B0); PG8_BAR; PG8_SCHED;
            PG8_STAGE(PG8_SB(1, 1), b3 + hstep, voffB);
            PG8_WAIT_V(6); PG8_BAR; PG8_MMA(1, 1, At, B1); PG8_BAR;
            }
        }
        if constexpr (ALIGN_EPI) { if (wr == 0) PG8_BAR; }
        if constexpr (F8) { __builtin_amdgcn_sched_barrier(0); asm volatile("s_nop 15\n\ts_nop 15\n\ts_nop 7" ::: "memory"); __builtin_amdgcn_sched_barrier(0); }
        E(acc, cur, wr, wc, fr, fq);
        if (!has_next) break;
#pragma unroll
        for (int a = 0; a < 2; ++a)
#pragma unroll
            for (int b = 0; b < 2; ++b)
#pragma unroll
                for (int m = 0; m < 4; ++m)
#pragma unroll
                    for (int n = 0; n < 2; ++n) acc[a][b][m][n] = (f32x4){0.f, 0.f, 0.f, 0.f};
        cur = nxt; cB = nB; ++ui;
#pragma unroll
        for (int h = 0; h < 2; ++h)
#pragma unroll
            for (int i = 0; i < 2; ++i) co[h][i] = no[h][i];
        if constexpr (ALIGN_EPI) { if (wr == 1) PG8_BAR; }
    }
    PG8_WAIT_V(0);
    if constexpr (!ALIGN_EPI) { if (wr == 0) PG8_BAR; }
    PG8_BAR;
#undef PG8_SA
#undef PG8_SB
#undef PG8_STAGE
#undef PG8_LDA
#undef PG8_LDF
#undef PG8_LDB
#undef PG8_MMA
#undef PG8_WAIT_V
#undef PG8_WAIT_L
#undef PG8_BAR
#undef PG8_SCHED
#undef PG8_AOFF
}

struct EpiInProj {
    static constexpr bool PERM = true;
    bf16_t* P; const float* ropeC; const float* ropeS;
    __device__ __forceinline__ void operator()(const f32x4 (&acc)[2][2][4][2], const Unit& u, int wr, int wc, int fr, int fq) const {
        const int row0 = u.pm * BM + wr * 64 + fr, col0 = u.pn * BM + wc * 32 + 8 * fq;
        const bool qk = u.pn < 4, rope = qk && (u.pm < NLAT / BM);
        const float ks = (u.pn >= 2 && u.pn < 4) ? 0.08838834764831845f : 1.0f;
        const int sec = wc >> 1, i0 = (wc & 1) * 16 + 4 * fq;
#pragma unroll
        for (int ai = 0; ai < 2; ++ai)
#pragma unroll
            for (int m = 0; m < 4; ++m) {
                const int row = row0 + ai * HALF + m * 16;
                asm volatile("" ::: "memory");
                f32x4 c4 = (f32x4){1.f, 1.f, 1.f, 1.f}, s4 = (f32x4){0.f, 0.f, 0.f, 0.f};
                if (rope) { const int t = row & (TL - 1), pos = sec ? (t & 63) : (t >> 6); const int ti = (sec ? 1024 : 0) + pos * 32 + i0;
                    c4 = *(const f32x4*)(ropeC + ti); s4 = *(const f32x4*)(ropeS + ti); }
                bf16_t* rowp = P + (size_t)row * NP + col0;
#pragma unroll
                for (int bj = 0; bj < 2; ++bj) {
                    f32x4 v0 = acc[ai][bj][m][0], v1 = acc[ai][bj][m][1];
                    if (qk) {
                        const float a0 = v0[0] * c4[0] - v0[1] * s4[0], b0 = v0[0] * s4[0] + v0[1] * c4[0];
                        const float a1 = v0[2] * c4[1] - v0[3] * s4[1], b1 = v0[2] * s4[1] + v0[3] * c4[1];
                        const float a2 = v1[0] * c4[2] - v1[1] * s4[2], b2 = v1[0] * s4[2] + v1[1] * c4[2];
                        const float a3 = v1[2] * c4[3] - v1[3] * s4[3], b3 = v1[2] * s4[3] + v1[3] * c4[3];
                        v0 = (f32x4){a0 * ks, b0 * ks, a1 * ks, b1 * ks}; v1 = (f32x4){a2 * ks, b2 * ks, a3 * ks, b3 * ks};
                    }
                    u32x4 w; w.x = cvt_pk_bf16(v0[0], v0[1]); w.y = cvt_pk_bf16(v0[2], v0[3]); w.z = cvt_pk_bf16(v1[0], v1[1]); w.w = cvt_pk_bf16(v1[2], v1[3]);
                    *(u32x4*)(rowp + bj * HALF) = w;
                }
            }
    }
};
struct EpiResid {
    static constexpr bool PERM = true;
    const float* rl; const float* rc; const bf16_t* rb; bf16_t* ob; float* ssq; const float* gmod;
    __device__ __forceinline__ void operator()(const f32x4 (&acc)[2][2][4][2], const Unit& u, int wr, int wc, int fr, int fq) const {
        const int row0 = u.pm * BM + wr * 64 + fr, col0 = u.pn * BM + wc * 32 + 8 * fq;
        const bool lat = u.pm < NLAT / BM; const int b = lat ? (u.pm >> 3) : 16;
        const float* rbase = rl ? (lat ? rl : rc - (size_t)NLAT * D) : nullptr;
        f32x4 gv[2][2];
#pragma unroll
        for (int bj = 0; bj < 2; ++bj)
#pragma unroll
            for (int n = 0; n < 2; ++n) gv[bj][n] = *(const f32x4*)(gmod + (size_t)b * 6 * D + col0 + bj * HALF + 4 * n);
#pragma unroll
        for (int ai = 0; ai < 2; ++ai)
#pragma unroll
            for (int m = 0; m < 4; ++m) { const int row = row0 + ai * HALF + m * 16; const size_t off = (size_t)row * D + col0; float ss = 0.f;
#pragma unroll
                for (int bj = 0; bj < 2; ++bj) { f32x4 r0, r1;
                    if (rbase) { r0 = *(const f32x4*)(rbase + off + bj * HALF); r1 = *(const f32x4*)(rbase + off + bj * HALF + 4); }
                    else { const u32x4 w = *(const u32x4*)(rb + off + bj * HALF); r0 = (f32x4){bflo(w.x), bfhi(w.x), bflo(w.y), bfhi(w.y)}; r1 = (f32x4){bflo(w.z), bfhi(w.z), bflo(w.w), bfhi(w.w)}; }
                    const f32x4 v0 = r0 + gv[bj][0] * acc[ai][bj][m][0], v1 = r1 + gv[bj][1] * acc[ai][bj][m][1];
                    ss += (v0[0] * v0[0] + v0[1] * v0[1]) + (v0[2] * v0[2] + v0[3] * v0[3]) + (v1[0] * v1[0] + v1[1] * v1[1]) + (v1[2] * v1[2] + v1[3] * v1[3]);
                    u32x4 w; w.x = cvt_pk_bf16(v0[0], v0[1]); w.y = cvt_pk_bf16(v0[2], v0[3]); w.z = cvt_pk_bf16(v1[0], v1[1]); w.w = cvt_pk_bf16(v1[2], v1[3]);
                    *(u32x4*)(ob + off + bj * HALF) = w; }
                ss += __shfl_xor(ss, 16); ss += __shfl_xor(ss, 32);
                if (fq == 0) ssq[(size_t)row * 16 + u.pn * 4 + wc] = ss;
                if (m & 1) asm volatile("" ::: "memory"); }
    }
};
struct EpiSwiGLU {
    static constexpr bool PERM = true;
    bf16_t* O;
    __device__ __forceinline__ void operator()(const f32x4 (&acc)[2][2][4][2], const Unit& u, int wr, int wc, int fr, int fq) const {
        const int row0 = u.pm * BM + wr * 64 + fr, col0 = u.pn * 128 + wc * 16 + 4 * fq;
#pragma unroll
        for (int ai = 0; ai < 2; ++ai)
#pragma unroll
            for (int m = 0; m < 4; ++m) { bf16_t* rowp = O + (size_t)(row0 + ai * HALF + m * 16) * FF + col0;
#pragma unroll
                for (int bj = 0; bj < 2; ++bj) { const f32x4 g = acc[ai][bj][m][0], up = acc[ai][bj][m][1];
                    u32x2 w; w.x = cvt_pk_bf16(silu_f(g[0]) * up[0], silu_f(g[1]) * up[1]); w.y = cvt_pk_bf16(silu_f(g[2]) * up[2], silu_f(g[3]) * up[3]);
                    *(u32x2*)(rowp + bj * 64) = w; } }
    }
};
__device__ __forceinline__ unsigned pk4_fp8(float a, float b, float c, float d) { int p = __builtin_amdgcn_cvt_pk_fp8_f32(a, b, 0, false); p = __builtin_amdgcn_cvt_pk_fp8_f32(c, d, p, true); return (unsigned)p; }
struct EpiSwiGLU8 {
    static constexpr bool PERM = true;
    unsigned char* O; float inv;
    __device__ __forceinline__ void operator()(const f32x4 (&acc)[2][2][4][2], const Unit& u, int wr, int wc, int fr, int fq) const {
        const int row0 = u.pm * BM + wr * 64 + fr, col0 = u.pn * 128 + wc * 32 + 8 * fq;
#pragma unroll
        for (int ai = 0; ai < 2; ++ai)
#pragma unroll
            for (int m = 0; m < 4; ++m) { unsigned char* rowp = O + (size_t)(row0 + ai * HALF + m * 16) * FF + col0;
                const f32x4 g0 = acc[ai][0][m][0] * inv, g1 = acc[ai][0][m][1] * inv, u0 = acc[ai][1][m][0] * inv, u1 = acc[ai][1][m][1] * inv;
                u32x2 w; w.x = pk4_fp8(silu_f(g0[0]) * u0[0], silu_f(g0[1]) * u0[1], silu_f(g0[2]) * u0[2], silu_f(g0[3]) * u0[3]);
                w.y = pk4_fp8(silu_f(g1[0]) * u1[0], silu_f(g1[1]) * u1[1], silu_f(g1[2]) * u1[2], silu_f(g1[3]) * u1[3]);
                *(u32x2*)rowp = w; }
    }
};
struct EpiFp8S {
    static constexpr bool PERM = true;
    unsigned char* O; int ldc; float inv;
    __device__ __forceinline__ void operator()(const f32x4 (&acc)[2][2][4][2], const Unit& u, int wr, int wc, int fr, int fq) const {
        const int row0 = u.pm * BM + wr * 64 + fr, col0 = u.pn * BM + wc * 32 + 8 * fq;
#pragma unroll
        for (int ai = 0; ai < 2; ++ai)
#pragma unroll
            for (int m = 0; m < 4; ++m) { unsigned char* rowp = O + (size_t)(row0 + ai * HALF + m * 16) * ldc + col0;
#pragma unroll
                for (int bj = 0; bj < 2; ++bj) { const f32x4 v0 = acc[ai][bj][m][0] * inv, v1 = acc[ai][bj][m][1] * inv;
                    u32x2 w; w.x = pk4_fp8(v0[0], v0[1], v0[2], v0[3]); w.y = pk4_fp8(v1[0], v1[1], v1[2], v1[3]);
                    *(u32x2*)(rowp + bj * HALF) = w; } }
    }
};
struct EpiBf16S {
    static constexpr bool PERM = true;
    bf16_t* O; int ldc; float inv;
    __device__ __forceinline__ void operator()(const f32x4 (&acc)[2][2][4][2], const Unit& u, int wr, int wc, int fr, int fq) const {
        const int row0 = u.pm * BM + wr * 64 + fr, col0 = u.pn * BM + wc * 32 + 8 * fq;
#pragma unroll
        for (int ai = 0; ai < 2; ++ai)
#pragma unroll
            for (int m = 0; m < 4; ++m) { bf16_t* rowp = O + (size_t)(row0 + ai * HALF + m * 16) * ldc + col0;
#pragma unroll
                for (int bj = 0; bj < 2; ++bj) { const f32x4 v0 = acc[ai][bj][m][0] * inv, v1 = acc[ai][bj][m][1] * inv;
                    u32x4 w; w.x = cvt_pk_bf16(v0[0], v0[1]); w.y = cvt_pk_bf16(v0[2], v0[3]); w.z = cvt_pk_bf16(v1[0], v1[1]); w.w = cvt_pk_bf16(v1[2], v1[3]);
                    *(u32x4*)(rowp + bj * HALF) = w; } }
    }
};
struct EpiBf16 {
    static constexpr bool PERM = true;
    bf16_t* O; int ldc;
    __device__ __forceinline__ void operator()(const f32x4 (&acc)[2][2][4][2], const Unit& u, int wr, int wc, int fr, int fq) const {
        const int row0 = u.pm * BM + wr * 64 + fr, col0 = u.pn * BM + wc * 32 + 8 * fq;
#pragma unroll
        for (int ai = 0; ai < 2; ++ai)
#pragma unroll
            for (int m = 0; m < 4; ++m) { bf16_t* rowp = O + (size_t)(row0 + ai * HALF + m * 16) * ldc + col0;
#pragma unroll
                for (int bj = 0; bj < 2; ++bj) { const f32x4 v0 = acc[ai][bj][m][0], v1 = acc[ai][bj][m][1];
                    u32x4 w; w.x = cvt_pk_bf16(v0[0], v0[1]); w.y = cvt_pk_bf16(v0[2], v0[3]); w.z = cvt_pk_bf16(v1[0], v1[1]); w.w = cvt_pk_bf16(v1[2], v1[3]);
                    *(u32x4*)(rowp + bj * HALF) = w; } }
    }
};
}

struct Args { const float* in[22]; float* out; unsigned char* ws; int ph_lo, ph_hi; };
enum { I_X = 0, I_C, I_CTX, I_CCTX, I_ADAW, I_ADAB, I_N1G, I_WIN, I_DF, I_DB, I_POOLW, I_POOLS, I_WOUT, I_N2G, I_RGW, I_RGB, I_REW, I_REB, I_WG, I_WU, I_WDN, I_FNG };

struct Frame {
    LAS unsigned char* lds; int tid, lane, wave, G, bx, vcu;
    const float* const* in; float* out; unsigned char* ws;
};
__device__ __forceinline__ bf16_t* xb_row(const Frame& F, int row) { return (bf16_t*)(F.ws + WS_XB) + (size_t)row * D; }
__device__ __forceinline__ bf16_t* hbuf(const Frame& F) { return (bf16_t*)F.out; }
__device__ __forceinline__ const float* mod_ptr(const Frame& F, int l, int b, int which) { return (const float*)(F.ws + WS_MOD) + ((size_t)(l * 17 + b) * 6 + which) * D; }

__device__ __forceinline__ void tr_item(const float* colp, size_t ldw, int k0, bf16_t* WT, int K, int n0, LAS float* scr, int lane) {
    { float v[32];
#pragma unroll
        for (int i = 0; i < 32; ++i) v[i] = colp[(size_t)(k0 + 2 * i + (lane >> 5)) * ldw];
#pragma unroll
        for (int i = 0; i < 32; ++i) scr[(2 * i + (lane >> 5)) * 33 + (lane & 31)] = v[i]; }
    asm volatile("s_waitcnt lgkmcnt(0)" ::: "memory");
    const int c = lane & 7;
#pragma unroll
    for (int j = 0; j < 4; ++j) { const int n = (lane >> 3) + 8 * j; const LAS float* s = scr + (8 * c) * 33 + n;
        u32x4 o; o.x = pk2(s[0 * 33], s[1 * 33]); o.y = pk2(s[2 * 33], s[3 * 33]); o.z = pk2(s[4 * 33], s[5 * 33]); o.w = pk2(s[6 * 33], s[7 * 33]);
        *(u32x4*)(WT + (size_t)(n0 + n) * K + k0 + 8 * c) = o; }
    asm volatile("s_waitcnt lgkmcnt(0)" ::: "memory");
}
constexpr float WGU_SCALE = 64.0f, WD_SCALE = 32.0f;
__device__ __forceinline__ void tr_item8(const float* colp, size_t ldw, int k0, unsigned char* WT, int K, int n0, LAS float* scr, int lane, float qs) {
    { float v[32];
#pragma unroll
        for (int i = 0; i < 32; ++i) v[i] = colp[(size_t)(k0 + 2 * i + (lane >> 5)) * ldw];
#pragma unroll
        for (int i = 0; i < 32; ++i) scr[(2 * i + (lane >> 5)) * 33 + (lane & 31)] = v[i] * qs; }
    asm volatile("s_waitcnt lgkmcnt(0)" ::: "memory");
    const int c = lane & 7;
#pragma unroll
    for (int j = 0; j < 4; ++j) { const int n = (lane >> 3) + 8 * j; const LAS float* s = scr + (8 * c) * 33 + n;
        u32x2 o; o.x = pg8::pk4_fp8(s[0 * 33], s[1 * 33], s[2 * 33], s[3 * 33]); o.y = pg8::pk4_fp8(s[4 * 33], s[5 * 33], s[6 * 33], s[7 * 33]);
        *(u32x2*)(WT + (size_t)(n0 + n) * K + k0 + 8 * c) = o; }
    asm volatile("s_waitcnt lgkmcnt(0)" ::: "memory");
}
__device__ __forceinline__ void fold_item(const float* win, const float* pw, const float* ps, int k0, bf16_t* WT, int n0, LAS float* scr, int lane) {
    const int n = n0 + (lane & 31), g = n >> 7, nn = n & 127;
    const float* pwc = pw + (size_t)g * 128 * 128 + nn; const float sc = ps[n];
    float acc[32];
#pragma unroll
    for (int i = 0; i < 32; ++i) acc[i] = 0.f;
    for (int hc = 0; hc < 8; ++hc) {
        float pc[16];
#pragma unroll
        for (int c = 0; c < 16; ++c) pc[c] = pwc[(size_t)(hc * 16 + c) * 128];
#pragma unroll
        for (int i = 0; i < 32; ++i) { const f32x4* wr = (const f32x4*)(win + (size_t)(k0 + 2 * i + (lane >> 5)) * NP + 2048 + g * 128 + hc * 16);
            float a = acc[i];
#pragma unroll
            for (int c4 = 0; c4 < 4; ++c4) { const f32x4 w = wr[c4]; a += w[0] * pc[4 * c4] + w[1] * pc[4 * c4 + 1] + w[2] * pc[4 * c4 + 2] + w[3] * pc[4 * c4 + 3]; }
            acc[i] = a; }
    }
#pragma unroll
    for (int i = 0; i < 32; ++i) scr[(2 * i + (lane >> 5)) * 33 + (lane & 31)] = acc[i] * sc;
    asm volatile("s_waitcnt lgkmcnt(0)" ::: "memory");
    const int c = lane & 7;
#pragma unroll
    for (int j = 0; j < 4; ++j) { const int nl = (lane >> 3) + 8 * j; const LAS float* s = scr + (8 * c) * 33 + nl;
        u32x4 o; o.x = pk2(s[0 * 33], s[1 * 33]); o.y = pk2(s[2 * 33], s[3 * 33]); o.z = pk2(s[4 * 33], s[5 * 33]); o.w = pk2(s[6 * 33], s[7 * 33]);
        *(u32x4*)(WT + (size_t)(2048 + n0 + nl) * D + k0 + 8 * c) = o; }
    asm volatile("s_waitcnt lgkmcnt(0)" ::: "memory");
}
__device__ __forceinline__ void p0_prologue(const Frame& F, int qsel) {
    for (int task = F.bx; task < 2 * 96; task += F.G) {
        const int l = task / 96, cg = task % 96;
        LAS float* sc = (LAS float*)F.lds;
        LAS float* part = (LAS float*)(F.lds + 17 * 1024 * 4);
        { float cv[34];
#pragma unroll
          for (int q = 0; q < 34; ++q) { const int i = F.tid + 512 * q, b = i >> 10, k = i & 1023; cv[q] = b < 16 ? F.in[I_C][b * D + k] : F.in[I_CCTX][k]; }
#pragma unroll
          for (int q = 0; q < 34; ++q) sc[F.tid + 512 * q] = silu_f(cv[q]); }
        __syncthreads();
        float acc[17];
#pragma unroll
        for (int b = 0; b < 17; ++b) acc[b] = 0.f;
        const float* aw = F.in[I_ADAW] + (size_t)l * D * 6 * D + cg * 64 + F.lane;
        for (int k0 = F.wave * 128; k0 < F.wave * 128 + 128; k0 += 16) { float w[16];
#pragma unroll
            for (int u = 0; u < 16; ++u) w[u] = aw[(size_t)(k0 + u) * 6 * D];
#pragma unroll
            for (int u = 0; u < 16; ++u) {
#pragma unroll
                for (int b = 0; b < 17; ++b) acc[b] += sc[b * 1024 + k0 + u] * w[u]; } }
#pragma unroll
        for (int b = 0; b < 17; ++b) part[(F.wave * 17 + b) * 64 + F.lane] = acc[b];
        __syncthreads();
        for (int i = F.tid; i < 17 * 64; i += 512) { const int b = i >> 6, n = i & 63; float s = F.in[I_ADAB][l * 6 * D + cg * 64 + n];
#pragma unroll
            for (int w = 0; w < 8; ++w) s += part[(w * 17 + b) * 64 + n];
            const int col = cg * 64 + n; ((float*)(F.ws + WS_MOD))[((size_t)(l * 17 + b) * 6 + (col >> 10)) * D + (col & 1023)] = s; }
        __syncthreads();
    }
    if (F.bx >= F.G - 3 && F.bx < F.G - 1) { const int l = F.G - 2 - F.bx; unsigned char* img = F.ws + WS_RIMG + (size_t)l * RW_EX;
        const float* rg = F.in[I_RGW] + (size_t)l * D * 4; const float* re = F.in[I_REW] + (size_t)l * D * NE;
        for (int i0 = F.tid; i0 < 1024 * 36; i0 += 512 * 8) { float w[8];
#pragma unroll
            for (int q = 0; q < 8; ++q) { const int i = i0 + 512 * q, k = i / 36, n = i % 36; w[q] = n < 4 ? rg[k * 4 + n] : re[k * NE + (n - 4)]; }
#pragma unroll
            for (int q = 0; q < 8; ++q) { const int i = i0 + 512 * q, k = i / 36, n = i % 36; const unsigned hi = f2bf(w[q]), lo = f2bf(w[q] - bflo(hi));
                *(bf16_t*)(img + n * RW_PITCH + k * 2) = (bf16_t)hi; *(bf16_t*)(img + RW_LO + n * RW_PITCH + k * 2) = (bf16_t)lo; } }
        for (int i = F.tid; i < 2 * 36 * 8; i += 512) { const int r = i >> 3; *(bf16_t*)(img + r * RW_PITCH + 2048 + (i & 7) * 2) = 0; }
    }
    if (F.bx == F.G - 1) {
        float* rc = (float*)(F.ws + WS_ROPE); float* rs = rc + 96 * 32;
        for (int i = F.tid; i < 96 * 32; i += 512) { const int p = i >> 5, f = i & 31; const int pos = p < 32 ? p : p - 32;
            const float inv = powf(10000.0f, -(float)f / 32.0f); const float ang = (float)pos * inv; rc[i] = cosf(ang); rs[i] = sinf(ang); }
    }
    LAS float* scr = (LAS float*)(F.lds + F.wave * 8448);
    constexpr int IT_WIN = 16 * 80, IT_WOUT = 16 * 32, IT_GU = 16 * 32, IT_DN = 8 * 32;
    constexpr int N_WIN = DEPTH * IT_WIN, N_WOUT = DEPTH * IT_WOUT, N_GU = DEPTH * NE * IT_GU, N_DN = DEPTH * NE * IT_DN;
    unsigned* qhead = (unsigned*)(F.ws + WS_CTL) + CW_QUEUE + 16 * qsel;
    constexpr int N_ALL = N_WIN + N_WOUT + N_GU + N_DN, QB = 16, NBATCH = N_ALL / QB;
    static_assert(N_ALL % QB == 0, "queue batches");
    for (;;) {
        int bq = 0; if (F.lane == 0) bq = (int)__hip_atomic_fetch_add(qhead, 1u, __ATOMIC_RELAXED, __HIP_MEMORY_SCOPE_AGENT);
        bq = __builtin_amdgcn_readfirstlane(bq);
        if (bq >= NBATCH) break;
      for (int qi = 0; qi < QB; ++qi) {
        int r = bq + qi * NBATCH;
        if (r < N_WIN) { const int l = r / IT_WIN; r %= IT_WIN; const int kb = r & 15, nb = 79 - (r >> 4), n0 = nb * 32;
            const float* win = F.in[I_WIN] + (size_t)l * D * NP; bf16_t* WT = (bf16_t*)(F.ws + WS_WIN) + (size_t)l * NP * D;
            if (n0 >= 2048) { fold_item(win, F.in[I_POOLW] + (size_t)l * 4 * 128 * 128, F.in[I_POOLS] + l * 512, kb * 64, WT, n0 - 2048, scr, F.lane); continue; }
            const int n = n0 + (F.lane & 31); int src = n;
            if (n < 1024) { const int hh = n >> 7, j = n & 127, sec = j >> 6, jj = j & 63; src = (n & 512) + (hh & 3) * 128 + sec * 64 + (jj & 1) * 32 + (jj >> 1); }
            tr_item(win + src, NP, kb * 64, WT, D, n0, scr, F.lane); continue; }
        r -= N_WIN;
        if (r < N_WOUT) { const int l = r / IT_WOUT; r %= IT_WOUT; const int kb = r / 32, nb = r % 32, n0 = nb * 32;
            tr_item(F.in[I_WOUT] + (size_t)l * D * D + n0 + (F.lane & 31), D, kb * 64, (bf16_t*)(F.ws + WS_WOUT) + (size_t)l * D * D, D, n0, scr, F.lane); continue; }
        r -= N_WOUT;
        if (r < N_GU) { const int le = r / IT_GU; r %= IT_GU; const int kb = r / 32, nb = r % 32, n0 = nb * 32;
            const int n = n0 + (F.lane & 31), col = (n >> 8) * 128 + (n & 127); const float* src = ((n & 128) ? F.in[I_WU] : F.in[I_WG]) + (size_t)le * D * FF + col;
            tr_item8(src, FF, kb * 64, (unsigned char*)(F.ws + WS_WGU) + (size_t)le * 1024 * D, D, n0, scr, F.lane, WGU_SCALE); continue; }
        r -= N_GU;
        { const int le = r / IT_DN; r %= IT_DN; const int kb = r / 32, nb = r % 32, n0 = nb * 32;
            tr_item8(F.in[I_WDN] + (size_t)le * FF * D + n0 + (F.lane & 31), D, kb * 64, (unsigned char*)(F.ws + WS_WD) + (size_t)le * D * FF, FF, n0, scr, F.lane, WD_SCALE); }
      }
    }
}

__device__ __forceinline__ LAS int* build_tb(const Frame& F, int l) {
    LAS int* tb = (LAS int*)(F.lds + MISC_OFF + 64);
    if (F.tid < 64) {
        const unsigned* cnt = (const unsigned*)(F.ws + WS_CTL) + CW_CNT + l * NE * 16;
        const int e = F.tid & 31; const int c = (int)__hip_atomic_load(cnt + e * 16, __ATOMIC_RELAXED, __HIP_MEMORY_SCOPE_AGENT);
        const int t = (c + 255) >> 8; int incl = t;
#pragma unroll
        for (int o = 1; o < 32; o <<= 1) { const int v = __shfl_up(incl, o, 32); if (e >= o) incl += v; }
        if (F.tid < 32) { tb[e] = incl - t; tb[64 + e] = c; if (e == 31) tb[NE] = incl; }
    }
    __syncthreads();
    return tb;
}

__device__ __forceinline__ void row_op_a(const Frame& F, int mode, bool dry) {
    const int gw = F.vcu * 8 + F.wave, NGW = F.G * 8;
    const int nrows = (mode == 2) ? NLAT : NTOK; const int l = (mode == 0) ? 0 : 1, lp = mode - 1;
    const LAS int* tb = nullptr; if (mode != 0) tb = build_tb(F, lp);
    const unsigned char* YB = (const unsigned char*)(F.ws + WS_P); bf16_t* H = hbuf(F);
    const float* gain = (mode == 2) ? F.in[I_FNG] : F.in[I_N1G] + l * D;
    const int R = (nrows + NGW - 1) / NGW, r_lo = gw * R, r_hi = (r_lo + R < nrows) ? r_lo + R : nrows;
    int4 ti1 = make_int4(0, 0, 0, 0), ti2 = ti1; f32x2 tw0 = (f32x2){0.f, 0.f}, tw1 = tw0, tw2 = tw0;
    f32x4 xf[4]; u32x2 xq[4]; unsigned ya[4], yc[4];
#define ROWA_INFO(r_, ti_, tw_) do { if (mode != 0 && (r_) < r_hi) { ti_ = *(const int4*)(F.ws + WS_TOKINFO + (size_t)(r_) * 32); tw_ = *(const f32x2*)(F.ws + WS_TOKINFO + (size_t)(r_) * 32 + 16); } } while (0)
#define ROWA_DATA(r_, ti_) do { if ((r_) < r_hi) { if (mode == 0) { const f32x4* src = (const f32x4*)((r_) < NLAT ? F.in[I_X] + (size_t)(r_) * D : F.in[I_CTX] + (size_t)((r_) - NLAT) * D) + F.lane; \
            _Pragma("unroll") for (int j = 0; j < 4; ++j) xf[j] = src[64 * j]; } \
        else { const size_t s1 = (size_t)(tb[ti_.x] * 256 + ti_.y), s2 = (size_t)(tb[ti_.z] * 256 + ti_.w); const u32x2* xr_ = (const u32x2*)xb_row(F, (r_)) + F.lane; \
            const unsigned* y1 = (const unsigned*)(YB + s1 * D) + F.lane; const unsigned* y2 = (const unsigned*)(YB + s2 * D) + F.lane; \
            _Pragma("unroll") for (int j = 0; j < 4; ++j) { xq[j] = xr_[64 * j]; ya[j] = y1[64 * j]; yc[j] = y2[64 * j]; } } } } while (0)
    ROWA_INFO(r_lo, ti1, tw1); ROWA_INFO(r_lo + 1, ti2, tw2);
    ROWA_DATA(r_lo, ti1); tw0 = tw1; ti1 = ti2; tw1 = tw2;
    f32x4 vA[4], vB[4], vG[4]; int bcur = -1;
    for (int row = r_lo; row < r_hi; ++row) {
        const int b = row < NLAT ? (row >> 11) : 16;
        if (b != bcur) { bcur = b;
#pragma unroll
            for (int j = 0; j < 4; ++j) { const f32x4 g = ((const f32x4*)gain)[F.lane + 64 * j];
                if (mode == 2) { vA[j] = g; vB[j] = (f32x4){0.f, 0.f, 0.f, 0.f}; }
                else { vA[j] = g * (((const f32x4*)mod_ptr(F, l, b, 1))[F.lane + 64 * j] + 1.0f); vB[j] = ((const f32x4*)mod_ptr(F, l, b, 0))[F.lane + 64 * j]; }
                if (mode != 0) vG[j] = ((const f32x4*)mod_ptr(F, lp, b, 5))[F.lane + 64 * j]; } }
        ROWA_INFO(row + 2, ti2, tw2);
        f32x4 v[4];
        if (mode == 0) {
#pragma unroll
            for (int j = 0; j < 4; ++j) v[j] = xf[j];
        } else {
#pragma unroll
            for (int j = 0; j < 4; ++j) { const u32x2 xw = xq[j]; const f32x4 x = (f32x4){bflo(xw.x), bfhi(xw.x), bflo(xw.y), bfhi(xw.y)};
                const int a = (int)ya[j], c = (int)yc[j];
                f32x4 y; y[0] = tw0.x * __builtin_amdgcn_cvt_f32_fp8(a, 0) + tw0.y * __builtin_amdgcn_cvt_f32_fp8(c, 0); y[1] = tw0.x * __builtin_amdgcn_cvt_f32_fp8(a, 1) + tw0.y * __builtin_amdgcn_cvt_f32_fp8(c, 1);
                y[2] = tw0.x * __builtin_amdgcn_cvt_f32_fp8(a, 2) + tw0.y * __builtin_amdgcn_cvt_f32_fp8(c, 2); y[3] = tw0.x * __builtin_amdgcn_cvt_f32_fp8(a, 3) + tw0.y * __builtin_amdgcn_cvt_f32_fp8(c, 3);
                v[j] = x + vG[j] * y; }
        }
        ROWA_DATA(row + 1, ti1);
        if (mode == 1 && !dry) { u32x2* xr = (u32x2*)xb_row(F, row) + F.lane;
#pragma unroll
            for (int j = 0; j < 4; ++j) { u32x2 w; w.x = pk2(v[j][0], v[j][1]); w.y = pk2(v[j][2], v[j][3]); xr[64 * j] = w; } }
        float ss = 0.f;
#pragma unroll
        for (int j = 0; j < 4; ++j) ss += (v[j][0] * v[j][0] + v[j][1] * v[j][1]) + (v[j][2] * v[j][2] + v[j][3] * v[j][3]);
        const float rstd = 1.0f / sqrtf(wave_sum(ss) * (1.0f / D) + EPS);
        if (mode == 2) {
#pragma unroll
            for (int j = 0; j < 4; ++j) ((f32x4*)((dry ? (float*)(F.ws + WS_WGU) : F.out) + (size_t)row * D))[F.lane + 64 * j] = v[j] * rstd * vA[j];
        } else {
            u32x2* o = (u32x2*)(H + (size_t)row * D) + F.lane;
#pragma unroll
            for (int j = 0; j < 4; ++j) { const f32x4 h = v[j] * rstd * vA[j] + vB[j];
                u32x2 w; w.x = pk2(h[0], h[1]); w.y = pk2(h[2], h[3]); o[64 * j] = w; }
        }
        tw0 = tw1; ti1 = ti2; tw1 = tw2;
    }
#undef ROWA_INFO
#undef ROWA_DATA
}

template <bool DRY> __device__ __forceinline__ void route_row(const Frame& F, int l, int row, const float (&s)[36], unsigned* cnt, int* list) {
    float gl[4];
#pragma unroll
    for (int i = 0; i < 4; ++i) gl[i] = s[i];
    int gt = 0; float gm = gl[0];
#pragma unroll
    for (int i = 1; i < 4; ++i) if (gl[i] > gm) { gm = gl[i]; gt = i; }
    float gs = 0.f;
#pragma unroll
    for (int i = 0; i < 4; ++i) gs += expf(gl[i] - gm);
    const float gwt = 1.0f / gs;
    float el[8];
#pragma unroll
    for (int j = 0; j < 8; ++j) el[j] = gt == 0 ? s[4 + j] : gt == 1 ? s[12 + j] : gt == 2 ? s[20 + j] : s[28 + j];
    int i1 = 0; float v1 = el[0];
#pragma unroll
    for (int j = 1; j < 8; ++j) if (el[j] > v1) { v1 = el[j]; i1 = j; }
    int i2 = -1; float v2 = -3.0e38f;
#pragma unroll
    for (int j = 0; j < 8; ++j) if (j != i1 && el[j] > v2) { v2 = el[j]; i2 = j; }
    const float e2 = expf(v2 - v1); const float w1 = gwt / (1.0f + e2), w2 = gwt * e2 / (1.0f + e2);
    if (!DRY) {
        const int x1 = gt * 8 + i1, x2 = gt * 8 + i2;
        const int r1 = (int)__hip_atomic_fetch_add(cnt + x1 * 16, 1u, __ATOMIC_RELAXED, __HIP_MEMORY_SCOPE_AGENT);
        const int r2 = (int)__hip_atomic_fetch_add(cnt + x2 * 16, 1u, __ATOMIC_RELAXED, __HIP_MEMORY_SCOPE_AGENT);
        list[(size_t)x1 * NTOK + r1] = row; list[(size_t)x2 * NTOK + r2] = row;
        *(int4*)(F.ws + WS_TOKINFO + (size_t)row * 32) = make_int4(x1, r1, x2, r2); *(f32x2*)(F.ws + WS_TOKINFO + (size_t)row * 32 + 16) = (f32x2){w1, w2};
    }
}
template <bool DRY> __device__ __forceinline__ void row_op_b(const Frame& F, int l) {
    const int gw = F.vcu * 8 + F.wave, NGW = F.G * 8;
    const int ngroups = ((l == 0) ? NTOK : NLAT) / 16;
    { const u32x4* img = (const u32x4*)(F.ws + WS_RIMG + (size_t)l * RW_EX);
      u32x4 t[19];
#pragma unroll
      for (int q = 0; q < 19; ++q) { const int i = F.tid + 512 * q; t[q] = img[i < RW_EX / 16 ? i : 0]; }
#pragma unroll
      for (int q = 0; q < 19; ++q) { const int i = F.tid + 512 * q; if (i < RW_EX / 16) *(LAS u32x4*)(F.lds + i * 16) = t[q]; } }
    __syncthreads();
    bf16_t* H = hbuf(F);
    const float* gain = F.in[I_N2G] + l * D;
    unsigned* cnt = (unsigned*)(F.ws + WS_CTL) + CW_CNT + l * NE * 16;
    int* list = (int*)(F.ws + WS_LIST);
    const int fr = F.lane & 15, fq = F.lane >> 4;
    unsigned bo[3];
#pragma unroll
    for (int nt = 0; nt < 3; ++nt) { const int n = 16 * nt + fr; bo[nt] = (unsigned)((n < 36 ? n : 35) * RW_PITCH + fq * 16); }
    LAS float* ex = (LAS float*)(F.lds + RW_EX + F.wave * 1152);
    float rbias[36];
#pragma unroll
    for (int n = 0; n < 36; ++n) rbias[n] = n < 4 ? F.in[I_RGB][l * 4 + n] : F.in[I_REB][l * NE + (n - 4)];
    for (int it = 0;; ++it) {
        const int gi = it == 0 ? gw : NGW + F.vcu + (it - 1) * F.G;
        if (gi >= ngroups || (it > 0 && F.wave != 0)) break;
        const int row = gi * 16 + fr, b = row < NLAT ? (row >> 11) : 16;
        const bf16_t* xr = xb_row(F, row) + fq * 8;
        float ss;
        { const f32x4* sp = (const f32x4*)((const float*)(F.ws + WS_SSQ) + (size_t)row * 16); const f32x4 p0 = sp[0], p1 = sp[1], p2 = sp[2], p3 = sp[3];
          ss = ((p0[0] + p0[1]) + (p0[2] + p0[3])) + ((p1[0] + p1[1]) + (p1[2] + p1[3])) + ((p2[0] + p2[1]) + (p2[2] + p2[3])) + ((p3[0] + p3[1]) + (p3[2] + p3[3])); }
        const float rstd = 1.0f / sqrtf(ss * (1.0f / D) + EPS);
        const float* shp = mod_ptr(F, l, b, 3) + fq * 8; const float* scp = mod_ptr(F, l, b, 4) + fq * 8; const float* gp = gain + fq * 8;
        unsigned char* hp = (unsigned char*)H + (size_t)row * D + fq * 8;
        f32x4 acc[3];
#pragma unroll
        for (int nt = 0; nt < 3; ++nt) acc[nt] = (f32x4){0.f, 0.f, 0.f, 0.f};
#pragma unroll 2
        for (int s = 0; s < 32; ++s) {
            const u32x4 xw = *(const u32x4*)(xr + 32 * s);
            const f32x4 x0 = (f32x4){bflo(xw.x), bfhi(xw.x), bflo(xw.y), bfhi(xw.y)}, x1 = (f32x4){bflo(xw.z), bfhi(xw.z), bflo(xw.w), bfhi(xw.w)};
            const f32x4 g0 = *(const f32x4*)(gp + 32 * s), g1 = *(const f32x4*)(gp + 32 * s + 4);
            const f32x4 c0 = *(const f32x4*)(scp + 32 * s), c1 = *(const f32x4*)(scp + 32 * s + 4);
            const f32x4 s0 = *(const f32x4*)(shp + 32 * s), s1 = *(const f32x4*)(shp + 32 * s + 4);
            const f32x4 h0 = x0 * rstd * g0 * (c0 + 1.0f) + s0, h1 = x1 * rstd * g1 * (c1 + 1.0f) + s1;
            u32x4 hi, lo;
            hi.x = pk2(h0[0], h0[1]); hi.y = pk2(h0[2], h0[3]); hi.z = pk2(h1[0], h1[1]); hi.w = pk2(h1[2], h1[3]);
            lo.x = pk2(h0[0] - bflo(hi.x), h0[1] - bfhi(hi.x)); lo.y = pk2(h0[2] - bflo(hi.y), h0[3] - bfhi(hi.y));
            lo.z = pk2(h1[0] - bflo(hi.z), h1[1] - bfhi(hi.z)); lo.w = pk2(h1[2] - bflo(hi.w), h1[3] - bfhi(hi.w));
            { u32x2 h8; h8.x = pg8::pk4_fp8(h0[0], h0[1], h0[2], h0[3]); h8.y = pg8::pk4_fp8(h1[0], h1[1], h1[2], h1[3]); *(u32x2*)(hp + 32 * s) = h8; }
            const bf16x8 ah = __builtin_bit_cast(bf16x8, hi), al = __builtin_bit_cast(bf16x8, lo);
#pragma unroll
            for (int nt = 0; nt < 3; ++nt) {
                const bf16x8 bh = *(const LAS bf16x8*)(F.lds + bo[nt] + s * 64), bl = *(const LAS bf16x8*)(F.lds + RW_LO + bo[nt] + s * 64);
                acc[nt] = __builtin_amdgcn_mfma_f32_16x16x32_bf16(ah, bh, acc[nt], 0, 0, 0);
                acc[nt] = __builtin_amdgcn_mfma_f32_16x16x32_bf16(ah, bl, acc[nt], 0, 0, 0);
                acc[nt] = __builtin_amdgcn_mfma_f32_16x16x32_bf16(al, bh, acc[nt], 0, 0, 0);
            }
        }
#pragma unroll
        for (int hf = 0; hf < 2; ++hf) {
            if ((fq >> 1) == hf) {
#pragma unroll
                for (int nt = 0; nt < 3; ++nt) { const int n = 16 * nt + fr;
                    if (n < 36) {
#pragma unroll
                        for (int r = 0; r < 4; ++r) ex[((fq & 1) * 4 + r) * 36 + n] = acc[nt][r]; } }
            }
            asm volatile("s_waitcnt lgkmcnt(0)" ::: "memory");
            if (F.lane < 8) { float sl[36];
#pragma unroll
                for (int n = 0; n < 36; ++n) sl[n] = ex[F.lane * 36 + n] + rbias[n];
                route_row<DRY>(F, l, gi * 16 + hf * 8 + F.lane, sl, cnt, list); }
            asm volatile("s_waitcnt lgkmcnt(0)" ::: "memory");
        }
    }
    __syncthreads();
}

__device__ __forceinline__ unsigned off_b(unsigned row, unsigned ch) { return 256u * row + 16u * (ch ^ (((row & 3) << 2) | ((row >> 2) & 3))); }
__device__ __forceinline__ unsigned tr_base_p(unsigned lane) { const unsigned g = lane >> 4, q = (lane & 15) >> 2, p = lane & 3; return off_b(4 * g + q, (p >> 1)) + 8 * (p & 1); }
template <int O0, int O1, int O2, int O3>
__device__ __forceinline__ void tr_frag4(bf16x8 (&f)[4], unsigned a0, unsigned a1, unsigned a2, unsigned a3) {
    s16x4 l0, h0, l1, h1, l2, h2, l3, h3;
    asm volatile("ds_read_b64_tr_b16 %0, %8 offset:%12\n\tds_read_b64_tr_b16 %1, %8 offset:%16\n\t"
                 "ds_read_b64_tr_b16 %2, %9 offset:%13\n\tds_read_b64_tr_b16 %3, %9 offset:%17\n\t"
                 "ds_read_b64_tr_b16 %4, %10 offset:%14\n\tds_read_b64_tr_b16 %5, %10 offset:%18\n\t"
                 "ds_read_b64_tr_b16 %6, %11 offset:%15\n\tds_read_b64_tr_b16 %7, %11 offset:%19\n\ts_waitcnt lgkmcnt(0)"
                 : "=&v"(l0), "=&v"(h0), "=&v"(l1), "=&v"(h1), "=&v"(l2), "=&v"(h2), "=&v"(l3), "=&v"(h3)
                 : "v"(a0), "v"(a1), "v"(a2), "v"(a3), "n"(O0), "n"(O1), "n"(O2), "n"(O3), "n"(O0 + 4096), "n"(O1 + 4096), "n"(O2 + 4096), "n"(O3 + 4096) : "memory");
    f[0] = __builtin_shufflevector(l0, h0, 0, 1, 2, 3, 4, 5, 6, 7); f[1] = __builtin_shufflevector(l1, h1, 0, 1, 2, 3, 4, 5, 6, 7);
    f[2] = __builtin_shufflevector(l2, h2, 0, 1, 2, 3, 4, 5, 6, 7); f[3] = __builtin_shufflevector(l3, h3, 0, 1, 2, 3, 4, 5, 6, 7);
}
template <int O>
__device__ __forceinline__ void tr_frag8(bf16x8 (&f)[8], unsigned a) {
    s16x4 l0, h0, l1, h1, l2, h2, l3, h3, l4, h4, l5, h5, l6, h6, l7, h7;
    const unsigned a1 = a ^ 32u, a2 = a ^ 64u, a3 = a ^ 96u, a4 = a ^ 128u, a5 = a ^ 160u, a6 = a ^ 192u, a7 = a ^ 224u;
    asm volatile("ds_read_b64_tr_b16 %0, %8 offset:%12\n\tds_read_b64_tr_b16 %1, %8 offset:%13\n\t"
                 "ds_read_b64_tr_b16 %2, %9 offset:%12\n\tds_read_b64_tr_b16 %3, %9 offset:%13\n\t"
                 "ds_read_b64_tr_b16 %4, %10 offset:%12\n\tds_read_b64_tr_b16 %5, %10 offset:%13\n\t"
                 "ds_read_b64_tr_b16 %6, %11 offset:%12\n\tds_read_b64_tr_b16 %7, %11 offset:%13"
                 : "=&v"(l0), "=&v"(h0), "=&v"(l1), "=&v"(h1), "=&v"(l2), "=&v"(h2), "=&v"(l3), "=&v"(h3)
                 : "v"(a), "v"(a1), "v"(a2), "v"(a3), "n"(O), "n"(O + 4096) : "memory");
    asm volatile("ds_read_b64_tr_b16 %0, %16 offset:%20\n\tds_read_b64_tr_b16 %1, %16 offset:%21\n\t"
                 "ds_read_b64_tr_b16 %2, %17 offset:%20\n\tds_read_b64_tr_b16 %3, %17 offset:%21\n\t"
                 "ds_read_b64_tr_b16 %4, %18 offset:%20\n\tds_read_b64_tr_b16 %5, %18 offset:%21\n\t"
                 "ds_read_b64_tr_b16 %6, %19 offset:%20\n\tds_read_b64_tr_b16 %7, %19 offset:%21\n\ts_waitcnt lgkmcnt(0)"
                 : "=&v"(l4), "=&v"(h4), "=&v"(l5), "=&v"(h5), "=&v"(l6), "=&v"(h6), "=&v"(l7), "=&v"(h7),
                   "+v"(l0), "+v"(h0), "+v"(l1), "+v"(h1), "+v"(l2), "+v"(h2), "+v"(l3), "+v"(h3)
                 : "v"(a4), "v"(a5), "v"(a6), "v"(a7), "n"(O), "n"(O + 4096) : "memory");
    f[0] = __builtin_shufflevector(l0, h0, 0, 1, 2, 3, 4, 5, 6, 7); f[1] = __builtin_shufflevector(l1, h1, 0, 1, 2, 3, 4, 5, 6, 7);
    f[2] = __builtin_shufflevector(l2, h2, 0, 1, 2, 3, 4, 5, 6, 7); f[3] = __builtin_shufflevector(l3, h3, 0, 1, 2, 3, 4, 5, 6, 7);
    f[4] = __builtin_shufflevector(l4, h4, 0, 1, 2, 3, 4, 5, 6, 7); f[5] = __builtin_shufflevector(l5, h5, 0, 1, 2, 3, 4, 5, 6, 7);
    f[6] = __builtin_shufflevector(l6, h6, 0, 1, 2, 3, 4, 5, 6, 7); f[7] = __builtin_shufflevector(l7, h7, 0, 1, 2, 3, 4, 5, 6, 7);
}
#define LBAR() do { asm volatile("s_waitcnt lgkmcnt(0)" ::: "memory"); __builtin_amdgcn_s_barrier(); asm volatile("" ::: "memory"); } while (0)
__device__ __forceinline__ int chunk_row0(int b, int ci) { return ci < 2 ? NLAT + b * CT + ci * 128 : b * TL + (ci - 2) * 128; }
__device__ __forceinline__ float log2_gamma(float decay) { return -log1pf(expf(-decay)) * 1.4426950408889634f; }

template <int HALF>
__device__ __forceinline__ void pool_item(const LAS unsigned char* tile, bf16_t* A2, int t0, int T, int rbase, int rl, int cg) {
    const int t = t0 + rl; int cnt = 0;
    float s[8];
#pragma unroll
    for (int i = 0; i < 8; ++i) s[i] = 0.f;
    u32x4 c = (u32x4){0u, 0u, 0u, 0u};
#pragma unroll
    for (int w = 0; w < 2 * HALF; ++w) { const int tt = t - HALF + w; const bool ok = tt >= 0 && tt < T;
        u32x4 x = *(const LAS u32x4*)(tile + (rl + 8 - HALF + w) * 1024 + cg * 16); if (!ok) x = (u32x4){0u, 0u, 0u, 0u}; cnt += ok ? 1 : 0; if (w == HALF) c = x;
        s[0] += bflo(x.x); s[1] += bfhi(x.x); s[2] += bflo(x.y); s[3] += bfhi(x.y); s[4] += bflo(x.z); s[5] += bfhi(x.z); s[6] += bflo(x.w); s[7] += bfhi(x.w); }
    const float inv = 1.0f / (float)cnt;
    u32x4 o; o.x = pk2(s[0] * inv - bflo(c.x), s[1] * inv - bfhi(c.x)); o.y = pk2(s[2] * inv - bflo(c.y), s[3] * inv - bfhi(c.y));
    o.z = pk2(s[4] * inv - bflo(c.z), s[5] * inv - bfhi(c.z)); o.w = pk2(s[6] * inv - bflo(c.w), s[7] * inv - bfhi(c.w));
    *(u32x4*)(A2 + (size_t)(rbase + t) * D + 512 + cg * 8) = o;
}

__device__ __forceinline__ void p3a_states_pool(const Frame& F, int l) {
    const bf16_t* P = (const bf16_t*)(F.ws + WS_P);
    bf16_t* ST = (bf16_t*)(F.ws + WS_ACT);
    bf16_t* A2 = hbuf(F);
    const int nstate = (F.G > 128) ? 128 : F.G;
    if (F.bx < nstate) {
        for (int unit = F.bx; unit < 128; unit += nstate) {
            const int dir = unit & 1, bh = unit >> 1, b = bh >> 2, h = bh & 3;
            const float lg2 = log2_gamma((dir ? F.in[I_DB] : F.in[I_DF])[l * NH + h]);
            const float gC = exp2f(lg2 * 128.0f);
            f32x4 acc[8];
#pragma unroll
            for (int dt = 0; dt < 8; ++dt) acc[dt] = (f32x4){0.f, 0.f, 0.f, 0.f};
            u32x4 kr[8], vr[8];
#define P3A_CI(n_) (dir ? ((n_) < 2 ? 1 - (n_) : 19 - (n_)) : (n_))
#define P3A_LOAD(st_) do { _Pragma("unroll") for (int sub = 0; sub < 2; ++sub) { const int r0_ = chunk_row0(b, P3A_CI(2 * (st_) + sub)); \
                _Pragma("unroll") for (int q = 0; q < 4; ++q) { const int p = F.tid + 512 * q, j = p >> 4, ch = p & 15; \
                    kr[sub * 4 + q] = *(const u32x4*)(P + (size_t)(r0_ + j) * NP + 512 + h * 128 + ch * 8); vr[sub * 4 + q] = *(const u32x4*)(P + (size_t)(r0_ + j) * NP + 1024 + h * 128 + ch * 8); } } } while (0)
#define P3A_STORE(n_) do { bf16_t* sp = ST + ((size_t)((bh * 2 + dir) * NCHUNK + P3A_CI(n_)) * 128 + (F.wave * 16 + (F.lane & 15))) * 128 + 4 * (F.lane >> 4); \
                _Pragma("unroll") for (int dt = 0; dt < 8; ++dt) { u32x2 w; w.x = pk2(acc[dt][0], acc[dt][1]); w.y = pk2(acc[dt][2], acc[dt][3]); *(u32x2*)(sp + dt * 16) = w; } } while (0)
#define P3A_KS(KO, VO, ks) do { bf16x8 ka[8]; tr_frag8<(KO) + (ks) * 8192>(ka, tpk); \
                _Pragma("unroll") for (int dt = 0; dt < 8; ++dt) acc[dt] = __builtin_amdgcn_mfma_f32_16x16x32_bf16(ka[dt], vb[ks], acc[dt], 0, 0, 0); } while (0)
#define P3A_SUB(KO, VO) do { _Pragma("unroll") for (int dt = 0; dt < 8; ++dt) acc[dt] *= gC; \
                bf16x8 vb[4]; tr_frag4<(VO), (VO) + 8192, (VO) + 16384, (VO) + 24576>(vb, tpv, tpv, tpv, tpv); \
                P3A_KS(KO, VO, 0); P3A_KS(KO, VO, 1); P3A_KS(KO, VO, 2); P3A_KS(KO, VO, 3); } while (0)
            P3A_LOAD(0);
            for (int st = 0; st < 9; ++st) {
#pragma unroll
                for (int sub = 0; sub < 2; ++sub)
#pragma unroll
                    for (int q = 0; q < 4; ++q) { const int p = F.tid + 512 * q, j = p >> 4, ch = p & 15;
                        const float kd = __builtin_amdgcn_exp2f(lg2 * (float)(dir ? j : 127 - j));
                        const u32x4 kk = kr[sub * 4 + q];
                        u32x4 ks; ks.x = pk2(bflo(kk.x) * kd, bfhi(kk.x) * kd); ks.y = pk2(bflo(kk.y) * kd, bfhi(kk.y) * kd); ks.z = pk2(bflo(kk.z) * kd, bfhi(kk.z) * kd); ks.w = pk2(bflo(kk.w) * kd, bfhi(kk.w) * kd);
                        *(LAS u32x4*)(F.lds + sub * 32768 + off_b(j, ch)) = ks; *(LAS u32x4*)(F.lds + 65536 + sub * 32768 + off_b(j, ch)) = vr[sub * 4 + q]; }
                LBAR();
                if (st < 8) P3A_LOAD(st + 1);
                const unsigned tpk = (unsigned)(size_t)F.lds + tr_base_p(F.lane); const unsigned tpv = (tpk ^ ((unsigned)F.wave << 5)) + 65536u;
                P3A_STORE(2 * st);
                P3A_SUB(0, 0);
                P3A_STORE(2 * st + 1);
                if (st < 8) P3A_SUB(32768, 32768);
                LBAR();
            }
#undef P3A_SUB
#undef P3A_KS
#undef P3A_STORE
#undef P3A_LOAD
#undef P3A_CI
        }
    } else {
        const int pb = F.bx - nstate, npb = F.G - nstate;
        u32x4 ld[10];
#define POOL_LOAD(tile_) do { const int r0_ = (tile_) * 64; int t0_, T_, rb_; if (r0_ < NLAT) { t0_ = r0_ & (TL - 1); T_ = TL; } else { t0_ = (r0_ - NLAT) & (CT - 1); T_ = CT; } rb_ = r0_ - t0_; \
            _Pragma("unroll") for (int q = 0; q < 10; ++q) { const int p = F.tid + 512 * q, rr = p >> 6, ch = p & 63; int tt = t0_ - 8 + rr; tt = tt < 0 ? 0 : (tt >= T_ ? T_ - 1 : tt); \
                ld[q] = *(const u32x4*)(P + (size_t)(rb_ + tt) * NP + 2048 + ch * 8); } } while (0)
        if (pb < 576) POOL_LOAD(pb);
        for (int tile = pb; tile < 576; tile += npb) {
            const int r0 = tile * 64; int t0, T; if (r0 < NLAT) { t0 = r0 & (TL - 1); T = TL; } else { t0 = (r0 - NLAT) & (CT - 1); T = CT; } const int rbase = r0 - t0;
            LBAR();
#pragma unroll
            for (int q = 0; q < 10; ++q) { const int p = F.tid + 512 * q; *(LAS u32x4*)(F.lds + (p >> 6) * 1024 + (p & 63) * 16) = ld[q]; }
            LBAR();
            if (tile + npb < 576) POOL_LOAD(tile + npb);
            for (int wi = F.wave; wi < 64; wi += 8) { const int g = wi & 3, rl = (wi >> 2) * 4 + (F.lane >> 4), cg = g * 16 + (F.lane & 15);
                if (g == 0) pool_item<1>(F.lds, A2, t0, T, rbase, rl, cg); else if (g == 1) pool_item<2>(F.lds, A2, t0, T, rbase, rl, cg);
                else if (g == 2) pool_item<4>(F.lds, A2, t0, T, rbase, rl, cg); else pool_item<8>(F.lds, A2, t0, T, rbase, rl, cg); }
        }
#undef POOL_LOAD
    }
    __syncthreads();
}

__device__ __forceinline__ void p3b_retention(const Frame& F, int l) {
    const bf16_t* P = (const bf16_t*)(F.ws + WS_P);
    const bf16_t* ST = (const bf16_t*)(F.ws + WS_ACT);
    bf16_t* A2 = hbuf(F);
    const int c_lo = (l == DEPTH - 1) ? 2 : 0, ncu = NCHUNK - c_lo, nunits = 64 * ncu;
    float lgF[NH], lgB[NH];
#pragma unroll
    for (int hh = 0; hh < NH; ++hh) { lgF[hh] = log2_gamma(F.in[I_DF][l * NH + hh]); lgB[hh] = log2_gamma(F.in[I_DB][l * NH + hh]); }
    u32x4 ld[8], st[8]; bf16x8 qf[4];
#define P3B_LOAD(unit_) do { const int bh_ = (unit_) / ncu, ci_ = c_lo + (unit_) % ncu, h_ = bh_ & 3; const int r0_ = chunk_row0(bh_ >> 2, ci_); \
        _Pragma("unroll") for (int q = 0; q < 4; ++q) { const int p = F.tid + 512 * q, j = p >> 4, ch = p & 15; \
            ld[q] = *(const u32x4*)(P + (size_t)(r0_ + j) * NP + 512 + h_ * 128 + ch * 8); ld[4 + q] = *(const u32x4*)(P + (size_t)(r0_ + j) * NP + 1024 + h_ * 128 + ch * 8); } } while (0)
#define P3B_LOADQ(unit_) do { const int bh_ = (unit_) / ncu, ci_ = c_lo + (unit_) % ncu, h_ = bh_ & 3; const int r0_ = chunk_row0(bh_ >> 2, ci_); \
        _Pragma("unroll") for (int ks = 0; ks < 4; ++ks) qf[ks] = *(const bf16x8*)(P + (size_t)(r0_ + F.wave * 16 + (F.lane & 15)) * NP + h_ * 128 + ks * 32 + (F.lane >> 4) * 8); } while (0)
    if (F.vcu < nunits) { P3B_LOAD(F.vcu); P3B_LOADQ(F.vcu); }
    for (int unit = F.vcu; unit < nunits; unit += F.G) {
        int lane_o = F.lane; asm volatile("" : "+v"(lane_o));
        const int fr = lane_o & 15, fq = lane_o >> 4;
        const unsigned rr0 = off_b((unsigned)fr, (unsigned)fq), tp = (unsigned)(size_t)F.lds + tr_base_p((unsigned)lane_o);
        const int il = F.wave * 16 + fr;
        const int bh = unit / ncu, ci = c_lo + unit % ncu, b = bh >> 2, h = bh & 3;
        const float lgf = h == 0 ? lgF[0] : h == 1 ? lgF[1] : h == 2 ? lgF[2] : lgF[3], lgb = h == 0 ? lgB[0] : h == 1 ? lgB[1] : h == 2 ? lgB[2] : lgB[3];
        const int row0 = chunk_row0(b, ci);
        { const bf16_t* sf = ST + ((size_t)((bh * 2 + 0) * NCHUNK + ci) * 128) * 128; const bf16_t* sb = ST + ((size_t)((bh * 2 + 1) * NCHUNK + ci) * 128) * 128;
#pragma unroll
          for (int q = 0; q < 4; ++q) { const int p = F.tid + 512 * q, j = p >> 4, ch = p & 15; st[q] = *(const u32x4*)(sf + (size_t)j * 128 + ch * 8); st[4 + q] = *(const u32x4*)(sb + (size_t)j * 128 + ch * 8); } }
        LBAR();
#pragma unroll
        for (int q = 0; q < 4; ++q) { const int p = F.tid + 512 * q, j = p >> 4, ch = p & 15; const unsigned o = off_b(j, ch);
            *(LAS u32x4*)(F.lds + o) = ld[q]; *(LAS u32x4*)(F.lds + 32768u + o) = ld[4 + q]; }
        LBAR();
        if (unit + F.G < nunits) P3B_LOAD(unit + F.G);
        u32x2 gg[8];
#pragma unroll
        for (int et = 0; et < 8; ++et) gg[et] = *(const u32x2*)(P + (size_t)(row0 + il) * NP + 1536 + h * 128 + 4 * fq + et * 16);
        bf16x8 pf[4];
#pragma unroll
        for (int ks2 = 0; ks2 < 4; ++ks2) {
            u32x2 half[2];
#pragma unroll
            for (int t = 0; t < 2; ++t) { const int jt = 2 * ks2 + t;
                asm volatile("" ::: "memory");
                f32x4 sa = (f32x4){0.f, 0.f, 0.f, 0.f};
#pragma unroll
                for (int ks = 0; ks < 4; ++ks) { const bf16x8 ka = *(const LAS bf16x8*)(F.lds + ((rr0 ^ ((unsigned)ks << 6)) + 4096u * jt)); sa = __builtin_amdgcn_mfma_f32_16x16x32_bf16(ka, qf[ks], sa, 0, 0, 0); }
                float pv[4];
#pragma unroll
                for (int r = 0; r < 4; ++r) { const int j = 16 * jt + 4 * fq + r, df = il - j;
                    const float w = df > 0 ? __builtin_amdgcn_exp2f(lgf * (float)df) : (df < 0 ? __builtin_amdgcn_exp2f(lgb * (float)(-df)) : 2.0f); pv[r] = sa[r] * w; }
                half[t].x = pk2(pv[0], pv[1]); half[t].y = pk2(pv[2], pv[3]); }
            const u32x4 w4 = (u32x4){half[0].x, half[0].y, half[1].x, half[1].y};
            pf[ks2] = __builtin_bit_cast(bf16x8, w4);
        }
#pragma unroll
        for (int q = 0; q < 4; ++q) { const int p = F.tid + 512 * q, j = p >> 4, ch = p & 15; const unsigned o = off_b(j, ch);
            *(LAS u32x4*)(F.lds + 65536u + o) = st[q]; *(LAS u32x4*)(F.lds + 98304u + o) = st[4 + q]; }
        LBAR();
        const float qdf = __builtin_amdgcn_exp2f(lgf * (float)(il + 1)), qdb = __builtin_amdgcn_exp2f(lgb * (float)(128 - il));
        float o[8][4]; float ss = 0.f;
#pragma unroll
        for (int et = 0; et < 8; ++et) {
            f32x4 ao = (f32x4){0.f, 0.f, 0.f, 0.f}, af = ao, ab = ao;
            bf16x8 va[4]; { const unsigned a = tp ^ ((unsigned)et << 5); tr_frag4<32768, 32768 + 8192, 32768 + 16384, 32768 + 24576>(va, a, a, a, a); }
#pragma unroll
            for (int ks = 0; ks < 4; ++ks) {
                ao = __builtin_amdgcn_mfma_f32_16x16x32_bf16(va[ks], pf[ks], ao, 0, 0, 0);
                const unsigned ra = (rr0 ^ ((unsigned)ks << 6)) + 4096u * et;
                const bf16x8 fa = *(const LAS bf16x8*)(F.lds + 65536u + ra);
                af = __builtin_amdgcn_mfma_f32_16x16x32_bf16(fa, qf[ks], af, 0, 0, 0);
                const bf16x8 ba = *(const LAS bf16x8*)(F.lds + 98304u + ra);
                ab = __builtin_amdgcn_mfma_f32_16x16x32_bf16(ba, qf[ks], ab, 0, 0, 0);
            }
#pragma unroll
            for (int r = 0; r < 4; ++r) { o[et][r] = ao[r] + qdf * af[r] + qdb * ab[r]; ss += o[et][r] * o[et][r]; }
        }
        if (unit + F.G < nunits) P3B_LOADQ(unit + F.G);
        ss += __shfl_xor(ss, 16); ss += __shfl_xor(ss, 32);
        const float rstd = 1.0f / sqrtf(ss * (1.0f / 128.0f) + EPS);
        bf16_t* op = A2 + (size_t)(row0 + il) * D + h * 128 + 4 * fq;
#pragma unroll
        for (int et = 0; et < 8; ++et) { const u32x2 g = gg[et];
            u32x2 w; w.x = pk2(silu_f(bflo(g.x)) * o[et][0] * rstd, silu_f(bfhi(g.x)) * o[et][1] * rstd); w.y = pk2(silu_f(bflo(g.y)) * o[et][2] * rstd, silu_f(bfhi(g.y)) * o[et][3] * rstd);
            *(u32x2*)(op + et * 16) = w; }
    }
#undef P3B_LOAD
#undef P3B_LOADQ
    __syncthreads();
}

#ifndef TYPE_MASK
#define TYPE_MASK 0x3ff
#endif
#define PTYPE(k) ((k) == 0 ? 0 : ((k) == 17 ? 9 : 1 + (((k) - 1) & 7)))
#define ENTER() do { if (PROBE_REPEAT >= 0) __syncthreads(); int _t = threadIdx.x; asm volatile("" : "+v"(_t)); F.tid = _t; F.lane = _t & 63; F.wave = __builtin_amdgcn_readfirstlane(_t >> 6); } while (0)
#define IN(k) (((TYPE_MASK >> PTYPE(k)) & 1) && lo <= (k) && (k) < hi)
#define SEAM(k) do { if (IN(k) && IN((k) + 1)) xcd_barrier(bar); } while (0)
#define REP(t) for (int rep = (PROBE_REPEAT == (t)) ? 0 : 1; rep < 2; ++rep)


template <int l> __device__ __forceinline__ void layer_phases(Frame& F, const XcdBarrier& bar, const int lo, const int hi) {
        const int pb = 1 + 8 * l;
        const bool last = (l == DEPTH - 1);
        const int Mrows = last ? NLAT : NTOK;
        if (IN(pb + 0)) REP(1) { ENTER(); row_op_a(F, l == 0 ? 0 : 1, rep == 0); }
        SEAM(pb + 0);
        if (IN(pb + 1)) REP(2) { ENTER();
            pg8::SchedDense S; S.init(NTOK, NP, D, F.G, F.bx);
            pg8::EpiInProj E{(bf16_t*)(F.ws + WS_P), (const float*)(F.ws + WS_ROPE), (const float*)(F.ws + WS_ROPE) + 96 * 32};
            pg8::gemm_phase<pg8::EpiInProj, pg8::SchedDense, true, true>(F.lds, F.tid, (const char*)hbuf(F), (const char*)(F.ws + WS_WIN) + (size_t)l * NP * D * 2, D, S, E);
        }
        SEAM(pb + 1);
        if (IN(pb + 2)) REP(3) { ENTER(); p3a_states_pool(F, l); }
        SEAM(pb + 2);
        if (IN(pb + 3)) REP(4) { ENTER(); p3b_retention(F, l); }
        SEAM(pb + 3);
        if (IN(pb + 4)) REP(5) { ENTER();
            pg8::SchedDense S; S.init(Mrows, D, D, F.G, F.bx);
            pg8::EpiResid E;
            if (l == 0) { E.rl = F.in[I_X]; E.rc = F.in[I_CTX]; E.rb = nullptr; } else { E.rl = nullptr; E.rc = nullptr; E.rb = (const bf16_t*)(F.ws + WS_XB); }
            E.ob = (rep == 0) ? (bf16_t*)(F.ws + WS_P) : (bf16_t*)(F.ws + WS_XB); E.ssq = (float*)(F.ws + WS_SSQ); E.gmod = mod_ptr(F, l, 0, 2);
            pg8::gemm_phase<pg8::EpiResid, pg8::SchedDense, true, true>(F.lds, F.tid, (const char*)hbuf(F), (const char*)(F.ws + WS_WOUT) + (size_t)l * D * D * 2, D, S, E);
        }
        SEAM(pb + 4);
        if (IN(pb + 5)) REP(6) { ENTER(); if (PROBE_REPEAT == 6 && rep == 0) row_op_b<true>(F, l); else row_op_b<false>(F, l); }
        SEAM(pb + 5);
        if (IN(pb + 6)) REP(7) { ENTER();
            LAS int* tb = build_tb(F, l);
            LAS int* tokt = (LAS int*)(F.lds + TOKT_OFF);
            const int* list = (const int*)(F.ws + WS_LIST);
            pg8::SchedGroup S; S.tb = tb; S.tokt = tokt; S.G = F.G; S.c = F.vcu; S.pitch = D; S.gather = 1;
            { int tokv[8];
#pragma unroll
              for (int i = 0; i < 8; ++i) { pg8::Unit u; tokv[i] = -1;
                  if (S.next(i, u)) { const int g = u.pm; const int e = (int)__popcll(__ballot(F.lane < NE && tb[F.lane + 1] <= g)); const int rt = g - tb[e], cnt = tb[64 + e];
                      if (F.tid < 256) { int r = rt * 256 + F.tid; if (r >= cnt) r = cnt - 1; tokv[i] = list[(size_t)e * NTOK + r]; } } }
#pragma unroll
              for (int i = 0; i < 8; ++i) if (F.tid < 256 && tokv[i] >= 0) tokt[i * 256 + F.tid] = tokv[i]; }
            __syncthreads();
            pg8::EpiSwiGLU8 E{(unsigned char*)(F.ws + WS_ACT), 1.0f / WGU_SCALE};
            pg8::gemm_phase<pg8::EpiSwiGLU8, pg8::SchedGroup, true, true, true>(F.lds, F.tid, (const char*)hbuf(F), (const char*)(F.ws + WS_WGU) + (size_t)l * NE * 1024 * D, D, S, E);
        }
        SEAM(pb + 6);
        if (IN(pb + 7)) REP(8) { ENTER();
            LAS int* tb = build_tb(F, l);
            pg8::SchedGroup S; S.tb = tb; S.tokt = nullptr; S.G = F.G; S.c = F.vcu; S.pitch = FF; S.gather = 0;
            pg8::EpiFp8S E{(unsigned char*)(F.ws + WS_P), D, 1.0f / WD_SCALE};
            pg8::gemm_phase<pg8::EpiFp8S, pg8::SchedGroup, true, true, true>(F.lds, F.tid, (const char*)(F.ws + WS_ACT), (const char*)(F.ws + WS_WD) + (size_t)l * NE * D * FF, FF, S, E);
        }
        SEAM(pb + 7);
}

__global__ void __launch_bounds__(512, 2) fwd_kernel(Args args) {
    extern __shared__ __attribute__((aligned(16))) unsigned char lds_raw[];
    Frame F;
    F.lds = (LAS unsigned char*)lds_raw; F.tid = threadIdx.x; F.lane = F.tid & 63; F.wave = __builtin_amdgcn_readfirstlane(F.tid >> 6);
    F.G = gridDim.x; F.bx = blockIdx.x; F.vcu = (F.G % 8 == 0) ? (F.bx % 8) * (F.G / 8) + F.bx / 8 : F.bx;
    F.in = args.in; F.out = args.out; F.ws = args.ws;
    volatile LAS unsigned* MISC = (volatile LAS unsigned*)(F.lds + MISC_OFF);
    if (F.tid < 4) MISC[F.tid] = 0u;
    __syncthreads();
    unsigned* ctl = (unsigned*)(F.ws + WS_CTL);
    XcdBarrier bar; bar.bar = ctl + CW_BAR; bar.x = 0; bar.st = nullptr;
    const int lo = args.ph_lo, hi = args.ph_hi;
    const bool multi = (hi - lo) > 1;
    if (multi) bar = xcd_barrier_post(ctl + CW_BAR, MISC);
    if (IN(0)) REP(0) { ENTER(); p0_prologue(F, rep); }
    SEAM(0);
    layer_phases<0>(F, bar, lo, hi);
    layer_phases<1>(F, bar, lo, hi);
    if (IN(17)) REP(9) { ENTER(); row_op_a(F, 2, rep == 0); }
#undef IN
#undef SEAM
}

extern "C" void kernel_launch(void* const* d_in, const int* in_sizes, int n_in, void* d_out, int out_size, void* d_ws, size_t ws_size, hipStream_t stream) {
    static int grid = 0;
    if (grid == 0) {
        if (n_in != 22 || out_size != NLAT * D || ws_size < WS_END) { fprintf(stderr, "kernel_launch: unexpected shapes (n_in %d, out %d, ws %zu)\n", n_in, out_size, ws_size); grid = -1; return; }
        int dev = 0, cus = 0, per_cu = 0;
        if (hipGetDevice(&dev) != hipSuccess || hipDeviceGetAttribute(&cus, hipDeviceAttributeMultiprocessorCount, dev) != hipSuccess) { grid = -1; return; }
        if (hipFuncSetAttribute((const void*)fwd_kernel, hipFuncAttributeMaxDynamicSharedMemorySize, LDS_BYTES) != hipSuccess) { fprintf(stderr, "kernel_launch: hipFuncSetAttribute failed\n"); grid = -1; return; }
        if (hipOccupancyMaxActiveBlocksPerMultiprocessor(&per_cu, (const void*)fwd_kernel, 512, LDS_BYTES) != hipSuccess || per_cu < 1) { fprintf(stderr, "kernel_launch: occupancy query says %d\n", per_cu); }
        (void)hipGetLastError();
        grid = cus;
    }
    if (grid < 0) return;
    (void)hipMemsetAsync((char*)d_ws + WS_CTL, 0, CTL_ZERO_BYTES, stream);
    Args a{};
    for (int i = 0; i < 22; ++i) a.in[i] = (const float*)d_in[i];
    a.out = (float*)d_out; a.ws = (unsigned char*)d_ws;
    if (MK_N_LAUNCHES == 1) { a.ph_lo = 0; a.ph_hi = N_PHASES; hipLaunchKernelGGL(fwd_kernel, dim3(grid), dim3(512), LDS_BYTES, stream, a); }
    else { for (int p = 0; p < N_PHASES; ++p) { a.ph_lo = p; a.ph_hi = p + 1; hipLaunchKernelGGL(fwd_kernel, dim3(grid), dim3(512), LDS_BYTES, stream, a); } }
}
```

```cpp
#include <hip/hip_runtime.h>
#include <cstdio>
#include <cstdint>

#ifndef MK_N_LAUNCHES
#define MK_N_LAUNCHES 1
#endif

#ifndef PROBE_REPEAT
#define PROBE_REPEAT -1
#endif
#define LAS __attribute__((address_space(3)))
#define GAS __attribute__((address_space(1)))
typedef unsigned short bf16_t;
typedef short bf16x8 __attribute__((ext_vector_type(8)));
typedef short s16x4 __attribute__((ext_vector_type(4)));
typedef float f32x4 __attribute__((ext_vector_type(4)));
typedef float f32x2 __attribute__((ext_vector_type(2)));
typedef unsigned u32x4 __attribute__((ext_vector_type(4)));
typedef unsigned u32x2 __attribute__((ext_vector_type(2)));

constexpr int Bn = 16, TL = 2048, CT = 256, D = 1024, DEPTH = 2;
constexpr int NLAT = Bn * TL, NCTX = Bn * CT, NTOK = NLAT + NCTX;
constexpr int NP = 2560;
constexpr int NE = 32, FF = 512, NH = 4, HD = 128;
constexpr int NCHUNK = 18;
constexpr float EPS = 1e-6f;
constexpr int MAXTILES = 320;
constexpr int N_PHASES = 18;

constexpr size_t MiB = 1u << 20;
constexpr size_t WS_CTL = 0, CTL_ZERO_BYTES = 1 * MiB;
constexpr size_t WS_MOD = 1 * MiB;
constexpr size_t WS_ROPE = 2 * MiB;
constexpr size_t WS_RIMG = 2 * MiB + 65536;
constexpr size_t WS_TOKINFO = 3 * MiB;
constexpr size_t WS_LIST = 5 * MiB;
constexpr size_t WS_WIN = 10 * MiB;
constexpr size_t WS_WOUT = 20 * MiB;
constexpr size_t WS_WGU = 24 * MiB;
constexpr size_t WS_WD = 152 * MiB;
constexpr size_t WS_SSQ = 216 * MiB;
constexpr size_t WS_XB = 232 * MiB;
constexpr size_t WS_P = 304 * MiB;
constexpr size_t WS_ACT = 484 * MiB;
constexpr size_t WS_END = 564 * MiB;
constexpr int CW_TMO = 0;
constexpr int CW_QUEUE = 512;
constexpr int CW_CNT = 1024;
constexpr int CW_BAR = 4096;

constexpr int RING_BYTES = 131072;
constexpr int TOKT_OFF = RING_BYTES;
constexpr int MISC_OFF = 161792;
constexpr int RW_PITCH = 2064;
constexpr int RW_LO = 36 * RW_PITCH, RW_EX = 2 * 36 * RW_PITCH;
constexpr int LDS_BYTES = 163840;

__device__ __forceinline__ unsigned f2bf(float f) { unsigned u = __builtin_bit_cast(unsigned, f); return (u + 0x7fffu + ((u >> 16) & 1u)) >> 16; }
typedef __bf16 bf16x2_t __attribute__((ext_vector_type(2)));
__device__ __forceinline__ unsigned pk2(float lo, float hi) { const f32x2 f = {lo, hi}; const bf16x2_t v = __builtin_convertvector(f, bf16x2_t); return __builtin_bit_cast(unsigned, v); }
__device__ __forceinline__ float bflo(unsigned w) { return __builtin_bit_cast(float, w << 16); }
__device__ __forceinline__ float bfhi(unsigned w) { return __builtin_bit_cast(float, w & 0xffff0000u); }
__device__ __forceinline__ float wave_sum(float v) {
#pragma unroll
    for (int o = 1; o < 64; o <<= 1) v += __shfl_xor(v, o);
    return v;
}
__device__ __forceinline__ float silu_f(float x) { return x * __builtin_amdgcn_rcpf(1.0f + __builtin_amdgcn_exp2f(-1.4426950408889634f * x)); }

#define XB_TMO      128
#define XB_XCNT(j)  (256  + 64 * (j))
#define XB_XSUB(j)  (1280 + 64 * (j))
#define XB_XGEN(j)  (2304 + 64 * (j))
#define XB_TOP      3328
#define XB_TOPGEN   3392
#define XCD_BAR_WORDS 3456
#define XB_SPIN_CAP (1u << 18)
__device__ __forceinline__ unsigned xb_ld(unsigned* p)              { return __hip_atomic_load(p, __ATOMIC_RELAXED, __HIP_MEMORY_SCOPE_AGENT); }
__device__ __forceinline__ unsigned xb_add(unsigned* p, unsigned v) { return __hip_atomic_fetch_add(p, v, __ATOMIC_RELAXED, __HIP_MEMORY_SCOPE_AGENT); }
__device__ __forceinline__ unsigned xb_xcc_id() { return (unsigned)__builtin_amdgcn_s_getreg((3 << 11) | 20) & 0xFu; }
#define XB_SPIN(cond, bar) do { unsigned _sp = 0; while (cond) { __builtin_amdgcn_s_sleep(1); \
    if ((++_sp & 255u) == 0u) { if (xb_ld(&(bar)[XB_TMO])) break; if (_sp > XB_SPIN_CAP) { atomicAdd(&(bar)[XB_TMO], 1u); break; } } } } while (0)
struct XcdBarrier { unsigned* bar; unsigned x; volatile LAS unsigned* st; };
__device__ __forceinline__ XcdBarrier xcd_barrier_post(unsigned* bar, volatile LAS unsigned* st) {
    XcdBarrier b; b.bar = bar; b.x = xb_xcc_id(); b.st = st;
    if (threadIdx.x == 0) (void)xb_add(&bar[XB_XCNT(b.x)], 1u);
    return b;
}
__device__ __forceinline__ void xcd_barrier_complete(unsigned* bar, unsigned x, unsigned& nloc, unsigned& nx) {
    const unsigned G = gridDim.x * gridDim.y * gridDim.z;
    unsigned sum, cnt, mine, sp = 0u;
    for (;;) {
        sum = 0u; cnt = 0u; mine = 0u;
#pragma unroll
        for (unsigned j = 0; j < 16; ++j) { const unsigned c = xb_ld(&bar[XB_XCNT(j)]); sum += c; cnt += (c > 0u) ? 1u : 0u; mine = (j == x) ? c : mine; }
        if (sum == G) break;
        __builtin_amdgcn_s_sleep(1);
        if ((++sp & 255u) == 0u) { if (xb_ld(&bar[XB_TMO])) break; if (sp > XB_SPIN_CAP) { atomicAdd(&bar[XB_TMO], 1u); break; } }
    }
    nloc = mine > 0u ? mine : 1u; nx = cnt > 0u ? cnt : 1u;
}
__device__ __forceinline__ void xcd_barrier(const XcdBarrier& b) {
    asm volatile("s_waitcnt vmcnt(0)" ::: "memory");
    __syncthreads();
    if (threadIdx.x == 0) {
        unsigned* bar = b.bar;
        __builtin_amdgcn_s_waitcnt(0);
        unsigned nloc = b.st[0], nx = b.st[1];
        if (nloc == 0u) { xcd_barrier_complete(bar, b.x, nloc, nx); b.st[0] = nloc; b.st[1] = nx; }
        const unsigned old = xb_add(&bar[XB_XSUB(b.x)], 1u);
        const unsigned gen = old / nloc;
        if (old + 1u == (gen + 1u) * nloc) {
            __builtin_amdgcn_fence(__ATOMIC_RELEASE, "agent");
            asm volatile("s_waitcnt vmcnt(0)" ::: "memory");
            const unsigned og = xb_add(&bar[XB_TOP], 1u);
            const unsigned tg = og / nx;
            if (og + 1u == (tg + 1u) * nx) xb_add(&bar[XB_TOPGEN], 1u);
            else XB_SPIN(xb_ld(&bar[XB_TOPGEN]) == tg, bar);
            __builtin_amdgcn_fence(__ATOMIC_ACQUIRE, "agent");
            xb_add(&bar[XB_XGEN(b.x)], 1u);
            asm volatile("s_waitcnt vmcnt(0)" ::: "memory");
        } else {
            XB_SPIN(xb_ld(&bar[XB_XGEN(b.x)]) == gen, bar);
            __builtin_amdgcn_fence(__ATOMIC_ACQUIRE, "agent");
            asm volatile("s_waitcnt vmcnt(0)" ::: "memory");
        }
    }
    __syncthreads();
}

namespace pg8 {
constexpr int BM = 256, BK = 64, HALF = 128, HTB = HALF * BK * 2, STAGE_BYTES = 8 * HTB, NXCD = 8, WGM = 8;
__device__ __forceinline__ int lds_byte(int r, int c) { const int st = (r >> 4) * 2 + (c >> 5), rr = r & 15, cc = c & 31, ob = rr * 64 + cc * 2; return st * 1024 + (ob ^ (((ob >> 9) & 1) << 5)); }
__device__ __forceinline__ void stage_rc(int b, int& R, int& C) { const int st = b / 1024, sb = b % 1024, swz = sb ^ (((sb >> 9) & 1) << 5); R = (st >> 1) * 16 + swz / 64; C = (st & 1) * 32 + (swz % 64) / 2; }
__device__ __forceinline__ int perm32(int rho) { const int n = rho >> 4, i = rho & 15; return 8 * (i >> 2) + 4 * n + (i & 3); }

struct Unit { int pm, pn; unsigned bofs; int aux; };

struct SchedDense {
    int nM, nN, nwg, G, c, K;
    __device__ void init(int M, int N, int K_, int G_, int c_) { nM = M / BM; nN = N / BM; nwg = nM * nN; G = G_; c = c_; K = K_; }
    __device__ bool next(int i, Unit& u) const {
        const long L = (long)i * G + c; if (L >= nwg) return false;
        int wgid = (int)L; { const int q = nwg / NXCD, r = nwg % NXCD, xcd = wgid % NXCD, off = wgid / NXCD; wgid = (xcd < r ? xcd * (q + 1) : r * (q + 1) + (xcd - r) * q) + off; }
        const int nig = WGM * nN, gid = wgid / nig, fm = gid * WGM, gsz = (nM - fm) < WGM ? (nM - fm) : WGM;
        u.pm = fm + ((wgid % nig) % gsz); u.pn = (wgid % nig) / gsz; u.bofs = (unsigned)u.pn * (unsigned)(BM * K * 2); u.aux = 0; return true;
    }
    __device__ __forceinline__ unsigned a_row(const Unit& u, int r) const { return (unsigned)(u.pm * BM + r); }
};
struct SchedGroup {
    const LAS int* tb; const LAS int* tokt; int G, c, pitch, gather;
    __device__ bool next(int i, Unit& u) const {
        const int L = i * G + c, nt = tb[NE]; if (L >= nt * 4) return false;
        const int g = L >> 2; const int ln = (int)(threadIdx.x & 63u);
        const int e = (int)__popcll(__ballot(ln < NE && tb[ln + 1] <= g));
        u.pm = g; u.pn = L & 3; u.bofs = (unsigned)(e * 1024 + u.pn * BM) * (unsigned)pitch; u.aux = i; return true;
    }
    __device__ __forceinline__ unsigned a_row(const Unit& u, int r) const { return gather ? (unsigned)tokt[u.aux * 256 + r] : (unsigned)(u.pm * BM + r); }
};

__device__ __forceinline__ unsigned cvt_pk_bf16(float lo, float hi) { unsigned r; asm volatile("v_cvt_pk_bf16_f32 %0, %1, %2" : "=v"(r) : "v"(lo), "v"(hi)); return r; }

typedef int i32x4 __attribute__((ext_vector_type(4)));
typedef int i32x8 __attribute__((ext_vector_type(8)));
template <bool F8> struct Frag { bf16x8 k[2]; };
template <> struct Frag<true> { i32x8 v; };
template <class Epi, class Sched, bool ALIGN_EPI, bool SP2, bool F8 = false>
__device__ __forceinline__ void gemm_phase(LAS unsigned char* lds, const int tid, const char* Abase, const char* Bbase, const int K, const Sched& S, const Epi& E) {
    const int wid = __builtin_amdgcn_readfirstlane(tid >> 6), lane = tid & 63, wr = wid >> 2, wc = wid & 3, fr = lane & 15, fq = lane >> 4;
    const int nt = F8 ? K / 128 : K / BK; const unsigned pitch = F8 ? (unsigned)K : 2u * (unsigned)K;
    int Rr[2], Cc[2]; unsigned voffB[2];
#pragma unroll
    for (int i = 0; i < 2; ++i) { int R, C; stage_rc(tid * 16 + i * 8192, R, C); const int Rb = Epi::PERM ? ((R & ~31) + perm32(R & 31)) : R;
        Rr[i] = R; Cc[i] = C; voffB[i] = (unsigned)Rb * pitch + 2u * (unsigned)C; }
    const size_t kstep = (size_t)(BK * 2);
    const size_t hstep = (size_t)HALF * pitch;
    const unsigned ldsw = (unsigned)wid * 1024u;
    const int fcol = F8 ? (fq >> 1) * 32 + (fq & 1) * 16 : fq * 8;
    const int aoff = lds_byte(wr * 64 + fr, fcol), boff = lds_byte(wc * 32 + fr, fcol);
#define PG8_SA(b, h) (((b) * 2 + (h)) * HTB)
#define PG8_SB(b, h) ((4 + (b) * 2 + (h)) * HTB)
#define PG8_STAGE(bufoff, gbase, voff) do { _Pragma("unroll") for (int _i = 0; _i < 2; ++_i) \
        __builtin_amdgcn_global_load_lds((const unsigned*)((const char*)(gbase) + (voff)[_i]), (LAS unsigned*)(lds + (bufoff) + ldsw + _i * 8192), 16, 0, 0); } while (0)
#define PG8_LDF(dstf, off_) do { if constexpr (F8) { const i32x4 _lo = *(const LAS i32x4*)(lds + (off_)), _hi = *(const LAS i32x4*)(lds + (off_) + 16); dstf.v = __builtin_shufflevector(_lo, _hi, 0, 1, 2, 3, 4, 5, 6, 7); } \
        else { dstf.k[0] = *(const LAS bf16x8*)(lds + (off_)); dstf.k[1] = *(const LAS bf16x8*)(lds + (off_) + 1024); } } while (0)
#define PG8_LDA(dst, b, h) do { _Pragma("unroll") for (int m = 0; m < 4; ++m) PG8_LDF(dst[m], PG8_SA(b, h) + aoff + m * 2048); } while (0)
#define PG8_LDB(dst, b, h) do { _Pragma("unroll") for (int n = 0; n < 2; ++n) PG8_LDF(dst[n], PG8_SB(b, h) + boff + n * 2048); } while (0)
#define PG8_MMA(ai, bj, At, Bt) do { __builtin_amdgcn_s_setprio(1); _Pragma("unroll") for (int m = 0; m < 4; ++m) _Pragma("unroll") for (int n = 0; n < 2; ++n) { \
        if constexpr (F8) asm volatile("v_mfma_f32_16x16x128_f8f6f4 %0, %1, %2, %0" : "+v"(acc[ai][bj][m][n]) : "v"(Bt[n].v), "v"(At[m].v));   \
        else { _Pragma("unroll") for (int k = 0; k < 2; ++k) acc[ai][bj][m][n] = __builtin_amdgcn_mfma_f32_16x16x32_bf16(Bt[n].k[k], At[m].k[k], acc[ai][bj][m][n], 0, 0, 0); } } \
        __builtin_amdgcn_s_setprio(0); } while (0)
#define PG8_WAIT_V(n) asm volatile("s_waitcnt vmcnt(" #n ")" ::: "memory")
#define PG8_WAIT_L(n) asm volatile("s_waitcnt lgkmcnt(" #n ")" ::: "memory")
#define PG8_BAR __builtin_amdgcn_s_barrier()
#define PG8_SCHED __builtin_amdgcn_sched_barrier(0)
#define PG8_AOFF(dst, u) do { _Pragma("unroll") for (int _h = 0; _h < 2; ++_h) _Pragma("unroll") for (int _i = 0; _i < 2; ++_i) \
        dst[_h][_i] = S.a_row(u, _h * HALF + Rr[_i]) * pitch + 2u * (unsigned)Cc[_i]; } while (0)
    Unit cur, nxt; int ui = 0;
    if (!S.next(0, cur)) return;
    f32x4 acc[2][2][4][2];
#pragma unroll
    for (int a = 0; a < 2; ++a)
#pragma unroll
        for (int b = 0; b < 2; ++b)
#pragma unroll
            for (int m = 0; m < 4; ++m)
#pragma unroll
                for (int n = 0; n < 2; ++n) acc[a][b][m][n] = (f32x4){0.f, 0.f, 0.f, 0.f};
    Frag<F8> At[4], B0[2], B1[2];
    unsigned co[2][2], no[2][2];
    PG8_AOFF(co, cur);
    const char* cB = Bbase + cur.bofs;
    if constexpr (SP2) {
        PG8_STAGE(PG8_SB(0, 0), cB, voffB); PG8_STAGE(PG8_SB(0, 1), cB + hstep, voffB); PG8_STAGE(PG8_SA(0, 0), Abase, co[0]); PG8_STAGE(PG8_SA(0, 1), Abase, co[1]);
        if (wr == 1) PG8_BAR;
        PG8_WAIT_V(2); PG8_BAR;
        PG8_STAGE(PG8_SB(1, 0), cB + kstep, voffB); PG8_STAGE(PG8_SA(1, 0), Abase + kstep, co[0]); PG8_STAGE(PG8_SB(1, 1), cB + hstep + kstep, voffB);
        PG8_WAIT_V(6); PG8_BAR;
    } else {
        PG8_STAGE(PG8_SB(0, 0), cB, voffB); PG8_STAGE(PG8_SA(0, 0), Abase, co[0]); PG8_STAGE(PG8_SB(0, 1), cB + hstep, voffB); PG8_STAGE(PG8_SA(0, 1), Abase, co[1]);
        if (wr == 1) PG8_BAR;
        PG8_WAIT_V(4); PG8_BAR;
        PG8_STAGE(PG8_SB(1, 0), cB + kstep, voffB); PG8_STAGE(PG8_SA(1, 0), Abase + kstep, co[0]); PG8_STAGE(PG8_SB(1, 1), cB + hstep + kstep, voffB);
        PG8_WAIT_V(6); PG8_BAR;
    }
    for (;;) {
        const bool has_next = S.next(ui + 1, nxt);
        const char* nB = has_next ? Bbase + nxt.bofs : cB;
        if (has_next) { PG8_AOFF(no, nxt); } else {
#pragma unroll
            for (int h = 0; h < 2; ++h)
#pragma unroll
                for (int i = 0; i < 2; ++i) no[h][i] = co[h][i]; }
#pragma unroll 1
        for (int t = 0; t < nt; t += 2) {
            const bool last = (t == nt - 2);
            const char* a1 = Abase + (size_t)(t + 1) * kstep;
            const char* a2 = last ? Abase : Abase + (size_t)(t + 2) * kstep; const char* b2 = last ? nB : cB + (size_t)(t + 2) * kstep;
            const char* a3 = a2 + kstep; const char* b3 = b2 + kstep;
            unsigned o2[2][2];
#pragma unroll
            for (int h = 0; h < 2; ++h)
#pragma unroll
                for (int i = 0; i < 2; ++i) o2[h][i] = last ? no[h][i] : co[h][i];
            if constexpr (SP2) {
            PG8_LDB(B0, 0, 0); PG8_LDB(B1, 0, 1); PG8_SCHED; PG8_LDA(At, 0, 0); PG8_STAGE(PG8_SA(1, 1), a1, co[1]);
            PG8_WAIT_V(8); PG8_WAIT_L(0); PG8_BAR; PG8_MMA(0, 0, At, B0); PG8_MMA(0, 1, At, B1); PG8_BAR; PG8_SCHED;
            PG8_LDA(At, 0, 1); PG8_STAGE(PG8_SB(0, 0), b2, voffB); PG8_STAGE(PG8_SB(0, 1), b2 + hstep, voffB); PG8_STAGE(PG8_SA(0, 0), a2, o2[0]);
            PG8_WAIT_V(8); PG8_WAIT_L(0); PG8_BAR; PG8_MMA(1, 0, At, B0); PG8_MMA(1, 1, At, B1); PG8_BAR; PG8_SCHED;
            PG8_LDB(B0, 1, 0); PG8_LDB(B1, 1, 1); PG8_SCHED; PG8_LDA(At, 1, 0); PG8_STAGE(PG8_SA(0, 1), a2, o2[1]);
            PG8_WAIT_V(8); PG8_WAIT_L(0); PG8_BAR; PG8_MMA(0, 0, At, B0); PG8_MMA(0, 1, At, B1); PG8_BAR; PG8_SCHED;
            PG8_LDA(At, 1, 1); PG8_STAGE(PG8_SB(1, 0), b3, voffB); PG8_STAGE(PG8_SB(1, 1), b3 + hstep, voffB); PG8_STAGE(PG8_SA(1, 0), a3, o2[0]);
            PG8_WAIT_V(8); PG8_WAIT_L(0); PG8_BAR; PG8_MMA(1, 0, At, B0); PG8_MMA(1, 1, At, B1); PG8_BAR; PG8_SCHED;
            } else {
            PG8_LDB(B0, 0, 0); PG8_SCHED; PG8_LDA(At, 0, 0); PG8_STAGE(PG8_SA(1, 1), a1, co[1]);
            PG8_WAIT_L(8); PG8_BAR; PG8_WAIT_L(0); PG8_MMA(0, 0, At, B0); PG8_BAR; PG8_SCHED;
            PG8_LDB(B1, 0, 1); PG8_STAGE(PG8_SB(0, 0), b2, voffB);
            PG8_BAR; PG8_WAIT_L(0); PG8_MMA(0, 1, At, B1); PG8_BAR;
            PG8_LDA(At, 0, 1); PG8_STAGE(PG8_SA(0, 0), a2, o2[0]);
            PG8_BAR; PG8_WAIT_L(0); PG8_MMA(1, 0, At, B0); PG8_BAR; PG8_SCHED;
            PG8_STAGE(PG8_SB(0, 1), b2 + hstep, voffB);
            PG8_WAIT_V(6); PG8_BAR; PG8_MMA(1, 1, At, B1); PG8_BAR;
            PG8_LDB(B0, 1, 0); PG8_SCHED; PG8_LDA(At, 1, 0); PG8_STAGE(PG8_SA(0, 1), a2, o2[1]);
            PG8_WAIT_L(8); PG8_BAR; PG8_WAIT_L(0); PG8_MMA(0, 0, At, B0); PG8_BAR; PG8_SCHED;
            PG8_LDB(B1, 1, 1); PG8_STAGE(PG8_SB(1, 0), b3, voffB);
            PG8_BAR; PG8_WAIT_L(0); PG8_MMA(0, 1, At, B1); PG8_BAR;
            PG8_LDA(At, 1, 1); PG8_STAGE(PG8_SA(1, 0), a3, o2[0]);
            PG8_BAR; PG8_WAIT_L(0); PG8_MMA(1, 0, At, B0); PG8_BAR; PG8_SCHED;
            PG8_STAGE(PG8_SB(1, 1), b3 + hstep, voffB);
            PG8_WAIT_V(6); PG8_BAR; PG8_MMA(1, 1, At, B1); PG8_BAR;
            }
        }
        if constexpr (ALIGN_EPI) { if (wr == 0) PG8_BAR; }
        if constexpr (F8) { __builtin_amdgcn_sched_barrier(0); asm volatile("s_nop 15\n\ts_nop 15\n\ts_nop 7" ::: "memory"); __builtin_amdgcn_sched_barrier(0); }
        E(acc, cur, wr, wc, fr, fq);
        if (!has_next) break;
#pragma unroll
        for (int a = 0; a < 2; ++a)
#pragma unroll
            for (int b = 0; b < 2; ++b)
#pragma unroll
                for (int m = 0; m < 4; ++m)
#pragma unroll
                    for (int n = 0; n < 2; ++n) acc[a][b][m][n] = (f32x4){0.f, 0.f, 0.f, 0.f};
        cur = nxt; cB = nB; ++ui;
#pragma unroll
        for (int h = 0; h < 2; ++h)
#pragma unroll
            for (int i = 0; i < 2; ++i) co[h][i] = no[h][i];
        if constexpr (ALIGN_EPI) { if (wr == 1) PG8_BAR; }
    }
    PG8_WAIT_V(0);
    if constexpr (!ALIGN_EPI) { if (wr == 0) PG8_BAR; }
    PG8_BAR;
#undef PG8_SA
#undef PG8_SB
#undef PG8_STAGE
#undef PG8_LDA
#undef PG8_LDF
#undef PG8_LDB
#undef PG8_MMA
#undef PG8_WAIT_V
#undef PG8_WAIT_L
#undef PG8_BAR
#undef PG8_SCHED
#undef PG8_AOFF
}

struct EpiInProj {
    static constexpr bool PERM = true;
    bf16_t* P; const float* ropeC; const float* ropeS;
    __device__ __forceinline__ void operator()(const f32x4 (&acc)[2][2][4][2], const Unit& u, int wr, int wc, int fr, int fq) const {
        const int row0 = u.pm * BM + wr * 64 + fr, col0 = u.pn * BM + wc * 32 + 8 * fq;
        const bool qk = u.pn < 4, rope = qk && (u.pm < NLAT / BM);
        const float ks = (u.pn >= 2 && u.pn < 4) ? 0.08838834764831845f : 1.0f;
        const int sec = wc >> 1, i0 = (wc & 1) * 16 + 4 * fq;
#pragma unroll
        for (int ai = 0; ai < 2; ++ai)
#pragma unroll
            for (int m = 0; m < 4; ++m) {
                const int row = row0 + ai * HALF + m * 16;
                asm volatile("" ::: "memory");
                f32x4 c4 = (f32x4){1.f, 1.f, 1.f, 1.f}, s4 = (f32x4){0.f, 0.f, 0.f, 0.f};
                if (rope) { const int t = row & (TL - 1), pos = sec ? (t & 63) : (t >> 6); const int ti = (sec ? 1024 : 0) + pos * 32 + i0;
                    c4 = *(const f32x4*)(ropeC + ti); s4 = *(const f32x4*)(ropeS + ti); }
                bf16_t* rowp = P + (size_t)row * NP + col0;
#pragma unroll
                for (int bj = 0; bj < 2; ++bj) {
                    f32x4 v0 = acc[ai][bj][m][0], v1 = acc[ai][bj][m][1];
                    if (qk) {
                        const float a0 = v0[0] * c4[0] - v0[1] * s4[0], b0 = v0[0] * s4[0] + v0[1] * c4[0];
                        const float a1 = v0[2] * c4[1] - v0[3] * s4[1], b1 = v0[2] * s4[1] + v0[3] * c4[1];
                        const float a2 = v1[0] * c4[2] - v1[1] * s4[2], b2 = v1[0] * s4[2] + v1[1] * c4[2];
                        const float a3 = v1[2] * c4[3] - v1[3] * s4[3], b3 = v1[2] * s4[3] + v1[3] * c4[3];
                        v0 = (f32x4){a0 * ks, b0 * ks, a1 * ks, b1 * ks}; v1 = (f32x4){a2 * ks, b2 * ks, a3 * ks, b3 * ks};
                    }
                    u32x4 w; w.x = cvt_pk_bf16(v0[0], v0[1]); w.y = cvt_pk_bf16(v0[2], v0[3]); w.z = cvt_pk_bf16(v1[0], v1[1]); w.w = cvt_pk_bf16(v1[2], v1[3]);
                    *(u32x4*)(rowp + bj * HALF) = w;
                }
            }
    }
};
struct EpiResid {
    static constexpr bool PERM = true;
    const float* rl; const float* rc; const bf16_t* rb; bf16_t* ob; float* ssq; const float* gmod;
    __device__ __forceinline__ void operator()(const f32x4 (&acc)[2][2][4][2], const Unit& u, int wr, int wc, int fr, int fq) const {
        const int row0 = u.pm * BM + wr * 64 + fr, col0 = u.pn * BM + wc * 32 + 8 * fq;
        const bool lat = u.pm < NLAT / BM; const int b = lat ? (u.pm >> 3) : 16;
        const float* rbase = rl ? (lat ? rl : rc - (size_t)NLAT * D) : nullptr;
        f32x4 gv[2][2];
#pragma unroll
        for (int bj = 0; bj < 2; ++bj)
#pragma unroll
            for (int n = 0; n < 2; ++n) gv[bj][n] = *(const f32x4*)(gmod + (size_t)b * 6 * D + col0 + bj * HALF + 4 * n);
#pragma unroll
        for (int ai = 0; ai < 2; ++ai)
#pragma unroll
            for (int m = 0; m < 4; ++m) { const int row = row0 + ai * HALF + m * 16; const size_t off = (size_t)row * D + col0; float ss = 0.f;
#pragma unroll
                for (int bj = 0; bj < 2; ++bj) { f32x4 r0, r1;
                    if (rbase) { r0 = *(const f32x4*)(rbase + off + bj * HALF); r1 = *(const f32x4*)(rbase + off + bj * HALF + 4); }
                    else { const u32x4 w = *(const u32x4*)(rb + off + bj * HALF); r0 = (f32x4){bflo(w.x), bfhi(w.x), bflo(w.y), bfhi(w.y)}; r1 = (f32x4){bflo(w.z), bfhi(w.z), bflo(w.w), bfhi(w.w)}; }
                    const f32x4 v0 = r0 + gv[bj][0] * acc[ai][bj][m][0], v1 = r1 + gv[bj][1] * acc[ai][bj][m][1];
                    ss += (v0[0] * v0[0] + v0[1] * v0[1]) + (v0[2] * v0[2] + v0[3] * v0[3]) + (v1[0] * v1[0] + v1[1] * v1[1]) + (v1[2] * v1[2] + v1[3] * v1[3]);
                    u32x4 w; w.x = cvt_pk_bf16(v0[0], v0[1]); w.y = cvt_pk_bf16(v0[2], v0[3]); w.z = cvt_pk_bf16(v1[0], v1[1]); w.w = cvt_pk_bf16(v1[2], v1[3]);
                    *(u32x4*)(ob + off + bj * HALF) = w; }
                ss += __shfl_xor(ss, 16); ss += __shfl_xor(ss, 32);
                if (fq == 0) ssq[(size_t)row * 16 + u.pn * 4 + wc] = ss;
                if (m & 1) asm volatile("" ::: "memory"); }
    }
};
struct EpiSwiGLU {
    static constexpr bool PERM = true;
    bf16_t* O;
    __device__ __forceinline__ void operator()(const f32x4 (&acc)[2][2][4][2], const Unit& u, int wr, int wc, int fr, int fq) const {
        const int row0 = u.pm * BM + wr * 64 + fr, col0 = u.pn * 128 + wc * 16 + 4 * fq;
#pragma unroll
        for (int ai = 0; ai < 2; ++ai)
#pragma unroll
            for (int m = 0; m < 4; ++m) { bf16_t* rowp = O + (size_t)(row0 + ai * HALF + m * 16) * FF + col0;
#pragma unroll
                for (int bj = 0; bj < 2; ++bj) { const f32x4 g = acc[ai][bj][m][0], up = acc[ai][bj][m][1];
                    u32x2 w; w.x = cvt_pk_bf16(silu_f(g[0]) * up[0], silu_f(g[1]) * up[1]); w.y = cvt_pk_bf16(silu_f(g[2]) * up[2], silu_f(g[3]) * up[3]);
                    *(u32x2*)(rowp + bj * 64) = w; } }
    }
};
__device__ __forceinline__ unsigned pk4_fp8(float a, float b, float c, float d) { int p = __builtin_amdgcn_cvt_pk_fp8_f32(a, b, 0, false); p = __builtin_amdgcn_cvt_pk_fp8_f32(c, d, p, true); return (unsigned)p; }
struct EpiSwiGLU8 {
    static constexpr bool PERM = true;
    unsigned char* O; float inv;
    __device__ __forceinline__ void operator()(const f32x4 (&acc)[2][2][4][2], const Unit& u, int wr, int wc, int fr, int fq) const {
        const int row0 = u.pm * BM + wr * 64 + fr, col0 = u.pn * 128 + wc * 32 + 8 * fq;
#pragma unroll
        for (int ai = 0; ai < 2; ++ai)
#pragma unroll
            for (int m = 0; m < 4; ++m) { unsigned char* rowp = O + (size_t)(row0 + ai * HALF + m * 16) * FF + col0;
                const f32x4 g0 = acc[ai][0][m][0] * inv, g1 = acc[ai][0][m][1] * inv, u0 = acc[ai][1][m][0] * inv, u1 = acc[ai][1][m][1] * inv;
                u32x2 w; w.x = pk4_fp8(silu_f(g0[0]) * u0[0], silu_f(g0[1]) * u0[1], silu_f(g0[2]) * u0[2], silu_f(g0[3]) * u0[3]);
                w.y = pk4_fp8(silu_f(g1[0]) * u1[0], silu_f(g1[1]) * u1[1], silu_f(g1[2]) * u1[2], silu_f(g1[3]) * u1[3]);
                *(u32x2*)rowp = w; }
    }
};
struct EpiFp8S {
    static constexpr bool PERM = true;
    unsigned char* O; int ldc; float inv;
    __device__ __forceinline__ void operator()(const f32x4 (&acc)[2][2][4][2], const Unit& u, int wr, int wc, int fr, int fq) const {
        const int row0 = u.pm * BM + wr * 64 + fr, col0 = u.pn * BM + wc * 32 + 8 * fq;
#pragma unroll
        for (int ai = 0; ai < 2; ++ai)
#pragma unroll
            for (int m = 0; m < 4; ++m) { unsigned char* rowp = O + (size_t)(row0 + ai * HALF + m * 16) * ldc + col0;
#pragma unroll
                for (int bj = 0; bj < 2; ++bj) { const f32x4 v0 = acc[ai][bj][m][0] * inv, v1 = acc[ai][bj][m][1] * inv;
                    u32x2 w; w.x = pk4_fp8(v0[0], v0[1], v0[2], v0[3]); w.y = pk4_fp8(v1[0], v1[1], v1[2], v1[3]);
                    *(u32x2*)(rowp + bj * HALF) = w; } }
    }
};
struct EpiBf16S {
    static constexpr bool PERM = true;
    bf16_t* O; int ldc; float inv;
    __device__ __forceinline__ void operator()(const f32x4 (&acc)[2][2][4][2], const Unit& u, int wr, int wc, int fr, int fq) const {
        const int row0 = u.pm * BM + wr * 64 + fr, col0 = u.pn * BM + wc * 32 + 8 * fq;
#pragma unroll
        for (int ai = 0; ai < 2; ++ai)
#pragma unroll
            for (int m = 0; m < 4; ++m) { bf16_t* rowp = O + (size_t)(row0 + ai * HALF + m * 16) * ldc + col0;
#pragma unroll
                for (int bj = 0; bj < 2; ++bj) { const f32x4 v0 = acc[ai][bj][m][0] * inv, v1 = acc[ai][bj][m][1] * inv;
                    u32x4 w; w.x = cvt_pk_bf16(v0[0], v0[1]); w.y = cvt_pk_bf16(v0[2], v0[3]); w.z = cvt_pk_bf16(v1[0], v1[1]); w.w = cvt_pk_bf16(v1[2], v1[3]);
                    *(u32x4*)(rowp + bj * HALF) = w; } }
    }
};
struct EpiBf16 {
    static constexpr bool PERM = true;
    bf16_t* O; int ldc;
    __device__ __forceinline__ void operator()(const f32x4 (&acc)[2][2][4][2], const Unit& u, int wr, int wc, int fr, int fq) const {
        const int row0 = u.pm * BM + wr * 64 + fr, col0 = u.pn * BM + wc * 32 + 8 * fq;
#pragma unroll
        for (int ai = 0; ai < 2; ++ai)
#pragma unroll
            for (int m = 0; m < 4; ++m) { bf16_t* rowp = O + (size_t)(row0 + ai * HALF + m * 16) * ldc + col0;
#pragma unroll
                for (int bj = 0; bj < 2; ++bj) { const f32x4 v0 = acc[ai][bj][m][0], v1 = acc[ai][bj][m][1];
                    u32x4 w; w.x = cvt_pk_bf16(v0[0], v0[1]); w.y = cvt_pk_bf16(v0[2], v0[3]); w.z = cvt_pk_bf16(v1[0], v1[1]); w.w = cvt_pk_bf16(v1[2], v1[3]);
                    *(u32x4*)(rowp + bj * HALF) = w; } }
    }
};
}

struct Args { const float* in[22]; float* out; unsigned char* ws; int ph_lo, ph_hi; };
enum { I_X = 0, I_C, I_CTX, I_CCTX, I_ADAW, I_ADAB, I_N1G, I_WIN, I_DF, I_DB, I_POOLW, I_POOLS, I_WOUT, I_N2G, I_RGW, I_RGB, I_REW, I_REB, I_WG, I_WU, I_WDN, I_FNG };

struct Frame {
    LAS unsigned char* lds; int tid, lane, wave, G, bx, vcu;
    const float* const* in; float* out; unsigned char* ws;
};
__device__ __forceinline__ bf16_t* xb_row(const Frame& F, int row) { return (bf16_t*)(F.ws + WS_XB) + (size_t)row * D; }
__device__ __forceinline__ bf16_t* hbuf(const Frame& F) { return (bf16_t*)F.out; }
__device__ __forceinline__ const float* mod_ptr(const Frame& F, int l, int b, int which) { return (const float*)(F.ws + WS_MOD) + ((size_t)(l * 17 + b) * 6 + which) * D; }

__device__ __forceinline__ void tr_item(const float* colp, size_t ldw, int k0, bf16_t* WT, int K, int n0, LAS float* scr, int lane) {
    { float v[32];
#pragma unroll
        for (int i = 0; i < 32; ++i) v[i] = colp[(size_t)(k0 + 2 * i + (lane >> 5)) * ldw];
#pragma unroll
        for (int i = 0; i < 32; ++i) scr[(2 * i + (lane >> 5)) * 33 + (lane & 31)] = v[i]; }
    asm volatile("s_waitcnt lgkmcnt(0)" ::: "memory");
    const int c = lane & 7;
#pragma unroll
    for (int j = 0; j < 4; ++j) { const int n = (lane >> 3) + 8 * j; const LAS float* s = scr + (8 * c) * 33 + n;
        u32x4 o; o.x = pk2(s[0 * 33], s[1 * 33]); o.y = pk2(s[2 * 33], s[3 * 33]); o.z = pk2(s[4 * 33], s[5 * 33]); o.w = pk2(s[6 * 33], s[7 * 33]);
        *(u32x4*)(WT + (size_t)(n0 + n) * K + k0 + 8 * c) = o; }
    asm volatile("s_waitcnt lgkmcnt(0)" ::: "memory");
}
constexpr float WGU_SCALE = 64.0f, WD_SCALE = 32.0f;
__device__ __forceinline__ void tr_item8(const float* colp, size_t ldw, int k0, unsigned char* WT, int K, int n0, LAS float* scr, int lane, float qs) {
    { float v[32];
#pragma unroll
        for (int i = 0; i < 32; ++i) v[i] = colp[(size_t)(k0 + 2 * i + (lane >> 5)) * ldw];
#pragma unroll
        for (int i = 0; i < 32; ++i) scr[(2 * i + (lane >> 5)) * 33 + (lane & 31)] = v[i] * qs; }
    asm volatile("s_waitcnt lgkmcnt(0)" ::: "memory");
    const int c = lane & 7;
#pragma unroll
    for (int j = 0; j < 4; ++j) { const int n = (lane >> 3) + 8 * j; const LAS float* s = scr + (8 * c) * 33 + n;
        u32x2 o; o.x = pg8::pk4_fp8(s[0 * 33], s[1 * 33], s[2 * 33], s[3 * 33]); o.y = pg8::pk4_fp8(s[4 * 33], s[5 * 33], s[6 * 33], s[7 * 33]);
        *(u32x2*)(WT + (size_t)(n0 + n) * K + k0 + 8 * c) = o; }
    asm volatile("s_waitcnt lgkmcnt(0)" ::: "memory");
}
__device__ __forceinline__ void fold_item(const float* win, const float* pw, const float* ps, int k0, bf16_t* WT, int n0, LAS float* scr, int lane) {
    const int n = n0 + (lane & 31), g = n >> 7, nn = n & 127;
    const float* pwc = pw + (size_t)g * 128 * 128 + nn; const float sc = ps[n];
    float acc[32];
#pragma unroll
    for (int i = 0; i < 32; ++i) acc[i] = 0.f;
    for (int hc = 0; hc < 8; ++hc) {
        float pc[16];
#pragma unroll
        for (int c = 0; c < 16; ++c) pc[c] = pwc[(size_t)(hc * 16 + c) * 128];
#pragma unroll
        for (int i = 0; i < 32; ++i) { const f32x4* wr = (const f32x4*)(win + (size_t)(k0 + 2 * i + (lane >> 5)) * NP + 2048 + g * 128 + hc * 16);
            float a = acc[i];
#pragma unroll
            for (int c4 = 0; c4 < 4; ++c4) { const f32x4 w = wr[c4]; a += w[0] * pc[4 * c4] + w[1] * pc[4 * c4 + 1] + w[2] * pc[4 * c4 + 2] + w[3] * pc[4 * c4 + 3]; }
            acc[i] = a; }
    }
#pragma unroll
    for (int i = 0; i < 32; ++i) scr[(2 * i + (lane >> 5)) * 33 + (lane & 31)] = acc[i] * sc;
    asm volatile("s_waitcnt lgkmcnt(0)" ::: "memory");
    const int c = lane & 7;
#pragma unroll
    for (int j = 0; j < 4; ++j) { const int nl = (lane >> 3) + 8 * j; const LAS float* s = scr + (8 * c) * 33 + nl;
        u32x4 o; o.x = pk2(s[0 * 33], s[1 * 33]); o.y = pk2(s[2 * 33], s[3 * 33]); o.z = pk2(s[4 * 33], s[5 * 33]); o.w = pk2(s[6 * 33], s[7 * 33]);
        *(u32x4*)(WT + (size_t)(2048 + n0 + nl) * D + k0 + 8 * c) = o; }
    asm volatile("s_waitcnt lgkmcnt(0)" ::: "memory");
}
__device__ __forceinline__ void p0_prologue(const Frame& F, int qsel) {
    for (int task = F.bx; task < 2 * 96; task += F.G) {
        const int l = task / 96, cg = task % 96;
        LAS float* sc = (LAS float*)F.lds;
        LAS float* part = (LAS float*)(F.lds + 17 * 1024 * 4);
        { float cv[34];
#pragma unroll
          for (int q = 0; q < 34; ++q) { const int i = F.tid + 512 * q, b = i >> 10, k = i & 1023; cv[q] = b < 16 ? F.in[I_C][b * D + k] : F.in[I_CCTX][k]; }
#pragma unroll
          for (int q = 0; q < 34; ++q) sc[F.tid + 512 * q] = silu_f(cv[q]); }
        __syncthreads();
        float acc[17];
#pragma unroll
        for (int b = 0; b < 17; ++b) acc[b] = 0.f;
        const float* aw = F.in[I_ADAW] + (size_t)l * D * 6 * D + cg * 64 + F.lane;
        for (int k0 = F.wave * 128; k0 < F.wave * 128 + 128; k0 += 16) { float w[16];
#pragma unroll
            for (int u = 0; u < 16; ++u) w[u] = aw[(size_t)(k0 + u) * 6 * D];
#pragma unroll
            for (int u = 0; u < 16; ++u) {
#pragma unroll
                for (int b = 0; b < 17; ++b) acc[b] += sc[b * 1024 + k0 + u] * w[u]; } }
#pragma unroll
        for (int b = 0; b < 17; ++b) part[(F.wave * 17 + b) * 64 + F.lane] = acc[b];
        __syncthreads();
        for (int i = F.tid; i < 17 * 64; i += 512) { const int b = i >> 6, n = i & 63; float s = F.in[I_ADAB][l * 6 * D + cg * 64 + n];
#pragma unroll
            for (int w = 0; w < 8; ++w) s += part[(w * 17 + b) * 64 + n];
            const int col = cg * 64 + n; ((float*)(F.ws + WS_MOD))[((size_t)(l * 17 + b) * 6 + (col >> 10)) * D + (col & 1023)] = s; }
        __syncthreads();
    }
    if (F.bx >= F.G - 3 && F.bx < F.G - 1) { const int l = F.G - 2 - F.bx; unsigned char* img = F.ws + WS_RIMG + (size_t)l * RW_EX;
        const float* rg = F.in[I_RGW] + (size_t)l * D * 4; const float* re = F.in[I_REW] + (size_t)l * D * NE;
        for (int i0 = F.tid; i0 < 1024 * 36; i0 += 512 * 8) { float w[8];
#pragma unroll
            for (int q = 0; q < 8; ++q) { const int i = i0 + 512 * q, k = i / 36, n = i % 36; w[q] = n < 4 ? rg[k * 4 + n] : re[k * NE + (n - 4)]; }
#pragma unroll
            for (int q = 0; q < 8; ++q) { const int i = i0 + 512 * q, k = i / 36, n = i % 36; const unsigned hi = f2bf(w[q]), lo = f2bf(w[q] - bflo(hi));
                *(bf16_t*)(img + n * RW_PITCH + k * 2) = (bf16_t)hi; *(bf16_t*)(img + RW_LO + n * RW_PITCH + k * 2) = (bf16_t)lo; } }
        for (int i = F.tid; i < 2 * 36 * 8; i += 512) { const int r = i >> 3; *(bf16_t*)(img + r * RW_PITCH + 2048 + (i & 7) * 2) = 0; }
    }
    if (F.bx == F.G - 1) {
        float* rc = (float*)(F.ws + WS_ROPE); float* rs = rc + 96 * 32;
        for (int i = F.tid; i < 96 * 32; i += 512) { const int p = i >> 5, f = i & 31; const int pos = p < 32 ? p : p - 32;
            const float inv = powf(10000.0f, -(float)f / 32.0f); const float ang = (float)pos * inv; rc[i] = cosf(ang); rs[i] = sinf(ang); }
    }
    LAS float* scr = (LAS float*)(F.lds + F.wave * 8448);
    constexpr int IT_WIN = 16 * 80, IT_WOUT = 16 * 32, IT_GU = 16 * 32, IT_DN = 8 * 32;
    constexpr int N_WIN = DEPTH * IT_WIN, N_WOUT = DEPTH * IT_WOUT, N_GU = DEPTH * NE * IT_GU, N_DN = DEPTH * NE * IT_DN;
    unsigned* qhead = (unsigned*)(F.ws + WS_CTL) + CW_QUEUE + 16 * qsel;
    constexpr int N_ALL = N_WIN + N_WOUT + N_GU + N_DN, QB = 16, NBATCH = N_ALL / QB;
    static_assert(N_ALL % QB == 0, "queue batches");
    for (;;) {
        int bq = 0; if (F.lane == 0) bq = (int)__hip_atomic_fetch_add(qhead, 1u, __ATOMIC_RELAXED, __HIP_MEMORY_SCOPE_AGENT);
        bq = __builtin_amdgcn_readfirstlane(bq);
        if (bq >= NBATCH) break;
      for (int qi = 0; qi < QB; ++qi) {
        int r = bq + qi * NBATCH;
        if (r < N_WIN) { const int l = r / IT_WIN; r %= IT_WIN; const int kb = r & 15, nb = 79 - (r >> 4), n0 = nb * 32;
            const float* win = F.in[I_WIN] + (size_t)l * D * NP; bf16_t* WT = (bf16_t*)(F.ws + WS_WIN) + (size_t)l * NP * D;
            if (n0 >= 2048) { fold_item(win, F.in[I_POOLW] + (size_t)l * 4 * 128 * 128, F.in[I_POOLS] + l * 512, kb * 64, WT, n0 - 2048, scr, F.lane); continue; }
            const int n = n0 + (F.lane & 31); int src = n;
            if (n < 1024) { const int hh = n >> 7, j = n & 127, sec = j >> 6, jj = j & 63; src = (n & 512) + (hh & 3) * 128 + sec * 64 + (jj & 1) * 32 + (jj >> 1); }
            tr_item(win + src, NP, kb * 64, WT, D, n0, scr, F.lane); continue; }
        r -= N_WIN;
        if (r < N_WOUT) { const int l = r / IT_WOUT; r %= IT_WOUT; const int kb = r / 32, nb = r % 32, n0 = nb * 32;
            tr_item(F.in[I_WOUT] + (size_t)l * D * D + n0 + (F.lane & 31), D, kb * 64, (bf16_t*)(F.ws + WS_WOUT) + (size_t)l * D * D, D, n0, scr, F.lane); continue; }
        r -= N_WOUT;
        if (r < N_GU) { const int le = r / IT_GU; r %= IT_GU; const int kb = r / 32, nb = r % 32, n0 = nb * 32;
            const int n = n0 + (F.lane & 31), col = (n >> 8) * 128 + (n & 127); const float* src = ((n & 128) ? F.in[I_WU] : F.in[I_WG]) + (size_t)le * D * FF + col;
            tr_item8(src, FF, kb * 64, (unsigned char*)(F.ws + WS_WGU) + (size_t)le * 1024 * D, D, n0, scr, F.lane, WGU_SCALE); continue; }
        r -= N_GU;
        { const int le = r / IT_DN; r %= IT_DN; const int kb = r / 32, nb = r % 32, n0 = nb * 32;
            tr_item8(F.in[I_WDN] + (size_t)le * FF * D + n0 + (F.lane & 31), D, kb * 64, (unsigned char*)(F.ws + WS_WD) + (size_t)le * D * FF, FF, n0, scr, F.lane, WD_SCALE); }
      }
    }
}

__device__ __forceinline__ LAS int* build_tb(const Frame& F, int l) {
    LAS int* tb = (LAS int*)(F.lds + MISC_OFF + 64);
    if (F.tid < 64) {
        const unsigned* cnt = (const unsigned*)(F.ws + WS_CTL) + CW_CNT + l * NE * 16;
        const int e = F.tid & 31; const int c = (int)__hip_atomic_load(cnt + e * 16, __ATOMIC_RELAXED, __HIP_MEMORY_SCOPE_AGENT);
        const int t = (c + 255) >> 8; int incl = t;
#pragma unroll
        for (int o = 1; o < 32; o <<= 1) { const int v = __shfl_up(incl, o, 32); if (e >= o) incl += v; }
        if (F.tid < 32) { tb[e] = incl - t; tb[64 + e] = c; if (e == 31) tb[NE] = incl; }
    }
    __syncthreads();
    return tb;
}

__device__ __forceinline__ void row_op_a(const Frame& F, int mode, bool dry) {
    const int gw = F.vcu * 8 + F.wave, NGW = F.G * 8;
    const int nrows = (mode == 2) ? NLAT : NTOK; const int l = (mode == 0) ? 0 : 1, lp = mode - 1;
    const LAS int* tb = nullptr; if (mode != 0) tb = build_tb(F, lp);
    const unsigned char* YB = (const unsigned char*)(F.ws + WS_P); bf16_t* H = hbuf(F);
    const float* gain = (mode == 2) ? F.in[I_FNG] : F.in[I_N1G] + l * D;
    const int R = (nrows + NGW - 1) / NGW, r_lo = gw * R, r_hi = (r_lo + R < nrows) ? r_lo + R : nrows;
    int4 ti1 = make_int4(0, 0, 0, 0), ti2 = ti1; f32x2 tw0 = (f32x2){0.f, 0.f}, tw1 = tw0, tw2 = tw0;
    f32x4 xf[4]; u32x2 xq[4]; unsigned ya[4], yc[4];
#define ROWA_INFO(r_, ti_, tw_) do { if (mode != 0 && (r_) < r_hi) { ti_ = *(const int4*)(F.ws + WS_TOKINFO + (size_t)(r_) * 32); tw_ = *(const f32x2*)(F.ws + WS_TOKINFO + (size_t)(r_) * 32 + 16); } } while (0)
#define ROWA_DATA(r_, ti_) do { if ((r_) < r_hi) { if (mode == 0) { const f32x4* src = (const f32x4*)((r_) < NLAT ? F.in[I_X] + (size_t)(r_) * D : F.in[I_CTX] + (size_t)((r_) - NLAT) * D) + F.lane; \
            _Pragma("unroll") for (int j = 0; j < 4; ++j) xf[j] = src[64 * j]; } \
        else { const size_t s1 = (size_t)(tb[ti_.x] * 256 + ti_.y), s2 = (size_t)(tb[ti_.z] * 256 + ti_.w); const u32x2* xr_ = (const u32x2*)xb_row(F, (r_)) + F.lane; \
            const unsigned* y1 = (const unsigned*)(YB + s1 * D) + F.lane; const unsigned* y2 = (const unsigned*)(YB + s2 * D) + F.lane; \
            _Pragma("unroll") for (int j = 0; j < 4; ++j) { xq[j] = xr_[64 * j]; ya[j] = y1[64 * j]; yc[j] = y2[64 * j]; } } } } while (0)
    ROWA_INFO(r_lo, ti1, tw1); ROWA_INFO(r_lo + 1, ti2, tw2);
    ROWA_DATA(r_lo, ti1); tw0 = tw1; ti1 = ti2; tw1 = tw2;
    f32x4 vA[4], vB[4], vG[4]; int bcur = -1;
    for (int row = r_lo; row < r_hi; ++row) {
        const int b = row < NLAT ? (row >> 11) : 16;
        if (b != bcur) { bcur = b;
#pragma unroll
            for (int j = 0; j < 4; ++j) { const f32x4 g = ((const f32x4*)gain)[F.lane + 64 * j];
                if (mode == 2) { vA[j] = g; vB[j] = (f32x4){0.f, 0.f, 0.f, 0.f}; }
                else { vA[j] = g * (((const f32x4*)mod_ptr(F, l, b, 1))[F.lane + 64 * j] + 1.0f); vB[j] = ((const f32x4*)mod_ptr(F, l, b, 0))[F.lane + 64 * j]; }
                if (mode != 0) vG[j] = ((const f32x4*)mod_ptr(F, lp, b, 5))[F.lane + 64 * j]; } }
        ROWA_INFO(row + 2, ti2, tw2);
        f32x4 v[4];
        if (mode == 0) {
#pragma unroll
            for (int j = 0; j < 4; ++j) v[j] = xf[j];
        } else {
#pragma unroll
            for (int j = 0; j < 4; ++j) { const u32x2 xw = xq[j]; const f32x4 x = (f32x4){bflo(xw.x), bfhi(xw.x), bflo(xw.y), bfhi(xw.y)};
                const int a = (int)ya[j], c = (int)yc[j];
                f32x4 y; y[0] = tw0.x * __builtin_amdgcn_cvt_f32_fp8(a, 0) + tw0.y * __builtin_amdgcn_cvt_f32_fp8(c, 0); y[1] = tw0.x * __builtin_amdgcn_cvt_f32_fp8(a, 1) + tw0.y * __builtin_amdgcn_cvt_f32_fp8(c, 1);
                y[2] = tw0.x * __builtin_amdgcn_cvt_f32_fp8(a, 2) + tw0.y * __builtin_amdgcn_cvt_f32_fp8(c, 2); y[3] = tw0.x * __builtin_amdgcn_cvt_f32_fp8(a, 3) + tw0.y * __builtin_amdgcn_cvt_f32_fp8(c, 3);
                v[j] = x + vG[j] * y; }
        }
        ROWA_DATA(row + 1, ti1);
        if (mode == 1 && !dry) { u32x2* xr = (u32x2*)xb_row(F, row) + F.lane;
#pragma unroll
            for (int j = 0; j < 4; ++j) { u32x2 w; w.x = pk2(v[j][0], v[j][1]); w.y = pk2(v[j][2], v[j][3]); xr[64 * j] = w; } }
        float ss = 0.f;
#pragma unroll
        for (int j = 0; j < 4; ++j) ss += (v[j][0] * v[j][0] + v[j][1] * v[j][1]) + (v[j][2] * v[j][2] + v[j][3] * v[j][3]);
        const float rstd = 1.0f / sqrtf(wave_sum(ss) * (1.0f / D) + EPS);
        if (mode == 2) {
#pragma unroll
            for (int j = 0; j < 4; ++j) ((f32x4*)((dry ? (float*)(F.ws + WS_WGU) : F.out) + (size_t)row * D))[F.lane + 64 * j] = v[j] * rstd * vA[j];
        } else {
            u32x2* o = (u32x2*)(H + (size_t)row * D) + F.lane;
#pragma unroll
            for (int j = 0; j < 4; ++j) { const f32x4 h = v[j] * rstd * vA[j] + vB[j];
                u32x2 w; w.x = pk2(h[0], h[1]); w.y = pk2(h[2], h[3]); o[64 * j] = w; }
        }
        tw0 = tw1; ti1 = ti2; tw1 = tw2;
    }
#undef ROWA_INFO
#undef ROWA_DATA
}

template <bool DRY> __device__ __forceinline__ void route_row(const Frame& F, int l, int row, const float (&s)[36], unsigned* cnt, int* list) {
    float gl[4];
#pragma unroll
    for (int i = 0; i < 4; ++i) gl[i] = s[i];
    int gt = 0; float gm = gl[0];
#pragma unroll
    for (int i = 1; i < 4; ++i) if (gl[i] > gm) { gm = gl[i]; gt = i; }
    float gs = 0.f;
#pragma unroll
    for (int i = 0; i < 4; ++i) gs += expf(gl[i] - gm);
    const float gwt = 1.0f / gs;
    float el[8];
#pragma unroll
    for (int j = 0; j < 8; ++j) el[j] = gt == 0 ? s[4 + j] : gt == 1 ? s[12 + j] : gt == 2 ? s[20 + j] : s[28 + j];
    int i1 = 0; float v1 = el[0];
#pragma unroll
    for (int j = 1; j < 8; ++j) if (el[j] > v1) { v1 = el[j]; i1 = j; }
    int i2 = -1; float v2 = -3.0e38f;
#pragma unroll
    for (int j = 0; j < 8; ++j) if (j != i1 && el[j] > v2) { v2 = el[j]; i2 = j; }
    const float e2 = expf(v2 - v1); const float w1 = gwt / (1.0f + e2), w2 = gwt * e2 / (1.0f + e2);
    if (!DRY) {
        const int x1 = gt * 8 + i1, x2 = gt * 8 + i2;
        const int r1 = (int)__hip_atomic_fetch_add(cnt + x1 * 16, 1u, __ATOMIC_RELAXED, __HIP_MEMORY_SCOPE_AGENT);
        const int r2 = (int)__hip_atomic_fetch_add(cnt + x2 * 16, 1u, __ATOMIC_RELAXED, __HIP_MEMORY_SCOPE_AGENT);
        list[(size_t)x1 * NTOK + r1] = row; list[(size_t)x2 * NTOK + r2] = row;
        *(int4*)(F.ws + WS_TOKINFO + (size_t)row * 32) = make_int4(x1, r1, x2, r2); *(f32x2*)(F.ws + WS_TOKINFO + (size_t)row * 32 + 16) = (f32x2){w1, w2};
    }
}
template <bool DRY> __device__ __forceinline__ void row_op_b(const Frame& F, int l) {
    const int gw = F.vcu * 8 + F.wave, NGW = F.G * 8;
    const int ngroups = ((l == 0) ? NTOK : NLAT) / 16;
    { const u32x4* img = (const u32x4*)(F.ws + WS_RIMG + (size_t)l * RW_EX);
      u32x4 t[19];
#pragma unroll
      for (int q = 0; q < 19; ++q) { const int i = F.tid + 512 * q; t[q] = img[i < RW_EX / 16 ? i : 0]; }
#pragma unroll
      for (int q = 0; q < 19; ++q) { const int i = F.tid + 512 * q; if (i < RW_EX / 16) *(LAS u32x4*)(F.lds + i * 16) = t[q]; } }
    __syncthreads();
    bf16_t* H = hbuf(F);
    const float* gain = F.in[I_N2G] + l * D;
    unsigned* cnt = (unsigned*)(F.ws + WS_CTL) + CW_CNT + l * NE * 16;
    int* list = (int*)(F.ws + WS_LIST);
    const int fr = F.lane & 15, fq = F.lane >> 4;
    unsigned bo[3];
#pragma unroll
    for (int nt = 0; nt < 3; ++nt) { const int n = 16 * nt + fr; bo[nt] = (unsigned)((n < 36 ? n : 35) * RW_PITCH + fq * 16); }
    LAS float* ex = (LAS float*)(F.lds + RW_EX + F.wave * 1152);
    float rbias[36];
#pragma unroll
    for (int n = 0; n < 36; ++n) rbias[n] = n < 4 ? F.in[I_RGB][l * 4 + n] : F.in[I_REB][l * NE + (n - 4)];
    for (int it = 0;; ++it) {
        const int gi = it == 0 ? gw : NGW + F.vcu + (it - 1) * F.G;
        if (gi >= ngroups || (it > 0 && F.wave != 0)) break;
        const int row = gi * 16 + fr, b = row < NLAT ? (row >> 11) : 16;
        const bf16_t* xr = xb_row(F, row) + fq * 8;
        float ss;
        { const f32x4* sp = (const f32x4*)((const float*)(F.ws + WS_SSQ) + (size_t)row * 16); const f32x4 p0 = sp[0], p1 = sp[1], p2 = sp[2], p3 = sp[3];
          ss = ((p0[0] + p0[1]) + (p0[2] + p0[3])) + ((p1[0] + p1[1]) + (p1[2] + p1[3])) + ((p2[0] + p2[1]) + (p2[2] + p2[3])) + ((p3[0] + p3[1]) + (p3[2] + p3[3])); }
        const float rstd = 1.0f / sqrtf(ss * (1.0f / D) + EPS);
        const float* shp = mod_ptr(F, l, b, 3) + fq * 8; const float* scp = mod_ptr(F, l, b, 4) + fq * 8; const float* gp = gain + fq * 8;
        unsigned char* hp = (unsigned char*)H + (size_t)row * D + fq * 8;
        f32x4 acc[3];
#pragma unroll
        for (int nt = 0; nt < 3; ++nt) acc[nt] = (f32x4){0.f, 0.f, 0.f, 0.f};
#pragma unroll 2
        for (int s = 0; s < 32; ++s) {
            const u32x4 xw = *(const u32x4*)(xr + 32 * s);
            const f32x4 x0 = (f32x4){bflo(xw.x), bfhi(xw.x), bflo(xw.y), bfhi(xw.y)}, x1 = (f32x4){bflo(xw.z), bfhi(xw.z), bflo(xw.w), bfhi(xw.w)};
            const f32x4 g0 = *(const f32x4*)(gp + 32 * s), g1 = *(const f32x4*)(gp + 32 * s + 4);
            const f32x4 c0 = *(const f32x4*)(scp + 32 * s), c1 = *(const f32x4*)(scp + 32 * s + 4);
            const f32x4 s0 = *(const f32x4*)(shp + 32 * s), s1 = *(const f32x4*)(shp + 32 * s + 4);
            const f32x4 h0 = x0 * rstd * g0 * (c0 + 1.0f) + s0, h1 = x1 * rstd * g1 * (c1 + 1.0f) + s1;
            u32x4 hi, lo;
            hi.x = pk2(h0[0], h0[1]); hi.y = pk2(h0[2], h0[3]); hi.z = pk2(h1[0], h1[1]); hi.w = pk2(h1[2], h1[3]);
            lo.x = pk2(h0[0] - bflo(hi.x), h0[1] - bfhi(hi.x)); lo.y = pk2(h0[2] - bflo(hi.y), h0[3] - bfhi(hi.y));
            lo.z = pk2(h1[0] - bflo(hi.z), h1[1] - bfhi(hi.z)); lo.w = pk2(h1[2] - bflo(hi.w), h1[3] - bfhi(hi.w));
            { u32x2 h8; h8.x = pg8::pk4_fp8(h0[0], h0[1], h0[2], h0[3]); h8.y = pg8::pk4_fp8(h1[0], h1[1], h1[2], h1[3]); *(u32x2*)(hp + 32 * s) = h8; }
            const bf16x8 ah = __builtin_bit_cast(bf16x8, hi), al = __builtin_bit_cast(bf16x8, lo);
#pragma unroll
            for (int nt = 0; nt < 3; ++nt) {
                const bf16x8 bh = *(const LAS bf16x8*)(F.lds + bo[nt] + s * 64), bl = *(const LAS bf16x8*)(F.lds + RW_LO + bo[nt] + s * 64);
                acc[nt] = __builtin_amdgcn_mfma_f32_16x16x32_bf16(ah, bh, acc[nt], 0, 0, 0);
                acc[nt] = __builtin_amdgcn_mfma_f32_16x16x32_bf16(ah, bl, acc[nt], 0, 0, 0);
                acc[nt] = __builtin_amdgcn_mfma_f32_16x16x32_bf16(al, bh, acc[nt], 0, 0, 0);
            }
        }
#pragma unroll
        for (int hf = 0; hf < 2; ++hf) {
            if ((fq >> 1) == hf) {
#pragma unroll
                for (int nt = 0; nt < 3; ++nt) { const int n = 16 * nt + fr;
                    if (n < 36) {
#pragma unroll
                        for (int r = 0; r < 4; ++r) ex[((fq & 1) * 4 + r) * 36 + n] = acc[nt][r]; } }
            }
            asm volatile("s_waitcnt lgkmcnt(0)" ::: "memory");
            if (F.lane < 8) { float sl[36];
#pragma unroll
                for (int n = 0; n < 36; ++n) sl[n] = ex[F.lane * 36 + n] + rbias[n];
                route_row<DRY>(F, l, gi * 16 + hf * 8 + F.lane, sl, cnt, list); }
            asm volatile("s_waitcnt lgkmcnt(0)" ::: "memory");
        }
    }
    __syncthreads();
}

__device__ __forceinline__ unsigned off_b(unsigned row, unsigned ch) { return 256u * row + 16u * (ch ^ (((row & 3) << 2) | ((row >> 2) & 3))); }
__device__ __forceinline__ unsigned tr_base_p(unsigned lane) { const unsigned g = lane >> 4, q = (lane & 15) >> 2, p = lane & 3; return off_b(4 * g + q, (p >> 1)) + 8 * (p & 1); }
template <int O0, int O1, int O2, int O3>
__device__ __forceinline__ void tr_frag4(bf16x8 (&f)[4], unsigned a0, unsigned a1, unsigned a2, unsigned a3) {
    s16x4 l0, h0, l1, h1, l2, h2, l3, h3;
    asm volatile("ds_read_b64_tr_b16 %0, %8 offset:%12\n\tds_read_b64_tr_b16 %1, %8 offset:%16\n\t"
                 "ds_read_b64_tr_b16 %2, %9 offset:%13\n\tds_read_b64_tr_b16 %3, %9 offset:%17\n\t"
                 "ds_read_b64_tr_b16 %4, %10 offset:%14\n\tds_read_b64_tr_b16 %5, %10 offset:%18\n\t"
                 "ds_read_b64_tr_b16 %6, %11 offset:%15\n\tds_read_b64_tr_b16 %7, %11 offset:%19\n\ts_waitcnt lgkmcnt(0)"
                 : "=&v"(l0), "=&v"(h0), "=&v"(l1), "=&v"(h1), "=&v"(l2), "=&v"(h2), "=&v"(l3), "=&v"(h3)
                 : "v"(a0), "v"(a1), "v"(a2), "v"(a3), "n"(O0), "n"(O1), "n"(O2), "n"(O3), "n"(O0 + 4096), "n"(O1 + 4096), "n"(O2 + 4096), "n"(O3 + 4096) : "memory");
    f[0] = __builtin_shufflevector(l0, h0, 0, 1, 2, 3, 4, 5, 6, 7); f[1] = __builtin_shufflevector(l1, h1, 0, 1, 2, 3, 4, 5, 6, 7);
    f[2] = __builtin_shufflevector(l2, h2, 0, 1, 2, 3, 4, 5, 6, 7); f[3] = __builtin_shufflevector(l3, h3, 0, 1, 2, 3, 4, 5, 6, 7);
}
template <int O>
__device__ __forceinline__ void tr_frag8(bf16x8 (&f)[8], unsigned a) {
    s16x4 l0, h0, l1, h1, l2, h2, l3, h3, l4, h4, l5, h5, l6, h6, l7, h7;
    const unsigned a1 = a ^ 32u, a2 = a ^ 64u, a3 = a ^ 96u, a4 = a ^ 128u, a5 = a ^ 160u, a6 = a ^ 192u, a7 = a ^ 224u;
    asm volatile("ds_read_b64_tr_b16 %0, %8 offset:%12\n\tds_read_b64_tr_b16 %1, %8 offset:%13\n\t"
                 "ds_read_b64_tr_b16 %2, %9 offset:%12\n\tds_read_b64_tr_b16 %3, %9 offset:%13\n\t"
                 "ds_read_b64_tr_b16 %4, %10 offset:%12\n\tds_read_b64_tr_b16 %5, %10 offset:%13\n\t"
                 "ds_read_b64_tr_b16 %6, %11 offset:%12\n\tds_read_b64_tr_b16 %7, %11 offset:%13"
                 : "=&v"(l0), "=&v"(h0), "=&v"(l1), "=&v"(h1), "=&v"(l2), "=&v"(h2), "=&v"(l3), "=&v"(h3)
                 : "v"(a), "v"(a1), "v"(a2), "v"(a3), "n"(O), "n"(O + 4096) : "memory");
    asm volatile("ds_read_b64_tr_b16 %0, %16 offset:%20\n\tds_read_b64_tr_b16 %1, %16 offset:%21\n\t"
                 "ds_read_b64_tr_b16 %2, %17 offset:%20\n\tds_read_b64_tr_b16 %3, %17 offset:%21\n\t"
                 "ds_read_b64_tr_b16 %4, %18 offset:%20\n\tds_read_b64_tr_b16 %5, %18 offset:%21\n\t"
                 "ds_read_b64_tr_b16 %6, %19 offset:%20\n\tds_read_b64_tr_b16 %7, %19 offset:%21\n\ts_waitcnt lgkmcnt(0)"
                 : "=&v"(l4), "=&v"(h4), "=&v"(l5), "=&v"(h5), "=&v"(l6), "=&v"(h6), "=&v"(l7), "=&v"(h7),
                   "+v"(l0), "+v"(h0), "+v"(l1), "+v"(h1), "+v"(l2), "+v"(h2), "+v"(l3), "+v"(h3)
                 : "v"(a4), "v"(a5), "v"(a6), "v"(a7), "n"(O), "n"(O + 4096) : "memory");
    f[0] = __builtin_shufflevector(l0, h0, 0, 1, 2, 3, 4, 5, 6, 7); f[1] = __builtin_shufflevector(l1, h1, 0, 1, 2, 3, 4, 5, 6, 7);
    f[2] = __builtin_shufflevector(l2, h2, 0, 1, 2, 3, 4, 5, 6, 7); f[3] = __builtin_shufflevector(l3, h3, 0, 1, 2, 3, 4, 5, 6, 7);
    f[4] = __builtin_shufflevector(l4, h4, 0, 1, 2, 3, 4, 5, 6, 7); f[5] = __builtin_shufflevector(l5, h5, 0, 1, 2, 3, 4, 5, 6, 7);
    f[6] = __builtin_shufflevector(l6, h6, 0, 1, 2, 3, 4, 5, 6, 7); f[7] = __builtin_shufflevector(l7, h7, 0, 1, 2, 3, 4, 5, 6, 7);
}
#define LBAR() do { asm volatile("s_waitcnt lgkmcnt(0)" ::: "memory"); __builtin_amdgcn_s_barrier(); asm volatile("" ::: "memory"); } while (0)
__device__ __forceinline__ int chunk_row0(int b, int ci) { return ci < 2 ? NLAT + b * CT + ci * 128 : b * TL + (ci - 2) * 128; }
__device__ __forceinline__ float log2_gamma(float decay) { return -log1pf(expf(-decay)) * 1.4426950408889634f; }

template <int HALF>
__device__ __forceinline__ void pool_item(const LAS unsigned char* tile, bf16_t* A2, int t0, int T, int rbase, int rl, int cg) {
    const int t = t0 + rl; int cnt = 0;
    float s[8];
#pragma unroll
    for (int i = 0; i < 8; ++i) s[i] = 0.f;
    u32x4 c = (u32x4){0u, 0u, 0u, 0u};
#pragma unroll
    for (int w = 0; w < 2 * HALF; ++w) { const int tt = t - HALF + w; const bool ok = tt >= 0 && tt < T;
        u32x4 x = *(const LAS u32x4*)(tile + (rl + 8 - HALF + w) * 1024 + cg * 16); if (!ok) x = (u32x4){0u, 0u, 0u, 0u}; cnt += ok ? 1 : 0; if (w == HALF) c = x;
        s[0] += bflo(x.x); s[1] += bfhi(x.x); s[2] += bflo(x.y); s[3] += bfhi(x.y); s[4] += bflo(x.z); s[5] += bfhi(x.z); s[6] += bflo(x.w); s[7] += bfhi(x.w); }
    const float inv = 1.0f / (float)cnt;
    u32x4 o; o.x = pk2(s[0] * inv - bflo(c.x), s[1] * inv - bfhi(c.x)); o.y = pk2(s[2] * inv - bflo(c.y), s[3] * inv - bfhi(c.y));
    o.z = pk2(s[4] * inv - bflo(c.z), s[5] * inv - bfhi(c.z)); o.w = pk2(s[6] * inv - bflo(c.w), s[7] * inv - bfhi(c.w));
    *(u32x4*)(A2 + (size_t)(rbase + t) * D + 512 + cg * 8) = o;
}

__device__ __forceinline__ void p3a_states_pool(const Frame& F, int l) {
    const bf16_t* P = (const bf16_t*)(F.ws + WS_P);
    bf16_t* ST = (bf16_t*)(F.ws + WS_ACT);
    bf16_t* A2 = hbuf(F);
    const int nstate = (F.G > 128) ? 128 : F.G;
    if (F.bx < nstate) {
        for (int unit = F.bx; unit < 128; unit += nstate) {
            const int dir = unit & 1, bh = unit >> 1, b = bh >> 2, h = bh & 3;
            const float lg2 = log2_gamma((dir ? F.in[I_DB] : F.in[I_DF])[l * NH + h]);
            const float gC = exp2f(lg2 * 128.0f);
            f32x4 acc[8];
#pragma unroll
            for (int dt = 0; dt < 8; ++dt) acc[dt] = (f32x4){0.f, 0.f, 0.f, 0.f};
            u32x4 kr[8], vr[8];
#define P3A_CI(n_) (dir ? ((n_) < 2 ? 1 - (n_) : 19 - (n_)) : (n_))
#define P3A_LOAD(st_) do { _Pragma("unroll") for (int sub = 0; sub < 2; ++sub) { const int r0_ = chunk_row0(b, P3A_CI(2 * (st_) + sub)); \
                _Pragma("unroll") for (int q = 0; q < 4; ++q) { const int p = F.tid + 512 * q, j = p >> 4, ch = p & 15; \
                    kr[sub * 4 + q] = *(const u32x4*)(P + (size_t)(r0_ + j) * NP + 512 + h * 128 + ch * 8); vr[sub * 4 + q] = *(const u32x4*)(P + (size_t)(r0_ + j) * NP + 1024 + h * 128 + ch * 8); } } } while (0)
#define P3A_STORE(n_) do { unsigned char* sp = (unsigned char*)ST + ((size_t)((bh * 2 + dir) * NCHUNK + P3A_CI(n_)) * 128 + (F.wave * 16 + (F.lane & 15))) * 128 + 4 * (F.lane >> 4); \
                _Pragma("unroll") for (int dt = 0; dt < 8; ++dt) *(unsigned*)(sp + dt * 16) = pg8::pk4_fp8(acc[dt][0], acc[dt][1], acc[dt][2], acc[dt][3]); } while (0)
#define P3A_KS(KO, VO, ks) do { bf16x8 ka[8]; tr_frag8<(KO) + (ks) * 8192>(ka, tpk); \
                _Pragma("unroll") for (int dt = 0; dt < 8; ++dt) acc[dt] = __builtin_amdgcn_mfma_f32_16x16x32_bf16(ka[dt], vb[ks], acc[dt], 0, 0, 0); } while (0)
#define P3A_SUB(KO, VO) do { _Pragma("unroll") for (int dt = 0; dt < 8; ++dt) acc[dt] *= gC; \
                bf16x8 vb[4]; tr_frag4<(VO), (VO) + 8192, (VO) + 16384, (VO) + 24576>(vb, tpv, tpv, tpv, tpv); \
                P3A_KS(KO, VO, 0); P3A_KS(KO, VO, 1); P3A_KS(KO, VO, 2); P3A_KS(KO, VO, 3); } while (0)
            P3A_LOAD(0);
            for (int st = 0; st < 9; ++st) {
#pragma unroll
                for (int sub = 0; sub < 2; ++sub)
#pragma unroll
                    for (int q = 0; q < 4; ++q) { const int p = F.tid + 512 * q, j = p >> 4, ch = p & 15;
                        const float kd = __builtin_amdgcn_exp2f(lg2 * (float)(dir ? j : 127 - j));
                        const u32x4 kk = kr[sub * 4 + q];
                        u32x4 ks; ks.x = pk2(bflo(kk.x) * kd, bfhi(kk.x) * kd); ks.y = pk2(bflo(kk.y) * kd, bfhi(kk.y) * kd); ks.z = pk2(bflo(kk.z) * kd, bfhi(kk.z) * kd); ks.w = pk2(bflo(kk.w) * kd, bfhi(kk.w) * kd);
                        *(LAS u32x4*)(F.lds + sub * 32768 + off_b(j, ch)) = ks; *(LAS u32x4*)(F.lds + 65536 + sub * 32768 + off_b(j, ch)) = vr[sub * 4 + q]; }
                LBAR();
                if (st < 8) P3A_LOAD(st + 1);
                const unsigned tpk = (unsigned)(size_t)F.lds + tr_base_p(F.lane); const unsigned tpv = (tpk ^ ((unsigned)F.wave << 5)) + 65536u;
                P3A_STORE(2 * st);
                P3A_SUB(0, 0);
                P3A_STORE(2 * st + 1);
                if (st < 8) P3A_SUB(32768, 32768);
                LBAR();
            }
#undef P3A_SUB
#undef P3A_KS
#undef P3A_STORE
#undef P3A_LOAD
#undef P3A_CI
        }
    } else {
        const int pb = F.bx - nstate, npb = F.G - nstate;
        u32x4 ld[10];
#define POOL_LOAD(tile_) do { const int r0_ = (tile_) * 64; int t0_, T_, rb_; if (r0_ < NLAT) { t0_ = r0_ & (TL - 1); T_ = TL; } else { t0_ = (r0_ - NLAT) & (CT - 1); T_ = CT; } rb_ = r0_ - t0_; \
            _Pragma("unroll") for (int q = 0; q < 10; ++q) { const int p = F.tid + 512 * q, rr = p >> 6, ch = p & 63; int tt = t0_ - 8 + rr; tt = tt < 0 ? 0 : (tt >= T_ ? T_ - 1 : tt); \
                ld[q] = *(const u32x4*)(P + (size_t)(rb_ + tt) * NP + 2048 + ch * 8); } } while (0)
        if (pb < 576) POOL_LOAD(pb);
        for (int tile = pb; tile < 576; tile += npb) {
            const int r0 = tile * 64; int t0, T; if (r0 < NLAT) { t0 = r0 & (TL - 1); T = TL; } else { t0 = (r0 - NLAT) & (CT - 1); T = CT; } const int rbase = r0 - t0;
            LBAR();
#pragma unroll
            for (int q = 0; q < 10; ++q) { const int p = F.tid + 512 * q; *(LAS u32x4*)(F.lds + (p >> 6) * 1024 + (p & 63) * 16) = ld[q]; }
            LBAR();
            if (tile + npb < 576) POOL_LOAD(tile + npb);
            for (int wi = F.wave; wi < 64; wi += 8) { const int g = wi & 3, rl = (wi >> 2) * 4 + (F.lane >> 4), cg = g * 16 + (F.lane & 15);
                if (g == 0) pool_item<1>(F.lds, A2, t0, T, rbase, rl, cg); else if (g == 1) pool_item<2>(F.lds, A2, t0, T, rbase, rl, cg);
                else if (g == 2) pool_item<4>(F.lds, A2, t0, T, rbase, rl, cg); else pool_item<8>(F.lds, A2, t0, T, rbase, rl, cg); }
        }
#undef POOL_LOAD
    }
    __syncthreads();
}

__device__ __forceinline__ void p3b_retention(const Frame& F, int l) {
    const bf16_t* P = (const bf16_t*)(F.ws + WS_P);
    const bf16_t* ST = (const bf16_t*)(F.ws + WS_ACT);
    bf16_t* A2 = hbuf(F);
    const int c_lo = (l == DEPTH - 1) ? 2 : 0, ncu = NCHUNK - c_lo, nunits = 64 * ncu;
    float lgF[NH], lgB[NH];
#pragma unroll
    for (int hh = 0; hh < NH; ++hh) { lgF[hh] = log2_gamma(F.in[I_DF][l * NH + hh]); lgB[hh] = log2_gamma(F.in[I_DB][l * NH + hh]); }
    u32x4 ld[8], st[4]; bf16x8 qf[4];
#define P3B_LOAD(unit_) do { const int bh_ = (unit_) / ncu, ci_ = c_lo + (unit_) % ncu, h_ = bh_ & 3; const int r0_ = chunk_row0(bh_ >> 2, ci_); \
        _Pragma("unroll") for (int q = 0; q < 4; ++q) { const int p = F.tid + 512 * q, j = p >> 4, ch = p & 15; \
            ld[q] = *(const u32x4*)(P + (size_t)(r0_ + j) * NP + 512 + h_ * 128 + ch * 8); ld[4 + q] = *(const u32x4*)(P + (size_t)(r0_ + j) * NP + 1024 + h_ * 128 + ch * 8); } } while (0)
#define P3B_LOADQ(unit_) do { const int bh_ = (unit_) / ncu, ci_ = c_lo + (unit_) % ncu, h_ = bh_ & 3; const int r0_ = chunk_row0(bh_ >> 2, ci_); \
        _Pragma("unroll") for (int ks = 0; ks < 4; ++ks) qf[ks] = *(const bf16x8*)(P + (size_t)(r0_ + F.wave * 16 + (F.lane & 15)) * NP + h_ * 128 + ks * 32 + (F.lane >> 4) * 8); } while (0)
    if (F.vcu < nunits) { P3B_LOAD(F.vcu); P3B_LOADQ(F.vcu); }
    for (int unit = F.vcu; unit < nunits; unit += F.G) {
        int lane_o = F.lane; asm volatile("" : "+v"(lane_o));
        const int fr = lane_o & 15, fq = lane_o >> 4;
        const unsigned rr0 = off_b((unsigned)fr, (unsigned)fq), tp = (unsigned)(size_t)F.lds + tr_base_p((unsigned)lane_o);
        const int il = F.wave * 16 + fr;
        const int bh = unit / ncu, ci = c_lo + unit % ncu, b = bh >> 2, h = bh & 3;
        const float lgf = h == 0 ? lgF[0] : h == 1 ? lgF[1] : h == 2 ? lgF[2] : lgF[3], lgb = h == 0 ? lgB[0] : h == 1 ? lgB[1] : h == 2 ? lgB[2] : lgB[3];
        const int row0 = chunk_row0(b, ci);
        { const unsigned char* sf = (const unsigned char*)ST + ((size_t)((bh * 2 + 0) * NCHUNK + ci) * 128) * 128; const unsigned char* sb = (const unsigned char*)ST + ((size_t)((bh * 2 + 1) * NCHUNK + ci) * 128) * 128;
#pragma unroll
          for (int q = 0; q < 2; ++q) { const int p = F.tid + 512 * q, j = p >> 3, c = p & 7; st[q] = *(const u32x4*)((const unsigned char*)sf + (size_t)j * 128 + c * 16); st[2 + q] = *(const u32x4*)((const unsigned char*)sb + (size_t)j * 128 + c * 16); } }
        LBAR();
#pragma unroll
        for (int q = 0; q < 4; ++q) { const int p = F.tid + 512 * q, j = p >> 4, ch = p & 15; const unsigned o = off_b(j, ch);
            *(LAS u32x4*)(F.lds + o) = ld[q]; *(LAS u32x4*)(F.lds + 32768u + o) = ld[4 + q]; }
        LBAR();
        if (unit + F.G < nunits) P3B_LOAD(unit + F.G);
        u32x2 gg[8];
#pragma unroll
        for (int et = 0; et < 8; ++et) gg[et] = *(const u32x2*)(P + (size_t)(row0 + il) * NP + 1536 + h * 128 + 4 * fq + et * 16);
        bf16x8 pf[4];
#pragma unroll
        for (int ks2 = 0; ks2 < 4; ++ks2) {
            u32x2 half[2];
#pragma unroll
            for (int t = 0; t < 2; ++t) { const int jt = 2 * ks2 + t;
                asm volatile("" ::: "memory");
                f32x4 sa = (f32x4){0.f, 0.f, 0.f, 0.f};
#pragma unroll
                for (int ks = 0; ks < 4; ++ks) { const bf16x8 ka = *(const LAS bf16x8*)(F.lds + ((rr0 ^ ((unsigned)ks << 6)) + 4096u * jt)); sa = __builtin_amdgcn_mfma_f32_16x16x32_bf16(ka, qf[ks], sa, 0, 0, 0); }
                float pv[4];
#pragma unroll
                for (int r = 0; r < 4; ++r) { const int j = 16 * jt + 4 * fq + r, df = il - j;
                    const float w = df > 0 ? __builtin_amdgcn_exp2f(lgf * (float)df) : (df < 0 ? __builtin_amdgcn_exp2f(lgb * (float)(-df)) : 2.0f); pv[r] = sa[r] * w; }
                half[t].x = pk2(pv[0], pv[1]); half[t].y = pk2(pv[2], pv[3]); }
            const u32x4 w4 = (u32x4){half[0].x, half[0].y, half[1].x, half[1].y};
            pf[ks2] = __builtin_bit_cast(bf16x8, w4);
        }
#pragma unroll
        for (int q = 0; q < 2; ++q) { const int p = F.tid + 512 * q, j = p >> 3, c = p & 7;
#pragma unroll
            for (int sd = 0; sd < 2; ++sd) { const u32x4 w = st[2 * sd + q];
                u32x4 lo, hi;
                lo.x = pk2(__builtin_amdgcn_cvt_f32_fp8((int)w.x, 0), __builtin_amdgcn_cvt_f32_fp8((int)w.x, 1)); lo.y = pk2(__builtin_amdgcn_cvt_f32_fp8((int)w.x, 2), __builtin_amdgcn_cvt_f32_fp8((int)w.x, 3));
                lo.z = pk2(__builtin_amdgcn_cvt_f32_fp8((int)w.y, 0), __builtin_amdgcn_cvt_f32_fp8((int)w.y, 1)); lo.w = pk2(__builtin_amdgcn_cvt_f32_fp8((int)w.y, 2), __builtin_amdgcn_cvt_f32_fp8((int)w.y, 3));
                hi.x = pk2(__builtin_amdgcn_cvt_f32_fp8((int)w.z, 0), __builtin_amdgcn_cvt_f32_fp8((int)w.z, 1)); hi.y = pk2(__builtin_amdgcn_cvt_f32_fp8((int)w.z, 2), __builtin_amdgcn_cvt_f32_fp8((int)w.z, 3));
                hi.z = pk2(__builtin_amdgcn_cvt_f32_fp8((int)w.w, 0), __builtin_amdgcn_cvt_f32_fp8((int)w.w, 1)); hi.w = pk2(__builtin_amdgcn_cvt_f32_fp8((int)w.w, 2), __builtin_amdgcn_cvt_f32_fp8((int)w.w, 3));
                const unsigned img = sd ? 98304u : 65536u;
                *(LAS u32x4*)(F.lds + img + off_b(j, 2 * c)) = lo; *(LAS u32x4*)(F.lds + img + off_b(j, 2 * c + 1)) = hi; } }
        LBAR();
        const float qdf = __builtin_amdgcn_exp2f(lgf * (float)(il + 1)), qdb = __builtin_amdgcn_exp2f(lgb * (float)(128 - il));
        float o[8][4]; float ss = 0.f;
#pragma unroll
        for (int et = 0; et < 8; ++et) {
            f32x4 ao = (f32x4){0.f, 0.f, 0.f, 0.f}, af = ao, ab = ao;
            bf16x8 va[4]; { const unsigned a = tp ^ ((unsigned)et << 5); tr_frag4<32768, 32768 + 8192, 32768 + 16384, 32768 + 24576>(va, a, a, a, a); }
#pragma unroll
            for (int ks = 0; ks < 4; ++ks) {
                ao = __builtin_amdgcn_mfma_f32_16x16x32_bf16(va[ks], pf[ks], ao, 0, 0, 0);
                const unsigned ra = (rr0 ^ ((unsigned)ks << 6)) + 4096u * et;
                const bf16x8 fa = *(const LAS bf16x8*)(F.lds + 65536u + ra);
                af = __builtin_amdgcn_mfma_f32_16x16x32_bf16(fa, qf[ks], af, 0, 0, 0);
                const bf16x8 ba = *(const LAS bf16x8*)(F.lds + 98304u + ra);
                ab = __builtin_amdgcn_mfma_f32_16x16x32_bf16(ba, qf[ks], ab, 0, 0, 0);
            }
#pragma unroll
            for (int r = 0; r < 4; ++r) { o[et][r] = ao[r] + qdf * af[r] + qdb * ab[r]; ss += o[et][r] * o[et][r]; }
        }
        if (unit + F.G < nunits) P3B_LOADQ(unit + F.G);
        ss += __shfl_xor(ss, 16); ss += __shfl_xor(ss, 32);
        const float rstd = 1.0f / sqrtf(ss * (1.0f / 128.0f) + EPS);
        bf16_t* op = A2 + (size_t)(row0 + il) * D + h * 128 + 4 * fq;
#pragma unroll
        for (int et = 0; et < 8; ++et) { const u32x2 g = gg[et];
            u32x2 w; w.x = pk2(silu_f(bflo(g.x)) * o[et][0] * rstd, silu_f(bfhi(g.x)) * o[et][1] * rstd); w.y = pk2(silu_f(bflo(g.y)) * o[et][2] * rstd, silu_f(bfhi(g.y)) * o[et][3] * rstd);
            *(u32x2*)(op + et * 16) = w; }
    }
#undef P3B_LOAD
#undef P3B_LOADQ
    __syncthreads();
}

#ifndef TYPE_MASK
#define TYPE_MASK 0x3ff
#endif
#define PTYPE(k) ((k) == 0 ? 0 : ((k) == 17 ? 9 : 1 + (((k) - 1) & 7)))
#define ENTER() do { if (PROBE_REPEAT >= 0) __syncthreads(); int _t = threadIdx.x; asm volatile("" : "+v"(_t)); F.tid = _t; F.lane = _t & 63; F.wave = __builtin_amdgcn_readfirstlane(_t >> 6); } while (0)
#define IN(k) (((TYPE_MASK >> PTYPE(k)) & 1) && lo <= (k) && (k) < hi)
#define SEAM(k) do { if (IN(k) && IN((k) + 1)) xcd_barrier(bar); } while (0)
#define REP(t) for (int rep = (PROBE_REPEAT == (t)) ? 0 : 1; rep < 2; ++rep)


template <int l> __device__ __forceinline__ void layer_phases(Frame& F, const XcdBarrier& bar, const int lo, const int hi) {
        const int pb = 1 + 8 * l;
        const bool last = (l == DEPTH - 1);
        const int Mrows = last ? NLAT : NTOK;
        if (IN(pb + 0)) REP(1) { ENTER(); row_op_a(F, l == 0 ? 0 : 1, rep == 0); }
        SEAM(pb + 0);
        if (IN(pb + 1)) REP(2) { ENTER();
            pg8::SchedDense S; S.init(NTOK, NP, D, F.G, F.bx);
            pg8::EpiInProj E{(bf16_t*)(F.ws + WS_P), (const float*)(F.ws + WS_ROPE), (const float*)(F.ws + WS_ROPE) + 96 * 32};
            pg8::gemm_phase<pg8::EpiInProj, pg8::SchedDense, true, true>(F.lds, F.tid, (const char*)hbuf(F), (const char*)(F.ws + WS_WIN) + (size_t)l * NP * D * 2, D, S, E);
        }
        SEAM(pb + 1);
        if (IN(pb + 2)) REP(3) { ENTER(); p3a_states_pool(F, l); }
        SEAM(pb + 2);
        if (IN(pb + 3)) REP(4) { ENTER(); p3b_retention(F, l); }
        SEAM(pb + 3);
        if (IN(pb + 4)) REP(5) { ENTER();
            pg8::SchedDense S; S.init(Mrows, D, D, F.G, F.bx);
            pg8::EpiResid E;
            if (l == 0) { E.rl = F.in[I_X]; E.rc = F.in[I_CTX]; E.rb = nullptr; } else { E.rl = nullptr; E.rc = nullptr; E.rb = (const bf16_t*)(F.ws + WS_XB); }
            E.ob = (rep == 0) ? (bf16_t*)(F.ws + WS_P) : (bf16_t*)(F.ws + WS_XB); E.ssq = (float*)(F.ws + WS_SSQ); E.gmod = mod_ptr(F, l, 0, 2);
            pg8::gemm_phase<pg8::EpiResid, pg8::SchedDense, true, true>(F.lds, F.tid, (const char*)hbuf(F), (const char*)(F.ws + WS_WOUT) + (size_t)l * D * D * 2, D, S, E);
        }
        SEAM(pb + 4);
        if (IN(pb + 5)) REP(6) { ENTER(); if (PROBE_REPEAT == 6 && rep == 0) row_op_b<true>(F, l); else row_op_b<false>(F, l); }
        SEAM(pb + 5);
        if (IN(pb + 6)) REP(7) { ENTER();
            LAS int* tb = build_tb(F, l);
            LAS int* tokt = (LAS int*)(F.lds + TOKT_OFF);
            const int* list = (const int*)(F.ws + WS_LIST);
            pg8::SchedGroup S; S.tb = tb; S.tokt = tokt; S.G = F.G; S.c = F.vcu; S.pitch = D; S.gather = 1;
            { int tokv[8];
#pragma unroll
              for (int i = 0; i < 8; ++i) { pg8::Unit u; tokv[i] = -1;
                  if (S.next(i, u)) { const int g = u.pm; const int e = (int)__popcll(__ballot(F.lane < NE && tb[F.lane + 1] <= g)); const int rt = g - tb[e], cnt = tb[64 + e];
                      if (F.tid < 256) { int r = rt * 256 + F.tid; if (r >= cnt) r = cnt - 1; tokv[i] = list[(size_t)e * NTOK + r]; } } }
#pragma unroll
              for (int i = 0; i < 8; ++i) if (F.tid < 256 && tokv[i] >= 0) tokt[i * 256 + F.tid] = tokv[i]; }
            __syncthreads();
            pg8::EpiSwiGLU8 E{(unsigned char*)(F.ws + WS_ACT), 1.0f / WGU_SCALE};
            pg8::gemm_phase<pg8::EpiSwiGLU8, pg8::SchedGroup, true, true, true>(F.lds, F.tid, (const char*)hbuf(F), (const char*)(F.ws + WS_WGU) + (size_t)l * NE * 1024 * D, D, S, E);
        }
        SEAM(pb + 6);
        if (IN(pb + 7)) REP(8) { ENTER();
            LAS int* tb = build_tb(F, l);
            pg8::SchedGroup S; S.tb = tb; S.tokt = nullptr; S.G = F.G; S.c = F.vcu; S.pitch = FF; S.gather = 0;
            pg8::EpiFp8S E{(unsigned char*)(F.ws + WS_P), D, 1.0f / WD_SCALE};
            pg8::gemm_phase<pg8::EpiFp8S, pg8::SchedGroup, true, true, true>(F.lds, F.tid, (const char*)(F.ws + WS_ACT), (const char*)(F.ws + WS_WD) + (size_t)l * NE * D * FF, FF, S, E);
        }
        SEAM(pb + 7);
}

__global__ void __launch_bounds__(512, 2) fwd_kernel(Args args) {
    extern __shared__ __attribute__((aligned(16))) unsigned char lds_raw[];
    Frame F;
    F.lds = (LAS unsigned char*)lds_raw; F.tid = threadIdx.x; F.lane = F.tid & 63; F.wave = __builtin_amdgcn_readfirstlane(F.tid >> 6);
    F.G = gridDim.x; F.bx = blockIdx.x; F.vcu = (F.G % 8 == 0) ? (F.bx % 8) * (F.G / 8) + F.bx / 8 : F.bx;
    F.in = args.in; F.out = args.out; F.ws = args.ws;
    volatile LAS unsigned* MISC = (volatile LAS unsigned*)(F.lds + MISC_OFF);
    if (F.tid < 4) MISC[F.tid] = 0u;
    __syncthreads();
    unsigned* ctl = (unsigned*)(F.ws + WS_CTL);
    XcdBarrier bar; bar.bar = ctl + CW_BAR; bar.x = 0; bar.st = nullptr;
    const int lo = args.ph_lo, hi = args.ph_hi;
    const bool multi = (hi - lo) > 1;
    if (multi) bar = xcd_barrier_post(ctl + CW_BAR, MISC);
    if (IN(0)) REP(0) { ENTER(); p0_prologue(F, rep); }
    SEAM(0);
    layer_phases<0>(F, bar, lo, hi);
    layer_phases<1>(F, bar, lo, hi);
    if (IN(17)) REP(9) { ENTER(); row_op_a(F, 2, rep == 0); }
#undef IN
#undef SEAM
}

extern "C" void kernel_launch(void* const* d_in, const int* in_sizes, int n_in, void* d_out, int out_size, void* d_ws, size_t ws_size, hipStream_t stream) {
    static int grid = 0;
    if (grid == 0) {
        if (n_in != 22 || out_size != NLAT * D || ws_size < WS_END) { fprintf(stderr, "kernel_launch: unexpected shapes (n_in %d, out %d, ws %zu)\n", n_in, out_size, ws_size); grid = -1; return; }
        int dev = 0, cus = 0, per_cu = 0;
        if (hipGetDevice(&dev) != hipSuccess || hipDeviceGetAttribute(&cus, hipDeviceAttributeMultiprocessorCount, dev) != hipSuccess) { grid = -1; return; }
        if (hipFuncSetAttribute((const void*)fwd_kernel, hipFuncAttributeMaxDynamicSharedMemorySize, LDS_BYTES) != hipSuccess) { fprintf(stderr, "kernel_launch: hipFuncSetAttribute failed\n"); grid = -1; return; }
        if (hipOccupancyMaxActiveBlocksPerMultiprocessor(&per_cu, (const void*)fwd_kernel, 512, LDS_BYTES) != hipSuccess || per_cu < 1) { fprintf(stderr, "kernel_launch: occupancy query says %d\n", per_cu); }
        (void)hipGetLastError();
        grid = cus;
    }
    if (grid < 0) return;
    (void)hipMemsetAsync((char*)d_ws + WS_CTL, 0, CTL_ZERO_BYTES, stream);
    Args a{};
    for (int i = 0; i < 22; ++i) a.in[i] = (const float*)d_in[i];
    a.out = (float*)d_out; a.ws = (unsigned char*)d_ws;
    if (MK_N_LAUNCHES == 1) { a.ph_lo = 0; a.ph_hi = N_PHASES; hipLaunchKernelGGL(fwd_kernel, dim3(grid), dim3(512), LDS_BYTES, stream, a); }
    else { for (int p = 0; p < N_PHASES; ++p) { a.ph_lo = p; a.ph_hi = p + 1; hipLaunchKernelGGL(fwd_kernel, dim3(grid), dim3(512), LDS_BYTES, stream, a); } }
}
```

```cpp
#include <hip/hip_runtime.h>
#include <cstdio>
#include <cstdint>

#ifndef MK_N_LAUNCHES
#define MK_N_LAUNCHES 1
#endif

#ifndef PROBE_REPEAT
#define PROBE_REPEAT -1
#endif
#define LAS __attribute__((address_space(3)))
#define GAS __attribute__((address_space(1)))
typedef unsigned short bf16_t;
typedef short bf16x8 __attribute__((ext_vector_type(8)));
typedef short s16x4 __attribute__((ext_vector_type(4)));
typedef float f32x4 __attribute__((ext_vector_type(4)));
typedef float f32x2 __attribute__((ext_vector_type(2)));
typedef unsigned u32x4 __attribute__((ext_vector_type(4)));
typedef unsigned u32x2 __attribute__((ext_vector_type(2)));

constexpr int Bn = 16, TL = 2048, CT = 256, D = 1024, DEPTH = 2;
constexpr int NLAT = Bn * TL, NCTX = Bn * CT, NTOK = NLAT + NCTX;
constexpr int NP = 2560;
constexpr int NE = 32, FF = 512, NH = 4, HD = 128;
constexpr int NCHUNK = 18;
constexpr float EPS = 1e-6f;
constexpr int MAXTILES = 320;
constexpr int N_PHASES = 18;

constexpr size_t MiB = 1u << 20;
constexpr size_t WS_CTL = 0, CTL_ZERO_BYTES = 1 * MiB;
constexpr size_t WS_MOD = 1 * MiB;
constexpr size_t WS_ROPE = 2 * MiB;
constexpr size_t WS_RIMG = 2 * MiB + 65536;
constexpr size_t WS_TOKINFO = 3 * MiB;
constexpr size_t WS_LIST = 5 * MiB;
constexpr size_t WS_WIN = 10 * MiB;
constexpr size_t WS_WOUT = 20 * MiB;
constexpr size_t WS_WGU = 24 * MiB;
constexpr size_t WS_WD = 152 * MiB;
constexpr size_t WS_SSQ = 216 * MiB;
constexpr size_t WS_XB = 232 * MiB;
constexpr size_t WS_P = 304 * MiB;
constexpr size_t WS_ACT = 484 * MiB;
constexpr size_t WS_END = 564 * MiB;
constexpr int CW_TMO = 0;
constexpr int CW_QUEUE = 512;
constexpr int CW_CNT = 1024;
constexpr int CW_BAR = 4096;

constexpr int RING_BYTES = 131072;
constexpr int TOKT_OFF = RING_BYTES;
constexpr int MISC_OFF = 161792;
constexpr int RW_PITCH = 2064;
constexpr int RW_LO = 36 * RW_PITCH, RW_EX = 2 * 36 * RW_PITCH;
constexpr int LDS_BYTES = 163840;

__device__ __forceinline__ unsigned f2bf(float f) { unsigned u = __builtin_bit_cast(unsigned, f); return (u + 0x7fffu + ((u >> 16) & 1u)) >> 16; }
typedef __bf16 bf16x2_t __attribute__((ext_vector_type(2)));
__device__ __forceinline__ unsigned pk2(float lo, float hi) { const f32x2 f = {lo, hi}; const bf16x2_t v = __builtin_convertvector(f, bf16x2_t); return __builtin_bit_cast(unsigned, v); }
__device__ __forceinline__ float bflo(unsigned w) { return __builtin_bit_cast(float, w << 16); }
__device__ __forceinline__ float bfhi(unsigned w) { return __builtin_bit_cast(float, w & 0xffff0000u); }
__device__ __forceinline__ float wave_sum(float v) {
#pragma unroll
    for (int o = 1; o < 64; o <<= 1) v += __shfl_xor(v, o);
    return v;
}
__device__ __forceinline__ float silu_f(float x) { return x * __builtin_amdgcn_rcpf(1.0f + __builtin_amdgcn_exp2f(-1.4426950408889634f * x)); }

#define XB_TMO      128
#define XB_XCNT(j)  (256  + 64 * (j))
#define XB_XSUB(j)  (1280 + 64 * (j))
#define XB_XGEN(j)  (2304 + 64 * (j))
#define XB_TOP      3328
#define XB_TOPGEN   3392
#define XCD_BAR_WORDS 3456
#define XB_SPIN_CAP (1u << 18)
__device__ __forceinline__ unsigned xb_ld(unsigned* p)              { return __hip_atomic_load(p, __ATOMIC_RELAXED, __HIP_MEMORY_SCOPE_AGENT); }
__device__ __forceinline__ unsigned xb_add(unsigned* p, unsigned v) { return __hip_atomic_fetch_add(p, v, __ATOMIC_RELAXED, __HIP_MEMORY_SCOPE_AGENT); }
__device__ __forceinline__ unsigned xb_xcc_id() { return (unsigned)__builtin_amdgcn_s_getreg((3 << 11) | 20) & 0xFu; }
#define XB_SPIN(cond, bar) do { unsigned _sp = 0; while (cond) { __builtin_amdgcn_s_sleep(1); \
    if ((++_sp & 255u) == 0u) { if (xb_ld(&(bar)[XB_TMO])) break; if (_sp > XB_SPIN_CAP) { atomicAdd(&(bar)[XB_TMO], 1u); break; } } } } while (0)
struct XcdBarrier { unsigned* bar; unsigned x; volatile LAS unsigned* st; };
__device__ __forceinline__ XcdBarrier xcd_barrier_post(unsigned* bar, volatile LAS unsigned* st) {
    XcdBarrier b; b.bar = bar; b.x = xb_xcc_id(); b.st = st;
    if (threadIdx.x == 0) (void)xb_add(&bar[XB_XCNT(b.x)], 1u);
    return b;
}
__device__ __forceinline__ void xcd_barrier_complete(unsigned* bar, unsigned x, unsigned& nloc, unsigned& nx) {
    const unsigned G = gridDim.x * gridDim.y * gridDim.z;
    unsigned sum, cnt, mine, sp = 0u;
    for (;;) {
        sum = 0u; cnt = 0u; mine = 0u;
#pragma unroll
        for (unsigned j = 0; j < 16; ++j) { const unsigned c = xb_ld(&bar[XB_XCNT(j)]); sum += c; cnt += (c > 0u) ? 1u : 0u; mine = (j == x) ? c : mine; }
        if (sum == G) break;
        __builtin_amdgcn_s_sleep(1);
        if ((++sp & 255u) == 0u) { if (xb_ld(&bar[XB_TMO])) break; if (sp > XB_SPIN_CAP) { atomicAdd(&bar[XB_TMO], 1u); break; } }
    }
    nloc = mine > 0u ? mine : 1u; nx = cnt > 0u ? cnt : 1u;
}
__device__ __forceinline__ void xcd_barrier(const XcdBarrier& b) {
    asm volatile("s_waitcnt vmcnt(0)" ::: "memory");
    __syncthreads();
    if (threadIdx.x == 0) {
        unsigned* bar = b.bar;
        __builtin_amdgcn_s_waitcnt(0);
        unsigned nloc = b.st[0], nx = b.st[1];
        if (nloc == 0u) { xcd_barrier_complete(bar, b.x, nloc, nx); b.st[0] = nloc; b.st[1] = nx; }
        const unsigned old = xb_add(&bar[XB_XSUB(b.x)], 1u);
        const unsigned gen = old / nloc;
        if (old + 1u == (gen + 1u) * nloc) {
            __builtin_amdgcn_fence(__ATOMIC_RELEASE, "agent");
            asm volatile("s_waitcnt vmcnt(0)" ::: "memory");
            const unsigned og = xb_add(&bar[XB_TOP], 1u);
            const unsigned tg = og / nx;
            if (og + 1u == (tg + 1u) * nx) xb_add(&bar[XB_TOPGEN], 1u);
            else XB_SPIN(xb_ld(&bar[XB_TOPGEN]) == tg, bar);
            __builtin_amdgcn_fence(__ATOMIC_ACQUIRE, "agent");
            xb_add(&bar[XB_XGEN(b.x)], 1u);
            asm volatile("s_waitcnt vmcnt(0)" ::: "memory");
        } else {
            XB_SPIN(xb_ld(&bar[XB_XGEN(b.x)]) == gen, bar);
            __builtin_amdgcn_fence(__ATOMIC_ACQUIRE, "agent");
            asm volatile("s_waitcnt vmcnt(0)" ::: "memory");
        }
    }
    __syncthreads();
}

namespace pg8 {
constexpr int BM = 256, BK = 64, HALF = 128, HTB = HALF * BK * 2, STAGE_BYTES = 8 * HTB, NXCD = 8, WGM = 8;
__device__ __forceinline__ int lds_byte(int r, int c) { const int st = (r >> 4) * 2 + (c >> 5), rr = r & 15, cc = c & 31, ob = rr * 64 + cc * 2; return st * 1024 + (ob ^ (((ob >> 9) & 1) << 5)); }
__device__ __forceinline__ void stage_rc(int b, int& R, int& C) { const int st = b / 1024, sb = b % 1024, swz = sb ^ (((sb >> 9) & 1) << 5); R = (st >> 1) * 16 + swz / 64; C = (st & 1) * 32 + (swz % 64) / 2; }
__device__ __forceinline__ int perm32(int rho) { const int n = rho >> 4, i = rho & 15; return 8 * (i >> 2) + 4 * n + (i & 3); }

struct Unit { int pm, pn; unsigned bofs; int aux; };

struct SchedDense {
    int nM, nN, nwg, G, c, K;
    __device__ void init(int M, int N, int K_, int G_, int c_) { nM = M / BM; nN = N / BM; nwg = nM * nN; G = G_; c = c_; K = K_; }
    __device__ bool next(int i, Unit& u) const {
        const long L = (long)i * G + c; if (L >= nwg) return false;
        int wgid = (int)L; { const int q = nwg / NXCD, r = nwg % NXCD, xcd = wgid % NXCD, off = wgid / NXCD; wgid = (xcd < r ? xcd * (q + 1) : r * (q + 1) + (xcd - r) * q) + off; }
        const int nig = WGM * nN, gid = wgid / nig, fm = gid * WGM, gsz = (nM - fm) < WGM ? (nM - fm) : WGM;
        u.pm = fm + ((wgid % nig) % gsz); u.pn = (wgid % nig) / gsz; u.bofs = (unsigned)u.pn * (unsigned)(BM * K * 2); u.aux = 0; return true;
    }
    __device__ __forceinline__ unsigned a_row(const Unit& u, int r) const { return (unsigned)(u.pm * BM + r); }
};
struct SchedGroup {
    const LAS int* tb; const LAS int* tokt; int G, c, pitch, gather;
    __device__ bool next(int i, Unit& u) const {
        const int L = i * G + c, nt = tb[NE]; if (L >= nt * 4) return false;
        const int g = L >> 2; const int ln = (int)(threadIdx.x & 63u);
        const int e = (int)__popcll(__ballot(ln < NE && tb[ln + 1] <= g));
        u.pm = g; u.pn = L & 3; u.bofs = (unsigned)(e * 1024 + u.pn * BM) * (unsigned)pitch; u.aux = i; return true;
    }
    __device__ __forceinline__ unsigned a_row(const Unit& u, int r) const { return gather ? (unsigned)tokt[u.aux * 256 + r] : (unsigned)(u.pm * BM + r); }
};

__device__ __forceinline__ unsigned cvt_pk_bf16(float lo, float hi) { unsigned r; asm volatile("v_cvt_pk_bf16_f32 %0, %1, %2" : "=v"(r) : "v"(lo), "v"(hi)); return r; }

typedef int i32x4 __attribute__((ext_vector_type(4)));
typedef int i32x8 __attribute__((ext_vector_type(8)));
template <bool F8> struct Frag { bf16x8 k[2]; };
template <> struct Frag<true> { i32x8 v; };
template <class Epi, class Sched, bool ALIGN_EPI, bool SP2, bool F8 = false>
__device__ __forceinline__ void gemm_phase(LAS unsigned char* lds, const int tid, const char* Abase, const char* Bbase, const int K, const Sched& S, const Epi& E) {
    const int wid = __builtin_amdgcn_readfirstlane(tid >> 6), lane = tid & 63, wr = wid >> 2, wc = wid & 3, fr = lane & 15, fq = lane >> 4;
    const int nt = F8 ? K / 128 : K / BK; const unsigned pitch = F8 ? (unsigned)K : 2u * (unsigned)K;
    int Rr[2], Cc[2]; unsigned voffB[2];
#pragma unroll
    for (int i = 0; i < 2; ++i) { int R, C; stage_rc(tid * 16 + i * 8192, R, C); const int Rb = Epi::PERM ? ((R & ~31) + perm32(R & 31)) : R;
        Rr[i] = R; Cc[i] = C; voffB[i] = (unsigned)Rb * pitch + 2u * (unsigned)C; }
    const size_t kstep = (size_t)(BK * 2);
    const size_t hstep = (size_t)HALF * pitch;
    const unsigned ldsw = (unsigned)wid * 1024u;
    const int fcol = F8 ? (fq >> 1) * 32 + (fq & 1) * 16 : fq * 8;
    const int aoff = lds_byte(wr * 64 + fr, fcol), boff = lds_byte(wc * 32 + fr, fcol);
#define PG8_SA(b, h) (((b) * 2 + (h)) * HTB)
#define PG8_SB(b, h) ((4 + (b) * 2 + (h)) * HTB)
#define PG8_STAGE(bufoff, gbase, voff) do { _Pragma("unroll") for (int _i = 0; _i < 2; ++_i) \
        __builtin_amdgcn_global_load_lds((const unsigned*)((const char*)(gbase) + (voff)[_i]), (LAS unsigned*)(lds + (bufoff) + ldsw + _i * 8192), 16, 0, 0); } while (0)
#define PG8_LDF(dstf, off_) do { if constexpr (F8) { const i32x4 _lo = *(const LAS i32x4*)(lds + (off_)), _hi = *(const LAS i32x4*)(lds + (off_) + 16); dstf.v = __builtin_shufflevector(_lo, _hi, 0, 1, 2, 3, 4, 5, 6, 7); } \
        else { dstf.k[0] = *(const LAS bf16x8*)(lds + (off_)); dstf.k[1] = *(const LAS bf16x8*)(lds + (off_) + 1024); } } while (0)
#define PG8_LDA(dst, b, h) do { _Pragma("unroll") for (int m = 0; m < 4; ++m) PG8_LDF(dst[m], PG8_SA(b, h) + aoff + m * 2048); } while (0)
#define PG8_LDB(dst, b, h) do { _Pragma("unroll") for (int n = 0; n < 2; ++n) PG8_LDF(dst[n], PG8_SB(b, h) + boff + n * 2048); } while (0)
#define PG8_MMA(ai, bj, At, Bt) do { __builtin_amdgcn_s_setprio(1); _Pragma("unroll") for (int m = 0; m < 4; ++m) _Pragma("unroll") for (int n = 0; n < 2; ++n) { \
        if constexpr (F8) asm volatile("v_mfma_f32_16x16x128_f8f6f4 %0, %1, %2, %0" : "+v"(acc[ai][bj][m][n]) : "v"(Bt[n].v), "v"(At[m].v));   \
        else { _Pragma("unroll") for (int k = 0; k < 2; ++k) acc[ai][bj][m][n] = __builtin_amdgcn_mfma_f32_16x16x32_bf16(Bt[n].k[k], At[m].k[k], acc[ai][bj][m][n], 0, 0, 0); } } \
        __builtin_amdgcn_s_setprio(0); } while (0)
#define PG8_WAIT_V(n) asm volatile("s_waitcnt vmcnt(" #n ")" ::: "memory")
#define PG8_WAIT_L(n) asm volatile("s_waitcnt lgkmcnt(" #n ")" ::: "memory")
#define PG8_BAR __builtin_amdgcn_s_barrier()
#define PG8_SCHED __builtin_amdgcn_sched_barrier(0)
#define PG8_AOFF(dst, u) do { _Pragma("unroll") for (int _h = 0; _h < 2; ++_h) _Pragma("unroll") for (int _i = 0; _i < 2; ++_i) \
        dst[_h][_i] = S.a_row(u, _h * HALF + Rr[_i]) * pitch + 2u * (unsigned)Cc[_i]; } while (0)
    Unit cur, nxt; int ui = 0;
    if (!S.next(0, cur)) return;
    f32x4 acc[2][2][4][2];
#pragma unroll
    for (int a = 0; a < 2; ++a)
#pragma unroll
        for (int b = 0; b < 2; ++b)
#pragma unroll
            for (int m = 0; m < 4; ++m)
#pragma unroll
                for (int n = 0; n < 2; ++n) acc[a][b][m][n] = (f32x4){0.f, 0.f, 0.f, 0.f};
    Frag<F8> At[4], B0[2], B1[2];
    unsigned co[2][2], no[2][2];
    PG8_AOFF(co, cur);
    const char* cB = Bbase + cur.bofs;
    if constexpr (SP2) {
        PG8_STAGE(PG8_SB(0, 0), cB, voffB); PG8_STAGE(PG8_SB(0, 1), cB + hstep, voffB); PG8_STAGE(PG8_SA(0, 0), Abase, co[0]); PG8_STAGE(PG8_SA(0, 1), Abase, co[1]);
        if (wr == 1) PG8_BAR;
        PG8_WAIT_V(2); PG8_BAR;
        PG8_STAGE(PG8_SB(1, 0), cB + kstep, voffB); PG8_STAGE(PG8_SA(1, 0), Abase + kstep, co[0]); PG8_STAGE(PG8_SB(1, 1), cB + hstep + kstep, voffB);
        PG8_WAIT_V(6); PG8_BAR;
    } else {
        PG8_STAGE(PG8_SB(0, 0), cB, voffB); PG8_STAGE(PG8_SA(0, 0), Abase, co[0]); PG8_STAGE(PG8_SB(0, 1), cB + hstep, voffB); PG8_STAGE(PG8_SA(0, 1), Abase, co[1]);
        if (wr == 1) PG8_BAR;
        PG8_WAIT_V(4); PG8_BAR;
        PG8_STAGE(PG8_SB(1, 0), cB + kstep, voffB); PG8_STAGE(PG8_SA(1, 0), Abase + kstep, co[0]); PG8_STAGE(PG8_SB(1, 1), cB + hstep + kstep, voffB);
        PG8_WAIT_V(6); PG8_BAR;
    }
    for (;;) {
        const bool has_next = S.next(ui + 1, nxt);
        const char* nB = has_next ? Bbase + nxt.bofs : cB;
        if (has_next) { PG8_AOFF(no, nxt); } else {
#pragma unroll
            for (int h = 0; h < 2; ++h)
#pragma unroll
                for (int i = 0; i < 2; ++i) no[h][i] = co[h][i]; }
#pragma unroll 1
        for (int t = 0; t < nt; t += 2) {
            const bool last = (t == nt - 2);
            const char* a1 = Abase + (size_t)(t + 1) * kstep;
            const char* a2 = last ? Abase : Abase + (size_t)(t + 2) * kstep; const char* b2 = last ? nB : cB + (size_t)(t + 2) * kstep;
            const char* a3 = a2 + kstep; const char* b3 = b2 + kstep;
            unsigned o2[2][2];
#pragma unroll
            for (int h = 0; h < 2; ++h)
#pragma unroll
                for (int i = 0; i < 2; ++i) o2[h][i] = last ? no[h][i] : co[h][i];
            if constexpr (SP2) {
            PG8_LDB(B0, 0, 0); PG8_LDB(B1, 0, 1); PG8_SCHED; PG8_LDA(At, 0, 0); PG8_STAGE(PG8_SA(1, 1), a1, co[1]);
            PG8_WAIT_V(8); PG8_WAIT_L(0); PG8_BAR; PG8_MMA(0, 0, At, B0); PG8_MMA(0, 1, At, B1); PG8_BAR; PG8_SCHED;
            PG8_LDA(At, 0, 1); PG8_STAGE(PG8_SB(0, 0), b2, voffB); PG8_STAGE(PG8_SB(0, 1), b2 + hstep, voffB); PG8_STAGE(PG8_SA(0, 0), a2, o2[0]);
            PG8_WAIT_V(8); PG8_WAIT_L(0); PG8_BAR; PG8_MMA(1, 0, At, B0); PG8_MMA(1, 1, At, B1); PG8_BAR; PG8_SCHED;
            PG8_LDB(B0, 1, 0); PG8_LDB(B1, 1, 1); PG8_SCHED; PG8_LDA(At, 1, 0); PG8_STAGE(PG8_SA(0, 1), a2, o2[1]);
            PG8_WAIT_V(8); PG8_WAIT_L(0); PG8_BAR; PG8_MMA(0, 0, At, B0); PG8_MMA(0, 1, At, B1); PG8_BAR; PG8_SCHED;
            PG8_LDA(At, 1, 1); PG8_STAGE(PG8_SB(1, 0), b3, voffB); PG8_STAGE(PG8_SB(1, 1), b3 + hstep, voffB); PG8_STAGE(PG8_SA(1, 0), a3, o2[0]);
            PG8_WAIT_V(8); PG8_WAIT_L(0); PG8_BAR; PG8_MMA(1, 0, At, B0); PG8_MMA(1, 1, At, B1); PG8_BAR; PG8_SCHED;
            } else {
            PG8_LDB(B0, 0, 0); PG8_SCHED; PG8_LDA(At, 0, 0); PG8_STAGE(PG8_SA(1, 1), a1, co[1]);
            PG8_WAIT_L(8); PG8_BAR; PG8_WAIT_L(0); PG8_MMA(0, 0, At, B0); PG8_BAR; PG8_SCHED;
            PG8_LDB(B1, 0, 1); PG8_STAGE(PG8_SB(0, 0), b2, voffB);
            PG8_BAR; PG8_WAIT_L(0); PG8_MMA(0, 1, At, B1); PG8_BAR;
            PG8_LDA(At, 0, 1); PG8_STAGE(PG8_SA(0, 0), a2, o2[0]);
            PG8_BAR; PG8_WAIT_L(0); PG8_MMA(1, 0, At, B0); PG8_BAR; PG8_SCHED;
            PG8_STAGE(PG8_SB(0, 1), b2 + hstep, voffB);
            PG8_WAIT_V(6); PG8_BAR; PG8_MMA(1, 1, At, B1); PG8_BAR;
            PG8_LDB(B0, 1, 0); PG8_SCHED; PG8_LDA(At, 1, 0); PG8_STAGE(PG8_SA(0, 1), a2, o2[1]);
            PG8_WAIT_L(8); PG8_BAR; PG8_WAIT_L(0); PG8_MMA(0, 0, At, B0); PG8_BAR; PG8_SCHED;
            PG8_LDB(B1, 1, 1); PG8_STAGE(PG8_SB(1, 0), b3, voffB);
            PG8_BAR; PG8_WAIT_L(0); PG8_MMA(0, 1, At, B1); PG8_BAR;
            PG8_LDA(At, 1, 1); PG8_STAGE(PG8_SA(1, 0), a3, o2[0]);
            PG8_BAR; PG8_WAIT_L(0); PG8_MMA(1, 0, At, B0); PG8_BAR; PG8_SCHED;
            PG8_STAGE(PG8_SB(1, 1), b3 + hstep, voffB);
            PG8_WAIT_V(6); PG8_BAR; PG8_MMA(1, 1, At, B1); PG8_BAR;
            }
        }
        if constexpr (ALIGN_EPI) { if (wr == 0) PG8_BAR; }
        if constexpr (F8) { __builtin_amdgcn_sched_barrier(0); asm volatile("s_nop 15\n\ts_nop 15\n\ts_nop 7" ::: "memory"); __builtin_amdgcn_sched_barrier(0); }
        E(acc, cur, wr, wc, fr, fq);
        if (!has_next) break;
#pragma unroll
        for (int a = 0; a < 2; ++a)
#pragma unroll
            for (int b = 0; b < 2; ++b)
#pragma unroll
                for (int m = 0; m < 4; ++m)
#pragma unroll
                    for (int n = 0; n < 2; ++n) acc[a][b][m][n] = (f32x4){0.f, 0.f, 0.f, 0.f};
        cur = nxt; cB = nB; ++ui;
#pragma unroll
        for (int h = 0; h < 2; ++h)
#pragma unroll
            for (int i = 0; i < 2; ++i) co[h][i] = no[h][i];
        if constexpr (ALIGN_EPI) { if (wr == 1) PG8_BAR; }
    }
    PG8_WAIT_V(0);
    if constexpr (!ALIGN_EPI) { if (wr == 0) PG8_BAR; }
    PG8_BAR;
#undef PG8_SA
#undef PG8_SB
#undef PG8_STAGE
#undef PG8_LDA
#undef PG8_LDF
#undef PG8_LDB
#undef PG8_MMA
#undef PG8_WAIT_V
#undef PG8_WAIT_L
#undef PG8_BAR
#undef PG8_SCHED
#undef PG8_AOFF
}

struct EpiInProj {
    static constexpr bool PERM = true;
    bf16_t* P; const float* ropeC; const float* ropeS;
    __device__ __forceinline__ void operator()(const f32x4 (&acc)[2][2][4][2], const Unit& u, int wr, int wc, int fr, int fq) const {
        const int row0 = u.pm * BM + wr * 64 + fr, col0 = u.pn * BM + wc * 32 + 8 * fq;
        const bool qk = u.pn < 4, rope = qk && (u.pm < NLAT / BM);
        const float ks = (u.pn >= 2 && u.pn < 4) ? 0.08838834764831845f : 1.0f;
        const int sec = wc >> 1, i0 = (wc & 1) * 16 + 4 * fq;
#pragma unroll
        for (int ai = 0; ai < 2; ++ai)
#pragma unroll
            for (int m = 0; m < 4; ++m) {
                const int row = row0 + ai * HALF + m * 16;
                asm volatile("" ::: "memory");
                f32x4 c4 = (f32x4){1.f, 1.f, 1.f, 1.f}, s4 = (f32x4){0.f, 0.f, 0.f, 0.f};
                if (rope) { const int t = row & (TL - 1), pos = sec ? (t & 63) : (t >> 6); const int ti = (sec ? 1024 : 0) + pos * 32 + i0;
                    c4 = *(const f32x4*)(ropeC + ti); s4 = *(const f32x4*)(ropeS + ti); }
                bf16_t* rowp = P + (size_t)row * NP + col0;
#pragma unroll
                for (int bj = 0; bj < 2; ++bj) {
                    f32x4 v0 = acc[ai][bj][m][0], v1 = acc[ai][bj][m][1];
                    if (qk) {
                        const float a0 = v0[0] * c4[0] - v0[1] * s4[0], b0 = v0[0] * s4[0] + v0[1] * c4[0];
                        const float a1 = v0[2] * c4[1] - v0[3] * s4[1], b1 = v0[2] * s4[1] + v0[3] * c4[1];
                        const float a2 = v1[0] * c4[2] - v1[1] * s4[2], b2 = v1[0] * s4[2] + v1[1] * c4[2];
                        const float a3 = v1[2] * c4[3] - v1[3] * s4[3], b3 = v1[2] * s4[3] + v1[3] * c4[3];
                        v0 = (f32x4){a0 * ks, b0 * ks, a1 * ks, b1 * ks}; v1 = (f32x4){a2 * ks, b2 * ks, a3 * ks, b3 * ks};
                    }
                    u32x4 w; w.x = cvt_pk_bf16(v0[0], v0[1]); w.y = cvt_pk_bf16(v0[2], v0[3]); w.z = cvt_pk_bf16(v1[0], v1[1]); w.w = cvt_pk_bf16(v1[2], v1[3]);
                    *(u32x4*)(rowp + bj * HALF) = w;
                }
            }
    }
};
struct EpiResid {
    static constexpr bool PERM = true;
    const float* rl; const float* rc; const bf16_t* rb; bf16_t* ob; float* ssq; const float* gmod;
    __device__ __forceinline__ void operator()(const f32x4 (&acc)[2][2][4][2], const Unit& u, int wr, int wc, int fr, int fq) const {
        const int row0 = u.pm * BM + wr * 64 + fr, col0 = u.pn * BM + wc * 32 + 8 * fq;
        const bool lat = u.pm < NLAT / BM; const int b = lat ? (u.pm >> 3) : 16;
        const float* rbase = rl ? (lat ? rl : rc - (size_t)NLAT * D) : nullptr;
        f32x4 gv[2][2];
#pragma unroll
        for (int bj = 0; bj < 2; ++bj)
#pragma unroll
            for (int n = 0; n < 2; ++n) gv[bj][n] = *(const f32x4*)(gmod + (size_t)b * 6 * D + col0 + bj * HALF + 4 * n);
#pragma unroll
        for (int ai = 0; ai < 2; ++ai)
#pragma unroll
            for (int m = 0; m < 4; ++m) { const int row = row0 + ai * HALF + m * 16; const size_t off = (size_t)row * D + col0; float ss = 0.f;
#pragma unroll
                for (int bj = 0; bj < 2; ++bj) { f32x4 r0, r1;
                    if (rbase) { r0 = *(const f32x4*)(rbase + off + bj * HALF); r1 = *(const f32x4*)(rbase + off + bj * HALF + 4); }
                    else { const u32x4 w = *(const u32x4*)(rb + off + bj * HALF); r0 = (f32x4){bflo(w.x), bfhi(w.x), bflo(w.y), bfhi(w.y)}; r1 = (f32x4){bflo(w.z), bfhi(w.z), bflo(w.w), bfhi(w.w)}; }
                    const f32x4 v0 = r0 + gv[bj][0] * acc[ai][bj][m][0], v1 = r1 + gv[bj][1] * acc[ai][bj][m][1];
                    ss += (v0[0] * v0[0] + v0[1] * v0[1]) + (v0[2] * v0[2] + v0[3] * v0[3]) + (v1[0] * v1[0] + v1[1] * v1[1]) + (v1[2] * v1[2] + v1[3] * v1[3]);
                    u32x4 w; w.x = cvt_pk_bf16(v0[0], v0[1]); w.y = cvt_pk_bf16(v0[2], v0[3]); w.z = cvt_pk_bf16(v1[0], v1[1]); w.w = cvt_pk_bf16(v1[2], v1[3]);
                    *(u32x4*)(ob + off + bj * HALF) = w; }
                ss += __shfl_xor(ss, 16); ss += __shfl_xor(ss, 32);
                if (fq == 0) ssq[(size_t)row * 16 + u.pn * 4 + wc] = ss;
                if (m & 1) asm volatile("" ::: "memory"); }
    }
};
struct EpiSwiGLU {
    static constexpr bool PERM = true;
    bf16_t* O;
    __device__ __forceinline__ void operator()(const f32x4 (&acc)[2][2][4][2], const Unit& u, int wr, int wc, int fr, int fq) const {
        const int row0 = u.pm * BM + wr * 64 + fr, col0 = u.pn * 128 + wc * 16 + 4 * fq;
#pragma unroll
        for (int ai = 0; ai < 2; ++ai)
#pragma unroll
            for (int m = 0; m < 4; ++m) { bf16_t* rowp = O + (size_t)(row0 + ai * HALF + m * 16) * FF + col0;
#pragma unroll
                for (int bj = 0; bj < 2; ++bj) { const f32x4 g = acc[ai][bj][m][0], up = acc[ai][bj][m][1];
                    u32x2 w; w.x = cvt_pk_bf16(silu_f(g[0]) * up[0], silu_f(g[1]) * up[1]); w.y = cvt_pk_bf16(silu_f(g[2]) * up[2], silu_f(g[3]) * up[3]);
                    *(u32x2*)(rowp + bj * 64) = w; } }
    }
};
__device__ __forceinline__ unsigned pk4_fp8(float a, float b, float c, float d) { int p = __builtin_amdgcn_cvt_pk_fp8_f32(a, b, 0, false); p = __builtin_amdgcn_cvt_pk_fp8_f32(c, d, p, true); return (unsigned)p; }
struct EpiSwiGLU8 {
    static constexpr bool PERM = true;
    unsigned char* O; float inv;
    __device__ __forceinline__ void operator()(const f32x4 (&acc)[2][2][4][2], const Unit& u, int wr, int wc, int fr, int fq) const {
        const int row0 = u.pm * BM + wr * 64 + fr, col0 = u.pn * 128 + wc * 32 + 8 * fq;
#pragma unroll
        for (int ai = 0; ai < 2; ++ai)
#pragma unroll
            for (int m = 0; m < 4; ++m) { unsigned char* rowp = O + (size_t)(row0 + ai * HALF + m * 16) * FF + col0;
                const f32x4 g0 = acc[ai][0][m][0] * inv, g1 = acc[ai][0][m][1] * inv, u0 = acc[ai][1][m][0] * inv, u1 = acc[ai][1][m][1] * inv;
                u32x2 w; w.x = pk4_fp8(silu_f(g0[0]) * u0[0], silu_f(g0[1]) * u0[1], silu_f(g0[2]) * u0[2], silu_f(g0[3]) * u0[3]);
                w.y = pk4_fp8(silu_f(g1[0]) * u1[0], silu_f(g1[1]) * u1[1], silu_f(g1[2]) * u1[2], silu_f(g1[3]) * u1[3]);
                *(u32x2*)rowp = w; }
    }
};
struct EpiFp8S {
    static constexpr bool PERM = true;
    unsigned char* O; int ldc; float inv;
    __device__ __forceinline__ void operator()(const f32x4 (&acc)[2][2][4][2], const Unit& u, int wr, int wc, int fr, int fq) const {
        const int row0 = u.pm * BM + wr * 64 + fr, col0 = u.pn * BM + wc * 32 + 8 * fq;
#pragma unroll
        for (int ai = 0; ai < 2; ++ai)
#pragma unroll
            for (int m = 0; m < 4; ++m) { unsigned char* rowp = O + (size_t)(row0 + ai * HALF + m * 16) * ldc + col0;
#pragma unroll
                for (int bj = 0; bj < 2; ++bj) { const f32x4 v0 = acc[ai][bj][m][0] * inv, v1 = acc[ai][bj][m][1] * inv;
                    u32x2 w; w.x = pk4_fp8(v0[0], v0[1], v0[2], v0[3]); w.y = pk4_fp8(v1[0], v1[1], v1[2], v1[3]);
                    *(u32x2*)(rowp + bj * HALF) = w; } }
    }
};
struct EpiBf16S {
    static constexpr bool PERM = true;
    bf16_t* O; int ldc; float inv;
    __device__ __forceinline__ void operator()(const f32x4 (&acc)[2][2][4][2], const Unit& u, int wr, int wc, int fr, int fq) const {
        const int row0 = u.pm * BM + wr * 64 + fr, col0 = u.pn * BM + wc * 32 + 8 * fq;
#pragma unroll
        for (int ai = 0; ai < 2; ++ai)
#pragma unroll
            for (int m = 0; m < 4; ++m) { bf16_t* rowp = O + (size_t)(row0 + ai * HALF + m * 16) * ldc + col0;
#pragma unroll
                for (int bj = 0; bj < 2; ++bj) { const f32x4 v0 = acc[ai][bj][m][0] * inv, v1 = acc[ai][bj][m][1] * inv;
                    u32x4 w; w.x = cvt_pk_bf16(v0[0], v0[1]); w.y = cvt_pk_bf16(v0[2], v0[3]); w.z = cvt_pk_bf16(v1[0], v1[1]); w.w = cvt_pk_bf16(v1[2], v1[3]);
                    *(u32x4*)(rowp + bj * HALF) = w; } }
    }
};
struct EpiBf16 {
    static constexpr bool PERM = true;
    bf16_t* O; int ldc;
    __device__ __forceinline__ void operator()(const f32x4 (&acc)[2][2][4][2], const Unit& u, int wr, int wc, int fr, int fq) const {
        const int row0 = u.pm * BM + wr * 64 + fr, col0 = u.pn * BM + wc * 32 + 8 * fq;
#pragma unroll
        for (int ai = 0; ai < 2; ++ai)
#pragma unroll
            for (int m = 0; m < 4; ++m) { bf16_t* rowp = O + (size_t)(row0 + ai * HALF + m * 16) * ldc + col0;
#pragma unroll
                for (int bj = 0; bj < 2; ++bj) { const f32x4 v0 = acc[ai][bj][m][0], v1 = acc[ai][bj][m][1];
                    u32x4 w; w.x = cvt_pk_bf16(v0[0], v0[1]); w.y = cvt_pk_bf16(v0[2], v0[3]); w.z = cvt_pk_bf16(v1[0], v1[1]); w.w = cvt_pk_bf16(v1[2], v1[3]);
                    *(u32x4*)(rowp + bj * HALF) = w; } }
    }
};
}

struct Args { const float* in[22]; float* out; unsigned char* ws; int ph_lo, ph_hi; };
enum { I_X = 0, I_C, I_CTX, I_CCTX, I_ADAW, I_ADAB, I_N1G, I_WIN, I_DF, I_DB, I_POOLW, I_POOLS, I_WOUT, I_N2G, I_RGW, I_RGB, I_REW, I_REB, I_WG, I_WU, I_WDN, I_FNG };

struct Frame {
    LAS unsigned char* lds; int tid, lane, wave, G, bx, vcu;
    const float* const* in; float* out; unsigned char* ws;
};
__device__ __forceinline__ bf16_t* xb_row(const Frame& F, int row) { return (bf16_t*)(F.ws + WS_XB) + (size_t)row * D; }
__device__ __forceinline__ bf16_t* hbuf(const Frame& F) { return (bf16_t*)F.out; }
__device__ __forceinline__ const float* mod_ptr(const Frame& F, int l, int b, int which) { return (const float*)(F.ws + WS_MOD) + ((size_t)(l * 17 + b) * 6 + which) * D; }

__device__ __forceinline__ void tr_item(const float* colp, size_t ldw, int k0, bf16_t* WT, int K, int n0, LAS float* scr, int lane) {
    { float v[32];
#pragma unroll
        for (int i = 0; i < 32; ++i) v[i] = colp[(size_t)(k0 + 2 * i + (lane >> 5)) * ldw];
#pragma unroll
        for (int i = 0; i < 32; ++i) scr[(2 * i + (lane >> 5)) * 33 + (lane & 31)] = v[i]; }
    asm volatile("s_waitcnt lgkmcnt(0)" ::: "memory");
    const int c = lane & 7;
#pragma unroll
    for (int j = 0; j < 4; ++j) { const int n = (lane >> 3) + 8 * j; const LAS float* s = scr + (8 * c) * 33 + n;
        u32x4 o; o.x = pk2(s[0 * 33], s[1 * 33]); o.y = pk2(s[2 * 33], s[3 * 33]); o.z = pk2(s[4 * 33], s[5 * 33]); o.w = pk2(s[6 * 33], s[7 * 33]);
        *(u32x4*)(WT + (size_t)(n0 + n) * K + k0 + 8 * c) = o; }
    asm volatile("s_waitcnt lgkmcnt(0)" ::: "memory");
}
constexpr float WGU_SCALE = 64.0f, WD_SCALE = 32.0f;
__device__ __forceinline__ void tr_item8(const float* colp, size_t ldw, int k0, unsigned char* WT, int K, int n0, LAS float* scr, int lane, float qs) {
    { float v[32];
#pragma unroll
        for (int i = 0; i < 32; ++i) v[i] = colp[(size_t)(k0 + 2 * i + (lane >> 5)) * ldw];
#pragma unroll
        for (int i = 0; i < 32; ++i) scr[(2 * i + (lane >> 5)) * 33 + (lane & 31)] = v[i] * qs; }
    asm volatile("s_waitcnt lgkmcnt(0)" ::: "memory");
    const int c = lane & 7;
#pragma unroll
    for (int j = 0; j < 4; ++j) { const int n = (lane >> 3) + 8 * j; const LAS float* s = scr + (8 * c) * 33 + n;
        u32x2 o; o.x = pg8::pk4_fp8(s[0 * 33], s[1 * 33], s[2 * 33], s[3 * 33]); o.y = pg8::pk4_fp8(s[4 * 33], s[5 * 33], s[6 * 33], s[7 * 33]);
        *(u32x2*)(WT + (size_t)(n0 + n) * K + k0 + 8 * c) = o; }
    asm volatile("s_waitcnt lgkmcnt(0)" ::: "memory");
}
__device__ __forceinline__ void fold_item(const float* win, const float* pw, const float* ps, int k0, bf16_t* WT, int n0, LAS float* scr, int lane) {
    const int n = n0 + (lane & 31), g = n >> 7, nn = n & 127;
    const float* pwc = pw + (size_t)g * 128 * 128 + nn; const float sc = ps[n];
    float acc[32];
#pragma unroll
    for (int i = 0; i < 32; ++i) acc[i] = 0.f;
    for (int hc = 0; hc < 8; ++hc) {
        float pc[16];
#pragma unroll
        for (int c = 0; c < 16; ++c) pc[c] = pwc[(size_t)(hc * 16 + c) * 128];
#pragma unroll
        for (int i = 0; i < 32; ++i) { const f32x4* wr = (const f32x4*)(win + (size_t)(k0 + 2 * i + (lane >> 5)) * NP + 2048 + g * 128 + hc * 16);
            float a = acc[i];
#pragma unroll
            for (int c4 = 0; c4 < 4; ++c4) { const f32x4 w = wr[c4]; a += w[0] * pc[4 * c4] + w[1] * pc[4 * c4 + 1] + w[2] * pc[4 * c4 + 2] + w[3] * pc[4 * c4 + 3]; }
            acc[i] = a; }
    }
#pragma unroll
    for (int i = 0; i < 32; ++i) scr[(2 * i + (lane >> 5)) * 33 + (lane & 31)] = acc[i] * sc;
    asm volatile("s_waitcnt lgkmcnt(0)" ::: "memory");
    const int c = lane & 7;
#pragma unroll
    for (int j = 0; j < 4; ++j) { const int nl = (lane >> 3) + 8 * j; const LAS float* s = scr + (8 * c) * 33 + nl;
        u32x4 o; o.x = pk2(s[0 * 33], s[1 * 33]); o.y = pk2(s[2 * 33], s[3 * 33]); o.z = pk2(s[4 * 33], s[5 * 33]); o.w = pk2(s[6 * 33], s[7 * 33]);
        *(u32x4*)(WT + (size_t)(2048 + n0 + nl) * D + k0 + 8 * c) = o; }
    asm volatile("s_waitcnt lgkmcnt(0)" ::: "memory");
}
constexpr int IT_WIN = 16 * 80, IT_WOUT = 16 * 32, IT_GU = 16 * 32, IT_DN = 8 * 32;
constexpr int N_WIN = DEPTH * IT_WIN, N_WOUT = DEPTH * IT_WOUT, N_SMALL = N_WIN + N_WOUT, EXP_ITEMS = NE * (IT_GU + IT_DN);
constexpr int IDLE_A = 192 * 8 * 8, IDLE_B = 128 * 8 * 6;
static_assert(IDLE_A + IDLE_B <= EXP_ITEMS && (N_SMALL + 2 * EXP_ITEMS) % 32 == 0 && (IDLE_A + IDLE_B) % 32 == 0, "item partition");
__device__ __forceinline__ void expert_item(const Frame& F, int layer, int q, LAS float* scr) {
    if (q < NE * IT_GU) { const int le = layer * NE + q / IT_GU; const int r = q % IT_GU, kb = r / 32, nb = r % 32, n0 = nb * 32;
        const int n = n0 + (F.lane & 31), col = (n >> 8) * 128 + (n & 127); const float* src = ((n & 128) ? F.in[I_WU] : F.in[I_WG]) + (size_t)le * D * FF + col;
        tr_item8(src, FF, kb * 64, (unsigned char*)(F.ws + WS_WGU) + (size_t)le * 1024 * D, D, n0, scr, F.lane, WGU_SCALE); }
    else { q -= NE * IT_GU; const int le = layer * NE + q / IT_DN; const int r = q % IT_DN, kb = r / 32, nb = r % 32, n0 = nb * 32;
        tr_item8(F.in[I_WDN] + (size_t)le * FF * D + n0 + (F.lane & 31), D, kb * 64, (unsigned char*)(F.ws + WS_WD) + (size_t)le * D * FF, FF, n0, scr, F.lane, WD_SCALE); }
}
__device__ __forceinline__ void p0_prologue(const Frame& F, int qsel) {
    for (int task = F.bx; task < 2 * 96; task += F.G) {
        const int l = task / 96, cg = task % 96;
        LAS float* sc = (LAS float*)F.lds;
        LAS float* part = (LAS float*)(F.lds + 17 * 1024 * 4);
        { float cv[34];
#pragma unroll
          for (int q = 0; q < 34; ++q) { const int i = F.tid + 512 * q, b = i >> 10, k = i & 1023; cv[q] = b < 16 ? F.in[I_C][b * D + k] : F.in[I_CCTX][k]; }
#pragma unroll
          for (int q = 0; q < 34; ++q) sc[F.tid + 512 * q] = silu_f(cv[q]); }
        __syncthreads();
        float acc[17];
#pragma unroll
        for (int b = 0; b < 17; ++b) acc[b] = 0.f;
        const float* aw = F.in[I_ADAW] + (size_t)l * D * 6 * D + cg * 64 + F.lane;
        for (int k0 = F.wave * 128; k0 < F.wave * 128 + 128; k0 += 16) { float w[16];
#pragma unroll
            for (int u = 0; u < 16; ++u) w[u] = aw[(size_t)(k0 + u) * 6 * D];
#pragma unroll
            for (int u = 0; u < 16; ++u) {
#pragma unroll
                for (int b = 0; b < 17; ++b) acc[b] += sc[b * 1024 + k0 + u] * w[u]; } }
#pragma unroll
        for (int b = 0; b < 17; ++b) part[(F.wave * 17 + b) * 64 + F.lane] = acc[b];
        __syncthreads();
        for (int i = F.tid; i < 17 * 64; i += 512) { const int b = i >> 6, n = i & 63; float s = F.in[I_ADAB][l * 6 * D + cg * 64 + n];
#pragma unroll
            for (int w = 0; w < 8; ++w) s += part[(w * 17 + b) * 64 + n];
            const int col = cg * 64 + n; ((float*)(F.ws + WS_MOD))[((size_t)(l * 17 + b) * 6 + (col >> 10)) * D + (col & 1023)] = s; }
        __syncthreads();
    }
    if (F.bx >= F.G - 3 && F.bx < F.G - 1) { const int l = F.G - 2 - F.bx; unsigned char* img = F.ws + WS_RIMG + (size_t)l * RW_EX;
        const float* rg = F.in[I_RGW] + (size_t)l * D * 4; const float* re = F.in[I_REW] + (size_t)l * D * NE;
        for (int i0 = F.tid; i0 < 1024 * 36; i0 += 512 * 8) { float w[8];
#pragma unroll
            for (int q = 0; q < 8; ++q) { const int i = i0 + 512 * q, k = i / 36, n = i % 36; w[q] = n < 4 ? rg[k * 4 + n] : re[k * NE + (n - 4)]; }
#pragma unroll
            for (int q = 0; q < 8; ++q) { const int i = i0 + 512 * q, k = i / 36, n = i % 36; const unsigned hi = f2bf(w[q]), lo = f2bf(w[q] - bflo(hi));
                *(bf16_t*)(img + n * RW_PITCH + k * 2) = (bf16_t)hi; *(bf16_t*)(img + RW_LO + n * RW_PITCH + k * 2) = (bf16_t)lo; } }
        for (int i = F.tid; i < 2 * 36 * 8; i += 512) { const int r = i >> 3; *(bf16_t*)(img + r * RW_PITCH + 2048 + (i & 7) * 2) = 0; }
    }
    if (F.bx == F.G - 1) {
        float* rc = (float*)(F.ws + WS_ROPE); float* rs = rc + 96 * 32;
        for (int i = F.tid; i < 96 * 32; i += 512) { const int p = i >> 5, f = i & 31; const int pos = p < 32 ? p : p - 32;
            const float inv = powf(10000.0f, -(float)f / 32.0f); const float ang = (float)pos * inv; rc[i] = cosf(ang); rs[i] = sinf(ang); }
    }
    LAS float* scr = (LAS float*)(F.lds + F.wave * 8448);
    const int n_l1 = (F.G == 256) ? EXP_ITEMS - IDLE_A - IDLE_B : EXP_ITEMS;
    const int n_all = N_SMALL + EXP_ITEMS + n_l1, QB = 4, NSH = 8, nbatch = n_all / QB, nb_s = nbatch / NSH;
    unsigned* qheads = (unsigned*)(F.ws + WS_CTL) + CW_QUEUE; (void)qsel;
    const int sh0 = (F.vcu * NSH) / F.G;
    for (int ds = 0; ds < NSH; ++ds) { const int shd = (sh0 + ds) % NSH; unsigned* qhead = qheads + 64 * shd;
    for (;;) {
        int kq = 0; if (F.lane == 0) kq = (int)__hip_atomic_fetch_add(qhead, 1u, __ATOMIC_RELAXED, __HIP_MEMORY_SCOPE_AGENT);
        kq = __builtin_amdgcn_readfirstlane(kq);
        if (kq >= nb_s) break;
        const int bq = shd + NSH * kq;
      for (int qi = 0; qi < QB; ++qi) {
        int r = bq + qi * nbatch;
        if (r < N_WIN) { const int l = r / IT_WIN; r %= IT_WIN; const int kb = r & 15, nb = 79 - (r >> 4), n0 = nb * 32;
            const float* win = F.in[I_WIN] + (size_t)l * D * NP; bf16_t* WT = (bf16_t*)(F.ws + WS_WIN) + (size_t)l * NP * D;
            if (n0 >= 2048) { fold_item(win, F.in[I_POOLW] + (size_t)l * 4 * 128 * 128, F.in[I_POOLS] + l * 512, kb * 64, WT, n0 - 2048, scr, F.lane); continue; }
            const int n = n0 + (F.lane & 31); int src = n;
            if (n < 1024) { const int hh = n >> 7, j = n & 127, sec = j >> 6, jj = j & 63; src = (n & 512) + (hh & 3) * 128 + sec * 64 + (jj & 1) * 32 + (jj >> 1); }
            tr_item(win + src, NP, kb * 64, WT, D, n0, scr, F.lane); continue; }
        r -= N_WIN;
        if (r < N_WOUT) { const int l = r / IT_WOUT; r %= IT_WOUT; const int kb = r / 32, nb = r % 32, n0 = nb * 32;
            tr_item(F.in[I_WOUT] + (size_t)l * D * D + n0 + (F.lane & 31), D, kb * 64, (bf16_t*)(F.ws + WS_WOUT) + (size_t)l * D * D, D, n0, scr, F.lane); continue; }
        r -= N_WOUT;
        if (r < EXP_ITEMS) expert_item(F, 0, r, scr); else expert_item(F, 1, EXP_ITEMS - n_l1 + (r - EXP_ITEMS), scr);
      }
    }
    }
}
__device__ __forceinline__ void idle_convert(const Frame& F, int gidx, int base, int per) {
    LAS float* scr = (LAS float*)(F.lds + F.wave * 8448);
    for (int i = 0; i < per; ++i) expert_item(F, 1, base + gidx * per + i, scr);
}

__device__ __forceinline__ LAS int* build_tb(const Frame& F, int l) {
    LAS int* tb = (LAS int*)(F.lds + MISC_OFF + 64);
    if (F.tid < 64) {
        const unsigned* cnt = (const unsigned*)(F.ws + WS_CTL) + CW_CNT + l * NE * 16;
        const int e = F.tid & 31; const int c = (int)__hip_atomic_load(cnt + e * 16, __ATOMIC_RELAXED, __HIP_MEMORY_SCOPE_AGENT);
        const int t = (c + 255) >> 8; int incl = t;
#pragma unroll
        for (int o = 1; o < 32; o <<= 1) { const int v = __shfl_up(incl, o, 32); if (e >= o) incl += v; }
        if (F.tid < 32) { tb[e] = incl - t; tb[64 + e] = c; if (e == 31) tb[NE] = incl; }
    }
    __syncthreads();
    return tb;
}

__device__ __forceinline__ void row_op_a(const Frame& F, int mode, bool dry) {
    const int gw = F.vcu * 8 + F.wave, NGW = F.G * 8;
    const int nrows = (mode == 2) ? NLAT : NTOK; const int l = (mode == 0) ? 0 : 1, lp = mode - 1;
    const LAS int* tb = nullptr; if (mode != 0) tb = build_tb(F, lp);
    const unsigned char* YB = (const unsigned char*)(F.ws + WS_P); bf16_t* H = hbuf(F);
    const float* gain = (mode == 2) ? F.in[I_FNG] : F.in[I_N1G] + l * D;
    const int R = (nrows + NGW - 1) / NGW, r_lo = gw * R, r_hi = (r_lo + R < nrows) ? r_lo + R : nrows;
    int4 ti1 = make_int4(0, 0, 0, 0), ti2 = ti1; f32x2 tw0 = (f32x2){0.f, 0.f}, tw1 = tw0, tw2 = tw0;
    f32x4 xf[4]; u32x2 xq[4]; unsigned ya[4], yc[4];
#define ROWA_INFO(r_, ti_, tw_) do { if (mode != 0 && (r_) < r_hi) { ti_ = *(const int4*)(F.ws + WS_TOKINFO + (size_t)(r_) * 32); tw_ = *(const f32x2*)(F.ws + WS_TOKINFO + (size_t)(r_) * 32 + 16); } } while (0)
#define ROWA_DATA(r_, ti_) do { if ((r_) < r_hi) { if (mode == 0) { const f32x4* src = (const f32x4*)((r_) < NLAT ? F.in[I_X] + (size_t)(r_) * D : F.in[I_CTX] + (size_t)((r_) - NLAT) * D) + F.lane; \
            _Pragma("unroll") for (int j = 0; j < 4; ++j) xf[j] = src[64 * j]; } \
        else { const size_t s1 = (size_t)(tb[ti_.x] * 256 + ti_.y), s2 = (size_t)(tb[ti_.z] * 256 + ti_.w); const u32x2* xr_ = (const u32x2*)xb_row(F, (r_)) + F.lane; \
            const unsigned* y1 = (const unsigned*)(YB + s1 * D) + F.lane; const unsigned* y2 = (const unsigned*)(YB + s2 * D) + F.lane; \
            _Pragma("unroll") for (int j = 0; j < 4; ++j) { xq[j] = xr_[64 * j]; ya[j] = y1[64 * j]; yc[j] = y2[64 * j]; } } } } while (0)
    ROWA_INFO(r_lo, ti1, tw1); ROWA_INFO(r_lo + 1, ti2, tw2);
    ROWA_DATA(r_lo, ti1); tw0 = tw1; ti1 = ti2; tw1 = tw2;
    f32x4 vA[4], vB[4], vG[4]; int bcur = -1;
    for (int row = r_lo; row < r_hi; ++row) {
        const int b = row < NLAT ? (row >> 11) : 16;
        if (b != bcur) { bcur = b;
#pragma unroll
            for (int j = 0; j < 4; ++j) { const f32x4 g = ((const f32x4*)gain)[F.lane + 64 * j];
                if (mode == 2) { vA[j] = g; vB[j] = (f32x4){0.f, 0.f, 0.f, 0.f}; }
                else { vA[j] = g * (((const f32x4*)mod_ptr(F, l, b, 1))[F.lane + 64 * j] + 1.0f); vB[j] = ((const f32x4*)mod_ptr(F, l, b, 0))[F.lane + 64 * j]; }
                if (mode != 0) vG[j] = ((const f32x4*)mod_ptr(F, lp, b, 5))[F.lane + 64 * j]; } }
        ROWA_INFO(row + 2, ti2, tw2);
        f32x4 v[4];
        if (mode == 0) {
#pragma unroll
            for (int j = 0; j < 4; ++j) v[j] = xf[j];
        } else {
#pragma unroll
            for (int j = 0; j < 4; ++j) { const u32x2 xw = xq[j]; const f32x4 x = (f32x4){bflo(xw.x), bfhi(xw.x), bflo(xw.y), bfhi(xw.y)};
                const int a = (int)ya[j], c = (int)yc[j];
                f32x4 y; y[0] = tw0.x * __builtin_amdgcn_cvt_f32_fp8(a, 0) + tw0.y * __builtin_amdgcn_cvt_f32_fp8(c, 0); y[1] = tw0.x * __builtin_amdgcn_cvt_f32_fp8(a, 1) + tw0.y * __builtin_amdgcn_cvt_f32_fp8(c, 1);
                y[2] = tw0.x * __builtin_amdgcn_cvt_f32_fp8(a, 2) + tw0.y * __builtin_amdgcn_cvt_f32_fp8(c, 2); y[3] = tw0.x * __builtin_amdgcn_cvt_f32_fp8(a, 3) + tw0.y * __builtin_amdgcn_cvt_f32_fp8(c, 3);
                v[j] = x + vG[j] * y; }
        }
        ROWA_DATA(row + 1, ti1);
        if (mode == 1 && !dry) { u32x2* xr = (u32x2*)xb_row(F, row) + F.lane;
#pragma unroll
            for (int j = 0; j < 4; ++j) { u32x2 w; w.x = pk2(v[j][0], v[j][1]); w.y = pk2(v[j][2], v[j][3]); xr[64 * j] = w; } }
        float ss = 0.f;
#pragma unroll
        for (int j = 0; j < 4; ++j) ss += (v[j][0] * v[j][0] + v[j][1] * v[j][1]) + (v[j][2] * v[j][2] + v[j][3] * v[j][3]);
        const float rstd = 1.0f / sqrtf(wave_sum(ss) * (1.0f / D) + EPS);
        if (mode == 2) {
#pragma unroll
            for (int j = 0; j < 4; ++j) ((f32x4*)((dry ? (float*)(F.ws + WS_WGU) : F.out) + (size_t)row * D))[F.lane + 64 * j] = v[j] * rstd * vA[j];
        } else {
            u32x2* o = (u32x2*)(H + (size_t)row * D) + F.lane;
#pragma unroll
            for (int j = 0; j < 4; ++j) { const f32x4 h = v[j] * rstd * vA[j] + vB[j];
                u32x2 w; w.x = pk2(h[0], h[1]); w.y = pk2(h[2], h[3]); o[64 * j] = w; }
        }
        tw0 = tw1; ti1 = ti2; tw1 = tw2;
    }
#undef ROWA_INFO
#undef ROWA_DATA
}

template <bool DRY> __device__ __forceinline__ void route_row(const Frame& F, int l, int row, const float (&s)[36], unsigned* cnt, int* list) {
    float gl[4];
#pragma unroll
    for (int i = 0; i < 4; ++i) gl[i] = s[i];
    int gt = 0; float gm = gl[0];
#pragma unroll
    for (int i = 1; i < 4; ++i) if (gl[i] > gm) { gm = gl[i]; gt = i; }
    float gs = 0.f;
#pragma unroll
    for (int i = 0; i < 4; ++i) gs += expf(gl[i] - gm);
    const float gwt = 1.0f / gs;
    float el[8];
#pragma unroll
    for (int j = 0; j < 8; ++j) el[j] = gt == 0 ? s[4 + j] : gt == 1 ? s[12 + j] : gt == 2 ? s[20 + j] : s[28 + j];
    int i1 = 0; float v1 = el[0];
#pragma unroll
    for (int j = 1; j < 8; ++j) if (el[j] > v1) { v1 = el[j]; i1 = j; }
    int i2 = -1; float v2 = -3.0e38f;
#pragma unroll
    for (int j = 0; j < 8; ++j) if (j != i1 && el[j] > v2) { v2 = el[j]; i2 = j; }
    const float e2 = expf(v2 - v1); const float w1 = gwt / (1.0f + e2), w2 = gwt * e2 / (1.0f + e2);
    if (!DRY) {
        const int x1 = gt * 8 + i1, x2 = gt * 8 + i2;
        const int r1 = (int)__hip_atomic_fetch_add(cnt + x1 * 16, 1u, __ATOMIC_RELAXED, __HIP_MEMORY_SCOPE_AGENT);
        const int r2 = (int)__hip_atomic_fetch_add(cnt + x2 * 16, 1u, __ATOMIC_RELAXED, __HIP_MEMORY_SCOPE_AGENT);
        list[(size_t)x1 * NTOK + r1] = row; list[(size_t)x2 * NTOK + r2] = row;
        *(int4*)(F.ws + WS_TOKINFO + (size_t)row * 32) = make_int4(x1, r1, x2, r2); *(f32x2*)(F.ws + WS_TOKINFO + (size_t)row * 32 + 16) = (f32x2){w1, w2};
    }
}
template <bool DRY> __device__ __forceinline__ void row_op_b(const Frame& F, int l) {
    const int gw = F.vcu * 8 + F.wave, NGW = F.G * 8;
    const int ngroups = ((l == 0) ? NTOK : NLAT) / 16;
    { const u32x4* img = (const u32x4*)(F.ws + WS_RIMG + (size_t)l * RW_EX);
      u32x4 t[19];
#pragma unroll
      for (int q = 0; q < 19; ++q) { const int i = F.tid + 512 * q; t[q] = img[i < RW_EX / 16 ? i : 0]; }
#pragma unroll
      for (int q = 0; q < 19; ++q) { const int i = F.tid + 512 * q; if (i < RW_EX / 16) *(LAS u32x4*)(F.lds + i * 16) = t[q]; } }
    __syncthreads();
    bf16_t* H = hbuf(F);
    const float* gain = F.in[I_N2G] + l * D;
    unsigned* cnt = (unsigned*)(F.ws + WS_CTL) + CW_CNT + l * NE * 16;
    int* list = (int*)(F.ws + WS_LIST);
    const int fr = F.lane & 15, fq = F.lane >> 4;
    unsigned bo[3];
#pragma unroll
    for (int nt = 0; nt < 3; ++nt) { const int n = 16 * nt + fr; bo[nt] = (unsigned)((n < 36 ? n : 35) * RW_PITCH + fq * 16); }
    LAS float* ex = (LAS float*)(F.lds + RW_EX + F.wave * 1152);
    float rbias[36];
#pragma unroll
    for (int n = 0; n < 36; ++n) rbias[n] = n < 4 ? F.in[I_RGB][l * 4 + n] : F.in[I_REB][l * NE + (n - 4)];
    for (int it = 0;; ++it) {
        const int gi = it == 0 ? gw : NGW + F.vcu + (it - 1) * F.G;
        if (gi >= ngroups || (it > 0 && F.wave != 0)) break;
        const int row = gi * 16 + fr, b = row < NLAT ? (row >> 11) : 16;
        const bf16_t* xr = xb_row(F, row) + fq * 8;
        float ss;
        { const f32x4* sp = (const f32x4*)((const float*)(F.ws + WS_SSQ) + (size_t)row * 16); const f32x4 p0 = sp[0], p1 = sp[1], p2 = sp[2], p3 = sp[3];
          ss = ((p0[0] + p0[1]) + (p0[2] + p0[3])) + ((p1[0] + p1[1]) + (p1[2] + p1[3])) + ((p2[0] + p2[1]) + (p2[2] + p2[3])) + ((p3[0] + p3[1]) + (p3[2] + p3[3])); }
        const float rstd = 1.0f / sqrtf(ss * (1.0f / D) + EPS);
        const float* shp = mod_ptr(F, l, b, 3) + fq * 8; const float* scp = mod_ptr(F, l, b, 4) + fq * 8; const float* gp = gain + fq * 8;
        unsigned char* hp = (unsigned char*)H + (size_t)row * D + fq * 8;
        f32x4 acc[3];
#pragma unroll
        for (int nt = 0; nt < 3; ++nt) acc[nt] = (f32x4){0.f, 0.f, 0.f, 0.f};
#pragma unroll 2
        for (int s = 0; s < 32; ++s) {
            const u32x4 xw = *(const u32x4*)(xr + 32 * s);
            const f32x4 x0 = (f32x4){bflo(xw.x), bfhi(xw.x), bflo(xw.y), bfhi(xw.y)}, x1 = (f32x4){bflo(xw.z), bfhi(xw.z), bflo(xw.w), bfhi(xw.w)};
            const f32x4 g0 = *(const f32x4*)(gp + 32 * s), g1 = *(const f32x4*)(gp + 32 * s + 4);
            const f32x4 c0 = *(const f32x4*)(scp + 32 * s), c1 = *(const f32x4*)(scp + 32 * s + 4);
            const f32x4 s0 = *(const f32x4*)(shp + 32 * s), s1 = *(const f32x4*)(shp + 32 * s + 4);
            const f32x4 h0 = x0 * rstd * g0 * (c0 + 1.0f) + s0, h1 = x1 * rstd * g1 * (c1 + 1.0f) + s1;
            u32x4 hi, lo;
            hi.x = pk2(h0[0], h0[1]); hi.y = pk2(h0[2], h0[3]); hi.z = pk2(h1[0], h1[1]); hi.w = pk2(h1[2], h1[3]);
            lo.x = pk2(h0[0] - bflo(hi.x), h0[1] - bfhi(hi.x)); lo.y = pk2(h0[2] - bflo(hi.y), h0[3] - bfhi(hi.y));
            lo.z = pk2(h1[0] - bflo(hi.z), h1[1] - bfhi(hi.z)); lo.w = pk2(h1[2] - bflo(hi.w), h1[3] - bfhi(hi.w));
            { u32x2 h8; h8.x = pg8::pk4_fp8(h0[0], h0[1], h0[2], h0[3]); h8.y = pg8::pk4_fp8(h1[0], h1[1], h1[2], h1[3]); *(u32x2*)(hp + 32 * s) = h8; }
            const bf16x8 ah = __builtin_bit_cast(bf16x8, hi), al = __builtin_bit_cast(bf16x8, lo);
#pragma unroll
            for (int nt = 0; nt < 3; ++nt) {
                const bf16x8 bh = *(const LAS bf16x8*)(F.lds + bo[nt] + s * 64), bl = *(const LAS bf16x8*)(F.lds + RW_LO + bo[nt] + s * 64);
                acc[nt] = __builtin_amdgcn_mfma_f32_16x16x32_bf16(ah, bh, acc[nt], 0, 0, 0);
                acc[nt] = __builtin_amdgcn_mfma_f32_16x16x32_bf16(ah, bl, acc[nt], 0, 0, 0);
                acc[nt] = __builtin_amdgcn_mfma_f32_16x16x32_bf16(al, bh, acc[nt], 0, 0, 0);
            }
        }
#pragma unroll
        for (int hf = 0; hf < 2; ++hf) {
            if ((fq >> 1) == hf) {
#pragma unroll
                for (int nt = 0; nt < 3; ++nt) { const int n = 16 * nt + fr;
                    if (n < 36) {
#pragma unroll
                        for (int r = 0; r < 4; ++r) ex[((fq & 1) * 4 + r) * 36 + n] = acc[nt][r]; } }
            }
            asm volatile("s_waitcnt lgkmcnt(0)" ::: "memory");
            if (F.lane < 8) { float sl[36];
#pragma unroll
                for (int n = 0; n < 36; ++n) sl[n] = ex[F.lane * 36 + n] + rbias[n];
                route_row<DRY>(F, l, gi * 16 + hf * 8 + F.lane, sl, cnt, list); }
            asm volatile("s_waitcnt lgkmcnt(0)" ::: "memory");
        }
    }
    __syncthreads();
}

__device__ __forceinline__ unsigned off_b(unsigned row, unsigned ch) { return 256u * row + 16u * (ch ^ (((row & 3) << 2) | ((row >> 2) & 3))); }
__device__ __forceinline__ unsigned tr_base_p(unsigned lane) { const unsigned g = lane >> 4, q = (lane & 15) >> 2, p = lane & 3; return off_b(4 * g + q, (p >> 1)) + 8 * (p & 1); }
template <int O0, int O1, int O2, int O3>
__device__ __forceinline__ void tr_frag4(bf16x8 (&f)[4], unsigned a0, unsigned a1, unsigned a2, unsigned a3) {
    s16x4 l0, h0, l1, h1, l2, h2, l3, h3;
    asm volatile("ds_read_b64_tr_b16 %0, %8 offset:%12\n\tds_read_b64_tr_b16 %1, %8 offset:%16\n\t"
                 "ds_read_b64_tr_b16 %2, %9 offset:%13\n\tds_read_b64_tr_b16 %3, %9 offset:%17\n\t"
                 "ds_read_b64_tr_b16 %4, %10 offset:%14\n\tds_read_b64_tr_b16 %5, %10 offset:%18\n\t"
                 "ds_read_b64_tr_b16 %6, %11 offset:%15\n\tds_read_b64_tr_b16 %7, %11 offset:%19\n\ts_waitcnt lgkmcnt(0)"
                 : "=&v"(l0), "=&v"(h0), "=&v"(l1), "=&v"(h1), "=&v"(l2), "=&v"(h2), "=&v"(l3), "=&v"(h3)
                 : "v"(a0), "v"(a1), "v"(a2), "v"(a3), "n"(O0), "n"(O1), "n"(O2), "n"(O3), "n"(O0 + 4096), "n"(O1 + 4096), "n"(O2 + 4096), "n"(O3 + 4096) : "memory");
    f[0] = __builtin_shufflevector(l0, h0, 0, 1, 2, 3, 4, 5, 6, 7); f[1] = __builtin_shufflevector(l1, h1, 0, 1, 2, 3, 4, 5, 6, 7);
    f[2] = __builtin_shufflevector(l2, h2, 0, 1, 2, 3, 4, 5, 6, 7); f[3] = __builtin_shufflevector(l3, h3, 0, 1, 2, 3, 4, 5, 6, 7);
}
template <int O>
__device__ __forceinline__ void tr_frag8(bf16x8 (&f)[8], unsigned a) {
    s16x4 l0, h0, l1, h1, l2, h2, l3, h3, l4, h4, l5, h5, l6, h6, l7, h7;
    const unsigned a1 = a ^ 32u, a2 = a ^ 64u, a3 = a ^ 96u, a4 = a ^ 128u, a5 = a ^ 160u, a6 = a ^ 192u, a7 = a ^ 224u;
    asm volatile("ds_read_b64_tr_b16 %0, %8 offset:%12\n\tds_read_b64_tr_b16 %1, %8 offset:%13\n\t"
                 "ds_read_b64_tr_b16 %2, %9 offset:%12\n\tds_read_b64_tr_b16 %3, %9 offset:%13\n\t"
                 "ds_read_b64_tr_b16 %4, %10 offset:%12\n\tds_read_b64_tr_b16 %5, %10 offset:%13\n\t"
                 "ds_read_b64_tr_b16 %6, %11 offset:%12\n\tds_read_b64_tr_b16 %7, %11 offset:%13"
                 : "=&v"(l0), "=&v"(h0), "=&v"(l1), "=&v"(h1), "=&v"(l2), "=&v"(h2), "=&v"(l3), "=&v"(h3)
                 : "v"(a), "v"(a1), "v"(a2), "v"(a3), "n"(O), "n"(O + 4096) : "memory");
    asm volatile("ds_read_b64_tr_b16 %0, %16 offset:%20\n\tds_read_b64_tr_b16 %1, %16 offset:%21\n\t"
                 "ds_read_b64_tr_b16 %2, %17 offset:%20\n\tds_read_b64_tr_b16 %3, %17 offset:%21\n\t"
                 "ds_read_b64_tr_b16 %4, %18 offset:%20\n\tds_read_b64_tr_b16 %5, %18 offset:%21\n\t"
                 "ds_read_b64_tr_b16 %6, %19 offset:%20\n\tds_read_b64_tr_b16 %7, %19 offset:%21\n\ts_waitcnt lgkmcnt(0)"
                 : "=&v"(l4), "=&v"(h4), "=&v"(l5), "=&v"(h5), "=&v"(l6), "=&v"(h6), "=&v"(l7), "=&v"(h7),
                   "+v"(l0), "+v"(h0), "+v"(l1), "+v"(h1), "+v"(l2), "+v"(h2), "+v"(l3), "+v"(h3)
                 : "v"(a4), "v"(a5), "v"(a6), "v"(a7), "n"(O), "n"(O + 4096) : "memory");
    f[0] = __builtin_shufflevector(l0, h0, 0, 1, 2, 3, 4, 5, 6, 7); f[1] = __builtin_shufflevector(l1, h1, 0, 1, 2, 3, 4, 5, 6, 7);
    f[2] = __builtin_shufflevector(l2, h2, 0, 1, 2, 3, 4, 5, 6, 7); f[3] = __builtin_shufflevector(l3, h3, 0, 1, 2, 3, 4, 5, 6, 7);
    f[4] = __builtin_shufflevector(l4, h4, 0, 1, 2, 3, 4, 5, 6, 7); f[5] = __builtin_shufflevector(l5, h5, 0, 1, 2, 3, 4, 5, 6, 7);
    f[6] = __builtin_shufflevector(l6, h6, 0, 1, 2, 3, 4, 5, 6, 7); f[7] = __builtin_shufflevector(l7, h7, 0, 1, 2, 3, 4, 5, 6, 7);
}
#define LBAR() do { asm volatile("s_waitcnt lgkmcnt(0)" ::: "memory"); __builtin_amdgcn_s_barrier(); asm volatile("" ::: "memory"); } while (0)
__device__ __forceinline__ int chunk_row0(int b, int ci) { return ci < 2 ? NLAT + b * CT + ci * 128 : b * TL + (ci - 2) * 128; }
__device__ __forceinline__ float log2_gamma(float decay) { return -log1pf(expf(-decay)) * 1.4426950408889634f; }

template <int HALF>
__device__ __forceinline__ void pool_item(const LAS unsigned char* tile, bf16_t* A2, int t0, int T, int rbase, int rl, int cg) {
    const int t = t0 + rl; int cnt = 0;
    float s[8];
#pragma unroll
    for (int i = 0; i < 8; ++i) s[i] = 0.f;
    u32x4 c = (u32x4){0u, 0u, 0u, 0u};
#pragma unroll
    for (int w = 0; w < 2 * HALF; ++w) { const int tt = t - HALF + w; const bool ok = tt >= 0 && tt < T;
        u32x4 x = *(const LAS u32x4*)(tile + (rl + 8 - HALF + w) * 1024 + cg * 16); if (!ok) x = (u32x4){0u, 0u, 0u, 0u}; cnt += ok ? 1 : 0; if (w == HALF) c = x;
        s[0] += bflo(x.x); s[1] += bfhi(x.x); s[2] += bflo(x.y); s[3] += bfhi(x.y); s[4] += bflo(x.z); s[5] += bfhi(x.z); s[6] += bflo(x.w); s[7] += bfhi(x.w); }
    const float inv = 1.0f / (float)cnt;
    u32x4 o; o.x = pk2(s[0] * inv - bflo(c.x), s[1] * inv - bfhi(c.x)); o.y = pk2(s[2] * inv - bflo(c.y), s[3] * inv - bfhi(c.y));
    o.z = pk2(s[4] * inv - bflo(c.z), s[5] * inv - bfhi(c.z)); o.w = pk2(s[6] * inv - bflo(c.w), s[7] * inv - bfhi(c.w));
    *(u32x4*)(A2 + (size_t)(rbase + t) * D + 512 + cg * 8) = o;
}

__device__ __forceinline__ void p3a_states_pool(const Frame& F, int l) {
    const bf16_t* P = (const bf16_t*)(F.ws + WS_P);
    bf16_t* ST = (bf16_t*)(F.ws + WS_ACT);
    bf16_t* A2 = hbuf(F);
    const int nstate = (F.G > 128) ? 128 : F.G;
    if (F.bx < nstate) {
        for (int unit = F.bx; unit < 128; unit += nstate) {
            const int dir = unit & 1, bh = unit >> 1, b = bh >> 2, h = bh & 3;
            const float lg2 = log2_gamma((dir ? F.in[I_DB] : F.in[I_DF])[l * NH + h]);
            const float gC = exp2f(lg2 * 128.0f);
            f32x4 acc[8];
#pragma unroll
            for (int dt = 0; dt < 8; ++dt) acc[dt] = (f32x4){0.f, 0.f, 0.f, 0.f};
            u32x4 kr[8], vr[8];
#define P3A_CI(n_) (dir ? ((n_) < 2 ? 1 - (n_) : 19 - (n_)) : (n_))
#define P3A_LOAD(st_) do { _Pragma("unroll") for (int sub = 0; sub < 2; ++sub) { const int r0_ = chunk_row0(b, P3A_CI(2 * (st_) + sub)); \
                _Pragma("unroll") for (int q = 0; q < 4; ++q) { const int p = F.tid + 512 * q, j = p >> 4, ch = p & 15; \
                    kr[sub * 4 + q] = *(const u32x4*)(P + (size_t)(r0_ + j) * NP + 512 + h * 128 + ch * 8); vr[sub * 4 + q] = *(const u32x4*)(P + (size_t)(r0_ + j) * NP + 1024 + h * 128 + ch * 8); } } } while (0)
#define P3A_STORE(n_) do { unsigned char* sp = (unsigned char*)ST + ((size_t)((bh * 2 + dir) * NCHUNK + P3A_CI(n_)) * 128 + (F.wave * 16 + (F.lane & 15))) * 128 + 4 * (F.lane >> 4); \
                _Pragma("unroll") for (int dt = 0; dt < 8; ++dt) *(unsigned*)(sp + dt * 16) = pg8::pk4_fp8(acc[dt][0], acc[dt][1], acc[dt][2], acc[dt][3]); } while (0)
#define P3A_KS(KO, VO, ks) do { bf16x8 ka[8]; tr_frag8<(KO) + (ks) * 8192>(ka, tpk); \
                _Pragma("unroll") for (int dt = 0; dt < 8; ++dt) acc[dt] = __builtin_amdgcn_mfma_f32_16x16x32_bf16(ka[dt], vb[ks], acc[dt], 0, 0, 0); } while (0)
#define P3A_SUB(KO, VO) do { _Pragma("unroll") for (int dt = 0; dt < 8; ++dt) acc[dt] *= gC; \
                bf16x8 vb[4]; tr_frag4<(VO), (VO) + 8192, (VO) + 16384, (VO) + 24576>(vb, tpv, tpv, tpv, tpv); \
                P3A_KS(KO, VO, 0); P3A_KS(KO, VO, 1); P3A_KS(KO, VO, 2); P3A_KS(KO, VO, 3); } while (0)
            P3A_LOAD(0);
            for (int st = 0; st < 9; ++st) {
#pragma unroll
                for (int sub = 0; sub < 2; ++sub)
#pragma unroll
                    for (int q = 0; q < 4; ++q) { const int p = F.tid + 512 * q, j = p >> 4, ch = p & 15;
                        const float kd = __builtin_amdgcn_exp2f(lg2 * (float)(dir ? j : 127 - j));
                        const u32x4 kk = kr[sub * 4 + q];
                        u32x4 ks; ks.x = pk2(bflo(kk.x) * kd, bfhi(kk.x) * kd); ks.y = pk2(bflo(kk.y) * kd, bfhi(kk.y) * kd); ks.z = pk2(bflo(kk.z) * kd, bfhi(kk.z) * kd); ks.w = pk2(bflo(kk.w) * kd, bfhi(kk.w) * kd);
                        *(LAS u32x4*)(F.lds + sub * 32768 + off_b(j, ch)) = ks; *(LAS u32x4*)(F.lds + 65536 + sub * 32768 + off_b(j, ch)) = vr[sub * 4 + q]; }
                LBAR();
                if (st < 8) P3A_LOAD(st + 1);
                const unsigned tpk = (unsigned)(size_t)F.lds + tr_base_p(F.lane); const unsigned tpv = (tpk ^ ((unsigned)F.wave << 5)) + 65536u;
                P3A_STORE(2 * st);
                P3A_SUB(0, 0);
                P3A_STORE(2 * st + 1);
                if (st < 8) P3A_SUB(32768, 32768);
                LBAR();
            }
#undef P3A_SUB
#undef P3A_KS
#undef P3A_STORE
#undef P3A_LOAD
#undef P3A_CI
        }
    } else {
        const int pb = F.bx - nstate, npb = F.G - nstate;
        u32x4 ld[10];
#define POOL_LOAD(tile_) do { const int r0_ = (tile_) * 64; int t0_, T_, rb_; if (r0_ < NLAT) { t0_ = r0_ & (TL - 1); T_ = TL; } else { t0_ = (r0_ - NLAT) & (CT - 1); T_ = CT; } rb_ = r0_ - t0_; \
            _Pragma("unroll") for (int q = 0; q < 10; ++q) { const int p = F.tid + 512 * q, rr = p >> 6, ch = p & 63; int tt = t0_ - 8 + rr; tt = tt < 0 ? 0 : (tt >= T_ ? T_ - 1 : tt); \
                ld[q] = *(const u32x4*)(P + (size_t)(rb_ + tt) * NP + 2048 + ch * 8); } } while (0)
        if (pb < 576) POOL_LOAD(pb);
        for (int tile = pb; tile < 576; tile += npb) {
            const int r0 = tile * 64; int t0, T; if (r0 < NLAT) { t0 = r0 & (TL - 1); T = TL; } else { t0 = (r0 - NLAT) & (CT - 1); T = CT; } const int rbase = r0 - t0;
            LBAR();
#pragma unroll
            for (int q = 0; q < 10; ++q) { const int p = F.tid + 512 * q; *(LAS u32x4*)(F.lds + (p >> 6) * 1024 + (p & 63) * 16) = ld[q]; }
            LBAR();
            if (tile + npb < 576) POOL_LOAD(tile + npb);
            for (int wi = F.wave; wi < 64; wi += 8) { const int g = wi & 3, rl = (wi >> 2) * 4 + (F.lane >> 4), cg = g * 16 + (F.lane & 15);
                if (g == 0) pool_item<1>(F.lds, A2, t0, T, rbase, rl, cg); else if (g == 1) pool_item<2>(F.lds, A2, t0, T, rbase, rl, cg);
                else if (g == 2) pool_item<4>(F.lds, A2, t0, T, rbase, rl, cg); else pool_item<8>(F.lds, A2, t0, T, rbase, rl, cg); }
        }
#undef POOL_LOAD
        if (l == 0 && F.G == 256) { __syncthreads(); idle_convert(F, pb * 8 + F.wave, IDLE_A, 6); }
    }
    __syncthreads();
}

__device__ __forceinline__ void p3b_retention(const Frame& F, int l) {
    const bf16_t* P = (const bf16_t*)(F.ws + WS_P);
    const bf16_t* ST = (const bf16_t*)(F.ws + WS_ACT);
    bf16_t* A2 = hbuf(F);
    const int c_lo = (l == DEPTH - 1) ? 2 : 0, ncu = NCHUNK - c_lo, nunits = 64 * ncu;
    float lgF[NH], lgB[NH];
#pragma unroll
    for (int hh = 0; hh < NH; ++hh) { lgF[hh] = log2_gamma(F.in[I_DF][l * NH + hh]); lgB[hh] = log2_gamma(F.in[I_DB][l * NH + hh]); }
    u32x4 ld[8], st[4]; bf16x8 qf[4];
#define P3B_LOAD(unit_) do { const int bh_ = (unit_) / ncu, ci_ = c_lo + (unit_) % ncu, h_ = bh_ & 3; const int r0_ = chunk_row0(bh_ >> 2, ci_); \
        _Pragma("unroll") for (int q = 0; q < 4; ++q) { const int p = F.tid + 512 * q, j = p >> 4, ch = p & 15; \
            ld[q] = *(const u32x4*)(P + (size_t)(r0_ + j) * NP + 512 + h_ * 128 + ch * 8); ld[4 + q] = *(const u32x4*)(P + (size_t)(r0_ + j) * NP + 1024 + h_ * 128 + ch * 8); } } while (0)
#define P3B_LOADQ(unit_) do { const int bh_ = (unit_) / ncu, ci_ = c_lo + (unit_) % ncu, h_ = bh_ & 3; const int r0_ = chunk_row0(bh_ >> 2, ci_); \
        _Pragma("unroll") for (int ks = 0; ks < 4; ++ks) qf[ks] = *(const bf16x8*)(P + (size_t)(r0_ + F.wave * 16 + (F.lane & 15)) * NP + h_ * 128 + ks * 32 + (F.lane >> 4) * 8); } while (0)
    if (F.vcu < nunits) { P3B_LOAD(F.vcu); P3B_LOADQ(F.vcu); }
    for (int unit = F.vcu; unit < nunits; unit += F.G) {
        int lane_o = F.lane; asm volatile("" : "+v"(lane_o));
        const int fr = lane_o & 15, fq = lane_o >> 4;
        const unsigned rr0 = off_b((unsigned)fr, (unsigned)fq), tp = (unsigned)(size_t)F.lds + tr_base_p((unsigned)lane_o);
        const int il = F.wave * 16 + fr;
        const int bh = unit / ncu, ci = c_lo + unit % ncu, b = bh >> 2, h = bh & 3;
        const float lgf = h == 0 ? lgF[0] : h == 1 ? lgF[1] : h == 2 ? lgF[2] : lgF[3], lgb = h == 0 ? lgB[0] : h == 1 ? lgB[1] : h == 2 ? lgB[2] : lgB[3];
        const int row0 = chunk_row0(b, ci);
        { const unsigned char* sf = (const unsigned char*)ST + ((size_t)((bh * 2 + 0) * NCHUNK + ci) * 128) * 128; const unsigned char* sb = (const unsigned char*)ST + ((size_t)((bh * 2 + 1) * NCHUNK + ci) * 128) * 128;
#pragma unroll
          for (int q = 0; q < 2; ++q) { const int p = F.tid + 512 * q, j = p >> 3, c = p & 7; st[q] = *(const u32x4*)((const unsigned char*)sf + (size_t)j * 128 + c * 16); st[2 + q] = *(const u32x4*)((const unsigned char*)sb + (size_t)j * 128 + c * 16); } }
        LBAR();
#pragma unroll
        for (int q = 0; q < 4; ++q) { const int p = F.tid + 512 * q, j = p >> 4, ch = p & 15; const unsigned o = off_b(j, ch);
            *(LAS u32x4*)(F.lds + o) = ld[q]; *(LAS u32x4*)(F.lds + 32768u + o) = ld[4 + q]; }
        LBAR();
        if (unit + F.G < nunits) P3B_LOAD(unit + F.G);
        u32x2 gg[8];
#pragma unroll
        for (int et = 0; et < 8; ++et) gg[et] = *(const u32x2*)(P + (size_t)(row0 + il) * NP + 1536 + h * 128 + 4 * fq + et * 16);
        bf16x8 pf[4];
#pragma unroll
        for (int ks2 = 0; ks2 < 4; ++ks2) {
            u32x2 half[2];
#pragma unroll
            for (int t = 0; t < 2; ++t) { const int jt = 2 * ks2 + t;
                asm volatile("" ::: "memory");
                f32x4 sa = (f32x4){0.f, 0.f, 0.f, 0.f};
#pragma unroll
                for (int ks = 0; ks < 4; ++ks) { const bf16x8 ka = *(const LAS bf16x8*)(F.lds + ((rr0 ^ ((unsigned)ks << 6)) + 4096u * jt)); sa = __builtin_amdgcn_mfma_f32_16x16x32_bf16(ka, qf[ks], sa, 0, 0, 0); }
                float pv[4];
#pragma unroll
                for (int r = 0; r < 4; ++r) { const int j = 16 * jt + 4 * fq + r, df = il - j;
                    const float w = df > 0 ? __builtin_amdgcn_exp2f(lgf * (float)df) : (df < 0 ? __builtin_amdgcn_exp2f(lgb * (float)(-df)) : 2.0f); pv[r] = sa[r] * w; }
                half[t].x = pk2(pv[0], pv[1]); half[t].y = pk2(pv[2], pv[3]); }
            const u32x4 w4 = (u32x4){half[0].x, half[0].y, half[1].x, half[1].y};
            pf[ks2] = __builtin_bit_cast(bf16x8, w4);
        }
#pragma unroll
        for (int q = 0; q < 2; ++q) { const int p = F.tid + 512 * q, j = p >> 3, c = p & 7;
#pragma unroll
            for (int sd = 0; sd < 2; ++sd) { const u32x4 w = st[2 * sd + q];
                u32x4 lo, hi;
                lo.x = pk2(__builtin_amdgcn_cvt_f32_fp8((int)w.x, 0), __builtin_amdgcn_cvt_f32_fp8((int)w.x, 1)); lo.y = pk2(__builtin_amdgcn_cvt_f32_fp8((int)w.x, 2), __builtin_amdgcn_cvt_f32_fp8((int)w.x, 3));
                lo.z = pk2(__builtin_amdgcn_cvt_f32_fp8((int)w.y, 0), __builtin_amdgcn_cvt_f32_fp8((int)w.y, 1)); lo.w = pk2(__builtin_amdgcn_cvt_f32_fp8((int)w.y, 2), __builtin_amdgcn_cvt_f32_fp8((int)w.y, 3));
                hi.x = pk2(__builtin_amdgcn_cvt_f32_fp8((int)w.z, 0), __builtin_amdgcn_cvt_f32_fp8((int)w.z, 1)); hi.y = pk2(__builtin_amdgcn_cvt_f32_fp8((int)w.z, 2), __builtin_amdgcn_cvt_f32_fp8((int)w.z, 3));
                hi.z = pk2(__builtin_amdgcn_cvt_f32_fp8((int)w.w, 0), __builtin_amdgcn_cvt_f32_fp8((int)w.w, 1)); hi.w = pk2(__builtin_amdgcn_cvt_f32_fp8((int)w.w, 2), __builtin_amdgcn_cvt_f32_fp8((int)w.w, 3));
                const unsigned img = sd ? 98304u : 65536u;
                *(LAS u32x4*)(F.lds + img + off_b(j, 2 * c)) = lo; *(LAS u32x4*)(F.lds + img + off_b(j, 2 * c + 1)) = hi; } }
        LBAR();
        const float qdf = __builtin_amdgcn_exp2f(lgf * (float)(il + 1)), qdb = __builtin_amdgcn_exp2f(lgb * (float)(128 - il));
        float o[8][4]; float ss = 0.f;
#pragma unroll
        for (int et = 0; et < 8; ++et) {
            f32x4 ao = (f32x4){0.f, 0.f, 0.f, 0.f}, af = ao, ab = ao;
            bf16x8 va[4]; { const unsigned a = tp ^ ((unsigned)et << 5); tr_frag4<32768, 32768 + 8192, 32768 + 16384, 32768 + 24576>(va, a, a, a, a); }
#pragma unroll
            for (int ks = 0; ks < 4; ++ks) {
                ao = __builtin_amdgcn_mfma_f32_16x16x32_bf16(va[ks], pf[ks], ao, 0, 0, 0);
                const unsigned ra = (rr0 ^ ((unsigned)ks << 6)) + 4096u * et;
                const bf16x8 fa = *(const LAS bf16x8*)(F.lds + 65536u + ra);
                af = __builtin_amdgcn_mfma_f32_16x16x32_bf16(fa, qf[ks], af, 0, 0, 0);
                const bf16x8 ba = *(const LAS bf16x8*)(F.lds + 98304u + ra);
                ab = __builtin_amdgcn_mfma_f32_16x16x32_bf16(ba, qf[ks], ab, 0, 0, 0);
            }
#pragma unroll
            for (int r = 0; r < 4; ++r) { o[et][r] = ao[r] + qdf * af[r] + qdb * ab[r]; ss += o[et][r] * o[et][r]; }
        }
        if (unit + F.G < nunits) P3B_LOADQ(unit + F.G);
        ss += __shfl_xor(ss, 16); ss += __shfl_xor(ss, 32);
        const float rstd = 1.0f / sqrtf(ss * (1.0f / 128.0f) + EPS);
        bf16_t* op = A2 + (size_t)(row0 + il) * D + h * 128 + 4 * fq;
#pragma unroll
        for (int et = 0; et < 8; ++et) { const u32x2 g = gg[et];
            u32x2 w; w.x = pk2(silu_f(bflo(g.x)) * o[et][0] * rstd, silu_f(bfhi(g.x)) * o[et][1] * rstd); w.y = pk2(silu_f(bflo(g.y)) * o[et][2] * rstd, silu_f(bfhi(g.y)) * o[et][3] * rstd);
            *(u32x2*)(op + et * 16) = w; }
    }
#undef P3B_LOAD
#undef P3B_LOADQ
    __syncthreads();
}

#ifndef TYPE_MASK
#define TYPE_MASK 0x3ff
#endif
#define PTYPE(k) ((k) == 0 ? 0 : ((k) == 17 ? 9 : 1 + (((k) - 1) & 7)))
#define ENTER() do { if (PROBE_REPEAT >= 0) __syncthreads(); int _t = threadIdx.x; asm volatile("" : "+v"(_t)); F.tid = _t; F.lane = _t & 63; F.wave = __builtin_amdgcn_readfirstlane(_t >> 6); } while (0)
#define IN(k) (((TYPE_MASK >> PTYPE(k)) & 1) && lo <= (k) && (k) < hi)
#define SEAM(k) do { if (IN(k) && IN((k) + 1)) xcd_barrier(bar); } while (0)
#define REP(t) for (int rep = (PROBE_REPEAT == (t)) ? 0 : 1; rep < 2; ++rep)


template <int l> __device__ __forceinline__ void layer_phases(Frame& F, const XcdBarrier& bar, const int lo, const int hi) {
        const int pb = 1 + 8 * l;
        const bool last = (l == DEPTH - 1);
        const int Mrows = last ? NLAT : NTOK;
        if (IN(pb + 0)) REP(1) { ENTER(); row_op_a(F, l == 0 ? 0 : 1, rep == 0); }
        SEAM(pb + 0);
        if (IN(pb + 1)) REP(2) { ENTER();
            pg8::SchedDense S; S.init(NTOK, NP, D, F.G, F.bx);
            pg8::EpiInProj E{(bf16_t*)(F.ws + WS_P), (const float*)(F.ws + WS_ROPE), (const float*)(F.ws + WS_ROPE) + 96 * 32};
            pg8::gemm_phase<pg8::EpiInProj, pg8::SchedDense, true, true>(F.lds, F.tid, (const char*)hbuf(F), (const char*)(F.ws + WS_WIN) + (size_t)l * NP * D * 2, D, S, E);
        }
        SEAM(pb + 1);
        if (IN(pb + 2)) REP(3) { ENTER(); p3a_states_pool(F, l); }
        SEAM(pb + 2);
        if (IN(pb + 3)) REP(4) { ENTER(); p3b_retention(F, l); }
        SEAM(pb + 3);
        if (IN(pb + 4)) REP(5) { ENTER();
            pg8::SchedDense S; S.init(Mrows, D, D, F.G, F.bx);
            pg8::EpiResid E;
            if (l == 0) { E.rl = F.in[I_X]; E.rc = F.in[I_CTX]; E.rb = nullptr; } else { E.rl = nullptr; E.rc = nullptr; E.rb = (const bf16_t*)(F.ws + WS_XB); }
            E.ob = (rep == 0) ? (bf16_t*)(F.ws + WS_P) : (bf16_t*)(F.ws + WS_XB); E.ssq = (float*)(F.ws + WS_SSQ); E.gmod = mod_ptr(F, l, 0, 2);
            pg8::gemm_phase<pg8::EpiResid, pg8::SchedDense, true, true>(F.lds, F.tid, (const char*)hbuf(F), (const char*)(F.ws + WS_WOUT) + (size_t)l * D * D * 2, D, S, E);
            if (l == 0 && F.G == 256 && F.bx >= 64) idle_convert(F, (F.bx - 64) * 8 + F.wave, 0, 8);
        }
        SEAM(pb + 4);
        if (IN(pb + 5)) REP(6) { ENTER(); if (PROBE_REPEAT == 6 && rep == 0) row_op_b<true>(F, l); else row_op_b<false>(F, l); }
        SEAM(pb + 5);
        if (IN(pb + 6)) REP(7) { ENTER();
            LAS int* tb = build_tb(F, l);
            LAS int* tokt = (LAS int*)(F.lds + TOKT_OFF);
            const int* list = (const int*)(F.ws + WS_LIST);
            pg8::SchedGroup S; S.tb = tb; S.tokt = tokt; S.G = F.G; S.c = F.vcu; S.pitch = D; S.gather = 1;
            { int tokv[8];
#pragma unroll
              for (int i = 0; i < 8; ++i) { pg8::Unit u; tokv[i] = -1;
                  if (S.next(i, u)) { const int g = u.pm; const int e = (int)__popcll(__ballot(F.lane < NE && tb[F.lane + 1] <= g)); const int rt = g - tb[e], cnt = tb[64 + e];
                      if (F.tid < 256) { int r = rt * 256 + F.tid; if (r >= cnt) r = cnt - 1; tokv[i] = list[(size_t)e * NTOK + r]; } } }
#pragma unroll
              for (int i = 0; i < 8; ++i) if (F.tid < 256 && tokv[i] >= 0) tokt[i * 256 + F.tid] = tokv[i]; }
            __syncthreads();
            pg8::EpiSwiGLU8 E{(unsigned char*)(F.ws + WS_ACT), 1.0f / WGU_SCALE};
            pg8::gemm_phase<pg8::EpiSwiGLU8, pg8::SchedGroup, true, true, true>(F.lds, F.tid, (const char*)hbuf(F), (const char*)(F.ws + WS_WGU) + (size_t)l * NE * 1024 * D, D, S, E);
        }
        SEAM(pb + 6);
        if (IN(pb + 7)) REP(8) { ENTER();
            LAS int* tb = build_tb(F, l);
            pg8::SchedGroup S; S.tb = tb; S.tokt = nullptr; S.G = F.G; S.c = F.vcu; S.pitch = FF; S.gather = 0;
            pg8::EpiFp8S E{(unsigned char*)(F.ws + WS_P), D, 1.0f / WD_SCALE};
            pg8::gemm_phase<pg8::EpiFp8S, pg8::SchedGroup, true, true, true>(F.lds, F.tid, (const char*)(F.ws + WS_ACT), (const char*)(F.ws + WS_WD) + (size_t)l * NE * D * FF, FF, S, E);
        }
        SEAM(pb + 7);
}

__global__ void __launch_bounds__(512, 2) fwd_kernel(Args args) {
    extern __shared__ __attribute__((aligned(16))) unsigned char lds_raw[];
    Frame F;
    F.lds = (LAS unsigned char*)lds_raw; F.tid = threadIdx.x; F.lane = F.tid & 63; F.wave = __builtin_amdgcn_readfirstlane(F.tid >> 6);
    F.G = gridDim.x; F.bx = blockIdx.x; F.vcu = (F.G % 8 == 0) ? (F.bx % 8) * (F.G / 8) + F.bx / 8 : F.bx;
    F.in = args.in; F.out = args.out; F.ws = args.ws;
    volatile LAS unsigned* MISC = (volatile LAS unsigned*)(F.lds + MISC_OFF);
    if (F.tid < 4) MISC[F.tid] = 0u;
    __syncthreads();
    unsigned* ctl = (unsigned*)(F.ws + WS_CTL);
    XcdBarrier bar; bar.bar = ctl + CW_BAR; bar.x = 0; bar.st = nullptr;
    const int lo = args.ph_lo, hi = args.ph_hi;
    const bool multi = (hi - lo) > 1;
    if (multi) bar = xcd_barrier_post(ctl + CW_BAR, MISC);
    if (IN(0)) REP(0) { ENTER(); p0_prologue(F, rep); }
    SEAM(0);
    layer_phases<0>(F, bar, lo, hi);
    layer_phases<1>(F, bar, lo, hi);
    if (IN(17)) REP(9) { ENTER(); row_op_a(F, 2, rep == 0); }
#undef IN
#undef SEAM
}

extern "C" void kernel_launch(void* const* d_in, const int* in_sizes, int n_in, void* d_out, int out_size, void* d_ws, size_t ws_size, hipStream_t stream) {
    static int grid = 0;
    if (grid == 0) {
        if (n_in != 22 || out_size != NLAT * D || ws_size < WS_END) { fprintf(stderr, "kernel_launch: unexpected shapes (n_in %d, out %d, ws %zu)\n", n_in, out_size, ws_size); grid = -1; return; }
        int dev = 0, cus = 0, per_cu = 0;
        if (hipGetDevice(&dev) != hipSuccess || hipDeviceGetAttribute(&cus, hipDeviceAttributeMultiprocessorCount, dev) != hipSuccess) { grid = -1; return; }
        if (hipFuncSetAttribute((const void*)fwd_kernel, hipFuncAttributeMaxDynamicSharedMemorySize, LDS_BYTES) != hipSuccess) { fprintf(stderr, "kernel_launch: hipFuncSetAttribute failed\n"); grid = -1; return; }
        if (hipOccupancyMaxActiveBlocksPerMultiprocessor(&per_cu, (const void*)fwd_kernel, 512, LDS_BYTES) != hipSuccess || per_cu < 1) { fprintf(stderr, "kernel_launch: occupancy query says %d\n", per_cu); }
        (void)hipGetLastError();
        grid = cus;
    }
    if (grid < 0) return;
    (void)hipMemsetAsync((char*)d_ws + WS_CTL, 0, CTL_ZERO_BYTES, stream);
    Args a{};
    for (int i = 0; i < 22; ++i) a.in[i] = (const float*)d_in[i];
    a.out = (float*)d_out; a.ws = (unsigned char*)d_ws;
    if (MK_N_LAUNCHES == 1) { a.ph_lo = 0; a.ph_hi = N_PHASES; hipLaunchKernelGGL(fwd_kernel, dim3(grid), dim3(512), LDS_BYTES, stream, a); }
    else { for (int p = 0; p < N_PHASES; ++p) { a.ph_lo = p; a.ph_hi = p + 1; hipLaunchKernelGGL(fwd_kernel, dim3(grid), dim3(512), LDS_BYTES, stream, a); } }
}
```

```cpp
#include <hip/hip_runtime.h>
#include <cstdio>
#include <cstdint>

#ifndef MK_N_LAUNCHES
#define MK_N_LAUNCHES 1
#endif

#ifndef PROBE_REPEAT
#define PROBE_REPEAT -1
#endif
#define LAS __attribute__((address_space(3)))
#define GAS __attribute__((address_space(1)))
typedef unsigned short bf16_t;
typedef short bf16x8 __attribute__((ext_vector_type(8)));
typedef short s16x4 __attribute__((ext_vector_type(4)));
typedef float f32x4 __attribute__((ext_vector_type(4)));
typedef float f32x2 __attribute__((ext_vector_type(2)));
typedef unsigned u32x4 __attribute__((ext_vector_type(4)));
typedef unsigned u32x2 __attribute__((ext_vector_type(2)));

constexpr int Bn = 16, TL = 2048, CT = 256, D = 1024, DEPTH = 2;
constexpr int NLAT = Bn * TL, NCTX = Bn * CT, NTOK = NLAT + NCTX;
constexpr int NP = 2560;
constexpr int NE = 32, FF = 512, NH = 4, HD = 128;
constexpr int NCHUNK = 18;
constexpr float EPS = 1e-6f;
constexpr int MAXTILES = 320;
constexpr int N_PHASES = 18;

constexpr size_t MiB = 1u << 20;
constexpr size_t WS_CTL = 0, CTL_ZERO_BYTES = 1 * MiB;
constexpr size_t WS_MOD = 1 * MiB;
constexpr size_t WS_ROPE = 2 * MiB;
constexpr size_t WS_RIMG = 2 * MiB + 65536;
constexpr size_t WS_TOKINFO = 3 * MiB;
constexpr size_t WS_LIST = 5 * MiB;
constexpr size_t WS_WIN = 10 * MiB;
constexpr size_t WS_WOUT = 20 * MiB;
constexpr size_t WS_WGU = 24 * MiB;
constexpr size_t WS_WD = 152 * MiB;
constexpr size_t WS_SSQ = 216 * MiB;
constexpr size_t WS_XB = 232 * MiB;
constexpr size_t WS_P = 304 * MiB;
constexpr size_t WS_ACT = 484 * MiB;
constexpr size_t WS_END = 564 * MiB;
constexpr int CW_TMO = 0;
constexpr int CW_QUEUE = 512;
constexpr int CW_CNT = 1024;
constexpr int CW_BAR = 4096;

constexpr int RING_BYTES = 131072;
constexpr int TOKT_OFF = RING_BYTES;
constexpr int MISC_OFF = 161792;
constexpr int RW_PITCH = 2064;
constexpr int RW_LO = 36 * RW_PITCH, RW_EX = 2 * 36 * RW_PITCH;
constexpr int LDS_BYTES = 163840;

__device__ __forceinline__ unsigned f2bf(float f) { unsigned u = __builtin_bit_cast(unsigned, f); return (u + 0x7fffu + ((u >> 16) & 1u)) >> 16; }
typedef __bf16 bf16x2_t __attribute__((ext_vector_type(2)));
__device__ __forceinline__ unsigned pk2(float lo, float hi) { const f32x2 f = {lo, hi}; const bf16x2_t v = __builtin_convertvector(f, bf16x2_t); return __builtin_bit_cast(unsigned, v); }
__device__ __forceinline__ float bflo(unsigned w) { return __builtin_bit_cast(float, w << 16); }
__device__ __forceinline__ float bfhi(unsigned w) { return __builtin_bit_cast(float, w & 0xffff0000u); }
__device__ __forceinline__ float wave_sum(float v) {
#pragma unroll
    for (int o = 1; o < 64; o <<= 1) v += __shfl_xor(v, o);
    return v;
}
__device__ __forceinline__ float silu_f(float x) { return x * __builtin_amdgcn_rcpf(1.0f + __builtin_amdgcn_exp2f(-1.4426950408889634f * x)); }

#define XB_TMO      128
#define XB_XCNT(j)  (256  + 64 * (j))
#define XB_XSUB(j)  (1280 + 64 * (j))
#define XB_XGEN(j)  (2304 + 64 * (j))
#define XB_TOP      3328
#define XB_TOPGEN   3392
#define XCD_BAR_WORDS 3456
#define XB_SPIN_CAP (1u << 18)
__device__ __forceinline__ unsigned xb_ld(unsigned* p)              { return __hip_atomic_load(p, __ATOMIC_RELAXED, __HIP_MEMORY_SCOPE_AGENT); }
__device__ __forceinline__ unsigned xb_add(unsigned* p, unsigned v) { return __hip_atomic_fetch_add(p, v, __ATOMIC_RELAXED, __HIP_MEMORY_SCOPE_AGENT); }
__device__ __forceinline__ unsigned xb_xcc_id() { return (unsigned)__builtin_amdgcn_s_getreg((3 << 11) | 20) & 0xFu; }
#define XB_SPIN(cond, bar) do { unsigned _sp = 0; while (cond) { __builtin_amdgcn_s_sleep(1); \
    if ((++_sp & 255u) == 0u) { if (xb_ld(&(bar)[XB_TMO])) break; if (_sp > XB_SPIN_CAP) { atomicAdd(&(bar)[XB_TMO], 1u); break; } } } } while (0)
struct XcdBarrier { unsigned* bar; unsigned x; volatile LAS unsigned* st; };
__device__ __forceinline__ XcdBarrier xcd_barrier_post(unsigned* bar, volatile LAS unsigned* st) {
    XcdBarrier b; b.bar = bar; b.x = xb_xcc_id(); b.st = st;
    if (threadIdx.x == 0) (void)xb_add(&bar[XB_XCNT(b.x)], 1u);
    return b;
}
__device__ __forceinline__ void xcd_barrier_complete(unsigned* bar, unsigned x, unsigned& nloc, unsigned& nx) {
    const unsigned G = gridDim.x * gridDim.y * gridDim.z;
    unsigned sum, cnt, mine, sp = 0u;
    for (;;) {
        sum = 0u; cnt = 0u; mine = 0u;
#pragma unroll
        for (unsigned j = 0; j < 16; ++j) { const unsigned c = xb_ld(&bar[XB_XCNT(j)]); sum += c; cnt += (c > 0u) ? 1u : 0u; mine = (j == x) ? c : mine; }
        if (sum == G) break;
        __builtin_amdgcn_s_sleep(1);
        if ((++sp & 255u) == 0u) { if (xb_ld(&bar[XB_TMO])) break; if (sp > XB_SPIN_CAP) { atomicAdd(&bar[XB_TMO], 1u); break; } }
    }
    nloc = mine > 0u ? mine : 1u; nx = cnt > 0u ? cnt : 1u;
}
__device__ __forceinline__ void xcd_barrier(const XcdBarrier& b) {
    asm volatile("s_waitcnt vmcnt(0)" ::: "memory");
    __syncthreads();
    if (threadIdx.x == 0) {
        unsigned* bar = b.bar;
        __builtin_amdgcn_s_waitcnt(0);
        unsigned nloc = b.st[0], nx = b.st[1];
        if (nloc == 0u) { xcd_barrier_complete(bar, b.x, nloc, nx); b.st[0] = nloc; b.st[1] = nx; }
        const unsigned old = xb_add(&bar[XB_XSUB(b.x)], 1u);
        const unsigned gen = old / nloc;
        if (old + 1u == (gen + 1u) * nloc) {
            __builtin_amdgcn_fence(__ATOMIC_RELEASE, "agent");
            asm volatile("s_waitcnt vmcnt(0)" ::: "memory");
            const unsigned og = xb_add(&bar[XB_TOP], 1u);
            const unsigned tg = og / nx;
            if (og + 1u == (tg + 1u) * nx) xb_add(&bar[XB_TOPGEN], 1u);
            else XB_SPIN(xb_ld(&bar[XB_TOPGEN]) == tg, bar);
            __builtin_amdgcn_fence(__ATOMIC_ACQUIRE, "agent");
            xb_add(&bar[XB_XGEN(b.x)], 1u);
            asm volatile("s_waitcnt vmcnt(0)" ::: "memory");
        } else {
            XB_SPIN(xb_ld(&bar[XB_XGEN(b.x)]) == gen, bar);
            __builtin_amdgcn_fence(__ATOMIC_ACQUIRE, "agent");
            asm volatile("s_waitcnt vmcnt(0)" ::: "memory");
        }
    }
    __syncthreads();
}

namespace pg8 {
constexpr int BM = 256, BK = 64, HALF = 128, HTB = HALF * BK * 2, STAGE_BYTES = 8 * HTB, NXCD = 8, WGM = 8;
__device__ __forceinline__ int lds_byte(int r, int c) { const int st = (r >> 4) * 2 + (c >> 5), rr = r & 15, cc = c & 31, ob = rr * 64 + cc * 2; return st * 1024 + (ob ^ (((ob >> 9) & 1) << 5)); }
__device__ __forceinline__ void stage_rc(int b, int& R, int& C) { const int st = b / 1024, sb = b % 1024, swz = sb ^ (((sb >> 9) & 1) << 5); R = (st >> 1) * 16 + swz / 64; C = (st & 1) * 32 + (swz % 64) / 2; }
__device__ __forceinline__ int perm32(int rho) { const int n = rho >> 4, i = rho & 15; return 8 * (i >> 2) + 4 * n + (i & 3); }

struct Unit { int pm, pn; unsigned bofs; int aux; };

struct SchedDense {
    int nM, nN, nwg, G, c, K;
    __device__ void init(int M, int N, int K_, int G_, int c_) { nM = M / BM; nN = N / BM; nwg = nM * nN; G = G_; c = c_; K = K_; }
    __device__ bool next(int i, Unit& u) const {
        const long L = (long)i * G + c; if (L >= nwg) return false;
        int wgid = (int)L; { const int q = nwg / NXCD, r = nwg % NXCD, xcd = wgid % NXCD, off = wgid / NXCD; wgid = (xcd < r ? xcd * (q + 1) : r * (q + 1) + (xcd - r) * q) + off; }
        const int nig = WGM * nN, gid = wgid / nig, fm = gid * WGM, gsz = (nM - fm) < WGM ? (nM - fm) : WGM;
        u.pm = fm + ((wgid % nig) % gsz); u.pn = (wgid % nig) / gsz; u.bofs = (unsigned)u.pn * (unsigned)(BM * K * 2); u.aux = 0; return true;
    }
    __device__ __forceinline__ unsigned a_row(const Unit& u, int r) const { return (unsigned)(u.pm * BM + r); }
};
struct SchedGroup {
    const LAS int* tb; const LAS int* tokt; int G, c, pitch, gather;
    __device__ bool next(int i, Unit& u) const {
        const int L = i * G + c, nt = tb[NE]; if (L >= nt * 4) return false;
        const int g = L >> 2; const int ln = (int)(threadIdx.x & 63u);
        const int e = (int)__popcll(__ballot(ln < NE && tb[ln + 1] <= g));
        u.pm = g; u.pn = L & 3; u.bofs = (unsigned)(e * 1024 + u.pn * BM) * (unsigned)pitch; u.aux = i; return true;
    }
    __device__ __forceinline__ unsigned a_row(const Unit& u, int r) const { return gather ? (unsigned)tokt[u.aux * 256 + r] : (unsigned)(u.pm * BM + r); }
};

__device__ __forceinline__ unsigned cvt_pk_bf16(float lo, float hi) { unsigned r; asm volatile("v_cvt_pk_bf16_f32 %0, %1, %2" : "=v"(r) : "v"(lo), "v"(hi)); return r; }

typedef int i32x4 __attribute__((ext_vector_type(4)));
typedef int i32x8 __attribute__((ext_vector_type(8)));
template <bool F8> struct Frag { bf16x8 k[2]; };
template <> struct Frag<true> { i32x8 v; };
template <class Epi, class Sched, bool ALIGN_EPI, bool SP2, bool F8 = false>
__device__ __forceinline__ void gemm_phase(LAS unsigned char* lds, const int tid, const char* Abase, const char* Bbase, const int K, const Sched& S, const Epi& E) {
    const int wid = __builtin_amdgcn_readfirstlane(tid >> 6), lane = tid & 63, wr = wid >> 2, wc = wid & 3, fr = lane & 15, fq = lane >> 4;
    const int nt = F8 ? K / 128 : K / BK; const unsigned pitch = F8 ? (unsigned)K : 2u * (unsigned)K;
    int Rr[2], Cc[2]; unsigned voffB[2];
#pragma unroll
    for (int i = 0; i < 2; ++i) { int R, C; stage_rc(tid * 16 + i * 8192, R, C); const int Rb = Epi::PERM ? ((R & ~31) + perm32(R & 31)) : R;
        Rr[i] = R; Cc[i] = C; voffB[i] = (unsigned)Rb * pitch + 2u * (unsigned)C; }
    const size_t kstep = (size_t)(BK * 2);
    const size_t hstep = (size_t)HALF * pitch;
    const unsigned ldsw = (unsigned)wid * 1024u;
    const int fcol = F8 ? (fq >> 1) * 32 + (fq & 1) * 16 : fq * 8;
    const int aoff = lds_byte(wr * 64 + fr, fcol), boff = lds_byte(wc * 32 + fr, fcol);
#define PG8_SA(b, h) (((b) * 2 + (h)) * HTB)
#define PG8_SB(b, h) ((4 + (b) * 2 + (h)) * HTB)
#define PG8_STAGE(bufoff, gbase, voff) do { _Pragma("unroll") for (int _i = 0; _i < 2; ++_i) \
        __builtin_amdgcn_global_load_lds((const unsigned*)((const char*)(gbase) + (voff)[_i]), (LAS unsigned*)(lds + (bufoff) + ldsw + _i * 8192), 16, 0, 0); } while (0)
#define PG8_LDF(dstf, off_) do { if constexpr (F8) { const i32x4 _lo = *(const LAS i32x4*)(lds + (off_)), _hi = *(const LAS i32x4*)(lds + (off_) + 16); dstf.v = __builtin_shufflevector(_lo, _hi, 0, 1, 2, 3, 4, 5, 6, 7); } \
        else { dstf.k[0] = *(const LAS bf16x8*)(lds + (off_)); dstf.k[1] = *(const LAS bf16x8*)(lds + (off_) + 1024); } } while (0)
#define PG8_LDA(dst, b, h) do { _Pragma("unroll") for (int m = 0; m < 4; ++m) PG8_LDF(dst[m], PG8_SA(b, h) + aoff + m * 2048); } while (0)
#define PG8_LDB(dst, b, h) do { _Pragma("unroll") for (int n = 0; n < 2; ++n) PG8_LDF(dst[n], PG8_SB(b, h) + boff + n * 2048); } while (0)
#define PG8_MMA(ai, bj, At, Bt) do { __builtin_amdgcn_s_setprio(1); _Pragma("unroll") for (int m = 0; m < 4; ++m) _Pragma("unroll") for (int n = 0; n < 2; ++n) { \
        if constexpr (F8) asm volatile("v_mfma_f32_16x16x128_f8f6f4 %0, %1, %2, %0" : "+v"(acc[ai][bj][m][n]) : "v"(Bt[n].v), "v"(At[m].v));   \
        else { _Pragma("unroll") for (int k = 0; k < 2; ++k) acc[ai][bj][m][n] = __builtin_amdgcn_mfma_f32_16x16x32_bf16(Bt[n].k[k], At[m].k[k], acc[ai][bj][m][n], 0, 0, 0); } } \
        __builtin_amdgcn_s_setprio(0); } while (0)
#define PG8_WAIT_V(n) asm volatile("s_waitcnt vmcnt(" #n ")" ::: "memory")
#define PG8_WAIT_L(n) asm volatile("s_waitcnt lgkmcnt(" #n ")" ::: "memory")
#define PG8_BAR __builtin_amdgcn_s_barrier()
#define PG8_SCHED __builtin_amdgcn_sched_barrier(0)
#define PG8_AOFF(dst, u) do { _Pragma("unroll") for (int _h = 0; _h < 2; ++_h) _Pragma("unroll") for (int _i = 0; _i < 2; ++_i) \
        dst[_h][_i] = S.a_row(u, _h * HALF + Rr[_i]) * pitch + 2u * (unsigned)Cc[_i]; } while (0)
    Unit cur, nxt; int ui = 0;
    if (!S.next(0, cur)) return;
    f32x4 acc[2][2][4][2];
#pragma unroll
    for (int a = 0; a < 2; ++a)
#pragma unroll
        for (int b = 0; b < 2; ++b)
#pragma unroll
            for (int m = 0; m < 4; ++m)
#pragma unroll
                for (int n = 0; n < 2; ++n) acc[a][b][m][n] = (f32x4){0.f, 0.f, 0.f, 0.f};
    Frag<F8> At[4], B0[2], B1[2];
    unsigned co[2][2], no[2][2];
    PG8_AOFF(co, cur);
    const char* cB = Bbase + cur.bofs;
    if constexpr (SP2) {
        PG8_STAGE(PG8_SB(0, 0), cB, voffB); PG8_STAGE(PG8_SB(0, 1), cB + hstep, voffB); PG8_STAGE(PG8_SA(0, 0), Abase, co[0]); PG8_STAGE(PG8_SA(0, 1), Abase, co[1]);
        if (wr == 1) PG8_BAR;
        PG8_WAIT_V(2); PG8_BAR;
        PG8_STAGE(PG8_SB(1, 0), cB + kstep, voffB); PG8_STAGE(PG8_SA(1, 0), Abase + kstep, co[0]); PG8_STAGE(PG8_SB(1, 1), cB + hstep + kstep, voffB);
        PG8_WAIT_V(6); PG8_BAR;
    } else {
        PG8_STAGE(PG8_SB(0, 0), cB, voffB); PG8_STAGE(PG8_SA(0, 0), Abase, co[0]); PG8_STAGE(PG8_SB(0, 1), cB + hstep, voffB); PG8_STAGE(PG8_SA(0, 1), Abase, co[1]);
        if (wr == 1) PG8_BAR;
        PG8_WAIT_V(4); PG8_BAR;
        PG8_STAGE(PG8_SB(1, 0), cB + kstep, voffB); PG8_STAGE(PG8_SA(1, 0), Abase + kstep, co[0]); PG8_STAGE(PG8_SB(1, 1), cB + hstep + kstep, voffB);
        PG8_WAIT_V(6); PG8_BAR;
    }
    for (;;) {
        const bool has_next = S.next(ui + 1, nxt);
        const char* nB = has_next ? Bbase + nxt.bofs : cB;
        if (has_next) { PG8_AOFF(no, nxt); } else {
#pragma unroll
            for (int h = 0; h < 2; ++h)
#pragma unroll
                for (int i = 0; i < 2; ++i) no[h][i] = co[h][i]; }
#pragma unroll 1
        for (int t = 0; t < nt; t += 2) {
            const bool last = (t == nt - 2);
            const char* a1 = Abase + (size_t)(t + 1) * kstep;
            const char* a2 = last ? Abase : Abase + (size_t)(t + 2) * kstep; const char* b2 = last ? nB : cB + (size_t)(t + 2) * kstep;
            const char* a3 = a2 + kstep; const char* b3 = b2 + kstep;
            unsigned o2[2][2];
#pragma unroll
            for (int h = 0; h < 2; ++h)
#pragma unroll
                for (int i = 0; i < 2; ++i) o2[h][i] = last ? no[h][i] : co[h][i];
            if constexpr (SP2) {
            PG8_LDB(B0, 0, 0); PG8_LDB(B1, 0, 1); PG8_SCHED; PG8_LDA(At, 0, 0); PG8_STAGE(PG8_SA(1, 1), a1, co[1]);
            PG8_WAIT_V(8); PG8_WAIT_L(0); PG8_BAR; PG8_MMA(0, 0, At, B0); PG8_MMA(0, 1, At, B1); PG8_BAR; PG8_SCHED;
            PG8_LDA(At, 0, 1); PG8_STAGE(PG8_SB(0, 0), b2, voffB); PG8_STAGE(PG8_SB(0, 1), b2 + hstep, voffB); PG8_STAGE(PG8_SA(0, 0), a2, o2[0]);
            PG8_WAIT_V(8); PG8_WAIT_L(0); PG8_BAR; PG8_MMA(1, 0, At, B0); PG8_MMA(1, 1, At, B1); PG8_BAR; PG8_SCHED;
            PG8_LDB(B0, 1, 0); PG8_LDB(B1, 1, 1); PG8_SCHED; PG8_LDA(At, 1, 0); PG8_STAGE(PG8_SA(0, 1), a2, o2[1]);
            PG8_WAIT_V(8); PG8_WAIT_L(0); PG8_BAR; PG8_MMA(0, 0, At, B0); PG8_MMA(0, 1, At, B1); PG8_BAR; PG8_SCHED;
            PG8_LDA(At, 1, 1); PG8_STAGE(PG8_SB(1, 0), b3, voffB); PG8_STAGE(PG8_SB(1, 1), b3 + hstep, voffB); PG8_STAGE(PG8_SA(1, 0), a3, o2[0]);
            PG8_WAIT_V(8); PG8_WAIT_L(0); PG8_BAR; PG8_MMA(1, 0, At, B0); PG8_MMA(1, 1, At, B1); PG8_BAR; PG8_SCHED;
            } else {
            PG8_LDB(B0, 0, 0); PG8_SCHED; PG8_LDA(At, 0, 0); PG8_STAGE(PG8_SA(1, 1), a1, co[1]);
            PG8_WAIT_L(8); PG8_BAR; PG8_WAIT_L(0); PG8_MMA(0, 0, At, B0); PG8_BAR; PG8_SCHED;
            PG8_LDB(B1, 0, 1); PG8_STAGE(PG8_SB(0, 0), b2, voffB);
            PG8_BAR; PG8_WAIT_L(0); PG8_MMA(0, 1, At, B1); PG8_BAR;
            PG8_LDA(At, 0, 1); PG8_STAGE(PG8_SA(0, 0), a2, o2[0]);
            PG8_BAR; PG8_WAIT_L(0); PG8_MMA(1, 0, At, B0); PG8_BAR; PG8_SCHED;
            PG8_STAGE(PG8_SB(0, 1), b2 + hstep, voffB);
            PG8_WAIT_V(6); PG8_BAR; PG8_MMA(1, 1, At, B1); PG8_BAR;
            PG8_LDB(B0, 1, 0); PG8_SCHED; PG8_LDA(At, 1, 0); PG8_STAGE(PG8_SA(0, 1), a2, o2[1]);
            PG8_WAIT_L(8); PG8_BAR; PG8_WAIT_L(0); PG8_MMA(0, 0, At, B0); PG8_BAR; PG8_SCHED;
            PG8_LDB(B1, 1, 1); PG8_STAGE(PG8_SB(1, 0), b3, voffB);
            PG8_BAR; PG8_WAIT_L(0); PG8_MMA(0, 1, At, B1); PG8_BAR;
            PG8_LDA(At, 1, 1); PG8_STAGE(PG8_SA(1, 0), a3, o2[0]);
            PG8_BAR; PG8_WAIT_L(0); PG8_MMA(1, 0, At, B0); PG8_BAR; PG8_SCHED;
            PG8_STAGE(PG8_SB(1, 1), b3 + hstep, voffB);
            PG8_WAIT_V(6); PG8_BAR; PG8_MMA(1, 1, At, B1); PG8_BAR;
            }
        }
        if constexpr (ALIGN_EPI) { if (wr == 0) PG8_BAR; }
        if constexpr (F8) { __builtin_amdgcn_sched_barrier(0); asm volatile("s_nop 15\n\ts_nop 15\n\ts_nop 7" ::: "memory"); __builtin_amdgcn_sched_barrier(0); }
        E(acc, cur, wr, wc, fr, fq);
        if (!has_next) break;
#pragma unroll
        for (int a = 0; a < 2; ++a)
#pragma unroll
            for (int b = 0; b < 2; ++b)
#pragma unroll
                for (int m = 0; m < 4; ++m)
#pragma unroll
                    for (int n = 0; n < 2; ++n) acc[a][b][m][n] = (f32x4){0.f, 0.f, 0.f, 0.f};
        cur = nxt; cB = nB; ++ui;
#pragma unroll
        for (int h = 0; h < 2; ++h)
#pragma unroll
            for (int i = 0; i < 2; ++i) co[h][i] = no[h][i];
        if constexpr (ALIGN_EPI) { if (wr == 1) PG8_BAR; }
    }
    PG8_WAIT_V(0);
    if constexpr (!ALIGN_EPI) { if (wr == 0) PG8_BAR; }
    PG8_BAR;
#undef PG8_SA
#undef PG8_SB
#undef PG8_STAGE
#undef PG8_LDA
#undef PG8_LDF
#undef PG8_LDB
#undef PG8_MMA
#undef PG8_WAIT_V
#undef PG8_WAIT_L
#undef PG8_BAR
#undef PG8_SCHED
#undef PG8_AOFF
}

struct EpiInProj {
    static constexpr bool PERM = true;
    bf16_t* P; const float* ropeC; const float* ropeS;
    __device__ __forceinline__ void operator()(const f32x4 (&acc)[2][2][4][2], const Unit& u, int wr, int wc, int fr, int fq) const {
        const int row0 = u.pm * BM + wr * 64 + fr, col0 = u.pn * BM + wc * 32 + 8 * fq;
        const bool qk = u.pn < 4, rope = qk && (u.pm < NLAT / BM);
        const float ks = (u.pn >= 2 && u.pn < 4) ? 0.08838834764831845f : 1.0f;
        const int sec = wc >> 1, i0 = (wc & 1) * 16 + 4 * fq;
#pragma unroll
        for (int ai = 0; ai < 2; ++ai)
#pragma unroll
            for (int m = 0; m < 4; ++m) {
                const int row = row0 + ai * HALF + m * 16;
                asm volatile("" ::: "memory");
                f32x4 c4 = (f32x4){1.f, 1.f, 1.f, 1.f}, s4 = (f32x4){0.f, 0.f, 0.f, 0.f};
                if (rope) { const int t = row & (TL - 1), pos = sec ? (t & 63) : (t >> 6); const int ti = (sec ? 1024 : 0) + pos * 32 + i0;
                    c4 = *(const f32x4*)(ropeC + ti); s4 = *(const f32x4*)(ropeS + ti); }
                bf16_t* rowp = P + (size_t)row * NP + col0;
#pragma unroll
                for (int bj = 0; bj < 2; ++bj) {
                    f32x4 v0 = acc[ai][bj][m][0], v1 = acc[ai][bj][m][1];
                    if (qk) {
                        const float a0 = v0[0] * c4[0] - v0[1] * s4[0], b0 = v0[0] * s4[0] + v0[1] * c4[0];
                        const float a1 = v0[2] * c4[1] - v0[3] * s4[1], b1 = v0[2] * s4[1] + v0[3] * c4[1];
                        const float a2 = v1[0] * c4[2] - v1[1] * s4[2], b2 = v1[0] * s4[2] + v1[1] * c4[2];
                        const float a3 = v1[2] * c4[3] - v1[3] * s4[3], b3 = v1[2] * s4[3] + v1[3] * c4[3];
                        v0 = (f32x4){a0 * ks, b0 * ks, a1 * ks, b1 * ks}; v1 = (f32x4){a2 * ks, b2 * ks, a3 * ks, b3 * ks};
                    }
                    u32x4 w; w.x = cvt_pk_bf16(v0[0], v0[1]); w.y = cvt_pk_bf16(v0[2], v0[3]); w.z = cvt_pk_bf16(v1[0], v1[1]); w.w = cvt_pk_bf16(v1[2], v1[3]);
                    *(u32x4*)(rowp + bj * HALF) = w;
                }
            }
    }
};
struct EpiResid {
    static constexpr bool PERM = true;
    const float* rl; const float* rc; const bf16_t* rb; bf16_t* ob; float* ssq; const float* gmod;
    __device__ __forceinline__ void operator()(const f32x4 (&acc)[2][2][4][2], const Unit& u, int wr, int wc, int fr, int fq) const {
        const int row0 = u.pm * BM + wr * 64 + fr, col0 = u.pn * BM + wc * 32 + 8 * fq;
        const bool lat = u.pm < NLAT / BM; const int b = lat ? (u.pm >> 3) : 16;
        const float* rbase = rl ? (lat ? rl : rc - (size_t)NLAT * D) : nullptr;
        f32x4 gv[2][2];
#pragma unroll
        for (int bj = 0; bj < 2; ++bj)
#pragma unroll
            for (int n = 0; n < 2; ++n) gv[bj][n] = *(const f32x4*)(gmod + (size_t)b * 6 * D + col0 + bj * HALF + 4 * n);
#pragma unroll
        for (int ai = 0; ai < 2; ++ai)
#pragma unroll
            for (int m = 0; m < 4; ++m) { const int row = row0 + ai * HALF + m * 16; const size_t off = (size_t)row * D + col0; float ss = 0.f;
#pragma unroll
                for (int bj = 0; bj < 2; ++bj) { f32x4 r0, r1;
                    if (rbase) { r0 = *(const f32x4*)(rbase + off + bj * HALF); r1 = *(const f32x4*)(rbase + off + bj * HALF + 4); }
                    else { const u32x4 w = *(const u32x4*)(rb + off + bj * HALF); r0 = (f32x4){bflo(w.x), bfhi(w.x), bflo(w.y), bfhi(w.y)}; r1 = (f32x4){bflo(w.z), bfhi(w.z), bflo(w.w), bfhi(w.w)}; }
                    const f32x4 v0 = r0 + gv[bj][0] * acc[ai][bj][m][0], v1 = r1 + gv[bj][1] * acc[ai][bj][m][1];
                    ss += (v0[0] * v0[0] + v0[1] * v0[1]) + (v0[2] * v0[2] + v0[3] * v0[3]) + (v1[0] * v1[0] + v1[1] * v1[1]) + (v1[2] * v1[2] + v1[3] * v1[3]);
                    u32x4 w; w.x = cvt_pk_bf16(v0[0], v0[1]); w.y = cvt_pk_bf16(v0[2], v0[3]); w.z = cvt_pk_bf16(v1[0], v1[1]); w.w = cvt_pk_bf16(v1[2], v1[3]);
                    *(u32x4*)(ob + off + bj * HALF) = w; }
                ss += __shfl_xor(ss, 16); ss += __shfl_xor(ss, 32);
                if (fq == 0) ssq[(size_t)row * 16 + u.pn * 4 + wc] = ss;
                if (m & 1) asm volatile("" ::: "memory"); }
    }
};
struct EpiSwiGLU {
    static constexpr bool PERM = true;
    bf16_t* O;
    __device__ __forceinline__ void operator()(const f32x4 (&acc)[2][2][4][2], const Unit& u, int wr, int wc, int fr, int fq) const {
        const int row0 = u.pm * BM + wr * 64 + fr, col0 = u.pn * 128 + wc * 16 + 4 * fq;
#pragma unroll
        for (int ai = 0; ai < 2; ++ai)
#pragma unroll
            for (int m = 0; m < 4; ++m) { bf16_t* rowp = O + (size_t)(row0 + ai * HALF + m * 16) * FF + col0;
#pragma unroll
                for (int bj = 0; bj < 2; ++bj) { const f32x4 g = acc[ai][bj][m][0], up = acc[ai][bj][m][1];
                    u32x2 w; w.x = cvt_pk_bf16(silu_f(g[0]) * up[0], silu_f(g[1]) * up[1]); w.y = cvt_pk_bf16(silu_f(g[2]) * up[2], silu_f(g[3]) * up[3]);
                    *(u32x2*)(rowp + bj * 64) = w; } }
    }
};
__device__ __forceinline__ unsigned pk4_fp8(float a, float b, float c, float d) { int p = __builtin_amdgcn_cvt_pk_fp8_f32(a, b, 0, false); p = __builtin_amdgcn_cvt_pk_fp8_f32(c, d, p, true); return (unsigned)p; }
struct EpiSwiGLU8 {
    static constexpr bool PERM = true;
    unsigned char* O; float inv;
    __device__ __forceinline__ void operator()(const f32x4 (&acc)[2][2][4][2], const Unit& u, int wr, int wc, int fr, int fq) const {
        const int row0 = u.pm * BM + wr * 64 + fr, col0 = u.pn * 128 + wc * 32 + 8 * fq;
#pragma unroll
        for (int ai = 0; ai < 2; ++ai)
#pragma unroll
            for (int m = 0; m < 4; ++m) { unsigned char* rowp = O + (size_t)(row0 + ai * HALF + m * 16) * FF + col0;
                const f32x4 g0 = acc[ai][0][m][0] * inv, g1 = acc[ai][0][m][1] * inv, u0 = acc[ai][1][m][0] * inv, u1 = acc[ai][1][m][1] * inv;
                u32x2 w; w.x = pk4_fp8(silu_f(g0[0]) * u0[0], silu_f(g0[1]) * u0[1], silu_f(g0[2]) * u0[2], silu_f(g0[3]) * u0[3]);
                w.y = pk4_fp8(silu_f(g1[0]) * u1[0], silu_f(g1[1]) * u1[1], silu_f(g1[2]) * u1[2], silu_f(g1[3]) * u1[3]);
                *(u32x2*)rowp = w; }
    }
};
struct EpiFp8S {
    static constexpr bool PERM = true;
    unsigned char* O; int ldc; float inv;
    __device__ __forceinline__ void operator()(const f32x4 (&acc)[2][2][4][2], const Unit& u, int wr, int wc, int fr, int fq) const {
        const int row0 = u.pm * BM + wr * 64 + fr, col0 = u.pn * BM + wc * 32 + 8 * fq;
#pragma unroll
        for (int ai = 0; ai < 2; ++ai)
#pragma unroll
            for (int m = 0; m < 4; ++m) { unsigned char* rowp = O + (size_t)(row0 + ai * HALF + m * 16) * ldc + col0;
#pragma unroll
                for (int bj = 0; bj < 2; ++bj) { const f32x4 v0 = acc[ai][bj][m][0] * inv, v1 = acc[ai][bj][m][1] * inv;
                    u32x2 w; w.x = pk4_fp8(v0[0], v0[1], v0[2], v0[3]); w.y = pk4_fp8(v1[0], v1[1], v1[2], v1[3]);
                    *(u32x2*)(rowp + bj * HALF) = w; } }
    }
};
struct EpiBf16S {
    static constexpr bool PERM = true;
    bf16_t* O; int ldc; float inv;
    __device__ __forceinline__ void operator()(const f32x4 (&acc)[2][2][4][2], const Unit& u, int wr, int wc, int fr, int fq) const {
        const int row0 = u.pm * BM + wr * 64 + fr, col0 = u.pn * BM + wc * 32 + 8 * fq;
#pragma unroll
        for (int ai = 0; ai < 2; ++ai)
#pragma unroll
            for (int m = 0; m < 4; ++m) { bf16_t* rowp = O + (size_t)(row0 + ai * HALF + m * 16) * ldc + col0;
#pragma unroll
                for (int bj = 0; bj < 2; ++bj) { const f32x4 v0 = acc[ai][bj][m][0] * inv, v1 = acc[ai][bj][m][1] * inv;
                    u32x4 w; w.x = cvt_pk_bf16(v0[0], v0[1]); w.y = cvt_pk_bf16(v0[2], v0[3]); w.z = cvt_pk_bf16(v1[0], v1[1]); w.w = cvt_pk_bf16(v1[2], v1[3]);
                    *(u32x4*)(rowp + bj * HALF) = w; } }
    }
};
struct EpiBf16 {
    static constexpr bool PERM = true;
    bf16_t* O; int ldc;
    __device__ __forceinline__ void operator()(const f32x4 (&acc)[2][2][4][2], const Unit& u, int wr, int wc, int fr, int fq) const {
        const int row0 = u.pm * BM + wr * 64 + fr, col0 = u.pn * BM + wc * 32 + 8 * fq;
#pragma unroll
        for (int ai = 0; ai < 2; ++ai)
#pragma unroll
            for (int m = 0; m < 4; ++m) { bf16_t* rowp = O + (size_t)(row0 + ai * HALF + m * 16) * ldc + col0;
#pragma unroll
                for (int bj = 0; bj < 2; ++bj) { const f32x4 v0 = acc[ai][bj][m][0], v1 = acc[ai][bj][m][1];
                    u32x4 w; w.x = cvt_pk_bf16(v0[0], v0[1]); w.y = cvt_pk_bf16(v0[2], v0[3]); w.z = cvt_pk_bf16(v1[0], v1[1]); w.w = cvt_pk_bf16(v1[2], v1[3]);
                    *(u32x4*)(rowp + bj * HALF) = w; } }
    }
};
}

struct Args { const float* in[22]; float* out; unsigned char* ws; int ph_lo, ph_hi; };
enum { I_X = 0, I_C, I_CTX, I_CCTX, I_ADAW, I_ADAB, I_N1G, I_WIN, I_DF, I_DB, I_POOLW, I_POOLS, I_WOUT, I_N2G, I_RGW, I_RGB, I_REW, I_REB, I_WG, I_WU, I_WDN, I_FNG };

struct Frame {
    LAS unsigned char* lds; int tid, lane, wave, G, bx, vcu;
    const float* const* in; float* out; unsigned char* ws;
};
__device__ __forceinline__ bf16_t* xb_row(const Frame& F, int row) { return (bf16_t*)(F.ws + WS_XB) + (size_t)row * D; }
__device__ __forceinline__ bf16_t* hbuf(const Frame& F) { return (bf16_t*)F.out; }
__device__ __forceinline__ const float* mod_ptr(const Frame& F, int l, int b, int which) { return (const float*)(F.ws + WS_MOD) + ((size_t)(l * 17 + b) * 6 + which) * D; }

__device__ __forceinline__ void tr_item(const float* colp, size_t ldw, int k0, bf16_t* WT, int K, int n0, LAS float* scr, int lane) {
    { float v[32];
#pragma unroll
        for (int i = 0; i < 32; ++i) v[i] = colp[(size_t)(k0 + 2 * i + (lane >> 5)) * ldw];
#pragma unroll
        for (int i = 0; i < 32; ++i) scr[(2 * i + (lane >> 5)) * 33 + (lane & 31)] = v[i]; }
    asm volatile("s_waitcnt lgkmcnt(0)" ::: "memory");
    const int c = lane & 7;
#pragma unroll
    for (int j = 0; j < 4; ++j) { const int n = (lane >> 3) + 8 * j; const LAS float* s = scr + (8 * c) * 33 + n;
        u32x4 o; o.x = pk2(s[0 * 33], s[1 * 33]); o.y = pk2(s[2 * 33], s[3 * 33]); o.z = pk2(s[4 * 33], s[5 * 33]); o.w = pk2(s[6 * 33], s[7 * 33]);
        *(u32x4*)(WT + (size_t)(n0 + n) * K + k0 + 8 * c) = o; }
    asm volatile("s_waitcnt lgkmcnt(0)" ::: "memory");
}
constexpr float WGU_SCALE = 64.0f, WD_SCALE = 32.0f;
__device__ __forceinline__ void tr_item8(const float* colp, size_t ldw, int k0, unsigned char* WT, int K, int n0, LAS float* scr, int lane, float qs) {
    { float v[32];
#pragma unroll
        for (int i = 0; i < 32; ++i) v[i] = colp[(size_t)(k0 + 2 * i + (lane >> 5)) * ldw];
#pragma unroll
        for (int i = 0; i < 32; ++i) scr[(2 * i + (lane >> 5)) * 33 + (lane & 31)] = v[i] * qs; }
    asm volatile("s_waitcnt lgkmcnt(0)" ::: "memory");
    const int c = lane & 7;
#pragma unroll
    for (int j = 0; j < 4; ++j) { const int n = (lane >> 3) + 8 * j; const LAS float* s = scr + (8 * c) * 33 + n;
        u32x2 o; o.x = pg8::pk4_fp8(s[0 * 33], s[1 * 33], s[2 * 33], s[3 * 33]); o.y = pg8::pk4_fp8(s[4 * 33], s[5 * 33], s[6 * 33], s[7 * 33]);
        *(u32x2*)(WT + (size_t)(n0 + n) * K + k0 + 8 * c) = o; }
    asm volatile("s_waitcnt lgkmcnt(0)" ::: "memory");
}
__device__ __forceinline__ void fold_item(const float* win, const float* pw, const float* ps, int k0, bf16_t* WT, int n0, LAS float* scr, int lane) {
    const int n = n0 + (lane & 31), g = n >> 7, nn = n & 127;
    const float* pwc = pw + (size_t)g * 128 * 128 + nn; const float sc = ps[n];
    float acc[32];
#pragma unroll
    for (int i = 0; i < 32; ++i) acc[i] = 0.f;
    for (int hc = 0; hc < 8; ++hc) {
        float pc[16];
#pragma unroll
        for (int c = 0; c < 16; ++c) pc[c] = pwc[(size_t)(hc * 16 + c) * 128];
#pragma unroll
        for (int i = 0; i < 32; ++i) { const f32x4* wr = (const f32x4*)(win + (size_t)(k0 + 2 * i + (lane >> 5)) * NP + 2048 + g * 128 + hc * 16);
            float a = acc[i];
#pragma unroll
            for (int c4 = 0; c4 < 4; ++c4) { const f32x4 w = wr[c4]; a += w[0] * pc[4 * c4] + w[1] * pc[4 * c4 + 1] + w[2] * pc[4 * c4 + 2] + w[3] * pc[4 * c4 + 3]; }
            acc[i] = a; }
    }
#pragma unroll
    for (int i = 0; i < 32; ++i) scr[(2 * i + (lane >> 5)) * 33 + (lane & 31)] = acc[i] * sc;
    asm volatile("s_waitcnt lgkmcnt(0)" ::: "memory");
    const int c = lane & 7;
#pragma unroll
    for (int j = 0; j < 4; ++j) { const int nl = (lane >> 3) + 8 * j; const LAS float* s = scr + (8 * c) * 33 + nl;
        u32x4 o; o.x = pk2(s[0 * 33], s[1 * 33]); o.y = pk2(s[2 * 33], s[3 * 33]); o.z = pk2(s[4 * 33], s[5 * 33]); o.w = pk2(s[6 * 33], s[7 * 33]);
        *(u32x4*)(WT + (size_t)(2048 + n0 + nl) * D + k0 + 8 * c) = o; }
    asm volatile("s_waitcnt lgkmcnt(0)" ::: "memory");
}
constexpr int IT_WIN = 16 * 80, IT_WOUT = 16 * 32, IT_GU = 16 * 32, IT_DN = 8 * 32;
constexpr int N_WIN = DEPTH * IT_WIN, N_WOUT = DEPTH * IT_WOUT, N_SMALL = N_WIN + N_WOUT, EXP_ITEMS = NE * (IT_GU + IT_DN);
constexpr int Z_S1 = 0, N_S1 = 96 * 8 * 6, Z_S2 = Z_S1 + N_S1, N_S2 = 128 * 8 * 6, Z_S3 = Z_S2 + N_S2, N_S3 = 128 * 8 * 2, Z_S4 = Z_S3 + N_S3, N_S4 = 192 * 8 * 8;
constexpr int Z_S7 = Z_S4 + N_S4, N_S7 = 96 * 8 * 6, Z_S8 = Z_S7 + N_S7, N_S8 = 128 * 8 * 6, Z_END = Z_S8 + N_S8;
constexpr int L1_IDLE = Z_END - EXP_ITEMS;
static_assert(Z_S7 >= EXP_ITEMS && L1_IDLE <= EXP_ITEMS && (N_SMALL + EXP_ITEMS - L1_IDLE) % 32 == 0 && (N_SMALL + 2 * EXP_ITEMS) % 32 == 0, "item partition");
__device__ __forceinline__ void expert_item(const Frame& F, int layer, int q, LAS float* scr) {
    if (q < NE * IT_GU) { const int le = layer * NE + q / IT_GU; const int r = q % IT_GU, kb = r / 32, nb = r % 32, n0 = nb * 32;
        const int n = n0 + (F.lane & 31), col = (n >> 8) * 128 + (n & 127); const float* src = ((n & 128) ? F.in[I_WU] : F.in[I_WG]) + (size_t)le * D * FF + col;
        tr_item8(src, FF, kb * 64, (unsigned char*)(F.ws + WS_WGU) + (size_t)le * 1024 * D, D, n0, scr, F.lane, WGU_SCALE); }
    else { q -= NE * IT_GU; const int le = layer * NE + q / IT_DN; const int r = q % IT_DN, kb = r / 32, nb = r % 32, n0 = nb * 32;
        tr_item8(F.in[I_WDN] + (size_t)le * FF * D + n0 + (F.lane & 31), D, kb * 64, (unsigned char*)(F.ws + WS_WD) + (size_t)le * D * FF, FF, n0, scr, F.lane, WD_SCALE); }
}
__device__ __forceinline__ void p0_prologue(const Frame& F, int qsel) {
    for (int task = F.bx; task < 2 * 96; task += F.G) {
        const int l = task / 96, cg = task % 96;
        LAS float* sc = (LAS float*)F.lds;
        LAS float* part = (LAS float*)(F.lds + 17 * 1024 * 4);
        { float cv[34];
#pragma unroll
          for (int q = 0; q < 34; ++q) { const int i = F.tid + 512 * q, b = i >> 10, k = i & 1023; cv[q] = b < 16 ? F.in[I_C][b * D + k] : F.in[I_CCTX][k]; }
#pragma unroll
          for (int q = 0; q < 34; ++q) sc[F.tid + 512 * q] = silu_f(cv[q]); }
        __syncthreads();
        float acc[17];
#pragma unroll
        for (int b = 0; b < 17; ++b) acc[b] = 0.f;
        const float* aw = F.in[I_ADAW] + (size_t)l * D * 6 * D + cg * 64 + F.lane;
        for (int k0 = F.wave * 128; k0 < F.wave * 128 + 128; k0 += 16) { float w[16];
#pragma unroll
            for (int u = 0; u < 16; ++u) w[u] = aw[(size_t)(k0 + u) * 6 * D];
#pragma unroll
            for (int u = 0; u < 16; ++u) {
#pragma unroll
                for (int b = 0; b < 17; ++b) acc[b] += sc[b * 1024 + k0 + u] * w[u]; } }
#pragma unroll
        for (int b = 0; b < 17; ++b) part[(F.wave * 17 + b) * 64 + F.lane] = acc[b];
        __syncthreads();
        for (int i = F.tid; i < 17 * 64; i += 512) { const int b = i >> 6, n = i & 63; float s = F.in[I_ADAB][l * 6 * D + cg * 64 + n];
#pragma unroll
            for (int w = 0; w < 8; ++w) s += part[(w * 17 + b) * 64 + n];
            const int col = cg * 64 + n; ((float*)(F.ws + WS_MOD))[((size_t)(l * 17 + b) * 6 + (col >> 10)) * D + (col & 1023)] = s; }
        __syncthreads();
    }
    if (F.bx >= F.G - 3 && F.bx < F.G - 1) { const int l = F.G - 2 - F.bx; unsigned char* img = F.ws + WS_RIMG + (size_t)l * RW_EX;
        const float* rg = F.in[I_RGW] + (size_t)l * D * 4; const float* re = F.in[I_REW] + (size_t)l * D * NE;
        for (int i0 = F.tid; i0 < 1024 * 36; i0 += 512 * 8) { float w[8];
#pragma unroll
            for (int q = 0; q < 8; ++q) { const int i = i0 + 512 * q, k = i / 36, n = i % 36; w[q] = n < 4 ? rg[k * 4 + n] : re[k * NE + (n - 4)]; }
#pragma unroll
            for (int q = 0; q < 8; ++q) { const int i = i0 + 512 * q, k = i / 36, n = i % 36; const unsigned hi = f2bf(w[q]), lo = f2bf(w[q] - bflo(hi));
                *(bf16_t*)(img + n * RW_PITCH + k * 2) = (bf16_t)hi; *(bf16_t*)(img + RW_LO + n * RW_PITCH + k * 2) = (bf16_t)lo; } }
        for (int i = F.tid; i < 2 * 36 * 8; i += 512) { const int r = i >> 3; *(bf16_t*)(img + r * RW_PITCH + 2048 + (i & 7) * 2) = 0; }
    }
    if (F.bx == F.G - 1) {
        float* rc = (float*)(F.ws + WS_ROPE); float* rs = rc + 96 * 32;
        for (int i = F.tid; i < 96 * 32; i += 512) { const int p = i >> 5, f = i & 31; const int pos = p < 32 ? p : p - 32;
            const float inv = powf(10000.0f, -(float)f / 32.0f); const float ang = (float)pos * inv; rc[i] = cosf(ang); rs[i] = sinf(ang); }
    }
    LAS float* scr = (LAS float*)(F.lds + F.wave * 8448);
    const bool slots = (F.G == 256);
    const int n_l0 = slots ? 0 : EXP_ITEMS, n_l1 = slots ? EXP_ITEMS - L1_IDLE : EXP_ITEMS;
    const int n_all = N_SMALL + n_l0 + n_l1, QB = 4, NSH = 8, nbatch = n_all / QB, nb_s = nbatch / NSH;
    unsigned* qheads = (unsigned*)(F.ws + WS_CTL) + CW_QUEUE; (void)qsel;
    const int sh0 = (F.vcu * NSH) / F.G;
    for (int ds = 0; ds < NSH; ++ds) { const int shd = (sh0 + ds) % NSH; unsigned* qhead = qheads + 64 * shd;
    for (;;) {
        int kq = 0; if (F.lane == 0) kq = (int)__hip_atomic_fetch_add(qhead, 1u, __ATOMIC_RELAXED, __HIP_MEMORY_SCOPE_AGENT);
        kq = __builtin_amdgcn_readfirstlane(kq);
        if (kq >= nb_s) break;
        const int bq = shd + NSH * kq;
      for (int qi = 0; qi < QB; ++qi) {
        int r = bq + qi * nbatch;
        if (r < N_WIN) { const int l = r / IT_WIN; r %= IT_WIN; const int kb = r & 15, nb = 79 - (r >> 4), n0 = nb * 32;
            const float* win = F.in[I_WIN] + (size_t)l * D * NP; bf16_t* WT = (bf16_t*)(F.ws + WS_WIN) + (size_t)l * NP * D;
            if (n0 >= 2048) { fold_item(win, F.in[I_POOLW] + (size_t)l * 4 * 128 * 128, F.in[I_POOLS] + l * 512, kb * 64, WT, n0 - 2048, scr, F.lane); continue; }
            const int n = n0 + (F.lane & 31); int src = n;
            if (n < 1024) { const int hh = n >> 7, j = n & 127, sec = j >> 6, jj = j & 63; src = (n & 512) + (hh & 3) * 128 + sec * 64 + (jj & 1) * 32 + (jj >> 1); }
            tr_item(win + src, NP, kb * 64, WT, D, n0, scr, F.lane); continue; }
        r -= N_WIN;
        if (r < N_WOUT) { const int l = r / IT_WOUT; r %= IT_WOUT; const int kb = r / 32, nb = r % 32, n0 = nb * 32;
            tr_item(F.in[I_WOUT] + (size_t)l * D * D + n0 + (F.lane & 31), D, kb * 64, (bf16_t*)(F.ws + WS_WOUT) + (size_t)l * D * D, D, n0, scr, F.lane); continue; }
        r -= N_WOUT;
        if (r < n_l0) expert_item(F, 0, r, scr); else expert_item(F, 1, EXP_ITEMS - n_l1 + (r - n_l0), scr);
      }
    }
    }
}
__device__ __forceinline__ void idle_convert(const Frame& F, int gidx, int z0, int per) {
    LAS float* scr = (LAS float*)(F.lds + F.wave * 8448);
    for (int i = 0; i < per; ++i) { const int z = z0 + gidx * per + i; if (z < EXP_ITEMS) expert_item(F, 0, z, scr); else expert_item(F, 1, z - EXP_ITEMS, scr); }
}

__device__ __forceinline__ LAS int* build_tb(const Frame& F, int l) {
    LAS int* tb = (LAS int*)(F.lds + MISC_OFF + 64);
    if (F.tid < 64) {
        const unsigned* cnt = (const unsigned*)(F.ws + WS_CTL) + CW_CNT + l * NE * 16;
        const int e = F.tid & 31; const int c = (int)__hip_atomic_load(cnt + e * 16, __ATOMIC_RELAXED, __HIP_MEMORY_SCOPE_AGENT);
        const int t = (c + 255) >> 8; int incl = t;
#pragma unroll
        for (int o = 1; o < 32; o <<= 1) { const int v = __shfl_up(incl, o, 32); if (e >= o) incl += v; }
        if (F.tid < 32) { tb[e] = incl - t; tb[64 + e] = c; if (e == 31) tb[NE] = incl; }
    }
    __syncthreads();
    return tb;
}

__device__ __forceinline__ void row_op_a(const Frame& F, int mode, bool dry) {
    const int gw = F.vcu * 8 + F.wave, NGW = F.G * 8;
    const int nrows = (mode == 2) ? NLAT : NTOK; const int l = (mode == 0) ? 0 : 1, lp = mode - 1;
    const LAS int* tb = nullptr; if (mode != 0) tb = build_tb(F, lp);
    const unsigned char* YB = (const unsigned char*)(F.ws + WS_P); bf16_t* H = hbuf(F);
    const float* gain = (mode == 2) ? F.in[I_FNG] : F.in[I_N1G] + l * D;
    const int R = (nrows + NGW - 1) / NGW, r_lo = gw * R, r_hi = (r_lo + R < nrows) ? r_lo + R : nrows;
    int4 ti1 = make_int4(0, 0, 0, 0), ti2 = ti1; f32x2 tw0 = (f32x2){0.f, 0.f}, tw1 = tw0, tw2 = tw0;
    f32x4 xf[4]; u32x2 xq[4]; unsigned ya[4], yc[4];
#define ROWA_INFO(r_, ti_, tw_) do { if (mode != 0 && (r_) < r_hi) { ti_ = *(const int4*)(F.ws + WS_TOKINFO + (size_t)(r_) * 32); tw_ = *(const f32x2*)(F.ws + WS_TOKINFO + (size_t)(r_) * 32 + 16); } } while (0)
#define ROWA_DATA(r_, ti_) do { if ((r_) < r_hi) { if (mode == 0) { const f32x4* src = (const f32x4*)((r_) < NLAT ? F.in[I_X] + (size_t)(r_) * D : F.in[I_CTX] + (size_t)((r_) - NLAT) * D) + F.lane; \
            _Pragma("unroll") for (int j = 0; j < 4; ++j) xf[j] = src[64 * j]; } \
        else { const size_t s1 = (size_t)(tb[ti_.x] * 256 + ti_.y), s2 = (size_t)(tb[ti_.z] * 256 + ti_.w); const u32x2* xr_ = (const u32x2*)xb_row(F, (r_)) + F.lane; \
            const unsigned* y1 = (const unsigned*)(YB + s1 * D) + F.lane; const unsigned* y2 = (const unsigned*)(YB + s2 * D) + F.lane; \
            _Pragma("unroll") for (int j = 0; j < 4; ++j) { xq[j] = xr_[64 * j]; ya[j] = y1[64 * j]; yc[j] = y2[64 * j]; } } } } while (0)
    ROWA_INFO(r_lo, ti1, tw1); ROWA_INFO(r_lo + 1, ti2, tw2);
    ROWA_DATA(r_lo, ti1); tw0 = tw1; ti1 = ti2; tw1 = tw2;
    f32x4 vA[4], vB[4], vG[4]; int bcur = -1;
    for (int row = r_lo; row < r_hi; ++row) {
        const int b = row < NLAT ? (row >> 11) : 16;
        if (b != bcur) { bcur = b;
#pragma unroll
            for (int j = 0; j < 4; ++j) { const f32x4 g = ((const f32x4*)gain)[F.lane + 64 * j];
                if (mode == 2) { vA[j] = g; vB[j] = (f32x4){0.f, 0.f, 0.f, 0.f}; }
                else { vA[j] = g * (((const f32x4*)mod_ptr(F, l, b, 1))[F.lane + 64 * j] + 1.0f); vB[j] = ((const f32x4*)mod_ptr(F, l, b, 0))[F.lane + 64 * j]; }
                if (mode != 0) vG[j] = ((const f32x4*)mod_ptr(F, lp, b, 5))[F.lane + 64 * j]; } }
        ROWA_INFO(row + 2, ti2, tw2);
        f32x4 v[4];
        if (mode == 0) {
#pragma unroll
            for (int j = 0; j < 4; ++j) v[j] = xf[j];
        } else {
#pragma unroll
            for (int j = 0; j < 4; ++j) { const u32x2 xw = xq[j]; const f32x4 x = (f32x4){bflo(xw.x), bfhi(xw.x), bflo(xw.y), bfhi(xw.y)};
                const int a = (int)ya[j], c = (int)yc[j];
                f32x4 y; y[0] = tw0.x * __builtin_amdgcn_cvt_f32_fp8(a, 0) + tw0.y * __builtin_amdgcn_cvt_f32_fp8(c, 0); y[1] = tw0.x * __builtin_amdgcn_cvt_f32_fp8(a, 1) + tw0.y * __builtin_amdgcn_cvt_f32_fp8(c, 1);
                y[2] = tw0.x * __builtin_amdgcn_cvt_f32_fp8(a, 2) + tw0.y * __builtin_amdgcn_cvt_f32_fp8(c, 2); y[3] = tw0.x * __builtin_amdgcn_cvt_f32_fp8(a, 3) + tw0.y * __builtin_amdgcn_cvt_f32_fp8(c, 3);
                v[j] = x + vG[j] * y; }
        }
        ROWA_DATA(row + 1, ti1);
        if (mode == 1 && !dry) { u32x2* xr = (u32x2*)xb_row(F, row) + F.lane;
#pragma unroll
            for (int j = 0; j < 4; ++j) { u32x2 w; w.x = pk2(v[j][0], v[j][1]); w.y = pk2(v[j][2], v[j][3]); xr[64 * j] = w; } }
        float ss = 0.f;
#pragma unroll
        for (int j = 0; j < 4; ++j) ss += (v[j][0] * v[j][0] + v[j][1] * v[j][1]) + (v[j][2] * v[j][2] + v[j][3] * v[j][3]);
        const float rstd = 1.0f / sqrtf(wave_sum(ss) * (1.0f / D) + EPS);
        if (mode == 2) {
#pragma unroll
            for (int j = 0; j < 4; ++j) ((f32x4*)((dry ? (float*)(F.ws + WS_WGU) : F.out) + (size_t)row * D))[F.lane + 64 * j] = v[j] * rstd * vA[j];
        } else {
            u32x2* o = (u32x2*)(H + (size_t)row * D) + F.lane;
#pragma unroll
            for (int j = 0; j < 4; ++j) { const f32x4 h = v[j] * rstd * vA[j] + vB[j];
                u32x2 w; w.x = pk2(h[0], h[1]); w.y = pk2(h[2], h[3]); o[64 * j] = w; }
        }
        tw0 = tw1; ti1 = ti2; tw1 = tw2;
    }
#undef ROWA_INFO
#undef ROWA_DATA
}

template <bool DRY> __device__ __forceinline__ void route_row(const Frame& F, int l, int row, const float (&s)[36], unsigned* cnt, int* list) {
    float gl[4];
#pragma unroll
    for (int i = 0; i < 4; ++i) gl[i] = s[i];
    int gt = 0; float gm = gl[0];
#pragma unroll
    for (int i = 1; i < 4; ++i) if (gl[i] > gm) { gm = gl[i]; gt = i; }
    float gs = 0.f;
#pragma unroll
    for (int i = 0; i < 4; ++i) gs += expf(gl[i] - gm);
    const float gwt = 1.0f / gs;
    float el[8];
#pragma unroll
    for (int j = 0; j < 8; ++j) el[j] = gt == 0 ? s[4 + j] : gt == 1 ? s[12 + j] : gt == 2 ? s[20 + j] : s[28 + j];
    int i1 = 0; float v1 = el[0];
#pragma unroll
    for (int j = 1; j < 8; ++j) if (el[j] > v1) { v1 = el[j]; i1 = j; }
    int i2 = -1; float v2 = -3.0e38f;
#pragma unroll
    for (int j = 0; j < 8; ++j) if (j != i1 && el[j] > v2) { v2 = el[j]; i2 = j; }
    const float e2 = expf(v2 - v1); const float w1 = gwt / (1.0f + e2), w2 = gwt * e2 / (1.0f + e2);
    if (!DRY) {
        const int x1 = gt * 8 + i1, x2 = gt * 8 + i2;
        const int r1 = (int)__hip_atomic_fetch_add(cnt + x1 * 16, 1u, __ATOMIC_RELAXED, __HIP_MEMORY_SCOPE_AGENT);
        const int r2 = (int)__hip_atomic_fetch_add(cnt + x2 * 16, 1u, __ATOMIC_RELAXED, __HIP_MEMORY_SCOPE_AGENT);
        list[(size_t)x1 * NTOK + r1] = row; list[(size_t)x2 * NTOK + r2] = row;
        *(int4*)(F.ws + WS_TOKINFO + (size_t)row * 32) = make_int4(x1, r1, x2, r2); *(f32x2*)(F.ws + WS_TOKINFO + (size_t)row * 32 + 16) = (f32x2){w1, w2};
    }
}
template <bool DRY> __device__ __forceinline__ void row_op_b(const Frame& F, int l) {
    const int gw = F.vcu * 8 + F.wave, NGW = F.G * 8;
    const int ngroups = ((l == 0) ? NTOK : NLAT) / 16;
    { const u32x4* img = (const u32x4*)(F.ws + WS_RIMG + (size_t)l * RW_EX);
      u32x4 t[19];
#pragma unroll
      for (int q = 0; q < 19; ++q) { const int i = F.tid + 512 * q; t[q] = img[i < RW_EX / 16 ? i : 0]; }
#pragma unroll
      for (int q = 0; q < 19; ++q) { const int i = F.tid + 512 * q; if (i < RW_EX / 16) *(LAS u32x4*)(F.lds + i * 16) = t[q]; } }
    __syncthreads();
    bf16_t* H = hbuf(F);
    const float* gain = F.in[I_N2G] + l * D;
    unsigned* cnt = (unsigned*)(F.ws + WS_CTL) + CW_CNT + l * NE * 16;
    int* list = (int*)(F.ws + WS_LIST);
    const int fr = F.lane & 15, fq = F.lane >> 4;
    unsigned bo[3];
#pragma unroll
    for (int nt = 0; nt < 3; ++nt) { const int n = 16 * nt + fr; bo[nt] = (unsigned)((n < 36 ? n : 35) * RW_PITCH + fq * 16); }
    LAS float* ex = (LAS float*)(F.lds + RW_EX + F.wave * 1152);
    float rbias[36];
#pragma unroll
    for (int n = 0; n < 36; ++n) rbias[n] = n < 4 ? F.in[I_RGB][l * 4 + n] : F.in[I_REB][l * NE + (n - 4)];
    for (int it = 0;; ++it) {
        const int gi = it == 0 ? gw : NGW + F.vcu + (it - 1) * F.G;
        if (gi >= ngroups || (it > 0 && F.wave != 0)) break;
        const int row = gi * 16 + fr, b = row < NLAT ? (row >> 11) : 16;
        const bf16_t* xr = xb_row(F, row) + fq * 8;
        float ss;
        { const f32x4* sp = (const f32x4*)((const float*)(F.ws + WS_SSQ) + (size_t)row * 16); const f32x4 p0 = sp[0], p1 = sp[1], p2 = sp[2], p3 = sp[3];
          ss = ((p0[0] + p0[1]) + (p0[2] + p0[3])) + ((p1[0] + p1[1]) + (p1[2] + p1[3])) + ((p2[0] + p2[1]) + (p2[2] + p2[3])) + ((p3[0] + p3[1]) + (p3[2] + p3[3])); }
        const float rstd = 1.0f / sqrtf(ss * (1.0f / D) + EPS);
        const float* shp = mod_ptr(F, l, b, 3) + fq * 8; const float* scp = mod_ptr(F, l, b, 4) + fq * 8; const float* gp = gain + fq * 8;
        unsigned char* hp = (unsigned char*)H + (size_t)row * D + fq * 8;
        f32x4 acc[3];
#pragma unroll
        for (int nt = 0; nt < 3; ++nt) acc[nt] = (f32x4){0.f, 0.f, 0.f, 0.f};
#pragma unroll 2
        for (int s = 0; s < 32; ++s) {
            const u32x4 xw = *(const u32x4*)(xr + 32 * s);
            const f32x4 x0 = (f32x4){bflo(xw.x), bfhi(xw.x), bflo(xw.y), bfhi(xw.y)}, x1 = (f32x4){bflo(xw.z), bfhi(xw.z), bflo(xw.w), bfhi(xw.w)};
            const f32x4 g0 = *(const f32x4*)(gp + 32 * s), g1 = *(const f32x4*)(gp + 32 * s + 4);
            const f32x4 c0 = *(const f32x4*)(scp + 32 * s), c1 = *(const f32x4*)(scp + 32 * s + 4);
            const f32x4 s0 = *(const f32x4*)(shp + 32 * s), s1 = *(const f32x4*)(shp + 32 * s + 4);
            const f32x4 h0 = x0 * rstd * g0 * (c0 + 1.0f) + s0, h1 = x1 * rstd * g1 * (c1 + 1.0f) + s1;
            u32x4 hi, lo;
            hi.x = pk2(h0[0], h0[1]); hi.y = pk2(h0[2], h0[3]); hi.z = pk2(h1[0], h1[1]); hi.w = pk2(h1[2], h1[3]);
            lo.x = pk2(h0[0] - bflo(hi.x), h0[1] - bfhi(hi.x)); lo.y = pk2(h0[2] - bflo(hi.y), h0[3] - bfhi(hi.y));
            lo.z = pk2(h1[0] - bflo(hi.z), h1[1] - bfhi(hi.z)); lo.w = pk2(h1[2] - bflo(hi.w), h1[3] - bfhi(hi.w));
            { u32x2 h8; h8.x = pg8::pk4_fp8(h0[0], h0[1], h0[2], h0[3]); h8.y = pg8::pk4_fp8(h1[0], h1[1], h1[2], h1[3]); *(u32x2*)(hp + 32 * s) = h8; }
            const bf16x8 ah = __builtin_bit_cast(bf16x8, hi), al = __builtin_bit_cast(bf16x8, lo);
#pragma unroll
            for (int nt = 0; nt < 3; ++nt) {
                const bf16x8 bh = *(const LAS bf16x8*)(F.lds + bo[nt] + s * 64), bl = *(const LAS bf16x8*)(F.lds + RW_LO + bo[nt] + s * 64);
                acc[nt] = __builtin_amdgcn_mfma_f32_16x16x32_bf16(ah, bh, acc[nt], 0, 0, 0);
                acc[nt] = __builtin_amdgcn_mfma_f32_16x16x32_bf16(ah, bl, acc[nt], 0, 0, 0);
                acc[nt] = __builtin_amdgcn_mfma_f32_16x16x32_bf16(al, bh, acc[nt], 0, 0, 0);
            }
        }
#pragma unroll
        for (int hf = 0; hf < 2; ++hf) {
            if ((fq >> 1) == hf) {
#pragma unroll
                for (int nt = 0; nt < 3; ++nt) { const int n = 16 * nt + fr;
                    if (n < 36) {
#pragma unroll
                        for (int r = 0; r < 4; ++r) ex[((fq & 1) * 4 + r) * 36 + n] = acc[nt][r]; } }
            }
            asm volatile("s_waitcnt lgkmcnt(0)" ::: "memory");
            if (F.lane < 8) { float sl[36];
#pragma unroll
                for (int n = 0; n < 36; ++n) sl[n] = ex[F.lane * 36 + n] + rbias[n];
                route_row<DRY>(F, l, gi * 16 + hf * 8 + F.lane, sl, cnt, list); }
            asm volatile("s_waitcnt lgkmcnt(0)" ::: "memory");
        }
    }
    __syncthreads();
}

__device__ __forceinline__ unsigned off_b(unsigned row, unsigned ch) { return 256u * row + 16u * (ch ^ (((row & 3) << 2) | ((row >> 2) & 3))); }
__device__ __forceinline__ unsigned tr_base_p(unsigned lane) { const unsigned g = lane >> 4, q = (lane & 15) >> 2, p = lane & 3; return off_b(4 * g + q, (p >> 1)) + 8 * (p & 1); }
template <int O0, int O1, int O2, int O3>
__device__ __forceinline__ void tr_frag4(bf16x8 (&f)[4], unsigned a0, unsigned a1, unsigned a2, unsigned a3) {
    s16x4 l0, h0, l1, h1, l2, h2, l3, h3;
    asm volatile("ds_read_b64_tr_b16 %0, %8 offset:%12\n\tds_read_b64_tr_b16 %1, %8 offset:%16\n\t"
                 "ds_read_b64_tr_b16 %2, %9 offset:%13\n\tds_read_b64_tr_b16 %3, %9 offset:%17\n\t"
                 "ds_read_b64_tr_b16 %4, %10 offset:%14\n\tds_read_b64_tr_b16 %5, %10 offset:%18\n\t"
                 "ds_read_b64_tr_b16 %6, %11 offset:%15\n\tds_read_b64_tr_b16 %7, %11 offset:%19\n\ts_waitcnt lgkmcnt(0)"
                 : "=&v"(l0), "=&v"(h0), "=&v"(l1), "=&v"(h1), "=&v"(l2), "=&v"(h2), "=&v"(l3), "=&v"(h3)
                 : "v"(a0), "v"(a1), "v"(a2), "v"(a3), "n"(O0), "n"(O1), "n"(O2), "n"(O3), "n"(O0 + 4096), "n"(O1 + 4096), "n"(O2 + 4096), "n"(O3 + 4096) : "memory");
    f[0] = __builtin_shufflevector(l0, h0, 0, 1, 2, 3, 4, 5, 6, 7); f[1] = __builtin_shufflevector(l1, h1, 0, 1, 2, 3, 4, 5, 6, 7);
    f[2] = __builtin_shufflevector(l2, h2, 0, 1, 2, 3, 4, 5, 6, 7); f[3] = __builtin_shufflevector(l3, h3, 0, 1, 2, 3, 4, 5, 6, 7);
}
template <int O>
__device__ __forceinline__ void tr_frag8(bf16x8 (&f)[8], unsigned a) {
    s16x4 l0, h0, l1, h1, l2, h2, l3, h3, l4, h4, l5, h5, l6, h6, l7, h7;
    const unsigned a1 = a ^ 32u, a2 = a ^ 64u, a3 = a ^ 96u, a4 = a ^ 128u, a5 = a ^ 160u, a6 = a ^ 192u, a7 = a ^ 224u;
    asm volatile("ds_read_b64_tr_b16 %0, %8 offset:%12\n\tds_read_b64_tr_b16 %1, %8 offset:%13\n\t"
                 "ds_read_b64_tr_b16 %2, %9 offset:%12\n\tds_read_b64_tr_b16 %3, %9 offset:%13\n\t"
                 "ds_read_b64_tr_b16 %4, %10 offset:%12\n\tds_read_b64_tr_b16 %5, %10 offset:%13\n\t"
                 "ds_read_b64_tr_b16 %6, %11 offset:%12\n\tds_read_b64_tr_b16 %7, %11 offset:%13"
                 : "=&v"(l0), "=&v"(h0), "=&v"(l1), "=&v"(h1), "=&v"(l2), "=&v"(h2), "=&v"(l3), "=&v"(h3)
                 : "v"(a), "v"(a1), "v"(a2), "v"(a3), "n"(O), "n"(O + 4096) : "memory");
    asm volatile("ds_read_b64_tr_b16 %0, %16 offset:%20\n\tds_read_b64_tr_b16 %1, %16 offset:%21\n\t"
                 "ds_read_b64_tr_b16 %2, %17 offset:%20\n\tds_read_b64_tr_b16 %3, %17 offset:%21\n\t"
                 "ds_read_b64_tr_b16 %4, %18 offset:%20\n\tds_read_b64_tr_b16 %5, %18 offset:%21\n\t"
                 "ds_read_b64_tr_b16 %6, %19 offset:%20\n\tds_read_b64_tr_b16 %7, %19 offset:%21\n\ts_waitcnt lgkmcnt(0)"
                 : "=&v"(l4), "=&v"(h4), "=&v"(l5), "=&v"(h5), "=&v"(l6), "=&v"(h6), "=&v"(l7), "=&v"(h7),
                   "+v"(l0), "+v"(h0), "+v"(l1), "+v"(h1), "+v"(l2), "+v"(h2), "+v"(l3), "+v"(h3)
                 : "v"(a4), "v"(a5), "v"(a6), "v"(a7), "n"(O), "n"(O + 4096) : "memory");
    f[0] = __builtin_shufflevector(l0, h0, 0, 1, 2, 3, 4, 5, 6, 7); f[1] = __builtin_shufflevector(l1, h1, 0, 1, 2, 3, 4, 5, 6, 7);
    f[2] = __builtin_shufflevector(l2, h2, 0, 1, 2, 3, 4, 5, 6, 7); f[3] = __builtin_shufflevector(l3, h3, 0, 1, 2, 3, 4, 5, 6, 7);
    f[4] = __builtin_shufflevector(l4, h4, 0, 1, 2, 3, 4, 5, 6, 7); f[5] = __builtin_shufflevector(l5, h5, 0, 1, 2, 3, 4, 5, 6, 7);
    f[6] = __builtin_shufflevector(l6, h6, 0, 1, 2, 3, 4, 5, 6, 7); f[7] = __builtin_shufflevector(l7, h7, 0, 1, 2, 3, 4, 5, 6, 7);
}
#define LBAR() do { asm volatile("s_waitcnt lgkmcnt(0)" ::: "memory"); __builtin_amdgcn_s_barrier(); asm volatile("" ::: "memory"); } while (0)
__device__ __forceinline__ int chunk_row0(int b, int ci) { return ci < 2 ? NLAT + b * CT + ci * 128 : b * TL + (ci - 2) * 128; }
__device__ __forceinline__ float log2_gamma(float decay) { return -log1pf(expf(-decay)) * 1.4426950408889634f; }

template <int HALF>
__device__ __forceinline__ void pool_item(const LAS unsigned char* tile, bf16_t* A2, int t0, int T, int rbase, int rl, int cg) {
    const int t = t0 + rl; int cnt = 0;
    float s[8];
#pragma unroll
    for (int i = 0; i < 8; ++i) s[i] = 0.f;
    u32x4 c = (u32x4){0u, 0u, 0u, 0u};
#pragma unroll
    for (int w = 0; w < 2 * HALF; ++w) { const int tt = t - HALF + w; const bool ok = tt >= 0 && tt < T;
        u32x4 x = *(const LAS u32x4*)(tile + (rl + 8 - HALF + w) * 1024 + cg * 16); if (!ok) x = (u32x4){0u, 0u, 0u, 0u}; cnt += ok ? 1 : 0; if (w == HALF) c = x;
        s[0] += bflo(x.x); s[1] += bfhi(x.x); s[2] += bflo(x.y); s[3] += bfhi(x.y); s[4] += bflo(x.z); s[5] += bfhi(x.z); s[6] += bflo(x.w); s[7] += bfhi(x.w); }
    const float inv = 1.0f / (float)cnt;
    u32x4 o; o.x = pk2(s[0] * inv - bflo(c.x), s[1] * inv - bfhi(c.x)); o.y = pk2(s[2] * inv - bflo(c.y), s[3] * inv - bfhi(c.y));
    o.z = pk2(s[4] * inv - bflo(c.z), s[5] * inv - bfhi(c.z)); o.w = pk2(s[6] * inv - bflo(c.w), s[7] * inv - bfhi(c.w));
    *(u32x4*)(A2 + (size_t)(rbase + t) * D + 512 + cg * 8) = o;
}

__device__ __forceinline__ void p3a_states_pool(const Frame& F, int l) {
    const bf16_t* P = (const bf16_t*)(F.ws + WS_P);
    bf16_t* ST = (bf16_t*)(F.ws + WS_ACT);
    bf16_t* A2 = hbuf(F);
    const int nstate = (F.G > 128) ? 128 : F.G;
    if (F.bx < nstate) {
        for (int unit = F.bx; unit < 128; unit += nstate) {
            const int dir = unit & 1, bh = unit >> 1, b = bh >> 2, h = bh & 3;
            const float lg2 = log2_gamma((dir ? F.in[I_DB] : F.in[I_DF])[l * NH + h]);
            const float gC = exp2f(lg2 * 128.0f);
            f32x4 acc[8];
#pragma unroll
            for (int dt = 0; dt < 8; ++dt) acc[dt] = (f32x4){0.f, 0.f, 0.f, 0.f};
            u32x4 kr[8], vr[8];
#define P3A_CI(n_) (dir ? ((n_) < 2 ? 1 - (n_) : 19 - (n_)) : (n_))
#define P3A_LOAD(st_) do { _Pragma("unroll") for (int sub = 0; sub < 2; ++sub) { const int r0_ = chunk_row0(b, P3A_CI(2 * (st_) + sub)); \
                _Pragma("unroll") for (int q = 0; q < 4; ++q) { const int p = F.tid + 512 * q, j = p >> 4, ch = p & 15; \
                    kr[sub * 4 + q] = *(const u32x4*)(P + (size_t)(r0_ + j) * NP + 512 + h * 128 + ch * 8); vr[sub * 4 + q] = *(const u32x4*)(P + (size_t)(r0_ + j) * NP + 1024 + h * 128 + ch * 8); } } } while (0)
#define P3A_STORE(n_) do { unsigned char* sp = (unsigned char*)ST + ((size_t)((bh * 2 + dir) * NCHUNK + P3A_CI(n_)) * 128 + (F.wave * 16 + (F.lane & 15))) * 128 + 4 * (F.lane >> 4); \
                _Pragma("unroll") for (int dt = 0; dt < 8; ++dt) *(unsigned*)(sp + dt * 16) = pg8::pk4_fp8(acc[dt][0], acc[dt][1], acc[dt][2], acc[dt][3]); } while (0)
#define P3A_KS(KO, VO, ks) do { bf16x8 ka[8]; tr_frag8<(KO) + (ks) * 8192>(ka, tpk); \
                _Pragma("unroll") for (int dt = 0; dt < 8; ++dt) acc[dt] = __builtin_amdgcn_mfma_f32_16x16x32_bf16(ka[dt], vb[ks], acc[dt], 0, 0, 0); } while (0)
#define P3A_SUB(KO, VO) do { _Pragma("unroll") for (int dt = 0; dt < 8; ++dt) acc[dt] *= gC; \
                bf16x8 vb[4]; tr_frag4<(VO), (VO) + 8192, (VO) + 16384, (VO) + 24576>(vb, tpv, tpv, tpv, tpv); \
                P3A_KS(KO, VO, 0); P3A_KS(KO, VO, 1); P3A_KS(KO, VO, 2); P3A_KS(KO, VO, 3); } while (0)
            P3A_LOAD(0);
            for (int st = 0; st < 9; ++st) {
#pragma unroll
                for (int sub = 0; sub < 2; ++sub)
#pragma unroll
                    for (int q = 0; q < 4; ++q) { const int p = F.tid + 512 * q, j = p >> 4, ch = p & 15;
                        const float kd = __builtin_amdgcn_exp2f(lg2 * (float)(dir ? j : 127 - j));
                        const u32x4 kk = kr[sub * 4 + q];
                        u32x4 ks; ks.x = pk2(bflo(kk.x) * kd, bfhi(kk.x) * kd); ks.y = pk2(bflo(kk.y) * kd, bfhi(kk.y) * kd); ks.z = pk2(bflo(kk.z) * kd, bfhi(kk.z) * kd); ks.w = pk2(bflo(kk.w) * kd, bfhi(kk.w) * kd);
                        *(LAS u32x4*)(F.lds + sub * 32768 + off_b(j, ch)) = ks; *(LAS u32x4*)(F.lds + 65536 + sub * 32768 + off_b(j, ch)) = vr[sub * 4 + q]; }
                LBAR();
                if (st < 8) P3A_LOAD(st + 1);
                const unsigned tpk = (unsigned)(size_t)F.lds + tr_base_p(F.lane); const unsigned tpv = (tpk ^ ((unsigned)F.wave << 5)) + 65536u;
                P3A_STORE(2 * st);
                P3A_SUB(0, 0);
                P3A_STORE(2 * st + 1);
                if (st < 8) P3A_SUB(32768, 32768);
                LBAR();
            }
#undef P3A_SUB
#undef P3A_KS
#undef P3A_STORE
#undef P3A_LOAD
#undef P3A_CI
        }
    } else {
        const int pb = F.bx - nstate, npb = F.G - nstate;
        u32x4 ld[10];
#define POOL_LOAD(tile_) do { const int r0_ = (tile_) * 64; int t0_, T_, rb_; if (r0_ < NLAT) { t0_ = r0_ & (TL - 1); T_ = TL; } else { t0_ = (r0_ - NLAT) & (CT - 1); T_ = CT; } rb_ = r0_ - t0_; \
            _Pragma("unroll") for (int q = 0; q < 10; ++q) { const int p = F.tid + 512 * q, rr = p >> 6, ch = p & 63; int tt = t0_ - 8 + rr; tt = tt < 0 ? 0 : (tt >= T_ ? T_ - 1 : tt); \
                ld[q] = *(const u32x4*)(P + (size_t)(rb_ + tt) * NP + 2048 + ch * 8); } } while (0)
        if (pb < 576) POOL_LOAD(pb);
        for (int tile = pb; tile < 576; tile += npb) {
            const int r0 = tile * 64; int t0, T; if (r0 < NLAT) { t0 = r0 & (TL - 1); T = TL; } else { t0 = (r0 - NLAT) & (CT - 1); T = CT; } const int rbase = r0 - t0;
            LBAR();
#pragma unroll
            for (int q = 0; q < 10; ++q) { const int p = F.tid + 512 * q; *(LAS u32x4*)(F.lds + (p >> 6) * 1024 + (p & 63) * 16) = ld[q]; }
            LBAR();
            if (tile + npb < 576) POOL_LOAD(tile + npb);
            for (int wi = F.wave; wi < 64; wi += 8) { const int g = wi & 3, rl = (wi >> 2) * 4 + (F.lane >> 4), cg = g * 16 + (F.lane & 15);
                if (g == 0) pool_item<1>(F.lds, A2, t0, T, rbase, rl, cg); else if (g == 1) pool_item<2>(F.lds, A2, t0, T, rbase, rl, cg);
                else if (g == 2) pool_item<4>(F.lds, A2, t0, T, rbase, rl, cg); else pool_item<8>(F.lds, A2, t0, T, rbase, rl, cg); }
        }
#undef POOL_LOAD
        if (F.G == 256) { __syncthreads(); idle_convert(F, pb * 8 + F.wave, l == 0 ? Z_S2 : Z_S8, 6); }
    }
    __syncthreads();
}

__device__ __forceinline__ void p3b_retention(const Frame& F, int l) {
    const bf16_t* P = (const bf16_t*)(F.ws + WS_P);
    const bf16_t* ST = (const bf16_t*)(F.ws + WS_ACT);
    bf16_t* A2 = hbuf(F);
    const int c_lo = (l == DEPTH - 1) ? 2 : 0, ncu = NCHUNK - c_lo, nunits = 64 * ncu;
    float lgF[NH], lgB[NH];
#pragma unroll
    for (int hh = 0; hh < NH; ++hh) { lgF[hh] = log2_gamma(F.in[I_DF][l * NH + hh]); lgB[hh] = log2_gamma(F.in[I_DB][l * NH + hh]); }
    u32x4 ld[8], st[4]; bf16x8 qf[4];
#define P3B_LOAD(unit_) do { const int bh_ = (unit_) / ncu, ci_ = c_lo + (unit_) % ncu, h_ = bh_ & 3; const int r0_ = chunk_row0(bh_ >> 2, ci_); \
        _Pragma("unroll") for (int q = 0; q < 4; ++q) { const int p = F.tid + 512 * q, j = p >> 4, ch = p & 15; \
            ld[q] = *(const u32x4*)(P + (size_t)(r0_ + j) * NP + 512 + h_ * 128 + ch * 8); ld[4 + q] = *(const u32x4*)(P + (size_t)(r0_ + j) * NP + 1024 + h_ * 128 + ch * 8); } } while (0)
#define P3B_LOADQ(unit_) do { const int bh_ = (unit_) / ncu, ci_ = c_lo + (unit_) % ncu, h_ = bh_ & 3; const int r0_ = chunk_row0(bh_ >> 2, ci_); \
        _Pragma("unroll") for (int ks = 0; ks < 4; ++ks) qf[ks] = *(const bf16x8*)(P + (size_t)(r0_ + F.wave * 16 + (F.lane & 15)) * NP + h_ * 128 + ks * 32 + (F.lane >> 4) * 8); } while (0)
    if (F.vcu < nunits) { P3B_LOAD(F.vcu); P3B_LOADQ(F.vcu); }
    for (int unit = F.vcu; unit < nunits; unit += F.G) {
        int lane_o = F.lane; asm volatile("" : "+v"(lane_o));
        const int fr = lane_o & 15, fq = lane_o >> 4;
        const unsigned rr0 = off_b((unsigned)fr, (unsigned)fq), tp = (unsigned)(size_t)F.lds + tr_base_p((unsigned)lane_o);
        const int il = F.wave * 16 + fr;
        const int bh = unit / ncu, ci = c_lo + unit % ncu, b = bh >> 2, h = bh & 3;
        const float lgf = h == 0 ? lgF[0] : h == 1 ? lgF[1] : h == 2 ? lgF[2] : lgF[3], lgb = h == 0 ? lgB[0] : h == 1 ? lgB[1] : h == 2 ? lgB[2] : lgB[3];
        const int row0 = chunk_row0(b, ci);
        { const unsigned char* sf = (const unsigned char*)ST + ((size_t)((bh * 2 + 0) * NCHUNK + ci) * 128) * 128; const unsigned char* sb = (const unsigned char*)ST + ((size_t)((bh * 2 + 1) * NCHUNK + ci) * 128) * 128;
#pragma unroll
          for (int q = 0; q < 2; ++q) { const int p = F.tid + 512 * q, j = p >> 3, c = p & 7; st[q] = *(const u32x4*)((const unsigned char*)sf + (size_t)j * 128 + c * 16); st[2 + q] = *(const u32x4*)((const unsigned char*)sb + (size_t)j * 128 + c * 16); } }
        LBAR();
#pragma unroll
        for (int q = 0; q < 4; ++q) { const int p = F.tid + 512 * q, j = p >> 4, ch = p & 15; const unsigned o = off_b(j, ch);
            *(LAS u32x4*)(F.lds + o) = ld[q]; *(LAS u32x4*)(F.lds + 32768u + o) = ld[4 + q]; }
        LBAR();
        if (unit + F.G < nunits) P3B_LOAD(unit + F.G);
        u32x2 gg[8];
#pragma unroll
        for (int et = 0; et < 8; ++et) gg[et] = *(const u32x2*)(P + (size_t)(row0 + il) * NP + 1536 + h * 128 + 4 * fq + et * 16);
        bf16x8 pf[4];
#pragma unroll
        for (int ks2 = 0; ks2 < 4; ++ks2) {
            u32x2 half[2];
#pragma unroll
            for (int t = 0; t < 2; ++t) { const int jt = 2 * ks2 + t;
                asm volatile("" ::: "memory");
                f32x4 sa = (f32x4){0.f, 0.f, 0.f, 0.f};
#pragma unroll
                for (int ks = 0; ks < 4; ++ks) { const bf16x8 ka = *(const LAS bf16x8*)(F.lds + ((rr0 ^ ((unsigned)ks << 6)) + 4096u * jt)); sa = __builtin_amdgcn_mfma_f32_16x16x32_bf16(ka, qf[ks], sa, 0, 0, 0); }
                float pv[4];
#pragma unroll
                for (int r = 0; r < 4; ++r) { const int j = 16 * jt + 4 * fq + r, df = il - j;
                    const float w = df > 0 ? __builtin_amdgcn_exp2f(lgf * (float)df) : (df < 0 ? __builtin_amdgcn_exp2f(lgb * (float)(-df)) : 2.0f); pv[r] = sa[r] * w; }
                half[t].x = pk2(pv[0], pv[1]); half[t].y = pk2(pv[2], pv[3]); }
            const u32x4 w4 = (u32x4){half[0].x, half[0].y, half[1].x, half[1].y};
            pf[ks2] = __builtin_bit_cast(bf16x8, w4);
        }
#pragma unroll
        for (int q = 0; q < 2; ++q) { const int p = F.tid + 512 * q, j = p >> 3, c = p & 7;
#pragma unroll
            for (int sd = 0; sd < 2; ++sd) { const u32x4 w = st[2 * sd + q];
                u32x4 lo, hi;
                lo.x = pk2(__builtin_amdgcn_cvt_f32_fp8((int)w.x, 0), __builtin_amdgcn_cvt_f32_fp8((int)w.x, 1)); lo.y = pk2(__builtin_amdgcn_cvt_f32_fp8((int)w.x, 2), __builtin_amdgcn_cvt_f32_fp8((int)w.x, 3));
                lo.z = pk2(__builtin_amdgcn_cvt_f32_fp8((int)w.y, 0), __builtin_amdgcn_cvt_f32_fp8((int)w.y, 1)); lo.w = pk2(__builtin_amdgcn_cvt_f32_fp8((int)w.y, 2), __builtin_amdgcn_cvt_f32_fp8((int)w.y, 3));
                hi.x = pk2(__builtin_amdgcn_cvt_f32_fp8((int)w.z, 0), __builtin_amdgcn_cvt_f32_fp8((int)w.z, 1)); hi.y = pk2(__builtin_amdgcn_cvt_f32_fp8((int)w.z, 2), __builtin_amdgcn_cvt_f32_fp8((int)w.z, 3));
                hi.z = pk2(__builtin_amdgcn_cvt_f32_fp8((int)w.w, 0), __builtin_amdgcn_cvt_f32_fp8((int)w.w, 1)); hi.w = pk2(__builtin_amdgcn_cvt_f32_fp8((int)w.w, 2), __builtin_amdgcn_cvt_f32_fp8((int)w.w, 3));
                const unsigned img = sd ? 98304u : 65536u;
                *(LAS u32x4*)(F.lds + img + off_b(j, 2 * c)) = lo; *(LAS u32x4*)(F.lds + img + off_b(j, 2 * c + 1)) = hi; } }
        LBAR();
        const float qdf = __builtin_amdgcn_exp2f(lgf * (float)(il + 1)), qdb = __builtin_amdgcn_exp2f(lgb * (float)(128 - il));
        float o[8][4]; float ss = 0.f;
#pragma unroll
        for (int et = 0; et < 8; ++et) {
            f32x4 ao = (f32x4){0.f, 0.f, 0.f, 0.f}, af = ao, ab = ao;
            bf16x8 va[4]; { const unsigned a = tp ^ ((unsigned)et << 5); tr_frag4<32768, 32768 + 8192, 32768 + 16384, 32768 + 24576>(va, a, a, a, a); }
#pragma unroll
            for (int ks = 0; ks < 4; ++ks) {
                ao = __builtin_amdgcn_mfma_f32_16x16x32_bf16(va[ks], pf[ks], ao, 0, 0, 0);
                const unsigned ra = (rr0 ^ ((unsigned)ks << 6)) + 4096u * et;
                const bf16x8 fa = *(const LAS bf16x8*)(F.lds + 65536u + ra);
                af = __builtin_amdgcn_mfma_f32_16x16x32_bf16(fa, qf[ks], af, 0, 0, 0);
                const bf16x8 ba = *(const LAS bf16x8*)(F.lds + 98304u + ra);
                ab = __builtin_amdgcn_mfma_f32_16x16x32_bf16(ba, qf[ks], ab, 0, 0, 0);
            }
#pragma unroll
            for (int r = 0; r < 4; ++r) { o[et][r] = ao[r] + qdf * af[r] + qdb * ab[r]; ss += o[et][r] * o[et][r]; }
        }
        if (unit + F.G < nunits) P3B_LOADQ(unit + F.G);
        ss += __shfl_xor(ss, 16); ss += __shfl_xor(ss, 32);
        const float rstd = 1.0f / sqrtf(ss * (1.0f / 128.0f) + EPS);
        bf16_t* op = A2 + (size_t)(row0 + il) * D + h * 128 + 4 * fq;
#pragma unroll
        for (int et = 0; et < 8; ++et) { const u32x2 g = gg[et];
            u32x2 w; w.x = pk2(silu_f(bflo(g.x)) * o[et][0] * rstd, silu_f(bfhi(g.x)) * o[et][1] * rstd); w.y = pk2(silu_f(bflo(g.y)) * o[et][2] * rstd, silu_f(bfhi(g.y)) * o[et][3] * rstd);
            *(u32x2*)(op + et * 16) = w; }
    }
#undef P3B_LOAD
#undef P3B_LOADQ
    __syncthreads();
}

#ifndef TYPE_MASK
#define TYPE_MASK 0x3ff
#endif
#define PTYPE(k) ((k) == 0 ? 0 : ((k) == 17 ? 9 : 1 + (((k) - 1) & 7)))
#define ENTER() do { if (PROBE_REPEAT >= 0) __syncthreads(); int _t = threadIdx.x; asm volatile("" : "+v"(_t)); F.tid = _t; F.lane = _t & 63; F.wave = __builtin_amdgcn_readfirstlane(_t >> 6); } while (0)
#define IN(k) (((TYPE_MASK >> PTYPE(k)) & 1) && lo <= (k) && (k) < hi)
#define SEAM(k) do { if (IN(k) && IN((k) + 1)) xcd_barrier(bar); } while (0)
#define REP(t) for (int rep = (PROBE_REPEAT == (t)) ? 0 : 1; rep < 2; ++rep)


template <int l> __device__ __forceinline__ void layer_phases(Frame& F, const XcdBarrier& bar, const int lo, const int hi) {
        const int pb = 1 + 8 * l;
        const bool last = (l == DEPTH - 1);
        const int Mrows = last ? NLAT : NTOK;
        if (IN(pb + 0)) REP(1) { ENTER(); row_op_a(F, l == 0 ? 0 : 1, rep == 0); }
        SEAM(pb + 0);
        if (IN(pb + 1)) REP(2) { ENTER();
            pg8::SchedDense S; S.init(NTOK, NP, D, F.G, F.bx);
            pg8::EpiInProj E{(bf16_t*)(F.ws + WS_P), (const float*)(F.ws + WS_ROPE), (const float*)(F.ws + WS_ROPE) + 96 * 32};
            pg8::gemm_phase<pg8::EpiInProj, pg8::SchedDense, true, true>(F.lds, F.tid, (const char*)hbuf(F), (const char*)(F.ws + WS_WIN) + (size_t)l * NP * D * 2, D, S, E);
            if (F.G == 256 && F.bx >= 160) idle_convert(F, (F.bx - 160) * 8 + F.wave, l == 0 ? Z_S1 : Z_S7, 6);
        }
        SEAM(pb + 1);
        if (IN(pb + 2)) REP(3) { ENTER(); p3a_states_pool(F, l); }
        SEAM(pb + 2);
        if (IN(pb + 3)) REP(4) { ENTER(); p3b_retention(F, l); if (l == 0 && F.G == 256 && F.vcu >= 128) idle_convert(F, (F.vcu - 128) * 8 + F.wave, Z_S3, 2); }
        SEAM(pb + 3);
        if (IN(pb + 4)) REP(5) { ENTER();
            pg8::SchedDense S; S.init(Mrows, D, D, F.G, F.bx);
            pg8::EpiResid E;
            if (l == 0) { E.rl = F.in[I_X]; E.rc = F.in[I_CTX]; E.rb = nullptr; } else { E.rl = nullptr; E.rc = nullptr; E.rb = (const bf16_t*)(F.ws + WS_XB); }
            E.ob = (rep == 0) ? (bf16_t*)(F.ws + WS_P) : (bf16_t*)(F.ws + WS_XB); E.ssq = (float*)(F.ws + WS_SSQ); E.gmod = mod_ptr(F, l, 0, 2);
            pg8::gemm_phase<pg8::EpiResid, pg8::SchedDense, true, true>(F.lds, F.tid, (const char*)hbuf(F), (const char*)(F.ws + WS_WOUT) + (size_t)l * D * D * 2, D, S, E);
            if (l == 0 && F.G == 256 && F.bx >= 64) idle_convert(F, (F.bx - 64) * 8 + F.wave, Z_S4, 8);
        }
        SEAM(pb + 4);
        if (IN(pb + 5)) REP(6) { ENTER(); if (PROBE_REPEAT == 6 && rep == 0) row_op_b<true>(F, l); else row_op_b<false>(F, l); }
        SEAM(pb + 5);
        if (IN(pb + 6)) REP(7) { ENTER();
            LAS int* tb = build_tb(F, l);
            LAS int* tokt = (LAS int*)(F.lds + TOKT_OFF);
            const int* list = (const int*)(F.ws + WS_LIST);
            pg8::SchedGroup S; S.tb = tb; S.tokt = tokt; S.G = F.G; S.c = F.vcu; S.pitch = D; S.gather = 1;
            { int tokv[8];
#pragma unroll
              for (int i = 0; i < 8; ++i) { pg8::Unit u; tokv[i] = -1;
                  if (S.next(i, u)) { const int g = u.pm; const int e = (int)__popcll(__ballot(F.lane < NE && tb[F.lane + 1] <= g)); const int rt = g - tb[e], cnt = tb[64 + e];
                      if (F.tid < 256) { int r = rt * 256 + F.tid; if (r >= cnt) r = cnt - 1; tokv[i] = list[(size_t)e * NTOK + r]; } } }
#pragma unroll
              for (int i = 0; i < 8; ++i) if (F.tid < 256 && tokv[i] >= 0) tokt[i * 256 + F.tid] = tokv[i]; }
            __syncthreads();
            pg8::EpiSwiGLU8 E{(unsigned char*)(F.ws + WS_ACT), 1.0f / WGU_SCALE};
            pg8::gemm_phase<pg8::EpiSwiGLU8, pg8::SchedGroup, true, true, true>(F.lds, F.tid, (const char*)hbuf(F), (const char*)(F.ws + WS_WGU) + (size_t)l * NE * 1024 * D, D, S, E);
        }
        SEAM(pb + 6);
        if (IN(pb + 7)) REP(8) { ENTER();
            LAS int* tb = build_tb(F, l);
            pg8::SchedGroup S; S.tb = tb; S.tokt = nullptr; S.G = F.G; S.c = F.vcu; S.pitch = FF; S.gather = 0;
            pg8::EpiFp8S E{(unsigned char*)(F.ws + WS_P), D, 1.0f / WD_SCALE};
            pg8::gemm_phase<pg8::EpiFp8S, pg8::SchedGroup, true, true, true>(F.lds, F.tid, (const char*)(F.ws + WS_ACT), (const char*)(F.ws + WS_WD) + (size_t)l * NE * D * FF, FF, S, E);
        }
        SEAM(pb + 7);
}

__global__ void __launch_bounds__(512, 2) fwd_kernel(Args args) {
    extern __shared__ __attribute__((aligned(16))) unsigned char lds_raw[];
    Frame F;
    F.lds = (LAS unsigned char*)lds_raw; F.tid = threadIdx.x; F.lane = F.tid & 63; F.wave = __builtin_amdgcn_readfirstlane(F.tid >> 6);
    F.G = gridDim.x; F.bx = blockIdx.x; F.vcu = (F.G % 8 == 0) ? (F.bx % 8) * (F.G / 8) + F.bx / 8 : F.bx;
    F.in = args.in; F.out = args.out; F.ws = args.ws;
    volatile LAS unsigned* MISC = (volatile LAS unsigned*)(F.lds + MISC_OFF);
    if (F.tid < 4) MISC[F.tid] = 0u;
    __syncthreads();
    unsigned* ctl = (unsigned*)(F.ws + WS_CTL);
    XcdBarrier bar; bar.bar = ctl + CW_BAR; bar.x = 0; bar.st = nullptr;
    const int lo = args.ph_lo, hi = args.ph_hi;
    const bool multi = (hi - lo) > 1;
    if (multi) bar = xcd_barrier_post(ctl + CW_BAR, MISC);
    if (IN(0)) REP(0) { ENTER(); p0_prologue(F, rep); }
    SEAM(0);
    layer_phases<0>(F, bar, lo, hi);
    layer_phases<1>(F, bar, lo, hi);
    if (IN(17)) REP(9) { ENTER(); row_op_a(F, 2, rep == 0); }
#undef IN
#undef SEAM
}

extern "C" void kernel_launch(void* const* d_in, const int* in_sizes, int n_in, void* d_out, int out_size, void* d_ws, size_t ws_size, hipStream_t stream) {
    static int grid = 0;
    if (grid == 0) {
        if (n_in != 22 || out_size != NLAT * D || ws_size < WS_END) { fprintf(stderr, "kernel_launch: unexpected shapes (n_in %d, out %d, ws %zu)\n", n_in, out_size, ws_size); grid = -1; return; }
        int dev = 0, cus = 0, per_cu = 0;
        if (hipGetDevice(&dev) != hipSuccess || hipDeviceGetAttribute(&cus, hipDeviceAttributeMultiprocessorCount, dev) != hipSuccess) { grid = -1; return; }
        if (hipFuncSetAttribute((const void*)fwd_kernel, hipFuncAttributeMaxDynamicSharedMemorySize, LDS_BYTES) != hipSuccess) { fprintf(stderr, "kernel_launch: hipFuncSetAttribute failed\n"); grid = -1; return; }
        if (hipOccupancyMaxActiveBlocksPerMultiprocessor(&per_cu, (const void*)fwd_kernel, 512, LDS_BYTES) != hipSuccess || per_cu < 1) { fprintf(stderr, "kernel_launch: occupancy query says %d\n", per_cu); }
        (void)hipGetLastError();
        grid = cus;
    }
    if (grid < 0) return;
    (void)hipMemsetAsync((char*)d_ws + WS_CTL, 0, CTL_ZERO_BYTES, stream);
    Args a{};
    for (int i = 0; i < 22; ++i) a.in[i] = (const float*)d_in[i];
    a.out = (float*)d_out; a.ws = (unsigned char*)d_ws;
    if (MK_N_LAUNCHES == 1) { a.ph_lo = 0; a.ph_hi = N_PHASES; hipLaunchKernelGGL(fwd_kernel, dim3(grid), dim3(512), LDS_BYTES, stream, a); }
    else { for (int p = 0; p < N_PHASES; ++p) { a.ph_lo = p; a.ph_hi = p + 1; hipLaunchKernelGGL(fwd_kernel, dim3(grid), dim3(512), LDS_BYTES, stream, a); } }
}
```
